# Optimizing an MI355X kernel written in HIP

```python
import math
import jax, jax.numpy as jnp
from jax import lax
import numpy as np


D_MODEL = 1024
BATCH = 16
SEQ = 2048
DEPTH = 1

CHUNK = 64
Q_BLOCK = 128
MLA_HEADS = 8
QK_NOPE_DIM = 64
QK_ROPE_DIM = 32
V_HEAD_DIM = 64
Q_LORA_RANK = 256
KV_LORA_RANK = 128
ATTN_WIDTH = MLA_HEADS * V_HEAD_DIM
CONV_WIDTH = D_MODEL - ATTN_WIDTH
CONV_GROUPS = 8
SHORT_CONV_K = 3
D_FF = 2816
FFN_CONV_K = 3
ROPE_THETA = 10000.0
RMS_EPS = 1e-6
LN_EPS = 1e-5
DEEPNORM_ALPHA = (2.0 * DEPTH) ** 0.25
DEEPNORM_BETA = (8.0 * DEPTH) ** -0.25
IN_PROJ_WIDTH = Q_LORA_RANK + KV_LORA_RANK + QK_ROPE_DIM + 3 * CONV_WIDTH

kernel_name = 'hybrid_mla_shortconv_convffn_block'


def layer_norm(x, g=None, b=None):
    xf = x.astype(jnp.float32)
    mu = jnp.mean(xf, axis=-1, keepdims=True)
    var = jnp.mean(jnp.square(xf - mu), axis=-1, keepdims=True)
    y = (xf - mu) * lax.rsqrt(var + LN_EPS)
    if g is not None:
        y = y * g.astype(jnp.float32) + b.astype(jnp.float32)
    return y.astype(x.dtype)


def rms_norm(x, g):
    xf = x.astype(jnp.float32)
    y = xf * lax.rsqrt(jnp.mean(jnp.square(xf), axis=-1, keepdims=True) + RMS_EPS)
    return (y * g.astype(jnp.float32)).astype(x.dtype)


def group_rms_norm(y, n_groups, g):
    B, S, W = y.shape
    yf = y.reshape(B, S, n_groups, W // n_groups).astype(jnp.float32)
    yf = yf * lax.rsqrt(jnp.mean(jnp.square(yf), axis=-1, keepdims=True) + RMS_EPS)
    return (yf.reshape(B, S, W) * g.astype(jnp.float32)).astype(y.dtype)


def rope_cos_sin(positions, dim, dtype):
    inv_freq = ROPE_THETA ** (-jnp.arange(0, dim, 2, dtype=jnp.float32) / dim)
    ang = positions.astype(jnp.float32)[..., None] * inv_freq
    return jnp.cos(ang).astype(dtype), jnp.sin(ang).astype(dtype)


def apply_rope(x, cos, sin):
    x1, x2 = jnp.split(x, 2, axis=-1)
    return jnp.concatenate([x1 * cos - x2 * sin, x2 * cos + x1 * sin], axis=-1)


def causal_dwconv(u, w, b):
    K = w.shape[0]
    S = u.shape[1]
    up = jnp.pad(u, ((0, 0), (K - 1, 0), (0, 0)))
    y = b
    for k in range(K):
        y = y + w[k] * up[:, k:k + S]
    return y


def chunk_causal_mla_attention(q_nope, q_rope, k_nope, k_rope, v):
    B, S, H, _ = q_nope.shape
    nb = S // Q_BLOCK
    scale = (QK_NOPE_DIM + QK_ROPE_DIM) ** -0.5
    key_chunk = jnp.arange(S) // CHUNK

    def to_blocks(t):
        return t.reshape((B, nb, Q_BLOCK) + t.shape[2:]).swapaxes(0, 1)

    def block(args):
        qn, qr, bi = args
        s = (jnp.einsum('bqhd,bkhd->bhqk', qn, k_nope)
             + jnp.einsum('bqhr,bkr->bhqk', qr, k_rope)).astype(jnp.float32) * scale
        q_chunk = (bi * Q_BLOCK + jnp.arange(Q_BLOCK)) // CHUNK
        allowed = key_chunk[None, :] <= q_chunk[:, None]
        s = jnp.where(allowed[None, None], s, -1e30)
        p = jax.nn.softmax(s, axis=-1).astype(v.dtype)
        return jnp.einsum('bhqk,bkhd->bqhd', p, v)

    out = lax.map(block, (to_blocks(q_nope), to_blocks(q_rope), jnp.arange(nb)))
    return out.swapaxes(0, 1).reshape(B, S, H * V_HEAD_DIM)


def hybrid_mixer(h, cos, sin, w_in, q_norm_g, w_q_up, kv_norm_g, w_kv_up,
                 conv_w, conv_b, out_norm_g, w_out):
    B, S, _ = h.shape
    proj = h @ w_in
    splits = np.cumsum([Q_LORA_RANK, KV_LORA_RANK, QK_ROPE_DIM, CONV_WIDTH, CONV_WIDTH]).tolist()
    c_q, c_kv, k_rope_raw, gate_b, gate_c, conv_v = jnp.split(proj, splits, axis=-1)

    q = (rms_norm(c_q, q_norm_g) @ w_q_up).reshape(B, S, MLA_HEADS, QK_NOPE_DIM + QK_ROPE_DIM)
    q_nope, q_rope = q[..., :QK_NOPE_DIM], q[..., QK_NOPE_DIM:]
    q_rope = apply_rope(q_rope, cos[:, :, None, :], sin[:, :, None, :])
    kv = (rms_norm(c_kv, kv_norm_g) @ w_kv_up).reshape(B, S, MLA_HEADS, QK_NOPE_DIM + V_HEAD_DIM)
    k_nope, v = kv[..., :QK_NOPE_DIM], kv[..., QK_NOPE_DIM:]
    k_rope = apply_rope(k_rope_raw, cos, sin)
    y_attn = chunk_causal_mla_attention(q_nope, q_rope, k_nope, k_rope, v)

    y_conv = gate_b * causal_dwconv(gate_c * conv_v, conv_w, conv_b)

    y = jnp.concatenate([group_rms_norm(y_attn, MLA_HEADS, out_norm_g[:ATTN_WIDTH]),
                         group_rms_norm(y_conv, CONV_GROUPS, out_norm_g[ATTN_WIDTH:])], axis=-1)
    return y @ w_out


def conv_ffn(h, w_up, ffn_conv_w, ffn_conv_b, w_down):
    u = causal_dwconv(h @ w_up, ffn_conv_w, ffn_conv_b)
    g, val = jnp.split(u, 2, axis=-1)
    return (jax.nn.silu(g) * val) @ w_down


def setup_inputs(seed: int = 0) -> dict:
    key = jax.random.key(seed)
    ks = jax.random.split(key, 24)
    L, D = DEPTH, D_MODEL

    def nrm(k, shape, scale):
        return jax.random.normal(k, shape, jnp.float32) * scale

    def gain(k, shape):
        return 1.0 + 0.02 * jax.random.normal(k, shape, jnp.float32)

    offsets = jax.random.randint(ks[2], (BATCH,), 0, 4096, dtype=jnp.int32)
    positions = offsets[:, None] + jnp.arange(SEQ, dtype=jnp.int32)[None, :]
    return {
        'x': nrm(ks[0], (BATCH, SEQ, D), 1.0),
        'c': nrm(ks[1], (BATCH, D), 1.0),
        'positions': positions,
        'w_ada': nrm(ks[3], (L, D, 6 * D), D ** -0.5),
        'b_ada': nrm(ks[4], (L, 6 * D), 0.02),
        'w_in': nrm(ks[5], (L, D, IN_PROJ_WIDTH), D ** -0.5),
        'q_norm_g': gain(ks[6], (L, Q_LORA_RANK)),
        'w_q_up': nrm(ks[7], (L, Q_LORA_RANK, MLA_HEADS * (QK_NOPE_DIM + QK_ROPE_DIM)), Q_LORA_RANK ** -0.5),
        'kv_norm_g': gain(ks[8], (L, KV_LORA_RANK)),
        'w_kv_up': nrm(ks[9], (L, KV_LORA_RANK, MLA_HEADS * (QK_NOPE_DIM + V_HEAD_DIM)), KV_LORA_RANK ** -0.5),
        'conv_w': nrm(ks[10], (L, SHORT_CONV_K, CONV_WIDTH), SHORT_CONV_K ** -0.5),
        'conv_b': nrm(ks[11], (L, CONV_WIDTH), 0.02),
        'out_norm_g': gain(ks[12], (L, D)),
        'w_out': nrm(ks[13], (L, D, D), D ** -0.5 * DEEPNORM_BETA),
        'ln1_g': gain(ks[14], (L, D)),
        'ln1_b': nrm(ks[15], (L, D), 0.02),
        'w_up': nrm(ks[16], (L, D, 2 * D_FF), D ** -0.5),
        'ffn_conv_w': nrm(ks[17], (L, FFN_CONV_K, 2 * D_FF), FFN_CONV_K ** -0.5),
        'ffn_conv_b': nrm(ks[18], (L, 2 * D_FF), 0.02),
        'w_down': nrm(ks[19], (L, D_FF, D), D_FF ** -0.5 * DEEPNORM_BETA),
        'ln2_g': gain(ks[20], (L, D)),
        'ln2_b': nrm(ks[21], (L, D), 0.02),
    }


def reference(x, c, positions, w_ada, b_ada, w_in, q_norm_g, w_q_up, kv_norm_g, w_kv_up,
              conv_w, conv_b, out_norm_g, w_out, ln1_g, ln1_b, w_up, ffn_conv_w, ffn_conv_b,
              w_down, ln2_g, ln2_b):
    cos, sin = rope_cos_sin(positions, QK_ROPE_DIM, x.dtype)
    c_act = jax.nn.silu(c)
    for l in range(DEPTH):
        mod = c_act @ w_ada[l] + b_ada[l]
        shift_m, scale_m, gate_m, shift_f, scale_f, gate_f = [m[:, None, :] for m in jnp.split(mod, 6, axis=-1)]
        h = layer_norm(x) * (1.0 + scale_m) + shift_m
        mix = hybrid_mixer(h, cos, sin, w_in[l], q_norm_g[l], w_q_up[l], kv_norm_g[l], w_kv_up[l],
                           conv_w[l], conv_b[l], out_norm_g[l], w_out[l])
        x = layer_norm(DEEPNORM_ALPHA * x + gate_m * mix, ln1_g[l], ln1_b[l])
        h = layer_norm(x) * (1.0 + scale_f) + shift_f
        ff = conv_ffn(h, w_up[l], ffn_conv_w[l], ffn_conv_b[l], w_down[l])
        x = layer_norm(DEEPNORM_ALPHA * x + gate_f * ff, ln2_g[l], ln2_b[l])
    return x
```

```cpp
#include <hip/hip_runtime.h>
#include <cstdio>
#include <cstdint>

#define LAS __attribute__((address_space(3)))
#define GAS __attribute__((address_space(1)))
typedef unsigned short bf16_t;
typedef short bf16x8 __attribute__((ext_vector_type(8)));
typedef short s16x4 __attribute__((ext_vector_type(4)));
typedef float f32x4 __attribute__((ext_vector_type(4)));
typedef float f32x2 __attribute__((ext_vector_type(2)));
typedef float f32x16 __attribute__((ext_vector_type(16)));
typedef unsigned u32x4 __attribute__((ext_vector_type(4)));
typedef unsigned u32x2 __attribute__((ext_vector_type(2)));
typedef GAS unsigned gu32;

#ifndef MK_N_LAUNCHES
#define MK_N_LAUNCHES 1
#endif

constexpr int D = 1024, NB = 16, SEQ = 2048, T = NB * SEQ, NH = 8, DFF = 2816, UPW = 2 * DFF;
constexpr int PW = 2048;
constexpr int QW = 768, INW = 1952;
constexpr float ALPHA = 1.189207115002721f;
constexpr float QSCALE = 0.10206207261596575f * 1.4426950408889634f;
constexpr float LOG2E = 1.4426950408889634f;

constexpr size_t MiB = 1u << 20;
constexpr size_t WS_CTL = 0, CTL_ZERO_BYTES = 64 * 1024;
constexpr size_t WS_MOD = 1 * MiB;
constexpr size_t WS_ROPE = 2 * MiB;
constexpr size_t WS_SSQQ = 6 * MiB;
constexpr size_t WS_SSQKV = 6 * MiB + 512 * 1024;
constexpr size_t WS_WIN = 8 * MiB;
constexpr size_t WS_WQ = 12 * MiB;
constexpr size_t WS_WKV = 12 * MiB + 512 * 1024;
constexpr size_t WS_WOUT = 13 * MiB;
constexpr size_t WS_WUP = 15 * MiB;
constexpr size_t WS_WDN = 26 * MiB;
constexpr size_t WS_HB = 32 * MiB;
constexpr size_t WS_FF = 32 * MiB;
constexpr size_t WS_P = 96 * MiB;
constexpr size_t WS_MIX = 96 * MiB;
constexpr size_t WS_Q = 224 * MiB;
constexpr size_t WS_KN = 272 * MiB;
constexpr size_t WS_KR = 304 * MiB;
constexpr size_t WS_V = 306 * MiB;
constexpr size_t WS_Y = 338 * MiB;
constexpr size_t WS_ACT = 96 * MiB;
constexpr size_t WS_E = 272 * MiB;
constexpr size_t WS_END = 402 * MiB;
constexpr int CW_BAR = 1024;

constexpr int RING_BYTES = 131072, LDSCTL_OFF = RING_BYTES, MISC_OFF = LDSCTL_OFF + 320, LDS_BYTES = 147456;

__device__ __forceinline__ unsigned cvt_pk_bf16(float lo, float hi) { unsigned r; asm volatile("v_cvt_pk_bf16_f32 %0, %1, %2" : "=v"(r) : "v"(lo), "v"(hi)); return r; }
__device__ __forceinline__ float bf_lo(unsigned u) { return __uint_as_float(u << 16); }
__device__ __forceinline__ float bf_hi(unsigned u) { return __uint_as_float(u & 0xffff0000u); }
__device__ __forceinline__ float fexp2(float x) { return __builtin_amdgcn_exp2f(x); }
__device__ __forceinline__ float frcp(float x) { return __builtin_amdgcn_rcpf(x); }
__device__ __forceinline__ float silu_f(float v) { return v * frcp(1.f + fexp2(-LOG2E * v)); }
__device__ __forceinline__ float wave_sum(float v) {
#pragma unroll
    for (int o = 1; o < 64; o <<= 1) v += __shfl_xor(v, o);
    return v;
}

namespace pg8 {
constexpr int BM = 256, BK = 64, HALF = 128, HTB = HALF * BK * 2, STAGE_BYTES = 8 * HTB, NXCD = 8, WGM = 8;
__host__ __device__ __forceinline__ int lds_byte(int r, int c) { const int st = (r >> 4) * 2 + (c >> 5), rr = r & 15, cc = c & 31, ob = rr * 64 + cc * 2; return st * 1024 + (ob ^ (((ob >> 9) & 1) << 5)); }
__host__ __device__ __forceinline__ void stage_rc(int b, int& R, int& C) { const int st = b / 1024, sb = b % 1024, swz = sb ^ (((sb >> 9) & 1) << 5); R = (st >> 1) * 16 + swz / 64; C = (st & 1) * 32 + (swz % 64) / 2; }
__host__ __device__ __forceinline__ int perm32(int rho) { const int n = rho >> 4, i = rho & 15; return 8 * (i >> 2) + 4 * n + (i & 3); }

struct Unit { int pm, pn; };
struct Gemm { const bf16_t* A; int lda; const bf16_t* Bt; int M, N, K; };

struct StaticOrder {
    int nM, nN, nwg, G, c;
    __device__ void init(int M, int N, int G_, int c_) { nM = M / BM; nN = N / BM; nwg = nM * nN; G = G_; c = c_; }
    __device__ bool next(int i, Unit& u) const {
        const long L = (long)i * G + c; if (L >= nwg) return false;
        int wgid = (int)L; { const int q = nwg / NXCD, r = nwg % NXCD, xcd = wgid % NXCD, off = wgid / NXCD; wgid = (xcd < r ? xcd * (q + 1) : r * (q + 1) + (xcd - r) * q) + off; }
        const int nig = WGM * nN, gid = wgid / nig, fm = gid * WGM, gsz = (nM - fm) < WGM ? (nM - fm) : WGM;
        u.pm = fm + ((wgid % nig) % gsz); u.pn = (wgid % nig) / gsz; return true;
    }
};

template <class Epi, bool ALIGN_EPI>
__device__ __forceinline__ void gemm_phase(LAS unsigned char* lds, const Gemm g, const StaticOrder& S, const Epi& E) {
    int tid = threadIdx.x; asm volatile("" : "+v"(tid));
    const int wid = __builtin_amdgcn_readfirstlane(tid >> 6), lane = tid & 63, wr = wid >> 2, wc = wid & 3, fr = lane & 15, fq = lane >> 4;
    const int K = g.K, nt = K / BK;
    unsigned voffA[2], voffB[2];
#pragma unroll
    for (int i = 0; i < 2; ++i) { int R, C; stage_rc(tid * 16 + i * 8192, R, C);
        voffA[i] = (unsigned)(R * g.lda + C) * 2u; voffB[i] = (unsigned)(R * K + C) * 2u; }
    const size_t kstep = (size_t)(BK * 2);
    const size_t hstepA = (size_t)HALF * g.lda * 2, hstepB = (size_t)HALF * K * 2;
    const size_t tstepA = 2 * hstepA, tstepB = 2 * hstepB;
    const unsigned ldsw = (unsigned)wid * 1024u;
    const int aoff = lds_byte(wr * 64 + fr, fq * 8), boff = lds_byte(wc * 32 + fr, fq * 8);
#define PG8_SA(b, h) (((b) * 2 + (h)) * HTB)
#define PG8_SB(b, h) ((4 + (b) * 2 + (h)) * HTB)
#define PG8_STAGE(bufoff, gbase, voff) do { _Pragma("unroll") for (int _i = 0; _i < 2; ++_i) \
        __builtin_amdgcn_global_load_lds((const unsigned*)((const char*)(gbase) + (voff)[_i]), (LAS unsigned*)(lds + (bufoff) + ldsw + _i * 8192), 16, 0, 0); } while (0)
#define PG8_LDA(dst, b, h) do { _Pragma("unroll") for (int m = 0; m < 4; ++m) _Pragma("unroll") for (int k = 0; k < 2; ++k) dst[m][k] = *(const LAS bf16x8*)(lds + PG8_SA(b, h) + aoff + m * 2048 + k * 1024); } while (0)
#define PG8_LDB(dst, b, h) do { _Pragma("unroll") for (int n = 0; n < 2; ++n) _Pragma("unroll") for (int k = 0; k < 2; ++k) dst[n][k] = *(const LAS bf16x8*)(lds + PG8_SB(b, h) + boff + n * 2048 + k * 1024); } while (0)
#define PG8_MMA(ai, bj, At, Bt) do { __builtin_amdgcn_s_setprio(1); _Pragma("unroll") for (int m = 0; m < 4; ++m) _Pragma("unroll") for (int n = 0; n < 2; ++n) _Pragma("unroll") for (int k = 0; k < 2; ++k) \
        acc[ai][bj][m][n] = __builtin_amdgcn_mfma_f32_16x16x32_bf16(Bt[n][k], At[m][k], acc[ai][bj][m][n], 0, 0, 0); __builtin_amdgcn_s_setprio(0); } while (0)
#define PG8_WAIT_V(n) asm volatile("s_waitcnt vmcnt(" #n ")" ::: "memory")
#define PG8_WAIT_L(n) asm volatile("s_waitcnt lgkmcnt(" #n ")" ::: "memory")
#define PG8_BAR __builtin_amdgcn_s_barrier()
#define PG8_SCHED __builtin_amdgcn_sched_barrier(0)
    Unit cur, nxt; int ui = 0;
    if (!S.next(0, cur)) return;
    f32x4 acc[2][2][4][2];
#pragma unroll
    for (int a = 0; a < 2; ++a)
#pragma unroll
        for (int b = 0; b < 2; ++b)
#pragma unroll
            for (int m = 0; m < 4; ++m)
#pragma unroll
                for (int n = 0; n < 2; ++n) acc[a][b][m][n] = (f32x4){0.f, 0.f, 0.f, 0.f};
    bf16x8 At[4][2], B0[2][2], B1[2][2];
    const char* cA = (const char*)g.A + (size_t)cur.pm * tstepA; const char* cB = (const char*)g.Bt + (size_t)cur.pn * tstepB;
    PG8_STAGE(PG8_SB(0, 0), cB, voffB); PG8_STAGE(PG8_SB(0, 1), cB + hstepB, voffB); PG8_STAGE(PG8_SA(0, 0), cA, voffA); PG8_STAGE(PG8_SA(0, 1), cA + hstepA, voffA);
    if (wr == 1) PG8_BAR;
    PG8_WAIT_V(2); PG8_BAR;
    PG8_STAGE(PG8_SB(1, 0), cB + kstep, voffB); PG8_STAGE(PG8_SA(1, 0), cA + kstep, voffA); PG8_STAGE(PG8_SB(1, 1), cB + hstepB + kstep, voffB);
    PG8_WAIT_V(6); PG8_BAR;
    for (;;) {
        const bool has_next = S.next(ui + 1, nxt);
        const char* nA = has_next ? (const char*)g.A + (size_t)nxt.pm * tstepA : cA; const char* nB = has_next ? (const char*)g.Bt + (size_t)nxt.pn * tstepB : cB;
#pragma nounroll
        for (int t = 0; t < nt; t += 2) {
            const bool last = (t == nt - 2);
            const char* a1 = cA + (size_t)(t + 1) * kstep;
            const char* a2 = last ? nA : cA + (size_t)(t + 2) * kstep; const char* b2 = last ? nB : cB + (size_t)(t + 2) * kstep;
            const char* a3 = a2 + kstep; const char* b3 = b2 + kstep;
            PG8_LDB(B0, 0, 0); PG8_LDB(B1, 0, 1); PG8_SCHED; PG8_LDA(At, 0, 0); PG8_STAGE(PG8_SA(1, 1), a1 + hstepA, voffA);
            PG8_WAIT_V(8); PG8_WAIT_L(0); PG8_BAR; PG8_MMA(0, 0, At, B0); PG8_MMA(0, 1, At, B1); PG8_BAR; PG8_SCHED;
            PG8_LDA(At, 0, 1); PG8_STAGE(PG8_SB(0, 0), b2, voffB); PG8_STAGE(PG8_SB(0, 1), b2 + hstepB, voffB); PG8_STAGE(PG8_SA(0, 0), a2, voffA);
            PG8_WAIT_V(8); PG8_WAIT_L(0); PG8_BAR; PG8_MMA(1, 0, At, B0); PG8_MMA(1, 1, At, B1); PG8_BAR; PG8_SCHED;
            PG8_LDB(B0, 1, 0); PG8_LDB(B1, 1, 1); PG8_SCHED; PG8_LDA(At, 1, 0); PG8_STAGE(PG8_SA(0, 1), a2 + hstepA, voffA);
            PG8_WAIT_V(8); PG8_WAIT_L(0); PG8_BAR; PG8_MMA(0, 0, At, B0); PG8_MMA(0, 1, At, B1); PG8_BAR; PG8_SCHED;
            PG8_LDA(At, 1, 1); PG8_STAGE(PG8_SB(1, 0), b3, voffB); PG8_STAGE(PG8_SB(1, 1), b3 + hstepB, voffB); PG8_STAGE(PG8_SA(1, 0), a3, voffA);
            PG8_WAIT_V(8); PG8_WAIT_L(0); PG8_BAR; PG8_MMA(1, 0, At, B0); PG8_MMA(1, 1, At, B1); PG8_BAR; PG8_SCHED;
        }
        if constexpr (ALIGN_EPI) { if (wr == 0) PG8_BAR; }
        { int t_e = threadIdx.x; asm volatile("" : "+v"(t_e)); const int fr_e = t_e & 15, fq_e = (t_e >> 4) & 3;
          E(acc, cur, wr, wc, fr_e, fq_e); }
        if (!has_next) break;
#pragma unroll
        for (int a = 0; a < 2; ++a)
#pragma unroll
            for (int b = 0; b < 2; ++b)
#pragma unroll
                for (int m = 0; m < 4; ++m)
#pragma unroll
                    for (int n = 0; n < 2; ++n) acc[a][b][m][n] = (f32x4){0.f, 0.f, 0.f, 0.f};
        cur = nxt; cA = nA; cB = nB; ++ui;
        if constexpr (ALIGN_EPI) { if (wr == 1) PG8_BAR; }
    }
    PG8_WAIT_V(0);
    if constexpr (!ALIGN_EPI) { if (wr == 0) PG8_BAR; }
    PG8_BAR;
#undef PG8_SA
#undef PG8_SB
#undef PG8_STAGE
#undef PG8_LDA
#undef PG8_LDB
#undef PG8_MMA
#undef PG8_WAIT_V
#undef PG8_WAIT_L
#undef PG8_BAR
#undef PG8_SCHED
}

typedef f32x4 Acc[2][2][4][2];

struct EpiStore {
    bf16_t* O; int ldc;
    __device__ __forceinline__ void operator()(const Acc& acc, const Unit& u, int wr, int wc, int fr, int fq) const {
        const int row0 = u.pm * BM + wr * 64 + fr, col0 = u.pn * BM + wc * 32 + 8 * fq;
#pragma unroll
        for (int ai = 0; ai < 2; ++ai)
#pragma unroll
            for (int m = 0; m < 4; ++m) { bf16_t* rowp = O + (size_t)(row0 + ai * HALF + m * 16) * ldc + col0;
#pragma unroll
                for (int bj = 0; bj < 2; ++bj) { const f32x4 v0 = acc[ai][bj][m][0], v1 = acc[ai][bj][m][1];
                    u32x4 w; w.x = cvt_pk_bf16(v0[0], v0[1]); w.y = cvt_pk_bf16(v0[2], v0[3]); w.z = cvt_pk_bf16(v1[0], v1[1]); w.w = cvt_pk_bf16(v1[2], v1[3]);
                    *(u32x4*)(rowp + bj * HALF) = w; } }
    }
};

struct EpiP {
    bf16_t* O; float* ssq_q; float* ssq_kv;
    __device__ __forceinline__ void operator()(const Acc& acc, const Unit& u, int wr, int wc, int fr, int fq) const {
        EpiStore st{O, PW}; st(acc, u, wr, wc, fr, fq);
        if (u.pn <= 1) {
            const int row0 = u.pm * BM + wr * 64 + fr; float* dst = (u.pn == 0) ? ssq_q : ssq_kv;
#pragma unroll
            for (int ai = 0; ai < 2; ++ai)
#pragma unroll
                for (int m = 0; m < 4; ++m) { float s = 0.f;
#pragma unroll
                    for (int n = 0; n < 2; ++n) { const f32x4 a = acc[ai][0][m][n]; s += (a[0] * a[0] + a[1] * a[1]) + (a[2] * a[2] + a[3] * a[3]); }
                    if (u.pn == 0) {
#pragma unroll
                        for (int n = 0; n < 2; ++n) { const f32x4 a = acc[ai][1][m][n]; s += (a[0] * a[0] + a[1] * a[1]) + (a[2] * a[2] + a[3] * a[3]); } }
                    s += __shfl_xor(s, 16); s += __shfl_xor(s, 32);
                    if (fq == 0) dst[(size_t)(row0 + ai * HALF + m * 16) * 4 + wc] = s; }
        }
    }
};

struct EpiQ {
    bf16_t* Q; const float* ssq; const float* rope;
    __device__ __forceinline__ void operator()(const Acc& acc, const Unit& u, int wr, int wc, int fr, int fq) const {
        const int row0 = u.pm * BM + wr * 64 + fr;
#pragma unroll
        for (int bj = 0; bj < 2; ++bj) { const int g = 8 * u.pn + 4 * bj + wc; const bool is_rope = (g % 3) == 2;
            bf16_t* qcol = Q + 32 * g;
            if (!is_rope) {
#pragma unroll
                for (int ai = 0; ai < 2; ++ai)
#pragma unroll
                    for (int m = 0; m < 4; ++m) { const int t = row0 + ai * HALF + m * 16;
                        const f32x4 sp = *(const f32x4*)(ssq + (size_t)t * 4);
                        const float f = rsqrtf(((sp[0] + sp[1]) + (sp[2] + sp[3])) * (1.f / 256.f) + 1e-6f) * QSCALE;
                        const f32x4 v0 = acc[ai][bj][m][0] * f, v1 = acc[ai][bj][m][1] * f;
                        u32x4 w; w.x = cvt_pk_bf16(v0[0], v0[1]); w.y = cvt_pk_bf16(v0[2], v0[3]); w.z = cvt_pk_bf16(v1[0], v1[1]); w.w = cvt_pk_bf16(v1[2], v1[3]);
                        *(u32x4*)(qcol + (size_t)t * QW + 8 * fq) = w;
                        if (m & 1) asm volatile("" ::: "memory"); }
            } else {
#pragma unroll
                for (int ai = 0; ai < 2; ++ai)
#pragma unroll
                    for (int m = 0; m < 4; ++m) { const int t = row0 + ai * HALF + m * 16;
                        const f32x4 sp = *(const f32x4*)(ssq + (size_t)t * 4);
                        const float f = rsqrtf(((sp[0] + sp[1]) + (sp[2] + sp[3])) * (1.f / 256.f) + 1e-6f) * QSCALE;
                        const f32x4 cs = *(const f32x4*)(rope + (size_t)t * 32 + 4 * fq), sn = *(const f32x4*)(rope + (size_t)t * 32 + 16 + 4 * fq);
                        const f32x4 a0 = acc[ai][bj][m][0], a1 = acc[ai][bj][m][1];
                        const f32x4 o1 = (a0 * cs - a1 * sn) * f, o2 = (a1 * cs + a0 * sn) * f;
                        u32x2 w1, w2; w1.x = cvt_pk_bf16(o1[0], o1[1]); w1.y = cvt_pk_bf16(o1[2], o1[3]); w2.x = cvt_pk_bf16(o2[0], o2[1]); w2.y = cvt_pk_bf16(o2[2], o2[3]);
                        *(u32x2*)(qcol + (size_t)t * QW + 4 * fq) = w1; *(u32x2*)(qcol + (size_t)t * QW + 16 + 4 * fq) = w2;
                        if (m & 1) asm volatile("" ::: "memory"); }
            } }
    }
};

struct EpiKV {
    bf16_t* KN; bf16_t* V; const float* ssq;
    __device__ __forceinline__ void operator()(const Acc& acc, const Unit& u, int wr, int wc, int fr, int fq) const {
        const int row0 = u.pm * BM + wr * 64 + fr; const int b = u.pm >> 3;
#pragma unroll
        for (int bj = 0; bj < 2; ++bj) { const int g = 8 * u.pn + 4 * bj + wc, head = g >> 2, part = g & 3;
            char* base = (part < 2) ? (char*)KN + (4 * part + fq) * 1024 + fr * 16 : (char*)V + (part - 2) * 4096 + fr * 64 + fq * 16;
            const int mstep = (part < 2) ? 256 : 1024;
            base += (size_t)(b * 8 + head) * 32 * 8192;
#pragma unroll
            for (int ai = 0; ai < 2; ++ai) { const int tile = (4 * u.pm + 2 * ai + wr) & 31;
#pragma unroll
                for (int m = 0; m < 4; ++m) { const int t = row0 + ai * HALF + m * 16;
                    const f32x4 sp = *(const f32x4*)(ssq + (size_t)t * 4);
                    const float f = rsqrtf(((sp[0] + sp[1]) + (sp[2] + sp[3])) * (1.f / 128.f) + 1e-6f);
                    const f32x4 v0 = acc[ai][bj][m][0] * f, v1 = acc[ai][bj][m][1] * f;
                    u32x4 w; w.x = cvt_pk_bf16(v0[0], v0[1]); w.y = cvt_pk_bf16(v0[2], v0[3]); w.z = cvt_pk_bf16(v1[0], v1[1]); w.w = cvt_pk_bf16(v1[2], v1[3]);
                    *(u32x4*)(base + (size_t)tile * 8192 + m * mstep) = w;
                    if (m & 1) asm volatile("" ::: "memory"); } } }
    }
};

__device__ __forceinline__ f32x4 shfl4(f32x4 v, int src) { f32x4 r; r[0] = __shfl(v[0], src); r[1] = __shfl(v[1], src); r[2] = __shfl(v[2], src); r[3] = __shfl(v[3], src); return r; }

struct EpiUp {
    bf16_t* ACT; float* E; const float* cw; const float* cb;
    __device__ __forceinline__ void operator()(const Acc& acc, const Unit& u, int wr, int wc, int fr, int fq) const {
        const int src1 = 16 * fq + ((fr + 15) & 15), src2 = 16 * fq + ((fr + 14) & 15);
        const int cbase = 128 * u.pn + 32 * wc + 8 * fq;
        u32x2 res0[2][4];
#pragma unroll
        for (int n = 0; n < 2; ++n) { const int c0 = cbase + 4 * n;
            const f32x4 wg0 = *(const f32x4*)(cw + c0), wg1 = *(const f32x4*)(cw + UPW + c0), wg2 = *(const f32x4*)(cw + 2 * UPW + c0), bg = *(const f32x4*)(cb + c0);
            const f32x4 wv0 = *(const f32x4*)(cw + DFF + c0), wv1 = *(const f32x4*)(cw + UPW + DFF + c0), wv2 = *(const f32x4*)(cw + 2 * UPW + DFF + c0), bv = *(const f32x4*)(cb + DFF + c0);
#pragma unroll
            for (int ai = 0; ai < 2; ++ai) { f32x4 pg1 = {0.f, 0.f, 0.f, 0.f}, pg2 = pg1, pv1 = pg1, pv2 = pg1;
                const int blk = 4 * u.pm + 2 * ai + wr;
#pragma unroll
                for (int m = 0; m < 4; ++m) { const f32x4 gcur = acc[ai][0][m][n], vcur = acc[ai][1][m][n];
                    const f32x4 rg1 = shfl4(gcur, src1), rg2 = shfl4(gcur, src2), rv1 = shfl4(vcur, src1), rv2 = shfl4(vcur, src2);
                    const f32x4 g1 = (fr >= 1) ? rg1 : pg1, g2 = (fr >= 2) ? rg2 : pg2, v1 = (fr >= 1) ? rv1 : pv1, v2 = (fr >= 2) ? rv2 : pv2;
                    const f32x4 cg = bg + wg0 * g2 + wg1 * g1 + wg2 * gcur, cv = bv + wv0 * v2 + wv1 * v1 + wv2 * vcur;
                    f32x4 a; a[0] = silu_f(cg[0]) * cv[0]; a[1] = silu_f(cg[1]) * cv[1]; a[2] = silu_f(cg[2]) * cv[2]; a[3] = silu_f(cg[3]) * cv[3];
                    u32x2 w; w.x = cvt_pk_bf16(a[0], a[1]); w.y = cvt_pk_bf16(a[2], a[3]);
                    const int t = u.pm * BM + ai * HALF + wr * 64 + m * 16 + fr;
                    if (n == 0) res0[ai][m] = w;
                    else if (!(m == 0 && fr < 2)) { u32x4 o; o.x = res0[ai][m].x; o.y = res0[ai][m].y; o.z = w.x; o.w = w.y; *(u32x4*)(ACT + (size_t)t * DFF + cbase) = o; }
                    if (m == 0 && fr < 2) { float* e = E + ((size_t)blk * 4 + fr) * UPW + c0; *(f32x4*)e = gcur; *(f32x4*)(e + DFF) = vcur; }
                    if (m == 3 && fr >= 14) { float* e = E + ((size_t)blk * 4 + 2 + (fr - 14)) * UPW + c0; *(f32x4*)e = gcur; *(f32x4*)(e + DFF) = vcur; }
                    pg1 = rg1; pg2 = rg2; pv1 = rv1; pv2 = rv2; } } }
    }
};
}

namespace att {
constexpr int K_OFF = 0, KSLOT = 12288, V_OFF = 2 * KSLOT, VSLOT = 8192, WS_OFF = V_OFF + 2 * VSLOT, OST_OFF = WS_OFF + 8 * 256, LDS_END = OST_OFF + 8 * 4096;
static_assert(LDS_END <= RING_BYTES, "attention LDS");
__device__ __forceinline__ int crow(int r, int hi) { return (r & 3) + 8 * (r >> 2) + 4 * hi; }
typedef short v4i16_t __attribute__((ext_vector_type(4)));
__device__ __forceinline__ s16x4 vtr(const LAS unsigned char* p) { return __builtin_bit_cast(s16x4, __builtin_amdgcn_ds_read_tr16_b64_v4i16((LAS v4i16_t*)p)); }
__device__ __forceinline__ void glds(const char* src, LAS unsigned char* dst) { __builtin_amdgcn_global_load_lds((const unsigned*)src, (LAS unsigned*)dst, 16, 0, 0); }
#define ATT_WAIT_BAR() asm volatile("s_waitcnt vmcnt(0) lgkmcnt(0)\n\ts_barrier" ::: "memory")

__device__ __forceinline__ void attn_unit(int b, int h, int qb, const bf16_t* Q, const bf16_t* KN, const bf16_t* KR, const bf16_t* V, bf16_t* Y, const float* ong, LAS unsigned char* lds) {
    int tid = threadIdx.x; asm volatile("" : "+v"(tid));
    const int lane = tid & 63, r32 = lane & 31, hi = lane >> 5; const int wid = __builtin_amdgcn_readfirstlane(tid >> 6);
    const int NT = 4 * qb + 4, jmax = 4 * qb + (wid >> 1);
    const size_t bh = (size_t)(b * 8 + h);
    const char* kn_src = (const char*)KN + bh * 32 * 8192 + wid * 1024 + lane * 16;
    const char* v_src = (const char*)V + bh * 32 * 8192 + wid * 1024 + lane * 16;
    const char* kr_src = (const char*)KR + (size_t)b * 32 * 4096 + (wid & 3) * 1024 + lane * 16;
#define ATT_ISSUE(tile, slot) do { glds(kn_src + (size_t)(tile) * 8192, lds + K_OFF + (slot) * KSLOT + wid * 1024); glds(v_src + (size_t)(tile) * 8192, lds + V_OFF + (slot) * VSLOT + wid * 1024); \
        if (wid < 4) glds(kr_src + (size_t)(tile) * 4096, lds + K_OFF + (slot) * KSLOT + 8192 + wid * 1024); } while (0)
    ATT_ISSUE(0, 0);
    const int t0 = b * SEQ + 256 * qb + 32 * wid;
    bf16x8 qr[6];
    { const bf16_t* qp = Q + (size_t)(t0 + r32) * QW + 96 * h + 8 * hi;
#pragma unroll
      for (int ks = 0; ks < 6; ++ks) qr[ks] = *(const bf16x8*)(qp + 16 * ks); }
    float mrun = -1e30f, lrun = 0.f; f32x16 o[2]; o[0] = f32x16{}; o[1] = f32x16{};
    LAS float* wsf = (LAS float*)(lds + WS_OFF + wid * 256);
    for (int j = 0; j < NT; ++j) {
        ATT_WAIT_BAR();
        const int slot = j & 1;
        if (j + 1 < NT) ATT_ISSUE(j + 1, slot ^ 1);
        if (j <= jmax) {
            const LAS unsigned char* kp = lds + K_OFF + slot * KSLOT + hi * 1024 + r32 * 16;
            f32x16 p0 = f32x16{}, p1 = f32x16{};
#pragma unroll
            for (int ks = 0; ks < 6; ++ks) { const bf16x8 k0 = *(const LAS bf16x8*)(kp + ks * 2048), k1 = *(const LAS bf16x8*)(kp + ks * 2048 + 512);
                p0 = __builtin_amdgcn_mfma_f32_32x32x16_bf16(k0, qr[ks], p0, 0, 0, 0); p1 = __builtin_amdgcn_mfma_f32_32x32x16_bf16(k1, qr[ks], p1, 0, 0, 0); }
            float rm = fmaxf(p0[0], p1[0]);
#pragma unroll
            for (int r = 1; r < 16; ++r) rm = fmaxf(rm, fmaxf(p0[r], p1[r]));
            rm = fmaxf(rm, __shfl_xor(rm, 32));
            const float mn = fmaxf(mrun, rm);
            if (__any(mn > mrun)) {
                const float alpha = fexp2(mrun - mn); lrun *= alpha; mrun = mn;
                if (hi == 0) wsf[r32] = alpha;
#pragma unroll
                for (int r = 0; r < 16; ++r) { const float a = wsf[crow(r, hi)]; o[0][r] *= a; o[1][r] *= a; }
            }
            float sum = 0.f;
#pragma unroll
            for (int r = 0; r < 16; ++r) { p0[r] = fexp2(p0[r] - mrun); p1[r] = fexp2(p1[r] - mrun); sum += p0[r] + p1[r]; }
            lrun += sum;
            bf16x8 pa[4];
            { u32x4 w0, w1, w2, w3;
              w0.x = cvt_pk_bf16(p0[0], p0[1]); w0.y = cvt_pk_bf16(p0[2], p0[3]); w0.z = cvt_pk_bf16(p0[4], p0[5]); w0.w = cvt_pk_bf16(p0[6], p0[7]);
              w1.x = cvt_pk_bf16(p0[8], p0[9]); w1.y = cvt_pk_bf16(p0[10], p0[11]); w1.z = cvt_pk_bf16(p0[12], p0[13]); w1.w = cvt_pk_bf16(p0[14], p0[15]);
              w2.x = cvt_pk_bf16(p1[0], p1[1]); w2.y = cvt_pk_bf16(p1[2], p1[3]); w2.z = cvt_pk_bf16(p1[4], p1[5]); w2.w = cvt_pk_bf16(p1[6], p1[7]);
              w3.x = cvt_pk_bf16(p1[8], p1[9]); w3.y = cvt_pk_bf16(p1[10], p1[11]); w3.z = cvt_pk_bf16(p1[12], p1[13]); w3.w = cvt_pk_bf16(p1[14], p1[15]);
              pa[0] = __builtin_bit_cast(bf16x8, w0); pa[1] = __builtin_bit_cast(bf16x8, w1); pa[2] = __builtin_bit_cast(bf16x8, w2); pa[3] = __builtin_bit_cast(bf16x8, w3); }
            const LAS unsigned char* vp = lds + V_OFF + slot * VSLOT + ((lane >> 4) & 1) * 32 + (lane & 3) * 8 + (4 * hi + ((lane & 15) >> 2)) * 64;
#pragma unroll
            for (int d0 = 0; d0 < 2; ++d0)
#pragma unroll
                for (int ks = 0; ks < 4; ++ks) { const s16x4 lo = vtr(vp + d0 * 4096 + ks * 1024), hh = vtr(vp + d0 * 4096 + ks * 1024 + 512);
                    const bf16x8 vf = {lo[0], lo[1], lo[2], lo[3], hh[0], hh[1], hh[2], hh[3]};
                    o[d0] = __builtin_amdgcn_mfma_f32_32x32x16_bf16(pa[ks], vf, o[d0], 0, 0, 0); }
        }
    }
    { const float lt = lrun + __shfl_xor(lrun, 32);
      if (hi == 0) wsf[r32] = frcp(lt);
      const float g0 = ong[64 * h + r32], g1 = ong[64 * h + 32 + r32];
      LAS bf16_t* stg = (LAS bf16_t*)(lds + OST_OFF + wid * 4096);
#pragma unroll
      for (int r = 0; r < 16; ++r) { const float inv = wsf[crow(r, hi)]; const float a = o[0][r] * inv, c = o[1][r] * inv;
          float ss = a * a + c * c;
          ss += __shfl_xor(ss, 1); ss += __shfl_xor(ss, 2); ss += __shfl_xor(ss, 4); ss += __shfl_xor(ss, 8); ss += __shfl_xor(ss, 16);
          const float rs = rsqrtf(ss * (1.f / 64.f) + 1e-6f);
          const unsigned w = cvt_pk_bf16(a * rs * g0, c * rs * g1);
          const int orow = crow(r, hi); stg[orow * 64 + r32] = (bf16_t)(w & 0xffffu); stg[orow * 64 + 32 + r32] = (bf16_t)(w >> 16); }
      bf16_t* Yw = Y + (size_t)t0 * D + 64 * h;
#pragma unroll
      for (int i = 0; i < 4; ++i) { const int row = i * 8 + (lane >> 3), ch = lane & 7; const u32x4 v = *(const LAS u32x4*)(stg + row * 64 + ch * 8); *(u32x4*)(Yw + (size_t)row * D + ch * 8) = v; } }
    asm volatile("s_waitcnt lgkmcnt(0)\n\ts_barrier" ::: "memory");
#undef ATT_ISSUE
}
}

#define XB_TMO      128
#define XB_XCNT(j)  (256  + 64 * (j))
#define XB_XSUB(j)  (1280 + 64 * (j))
#define XB_XGEN(j)  (2304 + 64 * (j))
#define XB_TOP      3328
#define XB_TOPGEN   3392
#define XCD_BAR_WORDS 3456
#define XB_SPIN_CAP (1u << 18)
__device__ __forceinline__ unsigned xb_ld(unsigned* p)              { return __hip_atomic_load(p, __ATOMIC_RELAXED, __HIP_MEMORY_SCOPE_AGENT); }
__device__ __forceinline__ unsigned xb_add(unsigned* p, unsigned v) { return __hip_atomic_fetch_add(p, v, __ATOMIC_RELAXED, __HIP_MEMORY_SCOPE_AGENT); }
__device__ __forceinline__ unsigned xb_xcc_id() { return (unsigned)__builtin_amdgcn_s_getreg((3 << 11) | 20) & 0xFu; }
#define XB_SPIN(cond, bar) do { unsigned _sp = 0; while (cond) { __builtin_amdgcn_s_sleep(1); \
    if ((++_sp & 255u) == 0u) { if (xb_ld(&(bar)[XB_TMO])) break; if (_sp > XB_SPIN_CAP) { atomicAdd(&(bar)[XB_TMO], 1u); break; } } } } while (0)
struct XcdBarrier { unsigned* bar; unsigned x; volatile LAS unsigned* st; };
__device__ __forceinline__ XcdBarrier xcd_barrier_post(unsigned* bar, volatile LAS unsigned* st) {
    XcdBarrier b; b.bar = bar; b.x = xb_xcc_id(); b.st = st;
    if (threadIdx.x == 0) (void)xb_add(&bar[XB_XCNT(b.x)], 1u);
    return b;
}
__device__ __forceinline__ void xcd_barrier_complete(unsigned* bar, unsigned x, unsigned& nloc, unsigned& nx) {
    const unsigned G = gridDim.x * gridDim.y * gridDim.z;
    unsigned sum, cnt, mine, sp = 0u;
    for (;;) {
        sum = 0u; cnt = 0u; mine = 0u;
#pragma unroll
        for (unsigned j = 0; j < 16; ++j) { const unsigned c = xb_ld(&bar[XB_XCNT(j)]); sum += c; cnt += (c > 0u) ? 1u : 0u; mine = (j == x) ? c : mine; }
        if (sum == G) break;
        __builtin_amdgcn_s_sleep(1);
        if ((++sp & 255u) == 0u) { if (xb_ld(&bar[XB_TMO])) break; if (sp > XB_SPIN_CAP) { atomicAdd(&bar[XB_TMO], 1u); break; } }
    }
    nloc = mine > 0u ? mine : 1u; nx = cnt > 0u ? cnt : 1u;
}
__device__ __forceinline__ void xcd_barrier(const XcdBarrier& b) {
    asm volatile("s_waitcnt vmcnt(0)" ::: "memory");
    __syncthreads();
    if (threadIdx.x == 0) {
        unsigned* bar = b.bar;
        __builtin_amdgcn_s_waitcnt(0);
        unsigned nloc = b.st[0], nx = b.st[1];
        if (nloc == 0u) { xcd_barrier_complete(bar, b.x, nloc, nx); b.st[0] = nloc; b.st[1] = nx; }
        const unsigned old = xb_add(&bar[XB_XSUB(b.x)], 1u);
        const unsigned gen = old / nloc;
        if (old + 1u == (gen + 1u) * nloc) {
            __builtin_amdgcn_fence(__ATOMIC_RELEASE, "agent");
            asm volatile("s_waitcnt vmcnt(0)" ::: "memory");
            const unsigned og = xb_add(&bar[XB_TOP], 1u);
            const unsigned tg = og / nx;
            if (og + 1u == (tg + 1u) * nx) xb_add(&bar[XB_TOPGEN], 1u);
            else XB_SPIN(xb_ld(&bar[XB_TOPGEN]) == tg, bar);
            __builtin_amdgcn_fence(__ATOMIC_ACQUIRE, "agent");
            xb_add(&bar[XB_XGEN(b.x)], 1u);
            asm volatile("s_waitcnt vmcnt(0)" ::: "memory");
        } else {
            XB_SPIN(xb_ld(&bar[XB_XGEN(b.x)]) == gen, bar);
            __builtin_amdgcn_fence(__ATOMIC_ACQUIRE, "agent");
            asm volatile("s_waitcnt vmcnt(0)" ::: "memory");
        }
    }
    __syncthreads();
}

struct Args { const float* in[22]; const int* pos; float* out; unsigned char* ws; int ph_lo, ph_hi; };
__constant__ float c_invfreq[16] = {1.0f, 0.5623413251903491f, 0.31622776601683794f, 0.1778279410038923f, 0.1f, 0.05623413251903491f, 0.03162277660168379f, 0.01778279410038923f,
                                    0.01f, 0.005623413251903491f, 0.0031622776601683794f, 0.001778279410038923f, 0.001f, 0.0005623413251903491f, 0.00031622776601683794f, 0.0001778279410038923f};

__device__ __forceinline__ int colmap(int which, int s) {
    const int p = (s & ~31) + pg8::perm32(s & 31);
    switch (which) {
        case 0: return p < 416 ? p : (p < 512 ? -1 : p - 96);
        case 1: return ((s >> 5) % 3 == 2) ? s : p;
        case 4: { const int pn = s >> 8, bj = (s >> 7) & 1, wc = (s >> 5) & 3; return bj * DFF + 128 * pn + 32 * wc + pg8::perm32(s & 31); }
        default: return p;
    }
}
__device__ __forceinline__ void p0_transpose_item(const float* W, int ldw, int Ksrc, const float* kscale, bf16_t* WT, int Kdst, int which, LAS float* scr, int item, int nblk, int lane) {
    const int kb = item / nblk, nb = item % nblk, k0 = 64 * kb, s0 = 32 * nb;
    const int cm = colmap(which, s0 + (lane & 31));
#pragma unroll 8
    for (int i = 0; i < 32; ++i) { const int kk = 2 * i + (lane >> 5); const int k = k0 + kk;
        float v = 0.f; if (cm >= 0 && k < Ksrc) { v = W[(size_t)k * ldw + cm]; if (kscale) v *= kscale[k]; }
        scr[kk * 33 + (lane & 31)] = v; }
    asm volatile("s_waitcnt lgkmcnt(0)" ::: "memory");
    const int c = lane & 7;
#pragma unroll
    for (int j = 0; j < 4; ++j) { const int n = (lane >> 3) + 8 * j; const LAS float* s = scr + (8 * c) * 33 + n;
        u32x4 o; o.x = cvt_pk_bf16(s[0 * 33], s[1 * 33]); o.y = cvt_pk_bf16(s[2 * 33], s[3 * 33]); o.z = cvt_pk_bf16(s[4 * 33], s[5 * 33]); o.w = cvt_pk_bf16(s[6 * 33], s[7 * 33]);
        *(u32x4*)(WT + (size_t)(s0 + n) * Kdst + k0 + 8 * c) = o; }
    asm volatile("s_waitcnt lgkmcnt(0)" ::: "memory");
}

constexpr int N_PHASES = 11;
#define OPAQUE_LANE(name) int name##_t = (int)threadIdx.x; asm volatile("" : "+v"(name##_t)); const int name = name##_t & 63

__global__ void __launch_bounds__(512, 2) mk_fwd(Args args) {
    extern __shared__ __attribute__((aligned(16))) unsigned char lds_raw[];
    LAS unsigned char* lds = (LAS unsigned char*)lds_raw;
    volatile LAS unsigned* MISC = (volatile LAS unsigned*)(lds + MISC_OFF);
    const int tid = threadIdx.x, lane = tid & 63, wave = __builtin_amdgcn_readfirstlane(tid >> 6);
    const int G = gridDim.x; const int bx = blockIdx.x; const int vcu = (G % 8 == 0) ? (bx % 8) * (G / 8) + bx / 8 : bx;
    const int gw = vcu * 8 + wave, NGW = G * 8;
    unsigned char* ws = args.ws;
    const float* x = args.in[0]; const float* cvec = args.in[1]; const int* pos = args.pos;
    const float* w_ada = args.in[3]; const float* b_ada = args.in[4]; const float* w_in = args.in[5];
    const float* qg = args.in[6]; const float* w_qup = args.in[7]; const float* kvg = args.in[8]; const float* w_kvup = args.in[9];
    const float* conv_w = args.in[10]; const float* conv_b = args.in[11]; const float* ong = args.in[12]; const float* w_out = args.in[13];
    const float* ln1g = args.in[14]; const float* ln1b = args.in[15]; const float* w_up = args.in[16];
    const float* fcw = args.in[17]; const float* fcb = args.in[18]; const float* w_down = args.in[19];
    const float* ln2g = args.in[20]; const float* ln2b = args.in[21];
    float* out = args.out;
    float* MOD = (float*)(ws + WS_MOD); float* ROPE = (float*)(ws + WS_ROPE); float* SSQQ = (float*)(ws + WS_SSQQ); float* SSQKV = (float*)(ws + WS_SSQKV);
    bf16_t* WIN = (bf16_t*)(ws + WS_WIN); bf16_t* WQ = (bf16_t*)(ws + WS_WQ); bf16_t* WKV = (bf16_t*)(ws + WS_WKV); bf16_t* WOUT = (bf16_t*)(ws + WS_WOUT);
    bf16_t* WUP = (bf16_t*)(ws + WS_WUP); bf16_t* WDN = (bf16_t*)(ws + WS_WDN);
    bf16_t* HB = (bf16_t*)(ws + WS_HB); bf16_t* FF = (bf16_t*)(ws + WS_FF); bf16_t* P = (bf16_t*)(ws + WS_P); bf16_t* MIX = (bf16_t*)(ws + WS_MIX);
    bf16_t* Qb = (bf16_t*)(ws + WS_Q); bf16_t* KN = (bf16_t*)(ws + WS_KN); bf16_t* KR = (bf16_t*)(ws + WS_KR); bf16_t* Vb = (bf16_t*)(ws + WS_V);
    bf16_t* Y = (bf16_t*)(ws + WS_Y); bf16_t* ACT = (bf16_t*)(ws + WS_ACT); float* E = (float*)(ws + WS_E);

    for (int u = tid; u < (LDS_BYTES - LDSCTL_OFF) / 4; u += 512) ((LAS unsigned*)(lds + LDSCTL_OFF))[u] = 0u;
    __syncthreads();
    XcdBarrier bar; bar.bar = (unsigned*)(ws + WS_CTL) + CW_BAR; bar.x = 0; bar.st = nullptr;
    if (MK_N_LAUNCHES == 1) bar = xcd_barrier_post((unsigned*)(ws + WS_CTL) + CW_BAR, MISC + 8);
    const int lo = args.ph_lo, hi = args.ph_hi;
#ifndef PH_MASK
#define PH_MASK 0x7ff
#endif
#define IN(k) (((PH_MASK >> (k)) & 1) && lo <= (k) && (k) < hi)
#define SEAM(k) do { if (IN(k) && IN((k) + 1)) xcd_barrier(bar); } while (0)

    if (IN(0)) {
        OPAQUE_LANE(ln);
        if (bx < 192) {
            LAS float* cact = (LAS float*)lds; LAS float* part = (LAS float*)(lds + 65536);
            for (int i = tid; i < 16 * 1024; i += 512) { const int k = i >> 4, b = i & 15; const float v = cvec[b * D + k]; cact[i] = v / (1.f + __expf(-v)); }
            __syncthreads();
            const int n0 = 32 * bx, col = tid & 31, ks = tid >> 5;
            float a[16];
#pragma unroll
            for (int b = 0; b < 16; ++b) a[b] = 0.f;
            for (int kk = 0; kk < 64; ++kk) { const int k = 64 * ks + kk; const float w = w_ada[(size_t)k * 6144 + n0 + col];
                const LAS f32x4* cp = (const LAS f32x4*)(cact + k * 16);
#pragma unroll
                for (int q4 = 0; q4 < 4; ++q4) { const f32x4 cv = cp[q4]; a[4 * q4 + 0] += w * cv[0]; a[4 * q4 + 1] += w * cv[1]; a[4 * q4 + 2] += w * cv[2]; a[4 * q4 + 3] += w * cv[3]; } }
#pragma unroll
            for (int b = 0; b < 16; ++b) part[(ks * 16 + b) * 32 + col] = a[b];
            __syncthreads();
            { const int b = tid >> 5; float s = 0.f;
              for (int k2 = 0; k2 < 16; ++k2) s += part[(k2 * 16 + b) * 32 + col];
              MOD[b * 6144 + n0 + col] = s + b_ada[n0 + col]; }
            __syncthreads();
        }
        for (int idx = gw * 64 + ln; idx < T * 16; idx += NGW * 64) { const int t = idx >> 4, i = idx & 15; const float ang = (float)pos[t] * c_invfreq[i];
            ROPE[(size_t)t * 32 + i] = cosf(ang); ROPE[(size_t)t * 32 + 16 + i] = sinf(ang); }
        LAS float* scr = (LAS float*)(lds + wave * 16384);
        constexpr int I0 = 16 * 64, I1 = 4 * 24, I2 = 4 * 32, I3 = 16 * 32, I4 = 16 * 176, I5 = 44 * 32, NIT = I0 + I1 + I2 + I3 + I4 + I5;
        for (int it = gw; it < NIT; it += NGW) {
            int r = it;
            if (r < I0) { p0_transpose_item(w_in, INW, D, nullptr, WIN, D, 0, scr, r, 64, ln); continue; } r -= I0;
            if (r < I1) { p0_transpose_item(w_qup, QW, 256, qg, WQ, 256, 1, scr, r, 24, ln); continue; } r -= I1;
            if (r < I2) { p0_transpose_item(w_kvup, 1024, 128, kvg, WKV, 256, 2, scr, r, 32, ln); continue; } r -= I2;
            if (r < I3) { p0_transpose_item(w_out, D, D, nullptr, WOUT, D, 3, scr, r, 32, ln); continue; } r -= I3;
            if (r < I4) { p0_transpose_item(w_up, UPW, D, nullptr, WUP, D, 4, scr, r, 176, ln); continue; } r -= I4;
            p0_transpose_item(w_down, D, DFF, nullptr, WDN, DFF, 5, scr, r, 32, ln);
        }
    }
    SEAM(0);
    if (IN(1)) {
        OPAQUE_LANE(ln);
        for (int row0 = gw * 16; row0 < T; row0 += NGW * 16) { const int b = row0 / SEQ; const float* mb = MOD + b * 6144;
            f32x4 sc[4], sh[4];
#pragma unroll
            for (int j = 0; j < 4; ++j) { const int col = 4 * ln + 256 * j; sh[j] = *(const f32x4*)(mb + col); sc[j] = *(const f32x4*)(mb + 1024 + col) + 1.f; }
            for (int rr = 0; rr < 16; ++rr) { const int t = row0 + rr; const float* xr = x + (size_t)t * D;
                f32x4 v[4]; float s = 0.f;
#pragma unroll
                for (int j = 0; j < 4; ++j) { v[j] = *(const f32x4*)(xr + 4 * ln + 256 * j); s += (v[j][0] + v[j][1]) + (v[j][2] + v[j][3]); }
                const float mean = wave_sum(s) * (1.f / D); float q = 0.f;
#pragma unroll
                for (int j = 0; j < 4; ++j) { v[j] = v[j] - mean; q += (v[j][0] * v[j][0] + v[j][1] * v[j][1]) + (v[j][2] * v[j][2] + v[j][3] * v[j][3]); }
                const float rstd = rsqrtf(wave_sum(q) * (1.f / D) + 1e-5f);
#pragma unroll
                for (int j = 0; j < 4; ++j) { const f32x4 o = v[j] * rstd * sc[j] + sh[j]; u32x2 w; w.x = cvt_pk_bf16(o[0], o[1]); w.y = cvt_pk_bf16(o[2], o[3]);
                    *(u32x2*)(HB + (size_t)t * D + 4 * ln + 256 * j) = w; } } }
    }
    SEAM(1);
    if (IN(2)) {
        pg8::Gemm g{HB, D, WIN, T, PW, D}; pg8::StaticOrder S; S.init(T, PW, G, bx);
        pg8::EpiP E1{P, SSQQ, SSQKV};
        pg8::gemm_phase<pg8::EpiP, true>(lds, g, S, E1);
    }
    SEAM(2);
    if (IN(3)) {
        OPAQUE_LANE(ln);
#ifndef P3_MASK
#define P3_MASK 15
#endif
        if (P3_MASK & 1) { pg8::Gemm g{P, PW, WQ, T, QW, 256}; pg8::StaticOrder S; S.init(T, QW, G, bx); pg8::EpiQ E2{Qb, SSQQ, ROPE}; pg8::gemm_phase<pg8::EpiQ, true>(lds, g, S, E2); }
        if (P3_MASK & 2) { pg8::Gemm g{P + 256, PW, WKV, T, 1024, 256}; pg8::StaticOrder S; S.init(T, 1024, G, bx); pg8::EpiKV E3{KN, Vb, SSQKV}; pg8::gemm_phase<pg8::EpiKV, true>(lds, g, S, E3); }
        if (P3_MASK & 4) for (int row0 = gw * 16; row0 < T; row0 += NGW * 16) {
            const int c0 = 8 * ln;
            float w0[8], w1[8], w2[8], cb8[8], gn[8];
#pragma unroll
            for (int e = 0; e < 8; ++e) { w0[e] = conv_w[c0 + e]; w1[e] = conv_w[512 + c0 + e]; w2[e] = conv_w[1024 + c0 + e]; cb8[e] = conv_b[c0 + e]; gn[e] = ong[512 + c0 + e]; }
            float um2[8], um1[8];
#pragma unroll
            for (int e = 0; e < 8; ++e) { um2[e] = 0.f; um1[e] = 0.f; }
            if ((row0 % SEQ) != 0) {
                const u32x4 a2 = *(const u32x4*)(P + (size_t)(row0 - 2) * PW + 1024 + c0), b2 = *(const u32x4*)(P + (size_t)(row0 - 2) * PW + 1536 + c0);
                const u32x4 a1 = *(const u32x4*)(P + (size_t)(row0 - 1) * PW + 1024 + c0), b1 = *(const u32x4*)(P + (size_t)(row0 - 1) * PW + 1536 + c0);
#pragma unroll
                for (int e = 0; e < 4; ++e) { um2[2 * e] = bf_lo(a2[e]) * bf_lo(b2[e]); um2[2 * e + 1] = bf_hi(a2[e]) * bf_hi(b2[e]); um1[2 * e] = bf_lo(a1[e]) * bf_lo(b1[e]); um1[2 * e + 1] = bf_hi(a1[e]) * bf_hi(b1[e]); }
            }
            for (int rr = 0; rr < 16; ++rr) { const int t = row0 + rr; const bf16_t* pr = P + (size_t)t * PW;
                const u32x4 gb = *(const u32x4*)(pr + 512 + c0), gc = *(const u32x4*)(pr + 1024 + c0), cv = *(const u32x4*)(pr + 1536 + c0);
                float u0[8], yv[8]; float ss = 0.f;
#pragma unroll
                for (int e = 0; e < 4; ++e) { u0[2 * e] = bf_lo(gc[e]) * bf_lo(cv[e]); u0[2 * e + 1] = bf_hi(gc[e]) * bf_hi(cv[e]); }
#pragma unroll
                for (int e = 0; e < 8; ++e) { const float gbe = (e & 1) ? bf_hi(gb[e >> 1]) : bf_lo(gb[e >> 1]);
                    yv[e] = gbe * (cb8[e] + w0[e] * um2[e] + w1[e] * um1[e] + w2[e] * u0[e]); ss += yv[e] * yv[e]; um2[e] = um1[e]; um1[e] = u0[e]; }
                ss += __shfl_xor(ss, 1); ss += __shfl_xor(ss, 2); ss += __shfl_xor(ss, 4);
                const float rs = rsqrtf(ss * (1.f / 64.f) + 1e-6f);
                u32x4 o; o.x = cvt_pk_bf16(yv[0] * rs * gn[0], yv[1] * rs * gn[1]); o.y = cvt_pk_bf16(yv[2] * rs * gn[2], yv[3] * rs * gn[3]);
                o.z = cvt_pk_bf16(yv[4] * rs * gn[4], yv[5] * rs * gn[5]); o.w = cvt_pk_bf16(yv[6] * rs * gn[6], yv[7] * rs * gn[7]);
                *(u32x4*)(Y + (size_t)t * D + 512 + c0) = o; }
        }
        if (P3_MASK & 8) for (int tl = gw; tl < NB * 32; tl += NGW) { const int t = tl * 64 + ln; const bf16_t* pr = P + (size_t)t * PW + 384;
            u32x4 raw[4];
#pragma unroll
            for (int e = 0; e < 4; ++e) raw[e] = *(const u32x4*)(pr + 8 * e);
            float xv[32];
#pragma unroll
            for (int e = 0; e < 16; ++e) { xv[2 * e] = bf_lo(raw[e >> 2][e & 3]); xv[2 * e + 1] = bf_hi(raw[e >> 2][e & 3]); }
            float cs[16], sn[16];
#pragma unroll
            for (int e = 0; e < 4; ++e) { const f32x4 c4 = *(const f32x4*)(ROPE + (size_t)t * 32 + 4 * e), s4 = *(const f32x4*)(ROPE + (size_t)t * 32 + 16 + 4 * e);
                cs[4 * e] = c4[0]; cs[4 * e + 1] = c4[1]; cs[4 * e + 2] = c4[2]; cs[4 * e + 3] = c4[3]; sn[4 * e] = s4[0]; sn[4 * e + 1] = s4[1]; sn[4 * e + 2] = s4[2]; sn[4 * e + 3] = s4[3]; }
            float ov[32];
#pragma unroll
            for (int i = 0; i < 16; ++i) { ov[i] = xv[i] * cs[i] - xv[16 + i] * sn[i]; ov[16 + i] = xv[16 + i] * cs[i] + xv[i] * sn[i]; }
            char* dst = (char*)KR + (size_t)tl * 4096 + ln * 16;
#pragma unroll
            for (int c = 0; c < 4; ++c) { u32x4 o; o.x = cvt_pk_bf16(ov[8 * c], ov[8 * c + 1]); o.y = cvt_pk_bf16(ov[8 * c + 2], ov[8 * c + 3]); o.z = cvt_pk_bf16(ov[8 * c + 4], ov[8 * c + 5]); o.w = cvt_pk_bf16(ov[8 * c + 6], ov[8 * c + 7]);
                *(u32x4*)(dst + c * 1024) = o; } }
    }
    SEAM(3);
    if (IN(4)) {
        for (int it = vcu; it < 256; it += G) { const int bh = it >> 1, e = it & 1, b = bh >> 3, h = bh & 7;
            for (int i = 0; i < 4; ++i) { const int qb = (i == 0) ? 7 - e : (i == 1) ? e : (i == 2) ? 5 - e : 2 + e;
                att::attn_unit(b, h, qb, Qb, KN, KR, Vb, Y, ong, lds); } }
    }
    SEAM(4);
    if (IN(5)) {
        pg8::Gemm g{Y, D, WOUT, T, D, D}; pg8::StaticOrder S; S.init(T, D, G, bx); pg8::EpiStore E4{MIX, D};
        pg8::gemm_phase<pg8::EpiStore, true>(lds, g, S, E4);
    }
    SEAM(5);
    if (IN(6)) {
        OPAQUE_LANE(ln);
        for (int row0 = gw * 16; row0 < T; row0 += NGW * 16) { const int b = row0 / SEQ; const float* mb = MOD + b * 6144;
            f32x4 gt[4], g1v[4], b1v[4], sc[4], sh[4];
#pragma unroll
            for (int j = 0; j < 4; ++j) { const int col = 4 * ln + 256 * j; gt[j] = *(const f32x4*)(mb + 2048 + col); g1v[j] = *(const f32x4*)(ln1g + col); b1v[j] = *(const f32x4*)(ln1b + col);
                sh[j] = *(const f32x4*)(mb + 3072 + col); sc[j] = *(const f32x4*)(mb + 4096 + col) + 1.f; }
            for (int rr = 0; rr < 16; ++rr) { const int t = row0 + rr;
                f32x4 v[4]; float s = 0.f;
#pragma unroll
                for (int j = 0; j < 4; ++j) { const int col = 4 * ln + 256 * j; const f32x4 xv = *(const f32x4*)(x + (size_t)t * D + col); const u32x2 mw = *(const u32x2*)(MIX + (size_t)t * D + col);
                    const f32x4 mx = {bf_lo(mw.x), bf_hi(mw.x), bf_lo(mw.y), bf_hi(mw.y)};
                    v[j] = xv * ALPHA + gt[j] * mx; s += (v[j][0] + v[j][1]) + (v[j][2] + v[j][3]); }
                float mean = wave_sum(s) * (1.f / D); float q = 0.f;
#pragma unroll
                for (int j = 0; j < 4; ++j) { v[j] = v[j] - mean; q += (v[j][0] * v[j][0] + v[j][1] * v[j][1]) + (v[j][2] * v[j][2] + v[j][3] * v[j][3]); }
                float rstd = rsqrtf(wave_sum(q) * (1.f / D) + 1e-5f);
                s = 0.f;
#pragma unroll
                for (int j = 0; j < 4; ++j) { v[j] = v[j] * rstd * g1v[j] + b1v[j]; *(f32x4*)(out + (size_t)t * D + 4 * ln + 256 * j) = v[j]; s += (v[j][0] + v[j][1]) + (v[j][2] + v[j][3]); }
                mean = wave_sum(s) * (1.f / D); q = 0.f;
#pragma unroll
                for (int j = 0; j < 4; ++j) { v[j] = v[j] - mean; q += (v[j][0] * v[j][0] + v[j][1] * v[j][1]) + (v[j][2] * v[j][2] + v[j][3] * v[j][3]); }
                rstd = rsqrtf(wave_sum(q) * (1.f / D) + 1e-5f);
#pragma unroll
                for (int j = 0; j < 4; ++j) { const f32x4 o = v[j] * rstd * sc[j] + sh[j]; u32x2 w; w.x = cvt_pk_bf16(o[0], o[1]); w.y = cvt_pk_bf16(o[2], o[3]);
                    *(u32x2*)(HB + (size_t)t * D + 4 * ln + 256 * j) = w; } } }
    }
    SEAM(6);
    if (IN(7)) {
        pg8::Gemm g{HB, D, WUP, T, UPW, D}; pg8::StaticOrder S; S.init(T, UPW, G, bx); pg8::EpiUp E5{ACT, E, fcw, fcb};
        pg8::gemm_phase<pg8::EpiUp, true>(lds, g, S, E5);
    }
    SEAM(7);
    if (IN(8)) {
        OPAQUE_LANE(ln);
        constexpr int NITEM = 512 * 2 * (DFF / 4);
        for (int it = (gw * 64 + ln); it < NITEM; it += NGW * 64) { const int c4 = it % (DFF / 4), rb = it / (DFF / 4), rr = rb & 1, blk = rb >> 1; const int c0 = 4 * c4;
            const bool first = (blk & 31) == 0;
            const float* e0 = E + ((size_t)blk * 4 + rr) * UPW + c0;
            const float* em1 = (rr == 0) ? E + ((size_t)(blk - 1) * 4 + 3) * UPW + c0 : E + ((size_t)blk * 4 + 0) * UPW + c0;
            const float* em2 = (rr == 0) ? E + ((size_t)(blk - 1) * 4 + 2) * UPW + c0 : E + ((size_t)(blk - 1) * 4 + 3) * UPW + c0;
            const f32x4 z = {0.f, 0.f, 0.f, 0.f};
            const f32x4 g0 = *(const f32x4*)e0, v0 = *(const f32x4*)(e0 + DFF);
            const bool has1 = !(first && rr == 0), has2 = !first;
            const f32x4 g1 = has1 ? *(const f32x4*)em1 : z, v1 = has1 ? *(const f32x4*)(em1 + DFF) : z;
            const f32x4 g2 = has2 ? *(const f32x4*)em2 : z, v2 = has2 ? *(const f32x4*)(em2 + DFF) : z;
            const f32x4 wg0 = *(const f32x4*)(fcw + c0), wg1 = *(const f32x4*)(fcw + UPW + c0), wg2 = *(const f32x4*)(fcw + 2 * UPW + c0), bg = *(const f32x4*)(fcb + c0);
            const f32x4 wv0 = *(const f32x4*)(fcw + DFF + c0), wv1 = *(const f32x4*)(fcw + UPW + DFF + c0), wv2 = *(const f32x4*)(fcw + 2 * UPW + DFF + c0), bv = *(const f32x4*)(fcb + DFF + c0);
            const f32x4 cg = bg + wg0 * g2 + wg1 * g1 + wg2 * g0, cv = bv + wv0 * v2 + wv1 * v1 + wv2 * v0;
            u32x2 w; w.x = cvt_pk_bf16(silu_f(cg[0]) * cv[0], silu_f(cg[1]) * cv[1]); w.y = cvt_pk_bf16(silu_f(cg[2]) * cv[2], silu_f(cg[3]) * cv[3]);
            *(u32x2*)(ACT + (size_t)(64 * blk + rr) * DFF + c0) = w; }
    }
    SEAM(8);
    if (IN(9)) {
        pg8::Gemm g{ACT, DFF, WDN, T, D, DFF}; pg8::StaticOrder S; S.init(T, D, G, bx); pg8::EpiStore E6{FF, D};
        pg8::gemm_phase<pg8::EpiStore, true>(lds, g, S, E6);
    }
    SEAM(9);
    if (IN(10)) {
        OPAQUE_LANE(ln);
        for (int row0 = gw * 16; row0 < T; row0 += NGW * 16) { const int b = row0 / SEQ; const float* mb = MOD + b * 6144;
            f32x4 gt[4], g2v[4], b2v[4];
#pragma unroll
            for (int j = 0; j < 4; ++j) { const int col = 4 * ln + 256 * j; gt[j] = *(const f32x4*)(mb + 5120 + col); g2v[j] = *(const f32x4*)(ln2g + col); b2v[j] = *(const f32x4*)(ln2b + col); }
            for (int rr = 0; rr < 16; ++rr) { const int t = row0 + rr;
                f32x4 v[4]; float s = 0.f;
#pragma unroll
                for (int j = 0; j < 4; ++j) { const int col = 4 * ln + 256 * j; const f32x4 xv = *(const f32x4*)(out + (size_t)t * D + col); const u32x2 mw = *(const u32x2*)(FF + (size_t)t * D + col);
                    const f32x4 mx = {bf_lo(mw.x), bf_hi(mw.x), bf_lo(mw.y), bf_hi(mw.y)};
                    v[j] = xv * ALPHA + gt[j] * mx; s += (v[j][0] + v[j][1]) + (v[j][2] + v[j][3]); }
                const float mean = wave_sum(s) * (1.f / D); float q = 0.f;
#pragma unroll
                for (int j = 0; j < 4; ++j) { v[j] = v[j] - mean; q += (v[j][0] * v[j][0] + v[j][1] * v[j][1]) + (v[j][2] * v[j][2] + v[j][3] * v[j][3]); }
                const float rstd = rsqrtf(wave_sum(q) * (1.f / D) + 1e-5f);
#pragma unroll
                for (int j = 0; j < 4; ++j) { *(f32x4*)(out + (size_t)t * D + 4 * ln + 256 * j) = v[j] * rstd * g2v[j] + b2v[j]; } } }
    }
#undef IN
#undef SEAM
}

extern "C" void kernel_launch(void* const* d_in, const int* in_sizes, int n_in, void* d_out, int out_size, void* d_ws, size_t ws_size, hipStream_t stream) {
    static int grid = 0;
    if (grid == 0) {
        if (n_in != 22 || in_sizes[0] != T * D || out_size != T * D || ws_size < WS_END) { fprintf(stderr, "kernel_launch: unexpected shapes / workspace (n_in %d, ws %zu)\n", n_in, ws_size); grid = -1; return; }
        int dev = 0, cus = 0, per_cu = 0;
        if (hipGetDevice(&dev) != hipSuccess || hipDeviceGetAttribute(&cus, hipDeviceAttributeMultiprocessorCount, dev) != hipSuccess) { grid = -1; return; }
        if (hipFuncSetAttribute((const void*)mk_fwd, hipFuncAttributeMaxDynamicSharedMemorySize, LDS_BYTES) != hipSuccess) { fprintf(stderr, "kernel_launch: hipFuncSetAttribute failed\n"); grid = -1; return; }
        if (hipOccupancyMaxActiveBlocksPerMultiprocessor(&per_cu, (const void*)mk_fwd, 512, LDS_BYTES) != hipSuccess || per_cu < 1) { fprintf(stderr, "kernel_launch: occupancy query says %d blocks per CU\n", per_cu); (void)hipGetLastError(); grid = -1; return; }
        grid = cus;
    }
    if (grid < 0) return;
    hipMemsetAsync((char*)d_ws + WS_CTL, 0, CTL_ZERO_BYTES, stream);
    Args a{};
    for (int i = 0; i < 22; ++i) a.in[i] = (const float*)d_in[i];
    a.pos = (const int*)d_in[2]; a.out = (float*)d_out; a.ws = (unsigned char*)d_ws;
#if MK_N_LAUNCHES == 1
    a.ph_lo = 0; a.ph_hi = N_PHASES;
    hipLaunchKernelGGL(mk_fwd, dim3(grid), dim3(512), LDS_BYTES, stream, a);
#else
    for (int p = 0; p < N_PHASES; ++p) { a.ph_lo = p; a.ph_hi = p + 1; hipLaunchKernelGGL(mk_fwd, dim3(grid), dim3(512), LDS_BYTES, stream, a); }
#endif
}
```

```cpp
#include <hip/hip_runtime.h>
#include <cstdio>
#include <cstdint>

#define LAS __attribute__((address_space(3)))
#define GAS __attribute__((address_space(1)))
typedef unsigned short bf16_t;
typedef short bf16x8 __attribute__((ext_vector_type(8)));
typedef short s16x4 __attribute__((ext_vector_type(4)));
typedef float f32x4 __attribute__((ext_vector_type(4)));
typedef float f32x2 __attribute__((ext_vector_type(2)));
typedef float f32x16 __attribute__((ext_vector_type(16)));
typedef unsigned u32x4 __attribute__((ext_vector_type(4)));
typedef unsigned u32x2 __attribute__((ext_vector_type(2)));
typedef GAS unsigned gu32;

#ifndef MK_N_LAUNCHES
#define MK_N_LAUNCHES 1
#endif

constexpr int D = 1024, NB = 16, SEQ = 2048, T = NB * SEQ, NH = 8, DFF = 2816, UPW = 2 * DFF;
constexpr int PW = 2048;
constexpr int QW = 768, INW = 1952;
constexpr float ALPHA = 1.189207115002721f;
constexpr float QSCALE = 0.10206207261596575f * 1.4426950408889634f;
constexpr float LOG2E = 1.4426950408889634f;

constexpr size_t MiB = 1u << 20;
constexpr size_t WS_CTL = 0, CTL_ZERO_BYTES = 64 * 1024;
constexpr size_t WS_MOD = 1 * MiB;
constexpr size_t WS_ROPE = 2 * MiB;
constexpr size_t WS_SSQQ = 6 * MiB;
constexpr size_t WS_SSQKV = 6 * MiB + 512 * 1024;
constexpr size_t WS_WIN = 8 * MiB;
constexpr size_t WS_WQ = 12 * MiB;
constexpr size_t WS_WKV = 12 * MiB + 512 * 1024;
constexpr size_t WS_WOUT = 13 * MiB;
constexpr size_t WS_WUP = 15 * MiB;
constexpr size_t WS_WDN = 26 * MiB;
constexpr size_t WS_HB = 32 * MiB;
constexpr size_t WS_FF = 32 * MiB;
constexpr size_t WS_P = 96 * MiB;
constexpr size_t WS_MIX = 96 * MiB;
constexpr size_t WS_Q = 224 * MiB;
constexpr size_t WS_KN = 272 * MiB;
constexpr size_t WS_KR = 304 * MiB;
constexpr size_t WS_V = 306 * MiB;
constexpr size_t WS_Y = 338 * MiB;
constexpr size_t WS_ACT = 96 * MiB;
constexpr size_t WS_E = 272 * MiB;
constexpr size_t WS_END = 402 * MiB;
constexpr int CW_BAR = 1024;

constexpr int RING_BYTES = 131072, LDSCTL_OFF = RING_BYTES, MISC_OFF = LDSCTL_OFF + 320, LDS_BYTES = 147456;

__device__ __forceinline__ unsigned cvt_pk_bf16(float lo, float hi) { unsigned r; asm volatile("v_cvt_pk_bf16_f32 %0, %1, %2" : "=v"(r) : "v"(lo), "v"(hi)); return r; }
__device__ __forceinline__ float bf_lo(unsigned u) { return __uint_as_float(u << 16); }
__device__ __forceinline__ float bf_hi(unsigned u) { return __uint_as_float(u & 0xffff0000u); }
__device__ __forceinline__ float fexp2(float x) { return __builtin_amdgcn_exp2f(x); }
__device__ __forceinline__ float frcp(float x) { return __builtin_amdgcn_rcpf(x); }
__device__ __forceinline__ float silu_f(float v) { return v * frcp(1.f + fexp2(-LOG2E * v)); }
__device__ __forceinline__ float wave_sum(float v) {
#pragma unroll
    for (int o = 1; o < 64; o <<= 1) v += __shfl_xor(v, o);
    return v;
}

namespace pg8 {
constexpr int BM = 256, BK = 64, HALF = 128, HTB = HALF * BK * 2, STAGE_BYTES = 8 * HTB, NXCD = 8, WGM = 8;
__host__ __device__ __forceinline__ int lds_byte(int r, int c) { const int st = (r >> 4) * 2 + (c >> 5), rr = r & 15, cc = c & 31, ob = rr * 64 + cc * 2; return st * 1024 + (ob ^ (((ob >> 9) & 1) << 5)); }
__host__ __device__ __forceinline__ void stage_rc(int b, int& R, int& C) { const int st = b / 1024, sb = b % 1024, swz = sb ^ (((sb >> 9) & 1) << 5); R = (st >> 1) * 16 + swz / 64; C = (st & 1) * 32 + (swz % 64) / 2; }
__host__ __device__ __forceinline__ int perm32(int rho) { const int n = rho >> 4, i = rho & 15; return 8 * (i >> 2) + 4 * n + (i & 3); }

struct Unit { int pm, pn; };
struct Gemm { const bf16_t* A; int lda; const bf16_t* Bt; int M, N, K; };

struct StaticOrder {
    int nM, nN, nwg, G, c;
    __device__ void init(int M, int N, int G_, int c_) { nM = M / BM; nN = N / BM; nwg = nM * nN; G = G_; c = c_; }
    __device__ bool next(int i, Unit& u) const {
        const long L = (long)i * G + c; if (L >= nwg) return false;
        int wgid = (int)L; { const int q = nwg / NXCD, r = nwg % NXCD, xcd = wgid % NXCD, off = wgid / NXCD; wgid = (xcd < r ? xcd * (q + 1) : r * (q + 1) + (xcd - r) * q) + off; }
        const int nig = WGM * nN, gid = wgid / nig, fm = gid * WGM, gsz = (nM - fm) < WGM ? (nM - fm) : WGM;
        u.pm = fm + ((wgid % nig) % gsz); u.pn = (wgid % nig) / gsz; return true;
    }
};

template <class Epi, bool ALIGN_EPI>
__device__ __forceinline__ void gemm_phase(LAS unsigned char* lds, const Gemm g, const StaticOrder& S, const Epi& E) {
    int tid = threadIdx.x; asm volatile("" : "+v"(tid));
    const int wid = __builtin_amdgcn_readfirstlane(tid >> 6), lane = tid & 63, wr = wid >> 2, wc = wid & 3, fr = lane & 15, fq = lane >> 4;
    const int K = g.K, nt = K / BK;
    unsigned voffA[2], voffB[2];
#pragma unroll
    for (int i = 0; i < 2; ++i) { int R, C; stage_rc(tid * 16 + i * 8192, R, C);
        voffA[i] = (unsigned)(R * g.lda + C) * 2u; voffB[i] = (unsigned)(R * K + C) * 2u; }
    const size_t kstep = (size_t)(BK * 2);
    const size_t hstepA = (size_t)HALF * g.lda * 2, hstepB = (size_t)HALF * K * 2;
    const size_t tstepA = 2 * hstepA, tstepB = 2 * hstepB;
    const unsigned ldsw = (unsigned)wid * 1024u;
    const int aoff = lds_byte(wr * 64 + fr, fq * 8), boff = lds_byte(wc * 32 + fr, fq * 8);
#define PG8_SA(b, h) (((b) * 2 + (h)) * HTB)
#define PG8_SB(b, h) ((4 + (b) * 2 + (h)) * HTB)
#define PG8_STAGE(bufoff, gbase, voff) do { _Pragma("unroll") for (int _i = 0; _i < 2; ++_i) \
        __builtin_amdgcn_global_load_lds((const unsigned*)((const char*)(gbase) + (voff)[_i]), (LAS unsigned*)(lds + (bufoff) + ldsw + _i * 8192), 16, 0, 0); } while (0)
#define PG8_LDA(dst, b, h) do { _Pragma("unroll") for (int m = 0; m < 4; ++m) _Pragma("unroll") for (int k = 0; k < 2; ++k) dst[m][k] = *(const LAS bf16x8*)(lds + PG8_SA(b, h) + aoff + m * 2048 + k * 1024); } while (0)
#define PG8_LDB(dst, b, h) do { _Pragma("unroll") for (int n = 0; n < 2; ++n) _Pragma("unroll") for (int k = 0; k < 2; ++k) dst[n][k] = *(const LAS bf16x8*)(lds + PG8_SB(b, h) + boff + n * 2048 + k * 1024); } while (0)
#define PG8_MMA(ai, bj, At, Bt) do { __builtin_amdgcn_s_setprio(1); _Pragma("unroll") for (int m = 0; m < 4; ++m) _Pragma("unroll") for (int n = 0; n < 2; ++n) _Pragma("unroll") for (int k = 0; k < 2; ++k) \
        acc[ai][bj][m][n] = __builtin_amdgcn_mfma_f32_16x16x32_bf16(Bt[n][k], At[m][k], acc[ai][bj][m][n], 0, 0, 0); __builtin_amdgcn_s_setprio(0); } while (0)
#define PG8_WAIT_V(n) asm volatile("s_waitcnt vmcnt(" #n ")" ::: "memory")
#define PG8_WAIT_L(n) asm volatile("s_waitcnt lgkmcnt(" #n ")" ::: "memory")
#define PG8_BAR __builtin_amdgcn_s_barrier()
#define PG8_SCHED __builtin_amdgcn_sched_barrier(0)
    Unit cur, nxt; int ui = 0;
    if (!S.next(0, cur)) return;
    f32x4 acc[2][2][4][2];
#pragma unroll
    for (int a = 0; a < 2; ++a)
#pragma unroll
        for (int b = 0; b < 2; ++b)
#pragma unroll
            for (int m = 0; m < 4; ++m)
#pragma unroll
                for (int n = 0; n < 2; ++n) acc[a][b][m][n] = (f32x4){0.f, 0.f, 0.f, 0.f};
    bf16x8 At[4][2], B0[2][2], B1[2][2];
    const char* cA = (const char*)g.A + (size_t)cur.pm * tstepA; const char* cB = (const char*)g.Bt + (size_t)cur.pn * tstepB;
    if constexpr (Epi::HAS_PREFETCH) E.prefetch(cur, 0, lds, wid, lane);
    PG8_STAGE(PG8_SB(0, 0), cB, voffB); PG8_STAGE(PG8_SB(0, 1), cB + hstepB, voffB); PG8_STAGE(PG8_SA(0, 0), cA, voffA); PG8_STAGE(PG8_SA(0, 1), cA + hstepA, voffA);
    if (wr == 1) PG8_BAR;
    PG8_WAIT_V(2); PG8_BAR;
    PG8_STAGE(PG8_SB(1, 0), cB + kstep, voffB); PG8_STAGE(PG8_SA(1, 0), cA + kstep, voffA); PG8_STAGE(PG8_SB(1, 1), cB + hstepB + kstep, voffB);
    PG8_WAIT_V(6); PG8_BAR;
    for (;;) {
        const bool has_next = S.next(ui + 1, nxt);
        const char* nA = has_next ? (const char*)g.A + (size_t)nxt.pm * tstepA : cA; const char* nB = has_next ? (const char*)g.Bt + (size_t)nxt.pn * tstepB : cB;
#pragma nounroll
        for (int t = 0; t < nt; t += 2) {
            const bool last = (t == nt - 2);
            const char* a1 = cA + (size_t)(t + 1) * kstep;
            const char* a2 = last ? nA : cA + (size_t)(t + 2) * kstep; const char* b2 = last ? nB : cB + (size_t)(t + 2) * kstep;
            const char* a3 = a2 + kstep; const char* b3 = b2 + kstep;
            PG8_LDB(B0, 0, 0); PG8_LDB(B1, 0, 1); PG8_SCHED; PG8_LDA(At, 0, 0); PG8_STAGE(PG8_SA(1, 1), a1 + hstepA, voffA);
            PG8_WAIT_V(8); PG8_WAIT_L(0); PG8_BAR; PG8_MMA(0, 0, At, B0); PG8_MMA(0, 1, At, B1); PG8_BAR; PG8_SCHED;
            PG8_LDA(At, 0, 1); PG8_STAGE(PG8_SB(0, 0), b2, voffB); PG8_STAGE(PG8_SB(0, 1), b2 + hstepB, voffB); PG8_STAGE(PG8_SA(0, 0), a2, voffA);
            PG8_WAIT_V(8); PG8_WAIT_L(0); PG8_BAR; PG8_MMA(1, 0, At, B0); PG8_MMA(1, 1, At, B1); PG8_BAR; PG8_SCHED;
            PG8_LDB(B0, 1, 0); PG8_LDB(B1, 1, 1); PG8_SCHED; PG8_LDA(At, 1, 0); PG8_STAGE(PG8_SA(0, 1), a2 + hstepA, voffA);
            PG8_WAIT_V(8); PG8_WAIT_L(0); PG8_BAR; PG8_MMA(0, 0, At, B0); PG8_MMA(0, 1, At, B1); PG8_BAR; PG8_SCHED;
            PG8_LDA(At, 1, 1); PG8_STAGE(PG8_SB(1, 0), b3, voffB); PG8_STAGE(PG8_SB(1, 1), b3 + hstepB, voffB); PG8_STAGE(PG8_SA(1, 0), a3, voffA);
            PG8_WAIT_V(8); PG8_WAIT_L(0); PG8_BAR; PG8_MMA(1, 0, At, B0); PG8_MMA(1, 1, At, B1); PG8_BAR; PG8_SCHED;
        }
        if constexpr (ALIGN_EPI) { if (wr == 0) PG8_BAR; }
        { int t_e = threadIdx.x; asm volatile("" : "+v"(t_e)); const int fr_e = t_e & 15, fq_e = (t_e >> 4) & 3;
          if constexpr (Epi::HAS_PREFETCH) { if (has_next) E.prefetch(nxt, (ui + 1) & 1, lds, wid, t_e & 63); E.run(acc, cur, wr, wc, fr_e, fq_e, lds, ui & 1); }
          else E(acc, cur, wr, wc, fr_e, fq_e); }
        if (!has_next) break;
#pragma unroll
        for (int a = 0; a < 2; ++a)
#pragma unroll
            for (int b = 0; b < 2; ++b)
#pragma unroll
                for (int m = 0; m < 4; ++m)
#pragma unroll
                    for (int n = 0; n < 2; ++n) acc[a][b][m][n] = (f32x4){0.f, 0.f, 0.f, 0.f};
        cur = nxt; cA = nA; cB = nB; ++ui;
        if constexpr (ALIGN_EPI) { if (wr == 1) PG8_BAR; }
    }
    PG8_WAIT_V(0);
    if constexpr (!ALIGN_EPI) { if (wr == 0) PG8_BAR; }
    PG8_BAR;
#undef PG8_SA
#undef PG8_SB
#undef PG8_STAGE
#undef PG8_LDA
#undef PG8_LDB
#undef PG8_MMA
#undef PG8_WAIT_V
#undef PG8_WAIT_L
#undef PG8_BAR
#undef PG8_SCHED
}

typedef f32x4 Acc[2][2][4][2];

struct EpiStore { static constexpr bool HAS_PREFETCH = false;
    bf16_t* O; int ldc;
    __device__ __forceinline__ void operator()(const Acc& acc, const Unit& u, int wr, int wc, int fr, int fq) const {
        const int row0 = u.pm * BM + wr * 64 + fr, col0 = u.pn * BM + wc * 32 + 8 * fq;
#pragma unroll
        for (int ai = 0; ai < 2; ++ai)
#pragma unroll
            for (int m = 0; m < 4; ++m) { bf16_t* rowp = O + (size_t)(row0 + ai * HALF + m * 16) * ldc + col0;
#pragma unroll
                for (int bj = 0; bj < 2; ++bj) { const f32x4 v0 = acc[ai][bj][m][0], v1 = acc[ai][bj][m][1];
                    u32x4 w; w.x = cvt_pk_bf16(v0[0], v0[1]); w.y = cvt_pk_bf16(v0[2], v0[3]); w.z = cvt_pk_bf16(v1[0], v1[1]); w.w = cvt_pk_bf16(v1[2], v1[3]);
                    *(u32x4*)(rowp + bj * HALF) = w; } }
    }
};

struct EpiP { static constexpr bool HAS_PREFETCH = false;
    bf16_t* O; float* ssq_q; float* ssq_kv;
    __device__ __forceinline__ void operator()(const Acc& acc, const Unit& u, int wr, int wc, int fr, int fq) const {
        EpiStore st{O, PW}; st(acc, u, wr, wc, fr, fq);
        if (u.pn <= 1) {
            const int row0 = u.pm * BM + wr * 64 + fr; float* dst = (u.pn == 0) ? ssq_q : ssq_kv;
#pragma unroll
            for (int ai = 0; ai < 2; ++ai)
#pragma unroll
                for (int m = 0; m < 4; ++m) { float s = 0.f;
#pragma unroll
                    for (int n = 0; n < 2; ++n) { const f32x4 a = acc[ai][0][m][n]; s += (a[0] * a[0] + a[1] * a[1]) + (a[2] * a[2] + a[3] * a[3]); }
                    if (u.pn == 0) {
#pragma unroll
                        for (int n = 0; n < 2; ++n) { const f32x4 a = acc[ai][1][m][n]; s += (a[0] * a[0] + a[1] * a[1]) + (a[2] * a[2] + a[3] * a[3]); } }
                    s += __shfl_xor(s, 16); s += __shfl_xor(s, 32);
                    if (fq == 0) dst[(size_t)(row0 + ai * HALF + m * 16) * 4 + wc] = s; }
        }
    }
};

struct EpiQ { static constexpr bool HAS_PREFETCH = false;
    bf16_t* Q; const float* ssq; const float* rope;
    __device__ __forceinline__ void operator()(const Acc& acc, const Unit& u, int wr, int wc, int fr, int fq) const {
        const int row0 = u.pm * BM + wr * 64 + fr;
#pragma unroll
        for (int bj = 0; bj < 2; ++bj) { const int g = 8 * u.pn + 4 * bj + wc; const bool is_rope = (g % 3) == 2;
            bf16_t* qcol = Q + 32 * g;
            if (!is_rope) {
#pragma unroll
                for (int ai = 0; ai < 2; ++ai)
#pragma unroll
                    for (int m = 0; m < 4; ++m) { const int t = row0 + ai * HALF + m * 16;
                        const f32x4 sp = *(const f32x4*)(ssq + (size_t)t * 4);
                        const float f = rsqrtf(((sp[0] + sp[1]) + (sp[2] + sp[3])) * (1.f / 256.f) + 1e-6f) * QSCALE;
                        const f32x4 v0 = acc[ai][bj][m][0] * f, v1 = acc[ai][bj][m][1] * f;
                        u32x4 w; w.x = cvt_pk_bf16(v0[0], v0[1]); w.y = cvt_pk_bf16(v0[2], v0[3]); w.z = cvt_pk_bf16(v1[0], v1[1]); w.w = cvt_pk_bf16(v1[2], v1[3]);
                        *(u32x4*)(qcol + (size_t)t * QW + 8 * fq) = w;
                        if (m & 1) asm volatile("" ::: "memory"); }
            } else {
#pragma unroll
                for (int ai = 0; ai < 2; ++ai)
#pragma unroll
                    for (int m = 0; m < 4; ++m) { const int t = row0 + ai * HALF + m * 16;
                        const f32x4 sp = *(const f32x4*)(ssq + (size_t)t * 4);
                        const float f = rsqrtf(((sp[0] + sp[1]) + (sp[2] + sp[3])) * (1.f / 256.f) + 1e-6f) * QSCALE;
                        const f32x4 cs = *(const f32x4*)(rope + (size_t)t * 32 + 4 * fq), sn = *(const f32x4*)(rope + (size_t)t * 32 + 16 + 4 * fq);
                        const f32x4 a0 = acc[ai][bj][m][0], a1 = acc[ai][bj][m][1];
                        const f32x4 o1 = (a0 * cs - a1 * sn) * f, o2 = (a1 * cs + a0 * sn) * f;
                        u32x2 w1, w2; w1.x = cvt_pk_bf16(o1[0], o1[1]); w1.y = cvt_pk_bf16(o1[2], o1[3]); w2.x = cvt_pk_bf16(o2[0], o2[1]); w2.y = cvt_pk_bf16(o2[2], o2[3]);
                        *(u32x2*)(qcol + (size_t)t * QW + 4 * fq) = w1; *(u32x2*)(qcol + (size_t)t * QW + 16 + 4 * fq) = w2;
                        if (m & 1) asm volatile("" ::: "memory"); }
            } }
    }
};

struct EpiKV { static constexpr bool HAS_PREFETCH = false;
    bf16_t* KN; bf16_t* V; const float* ssq;
    __device__ __forceinline__ void operator()(const Acc& acc, const Unit& u, int wr, int wc, int fr, int fq) const {
        const int row0 = u.pm * BM + wr * 64 + fr; const int b = u.pm >> 3;
#pragma unroll
        for (int bj = 0; bj < 2; ++bj) { const int g = 8 * u.pn + 4 * bj + wc, head = g >> 2, part = g & 3;
            char* base = (part < 2) ? (char*)KN + (4 * part + fq) * 1024 + fr * 16 : (char*)V + (part - 2) * 4096 + fr * 64 + fq * 16;
            const int mstep = (part < 2) ? 256 : 1024;
            base += (size_t)(b * 8 + head) * 32 * 8192;
#pragma unroll
            for (int ai = 0; ai < 2; ++ai) { const int tile = (4 * u.pm + 2 * ai + wr) & 31;
#pragma unroll
                for (int m = 0; m < 4; ++m) { const int t = row0 + ai * HALF + m * 16;
                    const f32x4 sp = *(const f32x4*)(ssq + (size_t)t * 4);
                    const float f = rsqrtf(((sp[0] + sp[1]) + (sp[2] + sp[3])) * (1.f / 128.f) + 1e-6f);
                    const f32x4 v0 = acc[ai][bj][m][0] * f, v1 = acc[ai][bj][m][1] * f;
                    u32x4 w; w.x = cvt_pk_bf16(v0[0], v0[1]); w.y = cvt_pk_bf16(v0[2], v0[3]); w.z = cvt_pk_bf16(v1[0], v1[1]); w.w = cvt_pk_bf16(v1[2], v1[3]);
                    *(u32x4*)(base + (size_t)tile * 8192 + m * mstep) = w;
                    if (m & 1) asm volatile("" ::: "memory"); } } }
    }
};

template <int CTRL> __device__ __forceinline__ float dppf(float v) { return __builtin_bit_cast(float, __builtin_amdgcn_update_dpp(0, __builtin_bit_cast(int, v), CTRL, 0xf, 0xf, true)); }
template <int CTRL> __device__ __forceinline__ f32x4 dpp4(f32x4 v) { f32x4 r; r[0] = dppf<CTRL>(v[0]); r[1] = dppf<CTRL>(v[1]); r[2] = dppf<CTRL>(v[2]); r[3] = dppf<CTRL>(v[3]); return r; }

constexpr int CW_LDS = RING_BYTES + 1024;
struct EpiUp { static constexpr bool HAS_PREFETCH = true;
    bf16_t* ACT; float* E; const float* cw; const float* cb;
    __device__ __forceinline__ void prefetch(const Unit& u, int buf, LAS unsigned char* lds, int wid, int lane) const {
        if (wid < 4) { const float* base = (wid < 3) ? cw + (size_t)wid * UPW : cb;
            const float* src = base + 128 * u.pn + ((lane & 32) ? DFF : 0) + 4 * (lane & 31);
            __builtin_amdgcn_global_load_lds((const unsigned*)src, (LAS unsigned*)(lds + CW_LDS + buf * 4096 + wid * 1024), 16, 0, 0); }
    }
    __device__ __forceinline__ void run(const Acc& acc, const Unit& u, int wr, int wc, int fr, int fq, LAS unsigned char* lds, int buf) const {
        const int cl = 32 * wc + 8 * fq;
        const int cbase = 128 * u.pn + cl;
        const LAS float* wl = (const LAS float*)(lds + CW_LDS + buf * 4096) + cl;
        u32x2 res0[2][4];
#pragma unroll
        for (int n = 0; n < 2; ++n) { const int c0 = cbase + 4 * n;
            const f32x4 wg0 = *(const LAS f32x4*)(wl + 4 * n), wg1 = *(const LAS f32x4*)(wl + 256 + 4 * n), wg2 = *(const LAS f32x4*)(wl + 512 + 4 * n), bg = *(const LAS f32x4*)(wl + 768 + 4 * n);
            const f32x4 wv0 = *(const LAS f32x4*)(wl + 128 + 4 * n), wv1 = *(const LAS f32x4*)(wl + 384 + 4 * n), wv2 = *(const LAS f32x4*)(wl + 640 + 4 * n), bv = *(const LAS f32x4*)(wl + 896 + 4 * n);
#pragma unroll
            for (int ai = 0; ai < 2; ++ai) { f32x4 pg1 = {0.f, 0.f, 0.f, 0.f}, pg2 = pg1, pv1 = pg1, pv2 = pg1;
                const int blk = 4 * u.pm + 2 * ai + wr;
#pragma unroll
                for (int m = 0; m < 4; ++m) { const f32x4 gcur = acc[ai][0][m][n], vcur = acc[ai][1][m][n];
                    const f32x4 rg1 = dpp4<0x121>(gcur), rg2 = dpp4<0x122>(gcur), rv1 = dpp4<0x121>(vcur), rv2 = dpp4<0x122>(vcur);
                    const f32x4 g1 = (fr >= 1) ? rg1 : pg1, g2 = (fr >= 2) ? rg2 : pg2, v1 = (fr >= 1) ? rv1 : pv1, v2 = (fr >= 2) ? rv2 : pv2;
                    const f32x4 cg = bg + wg0 * g2 + wg1 * g1 + wg2 * gcur, cv = bv + wv0 * v2 + wv1 * v1 + wv2 * vcur;
                    f32x4 a; a[0] = silu_f(cg[0]) * cv[0]; a[1] = silu_f(cg[1]) * cv[1]; a[2] = silu_f(cg[2]) * cv[2]; a[3] = silu_f(cg[3]) * cv[3];
                    u32x2 w; w.x = cvt_pk_bf16(a[0], a[1]); w.y = cvt_pk_bf16(a[2], a[3]);
                    const int t = u.pm * BM + ai * HALF + wr * 64 + m * 16 + fr;
                    if (n == 0) res0[ai][m] = w;
                    else if (!(m == 0 && fr < 2)) { u32x4 o; o.x = res0[ai][m].x; o.y = res0[ai][m].y; o.z = w.x; o.w = w.y; *(u32x4*)(ACT + (size_t)t * DFF + cbase) = o; }
                    if (m == 0 && fr < 2) { float* e = E + ((size_t)blk * 4 + fr) * UPW + c0; *(f32x4*)e = gcur; *(f32x4*)(e + DFF) = vcur; }
                    if (m == 3 && fr >= 14) { float* e = E + ((size_t)blk * 4 + 2 + (fr - 14)) * UPW + c0; *(f32x4*)e = gcur; *(f32x4*)(e + DFF) = vcur; }
                    pg1 = rg1; pg2 = rg2; pv1 = rv1; pv2 = rv2; } } }
    }
};
}

namespace att {
constexpr int K_OFF = 0, KSLOT = 12288, V_OFF = 2 * KSLOT, VSLOT = 8192, WS_OFF = V_OFF + 2 * VSLOT, OST_OFF = WS_OFF + 8 * 256, LDS_END = OST_OFF + 8 * 4096;
static_assert(LDS_END <= RING_BYTES, "attention LDS");
__device__ __forceinline__ int crow(int r, int hi) { return (r & 3) + 8 * (r >> 2) + 4 * hi; }
typedef short v4i16_t __attribute__((ext_vector_type(4)));
__device__ __forceinline__ s16x4 vtr(const LAS unsigned char* p) { return __builtin_bit_cast(s16x4, __builtin_amdgcn_ds_read_tr16_b64_v4i16((LAS v4i16_t*)p)); }
__device__ __forceinline__ void glds(const char* src, LAS unsigned char* dst) { __builtin_amdgcn_global_load_lds((const unsigned*)src, (LAS unsigned*)dst, 16, 0, 0); }
#define ATT_WAIT_BAR() asm volatile("s_waitcnt vmcnt(0) lgkmcnt(0)\n\ts_barrier" ::: "memory")

__device__ __forceinline__ void attn_unit(int b, int h, int qb, const bf16_t* Q, const bf16_t* KN, const bf16_t* KR, const bf16_t* V, bf16_t* Y, const float* ong, LAS unsigned char* lds) {
    int tid = threadIdx.x; asm volatile("" : "+v"(tid));
    const int lane = tid & 63, r32 = lane & 31, hi = lane >> 5; const int wid = __builtin_amdgcn_readfirstlane(tid >> 6);
    const int NT = 4 * qb + 4, jmax = 4 * qb + (wid >> 1);
    const size_t bh = (size_t)(b * 8 + h);
    const char* kn_src = (const char*)KN + bh * 32 * 8192 + wid * 1024 + lane * 16;
    const char* v_src = (const char*)V + bh * 32 * 8192 + wid * 1024 + lane * 16;
    const char* kr_src = (const char*)KR + (size_t)b * 32 * 4096 + (wid & 3) * 1024 + lane * 16;
#define ATT_ISSUE(tile, slot) do { glds(kn_src + (size_t)(tile) * 8192, lds + K_OFF + (slot) * KSLOT + wid * 1024); glds(v_src + (size_t)(tile) * 8192, lds + V_OFF + (slot) * VSLOT + wid * 1024); \
        if (wid < 4) glds(kr_src + (size_t)(tile) * 4096, lds + K_OFF + (slot) * KSLOT + 8192 + wid * 1024); } while (0)
    ATT_ISSUE(0, 0);
    const int t0 = b * SEQ + 256 * qb + 32 * wid;
    bf16x8 qr[6];
    { const bf16_t* qp = Q + (size_t)(t0 + r32) * QW + 96 * h + 8 * hi;
#pragma unroll
      for (int ks = 0; ks < 6; ++ks) qr[ks] = *(const bf16x8*)(qp + 16 * ks); }
    float mrun = -1e30f, lrun = 0.f; f32x16 o[2]; o[0] = f32x16{}; o[1] = f32x16{};
    LAS float* wsf = (LAS float*)(lds + WS_OFF + wid * 256);
    for (int j = 0; j < NT; ++j) {
        ATT_WAIT_BAR();
        const int slot = j & 1;
        if (j + 1 < NT) ATT_ISSUE(j + 1, slot ^ 1);
        if (j <= jmax) {
            const LAS unsigned char* kp = lds + K_OFF + slot * KSLOT + hi * 1024 + r32 * 16;
            f32x16 p0 = f32x16{}, p1 = f32x16{};
#pragma unroll
            for (int ks = 0; ks < 6; ++ks) { const bf16x8 k0 = *(const LAS bf16x8*)(kp + ks * 2048), k1 = *(const LAS bf16x8*)(kp + ks * 2048 + 512);
                p0 = __builtin_amdgcn_mfma_f32_32x32x16_bf16(k0, qr[ks], p0, 0, 0, 0); p1 = __builtin_amdgcn_mfma_f32_32x32x16_bf16(k1, qr[ks], p1, 0, 0, 0); }
            float rm = fmaxf(p0[0], p1[0]);
#pragma unroll
            for (int r = 1; r < 16; ++r) rm = fmaxf(rm, fmaxf(p0[r], p1[r]));
            rm = fmaxf(rm, __shfl_xor(rm, 32));
            const float mn = fmaxf(mrun, rm);
            if (__any(mn > mrun)) {
                const float alpha = fexp2(mrun - mn); lrun *= alpha; mrun = mn;
                if (hi == 0) wsf[r32] = alpha;
#pragma unroll
                for (int r = 0; r < 16; ++r) { const float a = wsf[crow(r, hi)]; o[0][r] *= a; o[1][r] *= a; }
            }
            float sum = 0.f;
#pragma unroll
            for (int r = 0; r < 16; ++r) { p0[r] = fexp2(p0[r] - mrun); p1[r] = fexp2(p1[r] - mrun); sum += p0[r] + p1[r]; }
            lrun += sum;
            bf16x8 pa[4];
            { u32x4 w0, w1, w2, w3;
              w0.x = cvt_pk_bf16(p0[0], p0[1]); w0.y = cvt_pk_bf16(p0[2], p0[3]); w0.z = cvt_pk_bf16(p0[4], p0[5]); w0.w = cvt_pk_bf16(p0[6], p0[7]);
              w1.x = cvt_pk_bf16(p0[8], p0[9]); w1.y = cvt_pk_bf16(p0[10], p0[11]); w1.z = cvt_pk_bf16(p0[12], p0[13]); w1.w = cvt_pk_bf16(p0[14], p0[15]);
              w2.x = cvt_pk_bf16(p1[0], p1[1]); w2.y = cvt_pk_bf16(p1[2], p1[3]); w2.z = cvt_pk_bf16(p1[4], p1[5]); w2.w = cvt_pk_bf16(p1[6], p1[7]);
              w3.x = cvt_pk_bf16(p1[8], p1[9]); w3.y = cvt_pk_bf16(p1[10], p1[11]); w3.z = cvt_pk_bf16(p1[12], p1[13]); w3.w = cvt_pk_bf16(p1[14], p1[15]);
              pa[0] = __builtin_bit_cast(bf16x8, w0); pa[1] = __builtin_bit_cast(bf16x8, w1); pa[2] = __builtin_bit_cast(bf16x8, w2); pa[3] = __builtin_bit_cast(bf16x8, w3); }
            const LAS unsigned char* vp = lds + V_OFF + slot * VSLOT + ((lane >> 4) & 1) * 32 + (lane & 3) * 8 + (4 * hi + ((lane & 15) >> 2)) * 64;
#pragma unroll
            for (int d0 = 0; d0 < 2; ++d0)
#pragma unroll
                for (int ks = 0; ks < 4; ++ks) { const s16x4 lo = vtr(vp + d0 * 4096 + ks * 1024), hh = vtr(vp + d0 * 4096 + ks * 1024 + 512);
                    const bf16x8 vf = {lo[0], lo[1], lo[2], lo[3], hh[0], hh[1], hh[2], hh[3]};
                    o[d0] = __builtin_amdgcn_mfma_f32_32x32x16_bf16(pa[ks], vf, o[d0], 0, 0, 0); }
        }
    }
    { const float lt = lrun + __shfl_xor(lrun, 32);
      if (hi == 0) wsf[r32] = frcp(lt);
      const float g0 = ong[64 * h + r32], g1 = ong[64 * h + 32 + r32];
      LAS bf16_t* stg = (LAS bf16_t*)(lds + OST_OFF + wid * 4096);
#pragma unroll
      for (int r = 0; r < 16; ++r) { const float inv = wsf[crow(r, hi)]; const float a = o[0][r] * inv, c = o[1][r] * inv;
          float ss = a * a + c * c;
          ss += __shfl_xor(ss, 1); ss += __shfl_xor(ss, 2); ss += __shfl_xor(ss, 4); ss += __shfl_xor(ss, 8); ss += __shfl_xor(ss, 16);
          const float rs = rsqrtf(ss * (1.f / 64.f) + 1e-6f);
          const unsigned w = cvt_pk_bf16(a * rs * g0, c * rs * g1);
          const int orow = crow(r, hi); stg[orow * 64 + r32] = (bf16_t)(w & 0xffffu); stg[orow * 64 + 32 + r32] = (bf16_t)(w >> 16); }
      bf16_t* Yw = Y + (size_t)t0 * D + 64 * h;
#pragma unroll
      for (int i = 0; i < 4; ++i) { const int row = i * 8 + (lane >> 3), ch = lane & 7; const u32x4 v = *(const LAS u32x4*)(stg + row * 64 + ch * 8); *(u32x4*)(Yw + (size_t)row * D + ch * 8) = v; } }
    asm volatile("s_waitcnt lgkmcnt(0)\n\ts_barrier" ::: "memory");
#undef ATT_ISSUE
}
}

#define XB_TMO      128
#define XB_XCNT(j)  (256  + 64 * (j))
#define XB_XSUB(j)  (1280 + 64 * (j))
#define XB_XGEN(j)  (2304 + 64 * (j))
#define XB_TOP      3328
#define XB_TOPGEN   3392
#define XCD_BAR_WORDS 3456
#define XB_SPIN_CAP (1u << 18)
__device__ __forceinline__ unsigned xb_ld(unsigned* p)              { return __hip_atomic_load(p, __ATOMIC_RELAXED, __HIP_MEMORY_SCOPE_AGENT); }
__device__ __forceinline__ unsigned xb_add(unsigned* p, unsigned v) { return __hip_atomic_fetch_add(p, v, __ATOMIC_RELAXED, __HIP_MEMORY_SCOPE_AGENT); }
__device__ __forceinline__ unsigned xb_xcc_id() { return (unsigned)__builtin_amdgcn_s_getreg((3 << 11) | 20) & 0xFu; }
#define XB_SPIN(cond, bar) do { unsigned _sp = 0; while (cond) { __builtin_amdgcn_s_sleep(1); \
    if ((++_sp & 255u) == 0u) { if (xb_ld(&(bar)[XB_TMO])) break; if (_sp > XB_SPIN_CAP) { atomicAdd(&(bar)[XB_TMO], 1u); break; } } } } while (0)
struct XcdBarrier { unsigned* bar; unsigned x; volatile LAS unsigned* st; };
__device__ __forceinline__ XcdBarrier xcd_barrier_post(unsigned* bar, volatile LAS unsigned* st) {
    XcdBarrier b; b.bar = bar; b.x = xb_xcc_id(); b.st = st;
    if (threadIdx.x == 0) (void)xb_add(&bar[XB_XCNT(b.x)], 1u);
    return b;
}
__device__ __forceinline__ void xcd_barrier_complete(unsigned* bar, unsigned x, unsigned& nloc, unsigned& nx) {
    const unsigned G = gridDim.x * gridDim.y * gridDim.z;
    unsigned sum, cnt, mine, sp = 0u;
    for (;;) {
        sum = 0u; cnt = 0u; mine = 0u;
#pragma unroll
        for (unsigned j = 0; j < 16; ++j) { const unsigned c = xb_ld(&bar[XB_XCNT(j)]); sum += c; cnt += (c > 0u) ? 1u : 0u; mine = (j == x) ? c : mine; }
        if (sum == G) break;
        __builtin_amdgcn_s_sleep(1);
        if ((++sp & 255u) == 0u) { if (xb_ld(&bar[XB_TMO])) break; if (sp > XB_SPIN_CAP) { atomicAdd(&bar[XB_TMO], 1u); break; } }
    }
    nloc = mine > 0u ? mine : 1u; nx = cnt > 0u ? cnt : 1u;
}
__device__ __forceinline__ void xcd_barrier(const XcdBarrier& b) {
    asm volatile("s_waitcnt vmcnt(0)" ::: "memory");
    __syncthreads();
    if (threadIdx.x == 0) {
        unsigned* bar = b.bar;
        __builtin_amdgcn_s_waitcnt(0);
        unsigned nloc = b.st[0], nx = b.st[1];
        if (nloc == 0u) { xcd_barrier_complete(bar, b.x, nloc, nx); b.st[0] = nloc; b.st[1] = nx; }
        const unsigned old = xb_add(&bar[XB_XSUB(b.x)], 1u);
        const unsigned gen = old / nloc;
        if (old + 1u == (gen + 1u) * nloc) {
            __builtin_amdgcn_fence(__ATOMIC_RELEASE, "agent");
            asm volatile("s_waitcnt vmcnt(0)" ::: "memory");
            const unsigned og = xb_add(&bar[XB_TOP], 1u);
            const unsigned tg = og / nx;
            if (og + 1u == (tg + 1u) * nx) xb_add(&bar[XB_TOPGEN], 1u);
            else XB_SPIN(xb_ld(&bar[XB_TOPGEN]) == tg, bar);
            __builtin_amdgcn_fence(__ATOMIC_ACQUIRE, "agent");
            xb_add(&bar[XB_XGEN(b.x)], 1u);
            asm volatile("s_waitcnt vmcnt(0)" ::: "memory");
        } else {
            XB_SPIN(xb_ld(&bar[XB_XGEN(b.x)]) == gen, bar);
            __builtin_amdgcn_fence(__ATOMIC_ACQUIRE, "agent");
            asm volatile("s_waitcnt vmcnt(0)" ::: "memory");
        }
    }
    __syncthreads();
}

struct Args { const float* in[22]; const int* pos; float* out; unsigned char* ws; int ph_lo, ph_hi; };
__constant__ float c_invfreq[16] = {1.0f, 0.5623413251903491f, 0.31622776601683794f, 0.1778279410038923f, 0.1f, 0.05623413251903491f, 0.03162277660168379f, 0.01778279410038923f,
                                    0.01f, 0.005623413251903491f, 0.0031622776601683794f, 0.001778279410038923f, 0.001f, 0.0005623413251903491f, 0.00031622776601683794f, 0.0001778279410038923f};

__device__ __forceinline__ int colmap(int which, int s) {
    const int p = (s & ~31) + pg8::perm32(s & 31);
    switch (which) {
        case 0: return p < 416 ? p : (p < 512 ? -1 : p - 96);
        case 1: return ((s >> 5) % 3 == 2) ? s : p;
        case 4: { const int pn = s >> 8, bj = (s >> 7) & 1, wc = (s >> 5) & 3; return bj * DFF + 128 * pn + 32 * wc + pg8::perm32(s & 31); }
        default: return p;
    }
}
__device__ __forceinline__ void p0_transpose_item(const float* W, int ldw, int Ksrc, const float* kscale, bf16_t* WT, int Kdst, int which, LAS float* scr, int item, int nblk, int lane) {
    const int kb = item / nblk, nb = item % nblk, k0 = 64 * kb, s0 = 32 * nb;
    const int cm = colmap(which, s0 + (lane & 31));
    float tv[32];
#pragma unroll
    for (int i = 0; i < 32; ++i) { const int k = k0 + 2 * i + (lane >> 5); tv[i] = (cm >= 0 && k < Ksrc) ? W[(size_t)k * ldw + cm] : 0.f; }
    if (kscale) {
#pragma unroll
        for (int i = 0; i < 32; ++i) { const int k = k0 + 2 * i + (lane >> 5); if (k < Ksrc) tv[i] *= kscale[k]; } }
#pragma unroll
    for (int i = 0; i < 32; ++i) scr[(2 * i + (lane >> 5)) * 33 + (lane & 31)] = tv[i];
    asm volatile("s_waitcnt lgkmcnt(0)" ::: "memory");
    const int c = lane & 7;
#pragma unroll
    for (int j = 0; j < 4; ++j) { const int n = (lane >> 3) + 8 * j; const LAS float* s = scr + (8 * c) * 33 + n;
        u32x4 o; o.x = cvt_pk_bf16(s[0 * 33], s[1 * 33]); o.y = cvt_pk_bf16(s[2 * 33], s[3 * 33]); o.z = cvt_pk_bf16(s[4 * 33], s[5 * 33]); o.w = cvt_pk_bf16(s[6 * 33], s[7 * 33]);
        *(u32x4*)(WT + (size_t)(s0 + n) * Kdst + k0 + 8 * c) = o; }
    asm volatile("s_waitcnt lgkmcnt(0)" ::: "memory");
}

constexpr int N_PHASES = 11;
#define OPAQUE_LANE(name) int name##_t = (int)threadIdx.x; asm volatile("" : "+v"(name##_t)); const int name = name##_t & 63

__global__ void __launch_bounds__(512, 2) mk_fwd(Args args) {
    extern __shared__ __attribute__((aligned(16))) unsigned char lds_raw[];
    LAS unsigned char* lds = (LAS unsigned char*)lds_raw;
    volatile LAS unsigned* MISC = (volatile LAS unsigned*)(lds + MISC_OFF);
    const int tid = threadIdx.x, lane = tid & 63, wave = __builtin_amdgcn_readfirstlane(tid >> 6);
    const int G = gridDim.x; const int bx = blockIdx.x; const int vcu = (G % 8 == 0) ? (bx % 8) * (G / 8) + bx / 8 : bx;
    const int gw = vcu * 8 + wave, NGW = G * 8;
    unsigned char* ws = args.ws;
    const float* x = args.in[0]; const float* cvec = args.in[1]; const int* pos = args.pos;
    const float* w_ada = args.in[3]; const float* b_ada = args.in[4]; const float* w_in = args.in[5];
    const float* qg = args.in[6]; const float* w_qup = args.in[7]; const float* kvg = args.in[8]; const float* w_kvup = args.in[9];
    const float* conv_w = args.in[10]; const float* conv_b = args.in[11]; const float* ong = args.in[12]; const float* w_out = args.in[13];
    const float* ln1g = args.in[14]; const float* ln1b = args.in[15]; const float* w_up = args.in[16];
    const float* fcw = args.in[17]; const float* fcb = args.in[18]; const float* w_down = args.in[19];
    const float* ln2g = args.in[20]; const float* ln2b = args.in[21];
    float* out = args.out;
    float* MOD = (float*)(ws + WS_MOD); float* ROPE = (float*)(ws + WS_ROPE); float* SSQQ = (float*)(ws + WS_SSQQ); float* SSQKV = (float*)(ws + WS_SSQKV);
    bf16_t* WIN = (bf16_t*)(ws + WS_WIN); bf16_t* WQ = (bf16_t*)(ws + WS_WQ); bf16_t* WKV = (bf16_t*)(ws + WS_WKV); bf16_t* WOUT = (bf16_t*)(ws + WS_WOUT);
    bf16_t* WUP = (bf16_t*)(ws + WS_WUP); bf16_t* WDN = (bf16_t*)(ws + WS_WDN);
    bf16_t* HB = (bf16_t*)(ws + WS_HB); bf16_t* FF = (bf16_t*)(ws + WS_FF); bf16_t* P = (bf16_t*)(ws + WS_P); bf16_t* MIX = (bf16_t*)(ws + WS_MIX);
    bf16_t* Qb = (bf16_t*)(ws + WS_Q); bf16_t* KN = (bf16_t*)(ws + WS_KN); bf16_t* KR = (bf16_t*)(ws + WS_KR); bf16_t* Vb = (bf16_t*)(ws + WS_V);
    bf16_t* Y = (bf16_t*)(ws + WS_Y); bf16_t* ACT = (bf16_t*)(ws + WS_ACT); float* E = (float*)(ws + WS_E);

    for (int u = tid; u < (LDS_BYTES - LDSCTL_OFF) / 4; u += 512) ((LAS unsigned*)(lds + LDSCTL_OFF))[u] = 0u;
    __syncthreads();
    XcdBarrier bar; bar.bar = (unsigned*)(ws + WS_CTL) + CW_BAR; bar.x = 0; bar.st = nullptr;
    if (MK_N_LAUNCHES == 1) bar = xcd_barrier_post((unsigned*)(ws + WS_CTL) + CW_BAR, MISC + 8);
    const int lo = args.ph_lo, hi = args.ph_hi;
#ifndef PH_MASK
#define PH_MASK 0x7ff
#endif
#define IN(k) (((PH_MASK >> (k)) & 1) && lo <= (k) && (k) < hi)
#define SEAM(k) do { if (IN(k) && IN((k) + 1)) xcd_barrier(bar); } while (0)

    if (IN(0)) {
        OPAQUE_LANE(ln);
        if (bx < 192) {
            LAS float* cact = (LAS float*)lds; LAS float* part = (LAS float*)(lds + 65536);
            const int n0 = 32 * bx, c4 = tid & 7, kr = tid >> 3;
            f32x4 wv[16];
#pragma unroll
            for (int i = 0; i < 16; ++i) wv[i] = *(const f32x4*)(w_ada + (size_t)(kr + 64 * i) * 6144 + n0 + 4 * c4);
            for (int i = tid; i < 16 * 1024; i += 512) { const float v = cvec[i]; cact[i] = v * frcp(1.f + fexp2(-LOG2E * v)); }
            __syncthreads();
            f32x4 a[16];
#pragma unroll
            for (int b = 0; b < 16; ++b) a[b] = (f32x4){0.f, 0.f, 0.f, 0.f};
#pragma unroll
            for (int i = 0; i < 16; ++i) { const int k = kr + 64 * i;
#pragma unroll
                for (int b = 0; b < 16; ++b) a[b] += wv[i] * cact[b * 1024 + k];
                if ((i & 1) == 1) asm volatile("" ::: "memory"); }
#pragma unroll
            for (int b = 0; b < 16; ++b)
#pragma unroll
                for (int e = 0; e < 4; ++e) { float v = a[b][e]; v += __shfl_xor(v, 8); v += __shfl_xor(v, 16); v += __shfl_xor(v, 32); a[b][e] = v; }
            if (ln < 8) {
#pragma unroll
                for (int b = 0; b < 16; ++b) *(LAS f32x4*)(part + (wave * 16 + b) * 32 + 4 * c4) = a[b]; }
            __syncthreads();
            { const int b = tid >> 5, col = tid & 31; float s = 0.f;
#pragma unroll
              for (int w8 = 0; w8 < 8; ++w8) s += part[(w8 * 16 + b) * 32 + col];
              MOD[b * 6144 + n0 + col] = s + b_ada[n0 + col]; }
            __syncthreads();
        }
        for (int idx = gw * 64 + ln; idx < T * 16; idx += NGW * 64) { const int t = idx >> 4, i = idx & 15; const float ang = (float)pos[t] * c_invfreq[i];
            ROPE[(size_t)t * 32 + i] = cosf(ang); ROPE[(size_t)t * 32 + 16 + i] = sinf(ang); }
        LAS float* scr = (LAS float*)(lds + wave * 16384);
        constexpr int I0 = 16 * 64, I1 = 4 * 24, I2 = 4 * 32, I3 = 16 * 32, I4 = 16 * 176, I5 = 44 * 32, NIT = I0 + I1 + I2 + I3 + I4 + I5;
        for (int it = gw; it < NIT; it += NGW) {
            int r = it;
            if (r < I0) { p0_transpose_item(w_in, INW, D, nullptr, WIN, D, 0, scr, r, 64, ln); continue; } r -= I0;
            if (r < I1) { p0_transpose_item(w_qup, QW, 256, qg, WQ, 256, 1, scr, r, 24, ln); continue; } r -= I1;
            if (r < I2) { p0_transpose_item(w_kvup, 1024, 128, kvg, WKV, 256, 2, scr, r, 32, ln); continue; } r -= I2;
            if (r < I3) { p0_transpose_item(w_out, D, D, nullptr, WOUT, D, 3, scr, r, 32, ln); continue; } r -= I3;
            if (r < I4) { p0_transpose_item(w_up, UPW, D, nullptr, WUP, D, 4, scr, r, 176, ln); continue; } r -= I4;
            p0_transpose_item(w_down, D, DFF, nullptr, WDN, DFF, 5, scr, r, 32, ln);
        }
    }
    SEAM(0);
    if (IN(1)) {
        OPAQUE_LANE(ln);
        for (int row0 = gw * 16; row0 < T; row0 += NGW * 16) { const int b = row0 / SEQ; const float* mb = MOD + b * 6144;
            f32x4 sc[4], sh[4];
#pragma unroll
            for (int j = 0; j < 4; ++j) { const int col = 4 * ln + 256 * j; sh[j] = *(const f32x4*)(mb + col); sc[j] = *(const f32x4*)(mb + 1024 + col) + 1.f; }
            for (int rr = 0; rr < 16; ++rr) { const int t = row0 + rr; const float* xr = x + (size_t)t * D;
                f32x4 v[4]; float s = 0.f;
#pragma unroll
                for (int j = 0; j < 4; ++j) { v[j] = *(const f32x4*)(xr + 4 * ln + 256 * j); s += (v[j][0] + v[j][1]) + (v[j][2] + v[j][3]); }
                const float mean = wave_sum(s) * (1.f / D); float q = 0.f;
#pragma unroll
                for (int j = 0; j < 4; ++j) { v[j] = v[j] - mean; q += (v[j][0] * v[j][0] + v[j][1] * v[j][1]) + (v[j][2] * v[j][2] + v[j][3] * v[j][3]); }
                const float rstd = rsqrtf(wave_sum(q) * (1.f / D) + 1e-5f);
#pragma unroll
                for (int j = 0; j < 4; ++j) { const f32x4 o = v[j] * rstd * sc[j] + sh[j]; u32x2 w; w.x = cvt_pk_bf16(o[0], o[1]); w.y = cvt_pk_bf16(o[2], o[3]);
                    *(u32x2*)(HB + (size_t)t * D + 4 * ln + 256 * j) = w; } } }
    }
    SEAM(1);
    if (IN(2)) {
        pg8::Gemm g{HB, D, WIN, T, PW, D}; pg8::StaticOrder S; S.init(T, PW, G, bx);
        pg8::EpiP E1{P, SSQQ, SSQKV};
        pg8::gemm_phase<pg8::EpiP, true>(lds, g, S, E1);
    }
    SEAM(2);
    if (IN(3)) {
        OPAQUE_LANE(ln);
#ifndef P3_MASK
#define P3_MASK 15
#endif
        if (P3_MASK & 1) { pg8::Gemm g{P, PW, WQ, T, QW, 256}; pg8::StaticOrder S; S.init(T, QW, G, bx); pg8::EpiQ E2{Qb, SSQQ, ROPE}; pg8::gemm_phase<pg8::EpiQ, true>(lds, g, S, E2); }
        if (P3_MASK & 2) { pg8::Gemm g{P + 256, PW, WKV, T, 1024, 256}; pg8::StaticOrder S; S.init(T, 1024, G, bx); pg8::EpiKV E3{KN, Vb, SSQKV}; pg8::gemm_phase<pg8::EpiKV, true>(lds, g, S, E3); }
        if (P3_MASK & 4) for (int row0 = gw * 16; row0 < T; row0 += NGW * 16) {
            const int c0 = 8 * ln;
            float w0[8], w1[8], w2[8], cb8[8], gn[8];
#pragma unroll
            for (int e = 0; e < 8; ++e) { w0[e] = conv_w[c0 + e]; w1[e] = conv_w[512 + c0 + e]; w2[e] = conv_w[1024 + c0 + e]; cb8[e] = conv_b[c0 + e]; gn[e] = ong[512 + c0 + e]; }
            float um2[8], um1[8];
#pragma unroll
            for (int e = 0; e < 8; ++e) { um2[e] = 0.f; um1[e] = 0.f; }
            if ((row0 % SEQ) != 0) {
                const u32x4 a2 = *(const u32x4*)(P + (size_t)(row0 - 2) * PW + 1024 + c0), b2 = *(const u32x4*)(P + (size_t)(row0 - 2) * PW + 1536 + c0);
                const u32x4 a1 = *(const u32x4*)(P + (size_t)(row0 - 1) * PW + 1024 + c0), b1 = *(const u32x4*)(P + (size_t)(row0 - 1) * PW + 1536 + c0);
#pragma unroll
                for (int e = 0; e < 4; ++e) { um2[2 * e] = bf_lo(a2[e]) * bf_lo(b2[e]); um2[2 * e + 1] = bf_hi(a2[e]) * bf_hi(b2[e]); um1[2 * e] = bf_lo(a1[e]) * bf_lo(b1[e]); um1[2 * e + 1] = bf_hi(a1[e]) * bf_hi(b1[e]); }
            }
            for (int rr = 0; rr < 16; ++rr) { const int t = row0 + rr; const bf16_t* pr = P + (size_t)t * PW;
                const u32x4 gb = *(const u32x4*)(pr + 512 + c0), gc = *(const u32x4*)(pr + 1024 + c0), cv = *(const u32x4*)(pr + 1536 + c0);
                float u0[8], yv[8]; float ss = 0.f;
#pragma unroll
                for (int e = 0; e < 4; ++e) { u0[2 * e] = bf_lo(gc[e]) * bf_lo(cv[e]); u0[2 * e + 1] = bf_hi(gc[e]) * bf_hi(cv[e]); }
#pragma unroll
                for (int e = 0; e < 8; ++e) { const float gbe = (e & 1) ? bf_hi(gb[e >> 1]) : bf_lo(gb[e >> 1]);
                    yv[e] = gbe * (cb8[e] + w0[e] * um2[e] + w1[e] * um1[e] + w2[e] * u0[e]); ss += yv[e] * yv[e]; um2[e] = um1[e]; um1[e] = u0[e]; }
                ss += __shfl_xor(ss, 1); ss += __shfl_xor(ss, 2); ss += __shfl_xor(ss, 4);
                const float rs = rsqrtf(ss * (1.f / 64.f) + 1e-6f);
                u32x4 o; o.x = cvt_pk_bf16(yv[0] * rs * gn[0], yv[1] * rs * gn[1]); o.y = cvt_pk_bf16(yv[2] * rs * gn[2], yv[3] * rs * gn[3]);
                o.z = cvt_pk_bf16(yv[4] * rs * gn[4], yv[5] * rs * gn[5]); o.w = cvt_pk_bf16(yv[6] * rs * gn[6], yv[7] * rs * gn[7]);
                *(u32x4*)(Y + (size_t)t * D + 512 + c0) = o; }
        }
        if (P3_MASK & 8) for (int tl = gw; tl < NB * 32; tl += NGW) { const int t = tl * 64 + ln; const bf16_t* pr = P + (size_t)t * PW + 384;
            u32x4 raw[4];
#pragma unroll
            for (int e = 0; e < 4; ++e) raw[e] = *(const u32x4*)(pr + 8 * e);
            float xv[32];
#pragma unroll
            for (int e = 0; e < 16; ++e) { xv[2 * e] = bf_lo(raw[e >> 2][e & 3]); xv[2 * e + 1] = bf_hi(raw[e >> 2][e & 3]); }
            float cs[16], sn[16];
#pragma unroll
            for (int e = 0; e < 4; ++e) { const f32x4 c4 = *(const f32x4*)(ROPE + (size_t)t * 32 + 4 * e), s4 = *(const f32x4*)(ROPE + (size_t)t * 32 + 16 + 4 * e);
                cs[4 * e] = c4[0]; cs[4 * e + 1] = c4[1]; cs[4 * e + 2] = c4[2]; cs[4 * e + 3] = c4[3]; sn[4 * e] = s4[0]; sn[4 * e + 1] = s4[1]; sn[4 * e + 2] = s4[2]; sn[4 * e + 3] = s4[3]; }
            float ov[32];
#pragma unroll
            for (int i = 0; i < 16; ++i) { ov[i] = xv[i] * cs[i] - xv[16 + i] * sn[i]; ov[16 + i] = xv[16 + i] * cs[i] + xv[i] * sn[i]; }
            char* dst = (char*)KR + (size_t)tl * 4096 + ln * 16;
#pragma unroll
            for (int c = 0; c < 4; ++c) { u32x4 o; o.x = cvt_pk_bf16(ov[8 * c], ov[8 * c + 1]); o.y = cvt_pk_bf16(ov[8 * c + 2], ov[8 * c + 3]); o.z = cvt_pk_bf16(ov[8 * c + 4], ov[8 * c + 5]); o.w = cvt_pk_bf16(ov[8 * c + 6], ov[8 * c + 7]);
                *(u32x4*)(dst + c * 1024) = o; } }
    }
    SEAM(3);
    if (IN(4)) {
        for (int it = vcu; it < 256; it += G) { const int bh = it >> 1, e = it & 1, b = bh >> 3, h = bh & 7;
            for (int i = 0; i < 4; ++i) { const int qb = (i == 0) ? 7 - e : (i == 1) ? e : (i == 2) ? 5 - e : 2 + e;
                att::attn_unit(b, h, qb, Qb, KN, KR, Vb, Y, ong, lds); } }
    }
    SEAM(4);
    if (IN(5)) {
        pg8::Gemm g{Y, D, WOUT, T, D, D}; pg8::StaticOrder S; S.init(T, D, G, bx); pg8::EpiStore E4{MIX, D};
        pg8::gemm_phase<pg8::EpiStore, true>(lds, g, S, E4);
    }
    SEAM(5);
    if (IN(6)) {
        OPAQUE_LANE(ln);
        for (int row0 = gw * 16; row0 < T; row0 += NGW * 16) { const int b = row0 / SEQ; const float* mb = MOD + b * 6144;
            f32x4 gt[4], g1v[4], b1v[4], sc[4], sh[4];
#pragma unroll
            for (int j = 0; j < 4; ++j) { const int col = 4 * ln + 256 * j; gt[j] = *(const f32x4*)(mb + 2048 + col); g1v[j] = *(const f32x4*)(ln1g + col); b1v[j] = *(const f32x4*)(ln1b + col);
                sh[j] = *(const f32x4*)(mb + 3072 + col); sc[j] = *(const f32x4*)(mb + 4096 + col) + 1.f; }
            for (int rr = 0; rr < 16; ++rr) { const int t = row0 + rr;
                f32x4 v[4]; float s = 0.f;
#pragma unroll
                for (int j = 0; j < 4; ++j) { const int col = 4 * ln + 256 * j; const f32x4 xv = *(const f32x4*)(x + (size_t)t * D + col); const u32x2 mw = *(const u32x2*)(MIX + (size_t)t * D + col);
                    const f32x4 mx = {bf_lo(mw.x), bf_hi(mw.x), bf_lo(mw.y), bf_hi(mw.y)};
                    v[j] = xv * ALPHA + gt[j] * mx; s += (v[j][0] + v[j][1]) + (v[j][2] + v[j][3]); }
                float mean = wave_sum(s) * (1.f / D); float q = 0.f;
#pragma unroll
                for (int j = 0; j < 4; ++j) { v[j] = v[j] - mean; q += (v[j][0] * v[j][0] + v[j][1] * v[j][1]) + (v[j][2] * v[j][2] + v[j][3] * v[j][3]); }
                float rstd = rsqrtf(wave_sum(q) * (1.f / D) + 1e-5f);
                s = 0.f;
#pragma unroll
                for (int j = 0; j < 4; ++j) { v[j] = v[j] * rstd * g1v[j] + b1v[j]; *(f32x4*)(out + (size_t)t * D + 4 * ln + 256 * j) = v[j]; s += (v[j][0] + v[j][1]) + (v[j][2] + v[j][3]); }
                mean = wave_sum(s) * (1.f / D); q = 0.f;
#pragma unroll
                for (int j = 0; j < 4; ++j) { v[j] = v[j] - mean; q += (v[j][0] * v[j][0] + v[j][1] * v[j][1]) + (v[j][2] * v[j][2] + v[j][3] * v[j][3]); }
                rstd = rsqrtf(wave_sum(q) * (1.f / D) + 1e-5f);
#pragma unroll
                for (int j = 0; j < 4; ++j) { const f32x4 o = v[j] * rstd * sc[j] + sh[j]; u32x2 w; w.x = cvt_pk_bf16(o[0], o[1]); w.y = cvt_pk_bf16(o[2], o[3]);
                    *(u32x2*)(HB + (size_t)t * D + 4 * ln + 256 * j) = w; } } }
    }
    SEAM(6);
    if (IN(7)) {
        pg8::Gemm g{HB, D, WUP, T, UPW, D}; pg8::StaticOrder S; S.init(T, UPW, G, bx); pg8::EpiUp E5{ACT, E, fcw, fcb};
        pg8::gemm_phase<pg8::EpiUp, true>(lds, g, S, E5);
    }
    SEAM(7);
    if (IN(8)) {
        OPAQUE_LANE(ln);
        constexpr int NITEM = 512 * 2 * (DFF / 4);
        for (int it = (gw * 64 + ln); it < NITEM; it += NGW * 64) { const int c4 = it % (DFF / 4), rb = it / (DFF / 4), rr = rb & 1, blk = rb >> 1; const int c0 = 4 * c4;
            const bool first = (blk & 31) == 0;
            const float* e0 = E + ((size_t)blk * 4 + rr) * UPW + c0;
            const float* em1 = (rr == 0) ? E + ((size_t)(blk - 1) * 4 + 3) * UPW + c0 : E + ((size_t)blk * 4 + 0) * UPW + c0;
            const float* em2 = (rr == 0) ? E + ((size_t)(blk - 1) * 4 + 2) * UPW + c0 : E + ((size_t)(blk - 1) * 4 + 3) * UPW + c0;
            const f32x4 z = {0.f, 0.f, 0.f, 0.f};
            const f32x4 g0 = *(const f32x4*)e0, v0 = *(const f32x4*)(e0 + DFF);
            const bool has1 = !(first && rr == 0), has2 = !first;
            const f32x4 g1 = has1 ? *(const f32x4*)em1 : z, v1 = has1 ? *(const f32x4*)(em1 + DFF) : z;
            const f32x4 g2 = has2 ? *(const f32x4*)em2 : z, v2 = has2 ? *(const f32x4*)(em2 + DFF) : z;
            const f32x4 wg0 = *(const f32x4*)(fcw + c0), wg1 = *(const f32x4*)(fcw + UPW + c0), wg2 = *(const f32x4*)(fcw + 2 * UPW + c0), bg = *(const f32x4*)(fcb + c0);
            const f32x4 wv0 = *(const f32x4*)(fcw + DFF + c0), wv1 = *(const f32x4*)(fcw + UPW + DFF + c0), wv2 = *(const f32x4*)(fcw + 2 * UPW + DFF + c0), bv = *(const f32x4*)(fcb + DFF + c0);
            const f32x4 cg = bg + wg0 * g2 + wg1 * g1 + wg2 * g0, cv = bv + wv0 * v2 + wv1 * v1 + wv2 * v0;
            u32x2 w; w.x = cvt_pk_bf16(silu_f(cg[0]) * cv[0], silu_f(cg[1]) * cv[1]); w.y = cvt_pk_bf16(silu_f(cg[2]) * cv[2], silu_f(cg[3]) * cv[3]);
            *(u32x2*)(ACT + (size_t)(64 * blk + rr) * DFF + c0) = w; }
    }
    SEAM(8);
    if (IN(9)) {
        pg8::Gemm g{ACT, DFF, WDN, T, D, DFF}; pg8::StaticOrder S; S.init(T, D, G, bx); pg8::EpiStore E6{FF, D};
        pg8::gemm_phase<pg8::EpiStore, true>(lds, g, S, E6);
    }
    SEAM(9);
    if (IN(10)) {
        OPAQUE_LANE(ln);
        for (int row0 = gw * 16; row0 < T; row0 += NGW * 16) { const int b = row0 / SEQ; const float* mb = MOD + b * 6144;
            f32x4 gt[4], g2v[4], b2v[4];
#pragma unroll
            for (int j = 0; j < 4; ++j) { const int col = 4 * ln + 256 * j; gt[j] = *(const f32x4*)(mb + 5120 + col); g2v[j] = *(const f32x4*)(ln2g + col); b2v[j] = *(const f32x4*)(ln2b + col); }
            for (int rr = 0; rr < 16; ++rr) { const int t = row0 + rr;
                f32x4 v[4]; float s = 0.f;
#pragma unroll
                for (int j = 0; j < 4; ++j) { const int col = 4 * ln + 256 * j; const f32x4 xv = *(const f32x4*)(out + (size_t)t * D + col); const u32x2 mw = *(const u32x2*)(FF + (size_t)t * D + col);
                    const f32x4 mx = {bf_lo(mw.x), bf_hi(mw.x), bf_lo(mw.y), bf_hi(mw.y)};
                    v[j] = xv * ALPHA + gt[j] * mx; s += (v[j][0] + v[j][1]) + (v[j][2] + v[j][3]); }
                const float mean = wave_sum(s) * (1.f / D); float q = 0.f;
#pragma unroll
                for (int j = 0; j < 4; ++j) { v[j] = v[j] - mean; q += (v[j][0] * v[j][0] + v[j][1] * v[j][1]) + (v[j][2] * v[j][2] + v[j][3] * v[j][3]); }
                const float rstd = rsqrtf(wave_sum(q) * (1.f / D) + 1e-5f);
#pragma unroll
                for (int j = 0; j < 4; ++j) { *(f32x4*)(out + (size_t)t * D + 4 * ln + 256 * j) = v[j] * rstd * g2v[j] + b2v[j]; } } }
    }
#undef IN
#undef SEAM
}

extern "C" void kernel_launch(void* const* d_in, const int* in_sizes, int n_in, void* d_out, int out_size, void* d_ws, size_t ws_size, hipStream_t stream) {
    static int grid = 0;
    if (grid == 0) {
        if (n_in != 22 || in_sizes[0] != T * D || out_size != T * D || ws_size < WS_END) { fprintf(stderr, "kernel_launch: unexpected shapes / workspace (n_in %d, ws %zu)\n", n_in, ws_size); grid = -1; return; }
        int dev = 0, cus = 0, per_cu = 0;
        if (hipGetDevice(&dev) != hipSuccess || hipDeviceGetAttribute(&cus, hipDeviceAttributeMultiprocessorCount, dev) != hipSuccess) { grid = -1; return; }
        if (hipFuncSetAttribute((const void*)mk_fwd, hipFuncAttributeMaxDynamicSharedMemorySize, LDS_BYTES) != hipSuccess) { fprintf(stderr, "kernel_launch: hipFuncSetAttribute failed\n"); grid = -1; return; }
        if (hipOccupancyMaxActiveBlocksPerMultiprocessor(&per_cu, (const void*)mk_fwd, 512, LDS_BYTES) != hipSuccess || per_cu < 1) { fprintf(stderr, "kernel_launch: occupancy query says %d blocks per CU\n", per_cu); (void)hipGetLastError(); grid = -1; return; }
        grid = cus;
    }
    if (grid < 0) return;
    hipMemsetAsync((char*)d_ws + WS_CTL, 0, CTL_ZERO_BYTES, stream);
    Args a{};
    for (int i = 0; i < 22; ++i) a.in[i] = (const float*)d_in[i];
    a.pos = (const int*)d_in[2]; a.out = (float*)d_out; a.ws = (unsigned char*)d_ws;
#if MK_N_LAUNCHES == 1
    a.ph_lo = 0; a.ph_hi = N_PHASES;
    hipLaunchKernelGGL(mk_fwd, dim3(grid), dim3(512), LDS_BYTES, stream, a);
#else
    for (int p = 0; p < N_PHASES; ++p) { a.ph_lo = p; a.ph_hi = p + 1; hipLaunchKernelGGL(mk_fwd, dim3(grid), dim3(512), LDS_BYTES, stream, a); }
#endif
}
```

```cpp
#include <hip/hip_runtime.h>
#include <cstdio>
#include <cstdint>

#define LAS __attribute__((address_space(3)))
#define GAS __attribute__((address_space(1)))
typedef unsigned short bf16_t;
typedef short bf16x8 __attribute__((ext_vector_type(8)));
typedef short s16x4 __attribute__((ext_vector_type(4)));
typedef float f32x4 __attribute__((ext_vector_type(4)));
typedef float f32x2 __attribute__((ext_vector_type(2)));
typedef float f32x16 __attribute__((ext_vector_type(16)));
typedef unsigned u32x4 __attribute__((ext_vector_type(4)));
typedef unsigned u32x2 __attribute__((ext_vector_type(2)));
typedef GAS unsigned gu32;

#ifndef MK_N_LAUNCHES
#define MK_N_LAUNCHES 1
#endif

constexpr int D = 1024, NB = 16, SEQ = 2048, T = NB * SEQ, NH = 8, DFF = 2816, UPW = 2 * DFF;
constexpr int PW = 2048;
constexpr int QW = 768, INW = 1952;
constexpr float ALPHA = 1.189207115002721f;
constexpr float QSCALE = 0.10206207261596575f * 1.4426950408889634f;
constexpr float LOG2E = 1.4426950408889634f;

constexpr size_t MiB = 1u << 20;
constexpr size_t WS_CTL = 0, CTL_ZERO_BYTES = 64 * 1024;
constexpr size_t WS_MOD = 1 * MiB;
constexpr size_t WS_ROPE = 2 * MiB;
constexpr size_t WS_SSQQ = 6 * MiB;
constexpr size_t WS_SSQKV = 6 * MiB + 512 * 1024;
constexpr size_t WS_WIN = 8 * MiB;
constexpr size_t WS_WQ = 12 * MiB;
constexpr size_t WS_WKV = 12 * MiB + 512 * 1024;
constexpr size_t WS_WOUT = 13 * MiB;
constexpr size_t WS_WUP = 15 * MiB;
constexpr size_t WS_WDN = 26 * MiB;
constexpr size_t WS_HB = 32 * MiB;
constexpr size_t WS_FF = 32 * MiB;
constexpr size_t WS_P = 96 * MiB;
constexpr size_t WS_MIX = 96 * MiB;
constexpr size_t WS_Q = 224 * MiB;
constexpr size_t WS_KN = 272 * MiB;
constexpr size_t WS_KR = 304 * MiB;
constexpr size_t WS_V = 306 * MiB;
constexpr size_t WS_Y = 338 * MiB;
constexpr size_t WS_ACT = 96 * MiB;
constexpr size_t WS_E = 272 * MiB;
constexpr size_t WS_END = 402 * MiB;
constexpr int CW_BAR = 1024;

constexpr int RING_BYTES = 131072, LDSCTL_OFF = RING_BYTES, MISC_OFF = LDSCTL_OFF + 320, LDS_BYTES = 147456;

__device__ __forceinline__ unsigned cvt_pk_bf16(float lo, float hi) { unsigned r; asm volatile("v_cvt_pk_bf16_f32 %0, %1, %2" : "=v"(r) : "v"(lo), "v"(hi)); return r; }
__device__ __forceinline__ float bf_lo(unsigned u) { return __uint_as_float(u << 16); }
__device__ __forceinline__ float bf_hi(unsigned u) { return __uint_as_float(u & 0xffff0000u); }
__device__ __forceinline__ float fexp2(float x) { return __builtin_amdgcn_exp2f(x); }
__device__ __forceinline__ float frcp(float x) { return __builtin_amdgcn_rcpf(x); }
__device__ __forceinline__ float silu_f(float v) { return v * frcp(1.f + fexp2(-LOG2E * v)); }
__device__ __forceinline__ float wave_sum(float v) {
#pragma unroll
    for (int o = 1; o < 64; o <<= 1) v += __shfl_xor(v, o);
    return v;
}

namespace pg8 {
constexpr int BM = 256, BK = 64, HALF = 128, HTB = HALF * BK * 2, STAGE_BYTES = 8 * HTB, NXCD = 8, WGM = 8;
__host__ __device__ __forceinline__ int lds_byte(int r, int c) { const int st = (r >> 4) * 2 + (c >> 5), rr = r & 15, cc = c & 31, ob = rr * 64 + cc * 2; return st * 1024 + (ob ^ (((ob >> 9) & 1) << 5)); }
__host__ __device__ __forceinline__ void stage_rc(int b, int& R, int& C) { const int st = b / 1024, sb = b % 1024, swz = sb ^ (((sb >> 9) & 1) << 5); R = (st >> 1) * 16 + swz / 64; C = (st & 1) * 32 + (swz % 64) / 2; }
__host__ __device__ __forceinline__ int perm32(int rho) { const int n = rho >> 4, i = rho & 15; return 8 * (i >> 2) + 4 * n + (i & 3); }

struct Unit { int pm, pn; };
struct Gemm { const bf16_t* A; int lda; const bf16_t* Bt; int M, N, K; };

struct StaticOrder {
    int nM, nN, nwg, G, c;
    __device__ void init(int M, int N, int G_, int c_) { nM = M / BM; nN = N / BM; nwg = nM * nN; G = G_; c = c_; }
    __device__ bool next(int i, Unit& u) const {
        const long L = (long)i * G + c; if (L >= nwg) return false;
        int wgid = (int)L; { const int q = nwg / NXCD, r = nwg % NXCD, xcd = wgid % NXCD, off = wgid / NXCD; wgid = (xcd < r ? xcd * (q + 1) : r * (q + 1) + (xcd - r) * q) + off; }
        const int nig = WGM * nN, gid = wgid / nig, fm = gid * WGM, gsz = (nM - fm) < WGM ? (nM - fm) : WGM;
        u.pm = fm + ((wgid % nig) % gsz); u.pn = (wgid % nig) / gsz; return true;
    }
};

template <class Epi, bool ALIGN_EPI>
__device__ __forceinline__ void gemm_phase(LAS unsigned char* lds, const Gemm g, const StaticOrder& S, const Epi& E) {
    int tid = threadIdx.x; asm volatile("" : "+v"(tid));
    const int wid = __builtin_amdgcn_readfirstlane(tid >> 6), lane = tid & 63, wr = wid >> 2, wc = wid & 3, fr = lane & 15, fq = lane >> 4;
    const int K = g.K, nt = K / BK;
    unsigned voffA[2], voffB[2];
#pragma unroll
    for (int i = 0; i < 2; ++i) { int R, C; stage_rc(tid * 16 + i * 8192, R, C);
        voffA[i] = (unsigned)(R * g.lda + C) * 2u; voffB[i] = (unsigned)(R * K + C) * 2u; }
    const size_t kstep = (size_t)(BK * 2);
    const size_t hstepA = (size_t)HALF * g.lda * 2, hstepB = (size_t)HALF * K * 2;
    const size_t tstepA = 2 * hstepA, tstepB = 2 * hstepB;
    const unsigned ldsw = (unsigned)wid * 1024u;
    const int aoff = lds_byte(wr * 64 + fr, fq * 8), boff = lds_byte(wc * 32 + fr, fq * 8);
#define PG8_SA(b, h) (((b) * 2 + (h)) * HTB)
#define PG8_SB(b, h) ((4 + (b) * 2 + (h)) * HTB)
#define PG8_STAGE(bufoff, gbase, voff) do { _Pragma("unroll") for (int _i = 0; _i < 2; ++_i) \
        __builtin_amdgcn_global_load_lds((const unsigned*)((const char*)(gbase) + (voff)[_i]), (LAS unsigned*)(lds + (bufoff) + ldsw + _i * 8192), 16, 0, 0); } while (0)
#define PG8_LDA(dst, b, h) do { _Pragma("unroll") for (int m = 0; m < 4; ++m) _Pragma("unroll") for (int k = 0; k < 2; ++k) dst[m][k] = *(const LAS bf16x8*)(lds + PG8_SA(b, h) + aoff + m * 2048 + k * 1024); } while (0)
#define PG8_LDB(dst, b, h) do { _Pragma("unroll") for (int n = 0; n < 2; ++n) _Pragma("unroll") for (int k = 0; k < 2; ++k) dst[n][k] = *(const LAS bf16x8*)(lds + PG8_SB(b, h) + boff + n * 2048 + k * 1024); } while (0)
#define PG8_MMA(ai, bj, At, Bt) do { __builtin_amdgcn_s_setprio(1); _Pragma("unroll") for (int m = 0; m < 4; ++m) _Pragma("unroll") for (int n = 0; n < 2; ++n) _Pragma("unroll") for (int k = 0; k < 2; ++k) \
        acc[ai][bj][m][n] = __builtin_amdgcn_mfma_f32_16x16x32_bf16(Bt[n][k], At[m][k], acc[ai][bj][m][n], 0, 0, 0); __builtin_amdgcn_s_setprio(0); } while (0)
#define PG8_WAIT_V(n) asm volatile("s_waitcnt vmcnt(" #n ")" ::: "memory")
#define PG8_WAIT_L(n) asm volatile("s_waitcnt lgkmcnt(" #n ")" ::: "memory")
#define PG8_BAR __builtin_amdgcn_s_barrier()
#define PG8_SCHED __builtin_amdgcn_sched_barrier(0)
    Unit cur, nxt; int ui = 0;
    if (!S.next(0, cur)) return;
    f32x4 acc[2][2][4][2];
#pragma unroll
    for (int a = 0; a < 2; ++a)
#pragma unroll
        for (int b = 0; b < 2; ++b)
#pragma unroll
            for (int m = 0; m < 4; ++m)
#pragma unroll
                for (int n = 0; n < 2; ++n) acc[a][b][m][n] = (f32x4){0.f, 0.f, 0.f, 0.f};
    bf16x8 At[4][2], B0[2][2], B1[2][2];
    const char* cA = (const char*)g.A + (size_t)cur.pm * tstepA; const char* cB = (const char*)g.Bt + (size_t)cur.pn * tstepB;
    if constexpr (Epi::HAS_PREFETCH) E.prefetch(cur, 0, lds, wid, lane);
    PG8_STAGE(PG8_SB(0, 0), cB, voffB); PG8_STAGE(PG8_SB(0, 1), cB + hstepB, voffB); PG8_STAGE(PG8_SA(0, 0), cA, voffA); PG8_STAGE(PG8_SA(0, 1), cA + hstepA, voffA);
    if (wr == 1) PG8_BAR;
    PG8_WAIT_V(2); PG8_BAR;
    PG8_STAGE(PG8_SB(1, 0), cB + kstep, voffB); PG8_STAGE(PG8_SA(1, 0), cA + kstep, voffA); PG8_STAGE(PG8_SB(1, 1), cB + hstepB + kstep, voffB);
    PG8_WAIT_V(6); PG8_BAR;
    for (;;) {
        const bool has_next = S.next(ui + 1, nxt);
        const char* nA = has_next ? (const char*)g.A + (size_t)nxt.pm * tstepA : cA; const char* nB = has_next ? (const char*)g.Bt + (size_t)nxt.pn * tstepB : cB;
#pragma nounroll
        for (int t = 0; t < nt; t += 2) {
            const bool last = (t == nt - 2);
            const char* a1 = cA + (size_t)(t + 1) * kstep;
            const char* a2 = last ? nA : cA + (size_t)(t + 2) * kstep; const char* b2 = last ? nB : cB + (size_t)(t + 2) * kstep;
            const char* a3 = a2 + kstep; const char* b3 = b2 + kstep;
            PG8_LDB(B0, 0, 0); PG8_LDB(B1, 0, 1); PG8_SCHED; PG8_LDA(At, 0, 0); PG8_STAGE(PG8_SA(1, 1), a1 + hstepA, voffA);
            PG8_WAIT_V(8); PG8_WAIT_L(0); PG8_BAR; PG8_MMA(0, 0, At, B0); PG8_MMA(0, 1, At, B1); PG8_BAR; PG8_SCHED;
            PG8_LDA(At, 0, 1); PG8_STAGE(PG8_SB(0, 0), b2, voffB); PG8_STAGE(PG8_SB(0, 1), b2 + hstepB, voffB); PG8_STAGE(PG8_SA(0, 0), a2, voffA);
            PG8_WAIT_V(8); PG8_WAIT_L(0); PG8_BAR; PG8_MMA(1, 0, At, B0); PG8_MMA(1, 1, At, B1); PG8_BAR; PG8_SCHED;
            PG8_LDB(B0, 1, 0); PG8_LDB(B1, 1, 1); PG8_SCHED; PG8_LDA(At, 1, 0); PG8_STAGE(PG8_SA(0, 1), a2 + hstepA, voffA);
            PG8_WAIT_V(8); PG8_WAIT_L(0); PG8_BAR; PG8_MMA(0, 0, At, B0); PG8_MMA(0, 1, At, B1); PG8_BAR; PG8_SCHED;
            PG8_LDA(At, 1, 1); PG8_STAGE(PG8_SB(1, 0), b3, voffB); PG8_STAGE(PG8_SB(1, 1), b3 + hstepB, voffB); PG8_STAGE(PG8_SA(1, 0), a3, voffA);
            PG8_WAIT_V(8); PG8_WAIT_L(0); PG8_BAR; PG8_MMA(1, 0, At, B0); PG8_MMA(1, 1, At, B1); PG8_BAR; PG8_SCHED;
        }
        if constexpr (ALIGN_EPI) { if (wr == 0) PG8_BAR; }
        { int t_e = threadIdx.x; asm volatile("" : "+v"(t_e)); const int fr_e = t_e & 15, fq_e = (t_e >> 4) & 3;
          if constexpr (Epi::HAS_PREFETCH) { if (has_next) E.prefetch(nxt, (ui + 1) & 1, lds, wid, t_e & 63); E.run(acc, cur, wr, wc, fr_e, fq_e, lds, ui & 1); }
          else E(acc, cur, wr, wc, fr_e, fq_e); }
        if (!has_next) break;
#pragma unroll
        for (int a = 0; a < 2; ++a)
#pragma unroll
            for (int b = 0; b < 2; ++b)
#pragma unroll
                for (int m = 0; m < 4; ++m)
#pragma unroll
                    for (int n = 0; n < 2; ++n) acc[a][b][m][n] = (f32x4){0.f, 0.f, 0.f, 0.f};
        cur = nxt; cA = nA; cB = nB; ++ui;
        if constexpr (ALIGN_EPI) { if (wr == 1) PG8_BAR; }
    }
    PG8_WAIT_V(0);
    if constexpr (!ALIGN_EPI) { if (wr == 0) PG8_BAR; }
    PG8_BAR;
#undef PG8_SA
#undef PG8_SB
#undef PG8_STAGE
#undef PG8_LDA
#undef PG8_LDB
#undef PG8_MMA
#undef PG8_WAIT_V
#undef PG8_WAIT_L
#undef PG8_BAR
#undef PG8_SCHED
}

typedef f32x4 Acc[2][2][4][2];

struct EpiStore { static constexpr bool HAS_PREFETCH = false;
    bf16_t* O; int ldc;
    __device__ __forceinline__ void operator()(const Acc& acc, const Unit& u, int wr, int wc, int fr, int fq) const {
        const int row0 = u.pm * BM + wr * 64 + fr, col0 = u.pn * BM + wc * 32 + 8 * fq;
#pragma unroll
        for (int ai = 0; ai < 2; ++ai)
#pragma unroll
            for (int m = 0; m < 4; ++m) { bf16_t* rowp = O + (size_t)(row0 + ai * HALF + m * 16) * ldc + col0;
#pragma unroll
                for (int bj = 0; bj < 2; ++bj) { const f32x4 v0 = acc[ai][bj][m][0], v1 = acc[ai][bj][m][1];
                    u32x4 w; w.x = cvt_pk_bf16(v0[0], v0[1]); w.y = cvt_pk_bf16(v0[2], v0[3]); w.z = cvt_pk_bf16(v1[0], v1[1]); w.w = cvt_pk_bf16(v1[2], v1[3]);
                    *(u32x4*)(rowp + bj * HALF) = w; } }
    }
};

struct EpiP { static constexpr bool HAS_PREFETCH = false;
    bf16_t* O; float* ssq_q; float* ssq_kv;
    __device__ __forceinline__ void operator()(const Acc& acc, const Unit& u, int wr, int wc, int fr, int fq) const {
        EpiStore st{O, PW}; st(acc, u, wr, wc, fr, fq);
        if (u.pn <= 1) {
            const int row0 = u.pm * BM + wr * 64 + fr; float* dst = (u.pn == 0) ? ssq_q : ssq_kv;
#pragma unroll
            for (int ai = 0; ai < 2; ++ai)
#pragma unroll
                for (int m = 0; m < 4; ++m) { float s = 0.f;
#pragma unroll
                    for (int n = 0; n < 2; ++n) { const f32x4 a = acc[ai][0][m][n]; s += (a[0] * a[0] + a[1] * a[1]) + (a[2] * a[2] + a[3] * a[3]); }
                    if (u.pn == 0) {
#pragma unroll
                        for (int n = 0; n < 2; ++n) { const f32x4 a = acc[ai][1][m][n]; s += (a[0] * a[0] + a[1] * a[1]) + (a[2] * a[2] + a[3] * a[3]); } }
                    s += __shfl_xor(s, 16); s += __shfl_xor(s, 32);
                    if (fq == 0) dst[(size_t)(row0 + ai * HALF + m * 16) * 4 + wc] = s; }
        }
    }
};

struct EpiQ { static constexpr bool HAS_PREFETCH = false;
    bf16_t* Q; const float* ssq; const float* rope;
    __device__ __forceinline__ void operator()(const Acc& acc, const Unit& u, int wr, int wc, int fr, int fq) const {
        const int row0 = u.pm * BM + wr * 64 + fr;
#pragma unroll
        for (int bj = 0; bj < 2; ++bj) { const int g = 8 * u.pn + 4 * bj + wc; const bool is_rope = (g % 3) == 2;
            bf16_t* qcol = Q + 32 * g;
            if (!is_rope) {
#pragma unroll
                for (int ai = 0; ai < 2; ++ai)
#pragma unroll
                    for (int m = 0; m < 4; ++m) { const int t = row0 + ai * HALF + m * 16;
                        const f32x4 sp = *(const f32x4*)(ssq + (size_t)t * 4);
                        const float f = rsqrtf(((sp[0] + sp[1]) + (sp[2] + sp[3])) * (1.f / 256.f) + 1e-6f) * QSCALE;
                        const f32x4 v0 = acc[ai][bj][m][0] * f, v1 = acc[ai][bj][m][1] * f;
                        u32x4 w; w.x = cvt_pk_bf16(v0[0], v0[1]); w.y = cvt_pk_bf16(v0[2], v0[3]); w.z = cvt_pk_bf16(v1[0], v1[1]); w.w = cvt_pk_bf16(v1[2], v1[3]);
                        *(u32x4*)(qcol + (size_t)t * QW + 8 * fq) = w;
                        if (m & 1) asm volatile("" ::: "memory"); }
            } else {
#pragma unroll
                for (int ai = 0; ai < 2; ++ai)
#pragma unroll
                    for (int m = 0; m < 4; ++m) { const int t = row0 + ai * HALF + m * 16;
                        const f32x4 sp = *(const f32x4*)(ssq + (size_t)t * 4);
                        const float f = rsqrtf(((sp[0] + sp[1]) + (sp[2] + sp[3])) * (1.f / 256.f) + 1e-6f) * QSCALE;
                        const f32x4 cs = *(const f32x4*)(rope + (size_t)t * 32 + 4 * fq), sn = *(const f32x4*)(rope + (size_t)t * 32 + 16 + 4 * fq);
                        const f32x4 a0 = acc[ai][bj][m][0], a1 = acc[ai][bj][m][1];
                        const f32x4 o1 = (a0 * cs - a1 * sn) * f, o2 = (a1 * cs + a0 * sn) * f;
                        u32x2 w1, w2; w1.x = cvt_pk_bf16(o1[0], o1[1]); w1.y = cvt_pk_bf16(o1[2], o1[3]); w2.x = cvt_pk_bf16(o2[0], o2[1]); w2.y = cvt_pk_bf16(o2[2], o2[3]);
                        *(u32x2*)(qcol + (size_t)t * QW + 4 * fq) = w1; *(u32x2*)(qcol + (size_t)t * QW + 16 + 4 * fq) = w2;
                        if (m & 1) asm volatile("" ::: "memory"); }
            } }
    }
};

struct EpiKV { static constexpr bool HAS_PREFETCH = false;
    bf16_t* KN; bf16_t* V; const float* ssq;
    __device__ __forceinline__ void operator()(const Acc& acc, const Unit& u, int wr, int wc, int fr, int fq) const {
        const int row0 = u.pm * BM + wr * 64 + fr; const int b = u.pm >> 3;
#pragma unroll
        for (int bj = 0; bj < 2; ++bj) { const int g = 8 * u.pn + 4 * bj + wc, head = g >> 2, part = g & 3;
            char* base = (part < 2) ? (char*)KN + (4 * part + fq) * 1024 + fr * 16 : (char*)V + (part - 2) * 4096 + fr * 64 + fq * 16;
            const int mstep = (part < 2) ? 256 : 1024;
            base += (size_t)(b * 8 + head) * 32 * 8192;
#pragma unroll
            for (int ai = 0; ai < 2; ++ai) { const int tile = (4 * u.pm + 2 * ai + wr) & 31;
#pragma unroll
                for (int m = 0; m < 4; ++m) { const int t = row0 + ai * HALF + m * 16;
                    const f32x4 sp = *(const f32x4*)(ssq + (size_t)t * 4);
                    const float f = rsqrtf(((sp[0] + sp[1]) + (sp[2] + sp[3])) * (1.f / 128.f) + 1e-6f);
                    const f32x4 v0 = acc[ai][bj][m][0] * f, v1 = acc[ai][bj][m][1] * f;
                    u32x4 w; w.x = cvt_pk_bf16(v0[0], v0[1]); w.y = cvt_pk_bf16(v0[2], v0[3]); w.z = cvt_pk_bf16(v1[0], v1[1]); w.w = cvt_pk_bf16(v1[2], v1[3]);
                    *(u32x4*)(base + (size_t)tile * 8192 + m * mstep) = w;
                    if (m & 1) asm volatile("" ::: "memory"); } } }
    }
};

template <int CTRL> __device__ __forceinline__ float dppf(float v) { return __builtin_bit_cast(float, __builtin_amdgcn_update_dpp(0, __builtin_bit_cast(int, v), CTRL, 0xf, 0xf, true)); }
template <int CTRL> __device__ __forceinline__ f32x4 dpp4(f32x4 v) { f32x4 r; r[0] = dppf<CTRL>(v[0]); r[1] = dppf<CTRL>(v[1]); r[2] = dppf<CTRL>(v[2]); r[3] = dppf<CTRL>(v[3]); return r; }

constexpr int CW_LDS = RING_BYTES + 1024;
struct EpiUp { static constexpr bool HAS_PREFETCH = true;
    bf16_t* ACT; float* E; const float* cw; const float* cb;
    __device__ __forceinline__ void prefetch(const Unit& u, int buf, LAS unsigned char* lds, int wid, int lane) const {
        if (wid < 4) { const float* base = (wid < 3) ? cw + (size_t)wid * UPW : cb;
            const float* src = base + 128 * u.pn + ((lane & 32) ? DFF : 0) + 4 * (lane & 31);
            __builtin_amdgcn_global_load_lds((const unsigned*)src, (LAS unsigned*)(lds + CW_LDS + buf * 4096 + wid * 1024), 16, 0, 0); }
    }
    __device__ __forceinline__ void run(const Acc& acc, const Unit& u, int wr, int wc, int fr, int fq, LAS unsigned char* lds, int buf) const {
        const int cl = 32 * wc + 8 * fq;
        const int cbase = 128 * u.pn + cl;
        const LAS float* wl = (const LAS float*)(lds + CW_LDS + buf * 4096) + cl;
        u32x2 res0[2][4];
#pragma unroll
        for (int n = 0; n < 2; ++n) { const int c0 = cbase + 4 * n;
            const f32x4 wg0 = *(const LAS f32x4*)(wl + 4 * n), wg1 = *(const LAS f32x4*)(wl + 256 + 4 * n), wg2 = *(const LAS f32x4*)(wl + 512 + 4 * n), bg = *(const LAS f32x4*)(wl + 768 + 4 * n);
            const f32x4 wv0 = *(const LAS f32x4*)(wl + 128 + 4 * n), wv1 = *(const LAS f32x4*)(wl + 384 + 4 * n), wv2 = *(const LAS f32x4*)(wl + 640 + 4 * n), bv = *(const LAS f32x4*)(wl + 896 + 4 * n);
#pragma unroll
            for (int ai = 0; ai < 2; ++ai) { f32x4 pg1 = {0.f, 0.f, 0.f, 0.f}, pg2 = pg1, pv1 = pg1, pv2 = pg1;
                const int blk = 4 * u.pm + 2 * ai + wr;
#pragma unroll
                for (int m = 0; m < 4; ++m) { const f32x4 gcur = acc[ai][0][m][n], vcur = acc[ai][1][m][n];
                    const f32x4 rg1 = dpp4<0x121>(gcur), rg2 = dpp4<0x122>(gcur), rv1 = dpp4<0x121>(vcur), rv2 = dpp4<0x122>(vcur);
                    const f32x4 g1 = (fr >= 1) ? rg1 : pg1, g2 = (fr >= 2) ? rg2 : pg2, v1 = (fr >= 1) ? rv1 : pv1, v2 = (fr >= 2) ? rv2 : pv2;
                    const f32x4 cg = bg + wg0 * g2 + wg1 * g1 + wg2 * gcur, cv = bv + wv0 * v2 + wv1 * v1 + wv2 * vcur;
                    f32x4 a; a[0] = silu_f(cg[0]) * cv[0]; a[1] = silu_f(cg[1]) * cv[1]; a[2] = silu_f(cg[2]) * cv[2]; a[3] = silu_f(cg[3]) * cv[3];
                    u32x2 w; w.x = cvt_pk_bf16(a[0], a[1]); w.y = cvt_pk_bf16(a[2], a[3]);
                    const int t = u.pm * BM + ai * HALF + wr * 64 + m * 16 + fr;
                    if (n == 0) res0[ai][m] = w;
                    else if (!(m == 0 && fr < 2)) { u32x4 o; o.x = res0[ai][m].x; o.y = res0[ai][m].y; o.z = w.x; o.w = w.y; *(u32x4*)(ACT + (size_t)t * DFF + cbase) = o; }
                    if (m == 0 && fr < 2) { float* e = E + ((size_t)blk * 4 + fr) * UPW + c0; *(f32x4*)e = gcur; *(f32x4*)(e + DFF) = vcur; }
                    if (m == 3 && fr >= 14) { float* e = E + ((size_t)blk * 4 + 2 + (fr - 14)) * UPW + c0; *(f32x4*)e = gcur; *(f32x4*)(e + DFF) = vcur; }
                    pg1 = rg1; pg2 = rg2; pv1 = rv1; pv2 = rv2; } } }
    }
};
}

namespace att {
constexpr int NSLOT = 3, K_OFF = 0, KSLOT = 12288, V_OFF = NSLOT * KSLOT, VSLOT = 8192, WS_OFF = V_OFF + NSLOT * VSLOT, OST_OFF = WS_OFF + 8 * 256, LDS_END = OST_OFF + 8 * 8192;
static_assert(LDS_END <= RING_BYTES, "attention LDS");
__device__ __forceinline__ int crow(int r, int hi) { return (r & 3) + 8 * (r >> 2) + 4 * hi; }
typedef short v4i16_t __attribute__((ext_vector_type(4)));
__device__ __forceinline__ s16x4 vtr(const LAS unsigned char* p) { return __builtin_bit_cast(s16x4, __builtin_amdgcn_ds_read_tr16_b64_v4i16((LAS v4i16_t*)p)); }
__device__ __forceinline__ void glds(const char* src, LAS unsigned char* dst) { unsigned keep; const unsigned d = (unsigned)__builtin_amdgcn_readfirstlane((int)(unsigned)(uintptr_t)dst);
    asm volatile("s_mov_b32 %0, m0\n\ts_mov_b32 m0, %2\n\ts_nop 0\n\tglobal_load_lds_dwordx4 %1, off\n\ts_mov_b32 m0, %0" : "=&s"(keep) : "v"(src), "s"(d) : "memory"); }
__device__ __forceinline__ float max3f(float a, float b, float c) { float r; asm("v_max3_f32 %0, %1, %2, %3" : "=v"(r) : "v"(a), "v"(b), "v"(c)); return r; }
__device__ __forceinline__ float max2f(float a, float b) { float r; asm("v_max_f32_e32 %0, %1, %2" : "=v"(r) : "v"(a), "v"(b)); return r; }
__device__ __forceinline__ float fadd_s(float a, float b) { float r; asm("v_add_f32_e32 %0, %1, %2" : "=v"(r) : "v"(a), "v"(b)); return r; }
constexpr float THRL = 4.0f;

struct AUnit { int b, h, qb; };
__device__ __forceinline__ bool unit_of(int k, int vcu, int G, AUnit& u) {
    const int it = vcu + (k >> 2) * G, r = k & 3; if (it >= 256) return false;
    const int grp = it >> 3, i8 = it & 7, bh = grp * 4 + r; u.b = bh >> 3; u.h = bh & 7;
    u.qb = (r == 0) ? 7 - i8 : (r == 1) ? i8 : (r == 2) ? 7 - (i8 ^ 1) : (i8 ^ 1); return true;
}
__device__ __forceinline__ void attn_phase(int vcu, int G, const bf16_t* Q, const bf16_t* KN, const bf16_t* KR, const bf16_t* V, bf16_t* Y, const float* ong, LAS unsigned char* lds) {
    int tid = threadIdx.x; asm volatile("" : "+v"(tid));
    const int lane = tid & 63, r32 = lane & 31, hi = lane >> 5; const int wid = __builtin_amdgcn_readfirstlane(tid >> 6);
    const int lo16 = wid * 1024 + lane * 16;
    LAS float* wsf = (LAS float*)(lds + WS_OFF + wid * 256);
    const int kl = hi * 1024 + r32 * 16, vl = ((lane >> 4) & 1) * 32 + (lane & 3) * 8 + (4 * hi + ((lane & 15) >> 2)) * 64;
#define ATT_ISSUE(U, tile, slot) do { const size_t bh_ = (size_t)((U).b * 8 + (U).h); \
        glds((const char*)KN + (bh_ * 32 + (tile)) * 8192 + lo16, lds + K_OFF + (slot) * KSLOT + wid * 1024); glds((const char*)V + (bh_ * 32 + (tile)) * 8192 + lo16, lds + V_OFF + (slot) * VSLOT + wid * 1024); \
        if (wid < 4) glds((const char*)KR + ((size_t)(U).b * 32 + (tile)) * 4096 + lo16, lds + K_OFF + (slot) * KSLOT + 8192 + wid * 1024); } while (0)
#define ATT_QLOAD(dst, U) do { const bf16_t* qp_ = Q + (size_t)((U).b * SEQ + 256 * (U).qb + 32 * wid + r32) * QW + 96 * (U).h + 8 * hi; \
        _Pragma("unroll") for (int ks = 0; ks < 6; ++ks) dst[ks] = *(const bf16x8*)(qp_ + 16 * ks); } while (0)
    AUnit cur, nxt;
    if (!unit_of(0, vcu, G, cur)) return;
    bf16x8 qr[6], qn[6];
    ATT_QLOAD(qr, cur);
    asm volatile("" : "+v"(qr[0]), "+v"(qr[1]), "+v"(qr[2]), "+v"(qr[3]), "+v"(qr[4]), "+v"(qr[5]));
    ATT_ISSUE(cur, 0, 0); ATT_ISSUE(cur, 1, 1);
    int slot = 0;
    for (int k = 0;; ++k) {
        const bool has_next = unit_of(k + 1, vcu, G, nxt);
        const int NT = 4 * cur.qb + 4, jmax = 4 * cur.qb + (wid >> 1);
        float mrun = 0.f, lrun = 0.f; f32x16 o[2]; o[0] = f32x16{}; o[1] = f32x16{}; f32x16 negm = f32x16{};
        for (int j = 0; j < NT; ++j) {
            if (j == 0 && k > 0) { if (wid < 4) asm volatile("s_waitcnt vmcnt(13) lgkmcnt(0)\n\ts_barrier" ::: "memory"); else asm volatile("s_waitcnt vmcnt(12) lgkmcnt(0)\n\ts_barrier" ::: "memory"); }
            else if (j + 1 < NT || has_next) { if (wid < 4) asm volatile("s_waitcnt vmcnt(3) lgkmcnt(0)\n\ts_barrier" ::: "memory"); else asm volatile("s_waitcnt vmcnt(2) lgkmcnt(0)\n\ts_barrier" ::: "memory"); }
            else asm volatile("s_waitcnt vmcnt(0) lgkmcnt(0)\n\ts_barrier" ::: "memory");
            { const int s2 = (slot == 0) ? 2 : slot - 1;
              if (j + 2 < NT) ATT_ISSUE(cur, j + 2, s2); else if (has_next) ATT_ISSUE(nxt, j + 2 - NT, s2); }
            if (j == NT - 1 && has_next) ATT_QLOAD(qn, nxt);
            if (j <= jmax) {
                const LAS unsigned char* kp = lds + K_OFF + slot * KSLOT + kl;
                f32x16 p0, p1;
#pragma unroll
                for (int ks = 0; ks < 6; ++ks) { const bf16x8 k0 = *(const LAS bf16x8*)(kp + ks * 2048), k1 = *(const LAS bf16x8*)(kp + ks * 2048 + 512);
                    if (ks == 0) { p0 = __builtin_amdgcn_mfma_f32_32x32x16_bf16(k0, qr[0], negm, 0, 0, 0); p1 = __builtin_amdgcn_mfma_f32_32x32x16_bf16(k1, qr[0], negm, 0, 0, 0); }
                    else { p0 = __builtin_amdgcn_mfma_f32_32x32x16_bf16(k0, qr[ks], p0, 0, 0, 0); p1 = __builtin_amdgcn_mfma_f32_32x32x16_bf16(k1, qr[ks], p1, 0, 0, 0); } }
                float rm;
                { float a = max3f(p0[0], p0[1], p1[0]), c = max3f(p0[2], p0[3], p1[1]); a = max3f(a, p1[2], p1[3]);
#pragma unroll
                  for (int r = 4; r < 16; r += 4) { a = max3f(a, p0[r], p0[r + 1]); c = max3f(c, p0[r + 2], p0[r + 3]); a = max3f(a, p1[r], p1[r + 1]); c = max3f(c, p1[r + 2], p1[r + 3]); }
                  rm = max2f(a, c); rm = max2f(rm, __shfl_xor(rm, 32)); }
                if (j == 0 || __any(rm > THRL)) {
                    const float dl = (j == 0) ? rm : fmaxf(rm, 0.f);
                    mrun += dl;
#pragma unroll
                    for (int r = 0; r < 16; ++r) { p0[r] -= dl; p1[r] -= dl; }
#pragma unroll
                    for (int r = 0; r < 16; ++r) negm[r] = -mrun;
                    if (j != 0) { const float alpha = fexp2(-dl); lrun *= alpha;
                        if (hi == 0) wsf[r32] = alpha;
#pragma unroll
                        for (int r = 0; r < 16; ++r) { const float a_ = wsf[crow(r, hi)]; o[0][r] *= a_; o[1][r] *= a_; } }
                }
#pragma unroll
                for (int r = 0; r < 16; ++r) { p0[r] = fexp2(p0[r]); p1[r] = fexp2(p1[r]); }
                { float s0 = fadd_s(p0[0], p1[0]), s1 = fadd_s(p0[1], p1[1]);
#pragma unroll
                  for (int r = 2; r < 16; r += 2) { s0 = fadd_s(s0, p0[r]); s1 = fadd_s(s1, p0[r + 1]); s0 = fadd_s(s0, p1[r]); s1 = fadd_s(s1, p1[r + 1]); }
                  lrun = fadd_s(lrun, fadd_s(s0, s1)); }
                bf16x8 pa[4];
                { u32x4 w0, w1, w2, w3;
                  w0.x = cvt_pk_bf16(p0[0], p0[1]); w0.y = cvt_pk_bf16(p0[2], p0[3]); w0.z = cvt_pk_bf16(p0[4], p0[5]); w0.w = cvt_pk_bf16(p0[6], p0[7]);
                  w1.x = cvt_pk_bf16(p0[8], p0[9]); w1.y = cvt_pk_bf16(p0[10], p0[11]); w1.z = cvt_pk_bf16(p0[12], p0[13]); w1.w = cvt_pk_bf16(p0[14], p0[15]);
                  w2.x = cvt_pk_bf16(p1[0], p1[1]); w2.y = cvt_pk_bf16(p1[2], p1[3]); w2.z = cvt_pk_bf16(p1[4], p1[5]); w2.w = cvt_pk_bf16(p1[6], p1[7]);
                  w3.x = cvt_pk_bf16(p1[8], p1[9]); w3.y = cvt_pk_bf16(p1[10], p1[11]); w3.z = cvt_pk_bf16(p1[12], p1[13]); w3.w = cvt_pk_bf16(p1[14], p1[15]);
                  pa[0] = __builtin_bit_cast(bf16x8, w0); pa[1] = __builtin_bit_cast(bf16x8, w1); pa[2] = __builtin_bit_cast(bf16x8, w2); pa[3] = __builtin_bit_cast(bf16x8, w3); }
                const LAS unsigned char* vp = lds + V_OFF + slot * VSLOT + vl;
#pragma unroll
                for (int d0 = 0; d0 < 2; ++d0)
#pragma unroll
                    for (int ks = 0; ks < 4; ++ks) { const s16x4 lo = vtr(vp + d0 * 4096 + ks * 1024), hh = vtr(vp + d0 * 4096 + ks * 1024 + 512);
                        const bf16x8 vf = {lo[0], lo[1], lo[2], lo[3], hh[0], hh[1], hh[2], hh[3]};
                        o[d0] = __builtin_amdgcn_mfma_f32_32x32x16_bf16(pa[ks], vf, o[d0], 0, 0, 0); }
            }
            slot = (slot == 2) ? 0 : slot + 1;
        }
        { const float lt = lrun + __shfl_xor(lrun, 32);
          if (hi == 0) wsf[r32] = frcp(lt);
          LAS float* stg = (LAS float*)(lds + OST_OFF + wid * 8192);
#pragma unroll
          for (int r = 0; r < 16; ++r) { const float inv = wsf[crow(r, hi)]; const int orow = crow(r, hi); stg[orow * 64 + r32] = o[0][r] * inv; stg[orow * 64 + 32 + r32] = o[1][r] * inv; }
          const int ch = lane & 7;
          const f32x4 ga = *(const f32x4*)(ong + 64 * cur.h + 8 * ch), gb = *(const f32x4*)(ong + 64 * cur.h + 8 * ch + 4);
          bf16_t* Yw = Y + (size_t)(cur.b * SEQ + 256 * cur.qb + 32 * wid) * D + 64 * cur.h + 8 * ch;
#pragma unroll
          for (int i = 0; i < 4; ++i) { const int row = i * 8 + (lane >> 3);
              const f32x4 va = *(const LAS f32x4*)(stg + row * 64 + 8 * ch), vb = *(const LAS f32x4*)(stg + row * 64 + 8 * ch + 4);
              float ss = (va[0] * va[0] + va[1] * va[1]) + (va[2] * va[2] + va[3] * va[3]) + (vb[0] * vb[0] + vb[1] * vb[1]) + (vb[2] * vb[2] + vb[3] * vb[3]);
              ss += pg8::dppf<0xB1>(ss); ss += pg8::dppf<0x4E>(ss); ss += pg8::dppf<0x141>(ss);
              const float rs = rsqrtf(ss * (1.f / 64.f) + 1e-6f);
              const f32x4 oa = va * rs * ga, ob = vb * rs * gb;
              u32x4 w; w.x = cvt_pk_bf16(oa[0], oa[1]); w.y = cvt_pk_bf16(oa[2], oa[3]); w.z = cvt_pk_bf16(ob[0], ob[1]); w.w = cvt_pk_bf16(ob[2], ob[3]);
              *(u32x4*)(Yw + (size_t)row * D) = w; } }
        if (!has_next) break;
        cur = nxt;
#pragma unroll
        for (int ks = 0; ks < 6; ++ks) qr[ks] = qn[ks];
    }
    asm volatile("s_waitcnt vmcnt(0) lgkmcnt(0)\n\ts_barrier" ::: "memory");
#undef ATT_ISSUE
#undef ATT_QLOAD
}
}

#define XB_TMO      128
#define XB_XCNT(j)  (256  + 64 * (j))
#define XB_XSUB(j)  (1280 + 64 * (j))
#define XB_XGEN(j)  (2304 + 64 * (j))
#define XB_TOP      3328
#define XB_TOPGEN   3392
#define XCD_BAR_WORDS 3456
#define XB_SPIN_CAP (1u << 18)
__device__ __forceinline__ unsigned xb_ld(unsigned* p)              { return __hip_atomic_load(p, __ATOMIC_RELAXED, __HIP_MEMORY_SCOPE_AGENT); }
__device__ __forceinline__ unsigned xb_add(unsigned* p, unsigned v) { return __hip_atomic_fetch_add(p, v, __ATOMIC_RELAXED, __HIP_MEMORY_SCOPE_AGENT); }
__device__ __forceinline__ unsigned xb_xcc_id() { return (unsigned)__builtin_amdgcn_s_getreg((3 << 11) | 20) & 0xFu; }
#define XB_SPIN(cond, bar) do { unsigned _sp = 0; while (cond) { __builtin_amdgcn_s_sleep(1); \
    if ((++_sp & 255u) == 0u) { if (xb_ld(&(bar)[XB_TMO])) break; if (_sp > XB_SPIN_CAP) { atomicAdd(&(bar)[XB_TMO], 1u); break; } } } } while (0)
struct XcdBarrier { unsigned* bar; unsigned x; volatile LAS unsigned* st; };
__device__ __forceinline__ XcdBarrier xcd_barrier_post(unsigned* bar, volatile LAS unsigned* st) {
    XcdBarrier b; b.bar = bar; b.x = xb_xcc_id(); b.st = st;
    if (threadIdx.x == 0) (void)xb_add(&bar[XB_XCNT(b.x)], 1u);
    return b;
}
__device__ __forceinline__ void xcd_barrier_complete(unsigned* bar, unsigned x, unsigned& nloc, unsigned& nx) {
    const unsigned G = gridDim.x * gridDim.y * gridDim.z;
    unsigned sum, cnt, mine, sp = 0u;
    for (;;) {
        sum = 0u; cnt = 0u; mine = 0u;
#pragma unroll
        for (unsigned j = 0; j < 16; ++j) { const unsigned c = xb_ld(&bar[XB_XCNT(j)]); sum += c; cnt += (c > 0u) ? 1u : 0u; mine = (j == x) ? c : mine; }
        if (sum == G) break;
        __builtin_amdgcn_s_sleep(1);
        if ((++sp & 255u) == 0u) { if (xb_ld(&bar[XB_TMO])) break; if (sp > XB_SPIN_CAP) { atomicAdd(&bar[XB_TMO], 1u); break; } }
    }
    nloc = mine > 0u ? mine : 1u; nx = cnt > 0u ? cnt : 1u;
}
__device__ __forceinline__ void xcd_barrier(const XcdBarrier& b) {
    asm volatile("s_waitcnt vmcnt(0)" ::: "memory");
    __syncthreads();
    if (threadIdx.x == 0) {
        unsigned* bar = b.bar;
        __builtin_amdgcn_s_waitcnt(0);
        unsigned nloc = b.st[0], nx = b.st[1];
        if (nloc == 0u) { xcd_barrier_complete(bar, b.x, nloc, nx); b.st[0] = nloc; b.st[1] = nx; }
        const unsigned old = xb_add(&bar[XB_XSUB(b.x)], 1u);
        const unsigned gen = old / nloc;
        if (old + 1u == (gen + 1u) * nloc) {
            __builtin_amdgcn_fence(__ATOMIC_RELEASE, "agent");
            asm volatile("s_waitcnt vmcnt(0)" ::: "memory");
            const unsigned og = xb_add(&bar[XB_TOP], 1u);
            const unsigned tg = og / nx;
            if (og + 1u == (tg + 1u) * nx) xb_add(&bar[XB_TOPGEN], 1u);
            else XB_SPIN(xb_ld(&bar[XB_TOPGEN]) == tg, bar);
            __builtin_amdgcn_fence(__ATOMIC_ACQUIRE, "agent");
            xb_add(&bar[XB_XGEN(b.x)], 1u);
            asm volatile("s_waitcnt vmcnt(0)" ::: "memory");
        } else {
            XB_SPIN(xb_ld(&bar[XB_XGEN(b.x)]) == gen, bar);
            __builtin_amdgcn_fence(__ATOMIC_ACQUIRE, "agent");
            asm volatile("s_waitcnt vmcnt(0)" ::: "memory");
        }
    }
    __syncthreads();
}

struct Args { const float* in[22]; const int* pos; float* out; unsigned char* ws; int ph_lo, ph_hi; };
__constant__ float c_invfreq[16] = {1.0f, 0.5623413251903491f, 0.31622776601683794f, 0.1778279410038923f, 0.1f, 0.05623413251903491f, 0.03162277660168379f, 0.01778279410038923f,
                                    0.01f, 0.005623413251903491f, 0.0031622776601683794f, 0.001778279410038923f, 0.001f, 0.0005623413251903491f, 0.00031622776601683794f, 0.0001778279410038923f};

__device__ __forceinline__ int colmap(int which, int s) {
    const int p = (s & ~31) + pg8::perm32(s & 31);
    switch (which) {
        case 0: return p < 416 ? p : (p < 512 ? -1 : p - 96);
        case 1: return ((s >> 5) % 3 == 2) ? s : p;
        case 4: { const int pn = s >> 8, bj = (s >> 7) & 1, wc = (s >> 5) & 3; return bj * DFF + 128 * pn + 32 * wc + pg8::perm32(s & 31); }
        default: return p;
    }
}
__device__ __forceinline__ void p0_transpose_item(const float* W, int ldw, int Ksrc, const float* kscale, bf16_t* WT, int Kdst, int which, LAS float* scr, int item, int nblk, int lane) {
    const int kb = item / nblk, nb = item % nblk, k0 = 64 * kb, s0 = 32 * nb;
    const int cm = colmap(which, s0 + (lane & 31));
    float tv[32];
#pragma unroll
    for (int i = 0; i < 32; ++i) { const int k = k0 + 2 * i + (lane >> 5); tv[i] = (cm >= 0 && k < Ksrc) ? W[(size_t)k * ldw + cm] : 0.f; }
    if (kscale) {
#pragma unroll
        for (int i = 0; i < 32; ++i) { const int k = k0 + 2 * i + (lane >> 5); if (k < Ksrc) tv[i] *= kscale[k]; } }
#pragma unroll
    for (int i = 0; i < 32; ++i) scr[(2 * i + (lane >> 5)) * 33 + (lane & 31)] = tv[i];
    asm volatile("s_waitcnt lgkmcnt(0)" ::: "memory");
    const int c = lane & 7;
#pragma unroll
    for (int j = 0; j < 4; ++j) { const int n = (lane >> 3) + 8 * j; const LAS float* s = scr + (8 * c) * 33 + n;
        u32x4 o; o.x = cvt_pk_bf16(s[0 * 33], s[1 * 33]); o.y = cvt_pk_bf16(s[2 * 33], s[3 * 33]); o.z = cvt_pk_bf16(s[4 * 33], s[5 * 33]); o.w = cvt_pk_bf16(s[6 * 33], s[7 * 33]);
        *(u32x4*)(WT + (size_t)(s0 + n) * Kdst + k0 + 8 * c) = o; }
    asm volatile("s_waitcnt lgkmcnt(0)" ::: "memory");
}

constexpr int N_PHASES = 11;
#define OPAQUE_LANE(name) int name##_t = (int)threadIdx.x; asm volatile("" : "+v"(name##_t)); const int name = name##_t & 63

__global__ void __launch_bounds__(512, 2) mk_fwd(Args args) {
    extern __shared__ __attribute__((aligned(16))) unsigned char lds_raw[];
    LAS unsigned char* lds = (LAS unsigned char*)lds_raw;
    volatile LAS unsigned* MISC = (volatile LAS unsigned*)(lds + MISC_OFF);
    const int tid = threadIdx.x, lane = tid & 63, wave = __builtin_amdgcn_readfirstlane(tid >> 6);
    const int G = gridDim.x; const int bx = blockIdx.x; const int vcu = (G % 8 == 0) ? (bx % 8) * (G / 8) + bx / 8 : bx;
    const int gw = vcu * 8 + wave, NGW = G * 8;
    unsigned char* ws = args.ws;
    const float* x = args.in[0]; const float* cvec = args.in[1]; const int* pos = args.pos;
    const float* w_ada = args.in[3]; const float* b_ada = args.in[4]; const float* w_in = args.in[5];
    const float* qg = args.in[6]; const float* w_qup = args.in[7]; const float* kvg = args.in[8]; const float* w_kvup = args.in[9];
    const float* conv_w = args.in[10]; const float* conv_b = args.in[11]; const float* ong = args.in[12]; const float* w_out = args.in[13];
    const float* ln1g = args.in[14]; const float* ln1b = args.in[15]; const float* w_up = args.in[16];
    const float* fcw = args.in[17]; const float* fcb = args.in[18]; const float* w_down = args.in[19];
    const float* ln2g = args.in[20]; const float* ln2b = args.in[21];
    float* out = args.out;
    float* MOD = (float*)(ws + WS_MOD); float* ROPE = (float*)(ws + WS_ROPE); float* SSQQ = (float*)(ws + WS_SSQQ); float* SSQKV = (float*)(ws + WS_SSQKV);
    bf16_t* WIN = (bf16_t*)(ws + WS_WIN); bf16_t* WQ = (bf16_t*)(ws + WS_WQ); bf16_t* WKV = (bf16_t*)(ws + WS_WKV); bf16_t* WOUT = (bf16_t*)(ws + WS_WOUT);
    bf16_t* WUP = (bf16_t*)(ws + WS_WUP); bf16_t* WDN = (bf16_t*)(ws + WS_WDN);
    bf16_t* HB = (bf16_t*)(ws + WS_HB); bf16_t* FF = (bf16_t*)(ws + WS_FF); bf16_t* P = (bf16_t*)(ws + WS_P); bf16_t* MIX = (bf16_t*)(ws + WS_MIX);
    bf16_t* Qb = (bf16_t*)(ws + WS_Q); bf16_t* KN = (bf16_t*)(ws + WS_KN); bf16_t* KR = (bf16_t*)(ws + WS_KR); bf16_t* Vb = (bf16_t*)(ws + WS_V);
    bf16_t* Y = (bf16_t*)(ws + WS_Y); bf16_t* ACT = (bf16_t*)(ws + WS_ACT); float* E = (float*)(ws + WS_E);

    for (int u = tid; u < (LDS_BYTES - LDSCTL_OFF) / 4; u += 512) ((LAS unsigned*)(lds + LDSCTL_OFF))[u] = 0u;
    __syncthreads();
    XcdBarrier bar; bar.bar = (unsigned*)(ws + WS_CTL) + CW_BAR; bar.x = 0; bar.st = nullptr;
    if (MK_N_LAUNCHES == 1) bar = xcd_barrier_post((unsigned*)(ws + WS_CTL) + CW_BAR, MISC + 8);
    const int lo = args.ph_lo, hi = args.ph_hi;
#ifndef PH_MASK
#define PH_MASK 0x7ff
#endif
#define IN(k) (((PH_MASK >> (k)) & 1) && lo <= (k) && (k) < hi)
#define SEAM(k) do { if (IN(k) && IN((k) + 1)) xcd_barrier(bar); } while (0)

    if (IN(0)) {
        OPAQUE_LANE(ln);
        if (bx < 192) {
            LAS float* cact = (LAS float*)lds; LAS float* part = (LAS float*)(lds + 65536);
            const int n0 = 32 * bx, c4 = tid & 7, kr = tid >> 3;
            f32x4 wv[16];
#pragma unroll
            for (int i = 0; i < 16; ++i) wv[i] = *(const f32x4*)(w_ada + (size_t)(kr + 64 * i) * 6144 + n0 + 4 * c4);
            for (int i = tid; i < 16 * 1024; i += 512) { const float v = cvec[i]; cact[i] = v * frcp(1.f + fexp2(-LOG2E * v)); }
            __syncthreads();
            f32x4 a[16];
#pragma unroll
            for (int b = 0; b < 16; ++b) a[b] = (f32x4){0.f, 0.f, 0.f, 0.f};
#pragma unroll
            for (int i = 0; i < 16; ++i) { const int k = kr + 64 * i;
#pragma unroll
                for (int b = 0; b < 16; ++b) a[b] += wv[i] * cact[b * 1024 + k];
                if ((i & 1) == 1) asm volatile("" ::: "memory"); }
#pragma unroll
            for (int b = 0; b < 16; ++b)
#pragma unroll
                for (int e = 0; e < 4; ++e) { float v = a[b][e]; v += __shfl_xor(v, 8); v += __shfl_xor(v, 16); v += __shfl_xor(v, 32); a[b][e] = v; }
            if (ln < 8) {
#pragma unroll
                for (int b = 0; b < 16; ++b) *(LAS f32x4*)(part + (wave * 16 + b) * 32 + 4 * c4) = a[b]; }
            __syncthreads();
            { const int b = tid >> 5, col = tid & 31; float s = 0.f;
#pragma unroll
              for (int w8 = 0; w8 < 8; ++w8) s += part[(w8 * 16 + b) * 32 + col];
              MOD[b * 6144 + n0 + col] = s + b_ada[n0 + col]; }
            __syncthreads();
        }
        for (int idx = gw * 64 + ln; idx < T * 16; idx += NGW * 64) { const int t = idx >> 4, i = idx & 15; const float ang = (float)pos[t] * c_invfreq[i];
            ROPE[(size_t)t * 32 + i] = cosf(ang); ROPE[(size_t)t * 32 + 16 + i] = sinf(ang); }
        LAS float* scr = (LAS float*)(lds + wave * 16384);
        constexpr int I0 = 16 * 64, I1 = 4 * 24, I2 = 4 * 32, I3 = 16 * 32, I4 = 16 * 176, I5 = 44 * 32, NIT = I0 + I1 + I2 + I3 + I4 + I5;
        for (int it = gw; it < NIT; it += NGW) {
            int r = it;
            if (r < I0) { p0_transpose_item(w_in, INW, D, nullptr, WIN, D, 0, scr, r, 64, ln); continue; } r -= I0;
            if (r < I1) { p0_transpose_item(w_qup, QW, 256, qg, WQ, 256, 1, scr, r, 24, ln); continue; } r -= I1;
            if (r < I2) { p0_transpose_item(w_kvup, 1024, 128, kvg, WKV, 256, 2, scr, r, 32, ln); continue; } r -= I2;
            if (r < I3) { p0_transpose_item(w_out, D, D, nullptr, WOUT, D, 3, scr, r, 32, ln); continue; } r -= I3;
            if (r < I4) { p0_transpose_item(w_up, UPW, D, nullptr, WUP, D, 4, scr, r, 176, ln); continue; } r -= I4;
            p0_transpose_item(w_down, D, DFF, nullptr, WDN, DFF, 5, scr, r, 32, ln);
        }
    }
    SEAM(0);
    if (IN(1)) {
        OPAQUE_LANE(ln);
        for (int row0 = gw * 16; row0 < T; row0 += NGW * 16) { const int b = row0 / SEQ; const float* mb = MOD + b * 6144;
            f32x4 sc[4], sh[4];
#pragma unroll
            for (int j = 0; j < 4; ++j) { const int col = 4 * ln + 256 * j; sh[j] = *(const f32x4*)(mb + col); sc[j] = *(const f32x4*)(mb + 1024 + col) + 1.f; }
            for (int rr = 0; rr < 16; ++rr) { const int t = row0 + rr; const float* xr = x + (size_t)t * D;
                f32x4 v[4]; float s = 0.f;
#pragma unroll
                for (int j = 0; j < 4; ++j) { v[j] = *(const f32x4*)(xr + 4 * ln + 256 * j); s += (v[j][0] + v[j][1]) + (v[j][2] + v[j][3]); }
                const float mean = wave_sum(s) * (1.f / D); float q = 0.f;
#pragma unroll
                for (int j = 0; j < 4; ++j) { v[j] = v[j] - mean; q += (v[j][0] * v[j][0] + v[j][1] * v[j][1]) + (v[j][2] * v[j][2] + v[j][3] * v[j][3]); }
                const float rstd = rsqrtf(wave_sum(q) * (1.f / D) + 1e-5f);
#pragma unroll
                for (int j = 0; j < 4; ++j) { const f32x4 o = v[j] * rstd * sc[j] + sh[j]; u32x2 w; w.x = cvt_pk_bf16(o[0], o[1]); w.y = cvt_pk_bf16(o[2], o[3]);
                    *(u32x2*)(HB + (size_t)t * D + 4 * ln + 256 * j) = w; } } }
    }
    SEAM(1);
    if (IN(2)) {
        pg8::Gemm g{HB, D, WIN, T, PW, D}; pg8::StaticOrder S; S.init(T, PW, G, bx);
        pg8::EpiP E1{P, SSQQ, SSQKV};
        pg8::gemm_phase<pg8::EpiP, true>(lds, g, S, E1);
    }
    SEAM(2);
    if (IN(3)) {
        OPAQUE_LANE(ln);
#ifndef P3_MASK
#define P3_MASK 15
#endif
        if (P3_MASK & 1) { pg8::Gemm g{P, PW, WQ, T, QW, 256}; pg8::StaticOrder S; S.init(T, QW, G, bx); pg8::EpiQ E2{Qb, SSQQ, ROPE}; pg8::gemm_phase<pg8::EpiQ, true>(lds, g, S, E2); }
        if (P3_MASK & 2) { pg8::Gemm g{P + 256, PW, WKV, T, 1024, 256}; pg8::StaticOrder S; S.init(T, 1024, G, bx); pg8::EpiKV E3{KN, Vb, SSQKV}; pg8::gemm_phase<pg8::EpiKV, true>(lds, g, S, E3); }
        if (P3_MASK & 4) for (int row0 = gw * 16; row0 < T; row0 += NGW * 16) {
            const int c0 = 8 * ln;
            float w0[8], w1[8], w2[8], cb8[8], gn[8];
#pragma unroll
            for (int e = 0; e < 8; ++e) { w0[e] = conv_w[c0 + e]; w1[e] = conv_w[512 + c0 + e]; w2[e] = conv_w[1024 + c0 + e]; cb8[e] = conv_b[c0 + e]; gn[e] = ong[512 + c0 + e]; }
            float um2[8], um1[8];
#pragma unroll
            for (int e = 0; e < 8; ++e) { um2[e] = 0.f; um1[e] = 0.f; }
            if ((row0 % SEQ) != 0) {
                const u32x4 a2 = *(const u32x4*)(P + (size_t)(row0 - 2) * PW + 1024 + c0), b2 = *(const u32x4*)(P + (size_t)(row0 - 2) * PW + 1536 + c0);
                const u32x4 a1 = *(const u32x4*)(P + (size_t)(row0 - 1) * PW + 1024 + c0), b1 = *(const u32x4*)(P + (size_t)(row0 - 1) * PW + 1536 + c0);
#pragma unroll
                for (int e = 0; e < 4; ++e) { um2[2 * e] = bf_lo(a2[e]) * bf_lo(b2[e]); um2[2 * e + 1] = bf_hi(a2[e]) * bf_hi(b2[e]); um1[2 * e] = bf_lo(a1[e]) * bf_lo(b1[e]); um1[2 * e + 1] = bf_hi(a1[e]) * bf_hi(b1[e]); }
            }
            for (int rr = 0; rr < 16; ++rr) { const int t = row0 + rr; const bf16_t* pr = P + (size_t)t * PW;
                const u32x4 gb = *(const u32x4*)(pr + 512 + c0), gc = *(const u32x4*)(pr + 1024 + c0), cv = *(const u32x4*)(pr + 1536 + c0);
                float u0[8], yv[8]; float ss = 0.f;
#pragma unroll
                for (int e = 0; e < 4; ++e) { u0[2 * e] = bf_lo(gc[e]) * bf_lo(cv[e]); u0[2 * e + 1] = bf_hi(gc[e]) * bf_hi(cv[e]); }
#pragma unroll
                for (int e = 0; e < 8; ++e) { const float gbe = (e & 1) ? bf_hi(gb[e >> 1]) : bf_lo(gb[e >> 1]);
                    yv[e] = gbe * (cb8[e] + w0[e] * um2[e] + w1[e] * um1[e] + w2[e] * u0[e]); ss += yv[e] * yv[e]; um2[e] = um1[e]; um1[e] = u0[e]; }
                ss += __shfl_xor(ss, 1); ss += __shfl_xor(ss, 2); ss += __shfl_xor(ss, 4);
                const float rs = rsqrtf(ss * (1.f / 64.f) + 1e-6f);
                u32x4 o; o.x = cvt_pk_bf16(yv[0] * rs * gn[0], yv[1] * rs * gn[1]); o.y = cvt_pk_bf16(yv[2] * rs * gn[2], yv[3] * rs * gn[3]);
                o.z = cvt_pk_bf16(yv[4] * rs * gn[4], yv[5] * rs * gn[5]); o.w = cvt_pk_bf16(yv[6] * rs * gn[6], yv[7] * rs * gn[7]);
                *(u32x4*)(Y + (size_t)t * D + 512 + c0) = o; }
        }
        if (P3_MASK & 8) for (int tl = gw; tl < NB * 32; tl += NGW) { const int t = tl * 64 + ln; const bf16_t* pr = P + (size_t)t * PW + 384;
            u32x4 raw[4];
#pragma unroll
            for (int e = 0; e < 4; ++e) raw[e] = *(const u32x4*)(pr + 8 * e);
            float xv[32];
#pragma unroll
            for (int e = 0; e < 16; ++e) { xv[2 * e] = bf_lo(raw[e >> 2][e & 3]); xv[2 * e + 1] = bf_hi(raw[e >> 2][e & 3]); }
            float cs[16], sn[16];
#pragma unroll
            for (int e = 0; e < 4; ++e) { const f32x4 c4 = *(const f32x4*)(ROPE + (size_t)t * 32 + 4 * e), s4 = *(const f32x4*)(ROPE + (size_t)t * 32 + 16 + 4 * e);
                cs[4 * e] = c4[0]; cs[4 * e + 1] = c4[1]; cs[4 * e + 2] = c4[2]; cs[4 * e + 3] = c4[3]; sn[4 * e] = s4[0]; sn[4 * e + 1] = s4[1]; sn[4 * e + 2] = s4[2]; sn[4 * e + 3] = s4[3]; }
            float ov[32];
#pragma unroll
            for (int i = 0; i < 16; ++i) { ov[i] = xv[i] * cs[i] - xv[16 + i] * sn[i]; ov[16 + i] = xv[16 + i] * cs[i] + xv[i] * sn[i]; }
            char* dst = (char*)KR + (size_t)tl * 4096 + ln * 16;
#pragma unroll
            for (int c = 0; c < 4; ++c) { u32x4 o; o.x = cvt_pk_bf16(ov[8 * c], ov[8 * c + 1]); o.y = cvt_pk_bf16(ov[8 * c + 2], ov[8 * c + 3]); o.z = cvt_pk_bf16(ov[8 * c + 4], ov[8 * c + 5]); o.w = cvt_pk_bf16(ov[8 * c + 6], ov[8 * c + 7]);
                *(u32x4*)(dst + c * 1024) = o; } }
    }
    SEAM(3);
    if (IN(4)) {
        att::attn_phase(vcu, G, Qb, KN, KR, Vb, Y, ong, lds);
    }
    SEAM(4);
    if (IN(5)) {
        pg8::Gemm g{Y, D, WOUT, T, D, D}; pg8::StaticOrder S; S.init(T, D, G, bx); pg8::EpiStore E4{MIX, D};
        pg8::gemm_phase<pg8::EpiStore, true>(lds, g, S, E4);
    }
    SEAM(5);
    if (IN(6)) {
        OPAQUE_LANE(ln);
        for (int row0 = gw * 16; row0 < T; row0 += NGW * 16) { const int b = row0 / SEQ; const float* mb = MOD + b * 6144;
            f32x4 gt[4], g1v[4], b1v[4], sc[4], sh[4];
#pragma unroll
            for (int j = 0; j < 4; ++j) { const int col = 4 * ln + 256 * j; gt[j] = *(const f32x4*)(mb + 2048 + col); g1v[j] = *(const f32x4*)(ln1g + col); b1v[j] = *(const f32x4*)(ln1b + col);
                sh[j] = *(const f32x4*)(mb + 3072 + col); sc[j] = *(const f32x4*)(mb + 4096 + col) + 1.f; }
            for (int rr = 0; rr < 16; ++rr) { const int t = row0 + rr;
                f32x4 v[4]; float s = 0.f;
#pragma unroll
                for (int j = 0; j < 4; ++j) { const int col = 4 * ln + 256 * j; const f32x4 xv = *(const f32x4*)(x + (size_t)t * D + col); const u32x2 mw = *(const u32x2*)(MIX + (size_t)t * D + col);
                    const f32x4 mx = {bf_lo(mw.x), bf_hi(mw.x), bf_lo(mw.y), bf_hi(mw.y)};
                    v[j] = xv * ALPHA + gt[j] * mx; s += (v[j][0] + v[j][1]) + (v[j][2] + v[j][3]); }
                float mean = wave_sum(s) * (1.f / D); float q = 0.f;
#pragma unroll
                for (int j = 0; j < 4; ++j) { v[j] = v[j] - mean; q += (v[j][0] * v[j][0] + v[j][1] * v[j][1]) + (v[j][2] * v[j][2] + v[j][3] * v[j][3]); }
                float rstd = rsqrtf(wave_sum(q) * (1.f / D) + 1e-5f);
                s = 0.f;
#pragma unroll
                for (int j = 0; j < 4; ++j) { v[j] = v[j] * rstd * g1v[j] + b1v[j]; *(f32x4*)(out + (size_t)t * D + 4 * ln + 256 * j) = v[j]; s += (v[j][0] + v[j][1]) + (v[j][2] + v[j][3]); }
                mean = wave_sum(s) * (1.f / D); q = 0.f;
#pragma unroll
                for (int j = 0; j < 4; ++j) { v[j] = v[j] - mean; q += (v[j][0] * v[j][0] + v[j][1] * v[j][1]) + (v[j][2] * v[j][2] + v[j][3] * v[j][3]); }
                rstd = rsqrtf(wave_sum(q) * (1.f / D) + 1e-5f);
#pragma unroll
                for (int j = 0; j < 4; ++j) { const f32x4 o = v[j] * rstd * sc[j] + sh[j]; u32x2 w; w.x = cvt_pk_bf16(o[0], o[1]); w.y = cvt_pk_bf16(o[2], o[3]);
                    *(u32x2*)(HB + (size_t)t * D + 4 * ln + 256 * j) = w; } } }
    }
    SEAM(6);
    if (IN(7)) {
        pg8::Gemm g{HB, D, WUP, T, UPW, D}; pg8::StaticOrder S; S.init(T, UPW, G, bx); pg8::EpiUp E5{ACT, E, fcw, fcb};
        pg8::gemm_phase<pg8::EpiUp, true>(lds, g, S, E5);
    }
    SEAM(7);
    if (IN(8)) {
        OPAQUE_LANE(ln);
        constexpr int NITEM = 512 * 2 * (DFF / 4);
        for (int it = (gw * 64 + ln); it < NITEM; it += NGW * 64) { const int c4 = it % (DFF / 4), rb = it / (DFF / 4), rr = rb & 1, blk = rb >> 1; const int c0 = 4 * c4;
            const bool first = (blk & 31) == 0;
            const float* e0 = E + ((size_t)blk * 4 + rr) * UPW + c0;
            const float* em1 = (rr == 0) ? E + ((size_t)(blk - 1) * 4 + 3) * UPW + c0 : E + ((size_t)blk * 4 + 0) * UPW + c0;
            const float* em2 = (rr == 0) ? E + ((size_t)(blk - 1) * 4 + 2) * UPW + c0 : E + ((size_t)(blk - 1) * 4 + 3) * UPW + c0;
            const f32x4 z = {0.f, 0.f, 0.f, 0.f};
            const f32x4 g0 = *(const f32x4*)e0, v0 = *(const f32x4*)(e0 + DFF);
            const bool has1 = !(first && rr == 0), has2 = !first;
            const f32x4 g1 = has1 ? *(const f32x4*)em1 : z, v1 = has1 ? *(const f32x4*)(em1 + DFF) : z;
            const f32x4 g2 = has2 ? *(const f32x4*)em2 : z, v2 = has2 ? *(const f32x4*)(em2 + DFF) : z;
            const f32x4 wg0 = *(const f32x4*)(fcw + c0), wg1 = *(const f32x4*)(fcw + UPW + c0), wg2 = *(const f32x4*)(fcw + 2 * UPW + c0), bg = *(const f32x4*)(fcb + c0);
            const f32x4 wv0 = *(const f32x4*)(fcw + DFF + c0), wv1 = *(const f32x4*)(fcw + UPW + DFF + c0), wv2 = *(const f32x4*)(fcw + 2 * UPW + DFF + c0), bv = *(const f32x4*)(fcb + DFF + c0);
            const f32x4 cg = bg + wg0 * g2 + wg1 * g1 + wg2 * g0, cv = bv + wv0 * v2 + wv1 * v1 + wv2 * v0;
            u32x2 w; w.x = cvt_pk_bf16(silu_f(cg[0]) * cv[0], silu_f(cg[1]) * cv[1]); w.y = cvt_pk_bf16(silu_f(cg[2]) * cv[2], silu_f(cg[3]) * cv[3]);
            *(u32x2*)(ACT + (size_t)(64 * blk + rr) * DFF + c0) = w; }
    }
    SEAM(8);
    if (IN(9)) {
        pg8::Gemm g{ACT, DFF, WDN, T, D, DFF}; pg8::StaticOrder S; S.init(T, D, G, bx); pg8::EpiStore E6{FF, D};
        pg8::gemm_phase<pg8::EpiStore, true>(lds, g, S, E6);
    }
    SEAM(9);
    if (IN(10)) {
        OPAQUE_LANE(ln);
        for (int row0 = gw * 16; row0 < T; row0 += NGW * 16) { const int b = row0 / SEQ; const float* mb = MOD + b * 6144;
            f32x4 gt[4], g2v[4], b2v[4];
#pragma unroll
            for (int j = 0; j < 4; ++j) { const int col = 4 * ln + 256 * j; gt[j] = *(const f32x4*)(mb + 5120 + col); g2v[j] = *(const f32x4*)(ln2g + col); b2v[j] = *(const f32x4*)(ln2b + col); }
            for (int rr = 0; rr < 16; ++rr) { const int t = row0 + rr;
                f32x4 v[4]; float s = 0.f;
#pragma unroll
                for (int j = 0; j < 4; ++j) { const int col = 4 * ln + 256 * j; const f32x4 xv = *(const f32x4*)(out + (size_t)t * D + col); const u32x2 mw = *(const u32x2*)(FF + (size_t)t * D + col);
                    const f32x4 mx = {bf_lo(mw.x), bf_hi(mw.x), bf_lo(mw.y), bf_hi(mw.y)};
                    v[j] = xv * ALPHA + gt[j] * mx; s += (v[j][0] + v[j][1]) + (v[j][2] + v[j][3]); }
                const float mean = wave_sum(s) * (1.f / D); float q = 0.f;
#pragma unroll
                for (int j = 0; j < 4; ++j) { v[j] = v[j] - mean; q += (v[j][0] * v[j][0] + v[j][1] * v[j][1]) + (v[j][2] * v[j][2] + v[j][3] * v[j][3]); }
                const float rstd = rsqrtf(wave_sum(q) * (1.f / D) + 1e-5f);
#pragma unroll
                for (int j = 0; j < 4; ++j) { *(f32x4*)(out + (size_t)t * D + 4 * ln + 256 * j) = v[j] * rstd * g2v[j] + b2v[j]; } } }
    }
#undef IN
#undef SEAM
}

extern "C" void kernel_launch(void* const* d_in, const int* in_sizes, int n_in, void* d_out, int out_size, void* d_ws, size_t ws_size, hipStream_t stream) {
    static int grid = 0;
    if (grid == 0) {
        if (n_in != 22 || in_sizes[0] != T * D || out_size != T * D || ws_size < WS_END) { fprintf(stderr, "kernel_launch: unexpected shapes / workspace (n_in %d, ws %zu)\n", n_in, ws_size); grid = -1; return; }
        int dev = 0, cus = 0, per_cu = 0;
        if (hipGetDevice(&dev) != hipSuccess || hipDeviceGetAttribute(&cus, hipDeviceAttributeMultiprocessorCount, dev) != hipSuccess) { grid = -1; return; }
        if (hipFuncSetAttribute((const void*)mk_fwd, hipFuncAttributeMaxDynamicSharedMemorySize, LDS_BYTES) != hipSuccess) { fprintf(stderr, "kernel_launch: hipFuncSetAttribute failed\n"); grid = -1; return; }
        if (hipOccupancyMaxActiveBlocksPerMultiprocessor(&per_cu, (const void*)mk_fwd, 512, LDS_BYTES) != hipSuccess || per_cu < 1) { fprintf(stderr, "kernel_launch: occupancy query says %d blocks per CU\n", per_cu); (void)hipGetLastError(); grid = -1; return; }
        grid = cus;
    }
    if (grid < 0) return;
    hipMemsetAsync((char*)d_ws + WS_CTL, 0, CTL_ZERO_BYTES, stream);
    Args a{};
    for (int i = 0; i < 22; ++i) a.in[i] = (const float*)d_in[i];
    a.pos = (const int*)d_in[2]; a.out = (float*)d_out; a.ws = (unsigned char*)d_ws;
#if MK_N_LAUNCHES == 1
    a.ph_lo = 0; a.ph_hi = N_PHASES;
    hipLaunchKernelGGL(mk_fwd, dim3(grid), dim3(512), LDS_BYTES, stream, a);
#else
    for (int p = 0; p < N_PHASES; ++p) { a.ph_lo = p; a.ph_hi = p + 1; hipLaunchKernelGGL(mk_fwd, dim3(grid), dim3(512), LDS_BYTES, stream, a); }
#endif
}
```

```cpp
#include <hip/hip_runtime.h>
#include <cstdio>
#include <cstdint>

#define LAS __attribute__((address_space(3)))
#define GAS __attribute__((address_space(1)))
typedef unsigned short bf16_t;
typedef short bf16x8 __attribute__((ext_vector_type(8)));
typedef short s16x4 __attribute__((ext_vector_type(4)));
typedef float f32x4 __attribute__((ext_vector_type(4)));
typedef float f32x2 __attribute__((ext_vector_type(2)));
typedef float f32x16 __attribute__((ext_vector_type(16)));
typedef unsigned u32x4 __attribute__((ext_vector_type(4)));
typedef unsigned u32x2 __attribute__((ext_vector_type(2)));
typedef GAS unsigned gu32;

#ifndef MK_N_LAUNCHES
#define MK_N_LAUNCHES 1
#endif

constexpr int D = 1024, NB = 16, SEQ = 2048, T = NB * SEQ, NH = 8, DFF = 2816, UPW = 2 * DFF;
constexpr int PW = 2048;
constexpr int QW = 768, INW = 1952;
constexpr float ALPHA = 1.189207115002721f;
constexpr float QSCALE = 0.10206207261596575f * 1.4426950408889634f;
constexpr float LOG2E = 1.4426950408889634f;

constexpr size_t MiB = 1u << 20;
constexpr size_t WS_CTL = 0, CTL_ZERO_BYTES = 64 * 1024;
constexpr size_t WS_MOD = 1 * MiB;
constexpr size_t WS_ROPE = 2 * MiB;
constexpr size_t WS_SSQQ = 6 * MiB;
constexpr size_t WS_SSQKV = 6 * MiB + 512 * 1024;
constexpr size_t WS_WIN = 8 * MiB;
constexpr size_t WS_WQ = 12 * MiB;
constexpr size_t WS_WKV = 12 * MiB + 512 * 1024;
constexpr size_t WS_WOUT = 13 * MiB;
constexpr size_t WS_WUP = 15 * MiB;
constexpr size_t WS_WDN = 26 * MiB;
constexpr size_t WS_HB = 32 * MiB;
constexpr size_t WS_FF = 32 * MiB;
constexpr size_t WS_P = 96 * MiB;
constexpr size_t WS_MIX = 96 * MiB;
constexpr size_t WS_Q = 224 * MiB;
constexpr size_t WS_KN = 272 * MiB;
constexpr size_t WS_KR = 304 * MiB;
constexpr size_t WS_V = 306 * MiB;
constexpr size_t WS_Y = 338 * MiB;
constexpr size_t WS_X1 = 338 * MiB;
constexpr size_t WS_ACT = 96 * MiB;
constexpr size_t WS_E = 272 * MiB;
constexpr size_t WS_END = 402 * MiB;
constexpr int CW_BAR = 1024;

constexpr int RING_BYTES = 131072, LDSCTL_OFF = RING_BYTES, MISC_OFF = LDSCTL_OFF + 320, LDS_BYTES = 147456;

__device__ __forceinline__ unsigned cvt_pk_bf16(float lo, float hi) { unsigned r; asm volatile("v_cvt_pk_bf16_f32 %0, %1, %2" : "=v"(r) : "v"(lo), "v"(hi)); return r; }
__device__ __forceinline__ float bf_lo(unsigned u) { return __uint_as_float(u << 16); }
__device__ __forceinline__ float bf_hi(unsigned u) { return __uint_as_float(u & 0xffff0000u); }
__device__ __forceinline__ float fexp2(float x) { return __builtin_amdgcn_exp2f(x); }
__device__ __forceinline__ float frcp(float x) { return __builtin_amdgcn_rcpf(x); }
__device__ __forceinline__ float silu_f(float v) { return v * frcp(1.f + fexp2(-LOG2E * v)); }
__device__ __forceinline__ float wave_sum(float v) {
#pragma unroll
    for (int o = 1; o < 64; o <<= 1) v += __shfl_xor(v, o);
    return v;
}

namespace pg8 {
constexpr int BM = 256, BK = 64, HALF = 128, HTB = HALF * BK * 2, STAGE_BYTES = 8 * HTB, NXCD = 8, WGM = 8;
__host__ __device__ __forceinline__ int lds_byte(int r, int c) { const int st = (r >> 4) * 2 + (c >> 5), rr = r & 15, cc = c & 31, ob = rr * 64 + cc * 2; return st * 1024 + (ob ^ (((ob >> 9) & 1) << 5)); }
__host__ __device__ __forceinline__ void stage_rc(int b, int& R, int& C) { const int st = b / 1024, sb = b % 1024, swz = sb ^ (((sb >> 9) & 1) << 5); R = (st >> 1) * 16 + swz / 64; C = (st & 1) * 32 + (swz % 64) / 2; }
__host__ __device__ __forceinline__ int perm32(int rho) { const int n = rho >> 4, i = rho & 15; return 8 * (i >> 2) + 4 * n + (i & 3); }

struct Unit { int pm, pn; };
struct Gemm { const bf16_t* A; int lda; const bf16_t* Bt; int M, N, K; };

struct StaticOrder {
    int nM, nN, nwg, G, c;
    __device__ __forceinline__ void init(int M, int N, int G_, int c_) { nM = M / BM; nN = N / BM; nwg = nM * nN; G = G_; c = c_; }
    __device__ __forceinline__ bool next(int i, Unit& u) const {
        const long L = (long)i * G + c; if (L >= nwg) return false;
        int wgid = (int)L; { const int q = nwg / NXCD, r = nwg % NXCD, xcd = wgid % NXCD, off = wgid / NXCD; wgid = (xcd < r ? xcd * (q + 1) : r * (q + 1) + (xcd - r) * q) + off; }
        const int nig = WGM * nN, gid = wgid / nig, fm = gid * WGM, gsz = (nM - fm) < WGM ? (nM - fm) : WGM;
        u.pm = fm + ((wgid % nig) % gsz); u.pn = (wgid % nig) / gsz; return true;
    }
};

template <class Epi, bool ALIGN_EPI>
__device__ __forceinline__ void gemm_phase(LAS unsigned char* lds, const Gemm g, const StaticOrder& S, const Epi& E) {
    int tid = threadIdx.x; asm volatile("" : "+v"(tid));
    const int wid = __builtin_amdgcn_readfirstlane(tid >> 6), lane = tid & 63, wr = wid >> 2, wc = wid & 3, fr = lane & 15, fq = lane >> 4;
    const int K = g.K, nt = K / BK;
    unsigned voffA[2], voffB[2];
#pragma unroll
    for (int i = 0; i < 2; ++i) { int R, C; stage_rc(tid * 16 + i * 8192, R, C);
        voffA[i] = (unsigned)(R * g.lda + C) * 2u; voffB[i] = (unsigned)(R * K + C) * 2u; }
    const size_t kstep = (size_t)(BK * 2);
    const size_t hstepA = (size_t)HALF * g.lda * 2, hstepB = (size_t)HALF * K * 2;
    const size_t tstepA = 2 * hstepA, tstepB = 2 * hstepB;
    const unsigned ldsw = (unsigned)wid * 1024u;
    const int aoff = lds_byte(wr * 64 + fr, fq * 8), boff = lds_byte(wc * 32 + fr, fq * 8);
#define PG8_SA(b, h) (((b) * 2 + (h)) * HTB)
#define PG8_SB(b, h) ((4 + (b) * 2 + (h)) * HTB)
#define PG8_STAGE(bufoff, gbase, voff) do { _Pragma("unroll") for (int _i = 0; _i < 2; ++_i) \
        __builtin_amdgcn_global_load_lds((const unsigned*)((const char*)(gbase) + (voff)[_i]), (LAS unsigned*)(lds + (bufoff) + ldsw + _i * 8192), 16, 0, 0); } while (0)
#define PG8_LDA(dst, b, h) do { _Pragma("unroll") for (int m = 0; m < 4; ++m) _Pragma("unroll") for (int k = 0; k < 2; ++k) dst[m][k] = *(const LAS bf16x8*)(lds + PG8_SA(b, h) + aoff + m * 2048 + k * 1024); } while (0)
#define PG8_LDB(dst, b, h) do { _Pragma("unroll") for (int n = 0; n < 2; ++n) _Pragma("unroll") for (int k = 0; k < 2; ++k) dst[n][k] = *(const LAS bf16x8*)(lds + PG8_SB(b, h) + boff + n * 2048 + k * 1024); } while (0)
#define PG8_MMA(ai, bj, At, Bt) do { __builtin_amdgcn_s_setprio(1); _Pragma("unroll") for (int m = 0; m < 4; ++m) _Pragma("unroll") for (int n = 0; n < 2; ++n) _Pragma("unroll") for (int k = 0; k < 2; ++k) \
        acc[ai][bj][m][n] = __builtin_amdgcn_mfma_f32_16x16x32_bf16(Bt[n][k], At[m][k], acc[ai][bj][m][n], 0, 0, 0); __builtin_amdgcn_s_setprio(0); } while (0)
#define PG8_WAIT_V(n) asm volatile("s_waitcnt vmcnt(" #n ")" ::: "memory")
#define PG8_WAIT_L(n) asm volatile("s_waitcnt lgkmcnt(" #n ")" ::: "memory")
#define PG8_BAR __builtin_amdgcn_s_barrier()
#define PG8_SCHED __builtin_amdgcn_sched_barrier(0)
    Unit cur, nxt; int ui = 0;
    if (!S.next(0, cur)) return;
    f32x4 acc[2][2][4][2];
#pragma unroll
    for (int a = 0; a < 2; ++a)
#pragma unroll
        for (int b = 0; b < 2; ++b)
#pragma unroll
            for (int m = 0; m < 4; ++m)
#pragma unroll
                for (int n = 0; n < 2; ++n) acc[a][b][m][n] = (f32x4){0.f, 0.f, 0.f, 0.f};
    bf16x8 At[4][2], B0[2][2], B1[2][2];
    const char* cA = (const char*)g.A + (size_t)cur.pm * tstepA; const char* cB = (const char*)g.Bt + (size_t)cur.pn * tstepB;
    if constexpr (Epi::HAS_PREFETCH) E.prefetch(cur, 0, lds, wid, lane);
    PG8_STAGE(PG8_SB(0, 0), cB, voffB); PG8_STAGE(PG8_SB(0, 1), cB + hstepB, voffB); PG8_STAGE(PG8_SA(0, 0), cA, voffA); PG8_STAGE(PG8_SA(0, 1), cA + hstepA, voffA);
    if (wr == 1) PG8_BAR;
    PG8_WAIT_V(2); PG8_BAR;
    PG8_STAGE(PG8_SB(1, 0), cB + kstep, voffB); PG8_STAGE(PG8_SA(1, 0), cA + kstep, voffA); PG8_STAGE(PG8_SB(1, 1), cB + hstepB + kstep, voffB);
    PG8_WAIT_V(6); PG8_BAR;
    for (;;) {
        const bool has_next = S.next(ui + 1, nxt);
        const char* nA = has_next ? (const char*)g.A + (size_t)nxt.pm * tstepA : cA; const char* nB = has_next ? (const char*)g.Bt + (size_t)nxt.pn * tstepB : cB;
#pragma nounroll
        for (int t = 0; t < nt; t += 2) {
            const bool last = (t == nt - 2);
            const char* a1 = cA + (size_t)(t + 1) * kstep;
            const char* a2 = last ? nA : cA + (size_t)(t + 2) * kstep; const char* b2 = last ? nB : cB + (size_t)(t + 2) * kstep;
            const char* a3 = a2 + kstep; const char* b3 = b2 + kstep;
            PG8_LDB(B0, 0, 0); PG8_LDB(B1, 0, 1); PG8_SCHED; PG8_LDA(At, 0, 0); PG8_STAGE(PG8_SA(1, 1), a1 + hstepA, voffA);
            PG8_WAIT_V(8); PG8_WAIT_L(0); PG8_BAR; PG8_MMA(0, 0, At, B0); PG8_MMA(0, 1, At, B1); PG8_BAR; PG8_SCHED;
            PG8_LDA(At, 0, 1); PG8_STAGE(PG8_SB(0, 0), b2, voffB); PG8_STAGE(PG8_SB(0, 1), b2 + hstepB, voffB); PG8_STAGE(PG8_SA(0, 0), a2, voffA);
            PG8_WAIT_V(8); PG8_WAIT_L(0); PG8_BAR; PG8_MMA(1, 0, At, B0); PG8_MMA(1, 1, At, B1); PG8_BAR; PG8_SCHED;
            PG8_LDB(B0, 1, 0); PG8_LDB(B1, 1, 1); PG8_SCHED; PG8_LDA(At, 1, 0); PG8_STAGE(PG8_SA(0, 1), a2 + hstepA, voffA);
            PG8_WAIT_V(8); PG8_WAIT_L(0); PG8_BAR; PG8_MMA(0, 0, At, B0); PG8_MMA(0, 1, At, B1); PG8_BAR; PG8_SCHED;
            PG8_LDA(At, 1, 1); PG8_STAGE(PG8_SB(1, 0), b3, voffB); PG8_STAGE(PG8_SB(1, 1), b3 + hstepB, voffB); PG8_STAGE(PG8_SA(1, 0), a3, voffA);
            PG8_WAIT_V(8); PG8_WAIT_L(0); PG8_BAR; PG8_MMA(1, 0, At, B0); PG8_MMA(1, 1, At, B1); PG8_BAR; PG8_SCHED;
        }
        if constexpr (ALIGN_EPI) { if (wr == 0) PG8_BAR; }
        { int t_e = threadIdx.x; asm volatile("" : "+v"(t_e)); const int fr_e = t_e & 15, fq_e = (t_e >> 4) & 3;
          if constexpr (Epi::HAS_PREFETCH) { if (has_next) E.prefetch(nxt, (ui + 1) & 1, lds, wid, t_e & 63); E.run(acc, cur, wr, wc, fr_e, fq_e, lds, ui & 1); }
          else E(acc, cur, wr, wc, fr_e, fq_e); }
        if (!has_next) break;
#pragma unroll
        for (int a = 0; a < 2; ++a)
#pragma unroll
            for (int b = 0; b < 2; ++b)
#pragma unroll
                for (int m = 0; m < 4; ++m)
#pragma unroll
                    for (int n = 0; n < 2; ++n) acc[a][b][m][n] = (f32x4){0.f, 0.f, 0.f, 0.f};
        cur = nxt; cA = nA; cB = nB; ++ui;
        if constexpr (ALIGN_EPI) { if (wr == 1) PG8_BAR; }
    }
    PG8_WAIT_V(0);
    if constexpr (!ALIGN_EPI) { if (wr == 0) PG8_BAR; }
    PG8_BAR;
#undef PG8_SA
#undef PG8_SB
#undef PG8_STAGE
#undef PG8_LDA
#undef PG8_LDB
#undef PG8_MMA
#undef PG8_WAIT_V
#undef PG8_WAIT_L
#undef PG8_BAR
#undef PG8_SCHED
}

typedef f32x4 Acc[2][2][4][2];

struct EpiStore { static constexpr bool HAS_PREFETCH = false;
    bf16_t* O; int ldc;
    __device__ __forceinline__ void operator()(const Acc& acc, const Unit& u, int wr, int wc, int fr, int fq) const {
        const int row0 = u.pm * BM + wr * 64 + fr, col0 = u.pn * BM + wc * 32 + 8 * fq;
#pragma unroll
        for (int ai = 0; ai < 2; ++ai)
#pragma unroll
            for (int m = 0; m < 4; ++m) { bf16_t* rowp = O + (size_t)(row0 + ai * HALF + m * 16) * ldc + col0;
#pragma unroll
                for (int bj = 0; bj < 2; ++bj) { const f32x4 v0 = acc[ai][bj][m][0], v1 = acc[ai][bj][m][1];
                    u32x4 w; w.x = cvt_pk_bf16(v0[0], v0[1]); w.y = cvt_pk_bf16(v0[2], v0[3]); w.z = cvt_pk_bf16(v1[0], v1[1]); w.w = cvt_pk_bf16(v1[2], v1[3]);
                    *(u32x4*)(rowp + bj * HALF) = w; } }
    }
};

struct EpiP { static constexpr bool HAS_PREFETCH = false;
    bf16_t* O; float* ssq_q; float* ssq_kv;
    __device__ __forceinline__ void operator()(const Acc& acc, const Unit& u, int wr, int wc, int fr, int fq) const {
        EpiStore st{O, PW}; st(acc, u, wr, wc, fr, fq);
        if (u.pn <= 1) {
            const int row0 = u.pm * BM + wr * 64 + fr; float* dst = (u.pn == 0) ? ssq_q : ssq_kv;
#pragma unroll
            for (int ai = 0; ai < 2; ++ai)
#pragma unroll
                for (int m = 0; m < 4; ++m) { float s = 0.f;
#pragma unroll
                    for (int n = 0; n < 2; ++n) { const f32x4 a = acc[ai][0][m][n]; s += (a[0] * a[0] + a[1] * a[1]) + (a[2] * a[2] + a[3] * a[3]); }
                    if (u.pn == 0) {
#pragma unroll
                        for (int n = 0; n < 2; ++n) { const f32x4 a = acc[ai][1][m][n]; s += (a[0] * a[0] + a[1] * a[1]) + (a[2] * a[2] + a[3] * a[3]); } }
                    s += __shfl_xor(s, 16); s += __shfl_xor(s, 32);
                    if (fq == 0) dst[(size_t)(row0 + ai * HALF + m * 16) * 4 + wc] = s; }
        }
    }
};

struct EpiQ { static constexpr bool HAS_PREFETCH = false;
    bf16_t* Q; const float* ssq; const float* rope;
    __device__ __forceinline__ void operator()(const Acc& acc, const Unit& u, int wr, int wc, int fr, int fq) const {
        const int row0 = u.pm * BM + wr * 64 + fr;
#pragma unroll
        for (int bj = 0; bj < 2; ++bj) { const int g = 8 * u.pn + 4 * bj + wc; const bool is_rope = (g % 3) == 2;
            bf16_t* qcol = Q + 32 * g;
            if (!is_rope) {
#pragma unroll
                for (int ai = 0; ai < 2; ++ai)
#pragma unroll
                    for (int m = 0; m < 4; ++m) { const int t = row0 + ai * HALF + m * 16;
                        const f32x4 sp = *(const f32x4*)(ssq + (size_t)t * 4);
                        const float f = rsqrtf(((sp[0] + sp[1]) + (sp[2] + sp[3])) * (1.f / 256.f) + 1e-6f) * QSCALE;
                        const f32x4 v0 = acc[ai][bj][m][0] * f, v1 = acc[ai][bj][m][1] * f;
                        u32x4 w; w.x = cvt_pk_bf16(v0[0], v0[1]); w.y = cvt_pk_bf16(v0[2], v0[3]); w.z = cvt_pk_bf16(v1[0], v1[1]); w.w = cvt_pk_bf16(v1[2], v1[3]);
                        *(u32x4*)(qcol + (size_t)t * QW + 8 * fq) = w;
                        if (m & 1) asm volatile("" ::: "memory"); }
            } else {
#pragma unroll
                for (int ai = 0; ai < 2; ++ai)
#pragma unroll
                    for (int m = 0; m < 4; ++m) { const int t = row0 + ai * HALF + m * 16;
                        const f32x4 sp = *(const f32x4*)(ssq + (size_t)t * 4);
                        const float f = rsqrtf(((sp[0] + sp[1]) + (sp[2] + sp[3])) * (1.f / 256.f) + 1e-6f) * QSCALE;
                        const f32x4 cs = *(const f32x4*)(rope + (size_t)t * 32 + 4 * fq), sn = *(const f32x4*)(rope + (size_t)t * 32 + 16 + 4 * fq);
                        const f32x4 a0 = acc[ai][bj][m][0], a1 = acc[ai][bj][m][1];
                        const f32x4 o1 = (a0 * cs - a1 * sn) * f, o2 = (a1 * cs + a0 * sn) * f;
                        u32x2 w1, w2; w1.x = cvt_pk_bf16(o1[0], o1[1]); w1.y = cvt_pk_bf16(o1[2], o1[3]); w2.x = cvt_pk_bf16(o2[0], o2[1]); w2.y = cvt_pk_bf16(o2[2], o2[3]);
                        *(u32x2*)(qcol + (size_t)t * QW + 4 * fq) = w1; *(u32x2*)(qcol + (size_t)t * QW + 16 + 4 * fq) = w2;
                        if (m & 1) asm volatile("" ::: "memory"); }
            } }
    }
};

struct EpiKV { static constexpr bool HAS_PREFETCH = false;
    bf16_t* KN; bf16_t* V; const float* ssq;
    __device__ __forceinline__ void operator()(const Acc& acc, const Unit& u, int wr, int wc, int fr, int fq) const {
        const int row0 = u.pm * BM + wr * 64 + fr; const int b = u.pm >> 3;
#pragma unroll
        for (int bj = 0; bj < 2; ++bj) { const int g = 8 * u.pn + 4 * bj + wc, head = g >> 2, part = g & 3;
            char* base = (part < 2) ? (char*)KN + (4 * part + fq) * 1024 + fr * 16 : (char*)V + (part - 2) * 4096 + fr * 64 + fq * 16;
            const int mstep = (part < 2) ? 256 : 1024;
            base += (size_t)(b * 8 + head) * 32 * 8192;
#pragma unroll
            for (int ai = 0; ai < 2; ++ai) { const int tile = (4 * u.pm + 2 * ai + wr) & 31;
#pragma unroll
                for (int m = 0; m < 4; ++m) { const int t = row0 + ai * HALF + m * 16;
                    const f32x4 sp = *(const f32x4*)(ssq + (size_t)t * 4);
                    const float f = rsqrtf(((sp[0] + sp[1]) + (sp[2] + sp[3])) * (1.f / 128.f) + 1e-6f);
                    const f32x4 v0 = acc[ai][bj][m][0] * f, v1 = acc[ai][bj][m][1] * f;
                    u32x4 w; w.x = cvt_pk_bf16(v0[0], v0[1]); w.y = cvt_pk_bf16(v0[2], v0[3]); w.z = cvt_pk_bf16(v1[0], v1[1]); w.w = cvt_pk_bf16(v1[2], v1[3]);
                    *(u32x4*)(base + (size_t)tile * 8192 + m * mstep) = w;
                    if (m & 1) asm volatile("" ::: "memory"); } } }
    }
};

template <int CTRL> __device__ __forceinline__ float dppf(float v) { return __builtin_bit_cast(float, __builtin_amdgcn_update_dpp(0, __builtin_bit_cast(int, v), CTRL, 0xf, 0xf, true)); }
template <int CTRL> __device__ __forceinline__ f32x4 dpp4(f32x4 v) { f32x4 r; r[0] = dppf<CTRL>(v[0]); r[1] = dppf<CTRL>(v[1]); r[2] = dppf<CTRL>(v[2]); r[3] = dppf<CTRL>(v[3]); return r; }

constexpr int CW_LDS = RING_BYTES + 1024;
struct EpiUp { static constexpr bool HAS_PREFETCH = true;
    bf16_t* ACT; float* E; const float* cw; const float* cb;
    __device__ __forceinline__ void prefetch(const Unit& u, int buf, LAS unsigned char* lds, int wid, int lane) const {
        if (wid < 4) { const float* base = (wid < 3) ? cw + (size_t)wid * UPW : cb;
            const float* src = base + 128 * u.pn + ((lane & 32) ? DFF : 0) + 4 * (lane & 31);
            __builtin_amdgcn_global_load_lds((const unsigned*)src, (LAS unsigned*)(lds + CW_LDS + buf * 4096 + wid * 1024), 16, 0, 0); }
    }
    __device__ __forceinline__ void run(const Acc& acc, const Unit& u, int wr, int wc, int fr, int fq, LAS unsigned char* lds, int buf) const {
        const int cl = 32 * wc + 8 * fq;
        const int cbase = 128 * u.pn + cl;
        const LAS float* wl = (const LAS float*)(lds + CW_LDS + buf * 4096) + cl;
        u32x2 res0[2][4];
#pragma unroll
        for (int n = 0; n < 2; ++n) { const int c0 = cbase + 4 * n;
            const f32x4 wg0 = *(const LAS f32x4*)(wl + 4 * n), wg1 = *(const LAS f32x4*)(wl + 256 + 4 * n), wg2 = *(const LAS f32x4*)(wl + 512 + 4 * n), bg = *(const LAS f32x4*)(wl + 768 + 4 * n);
            const f32x4 wv0 = *(const LAS f32x4*)(wl + 128 + 4 * n), wv1 = *(const LAS f32x4*)(wl + 384 + 4 * n), wv2 = *(const LAS f32x4*)(wl + 640 + 4 * n), bv = *(const LAS f32x4*)(wl + 896 + 4 * n);
#pragma unroll
            for (int ai = 0; ai < 2; ++ai) { f32x4 pg1 = {0.f, 0.f, 0.f, 0.f}, pg2 = pg1, pv1 = pg1, pv2 = pg1;
                const int blk = 4 * u.pm + 2 * ai + wr;
#pragma unroll
                for (int m = 0; m < 4; ++m) { const f32x4 gcur = acc[ai][0][m][n], vcur = acc[ai][1][m][n];
                    const f32x4 rg1 = dpp4<0x121>(gcur), rg2 = dpp4<0x122>(gcur), rv1 = dpp4<0x121>(vcur), rv2 = dpp4<0x122>(vcur);
                    const f32x4 g1 = (fr >= 1) ? rg1 : pg1, g2 = (fr >= 2) ? rg2 : pg2, v1 = (fr >= 1) ? rv1 : pv1, v2 = (fr >= 2) ? rv2 : pv2;
                    const f32x4 cg = bg + wg0 * g2 + wg1 * g1 + wg2 * gcur, cv = bv + wv0 * v2 + wv1 * v1 + wv2 * vcur;
                    f32x4 a; a[0] = silu_f(cg[0]) * cv[0]; a[1] = silu_f(cg[1]) * cv[1]; a[2] = silu_f(cg[2]) * cv[2]; a[3] = silu_f(cg[3]) * cv[3];
                    u32x2 w; w.x = cvt_pk_bf16(a[0], a[1]); w.y = cvt_pk_bf16(a[2], a[3]);
                    const int t = u.pm * BM + ai * HALF + wr * 64 + m * 16 + fr;
                    if (n == 0) res0[ai][m] = w;
                    else if (!(m == 0 && fr < 2)) { u32x4 o; o.x = res0[ai][m].x; o.y = res0[ai][m].y; o.z = w.x; o.w = w.y; *(u32x4*)(ACT + (size_t)t * DFF + cbase) = o; }
                    if (m == 0 && fr < 2) { float* e = E + ((size_t)blk * 4 + fr) * UPW + c0; *(f32x4*)e = gcur; *(f32x4*)(e + DFF) = vcur; }
                    if (m == 3 && fr >= 14) { float* e = E + ((size_t)blk * 4 + 2 + (fr - 14)) * UPW + c0; *(f32x4*)e = gcur; *(f32x4*)(e + DFF) = vcur; }
                    pg1 = rg1; pg2 = rg2; pv1 = rv1; pv2 = rv2; } } }
    }
};
}

namespace att {
constexpr int NSLOT = 3, K_OFF = 0, KSLOT = 12288, V_OFF = NSLOT * KSLOT, VSLOT = 8192, WS_OFF = V_OFF + NSLOT * VSLOT, OST_OFF = WS_OFF + 8 * 256, LDS_END = OST_OFF + 8 * 8192;
static_assert(LDS_END <= RING_BYTES, "attention LDS");
__device__ __forceinline__ int crow(int r, int hi) { return (r & 3) + 8 * (r >> 2) + 4 * hi; }
typedef short v4i16_t __attribute__((ext_vector_type(4)));
__device__ __forceinline__ s16x4 vtr(const LAS unsigned char* p) { return __builtin_bit_cast(s16x4, __builtin_amdgcn_ds_read_tr16_b64_v4i16((LAS v4i16_t*)p)); }
__device__ __forceinline__ void glds(const char* src, LAS unsigned char* dst) { unsigned keep; const unsigned d = (unsigned)__builtin_amdgcn_readfirstlane((int)(unsigned)(uintptr_t)dst);
    asm volatile("s_mov_b32 %0, m0\n\ts_mov_b32 m0, %2\n\ts_nop 0\n\tglobal_load_lds_dwordx4 %1, off\n\ts_mov_b32 m0, %0" : "=&s"(keep) : "v"(src), "s"(d) : "memory"); }
__device__ __forceinline__ float max3f(float a, float b, float c) { float r; asm("v_max3_f32 %0, %1, %2, %3" : "=v"(r) : "v"(a), "v"(b), "v"(c)); return r; }
__device__ __forceinline__ float max2f(float a, float b) { float r; asm("v_max_f32_e32 %0, %1, %2" : "=v"(r) : "v"(a), "v"(b)); return r; }
__device__ __forceinline__ float fadd_s(float a, float b) { float r; asm("v_add_f32_e32 %0, %1, %2" : "=v"(r) : "v"(a), "v"(b)); return r; }
constexpr float THRL = 4.0f;

struct AUnit { int b, h, qb; };
__device__ __forceinline__ bool unit_of(int k, int vcu, int G, AUnit& u) {
    const int it = vcu + (k >> 2) * G, r = k & 3; if (it >= 256) return false;
    const int grp = it >> 3, i8 = it & 7, bh = grp * 4 + r; u.b = bh >> 3; u.h = bh & 7;
    u.qb = (r == 0) ? 7 - i8 : (r == 1) ? i8 : (r == 2) ? 7 - (i8 ^ 1) : (i8 ^ 1); return true;
}
__device__ __forceinline__ void attn_phase(int vcu, int G, const bf16_t* Q, const bf16_t* KN, const bf16_t* KR, const bf16_t* V, bf16_t* Y, const float* ong, LAS unsigned char* lds) {
    int tid = threadIdx.x; asm volatile("" : "+v"(tid));
    const int lane = tid & 63, r32 = lane & 31, hi = lane >> 5; const int wid = __builtin_amdgcn_readfirstlane(tid >> 6);
    const int lo16 = wid * 1024 + lane * 16;
    LAS float* wsf = (LAS float*)(lds + WS_OFF + wid * 256);
    const int kl = hi * 1024 + r32 * 16, vl = ((lane >> 4) & 1) * 32 + (lane & 3) * 8 + (4 * hi + ((lane & 15) >> 2)) * 64;
#define ATT_ISSUE(U, tile, slot) do { const size_t bh_ = (size_t)((U).b * 8 + (U).h); \
        glds((const char*)KN + (bh_ * 32 + (tile)) * 8192 + lo16, lds + K_OFF + (slot) * KSLOT + wid * 1024); glds((const char*)V + (bh_ * 32 + (tile)) * 8192 + lo16, lds + V_OFF + (slot) * VSLOT + wid * 1024); \
        if (wid < 4) glds((const char*)KR + ((size_t)(U).b * 32 + (tile)) * 4096 + lo16, lds + K_OFF + (slot) * KSLOT + 8192 + wid * 1024); } while (0)
#define ATT_QLOAD(dst, U) do { const bf16_t* qp_ = Q + (size_t)((U).b * SEQ + 256 * (U).qb + 32 * wid + r32) * QW + 96 * (U).h + 8 * hi; \
        _Pragma("unroll") for (int ks = 0; ks < 6; ++ks) dst[ks] = *(const bf16x8*)(qp_ + 16 * ks); } while (0)
    AUnit cur, nxt;
    if (!unit_of(0, vcu, G, cur)) return;
    bf16x8 qr[6], qn[6];
    ATT_QLOAD(qr, cur);
    asm volatile("" : "+v"(qr[0]), "+v"(qr[1]), "+v"(qr[2]), "+v"(qr[3]), "+v"(qr[4]), "+v"(qr[5]));
    ATT_ISSUE(cur, 0, 0); ATT_ISSUE(cur, 1, 1);
    int slot = 0;
    for (int k = 0;; ++k) {
        const bool has_next = unit_of(k + 1, vcu, G, nxt);
        const int NT = 4 * cur.qb + 4, jmax = 4 * cur.qb + (wid >> 1);
        float mrun = 0.f, lrun = 0.f; f32x16 o[2]; o[0] = f32x16{}; o[1] = f32x16{}; f32x16 negm = f32x16{};
        for (int j = 0; j < NT; ++j) {
            if (j == 0 && k > 0) { if (wid < 4) asm volatile("s_waitcnt vmcnt(13) lgkmcnt(0)\n\ts_barrier" ::: "memory"); else asm volatile("s_waitcnt vmcnt(12) lgkmcnt(0)\n\ts_barrier" ::: "memory"); }
            else if (j + 1 < NT || has_next) { if (wid < 4) asm volatile("s_waitcnt vmcnt(3) lgkmcnt(0)\n\ts_barrier" ::: "memory"); else asm volatile("s_waitcnt vmcnt(2) lgkmcnt(0)\n\ts_barrier" ::: "memory"); }
            else asm volatile("s_waitcnt vmcnt(0) lgkmcnt(0)\n\ts_barrier" ::: "memory");
            { const int s2 = (slot == 0) ? 2 : slot - 1;
              if (j + 2 < NT) ATT_ISSUE(cur, j + 2, s2); else if (has_next) ATT_ISSUE(nxt, j + 2 - NT, s2); }
            if (j == NT - 1 && has_next) ATT_QLOAD(qn, nxt);
            if (j <= jmax) {
                const LAS unsigned char* kp = lds + K_OFF + slot * KSLOT + kl;
                f32x16 p0, p1;
#pragma unroll
                for (int ks = 0; ks < 6; ++ks) { const bf16x8 k0 = *(const LAS bf16x8*)(kp + ks * 2048), k1 = *(const LAS bf16x8*)(kp + ks * 2048 + 512);
                    if (ks == 0) { p0 = __builtin_amdgcn_mfma_f32_32x32x16_bf16(k0, qr[0], negm, 0, 0, 0); p1 = __builtin_amdgcn_mfma_f32_32x32x16_bf16(k1, qr[0], negm, 0, 0, 0); }
                    else { p0 = __builtin_amdgcn_mfma_f32_32x32x16_bf16(k0, qr[ks], p0, 0, 0, 0); p1 = __builtin_amdgcn_mfma_f32_32x32x16_bf16(k1, qr[ks], p1, 0, 0, 0); } }
                float rm;
                { float a = max3f(p0[0], p0[1], p1[0]), c = max3f(p0[2], p0[3], p1[1]); a = max3f(a, p1[2], p1[3]);
#pragma unroll
                  for (int r = 4; r < 16; r += 4) { a = max3f(a, p0[r], p0[r + 1]); c = max3f(c, p0[r + 2], p0[r + 3]); a = max3f(a, p1[r], p1[r + 1]); c = max3f(c, p1[r + 2], p1[r + 3]); }
                  rm = max2f(a, c); rm = max2f(rm, __shfl_xor(rm, 32)); }
                if (j == 0 || __any(rm > THRL)) {
                    const float dl = (j == 0) ? rm : fmaxf(rm, 0.f);
                    mrun += dl;
#pragma unroll
                    for (int r = 0; r < 16; ++r) { p0[r] -= dl; p1[r] -= dl; }
#pragma unroll
                    for (int r = 0; r < 16; ++r) negm[r] = -mrun;
                    if (j != 0) { const float alpha = fexp2(-dl); lrun *= alpha;
                        if (hi == 0) wsf[r32] = alpha;
#pragma unroll
                        for (int r = 0; r < 16; ++r) { const float a_ = wsf[crow(r, hi)]; o[0][r] *= a_; o[1][r] *= a_; } }
                }
#pragma unroll
                for (int r = 0; r < 16; ++r) { p0[r] = fexp2(p0[r]); p1[r] = fexp2(p1[r]); }
                { float s0 = fadd_s(p0[0], p1[0]), s1 = fadd_s(p0[1], p1[1]);
#pragma unroll
                  for (int r = 2; r < 16; r += 2) { s0 = fadd_s(s0, p0[r]); s1 = fadd_s(s1, p0[r + 1]); s0 = fadd_s(s0, p1[r]); s1 = fadd_s(s1, p1[r + 1]); }
                  lrun = fadd_s(lrun, fadd_s(s0, s1)); }
                bf16x8 pa[4];
                { u32x4 w0, w1, w2, w3;
                  w0.x = cvt_pk_bf16(p0[0], p0[1]); w0.y = cvt_pk_bf16(p0[2], p0[3]); w0.z = cvt_pk_bf16(p0[4], p0[5]); w0.w = cvt_pk_bf16(p0[6], p0[7]);
                  w1.x = cvt_pk_bf16(p0[8], p0[9]); w1.y = cvt_pk_bf16(p0[10], p0[11]); w1.z = cvt_pk_bf16(p0[12], p0[13]); w1.w = cvt_pk_bf16(p0[14], p0[15]);
                  w2.x = cvt_pk_bf16(p1[0], p1[1]); w2.y = cvt_pk_bf16(p1[2], p1[3]); w2.z = cvt_pk_bf16(p1[4], p1[5]); w2.w = cvt_pk_bf16(p1[6], p1[7]);
                  w3.x = cvt_pk_bf16(p1[8], p1[9]); w3.y = cvt_pk_bf16(p1[10], p1[11]); w3.z = cvt_pk_bf16(p1[12], p1[13]); w3.w = cvt_pk_bf16(p1[14], p1[15]);
                  pa[0] = __builtin_bit_cast(bf16x8, w0); pa[1] = __builtin_bit_cast(bf16x8, w1); pa[2] = __builtin_bit_cast(bf16x8, w2); pa[3] = __builtin_bit_cast(bf16x8, w3); }
                const LAS unsigned char* vp = lds + V_OFF + slot * VSLOT + vl;
#pragma unroll
                for (int d0 = 0; d0 < 2; ++d0)
#pragma unroll
                    for (int ks = 0; ks < 4; ++ks) { const s16x4 lo = vtr(vp + d0 * 4096 + ks * 1024), hh = vtr(vp + d0 * 4096 + ks * 1024 + 512);
                        const bf16x8 vf = {lo[0], lo[1], lo[2], lo[3], hh[0], hh[1], hh[2], hh[3]};
                        o[d0] = __builtin_amdgcn_mfma_f32_32x32x16_bf16(pa[ks], vf, o[d0], 0, 0, 0); }
            }
            slot = (slot == 2) ? 0 : slot + 1;
        }
        { const float lt = lrun + __shfl_xor(lrun, 32);
          if (hi == 0) wsf[r32] = frcp(lt);
          LAS float* stg = (LAS float*)(lds + OST_OFF + wid * 8192);
#pragma unroll
          for (int r = 0; r < 16; ++r) { const float inv = wsf[crow(r, hi)]; const int orow = crow(r, hi); stg[orow * 64 + r32] = o[0][r] * inv; stg[orow * 64 + 32 + r32] = o[1][r] * inv; }
          const int ch = lane & 7;
          const f32x4 ga = *(const f32x4*)(ong + 64 * cur.h + 8 * ch), gb = *(const f32x4*)(ong + 64 * cur.h + 8 * ch + 4);
          bf16_t* Yw = Y + (size_t)(cur.b * SEQ + 256 * cur.qb + 32 * wid) * D + 64 * cur.h + 8 * ch;
#pragma unroll
          for (int i = 0; i < 4; ++i) { const int row = i * 8 + (lane >> 3);
              const f32x4 va = *(const LAS f32x4*)(stg + row * 64 + 8 * ch), vb = *(const LAS f32x4*)(stg + row * 64 + 8 * ch + 4);
              float ss = (va[0] * va[0] + va[1] * va[1]) + (va[2] * va[2] + va[3] * va[3]) + (vb[0] * vb[0] + vb[1] * vb[1]) + (vb[2] * vb[2] + vb[3] * vb[3]);
              ss += pg8::dppf<0xB1>(ss); ss += pg8::dppf<0x4E>(ss); ss += pg8::dppf<0x141>(ss);
              const float rs = rsqrtf(ss * (1.f / 64.f) + 1e-6f);
              const f32x4 oa = va * rs * ga, ob = vb * rs * gb;
              u32x4 w; w.x = cvt_pk_bf16(oa[0], oa[1]); w.y = cvt_pk_bf16(oa[2], oa[3]); w.z = cvt_pk_bf16(ob[0], ob[1]); w.w = cvt_pk_bf16(ob[2], ob[3]);
              *(u32x4*)(Yw + (size_t)row * D) = w; } }
        if (!has_next) break;
        cur = nxt;
#pragma unroll
        for (int ks = 0; ks < 6; ++ks) qr[ks] = qn[ks];
    }
    asm volatile("s_waitcnt vmcnt(0) lgkmcnt(0)\n\ts_barrier" ::: "memory");
#undef ATT_ISSUE
#undef ATT_QLOAD
}
}

#define XB_TMO      128
#define XB_XCNT(j)  (256  + 64 * (j))
#define XB_XSUB(j)  (1280 + 64 * (j))
#define XB_XGEN(j)  (2304 + 64 * (j))
#define XB_TOP      3328
#define XB_TOPGEN   3392
#define XCD_BAR_WORDS 3456
#define XB_SPIN_CAP (1u << 18)
__device__ __forceinline__ unsigned xb_ld(unsigned* p)              { return __hip_atomic_load(p, __ATOMIC_RELAXED, __HIP_MEMORY_SCOPE_AGENT); }
__device__ __forceinline__ unsigned xb_add(unsigned* p, unsigned v) { return __hip_atomic_fetch_add(p, v, __ATOMIC_RELAXED, __HIP_MEMORY_SCOPE_AGENT); }
__device__ __forceinline__ unsigned xb_xcc_id() { return (unsigned)__builtin_amdgcn_s_getreg((3 << 11) | 20) & 0xFu; }
#define XB_SPIN(cond, bar) do { unsigned _sp = 0; while (cond) { __builtin_amdgcn_s_sleep(1); \
    if ((++_sp & 255u) == 0u) { if (xb_ld(&(bar)[XB_TMO])) break; if (_sp > XB_SPIN_CAP) { atomicAdd(&(bar)[XB_TMO], 1u); break; } } } } while (0)
struct XcdBarrier { unsigned* bar; unsigned x; volatile LAS unsigned* st; };
__device__ __forceinline__ XcdBarrier xcd_barrier_post(unsigned* bar, volatile LAS unsigned* st) {
    XcdBarrier b; b.bar = bar; b.x = xb_xcc_id(); b.st = st;
    if (threadIdx.x == 0) (void)xb_add(&bar[XB_XCNT(b.x)], 1u);
    return b;
}
__device__ __forceinline__ void xcd_barrier_complete(unsigned* bar, unsigned x, unsigned& nloc, unsigned& nx) {
    const unsigned G = gridDim.x * gridDim.y * gridDim.z;
    unsigned sum, cnt, mine, sp = 0u;
    for (;;) {
        sum = 0u; cnt = 0u; mine = 0u;
#pragma unroll
        for (unsigned j = 0; j < 16; ++j) { const unsigned c = xb_ld(&bar[XB_XCNT(j)]); sum += c; cnt += (c > 0u) ? 1u : 0u; mine = (j == x) ? c : mine; }
        if (sum == G) break;
        __builtin_amdgcn_s_sleep(1);
        if ((++sp & 255u) == 0u) { if (xb_ld(&bar[XB_TMO])) break; if (sp > XB_SPIN_CAP) { atomicAdd(&bar[XB_TMO], 1u); break; } }
    }
    nloc = mine > 0u ? mine : 1u; nx = cnt > 0u ? cnt : 1u;
}
__device__ __forceinline__ void xcd_barrier(const XcdBarrier& b) {
    asm volatile("s_waitcnt vmcnt(0)" ::: "memory");
    __syncthreads();
    if (threadIdx.x == 0) {
        unsigned* bar = b.bar;
        __builtin_amdgcn_s_waitcnt(0);
        unsigned nloc = b.st[0], nx = b.st[1];
        if (nloc == 0u) { xcd_barrier_complete(bar, b.x, nloc, nx); b.st[0] = nloc; b.st[1] = nx; }
        const unsigned old = xb_add(&bar[XB_XSUB(b.x)], 1u);
        const unsigned gen = old / nloc;
        if (old + 1u == (gen + 1u) * nloc) {
            __builtin_amdgcn_fence(__ATOMIC_RELEASE, "agent");
            asm volatile("s_waitcnt vmcnt(0)" ::: "memory");
            const unsigned og = xb_add(&bar[XB_TOP], 1u);
            const unsigned tg = og / nx;
            if (og + 1u == (tg + 1u) * nx) xb_add(&bar[XB_TOPGEN], 1u);
            else XB_SPIN(xb_ld(&bar[XB_TOPGEN]) == tg, bar);
            __builtin_amdgcn_fence(__ATOMIC_ACQUIRE, "agent");
            xb_add(&bar[XB_XGEN(b.x)], 1u);
            asm volatile("s_waitcnt vmcnt(0)" ::: "memory");
        } else {
            XB_SPIN(xb_ld(&bar[XB_XGEN(b.x)]) == gen, bar);
            __builtin_amdgcn_fence(__ATOMIC_ACQUIRE, "agent");
            asm volatile("s_waitcnt vmcnt(0)" ::: "memory");
        }
    }
    __syncthreads();
}

struct Args { const float* in[22]; const int* pos; float* out; unsigned char* ws; int ph_lo, ph_hi; };
__constant__ float c_invfreq[16] = {1.0f, 0.5623413251903491f, 0.31622776601683794f, 0.1778279410038923f, 0.1f, 0.05623413251903491f, 0.03162277660168379f, 0.01778279410038923f,
                                    0.01f, 0.005623413251903491f, 0.0031622776601683794f, 0.001778279410038923f, 0.001f, 0.0005623413251903491f, 0.00031622776601683794f, 0.0001778279410038923f};

__device__ __forceinline__ int colmap(int which, int s) {
    const int p = (s & ~31) + pg8::perm32(s & 31);
    switch (which) {
        case 0: return p < 416 ? p : (p < 512 ? -1 : p - 96);
        case 1: return ((s >> 5) % 3 == 2) ? s : p;
        case 4: { const int pn = s >> 8, bj = (s >> 7) & 1, wc = (s >> 5) & 3; return bj * DFF + 128 * pn + 32 * wc + pg8::perm32(s & 31); }
        default: return p;
    }
}
__device__ __forceinline__ void p0_transpose_item(const float* W, int ldw, int Ksrc, const float* kscale, bf16_t* WT, int Kdst, int which, LAS float* scr, int item, int nblk, int lane) {
    const int kb = item / nblk, nb = item % nblk, k0 = 64 * kb, s0 = 32 * nb;
    const int cm = colmap(which, s0 + (lane & 31));
    float tv[32];
#pragma unroll
    for (int i = 0; i < 32; ++i) { const int k = k0 + 2 * i + (lane >> 5); tv[i] = (cm >= 0 && k < Ksrc) ? W[(size_t)k * ldw + cm] : 0.f; }
    if (kscale) {
#pragma unroll
        for (int i = 0; i < 32; ++i) { const int k = k0 + 2 * i + (lane >> 5); if (k < Ksrc) tv[i] *= kscale[k]; } }
#pragma unroll
    for (int i = 0; i < 32; ++i) scr[(2 * i + (lane >> 5)) * 33 + (lane & 31)] = tv[i];
    asm volatile("s_waitcnt lgkmcnt(0)" ::: "memory");
    const int c = lane & 7;
#pragma unroll
    for (int j = 0; j < 4; ++j) { const int n = (lane >> 3) + 8 * j; const LAS float* s = scr + (8 * c) * 33 + n;
        u32x4 o; o.x = cvt_pk_bf16(s[0 * 33], s[1 * 33]); o.y = cvt_pk_bf16(s[2 * 33], s[3 * 33]); o.z = cvt_pk_bf16(s[4 * 33], s[5 * 33]); o.w = cvt_pk_bf16(s[6 * 33], s[7 * 33]);
        *(u32x4*)(WT + (size_t)(s0 + n) * Kdst + k0 + 8 * c) = o; }
    asm volatile("s_waitcnt lgkmcnt(0)" ::: "memory");
}

constexpr int N_PHASES = 11;
#define OPAQUE_LANE(name) int name##_t = (int)threadIdx.x; asm volatile("" : "+v"(name##_t)); const int name = name##_t & 63

__global__ void __launch_bounds__(512, 2) mk_fwd(Args args) {
    extern __shared__ __attribute__((aligned(16))) unsigned char lds_raw[];
    LAS unsigned char* lds = (LAS unsigned char*)lds_raw;
    volatile LAS unsigned* MISC = (volatile LAS unsigned*)(lds + MISC_OFF);
    const int tid = threadIdx.x, lane = tid & 63, wave = __builtin_amdgcn_readfirstlane(tid >> 6);
    const int G = gridDim.x; const int bx = blockIdx.x; const int vcu = (G % 8 == 0) ? (bx % 8) * (G / 8) + bx / 8 : bx;
    const int gw = vcu * 8 + wave, NGW = G * 8;
    unsigned char* ws = args.ws;
    const float* x = args.in[0]; const float* cvec = args.in[1]; const int* pos = args.pos;
    const float* w_ada = args.in[3]; const float* b_ada = args.in[4]; const float* w_in = args.in[5];
    const float* qg = args.in[6]; const float* w_qup = args.in[7]; const float* kvg = args.in[8]; const float* w_kvup = args.in[9];
    const float* conv_w = args.in[10]; const float* conv_b = args.in[11]; const float* ong = args.in[12]; const float* w_out = args.in[13];
    const float* ln1g = args.in[14]; const float* ln1b = args.in[15]; const float* w_up = args.in[16];
    const float* fcw = args.in[17]; const float* fcb = args.in[18]; const float* w_down = args.in[19];
    const float* ln2g = args.in[20]; const float* ln2b = args.in[21];
    float* out = args.out;
    float* MOD = (float*)(ws + WS_MOD); float* ROPE = (float*)(ws + WS_ROPE); float* SSQQ = (float*)(ws + WS_SSQQ); float* SSQKV = (float*)(ws + WS_SSQKV);
    bf16_t* WIN = (bf16_t*)(ws + WS_WIN); bf16_t* WQ = (bf16_t*)(ws + WS_WQ); bf16_t* WKV = (bf16_t*)(ws + WS_WKV); bf16_t* WOUT = (bf16_t*)(ws + WS_WOUT);
    bf16_t* WUP = (bf16_t*)(ws + WS_WUP); bf16_t* WDN = (bf16_t*)(ws + WS_WDN);
    bf16_t* HB = (bf16_t*)(ws + WS_HB); bf16_t* FF = (bf16_t*)(ws + WS_FF); bf16_t* P = (bf16_t*)(ws + WS_P); bf16_t* MIX = (bf16_t*)(ws + WS_MIX);
    bf16_t* Qb = (bf16_t*)(ws + WS_Q); bf16_t* KN = (bf16_t*)(ws + WS_KN); bf16_t* KR = (bf16_t*)(ws + WS_KR); bf16_t* Vb = (bf16_t*)(ws + WS_V);
    bf16_t* Y = (bf16_t*)(ws + WS_Y); bf16_t* X1 = (bf16_t*)(ws + WS_X1); bf16_t* ACT = (bf16_t*)(ws + WS_ACT); float* E = (float*)(ws + WS_E);

    for (int u = tid; u < (LDS_BYTES - LDSCTL_OFF) / 4; u += 512) ((LAS unsigned*)(lds + LDSCTL_OFF))[u] = 0u;
    __syncthreads();
    XcdBarrier bar; bar.bar = (unsigned*)(ws + WS_CTL) + CW_BAR; bar.x = 0; bar.st = nullptr;
    if (MK_N_LAUNCHES == 1) bar = xcd_barrier_post((unsigned*)(ws + WS_CTL) + CW_BAR, MISC + 8);
    const int lo = args.ph_lo, hi = args.ph_hi;
#ifndef PH_MASK
#define PH_MASK 0x7ff
#endif
#define IN(k) (((PH_MASK >> (k)) & 1) && lo <= (k) && (k) < hi)
#define SEAM(k) do { if (IN(k) && IN((k) + 1)) xcd_barrier(bar); } while (0)

    if (IN(0)) {
        OPAQUE_LANE(ln);
        if (bx < 192) {
            LAS float* cact = (LAS float*)lds; LAS float* part = (LAS float*)(lds + 65536);
            const int n0 = 32 * bx, c4 = tid & 7, kr = tid >> 3;
            f32x4 wv[16];
#pragma unroll
            for (int i = 0; i < 16; ++i) wv[i] = *(const f32x4*)(w_ada + (size_t)(kr + 64 * i) * 6144 + n0 + 4 * c4);
            for (int i = tid; i < 16 * 1024; i += 512) { const float v = cvec[i]; cact[i] = v * frcp(1.f + fexp2(-LOG2E * v)); }
            __syncthreads();
            f32x4 a[16];
#pragma unroll
            for (int b = 0; b < 16; ++b) a[b] = (f32x4){0.f, 0.f, 0.f, 0.f};
#pragma unroll
            for (int i = 0; i < 16; ++i) { const int k = kr + 64 * i;
#pragma unroll
                for (int b = 0; b < 16; ++b) a[b] += wv[i] * cact[b * 1024 + k];
                if ((i & 1) == 1) asm volatile("" ::: "memory"); }
#pragma unroll
            for (int b = 0; b < 16; ++b)
#pragma unroll
                for (int e = 0; e < 4; ++e) { float v = a[b][e]; v += __shfl_xor(v, 8); v += __shfl_xor(v, 16); v += __shfl_xor(v, 32); a[b][e] = v; }
            if (ln < 8) {
#pragma unroll
                for (int b = 0; b < 16; ++b) *(LAS f32x4*)(part + (wave * 16 + b) * 32 + 4 * c4) = a[b]; }
            __syncthreads();
            { const int b = tid >> 5, col = tid & 31; float s = 0.f;
#pragma unroll
              for (int w8 = 0; w8 < 8; ++w8) s += part[(w8 * 16 + b) * 32 + col];
              MOD[b * 6144 + n0 + col] = s + b_ada[n0 + col]; }
            __syncthreads();
        }
        for (int idx = gw * 64 + ln; idx < T * 16; idx += NGW * 64) { const int t = idx >> 4, i = idx & 15; const float ang = (float)pos[t] * c_invfreq[i];
            ROPE[(size_t)t * 32 + i] = cosf(ang); ROPE[(size_t)t * 32 + 16 + i] = sinf(ang); }
        LAS float* scr = (LAS float*)(lds + wave * 16384);
        constexpr int I0 = 16 * 64, I1 = 4 * 24, I2 = 4 * 32, I3 = 16 * 32, I4 = 16 * 176, I5 = 44 * 32, NIT = I0 + I1 + I2 + I3 + I4 + I5;
        for (int it = gw; it < NIT; it += NGW) {
            int r = it;
            if (r < I0) { p0_transpose_item(w_in, INW, D, nullptr, WIN, D, 0, scr, r, 64, ln); continue; } r -= I0;
            if (r < I1) { p0_transpose_item(w_qup, QW, 256, qg, WQ, 256, 1, scr, r, 24, ln); continue; } r -= I1;
            if (r < I2) { p0_transpose_item(w_kvup, 1024, 128, kvg, WKV, 256, 2, scr, r, 32, ln); continue; } r -= I2;
            if (r < I3) { p0_transpose_item(w_out, D, D, nullptr, WOUT, D, 3, scr, r, 32, ln); continue; } r -= I3;
            if (r < I4) { p0_transpose_item(w_up, UPW, D, nullptr, WUP, D, 4, scr, r, 176, ln); continue; } r -= I4;
            p0_transpose_item(w_down, D, DFF, nullptr, WDN, DFF, 5, scr, r, 32, ln);
        }
    }
    SEAM(0);
    if (IN(1)) {
        OPAQUE_LANE(ln);
        for (int row0 = gw * 16; row0 < T; row0 += NGW * 16) { const int b = row0 / SEQ; const float* mb = MOD + b * 6144;
            f32x4 sc[4], sh[4];
#pragma unroll
            for (int j = 0; j < 4; ++j) { const int col = 4 * ln + 256 * j; sh[j] = *(const f32x4*)(mb + col); sc[j] = *(const f32x4*)(mb + 1024 + col) + 1.f; }
            for (int rr = 0; rr < 16; ++rr) { const int t = row0 + rr; const float* xr = x + (size_t)t * D;
                f32x4 v[4]; float s = 0.f;
#pragma unroll
                for (int j = 0; j < 4; ++j) { v[j] = *(const f32x4*)(xr + 4 * ln + 256 * j); s += (v[j][0] + v[j][1]) + (v[j][2] + v[j][3]); }
                const float mean = wave_sum(s) * (1.f / D); float q = 0.f;
#pragma unroll
                for (int j = 0; j < 4; ++j) { v[j] = v[j] - mean; q += (v[j][0] * v[j][0] + v[j][1] * v[j][1]) + (v[j][2] * v[j][2] + v[j][3] * v[j][3]); }
                const float rstd = rsqrtf(wave_sum(q) * (1.f / D) + 1e-5f);
#pragma unroll
                for (int j = 0; j < 4; ++j) { const f32x4 o = v[j] * rstd * sc[j] + sh[j]; u32x2 w; w.x = cvt_pk_bf16(o[0], o[1]); w.y = cvt_pk_bf16(o[2], o[3]);
                    *(u32x2*)(HB + (size_t)t * D + 4 * ln + 256 * j) = w; } } }
    }
    SEAM(1);
    if (IN(2)) {
        pg8::Gemm g{HB, D, WIN, T, PW, D}; pg8::StaticOrder S; S.init(T, PW, G, bx);
        pg8::EpiP E1{P, SSQQ, SSQKV};
        pg8::gemm_phase<pg8::EpiP, true>(lds, g, S, E1);
    }
    SEAM(2);
    if (IN(3)) {
        OPAQUE_LANE(ln);
#ifndef P3_MASK
#define P3_MASK 15
#endif
        if (P3_MASK & 1) { pg8::Gemm g{P, PW, WQ, T, QW, 256}; pg8::StaticOrder S; S.init(T, QW, G, bx); pg8::EpiQ E2{Qb, SSQQ, ROPE}; pg8::gemm_phase<pg8::EpiQ, true>(lds, g, S, E2); }
        if (P3_MASK & 2) { pg8::Gemm g{P + 256, PW, WKV, T, 1024, 256}; pg8::StaticOrder S; S.init(T, 1024, G, bx); pg8::EpiKV E3{KN, Vb, SSQKV}; pg8::gemm_phase<pg8::EpiKV, true>(lds, g, S, E3); }
        if (P3_MASK & 4) for (int row0 = gw * 16; row0 < T; row0 += NGW * 16) {
            const int c0 = 8 * ln;
            float w0[8], w1[8], w2[8], cb8[8], gn[8];
#pragma unroll
            for (int e = 0; e < 8; ++e) { w0[e] = conv_w[c0 + e]; w1[e] = conv_w[512 + c0 + e]; w2[e] = conv_w[1024 + c0 + e]; cb8[e] = conv_b[c0 + e]; gn[e] = ong[512 + c0 + e]; }
            float um2[8], um1[8];
#pragma unroll
            for (int e = 0; e < 8; ++e) { um2[e] = 0.f; um1[e] = 0.f; }
            if ((row0 % SEQ) != 0) {
                const u32x4 a2 = *(const u32x4*)(P + (size_t)(row0 - 2) * PW + 1024 + c0), b2 = *(const u32x4*)(P + (size_t)(row0 - 2) * PW + 1536 + c0);
                const u32x4 a1 = *(const u32x4*)(P + (size_t)(row0 - 1) * PW + 1024 + c0), b1 = *(const u32x4*)(P + (size_t)(row0 - 1) * PW + 1536 + c0);
#pragma unroll
                for (int e = 0; e < 4; ++e) { um2[2 * e] = bf_lo(a2[e]) * bf_lo(b2[e]); um2[2 * e + 1] = bf_hi(a2[e]) * bf_hi(b2[e]); um1[2 * e] = bf_lo(a1[e]) * bf_lo(b1[e]); um1[2 * e + 1] = bf_hi(a1[e]) * bf_hi(b1[e]); }
            }
            for (int rr = 0; rr < 16; ++rr) { const int t = row0 + rr; const bf16_t* pr = P + (size_t)t * PW;
                const u32x4 gb = *(const u32x4*)(pr + 512 + c0), gc = *(const u32x4*)(pr + 1024 + c0), cv = *(const u32x4*)(pr + 1536 + c0);
                float u0[8], yv[8]; float ss = 0.f;
#pragma unroll
                for (int e = 0; e < 4; ++e) { u0[2 * e] = bf_lo(gc[e]) * bf_lo(cv[e]); u0[2 * e + 1] = bf_hi(gc[e]) * bf_hi(cv[e]); }
#pragma unroll
                for (int e = 0; e < 8; ++e) { const float gbe = (e & 1) ? bf_hi(gb[e >> 1]) : bf_lo(gb[e >> 1]);
                    yv[e] = gbe * (cb8[e] + w0[e] * um2[e] + w1[e] * um1[e] + w2[e] * u0[e]); ss += yv[e] * yv[e]; um2[e] = um1[e]; um1[e] = u0[e]; }
                ss += __shfl_xor(ss, 1); ss += __shfl_xor(ss, 2); ss += __shfl_xor(ss, 4);
                const float rs = rsqrtf(ss * (1.f / 64.f) + 1e-6f);
                u32x4 o; o.x = cvt_pk_bf16(yv[0] * rs * gn[0], yv[1] * rs * gn[1]); o.y = cvt_pk_bf16(yv[2] * rs * gn[2], yv[3] * rs * gn[3]);
                o.z = cvt_pk_bf16(yv[4] * rs * gn[4], yv[5] * rs * gn[5]); o.w = cvt_pk_bf16(yv[6] * rs * gn[6], yv[7] * rs * gn[7]);
                *(u32x4*)(Y + (size_t)t * D + 512 + c0) = o; }
        }
        if (P3_MASK & 8) for (int tl = gw; tl < NB * 32; tl += NGW) { const int t = tl * 64 + ln; const bf16_t* pr = P + (size_t)t * PW + 384;
            u32x4 raw[4];
#pragma unroll
            for (int e = 0; e < 4; ++e) raw[e] = *(const u32x4*)(pr + 8 * e);
            float xv[32];
#pragma unroll
            for (int e = 0; e < 16; ++e) { xv[2 * e] = bf_lo(raw[e >> 2][e & 3]); xv[2 * e + 1] = bf_hi(raw[e >> 2][e & 3]); }
            float cs[16], sn[16];
#pragma unroll
            for (int e = 0; e < 4; ++e) { const f32x4 c4 = *(const f32x4*)(ROPE + (size_t)t * 32 + 4 * e), s4 = *(const f32x4*)(ROPE + (size_t)t * 32 + 16 + 4 * e);
                cs[4 * e] = c4[0]; cs[4 * e + 1] = c4[1]; cs[4 * e + 2] = c4[2]; cs[4 * e + 3] = c4[3]; sn[4 * e] = s4[0]; sn[4 * e + 1] = s4[1]; sn[4 * e + 2] = s4[2]; sn[4 * e + 3] = s4[3]; }
            float ov[32];
#pragma unroll
            for (int i = 0; i < 16; ++i) { ov[i] = xv[i] * cs[i] - xv[16 + i] * sn[i]; ov[16 + i] = xv[16 + i] * cs[i] + xv[i] * sn[i]; }
            char* dst = (char*)KR + (size_t)tl * 4096 + ln * 16;
#pragma unroll
            for (int c = 0; c < 4; ++c) { u32x4 o; o.x = cvt_pk_bf16(ov[8 * c], ov[8 * c + 1]); o.y = cvt_pk_bf16(ov[8 * c + 2], ov[8 * c + 3]); o.z = cvt_pk_bf16(ov[8 * c + 4], ov[8 * c + 5]); o.w = cvt_pk_bf16(ov[8 * c + 6], ov[8 * c + 7]);
                *(u32x4*)(dst + c * 1024) = o; } }
    }
    SEAM(3);
    if (IN(4)) {
        att::attn_phase(vcu, G, Qb, KN, KR, Vb, Y, ong, lds);
    }
    SEAM(4);
    if (IN(5)) {
        pg8::Gemm g{Y, D, WOUT, T, D, D}; pg8::StaticOrder S; S.init(T, D, G, bx); pg8::EpiStore E4{MIX, D};
        pg8::gemm_phase<pg8::EpiStore, true>(lds, g, S, E4);
    }
    SEAM(5);
    if (IN(6)) {
        OPAQUE_LANE(ln);
        for (int row0 = gw * 16; row0 < T; row0 += NGW * 16) { const int b = row0 / SEQ; const float* mb = MOD + b * 6144;
            f32x4 gt[4], g1v[4], b1v[4], sc[4], sh[4];
#pragma unroll
            for (int j = 0; j < 4; ++j) { const int col = 4 * ln + 256 * j; gt[j] = *(const f32x4*)(mb + 2048 + col); g1v[j] = *(const f32x4*)(ln1g + col); b1v[j] = *(const f32x4*)(ln1b + col);
                sh[j] = *(const f32x4*)(mb + 3072 + col); sc[j] = *(const f32x4*)(mb + 4096 + col) + 1.f; }
            for (int rr = 0; rr < 16; ++rr) { const int t = row0 + rr;
                f32x4 v[4]; float s = 0.f;
#pragma unroll
                for (int j = 0; j < 4; ++j) { const int col = 4 * ln + 256 * j; const f32x4 xv = *(const f32x4*)(x + (size_t)t * D + col); const u32x2 mw = *(const u32x2*)(MIX + (size_t)t * D + col);
                    const f32x4 mx = {bf_lo(mw.x), bf_hi(mw.x), bf_lo(mw.y), bf_hi(mw.y)};
                    v[j] = xv * ALPHA + gt[j] * mx; s += (v[j][0] + v[j][1]) + (v[j][2] + v[j][3]); }
                float mean = wave_sum(s) * (1.f / D); float q = 0.f;
#pragma unroll
                for (int j = 0; j < 4; ++j) { v[j] = v[j] - mean; q += (v[j][0] * v[j][0] + v[j][1] * v[j][1]) + (v[j][2] * v[j][2] + v[j][3] * v[j][3]); }
                float rstd = rsqrtf(wave_sum(q) * (1.f / D) + 1e-5f);
                s = 0.f;
#pragma unroll
                for (int j = 0; j < 4; ++j) { v[j] = v[j] * rstd * g1v[j] + b1v[j]; u32x2 w; w.x = cvt_pk_bf16(v[j][0], v[j][1]); w.y = cvt_pk_bf16(v[j][2], v[j][3]); *(u32x2*)(X1 + (size_t)t * D + 4 * ln + 256 * j) = w; s += (v[j][0] + v[j][1]) + (v[j][2] + v[j][3]); }
                mean = wave_sum(s) * (1.f / D); q = 0.f;
#pragma unroll
                for (int j = 0; j < 4; ++j) { v[j] = v[j] - mean; q += (v[j][0] * v[j][0] + v[j][1] * v[j][1]) + (v[j][2] * v[j][2] + v[j][3] * v[j][3]); }
                rstd = rsqrtf(wave_sum(q) * (1.f / D) + 1e-5f);
#pragma unroll
                for (int j = 0; j < 4; ++j) { const f32x4 o = v[j] * rstd * sc[j] + sh[j]; u32x2 w; w.x = cvt_pk_bf16(o[0], o[1]); w.y = cvt_pk_bf16(o[2], o[3]);
                    *(u32x2*)(HB + (size_t)t * D + 4 * ln + 256 * j) = w; } } }
    }
    SEAM(6);
    if (IN(7)) {
        pg8::Gemm g{HB, D, WUP, T, UPW, D}; pg8::StaticOrder S; S.init(T, UPW, G, bx); pg8::EpiUp E5{ACT, E, fcw, fcb};
        pg8::gemm_phase<pg8::EpiUp, true>(lds, g, S, E5);
    }
    SEAM(7);
    if (IN(8)) {
        OPAQUE_LANE(ln);
        constexpr int NITEM = 512 * 2 * (DFF / 4);
        for (int it = (gw * 64 + ln); it < NITEM; it += NGW * 64) { const int c4 = it % (DFF / 4), rb = it / (DFF / 4), rr = rb & 1, blk = rb >> 1; const int c0 = 4 * c4;
            const bool first = (blk & 31) == 0;
            const float* e0 = E + ((size_t)blk * 4 + rr) * UPW + c0;
            const float* em1 = (rr == 0) ? E + ((size_t)(blk - 1) * 4 + 3) * UPW + c0 : E + ((size_t)blk * 4 + 0) * UPW + c0;
            const float* em2 = (rr == 0) ? E + ((size_t)(blk - 1) * 4 + 2) * UPW + c0 : E + ((size_t)(blk - 1) * 4 + 3) * UPW + c0;
            const f32x4 z = {0.f, 0.f, 0.f, 0.f};
            const f32x4 g0 = *(const f32x4*)e0, v0 = *(const f32x4*)(e0 + DFF);
            const bool has1 = !(first && rr == 0), has2 = !first;
            const f32x4 g1 = has1 ? *(const f32x4*)em1 : z, v1 = has1 ? *(const f32x4*)(em1 + DFF) : z;
            const f32x4 g2 = has2 ? *(const f32x4*)em2 : z, v2 = has2 ? *(const f32x4*)(em2 + DFF) : z;
            const f32x4 wg0 = *(const f32x4*)(fcw + c0), wg1 = *(const f32x4*)(fcw + UPW + c0), wg2 = *(const f32x4*)(fcw + 2 * UPW + c0), bg = *(const f32x4*)(fcb + c0);
            const f32x4 wv0 = *(const f32x4*)(fcw + DFF + c0), wv1 = *(const f32x4*)(fcw + UPW + DFF + c0), wv2 = *(const f32x4*)(fcw + 2 * UPW + DFF + c0), bv = *(const f32x4*)(fcb + DFF + c0);
            const f32x4 cg = bg + wg0 * g2 + wg1 * g1 + wg2 * g0, cv = bv + wv0 * v2 + wv1 * v1 + wv2 * v0;
            u32x2 w; w.x = cvt_pk_bf16(silu_f(cg[0]) * cv[0], silu_f(cg[1]) * cv[1]); w.y = cvt_pk_bf16(silu_f(cg[2]) * cv[2], silu_f(cg[3]) * cv[3]);
            *(u32x2*)(ACT + (size_t)(64 * blk + rr) * DFF + c0) = w; }
    }
    SEAM(8);
    if (IN(9)) {
        pg8::Gemm g{ACT, DFF, WDN, T, D, DFF}; pg8::StaticOrder S; S.init(T, D, G, bx); pg8::EpiStore E6{FF, D};
        pg8::gemm_phase<pg8::EpiStore, true>(lds, g, S, E6);
    }
    SEAM(9);
    if (IN(10)) {
        OPAQUE_LANE(ln);
        for (int row0 = gw * 16; row0 < T; row0 += NGW * 16) { const int b = row0 / SEQ; const float* mb = MOD + b * 6144;
            f32x4 gt[4], g2v[4], b2v[4];
#pragma unroll
            for (int j = 0; j < 4; ++j) { const int col = 4 * ln + 256 * j; gt[j] = *(const f32x4*)(mb + 5120 + col); g2v[j] = *(const f32x4*)(ln2g + col); b2v[j] = *(const f32x4*)(ln2b + col); }
            for (int rr = 0; rr < 16; ++rr) { const int t = row0 + rr;
                f32x4 v[4]; float s = 0.f;
#pragma unroll
                for (int j = 0; j < 4; ++j) { const int col = 4 * ln + 256 * j; const u32x2 xw = *(const u32x2*)(X1 + (size_t)t * D + col); const f32x4 xv = {bf_lo(xw.x), bf_hi(xw.x), bf_lo(xw.y), bf_hi(xw.y)}; const u32x2 mw = *(const u32x2*)(FF + (size_t)t * D + col);
                    const f32x4 mx = {bf_lo(mw.x), bf_hi(mw.x), bf_lo(mw.y), bf_hi(mw.y)};
                    v[j] = xv * ALPHA + gt[j] * mx; s += (v[j][0] + v[j][1]) + (v[j][2] + v[j][3]); }
                const float mean = wave_sum(s) * (1.f / D); float q = 0.f;
#pragma unroll
                for (int j = 0; j < 4; ++j) { v[j] = v[j] - mean; q += (v[j][0] * v[j][0] + v[j][1] * v[j][1]) + (v[j][2] * v[j][2] + v[j][3] * v[j][3]); }
                const float rstd = rsqrtf(wave_sum(q) * (1.f / D) + 1e-5f);
#pragma unroll
                for (int j = 0; j < 4; ++j) { *(f32x4*)(out + (size_t)t * D + 4 * ln + 256 * j) = v[j] * rstd * g2v[j] + b2v[j]; } } }
    }
#undef IN
#undef SEAM
}

extern "C" void kernel_launch(void* const* d_in, const int* in_sizes, int n_in, void* d_out, int out_size, void* d_ws, size_t ws_size, hipStream_t stream) {
    static int grid = 0;
    if (grid == 0) {
        if (n_in != 22 || in_sizes[0] != T * D || out_size != T * D || ws_size < WS_END) { fprintf(stderr, "kernel_launch: unexpected shapes / workspace (n_in %d, ws %zu)\n", n_in, ws_size); grid = -1; return; }
        int dev = 0, cus = 0, per_cu = 0;
        if (hipGetDevice(&dev) != hipSuccess || hipDeviceGetAttribute(&cus, hipDeviceAttributeMultiprocessorCount, dev) != hipSuccess) { grid = -1; return; }
        if (hipFuncSetAttribute((const void*)mk_fwd, hipFuncAttributeMaxDynamicSharedMemorySize, LDS_BYTES) != hipSuccess) { fprintf(stderr, "kernel_launch: hipFuncSetAttribute failed\n"); grid = -1; return; }
        if (hipOccupancyMaxActiveBlocksPerMultiprocessor(&per_cu, (const void*)mk_fwd, 512, LDS_BYTES) != hipSuccess || per_cu < 1) { fprintf(stderr, "kernel_launch: occupancy query says %d blocks per CU\n", per_cu); (void)hipGetLastError(); grid = -1; return; }
        grid = cus;
    }
    if (grid < 0) return;
    hipMemsetAsync((char*)d_ws + WS_CTL, 0, CTL_ZERO_BYTES, stream);
    Args a{};
    for (int i = 0; i < 22; ++i) a.in[i] = (const float*)d_in[i];
    a.pos = (const int*)d_in[2]; a.out = (float*)d_out; a.ws = (unsigned char*)d_ws;
#if MK_N_LAUNCHES == 1
    a.ph_lo = 0; a.ph_hi = N_PHASES;
    hipLaunchKernelGGL(mk_fwd, dim3(grid), dim3(512), LDS_BYTES, stream, a);
#else
    for (int p = 0; p < N_PHASES; ++p) { a.ph_lo = p; a.ph_hi = p + 1; hipLaunchKernelGGL(mk_fwd, dim3(grid), dim3(512), LDS_BYTES, stream, a); }
#endif
}
```

```cpp
#include <hip/hip_runtime.h>
#include <cstdio>
#include <cstdint>

#define LAS __attribute__((address_space(3)))
#define GAS __attribute__((address_space(1)))
typedef unsigned short bf16_t;
typedef short bf16x8 __attribute__((ext_vector_type(8)));
typedef short s16x4 __attribute__((ext_vector_type(4)));
typedef float f32x4 __attribute__((ext_vector_type(4)));
typedef float f32x2 __attribute__((ext_vector_type(2)));
typedef float f32x16 __attribute__((ext_vector_type(16)));
typedef unsigned u32x4 __attribute__((ext_vector_type(4)));
typedef unsigned u32x2 __attribute__((ext_vector_type(2)));
typedef GAS unsigned gu32;

#ifndef MK_N_LAUNCHES
#define MK_N_LAUNCHES 1
#endif

constexpr int D = 1024, NB = 16, SEQ = 2048, T = NB * SEQ, NH = 8, DFF = 2816, UPW = 2 * DFF;
constexpr int PW = 1024;
constexpr int G1N = 2048;
constexpr int QW = 768, INW = 1952;
constexpr float ALPHA = 1.189207115002721f;
constexpr float QSCALE = 0.10206207261596575f * 1.4426950408889634f;
constexpr float LOG2E = 1.4426950408889634f;

constexpr size_t MiB = 1u << 20;
constexpr size_t WS_CTL = 0, CTL_ZERO_BYTES = 64 * 1024;
constexpr size_t WS_MOD = 1 * MiB;
constexpr size_t WS_ROPE = 2 * MiB;
constexpr size_t WS_SSQQ = 6 * MiB;
constexpr size_t WS_SSQKV = 6 * MiB + 512 * 1024;
constexpr size_t WS_WIN = 8 * MiB;
constexpr size_t WS_WQ = 12 * MiB;
constexpr size_t WS_WKV = 12 * MiB + 512 * 1024;
constexpr size_t WS_WOUT = 13 * MiB;
constexpr size_t WS_WUP = 15 * MiB;
constexpr size_t WS_WDN = 26 * MiB;
constexpr size_t WS_HB = 32 * MiB;
constexpr size_t WS_FF = 32 * MiB;
constexpr size_t WS_P = 96 * MiB;
constexpr size_t WS_U = 160 * MiB;
constexpr size_t WS_MIX = 96 * MiB;
constexpr size_t WS_Q = 224 * MiB;
constexpr size_t WS_KN = 272 * MiB;
constexpr size_t WS_KR = 304 * MiB;
constexpr size_t WS_V = 306 * MiB;
constexpr size_t WS_Y = 338 * MiB;
constexpr size_t WS_X1 = 338 * MiB;
constexpr size_t WS_ACT = 96 * MiB;
constexpr size_t WS_E = 272 * MiB;
constexpr size_t WS_END = 402 * MiB;
constexpr int CW_BAR = 1024;

constexpr int RING_BYTES = 131072, LDSCTL_OFF = RING_BYTES, MISC_OFF = LDSCTL_OFF + 320, LDS_BYTES = 147456;

__device__ __forceinline__ unsigned cvt_pk_bf16(float lo, float hi) { unsigned r; asm volatile("v_cvt_pk_bf16_f32 %0, %1, %2" : "=v"(r) : "v"(lo), "v"(hi)); return r; }
__device__ __forceinline__ float bf_lo(unsigned u) { return __uint_as_float(u << 16); }
__device__ __forceinline__ float bf_hi(unsigned u) { return __uint_as_float(u & 0xffff0000u); }
__device__ __forceinline__ float fexp2(float x) { return __builtin_amdgcn_exp2f(x); }
__device__ __forceinline__ float frcp(float x) { return __builtin_amdgcn_rcpf(x); }
__device__ __forceinline__ float silu_f(float v) { return v * frcp(1.f + fexp2(-LOG2E * v)); }
__device__ __forceinline__ float wave_sum(float v) {
#pragma unroll
    for (int o = 1; o < 64; o <<= 1) v += __shfl_xor(v, o);
    return v;
}

namespace pg8 {
constexpr int BM = 256, BK = 64, HALF = 128, HTB = HALF * BK * 2, STAGE_BYTES = 8 * HTB, NXCD = 8, WGM = 8;
__host__ __device__ __forceinline__ int lds_byte(int r, int c) { const int st = (r >> 4) * 2 + (c >> 5), rr = r & 15, cc = c & 31, ob = rr * 64 + cc * 2; return st * 1024 + (ob ^ (((ob >> 9) & 1) << 5)); }
__host__ __device__ __forceinline__ void stage_rc(int b, int& R, int& C) { const int st = b / 1024, sb = b % 1024, swz = sb ^ (((sb >> 9) & 1) << 5); R = (st >> 1) * 16 + swz / 64; C = (st & 1) * 32 + (swz % 64) / 2; }
__host__ __device__ __forceinline__ int perm32(int rho) { const int n = rho >> 4, i = rho & 15; return 8 * (i >> 2) + 4 * n + (i & 3); }

struct Unit { int pm, pn; };
struct Gemm { const bf16_t* A; int lda; const bf16_t* Bt; int M, N, K; };

struct StaticOrder {
    int nM, nN, nwg, G, c;
    __device__ __forceinline__ void init(int M, int N, int G_, int c_) { nM = M / BM; nN = N / BM; nwg = nM * nN; G = G_; c = c_; }
    __device__ __forceinline__ bool next(int i, Unit& u) const {
        const long L = (long)i * G + c; if (L >= nwg) return false;
        int wgid = (int)L; { const int q = nwg / NXCD, r = nwg % NXCD, xcd = wgid % NXCD, off = wgid / NXCD; wgid = (xcd < r ? xcd * (q + 1) : r * (q + 1) + (xcd - r) * q) + off; }
        const int nig = WGM * nN, gid = wgid / nig, fm = gid * WGM, gsz = (nM - fm) < WGM ? (nM - fm) : WGM;
        u.pm = fm + ((wgid % nig) % gsz); u.pn = (wgid % nig) / gsz; return true;
    }
};

template <class Epi, bool ALIGN_EPI>
__device__ __forceinline__ void gemm_phase(LAS unsigned char* lds, const Gemm g, const StaticOrder& S, const Epi& E) {
    int tid = threadIdx.x; asm volatile("" : "+v"(tid));
    const int wid = __builtin_amdgcn_readfirstlane(tid >> 6), lane = tid & 63, wr = wid >> 2, wc = wid & 3, fr = lane & 15, fq = lane >> 4;
    const int K = g.K, nt = K / BK;
    unsigned voffA[2], voffB[2];
#pragma unroll
    for (int i = 0; i < 2; ++i) { int R, C; stage_rc(tid * 16 + i * 8192, R, C);
        voffA[i] = (unsigned)(R * g.lda + C) * 2u; voffB[i] = (unsigned)(R * K + C) * 2u; }
    const size_t kstep = (size_t)(BK * 2);
    const size_t hstepA = (size_t)HALF * g.lda * 2, hstepB = (size_t)HALF * K * 2;
    const size_t tstepA = 2 * hstepA, tstepB = 2 * hstepB;
    const unsigned ldsw = (unsigned)wid * 1024u;
    const int aoff = lds_byte(wr * 64 + fr, fq * 8), boff = lds_byte(wc * 32 + fr, fq * 8);
#define PG8_SA(b, h) (((b) * 2 + (h)) * HTB)
#define PG8_SB(b, h) ((4 + (b) * 2 + (h)) * HTB)
#define PG8_STAGE(bufoff, gbase, voff) do { _Pragma("unroll") for (int _i = 0; _i < 2; ++_i) \
        __builtin_amdgcn_global_load_lds((const unsigned*)((const char*)(gbase) + (voff)[_i]), (LAS unsigned*)(lds + (bufoff) + ldsw + _i * 8192), 16, 0, 0); } while (0)
#define PG8_LDA(dst, b, h) do { _Pragma("unroll") for (int m = 0; m < 4; ++m) _Pragma("unroll") for (int k = 0; k < 2; ++k) dst[m][k] = *(const LAS bf16x8*)(lds + PG8_SA(b, h) + aoff + m * 2048 + k * 1024); } while (0)
#define PG8_LDB(dst, b, h) do { _Pragma("unroll") for (int n = 0; n < 2; ++n) _Pragma("unroll") for (int k = 0; k < 2; ++k) dst[n][k] = *(const LAS bf16x8*)(lds + PG8_SB(b, h) + boff + n * 2048 + k * 1024); } while (0)
#define PG8_MMA(ai, bj, At, Bt) do { __builtin_amdgcn_s_setprio(1); _Pragma("unroll") for (int m = 0; m < 4; ++m) _Pragma("unroll") for (int n = 0; n < 2; ++n) _Pragma("unroll") for (int k = 0; k < 2; ++k) \
        acc[ai][bj][m][n] = __builtin_amdgcn_mfma_f32_16x16x32_bf16(Bt[n][k], At[m][k], acc[ai][bj][m][n], 0, 0, 0); __builtin_amdgcn_s_setprio(0); } while (0)
#define PG8_WAIT_V(n) asm volatile("s_waitcnt vmcnt(" #n ")" ::: "memory")
#define PG8_WAIT_L(n) asm volatile("s_waitcnt lgkmcnt(" #n ")" ::: "memory")
#define PG8_BAR __builtin_amdgcn_s_barrier()
#define PG8_SCHED __builtin_amdgcn_sched_barrier(0)
    Unit cur, nxt; int ui = 0;
    if (!S.next(0, cur)) return;
    f32x4 acc[2][2][4][2];
#pragma unroll
    for (int a = 0; a < 2; ++a)
#pragma unroll
        for (int b = 0; b < 2; ++b)
#pragma unroll
            for (int m = 0; m < 4; ++m)
#pragma unroll
                for (int n = 0; n < 2; ++n) acc[a][b][m][n] = (f32x4){0.f, 0.f, 0.f, 0.f};
    bf16x8 At[4][2], B0[2][2], B1[2][2];
    const char* cA = (const char*)g.A + (size_t)cur.pm * tstepA; const char* cB = (const char*)g.Bt + (size_t)cur.pn * tstepB;
    if constexpr (Epi::HAS_PREFETCH) E.prefetch(cur, 0, lds, wid, lane);
    PG8_STAGE(PG8_SB(0, 0), cB, voffB); PG8_STAGE(PG8_SB(0, 1), cB + hstepB, voffB); PG8_STAGE(PG8_SA(0, 0), cA, voffA); PG8_STAGE(PG8_SA(0, 1), cA + hstepA, voffA);
    if (wr == 1) PG8_BAR;
    PG8_WAIT_V(2); PG8_BAR;
    PG8_STAGE(PG8_SB(1, 0), cB + kstep, voffB); PG8_STAGE(PG8_SA(1, 0), cA + kstep, voffA); PG8_STAGE(PG8_SB(1, 1), cB + hstepB + kstep, voffB);
    PG8_WAIT_V(6); PG8_BAR;
    for (;;) {
        const bool has_next = S.next(ui + 1, nxt);
        const char* nA = has_next ? (const char*)g.A + (size_t)nxt.pm * tstepA : cA; const char* nB = has_next ? (const char*)g.Bt + (size_t)nxt.pn * tstepB : cB;
#pragma nounroll
        for (int t = 0; t < nt; t += 2) {
            const bool last = (t == nt - 2);
            const char* a1 = cA + (size_t)(t + 1) * kstep;
            const char* a2 = last ? nA : cA + (size_t)(t + 2) * kstep; const char* b2 = last ? nB : cB + (size_t)(t + 2) * kstep;
            const char* a3 = a2 + kstep; const char* b3 = b2 + kstep;
            PG8_LDB(B0, 0, 0); PG8_LDB(B1, 0, 1); PG8_SCHED; PG8_LDA(At, 0, 0); PG8_STAGE(PG8_SA(1, 1), a1 + hstepA, voffA);
            PG8_WAIT_V(8); PG8_WAIT_L(0); PG8_BAR; PG8_MMA(0, 0, At, B0); PG8_MMA(0, 1, At, B1); PG8_BAR; PG8_SCHED;
            PG8_LDA(At, 0, 1); PG8_STAGE(PG8_SB(0, 0), b2, voffB); PG8_STAGE(PG8_SB(0, 1), b2 + hstepB, voffB); PG8_STAGE(PG8_SA(0, 0), a2, voffA);
            PG8_WAIT_V(8); PG8_WAIT_L(0); PG8_BAR; PG8_MMA(1, 0, At, B0); PG8_MMA(1, 1, At, B1); PG8_BAR; PG8_SCHED;
            PG8_LDB(B0, 1, 0); PG8_LDB(B1, 1, 1); PG8_SCHED; PG8_LDA(At, 1, 0); PG8_STAGE(PG8_SA(0, 1), a2 + hstepA, voffA);
            PG8_WAIT_V(8); PG8_WAIT_L(0); PG8_BAR; PG8_MMA(0, 0, At, B0); PG8_MMA(0, 1, At, B1); PG8_BAR; PG8_SCHED;
            PG8_LDA(At, 1, 1); PG8_STAGE(PG8_SB(1, 0), b3, voffB); PG8_STAGE(PG8_SB(1, 1), b3 + hstepB, voffB); PG8_STAGE(PG8_SA(1, 0), a3, voffA);
            PG8_WAIT_V(8); PG8_WAIT_L(0); PG8_BAR; PG8_MMA(1, 0, At, B0); PG8_MMA(1, 1, At, B1); PG8_BAR; PG8_SCHED;
        }
        if constexpr (ALIGN_EPI) { if (wr == 0) PG8_BAR; }
        { int t_e = threadIdx.x; asm volatile("" : "+v"(t_e)); const int fr_e = t_e & 15, fq_e = (t_e >> 4) & 3;
          if constexpr (Epi::HAS_PREFETCH) { if (has_next) E.prefetch(nxt, (ui + 1) & 1, lds, wid, t_e & 63); E.run(acc, cur, wr, wc, fr_e, fq_e, lds, ui & 1); }
          else E(acc, cur, wr, wc, fr_e, fq_e); }
        if (!has_next) break;
#pragma unroll
        for (int a = 0; a < 2; ++a)
#pragma unroll
            for (int b = 0; b < 2; ++b)
#pragma unroll
                for (int m = 0; m < 4; ++m)
#pragma unroll
                    for (int n = 0; n < 2; ++n) acc[a][b][m][n] = (f32x4){0.f, 0.f, 0.f, 0.f};
        cur = nxt; cA = nA; cB = nB; ++ui;
        if constexpr (ALIGN_EPI) { if (wr == 1) PG8_BAR; }
    }
    PG8_WAIT_V(0);
    if constexpr (!ALIGN_EPI) { if (wr == 0) PG8_BAR; }
    PG8_BAR;
#undef PG8_SA
#undef PG8_SB
#undef PG8_STAGE
#undef PG8_LDA
#undef PG8_LDB
#undef PG8_MMA
#undef PG8_WAIT_V
#undef PG8_WAIT_L
#undef PG8_BAR
#undef PG8_SCHED
}

typedef f32x4 Acc[2][2][4][2];

struct EpiStore { static constexpr bool HAS_PREFETCH = false;
    bf16_t* O; int ldc;
    __device__ __forceinline__ void operator()(const Acc& acc, const Unit& u, int wr, int wc, int fr, int fq) const {
        const int row0 = u.pm * BM + wr * 64 + fr, col0 = u.pn * BM + wc * 32 + 8 * fq;
#pragma unroll
        for (int ai = 0; ai < 2; ++ai)
#pragma unroll
            for (int m = 0; m < 4; ++m) { bf16_t* rowp = O + (size_t)(row0 + ai * HALF + m * 16) * ldc + col0;
#pragma unroll
                for (int bj = 0; bj < 2; ++bj) { const f32x4 v0 = acc[ai][bj][m][0], v1 = acc[ai][bj][m][1];
                    u32x4 w; w.x = cvt_pk_bf16(v0[0], v0[1]); w.y = cvt_pk_bf16(v0[2], v0[3]); w.z = cvt_pk_bf16(v1[0], v1[1]); w.w = cvt_pk_bf16(v1[2], v1[3]);
                    *(u32x4*)(rowp + bj * HALF) = w; } }
    }
};

struct EpiP { static constexpr bool HAS_PREFETCH = false, AFTER_DRAIN = false;
    bf16_t* O; bf16_t* U; float* ssq_q; float* ssq_kv;
    __device__ __forceinline__ void operator()(const Acc& acc, const Unit& u, int wr, int wc, int fr, int fq) const {
        const int row0 = u.pm * BM + wr * 64 + fr;
        if (u.pn >= 4) {
            bf16_t* ucol = U + 128 * (u.pn - 4) + 32 * wc + 8 * fq;
#pragma unroll
            for (int ai = 0; ai < 2; ++ai)
#pragma unroll
                for (int m = 0; m < 4; ++m) { const f32x4 v0 = acc[ai][0][m][0] * acc[ai][1][m][0], v1 = acc[ai][0][m][1] * acc[ai][1][m][1];
                    u32x4 w; w.x = cvt_pk_bf16(v0[0], v0[1]); w.y = cvt_pk_bf16(v0[2], v0[3]); w.z = cvt_pk_bf16(v1[0], v1[1]); w.w = cvt_pk_bf16(v1[2], v1[3]);
                    *(u32x4*)(ucol + (size_t)(row0 + ai * HALF + m * 16) * 512) = w; }
            return;
        }
        EpiStore st{O, PW}; st(acc, u, wr, wc, fr, fq);
        if (u.pn <= 1) {
            float* dst = (u.pn == 0) ? ssq_q : ssq_kv;
#pragma unroll
            for (int ai = 0; ai < 2; ++ai)
#pragma unroll
                for (int m = 0; m < 4; ++m) { float s = 0.f;
#pragma unroll
                    for (int n = 0; n < 2; ++n) { const f32x4 a = acc[ai][0][m][n]; s += (a[0] * a[0] + a[1] * a[1]) + (a[2] * a[2] + a[3] * a[3]); }
                    if (u.pn == 0) {
#pragma unroll
                        for (int n = 0; n < 2; ++n) { const f32x4 a = acc[ai][1][m][n]; s += (a[0] * a[0] + a[1] * a[1]) + (a[2] * a[2] + a[3] * a[3]); } }
                    s += __shfl_xor(s, 16); s += __shfl_xor(s, 32);
                    if (fq == 0) dst[(size_t)(row0 + ai * HALF + m * 16) * 4 + wc] = s; }
        }
    }
};

struct EpiQ { static constexpr bool HAS_PREFETCH = false, AFTER_DRAIN = false;
    bf16_t* Q; const float* ssq; const float* rope;
    __device__ __forceinline__ void operator()(const Acc& acc, const Unit& u, int wr, int wc, int fr, int fq) const {
        const int row0 = u.pm * BM + wr * 64 + fr;
        float f[2][4];
        { f32x4 sp[2][4];
#pragma unroll
          for (int ai = 0; ai < 2; ++ai)
#pragma unroll
              for (int m = 0; m < 4; ++m) sp[ai][m] = *(const f32x4*)(ssq + (size_t)(row0 + ai * HALF + m * 16) * 4);
#pragma unroll
          for (int ai = 0; ai < 2; ++ai)
#pragma unroll
              for (int m = 0; m < 4; ++m) f[ai][m] = rsqrtf(((sp[ai][m][0] + sp[ai][m][1]) + (sp[ai][m][2] + sp[ai][m][3])) * (1.f / 256.f) + 1e-6f) * QSCALE; }
#pragma unroll
        for (int bj = 0; bj < 2; ++bj) { const int g = 8 * u.pn + 4 * bj + wc; const bool is_rope = (g % 3) == 2;
            bf16_t* qcol = Q + 32 * g;
            if (!is_rope) {
#pragma unroll
                for (int ai = 0; ai < 2; ++ai)
#pragma unroll
                    for (int m = 0; m < 4; ++m) { const int t = row0 + ai * HALF + m * 16;
                        const f32x4 v0 = acc[ai][bj][m][0] * f[ai][m], v1 = acc[ai][bj][m][1] * f[ai][m];
                        u32x4 w; w.x = cvt_pk_bf16(v0[0], v0[1]); w.y = cvt_pk_bf16(v0[2], v0[3]); w.z = cvt_pk_bf16(v1[0], v1[1]); w.w = cvt_pk_bf16(v1[2], v1[3]);
                        *(u32x4*)(qcol + (size_t)t * QW + 8 * fq) = w; }
            } else {
#pragma unroll
                for (int ai = 0; ai < 2; ++ai) { f32x4 cs[4], sn[4];
#pragma unroll
                    for (int m = 0; m < 4; ++m) { const int t = row0 + ai * HALF + m * 16; cs[m] = *(const f32x4*)(rope + (size_t)t * 32 + 4 * fq); sn[m] = *(const f32x4*)(rope + (size_t)t * 32 + 16 + 4 * fq); }
#pragma unroll
                    for (int m = 0; m < 4; ++m) { const int t = row0 + ai * HALF + m * 16;
                        const f32x4 a0 = acc[ai][bj][m][0], a1 = acc[ai][bj][m][1];
                        const f32x4 o1 = (a0 * cs[m] - a1 * sn[m]) * f[ai][m], o2 = (a1 * cs[m] + a0 * sn[m]) * f[ai][m];
                        u32x2 w1, w2; w1.x = cvt_pk_bf16(o1[0], o1[1]); w1.y = cvt_pk_bf16(o1[2], o1[3]); w2.x = cvt_pk_bf16(o2[0], o2[1]); w2.y = cvt_pk_bf16(o2[2], o2[3]);
                        *(u32x2*)(qcol + (size_t)t * QW + 4 * fq) = w1; *(u32x2*)(qcol + (size_t)t * QW + 16 + 4 * fq) = w2; }
                    asm volatile("" ::: "memory"); }
            } }
    }
};

struct EpiKV { static constexpr bool HAS_PREFETCH = false, AFTER_DRAIN = false;
    bf16_t* KN; bf16_t* V; const float* ssq;
    __device__ __forceinline__ void operator()(const Acc& acc, const Unit& u, int wr, int wc, int fr, int fq) const {
        const int row0 = u.pm * BM + wr * 64 + fr; const int b = u.pm >> 3;
        float f[2][4];
        { f32x4 sp[2][4];
#pragma unroll
          for (int ai = 0; ai < 2; ++ai)
#pragma unroll
              for (int m = 0; m < 4; ++m) sp[ai][m] = *(const f32x4*)(ssq + (size_t)(row0 + ai * HALF + m * 16) * 4);
#pragma unroll
          for (int ai = 0; ai < 2; ++ai)
#pragma unroll
              for (int m = 0; m < 4; ++m) f[ai][m] = rsqrtf(((sp[ai][m][0] + sp[ai][m][1]) + (sp[ai][m][2] + sp[ai][m][3])) * (1.f / 128.f) + 1e-6f); }
#pragma unroll
        for (int bj = 0; bj < 2; ++bj) { const int g = 8 * u.pn + 4 * bj + wc, head = g >> 2, part = g & 3;
            char* base = (part < 2) ? (char*)KN + (4 * part + fq) * 1024 + fr * 16 : (char*)V + (part - 2) * 4096 + fr * 64 + fq * 16;
            const int mstep = (part < 2) ? 256 : 1024;
            base += (size_t)(b * 8 + head) * 32 * 8192;
#pragma unroll
            for (int ai = 0; ai < 2; ++ai) { const int tile = (4 * u.pm + 2 * ai + wr) & 31;
#pragma unroll
                for (int m = 0; m < 4; ++m) {
                    const f32x4 v0 = acc[ai][bj][m][0] * f[ai][m], v1 = acc[ai][bj][m][1] * f[ai][m];
                    u32x4 w; w.x = cvt_pk_bf16(v0[0], v0[1]); w.y = cvt_pk_bf16(v0[2], v0[3]); w.z = cvt_pk_bf16(v1[0], v1[1]); w.w = cvt_pk_bf16(v1[2], v1[3]);
                    *(u32x4*)(base + (size_t)tile * 8192 + m * mstep) = w; } } }
    }
};

template <int CTRL> __device__ __forceinline__ float dppf(float v) { return __builtin_bit_cast(float, __builtin_amdgcn_update_dpp(0, __builtin_bit_cast(int, v), CTRL, 0xf, 0xf, true)); }
template <int CTRL> __device__ __forceinline__ f32x4 dpp4(f32x4 v) { f32x4 r; r[0] = dppf<CTRL>(v[0]); r[1] = dppf<CTRL>(v[1]); r[2] = dppf<CTRL>(v[2]); r[3] = dppf<CTRL>(v[3]); return r; }

constexpr int CW_LDS = RING_BYTES + 1024;
struct EpiUp { static constexpr bool HAS_PREFETCH = true;
    bf16_t* ACT; float* E; const float* cw; const float* cb;
    __device__ __forceinline__ void prefetch(const Unit& u, int buf, LAS unsigned char* lds, int wid, int lane) const {
        if (wid < 4) { const float* base = (wid < 3) ? cw + (size_t)wid * UPW : cb;
            const float* src = base + 128 * u.pn + ((lane & 32) ? DFF : 0) + 4 * (lane & 31);
            __builtin_amdgcn_global_load_lds((const unsigned*)src, (LAS unsigned*)(lds + CW_LDS + buf * 4096 + wid * 1024), 16, 0, 0); }
    }
    __device__ __forceinline__ void run(const Acc& acc, const Unit& u, int wr, int wc, int fr, int fq, LAS unsigned char* lds, int buf) const {
        const int cl = 32 * wc + 8 * fq;
        const int cbase = 128 * u.pn + cl;
        const LAS float* wl = (const LAS float*)(lds + CW_LDS + buf * 4096) + cl;
        u32x2 res0[2][4];
#pragma unroll
        for (int n = 0; n < 2; ++n) { const int c0 = cbase + 4 * n;
            const f32x4 wg0 = *(const LAS f32x4*)(wl + 4 * n), wg1 = *(const LAS f32x4*)(wl + 256 + 4 * n), wg2 = *(const LAS f32x4*)(wl + 512 + 4 * n), bg = *(const LAS f32x4*)(wl + 768 + 4 * n);
            const f32x4 wv0 = *(const LAS f32x4*)(wl + 128 + 4 * n), wv1 = *(const LAS f32x4*)(wl + 384 + 4 * n), wv2 = *(const LAS f32x4*)(wl + 640 + 4 * n), bv = *(const LAS f32x4*)(wl + 896 + 4 * n);
#pragma unroll
            for (int ai = 0; ai < 2; ++ai) { f32x4 pg1 = {0.f, 0.f, 0.f, 0.f}, pg2 = pg1, pv1 = pg1, pv2 = pg1;
                const int blk = 4 * u.pm + 2 * ai + wr;
#pragma unroll
                for (int m = 0; m < 4; ++m) { const f32x4 gcur = acc[ai][0][m][n], vcur = acc[ai][1][m][n];
                    const f32x4 rg1 = dpp4<0x121>(gcur), rg2 = dpp4<0x122>(gcur), rv1 = dpp4<0x121>(vcur), rv2 = dpp4<0x122>(vcur);
                    const f32x4 g1 = (fr >= 1) ? rg1 : pg1, g2 = (fr >= 2) ? rg2 : pg2, v1 = (fr >= 1) ? rv1 : pv1, v2 = (fr >= 2) ? rv2 : pv2;
                    const f32x4 cg = bg + wg0 * g2 + wg1 * g1 + wg2 * gcur, cv = bv + wv0 * v2 + wv1 * v1 + wv2 * vcur;
                    f32x4 a; a[0] = silu_f(cg[0]) * cv[0]; a[1] = silu_f(cg[1]) * cv[1]; a[2] = silu_f(cg[2]) * cv[2]; a[3] = silu_f(cg[3]) * cv[3];
                    u32x2 w; w.x = cvt_pk_bf16(a[0], a[1]); w.y = cvt_pk_bf16(a[2], a[3]);
                    const int t = u.pm * BM + ai * HALF + wr * 64 + m * 16 + fr;
                    if (n == 0) res0[ai][m] = w;
                    else if (!(m == 0 && fr < 2)) { u32x4 o; o.x = res0[ai][m].x; o.y = res0[ai][m].y; o.z = w.x; o.w = w.y; *(u32x4*)(ACT + (size_t)t * DFF + cbase) = o; }
                    if (m == 0 && fr < 2) { float* e = E + ((size_t)blk * 4 + fr) * UPW + c0; *(f32x4*)e = gcur; *(f32x4*)(e + DFF) = vcur; }
                    if (m == 3 && fr >= 14) { float* e = E + ((size_t)blk * 4 + 2 + (fr - 14)) * UPW + c0; *(f32x4*)e = gcur; *(f32x4*)(e + DFF) = vcur; }
                    pg1 = rg1; pg2 = rg2; pv1 = rv1; pv2 = rv2; } } }
    }
};
}

namespace att {
constexpr int NSLOT = 3, K_OFF = 0, KSLOT = 12288, V_OFF = NSLOT * KSLOT, VSLOT = 8192, WS_OFF = V_OFF + NSLOT * VSLOT, OST_OFF = WS_OFF + 8 * 256, LDS_END = OST_OFF + 8 * 8192;
static_assert(LDS_END <= RING_BYTES, "attention LDS");
__device__ __forceinline__ int crow(int r, int hi) { return (r & 3) + 8 * (r >> 2) + 4 * hi; }
typedef short v4i16_t __attribute__((ext_vector_type(4)));
__device__ __forceinline__ s16x4 vtr(const LAS unsigned char* p) { return __builtin_bit_cast(s16x4, __builtin_amdgcn_ds_read_tr16_b64_v4i16((LAS v4i16_t*)p)); }
__device__ __forceinline__ void glds(const char* src, LAS unsigned char* dst) { unsigned keep; const unsigned d = (unsigned)__builtin_amdgcn_readfirstlane((int)(unsigned)(uintptr_t)dst);
    asm volatile("s_mov_b32 %0, m0\n\ts_mov_b32 m0, %2\n\ts_nop 0\n\tglobal_load_lds_dwordx4 %1, off\n\ts_mov_b32 m0, %0" : "=&s"(keep) : "v"(src), "s"(d) : "memory"); }
__device__ __forceinline__ float max3f(float a, float b, float c) { float r; asm("v_max3_f32 %0, %1, %2, %3" : "=v"(r) : "v"(a), "v"(b), "v"(c)); return r; }
__device__ __forceinline__ float max2f(float a, float b) { float r; asm("v_max_f32_e32 %0, %1, %2" : "=v"(r) : "v"(a), "v"(b)); return r; }
__device__ __forceinline__ float fadd_s(float a, float b) { float r; asm("v_add_f32_e32 %0, %1, %2" : "=v"(r) : "v"(a), "v"(b)); return r; }
constexpr float THRL = 4.0f;

struct AUnit { int b, h, qb; };
__device__ __forceinline__ bool unit_of(int k, int vcu, int G, AUnit& u) {
    const int it = vcu + (k >> 2) * G, r = k & 3; if (it >= 256) return false;
    const int grp = it >> 3, i8 = it & 7, bh = grp * 4 + r; u.b = bh >> 3; u.h = bh & 7;
    u.qb = (r == 0) ? 7 - i8 : (r == 1) ? i8 : (r == 2) ? 7 - (i8 ^ 1) : (i8 ^ 1); return true;
}
__device__ __forceinline__ void attn_phase(int vcu, int G, const bf16_t* Q, const bf16_t* KN, const bf16_t* KR, const bf16_t* V, bf16_t* Y, const float* ong, LAS unsigned char* lds) {
    int tid = threadIdx.x; asm volatile("" : "+v"(tid));
    const int lane = tid & 63, r32 = lane & 31, hi = lane >> 5; const int wid = __builtin_amdgcn_readfirstlane(tid >> 6);
    const int lo16 = wid * 1024 + lane * 16;
    LAS float* wsf = (LAS float*)(lds + WS_OFF + wid * 256);
    const int kl = hi * 1024 + r32 * 16, vl = ((lane >> 4) & 1) * 32 + (lane & 3) * 8 + (4 * hi + ((lane & 15) >> 2)) * 64;
#define ATT_ISSUE(U, tile, slot) do { const size_t bh_ = (size_t)((U).b * 8 + (U).h); \
        glds((const char*)KN + (bh_ * 32 + (tile)) * 8192 + lo16, lds + K_OFF + (slot) * KSLOT + wid * 1024); glds((const char*)V + (bh_ * 32 + (tile)) * 8192 + lo16, lds + V_OFF + (slot) * VSLOT + wid * 1024); \
        if (wid < 4) glds((const char*)KR + ((size_t)(U).b * 32 + (tile)) * 4096 + lo16, lds + K_OFF + (slot) * KSLOT + 8192 + wid * 1024); } while (0)
#define ATT_QLOAD(dst, U) do { const bf16_t* qp_ = Q + (size_t)((U).b * SEQ + 256 * (U).qb + 32 * wid + r32) * QW + 96 * (U).h + 8 * hi; \
        _Pragma("unroll") for (int ks = 0; ks < 6; ++ks) dst[ks] = *(const bf16x8*)(qp_ + 16 * ks); } while (0)
    AUnit cur, nxt;
    if (!unit_of(0, vcu, G, cur)) return;
    bf16x8 qr[6], qn[6];
    ATT_QLOAD(qr, cur);
    asm volatile("" : "+v"(qr[0]), "+v"(qr[1]), "+v"(qr[2]), "+v"(qr[3]), "+v"(qr[4]), "+v"(qr[5]));
    ATT_ISSUE(cur, 0, 0); ATT_ISSUE(cur, 1, 1);
    int slot = 0;
    for (int k = 0;; ++k) {
        const bool has_next = unit_of(k + 1, vcu, G, nxt);
        const int NT = 4 * cur.qb + 4, jmax = 4 * cur.qb + (wid >> 1);
        float mrun = 0.f, lrun = 0.f; f32x16 o[2]; o[0] = f32x16{}; o[1] = f32x16{}; f32x16 negm = f32x16{};
        for (int j = 0; j < NT; ++j) {
            if (j == 0 && k > 0) { if (wid < 4) asm volatile("s_waitcnt vmcnt(13) lgkmcnt(0)\n\ts_barrier" ::: "memory"); else asm volatile("s_waitcnt vmcnt(12) lgkmcnt(0)\n\ts_barrier" ::: "memory"); }
            else if (j + 1 < NT || has_next) { if (wid < 4) asm volatile("s_waitcnt vmcnt(3) lgkmcnt(0)\n\ts_barrier" ::: "memory"); else asm volatile("s_waitcnt vmcnt(2) lgkmcnt(0)\n\ts_barrier" ::: "memory"); }
            else asm volatile("s_waitcnt vmcnt(0) lgkmcnt(0)\n\ts_barrier" ::: "memory");
            { const int s2 = (slot == 0) ? 2 : slot - 1;
              if (j + 2 < NT) ATT_ISSUE(cur, j + 2, s2); else if (has_next) ATT_ISSUE(nxt, j + 2 - NT, s2); }
            if (j == NT - 1 && has_next) ATT_QLOAD(qn, nxt);
            if (j <= jmax) {
                const LAS unsigned char* kp = lds + K_OFF + slot * KSLOT + kl;
                f32x16 p0, p1;
#pragma unroll
                for (int ks = 0; ks < 6; ++ks) { const bf16x8 k0 = *(const LAS bf16x8*)(kp + ks * 2048), k1 = *(const LAS bf16x8*)(kp + ks * 2048 + 512);
                    if (ks == 0) { p0 = __builtin_amdgcn_mfma_f32_32x32x16_bf16(k0, qr[0], negm, 0, 0, 0); p1 = __builtin_amdgcn_mfma_f32_32x32x16_bf16(k1, qr[0], negm, 0, 0, 0); }
                    else { p0 = __builtin_amdgcn_mfma_f32_32x32x16_bf16(k0, qr[ks], p0, 0, 0, 0); p1 = __builtin_amdgcn_mfma_f32_32x32x16_bf16(k1, qr[ks], p1, 0, 0, 0); } }
                float rm;
                { float a = max3f(p0[0], p0[1], p1[0]), c = max3f(p0[2], p0[3], p1[1]); a = max3f(a, p1[2], p1[3]);
#pragma unroll
                  for (int r = 4; r < 16; r += 4) { a = max3f(a, p0[r], p0[r + 1]); c = max3f(c, p0[r + 2], p0[r + 3]); a = max3f(a, p1[r], p1[r + 1]); c = max3f(c, p1[r + 2], p1[r + 3]); }
                  rm = max2f(a, c); rm = max2f(rm, __shfl_xor(rm, 32)); }
                if (j == 0 || __any(rm > THRL)) {
                    const float dl = (j == 0) ? rm : fmaxf(rm, 0.f);
                    mrun += dl;
#pragma unroll
                    for (int r = 0; r < 16; ++r) { p0[r] -= dl; p1[r] -= dl; }
#pragma unroll
                    for (int r = 0; r < 16; ++r) negm[r] = -mrun;
                    if (j != 0) { const float alpha = fexp2(-dl); lrun *= alpha;
                        if (hi == 0) wsf[r32] = alpha;
#pragma unroll
                        for (int r = 0; r < 16; ++r) { const float a_ = wsf[crow(r, hi)]; o[0][r] *= a_; o[1][r] *= a_; } }
                }
#pragma unroll
                for (int r = 0; r < 16; ++r) { p0[r] = fexp2(p0[r]); p1[r] = fexp2(p1[r]); }
                { float s0 = fadd_s(p0[0], p1[0]), s1 = fadd_s(p0[1], p1[1]);
#pragma unroll
                  for (int r = 2; r < 16; r += 2) { s0 = fadd_s(s0, p0[r]); s1 = fadd_s(s1, p0[r + 1]); s0 = fadd_s(s0, p1[r]); s1 = fadd_s(s1, p1[r + 1]); }
                  lrun = fadd_s(lrun, fadd_s(s0, s1)); }
                bf16x8 pa[4];
                { u32x4 w0, w1, w2, w3;
                  w0.x = cvt_pk_bf16(p0[0], p0[1]); w0.y = cvt_pk_bf16(p0[2], p0[3]); w0.z = cvt_pk_bf16(p0[4], p0[5]); w0.w = cvt_pk_bf16(p0[6], p0[7]);
                  w1.x = cvt_pk_bf16(p0[8], p0[9]); w1.y = cvt_pk_bf16(p0[10], p0[11]); w1.z = cvt_pk_bf16(p0[12], p0[13]); w1.w = cvt_pk_bf16(p0[14], p0[15]);
                  w2.x = cvt_pk_bf16(p1[0], p1[1]); w2.y = cvt_pk_bf16(p1[2], p1[3]); w2.z = cvt_pk_bf16(p1[4], p1[5]); w2.w = cvt_pk_bf16(p1[6], p1[7]);
                  w3.x = cvt_pk_bf16(p1[8], p1[9]); w3.y = cvt_pk_bf16(p1[10], p1[11]); w3.z = cvt_pk_bf16(p1[12], p1[13]); w3.w = cvt_pk_bf16(p1[14], p1[15]);
                  pa[0] = __builtin_bit_cast(bf16x8, w0); pa[1] = __builtin_bit_cast(bf16x8, w1); pa[2] = __builtin_bit_cast(bf16x8, w2); pa[3] = __builtin_bit_cast(bf16x8, w3); }
                const LAS unsigned char* vp = lds + V_OFF + slot * VSLOT + vl;
#pragma unroll
                for (int d0 = 0; d0 < 2; ++d0)
#pragma unroll
                    for (int ks = 0; ks < 4; ++ks) { const s16x4 lo = vtr(vp + d0 * 4096 + ks * 1024), hh = vtr(vp + d0 * 4096 + ks * 1024 + 512);
                        const bf16x8 vf = {lo[0], lo[1], lo[2], lo[3], hh[0], hh[1], hh[2], hh[3]};
                        o[d0] = __builtin_amdgcn_mfma_f32_32x32x16_bf16(pa[ks], vf, o[d0], 0, 0, 0); }
            }
            slot = (slot == 2) ? 0 : slot + 1;
        }
        { const float lt = lrun + __shfl_xor(lrun, 32);
          if (hi == 0) wsf[r32] = frcp(lt);
          LAS float* stg = (LAS float*)(lds + OST_OFF + wid * 8192);
#pragma unroll
          for (int r = 0; r < 16; ++r) { const float inv = wsf[crow(r, hi)]; const int orow = crow(r, hi); stg[orow * 64 + r32] = o[0][r] * inv; stg[orow * 64 + 32 + r32] = o[1][r] * inv; }
          const int ch = lane & 7;
          const f32x4 ga = *(const f32x4*)(ong + 64 * cur.h + 8 * ch), gb = *(const f32x4*)(ong + 64 * cur.h + 8 * ch + 4);
          bf16_t* Yw = Y + (size_t)(cur.b * SEQ + 256 * cur.qb + 32 * wid) * D + 64 * cur.h + 8 * ch;
#pragma unroll
          for (int i = 0; i < 4; ++i) { const int row = i * 8 + (lane >> 3);
              const f32x4 va = *(const LAS f32x4*)(stg + row * 64 + 8 * ch), vb = *(const LAS f32x4*)(stg + row * 64 + 8 * ch + 4);
              float ss = (va[0] * va[0] + va[1] * va[1]) + (va[2] * va[2] + va[3] * va[3]) + (vb[0] * vb[0] + vb[1] * vb[1]) + (vb[2] * vb[2] + vb[3] * vb[3]);
              ss += pg8::dppf<0xB1>(ss); ss += pg8::dppf<0x4E>(ss); ss += pg8::dppf<0x141>(ss);
              const float rs = rsqrtf(ss * (1.f / 64.f) + 1e-6f);
              const f32x4 oa = va * rs * ga, ob = vb * rs * gb;
              u32x4 w; w.x = cvt_pk_bf16(oa[0], oa[1]); w.y = cvt_pk_bf16(oa[2], oa[3]); w.z = cvt_pk_bf16(ob[0], ob[1]); w.w = cvt_pk_bf16(ob[2], ob[3]);
              *(u32x4*)(Yw + (size_t)row * D) = w; } }
        if (!has_next) break;
        cur = nxt;
#pragma unroll
        for (int ks = 0; ks < 6; ++ks) qr[ks] = qn[ks];
    }
    asm volatile("s_waitcnt vmcnt(0) lgkmcnt(0)\n\ts_barrier" ::: "memory");
#undef ATT_ISSUE
#undef ATT_QLOAD
}
}

#define XB_TMO      128
#define XB_XCNT(j)  (256  + 64 * (j))
#define XB_XSUB(j)  (1280 + 64 * (j))
#define XB_XGEN(j)  (2304 + 64 * (j))
#define XB_TOP      3328
#define XB_TOPGEN   3392
#define XCD_BAR_WORDS 3456
#define XB_SPIN_CAP (1u << 18)
__device__ __forceinline__ unsigned xb_ld(unsigned* p)              { return __hip_atomic_load(p, __ATOMIC_RELAXED, __HIP_MEMORY_SCOPE_AGENT); }
__device__ __forceinline__ unsigned xb_add(unsigned* p, unsigned v) { return __hip_atomic_fetch_add(p, v, __ATOMIC_RELAXED, __HIP_MEMORY_SCOPE_AGENT); }
__device__ __forceinline__ unsigned xb_xcc_id() { return (unsigned)__builtin_amdgcn_s_getreg((3 << 11) | 20) & 0xFu; }
#define XB_SPIN(cond, bar) do { unsigned _sp = 0; while (cond) { __builtin_amdgcn_s_sleep(1); \
    if ((++_sp & 255u) == 0u) { if (xb_ld(&(bar)[XB_TMO])) break; if (_sp > XB_SPIN_CAP) { atomicAdd(&(bar)[XB_TMO], 1u); break; } } } } while (0)
struct XcdBarrier { unsigned* bar; unsigned x; volatile LAS unsigned* st; };
__device__ __forceinline__ XcdBarrier xcd_barrier_post(unsigned* bar, volatile LAS unsigned* st) {
    XcdBarrier b; b.bar = bar; b.x = xb_xcc_id(); b.st = st;
    if (threadIdx.x == 0) (void)xb_add(&bar[XB_XCNT(b.x)], 1u);
    return b;
}
__device__ __forceinline__ void xcd_barrier_complete(unsigned* bar, unsigned x, unsigned& nloc, unsigned& nx) {
    const unsigned G = gridDim.x * gridDim.y * gridDim.z;
    unsigned sum, cnt, mine, sp = 0u;
    for (;;) {
        sum = 0u; cnt = 0u; mine = 0u;
#pragma unroll
        for (unsigned j = 0; j < 16; ++j) { const unsigned c = xb_ld(&bar[XB_XCNT(j)]); sum += c; cnt += (c > 0u) ? 1u : 0u; mine = (j == x) ? c : mine; }
        if (sum == G) break;
        __builtin_amdgcn_s_sleep(1);
        if ((++sp & 255u) == 0u) { if (xb_ld(&bar[XB_TMO])) break; if (sp > XB_SPIN_CAP) { atomicAdd(&bar[XB_TMO], 1u); break; } }
    }
    nloc = mine > 0u ? mine : 1u; nx = cnt > 0u ? cnt : 1u;
}
__device__ __forceinline__ void xcd_barrier(const XcdBarrier& b) {
    asm volatile("s_waitcnt vmcnt(0)" ::: "memory");
    __syncthreads();
    if (threadIdx.x == 0) {
        unsigned* bar = b.bar;
        __builtin_amdgcn_s_waitcnt(0);
        unsigned nloc = b.st[0], nx = b.st[1];
        if (nloc == 0u) { xcd_barrier_complete(bar, b.x, nloc, nx); b.st[0] = nloc; b.st[1] = nx; }
        const unsigned old = xb_add(&bar[XB_XSUB(b.x)], 1u);
        const unsigned gen = old / nloc;
        if (old + 1u == (gen + 1u) * nloc) {
            __builtin_amdgcn_fence(__ATOMIC_RELEASE, "agent");
            asm volatile("s_waitcnt vmcnt(0)" ::: "memory");
            const unsigned og = xb_add(&bar[XB_TOP], 1u);
            const unsigned tg = og / nx;
            if (og + 1u == (tg + 1u) * nx) xb_add(&bar[XB_TOPGEN], 1u);
            else XB_SPIN(xb_ld(&bar[XB_TOPGEN]) == tg, bar);
            __builtin_amdgcn_fence(__ATOMIC_ACQUIRE, "agent");
            xb_add(&bar[XB_XGEN(b.x)], 1u);
            asm volatile("s_waitcnt vmcnt(0)" ::: "memory");
        } else {
            XB_SPIN(xb_ld(&bar[XB_XGEN(b.x)]) == gen, bar);
            __builtin_amdgcn_fence(__ATOMIC_ACQUIRE, "agent");
            asm volatile("s_waitcnt vmcnt(0)" ::: "memory");
        }
    }
    __syncthreads();
}

struct Args { const float* in[22]; const int* pos; float* out; unsigned char* ws; int ph_lo, ph_hi; };
__constant__ float c_invfreq[16] = {1.0f, 0.5623413251903491f, 0.31622776601683794f, 0.1778279410038923f, 0.1f, 0.05623413251903491f, 0.03162277660168379f, 0.01778279410038923f,
                                    0.01f, 0.005623413251903491f, 0.0031622776601683794f, 0.001778279410038923f, 0.001f, 0.0005623413251903491f, 0.00031622776601683794f, 0.0001778279410038923f};

__device__ __forceinline__ int colmap(int which, int s) {
    const int p = (s & ~31) + pg8::perm32(s & 31);
    switch (which) {
        case 0: { if (s < 1024) return p < 416 ? p : (p < 512 ? -1 : p - 96);
                  const int bj = (s >> 7) & 1, ch = 128 * ((s >> 8) - 4) + 32 * ((s >> 5) & 3) + pg8::perm32(s & 31); return (bj ? 1440 : 928) + ch; }
        case 1: return ((s >> 5) % 3 == 2) ? s : p;
        case 4: { const int pn = s >> 8, bj = (s >> 7) & 1, wc = (s >> 5) & 3; return bj * DFF + 128 * pn + 32 * wc + pg8::perm32(s & 31); }
        default: return p;
    }
}
__device__ __forceinline__ void p0_transpose_item(const float* W, int ldw, int Ksrc, const float* kscale, bf16_t* WT, int Kdst, int which, LAS float* scr, int item, int nblk, int lane) {
    const int kb = item / nblk, nb = item % nblk, k0 = 64 * kb, s0 = 32 * nb;
    const int cm = colmap(which, s0 + (lane & 31));
    float tv[32];
#pragma unroll
    for (int i = 0; i < 32; ++i) { const int k = k0 + 2 * i + (lane >> 5); tv[i] = (cm >= 0 && k < Ksrc) ? W[(size_t)k * ldw + cm] : 0.f; }
    if (kscale) {
#pragma unroll
        for (int i = 0; i < 32; ++i) { const int k = k0 + 2 * i + (lane >> 5); if (k < Ksrc) tv[i] *= kscale[k]; } }
#pragma unroll
    for (int i = 0; i < 32; ++i) scr[(2 * i + (lane >> 5)) * 33 + (lane & 31)] = tv[i];
    asm volatile("s_waitcnt lgkmcnt(0)" ::: "memory");
    const int c = lane & 7;
#pragma unroll
    for (int j = 0; j < 4; ++j) { const int n = (lane >> 3) + 8 * j; const LAS float* s = scr + (8 * c) * 33 + n;
        u32x4 o; o.x = cvt_pk_bf16(s[0 * 33], s[1 * 33]); o.y = cvt_pk_bf16(s[2 * 33], s[3 * 33]); o.z = cvt_pk_bf16(s[4 * 33], s[5 * 33]); o.w = cvt_pk_bf16(s[6 * 33], s[7 * 33]);
        *(u32x4*)(WT + (size_t)(s0 + n) * Kdst + k0 + 8 * c) = o; }
    asm volatile("s_waitcnt lgkmcnt(0)" ::: "memory");
}

constexpr int N_PHASES = 11;
#define OPAQUE_LANE(name) int name##_t = (int)threadIdx.x; asm volatile("" : "+v"(name##_t)); const int name = name##_t & 63

__global__ void __launch_bounds__(512, 2) mk_fwd(Args args) {
    extern __shared__ __attribute__((aligned(16))) unsigned char lds_raw[];
    LAS unsigned char* lds = (LAS unsigned char*)lds_raw;
    volatile LAS unsigned* MISC = (volatile LAS unsigned*)(lds + MISC_OFF);
    const int tid = threadIdx.x, lane = tid & 63, wave = __builtin_amdgcn_readfirstlane(tid >> 6);
    const int G = gridDim.x; const int bx = blockIdx.x; const int vcu = (G % 8 == 0) ? (bx % 8) * (G / 8) + bx / 8 : bx;
    const int gw = vcu * 8 + wave, NGW = G * 8;
    unsigned char* ws = args.ws;
    const float* x = args.in[0]; const float* cvec = args.in[1]; const int* pos = args.pos;
    const float* w_ada = args.in[3]; const float* b_ada = args.in[4]; const float* w_in = args.in[5];
    const float* qg = args.in[6]; const float* w_qup = args.in[7]; const float* kvg = args.in[8]; const float* w_kvup = args.in[9];
    const float* conv_w = args.in[10]; const float* conv_b = args.in[11]; const float* ong = args.in[12]; const float* w_out = args.in[13];
    const float* ln1g = args.in[14]; const float* ln1b = args.in[15]; const float* w_up = args.in[16];
    const float* fcw = args.in[17]; const float* fcb = args.in[18]; const float* w_down = args.in[19];
    const float* ln2g = args.in[20]; const float* ln2b = args.in[21];
    float* out = args.out;
    float* MOD = (float*)(ws + WS_MOD); float* ROPE = (float*)(ws + WS_ROPE); float* SSQQ = (float*)(ws + WS_SSQQ); float* SSQKV = (float*)(ws + WS_SSQKV);
    bf16_t* WIN = (bf16_t*)(ws + WS_WIN); bf16_t* WQ = (bf16_t*)(ws + WS_WQ); bf16_t* WKV = (bf16_t*)(ws + WS_WKV); bf16_t* WOUT = (bf16_t*)(ws + WS_WOUT);
    bf16_t* WUP = (bf16_t*)(ws + WS_WUP); bf16_t* WDN = (bf16_t*)(ws + WS_WDN);
    bf16_t* HB = (bf16_t*)(ws + WS_HB); bf16_t* FF = (bf16_t*)(ws + WS_FF); bf16_t* P = (bf16_t*)(ws + WS_P); bf16_t* MIX = (bf16_t*)(ws + WS_MIX);
    bf16_t* U = (bf16_t*)(ws + WS_U); bf16_t* Qb = (bf16_t*)(ws + WS_Q); bf16_t* KN = (bf16_t*)(ws + WS_KN); bf16_t* KR = (bf16_t*)(ws + WS_KR); bf16_t* Vb = (bf16_t*)(ws + WS_V);
    bf16_t* Y = (bf16_t*)(ws + WS_Y); bf16_t* X1 = (bf16_t*)(ws + WS_X1); bf16_t* ACT = (bf16_t*)(ws + WS_ACT); float* E = (float*)(ws + WS_E);

    for (int u = tid; u < (LDS_BYTES - LDSCTL_OFF) / 4; u += 512) ((LAS unsigned*)(lds + LDSCTL_OFF))[u] = 0u;
    __syncthreads();
    XcdBarrier bar; bar.bar = (unsigned*)(ws + WS_CTL) + CW_BAR; bar.x = 0; bar.st = nullptr;
    if (MK_N_LAUNCHES == 1) bar = xcd_barrier_post((unsigned*)(ws + WS_CTL) + CW_BAR, MISC + 8);
    const int lo = args.ph_lo, hi = args.ph_hi;
#ifndef PH_MASK
#define PH_MASK 0x7ff
#endif
#define IN(k) (((PH_MASK >> (k)) & 1) && lo <= (k) && (k) < hi)
#define SEAM(k) do { if (IN(k) && IN((k) + 1)) xcd_barrier(bar); } while (0)

    if (IN(0)) {
        OPAQUE_LANE(ln);
        if (bx < 192) {
            LAS float* cact = (LAS float*)lds; LAS float* part = (LAS float*)(lds + 65536);
            const int n0 = 32 * bx, c4 = tid & 7, kr = tid >> 3;
            f32x4 wv[16];
#pragma unroll
            for (int i = 0; i < 16; ++i) wv[i] = *(const f32x4*)(w_ada + (size_t)(kr + 64 * i) * 6144 + n0 + 4 * c4);
            for (int i = tid; i < 16 * 1024; i += 512) { const float v = cvec[i]; cact[i] = v * frcp(1.f + fexp2(-LOG2E * v)); }
            __syncthreads();
            f32x4 a[16];
#pragma unroll
            for (int b = 0; b < 16; ++b) a[b] = (f32x4){0.f, 0.f, 0.f, 0.f};
#pragma unroll
            for (int i = 0; i < 16; ++i) { const int k = kr + 64 * i;
#pragma unroll
                for (int b = 0; b < 16; ++b) a[b] += wv[i] * cact[b * 1024 + k];
                if ((i & 1) == 1) asm volatile("" ::: "memory"); }
#pragma unroll
            for (int b = 0; b < 16; ++b)
#pragma unroll
                for (int e = 0; e < 4; ++e) { float v = a[b][e]; v += __shfl_xor(v, 8); v += __shfl_xor(v, 16); v += __shfl_xor(v, 32); a[b][e] = v; }
            if (ln < 8) {
#pragma unroll
                for (int b = 0; b < 16; ++b) *(LAS f32x4*)(part + (wave * 16 + b) * 32 + 4 * c4) = a[b]; }
            __syncthreads();
            { const int b = tid >> 5, col = tid & 31; float s = 0.f;
#pragma unroll
              for (int w8 = 0; w8 < 8; ++w8) s += part[(w8 * 16 + b) * 32 + col];
              MOD[b * 6144 + n0 + col] = s + b_ada[n0 + col]; }
            __syncthreads();
        }
        for (int idx = gw * 64 + ln; idx < T * 16; idx += NGW * 64) { const int t = idx >> 4, i = idx & 15; const float ang = (float)pos[t] * c_invfreq[i];
            ROPE[(size_t)t * 32 + i] = cosf(ang); ROPE[(size_t)t * 32 + 16 + i] = sinf(ang); }
    }
    SEAM(0);
    if (IN(1)) {
        OPAQUE_LANE(ln);
        {
        LAS float* scr = (LAS float*)(lds + wave * 16384);
        constexpr int I0 = 16 * 64, I1 = 4 * 24, I2 = 4 * 32, I3 = 16 * 32, I4 = 16 * 176, I5 = 44 * 32, NIT = I0 + I1 + I2 + I3 + I4 + I5;
        for (int it = gw; it < NIT; it += NGW) {
            int r = it;
            if (r < I0) { p0_transpose_item(w_in, INW, D, nullptr, WIN, D, 0, scr, r, 64, ln); continue; } r -= I0;
            if (r < I1) { p0_transpose_item(w_qup, QW, 256, qg, WQ, 256, 1, scr, r, 24, ln); continue; } r -= I1;
            if (r < I2) { p0_transpose_item(w_kvup, 1024, 128, kvg, WKV, 256, 2, scr, r, 32, ln); continue; } r -= I2;
            if (r < I3) { p0_transpose_item(w_out, D, D, nullptr, WOUT, D, 3, scr, r, 32, ln); continue; } r -= I3;
            if (r < I4) { p0_transpose_item(w_up, UPW, D, nullptr, WUP, D, 4, scr, r, 176, ln); continue; } r -= I4;
            p0_transpose_item(w_down, D, DFF, nullptr, WDN, DFF, 5, scr, r, 32, ln);
        }
            }
        for (int row0 = gw * 16; row0 < T; row0 += NGW * 16) { const int b = row0 / SEQ; const float* mb = MOD + b * 6144;
            f32x4 sc[4], sh[4];
#pragma unroll
            for (int j = 0; j < 4; ++j) { const int col = 4 * ln + 256 * j; sh[j] = *(const f32x4*)(mb + col); sc[j] = *(const f32x4*)(mb + 1024 + col) + 1.f; }
            for (int rr = 0; rr < 16; ++rr) { const int t = row0 + rr; const float* xr = x + (size_t)t * D;
                f32x4 v[4]; float s = 0.f;
#pragma unroll
                for (int j = 0; j < 4; ++j) { v[j] = *(const f32x4*)(xr + 4 * ln + 256 * j); s += (v[j][0] + v[j][1]) + (v[j][2] + v[j][3]); }
                const float mean = wave_sum(s) * (1.f / D); float q = 0.f;
#pragma unroll
                for (int j = 0; j < 4; ++j) { v[j] = v[j] - mean; q += (v[j][0] * v[j][0] + v[j][1] * v[j][1]) + (v[j][2] * v[j][2] + v[j][3] * v[j][3]); }
                const float rstd = rsqrtf(wave_sum(q) * (1.f / D) + 1e-5f);
#pragma unroll
                for (int j = 0; j < 4; ++j) { const f32x4 o = v[j] * rstd * sc[j] + sh[j]; u32x2 w; w.x = cvt_pk_bf16(o[0], o[1]); w.y = cvt_pk_bf16(o[2], o[3]);
                    *(u32x2*)(HB + (size_t)t * D + 4 * ln + 256 * j) = w; } } }
    }
    SEAM(1);
    if (IN(2)) {
        pg8::Gemm g{HB, D, WIN, T, G1N, D}; pg8::StaticOrder S; S.init(T, G1N, G, bx);
        pg8::EpiP E1{P, U, SSQQ, SSQKV};
        pg8::gemm_phase<pg8::EpiP, true>(lds, g, S, E1);
    }
    SEAM(2);
    if (IN(3)) {
        OPAQUE_LANE(ln);
#ifndef P3_MASK
#define P3_MASK 15
#endif
        if (P3_MASK & 1) { pg8::Gemm g{P, PW, WQ, T, QW, 256}; pg8::StaticOrder S; S.init(T, QW, G, bx); pg8::EpiQ E2{Qb, SSQQ, ROPE}; pg8::gemm_phase<pg8::EpiQ, true>(lds, g, S, E2); }
        if (P3_MASK & 2) { pg8::Gemm g{P + 256, PW, WKV, T, 1024, 256}; pg8::StaticOrder S; S.init(T, 1024, G, bx); pg8::EpiKV E3{KN, Vb, SSQKV}; pg8::gemm_phase<pg8::EpiKV, true>(lds, g, S, E3); }
        if (P3_MASK & 4) for (int row0 = gw * 16; row0 < T; row0 += NGW * 16) {
            { const int t = row0 + (ln >> 2), c = ln & 3, i0 = 8 * (c & 1); const bf16_t* pr = P + (size_t)t * PW + 384;
              const u32x4 r1 = *(const u32x4*)(pr + i0), r2 = *(const u32x4*)(pr + 16 + i0);
              const f32x4 ca = *(const f32x4*)(ROPE + (size_t)t * 32 + i0), cb = *(const f32x4*)(ROPE + (size_t)t * 32 + i0 + 4), sa = *(const f32x4*)(ROPE + (size_t)t * 32 + 16 + i0), sb = *(const f32x4*)(ROPE + (size_t)t * 32 + 16 + i0 + 4);
              float ov[8];
#pragma unroll
              for (int e = 0; e < 8; ++e) { const float x1 = (e & 1) ? bf_hi(r1[e >> 1]) : bf_lo(r1[e >> 1]), x2 = (e & 1) ? bf_hi(r2[e >> 1]) : bf_lo(r2[e >> 1]);
                  const float cs = (e < 4) ? ca[e & 3] : cb[e & 3], sn = (e < 4) ? sa[e & 3] : sb[e & 3];
                  ov[e] = (c < 2) ? x1 * cs - x2 * sn : x2 * cs + x1 * sn; }
              u32x4 o; o.x = cvt_pk_bf16(ov[0], ov[1]); o.y = cvt_pk_bf16(ov[2], ov[3]); o.z = cvt_pk_bf16(ov[4], ov[5]); o.w = cvt_pk_bf16(ov[6], ov[7]);
              *(u32x4*)((char*)KR + (size_t)(t >> 6) * 4096 + c * 1024 + (t & 63) * 16) = o; }
            const int c0 = 8 * ln;
            float w0[8], w1[8], w2[8], cb8[8], gn[8];
#pragma unroll
            for (int e = 0; e < 8; ++e) { w0[e] = conv_w[c0 + e]; w1[e] = conv_w[512 + c0 + e]; w2[e] = conv_w[1024 + c0 + e]; cb8[e] = conv_b[c0 + e]; gn[e] = ong[512 + c0 + e]; }
            float um2[8], um1[8];
#pragma unroll
            for (int e = 0; e < 8; ++e) { um2[e] = 0.f; um1[e] = 0.f; }
            if ((row0 % SEQ) != 0) {
                const u32x4 a2 = *(const u32x4*)(U + (size_t)(row0 - 2) * 512 + c0), a1 = *(const u32x4*)(U + (size_t)(row0 - 1) * 512 + c0);
#pragma unroll
                for (int e = 0; e < 4; ++e) { um2[2 * e] = bf_lo(a2[e]); um2[2 * e + 1] = bf_hi(a2[e]); um1[2 * e] = bf_lo(a1[e]); um1[2 * e + 1] = bf_hi(a1[e]); }
            }
            for (int rr = 0; rr < 16; ++rr) { const int t = row0 + rr;
                const u32x4 gb = *(const u32x4*)(P + (size_t)t * PW + 512 + c0), uu = *(const u32x4*)(U + (size_t)t * 512 + c0);
                float u0[8], yv[8]; float ss = 0.f;
#pragma unroll
                for (int e = 0; e < 4; ++e) { u0[2 * e] = bf_lo(uu[e]); u0[2 * e + 1] = bf_hi(uu[e]); }
#pragma unroll
                for (int e = 0; e < 8; ++e) { const float gbe = (e & 1) ? bf_hi(gb[e >> 1]) : bf_lo(gb[e >> 1]);
                    yv[e] = gbe * (cb8[e] + w0[e] * um2[e] + w1[e] * um1[e] + w2[e] * u0[e]); ss += yv[e] * yv[e]; um2[e] = um1[e]; um1[e] = u0[e]; }
                ss += __shfl_xor(ss, 1); ss += __shfl_xor(ss, 2); ss += __shfl_xor(ss, 4);
                const float rs = rsqrtf(ss * (1.f / 64.f) + 1e-6f);
                u32x4 o; o.x = cvt_pk_bf16(yv[0] * rs * gn[0], yv[1] * rs * gn[1]); o.y = cvt_pk_bf16(yv[2] * rs * gn[2], yv[3] * rs * gn[3]);
                o.z = cvt_pk_bf16(yv[4] * rs * gn[4], yv[5] * rs * gn[5]); o.w = cvt_pk_bf16(yv[6] * rs * gn[6], yv[7] * rs * gn[7]);
                *(u32x4*)(Y + (size_t)t * D + 512 + c0) = o; }
        }
    }
    SEAM(3);
    if (IN(4)) {
        att::attn_phase(vcu, G, Qb, KN, KR, Vb, Y, ong, lds);
    }
    SEAM(4);
    if (IN(5)) {
        pg8::Gemm g{Y, D, WOUT, T, D, D}; pg8::StaticOrder S; S.init(T, D, G, bx); pg8::EpiStore E4{MIX, D};
        pg8::gemm_phase<pg8::EpiStore, true>(lds, g, S, E4);
    }
    SEAM(5);
    if (IN(6)) {
        OPAQUE_LANE(ln);
        for (int row0 = gw * 16; row0 < T; row0 += NGW * 16) { const int b = row0 / SEQ; const float* mb = MOD + b * 6144;
            f32x4 gt[4], g1v[4], b1v[4], sc[4], sh[4];
#pragma unroll
            for (int j = 0; j < 4; ++j) { const int col = 4 * ln + 256 * j; gt[j] = *(const f32x4*)(mb + 2048 + col); g1v[j] = *(const f32x4*)(ln1g + col); b1v[j] = *(const f32x4*)(ln1b + col);
                sh[j] = *(const f32x4*)(mb + 3072 + col); sc[j] = *(const f32x4*)(mb + 4096 + col) + 1.f; }
            for (int rr = 0; rr < 16; ++rr) { const int t = row0 + rr;
                f32x4 v[4]; float s = 0.f;
#pragma unroll
                for (int j = 0; j < 4; ++j) { const int col = 4 * ln + 256 * j; const f32x4 xv = *(const f32x4*)(x + (size_t)t * D + col); const u32x2 mw = *(const u32x2*)(MIX + (size_t)t * D + col);
                    const f32x4 mx = {bf_lo(mw.x), bf_hi(mw.x), bf_lo(mw.y), bf_hi(mw.y)};
                    v[j] = xv * ALPHA + gt[j] * mx; s += (v[j][0] + v[j][1]) + (v[j][2] + v[j][3]); }
                float mean = wave_sum(s) * (1.f / D); float q = 0.f;
#pragma unroll
                for (int j = 0; j < 4; ++j) { v[j] = v[j] - mean; q += (v[j][0] * v[j][0] + v[j][1] * v[j][1]) + (v[j][2] * v[j][2] + v[j][3] * v[j][3]); }
                float rstd = rsqrtf(wave_sum(q) * (1.f / D) + 1e-5f);
                s = 0.f;
#pragma unroll
                for (int j = 0; j < 4; ++j) { v[j] = v[j] * rstd * g1v[j] + b1v[j]; u32x2 w; w.x = cvt_pk_bf16(v[j][0], v[j][1]); w.y = cvt_pk_bf16(v[j][2], v[j][3]); *(u32x2*)(X1 + (size_t)t * D + 4 * ln + 256 * j) = w; s += (v[j][0] + v[j][1]) + (v[j][2] + v[j][3]); }
                mean = wave_sum(s) * (1.f / D); q = 0.f;
#pragma unroll
                for (int j = 0; j < 4; ++j) { v[j] = v[j] - mean; q += (v[j][0] * v[j][0] + v[j][1] * v[j][1]) + (v[j][2] * v[j][2] + v[j][3] * v[j][3]); }
                rstd = rsqrtf(wave_sum(q) * (1.f / D) + 1e-5f);
#pragma unroll
                for (int j = 0; j < 4; ++j) { const f32x4 o = v[j] * rstd * sc[j] + sh[j]; u32x2 w; w.x = cvt_pk_bf16(o[0], o[1]); w.y = cvt_pk_bf16(o[2], o[3]);
                    *(u32x2*)(HB + (size_t)t * D + 4 * ln + 256 * j) = w; } } }
    }
    SEAM(6);
    if (IN(7)) {
        pg8::Gemm g{HB, D, WUP, T, UPW, D}; pg8::StaticOrder S; S.init(T, UPW, G, bx); pg8::EpiUp E5{ACT, E, fcw, fcb};
        pg8::gemm_phase<pg8::EpiUp, true>(lds, g, S, E5);
    }
    SEAM(7);
    if (IN(8)) {
        OPAQUE_LANE(ln);
        constexpr int NITEM = 512 * 2 * (DFF / 4);
        for (int it = (gw * 64 + ln); it < NITEM; it += NGW * 64) { const int c4 = it % (DFF / 4), rb = it / (DFF / 4), rr = rb & 1, blk = rb >> 1; const int c0 = 4 * c4;
            const bool first = (blk & 31) == 0;
            const float* e0 = E + ((size_t)blk * 4 + rr) * UPW + c0;
            const float* em1 = (rr == 0) ? E + ((size_t)(blk - 1) * 4 + 3) * UPW + c0 : E + ((size_t)blk * 4 + 0) * UPW + c0;
            const float* em2 = (rr == 0) ? E + ((size_t)(blk - 1) * 4 + 2) * UPW + c0 : E + ((size_t)(blk - 1) * 4 + 3) * UPW + c0;
            const f32x4 z = {0.f, 0.f, 0.f, 0.f};
            const f32x4 g0 = *(const f32x4*)e0, v0 = *(const f32x4*)(e0 + DFF);
            const bool has1 = !(first && rr == 0), has2 = !first;
            const f32x4 g1 = has1 ? *(const f32x4*)em1 : z, v1 = has1 ? *(const f32x4*)(em1 + DFF) : z;
            const f32x4 g2 = has2 ? *(const f32x4*)em2 : z, v2 = has2 ? *(const f32x4*)(em2 + DFF) : z;
            const f32x4 wg0 = *(const f32x4*)(fcw + c0), wg1 = *(const f32x4*)(fcw + UPW + c0), wg2 = *(const f32x4*)(fcw + 2 * UPW + c0), bg = *(const f32x4*)(fcb + c0);
            const f32x4 wv0 = *(const f32x4*)(fcw + DFF + c0), wv1 = *(const f32x4*)(fcw + UPW + DFF + c0), wv2 = *(const f32x4*)(fcw + 2 * UPW + DFF + c0), bv = *(const f32x4*)(fcb + DFF + c0);
            const f32x4 cg = bg + wg0 * g2 + wg1 * g1 + wg2 * g0, cv = bv + wv0 * v2 + wv1 * v1 + wv2 * v0;
            u32x2 w; w.x = cvt_pk_bf16(silu_f(cg[0]) * cv[0], silu_f(cg[1]) * cv[1]); w.y = cvt_pk_bf16(silu_f(cg[2]) * cv[2], silu_f(cg[3]) * cv[3]);
            *(u32x2*)(ACT + (size_t)(64 * blk + rr) * DFF + c0) = w; }
    }
    SEAM(8);
    if (IN(9)) {
        pg8::Gemm g{ACT, DFF, WDN, T, D, DFF}; pg8::StaticOrder S; S.init(T, D, G, bx); pg8::EpiStore E6{FF, D};
        pg8::gemm_phase<pg8::EpiStore, true>(lds, g, S, E6);
    }
    SEAM(9);
    if (IN(10)) {
        OPAQUE_LANE(ln);
        for (int row0 = gw * 16; row0 < T; row0 += NGW * 16) { const int b = row0 / SEQ; const float* mb = MOD + b * 6144;
            f32x4 gt[4], g2v[4], b2v[4];
#pragma unroll
            for (int j = 0; j < 4; ++j) { const int col = 4 * ln + 256 * j; gt[j] = *(const f32x4*)(mb + 5120 + col); g2v[j] = *(const f32x4*)(ln2g + col); b2v[j] = *(const f32x4*)(ln2b + col); }
            for (int rr = 0; rr < 16; ++rr) { const int t = row0 + rr;
                f32x4 v[4]; float s = 0.f;
#pragma unroll
                for (int j = 0; j < 4; ++j) { const int col = 4 * ln + 256 * j; const u32x2 xw = *(const u32x2*)(X1 + (size_t)t * D + col); const f32x4 xv = {bf_lo(xw.x), bf_hi(xw.x), bf_lo(xw.y), bf_hi(xw.y)}; const u32x2 mw = *(const u32x2*)(FF + (size_t)t * D + col);
                    const f32x4 mx = {bf_lo(mw.x), bf_hi(mw.x), bf_lo(mw.y), bf_hi(mw.y)};
                    v[j] = xv * ALPHA + gt[j] * mx; s += (v[j][0] + v[j][1]) + (v[j][2] + v[j][3]); }
                const float mean = wave_sum(s) * (1.f / D); float q = 0.f;
#pragma unroll
                for (int j = 0; j < 4; ++j) { v[j] = v[j] - mean; q += (v[j][0] * v[j][0] + v[j][1] * v[j][1]) + (v[j][2] * v[j][2] + v[j][3] * v[j][3]); }
                const float rstd = rsqrtf(wave_sum(q) * (1.f / D) + 1e-5f);
#pragma unroll
                for (int j = 0; j < 4; ++j) { *(f32x4*)(out + (size_t)t * D + 4 * ln + 256 * j) = v[j] * rstd * g2v[j] + b2v[j]; } } }
    }
#undef IN
#undef SEAM
}

extern "C" void kernel_launch(void* const* d_in, const int* in_sizes, int n_in, void* d_out, int out_size, void* d_ws, size_t ws_size, hipStream_t stream) {
    static int grid = 0;
    if (grid == 0) {
        if (n_in != 22 || in_sizes[0] != T * D || out_size != T * D || ws_size < WS_END) { fprintf(stderr, "kernel_launch: unexpected shapes / workspace (n_in %d, ws %zu)\n", n_in, ws_size); grid = -1; return; }
        int dev = 0, cus = 0, per_cu = 0;
        if (hipGetDevice(&dev) != hipSuccess || hipDeviceGetAttribute(&cus, hipDeviceAttributeMultiprocessorCount, dev) != hipSuccess) { grid = -1; return; }
        if (hipFuncSetAttribute((const void*)mk_fwd, hipFuncAttributeMaxDynamicSharedMemorySize, LDS_BYTES) != hipSuccess) { fprintf(stderr, "kernel_launch: hipFuncSetAttribute failed\n"); grid = -1; return; }
        if (hipOccupancyMaxActiveBlocksPerMultiprocessor(&per_cu, (const void*)mk_fwd, 512, LDS_BYTES) != hipSuccess || per_cu < 1) { fprintf(stderr, "kernel_launch: occupancy query says %d blocks per CU\n", per_cu); (void)hipGetLastError(); grid = -1; return; }
        grid = cus;
    }
    if (grid < 0) return;
    hipMemsetAsync((char*)d_ws + WS_CTL, 0, CTL_ZERO_BYTES, stream);
    Args a{};
    for (int i = 0; i < 22; ++i) a.in[i] = (const float*)d_in[i];
    a.pos = (const int*)d_in[2]; a.out = (float*)d_out; a.ws = (unsigned char*)d_ws;
#if MK_N_LAUNCHES == 1
    a.ph_lo = 0; a.ph_hi = N_PHASES;
    hipLaunchKernelGGL(mk_fwd, dim3(grid), dim3(512), LDS_BYTES, stream, a);
#else
    for (int p = 0; p < N_PHASES; ++p) { a.ph_lo = p; a.ph_hi = p + 1; hipLaunchKernelGGL(mk_fwd, dim3(grid), dim3(512), LDS_BYTES, stream, a); }
#endif
}
```

```cpp
#include <hip/hip_runtime.h>
#include <cstdio>
#include <cstdint>

#define LAS __attribute__((address_space(3)))
#define GAS __attribute__((address_space(1)))
typedef unsigned short bf16_t;
typedef short bf16x8 __attribute__((ext_vector_type(8)));
typedef short s16x4 __attribute__((ext_vector_type(4)));
typedef float f32x4 __attribute__((ext_vector_type(4)));
typedef float f32x2 __attribute__((ext_vector_type(2)));
typedef float f32x16 __attribute__((ext_vector_type(16)));
typedef unsigned u32x4 __attribute__((ext_vector_type(4)));
typedef unsigned u32x2 __attribute__((ext_vector_type(2)));
typedef GAS unsigned gu32;

#ifndef MK_N_LAUNCHES
#define MK_N_LAUNCHES 1
#endif

constexpr int D = 1024, NB = 16, SEQ = 2048, T = NB * SEQ, NH = 8, DFF = 2816, UPW = 2 * DFF;
constexpr int PW = 1024;
constexpr int G1N = 2048;
constexpr int QW = 768, INW = 1952;
constexpr float ALPHA = 1.189207115002721f;
constexpr float QSCALE = 0.10206207261596575f * 1.4426950408889634f;
constexpr float LOG2E = 1.4426950408889634f;

constexpr size_t MiB = 1u << 20;
constexpr size_t WS_CTL = 0, CTL_ZERO_BYTES = 64 * 1024;
constexpr size_t WS_MOD = 1 * MiB;
constexpr size_t WS_ROPE = 2 * MiB;
constexpr size_t WS_SSQQ = 6 * MiB;
constexpr size_t WS_SSQKV = 6 * MiB + 512 * 1024;
constexpr size_t WS_WIN = 8 * MiB;
constexpr size_t WS_WQ = 12 * MiB;
constexpr size_t WS_WKV = 12 * MiB + 512 * 1024;
constexpr size_t WS_WOUT = 13 * MiB;
constexpr size_t WS_WUP = 15 * MiB;
constexpr size_t WS_WDN = 26 * MiB;
constexpr size_t WS_HB = 32 * MiB;
constexpr size_t WS_FF = 32 * MiB;
constexpr size_t WS_P = 96 * MiB;
constexpr size_t WS_U = 160 * MiB;
constexpr size_t WS_MIX = 96 * MiB;
constexpr size_t WS_Q = 224 * MiB;
constexpr size_t WS_KN = 272 * MiB;
constexpr size_t WS_KR = 304 * MiB;
constexpr size_t WS_V = 306 * MiB;
constexpr size_t WS_Y = 338 * MiB;
constexpr size_t WS_X1 = 338 * MiB;
constexpr size_t WS_ACT = 96 * MiB;
constexpr size_t WS_E = 272 * MiB;
constexpr size_t WS_END = 402 * MiB;
constexpr int CW_BAR = 1024;

constexpr int RING_BYTES = 131072, LDSCTL_OFF = RING_BYTES, MISC_OFF = LDSCTL_OFF + 320, LDS_BYTES = 147456;

__device__ __forceinline__ unsigned cvt_pk_bf16(float lo, float hi) { unsigned r; asm volatile("v_cvt_pk_bf16_f32 %0, %1, %2" : "=v"(r) : "v"(lo), "v"(hi)); return r; }
__device__ __forceinline__ float bf_lo(unsigned u) { return __uint_as_float(u << 16); }
__device__ __forceinline__ float bf_hi(unsigned u) { return __uint_as_float(u & 0xffff0000u); }
__device__ __forceinline__ float fexp2(float x) { return __builtin_amdgcn_exp2f(x); }
__device__ __forceinline__ float frcp(float x) { return __builtin_amdgcn_rcpf(x); }
__device__ __forceinline__ float silu_f(float v) { return v * frcp(1.f + fexp2(-LOG2E * v)); }
__device__ __forceinline__ float wave_sum(float v) {
#pragma unroll
    for (int o = 1; o < 64; o <<= 1) v += __shfl_xor(v, o);
    return v;
}

namespace pg8 {
constexpr int BM = 256, BK = 64, HALF = 128, HTB = HALF * BK * 2, STAGE_BYTES = 8 * HTB, NXCD = 8, WGM = 8;
__host__ __device__ __forceinline__ int lds_byte(int r, int c) { const int st = (r >> 4) * 2 + (c >> 5), rr = r & 15, cc = c & 31, ob = rr * 64 + cc * 2; return st * 1024 + (ob ^ (((ob >> 9) & 1) << 5)); }
__host__ __device__ __forceinline__ void stage_rc(int b, int& R, int& C) { const int st = b / 1024, sb = b % 1024, swz = sb ^ (((sb >> 9) & 1) << 5); R = (st >> 1) * 16 + swz / 64; C = (st & 1) * 32 + (swz % 64) / 2; }
__host__ __device__ __forceinline__ int perm32(int rho) { const int n = rho >> 4, i = rho & 15; return 8 * (i >> 2) + 4 * n + (i & 3); }

struct Unit { int pm, pn; };
struct Gemm { const bf16_t* A; int lda; const bf16_t* Bt; int M, N, K; };

struct StaticOrder {
    int nM, nN, nwg, G, c;
    __device__ __forceinline__ void init(int M, int N, int G_, int c_) { nM = M / BM; nN = N / BM; nwg = nM * nN; G = G_; c = c_; }
    __device__ __forceinline__ bool next(int i, Unit& u) const {
        const long L = (long)i * G + c; if (L >= nwg) return false;
        int wgid = (int)L; { const int q = nwg / NXCD, r = nwg % NXCD, xcd = wgid % NXCD, off = wgid / NXCD; wgid = (xcd < r ? xcd * (q + 1) : r * (q + 1) + (xcd - r) * q) + off; }
        const int nig = WGM * nN, gid = wgid / nig, fm = gid * WGM, gsz = (nM - fm) < WGM ? (nM - fm) : WGM;
        u.pm = fm + ((wgid % nig) % gsz); u.pn = (wgid % nig) / gsz; return true;
    }
};

template <class Epi, bool ALIGN_EPI>
__device__ __forceinline__ void gemm_phase(LAS unsigned char* lds, const Gemm g, const StaticOrder& S, const Epi& E) {
    int tid = threadIdx.x; asm volatile("" : "+v"(tid));
    const int wid = __builtin_amdgcn_readfirstlane(tid >> 6), lane = tid & 63, wr = wid >> 2, wc = wid & 3, fr = lane & 15, fq = lane >> 4;
    const int K = g.K, nt = K / BK;
    unsigned voffA[2], voffB[2];
#pragma unroll
    for (int i = 0; i < 2; ++i) { int R, C; stage_rc(tid * 16 + i * 8192, R, C);
        voffA[i] = (unsigned)(R * g.lda + C) * 2u; voffB[i] = (unsigned)(R * K + C) * 2u; }
    const size_t kstep = (size_t)(BK * 2);
    const size_t hstepA = (size_t)HALF * g.lda * 2, hstepB = (size_t)HALF * K * 2;
    const size_t tstepA = 2 * hstepA, tstepB = 2 * hstepB;
    const unsigned ldsw = (unsigned)wid * 1024u;
    const int aoff = lds_byte(wr * 64 + fr, fq * 8), boff = lds_byte(wc * 32 + fr, fq * 8);
#define PG8_SA(b, h) (((b) * 2 + (h)) * HTB)
#define PG8_SB(b, h) ((4 + (b) * 2 + (h)) * HTB)
#define PG8_STAGE(bufoff, gbase, voff) do { _Pragma("unroll") for (int _i = 0; _i < 2; ++_i) \
        __builtin_amdgcn_global_load_lds((const unsigned*)((const char*)(gbase) + (voff)[_i]), (LAS unsigned*)(lds + (bufoff) + ldsw + _i * 8192), 16, 0, 0); } while (0)
#define PG8_LDA(dst, b, h) do { _Pragma("unroll") for (int m = 0; m < 4; ++m) _Pragma("unroll") for (int k = 0; k < 2; ++k) dst[m][k] = *(const LAS bf16x8*)(lds + PG8_SA(b, h) + aoff + m * 2048 + k * 1024); } while (0)
#define PG8_LDB(dst, b, h) do { _Pragma("unroll") for (int n = 0; n < 2; ++n) _Pragma("unroll") for (int k = 0; k < 2; ++k) dst[n][k] = *(const LAS bf16x8*)(lds + PG8_SB(b, h) + boff + n * 2048 + k * 1024); } while (0)
#define PG8_MMA(ai, bj, At, Bt) do { __builtin_amdgcn_s_setprio(1); _Pragma("unroll") for (int m = 0; m < 4; ++m) _Pragma("unroll") for (int n = 0; n < 2; ++n) _Pragma("unroll") for (int k = 0; k < 2; ++k) \
        acc[ai][bj][m][n] = __builtin_amdgcn_mfma_f32_16x16x32_bf16(Bt[n][k], At[m][k], acc[ai][bj][m][n], 0, 0, 0); __builtin_amdgcn_s_setprio(0); } while (0)
#define PG8_WAIT_V(n) asm volatile("s_waitcnt vmcnt(" #n ")" ::: "memory")
#define PG8_WAIT_L(n) asm volatile("s_waitcnt lgkmcnt(" #n ")" ::: "memory")
#define PG8_BAR __builtin_amdgcn_s_barrier()
#define PG8_SCHED __builtin_amdgcn_sched_barrier(0)
    Unit cur, nxt; int ui = 0;
    if (!S.next(0, cur)) return;
    f32x4 acc[2][2][4][2];
#pragma unroll
    for (int a = 0; a < 2; ++a)
#pragma unroll
        for (int b = 0; b < 2; ++b)
#pragma unroll
            for (int m = 0; m < 4; ++m)
#pragma unroll
                for (int n = 0; n < 2; ++n) acc[a][b][m][n] = (f32x4){0.f, 0.f, 0.f, 0.f};
    bf16x8 At[4][2], B0[2][2], B1[2][2];
    const char* cA = (const char*)g.A + (size_t)cur.pm * tstepA; const char* cB = (const char*)g.Bt + (size_t)cur.pn * tstepB;
    if constexpr (Epi::HAS_PREFETCH) E.prefetch(cur, 0, lds, wid, lane);
    PG8_STAGE(PG8_SB(0, 0), cB, voffB); PG8_STAGE(PG8_SB(0, 1), cB + hstepB, voffB); PG8_STAGE(PG8_SA(0, 0), cA, voffA); PG8_STAGE(PG8_SA(0, 1), cA + hstepA, voffA);
    if (wr == 1) PG8_BAR;
    PG8_WAIT_V(2); PG8_BAR;
    PG8_STAGE(PG8_SB(1, 0), cB + kstep, voffB); PG8_STAGE(PG8_SA(1, 0), cA + kstep, voffA); PG8_STAGE(PG8_SB(1, 1), cB + hstepB + kstep, voffB);
    PG8_WAIT_V(6); PG8_BAR;
    for (;;) {
        const bool has_next = S.next(ui + 1, nxt);
        const char* nA = has_next ? (const char*)g.A + (size_t)nxt.pm * tstepA : cA; const char* nB = has_next ? (const char*)g.Bt + (size_t)nxt.pn * tstepB : cB;
#pragma nounroll
        for (int t = 0; t < nt; t += 2) {
            const bool last = (t == nt - 2);
            const char* a1 = cA + (size_t)(t + 1) * kstep;
            const char* a2 = last ? nA : cA + (size_t)(t + 2) * kstep; const char* b2 = last ? nB : cB + (size_t)(t + 2) * kstep;
            const char* a3 = a2 + kstep; const char* b3 = b2 + kstep;
            const bool rlx = (Epi::NST > 0) && (t == 0) && (ui > 0);
            PG8_LDB(B0, 0, 0); PG8_LDB(B1, 0, 1); PG8_SCHED; PG8_LDA(At, 0, 0); PG8_STAGE(PG8_SA(1, 1), a1 + hstepA, voffA);
            if (rlx) { if constexpr (Epi::NST >= 16) PG8_WAIT_V(24); else PG8_WAIT_V(16); } else PG8_WAIT_V(8);
            PG8_WAIT_L(0); PG8_BAR; PG8_MMA(0, 0, At, B0); PG8_MMA(0, 1, At, B1); PG8_BAR; PG8_SCHED;
            PG8_LDA(At, 0, 1); PG8_STAGE(PG8_SB(0, 0), b2, voffB); PG8_STAGE(PG8_SB(0, 1), b2 + hstepB, voffB); PG8_STAGE(PG8_SA(0, 0), a2, voffA);
            if (rlx) { if constexpr (Epi::NST >= 16) PG8_WAIT_V(24); else PG8_WAIT_V(16); } else PG8_WAIT_V(8);
            PG8_WAIT_L(0); PG8_BAR; PG8_MMA(1, 0, At, B0); PG8_MMA(1, 1, At, B1); PG8_BAR; PG8_SCHED;
            PG8_LDB(B0, 1, 0); PG8_LDB(B1, 1, 1); PG8_SCHED; PG8_LDA(At, 1, 0); PG8_STAGE(PG8_SA(0, 1), a2 + hstepA, voffA);
            PG8_WAIT_V(8); PG8_WAIT_L(0); PG8_BAR; PG8_MMA(0, 0, At, B0); PG8_MMA(0, 1, At, B1); PG8_BAR; PG8_SCHED;
            PG8_LDA(At, 1, 1); PG8_STAGE(PG8_SB(1, 0), b3, voffB); PG8_STAGE(PG8_SB(1, 1), b3 + hstepB, voffB); PG8_STAGE(PG8_SA(1, 0), a3, voffA);
            PG8_WAIT_V(8); PG8_WAIT_L(0); PG8_BAR; PG8_MMA(1, 0, At, B0); PG8_MMA(1, 1, At, B1); PG8_BAR; PG8_SCHED;
        }
        if constexpr (ALIGN_EPI) { if (wr == 0) PG8_BAR; }
        { int t_e = threadIdx.x; asm volatile("" : "+v"(t_e)); const int fr_e = t_e & 15, fq_e = (t_e >> 4) & 3;
          if constexpr (Epi::HAS_PREFETCH) { if (has_next) E.prefetch(nxt, (ui + 1) & 1, lds, wid, t_e & 63); E.run(acc, cur, wr, wc, fr_e, fq_e, lds, ui & 1); }
          else E(acc, cur, wr, wc, fr_e, fq_e); }
        if (!has_next) break;
#pragma unroll
        for (int a = 0; a < 2; ++a)
#pragma unroll
            for (int b = 0; b < 2; ++b)
#pragma unroll
                for (int m = 0; m < 4; ++m)
#pragma unroll
                    for (int n = 0; n < 2; ++n) acc[a][b][m][n] = (f32x4){0.f, 0.f, 0.f, 0.f};
        cur = nxt; cA = nA; cB = nB; ++ui;
        if constexpr (ALIGN_EPI) { if (wr == 1) PG8_BAR; }
    }
    PG8_WAIT_V(0);
    if constexpr (!ALIGN_EPI) { if (wr == 0) PG8_BAR; }
    PG8_BAR;
#undef PG8_SA
#undef PG8_SB
#undef PG8_STAGE
#undef PG8_LDA
#undef PG8_LDB
#undef PG8_MMA
#undef PG8_WAIT_V
#undef PG8_WAIT_L
#undef PG8_BAR
#undef PG8_SCHED
}

struct MUnit { const char* A; const char* B; int nt; unsigned kb2; int type; Unit u; };
template <class Sched, class Disp>
__device__ __forceinline__ void gemm_multi(LAS unsigned char* lds, const Sched& S, const Disp& E) {
    int tid = threadIdx.x; asm volatile("" : "+v"(tid));
    const int wid = __builtin_amdgcn_readfirstlane(tid >> 6), lane = tid & 63, wr = wid >> 2, wc = wid & 3, fr = lane & 15, fq = lane >> 4;
    unsigned voffA[2], rB[2], cB2[2];
#pragma unroll
    for (int i = 0; i < 2; ++i) { int R, C; stage_rc(tid * 16 + i * 8192, R, C); voffA[i] = (unsigned)(R * 1024 + C) * 2u; rB[i] = (unsigned)R; cB2[i] = (unsigned)C * 2u; }
    const size_t kstep = (size_t)(BK * 2);
    const size_t hstepA = (size_t)HALF * 1024 * 2;
    const unsigned ldsw = (unsigned)wid * 1024u;
    const int aoff = lds_byte(wr * 64 + fr, fq * 8), boff = lds_byte(wc * 32 + fr, fq * 8);
#define PG8_SA(b, h) (((b) * 2 + (h)) * HTB)
#define PG8_SB(b, h) ((4 + (b) * 2 + (h)) * HTB)
#define PG8_STAGE(bufoff, gbase, voff) do { _Pragma("unroll") for (int _i = 0; _i < 2; ++_i) \
        __builtin_amdgcn_global_load_lds((const unsigned*)((const char*)(gbase) + (voff)[_i]), (LAS unsigned*)(lds + (bufoff) + ldsw + _i * 8192), 16, 0, 0); } while (0)
#define PG8_LDA(dst, b, h) do { _Pragma("unroll") for (int m = 0; m < 4; ++m) _Pragma("unroll") for (int k = 0; k < 2; ++k) dst[m][k] = *(const LAS bf16x8*)(lds + PG8_SA(b, h) + aoff + m * 2048 + k * 1024); } while (0)
#define PG8_LDB(dst, b, h) do { _Pragma("unroll") for (int n = 0; n < 2; ++n) _Pragma("unroll") for (int k = 0; k < 2; ++k) dst[n][k] = *(const LAS bf16x8*)(lds + PG8_SB(b, h) + boff + n * 2048 + k * 1024); } while (0)
#define PG8_MMA(ai, bj, At, Bt) do { __builtin_amdgcn_s_setprio(1); _Pragma("unroll") for (int m = 0; m < 4; ++m) _Pragma("unroll") for (int n = 0; n < 2; ++n) _Pragma("unroll") for (int k = 0; k < 2; ++k) \
        acc[ai][bj][m][n] = __builtin_amdgcn_mfma_f32_16x16x32_bf16(Bt[n][k], At[m][k], acc[ai][bj][m][n], 0, 0, 0); __builtin_amdgcn_s_setprio(0); } while (0)
#define PG8_WAIT_V(n) asm volatile("s_waitcnt vmcnt(" #n ")" ::: "memory")
#define PG8_WAIT_L(n) asm volatile("s_waitcnt lgkmcnt(" #n ")" ::: "memory")
#define PG8_BAR __builtin_amdgcn_s_barrier()
#define PG8_SCHED __builtin_amdgcn_sched_barrier(0)
    MUnit cur, nxt; int ui = 0; int relax = 0;
    if (!S.next(0, cur)) return;
    f32x4 acc[2][2][4][2];
#pragma unroll
    for (int a = 0; a < 2; ++a)
#pragma unroll
        for (int b = 0; b < 2; ++b)
#pragma unroll
            for (int m = 0; m < 4; ++m)
#pragma unroll
                for (int n = 0; n < 2; ++n) acc[a][b][m][n] = (f32x4){0.f, 0.f, 0.f, 0.f};
    bf16x8 At[4][2], B0[2][2], B1[2][2];
    const char* cA = cur.A; const char* cB = cur.B;
    E.prefetch(cur, 0, lds, wid, lane);
    unsigned voffB[2]; voffB[0] = rB[0] * cur.kb2 + cB2[0]; voffB[1] = rB[1] * cur.kb2 + cB2[1];
    size_t hstepB = (size_t)HALF * cur.kb2;
    PG8_STAGE(PG8_SB(0, 0), cB, voffB); PG8_STAGE(PG8_SB(0, 1), cB + hstepB, voffB); PG8_STAGE(PG8_SA(0, 0), cA, voffA); PG8_STAGE(PG8_SA(0, 1), cA + hstepA, voffA);
    if (wr == 1) PG8_BAR;
    PG8_WAIT_V(2); PG8_BAR;
    PG8_STAGE(PG8_SB(1, 0), cB + kstep, voffB); PG8_STAGE(PG8_SA(1, 0), cA + kstep, voffA); PG8_STAGE(PG8_SB(1, 1), cB + hstepB + kstep, voffB);
    PG8_WAIT_V(6); PG8_BAR;
    for (;;) {
        const bool has_next = S.next(ui + 1, nxt);
        if (!has_next) nxt = cur;
        const char* nA = nxt.A; const char* nB = nxt.B;
        unsigned nvoffB[2]; nvoffB[0] = rB[0] * nxt.kb2 + cB2[0]; nvoffB[1] = rB[1] * nxt.kb2 + cB2[1];
        const size_t nhstepB = (size_t)HALF * nxt.kb2;
        const int nt = cur.nt;
#pragma nounroll
        for (int t = 0; t < nt; t += 2) {
            const bool last = (t == nt - 2);
            const char* a1 = cA + (size_t)(t + 1) * kstep;
            const char* a2 = last ? nA : cA + (size_t)(t + 2) * kstep; const char* b2 = last ? nB : cB + (size_t)(t + 2) * kstep;
            const char* a3 = a2 + kstep; const char* b3 = b2 + kstep;
            unsigned vB2[2]; vB2[0] = last ? nvoffB[0] : voffB[0]; vB2[1] = last ? nvoffB[1] : voffB[1];
            const size_t hB2 = last ? nhstepB : hstepB;
            const int rlx = (t == 0) ? relax : 0;
            PG8_LDB(B0, 0, 0); PG8_LDB(B1, 0, 1); PG8_SCHED; PG8_LDA(At, 0, 0); PG8_STAGE(PG8_SA(1, 1), a1 + hstepA, voffA);
            if (rlx >= 16) PG8_WAIT_V(24); else if (rlx >= 8) PG8_WAIT_V(16); else PG8_WAIT_V(8);
            PG8_WAIT_L(0); PG8_BAR; PG8_MMA(0, 0, At, B0); PG8_MMA(0, 1, At, B1); PG8_BAR; PG8_SCHED;
            PG8_LDA(At, 0, 1); PG8_STAGE(PG8_SB(0, 0), b2, vB2); PG8_STAGE(PG8_SB(0, 1), b2 + hB2, vB2); PG8_STAGE(PG8_SA(0, 0), a2, voffA);
            if (rlx >= 16) PG8_WAIT_V(24); else if (rlx >= 8) PG8_WAIT_V(16); else PG8_WAIT_V(8);
            PG8_WAIT_L(0); PG8_BAR; PG8_MMA(1, 0, At, B0); PG8_MMA(1, 1, At, B1); PG8_BAR; PG8_SCHED;
            PG8_LDB(B0, 1, 0); PG8_LDB(B1, 1, 1); PG8_SCHED; PG8_LDA(At, 1, 0); PG8_STAGE(PG8_SA(0, 1), a2 + hstepA, voffA);
            PG8_WAIT_V(8); PG8_WAIT_L(0); PG8_BAR; PG8_MMA(0, 0, At, B0); PG8_MMA(0, 1, At, B1); PG8_BAR; PG8_SCHED;
            PG8_LDA(At, 1, 1); PG8_STAGE(PG8_SB(1, 0), b3, vB2); PG8_STAGE(PG8_SB(1, 1), b3 + hB2, vB2); PG8_STAGE(PG8_SA(1, 0), a3, voffA);
            PG8_WAIT_V(8); PG8_WAIT_L(0); PG8_BAR; PG8_MMA(1, 0, At, B0); PG8_MMA(1, 1, At, B1); PG8_BAR; PG8_SCHED;
        }
        if (wr == 0) PG8_BAR;
        { int t_e = threadIdx.x; asm volatile("" : "+v"(t_e)); if (has_next) E.prefetch(nxt, (ui + 1) & 1, lds, wid, t_e & 63); E(acc, cur, wr, wc, t_e & 15, (t_e >> 4) & 3, lds, ui & 1); }
        if (!has_next) break;
#pragma unroll
        for (int a = 0; a < 2; ++a)
#pragma unroll
            for (int b = 0; b < 2; ++b)
#pragma unroll
                for (int m = 0; m < 4; ++m)
#pragma unroll
                    for (int n = 0; n < 2; ++n) acc[a][b][m][n] = (f32x4){0.f, 0.f, 0.f, 0.f};
        relax = (cur.type == 0 && cur.u.pn >= 4) ? 8 : 16;
        cur = nxt; cA = nA; cB = nB; voffB[0] = nvoffB[0]; voffB[1] = nvoffB[1]; hstepB = nhstepB; ++ui;
        if (wr == 1) PG8_BAR;
    }
    PG8_WAIT_V(0);
    PG8_BAR;
#undef PG8_SA
#undef PG8_SB
#undef PG8_STAGE
#undef PG8_LDA
#undef PG8_LDB
#undef PG8_MMA
#undef PG8_WAIT_V
#undef PG8_WAIT_L
#undef PG8_BAR
#undef PG8_SCHED
}

typedef f32x4 Acc[2][2][4][2];

struct EpiStore { static constexpr bool HAS_PREFETCH = false; static constexpr int NST = 16;
    bf16_t* O; int ldc;
    __device__ __forceinline__ void operator()(const Acc& acc, const Unit& u, int wr, int wc, int fr, int fq) const {
        const int row0 = u.pm * BM + wr * 64 + fr, col0 = u.pn * BM + wc * 32 + 8 * fq;
#pragma unroll
        for (int ai = 0; ai < 2; ++ai)
#pragma unroll
            for (int m = 0; m < 4; ++m) { bf16_t* rowp = O + (size_t)(row0 + ai * HALF + m * 16) * ldc + col0;
#pragma unroll
                for (int bj = 0; bj < 2; ++bj) { const f32x4 v0 = acc[ai][bj][m][0], v1 = acc[ai][bj][m][1];
                    u32x4 w; w.x = cvt_pk_bf16(v0[0], v0[1]); w.y = cvt_pk_bf16(v0[2], v0[3]); w.z = cvt_pk_bf16(v1[0], v1[1]); w.w = cvt_pk_bf16(v1[2], v1[3]);
                    *(u32x4*)(rowp + bj * HALF) = w; } }
    }
};

struct EpiP { static constexpr bool HAS_PREFETCH = false, AFTER_DRAIN = false; static constexpr int NST = 8;
    bf16_t* O; bf16_t* U; float* ssq_q; float* ssq_kv;
    __device__ __forceinline__ void operator()(const Acc& acc, const Unit& u, int wr, int wc, int fr, int fq) const {
        const int row0 = u.pm * BM + wr * 64 + fr;
        if (u.pn >= 4) {
            bf16_t* ucol = U + 128 * (u.pn - 4) + 32 * wc + 8 * fq;
#pragma unroll
            for (int ai = 0; ai < 2; ++ai)
#pragma unroll
                for (int m = 0; m < 4; ++m) { const f32x4 v0 = acc[ai][0][m][0] * acc[ai][1][m][0], v1 = acc[ai][0][m][1] * acc[ai][1][m][1];
                    u32x4 w; w.x = cvt_pk_bf16(v0[0], v0[1]); w.y = cvt_pk_bf16(v0[2], v0[3]); w.z = cvt_pk_bf16(v1[0], v1[1]); w.w = cvt_pk_bf16(v1[2], v1[3]);
                    *(u32x4*)(ucol + (size_t)(row0 + ai * HALF + m * 16) * 512) = w; }
            return;
        }
        EpiStore st{O, PW}; st(acc, u, wr, wc, fr, fq);
        if (u.pn <= 1) {
            float* dst = (u.pn == 0) ? ssq_q : ssq_kv;
#pragma unroll
            for (int ai = 0; ai < 2; ++ai)
#pragma unroll
                for (int m = 0; m < 4; ++m) { float s = 0.f;
#pragma unroll
                    for (int n = 0; n < 2; ++n) { const f32x4 a = acc[ai][0][m][n]; s += (a[0] * a[0] + a[1] * a[1]) + (a[2] * a[2] + a[3] * a[3]); }
                    if (u.pn == 0) {
#pragma unroll
                        for (int n = 0; n < 2; ++n) { const f32x4 a = acc[ai][1][m][n]; s += (a[0] * a[0] + a[1] * a[1]) + (a[2] * a[2] + a[3] * a[3]); } }
                    s += __shfl_xor(s, 16); s += __shfl_xor(s, 32);
                    if (fq == 0) dst[(size_t)(row0 + ai * HALF + m * 16) * 4 + wc] = s; }
        }
    }
};

struct EpiQ { static constexpr bool HAS_PREFETCH = false, AFTER_DRAIN = false; static constexpr int NST = 0;
    bf16_t* Q; const float* ssq; const float* rope;
    __device__ __forceinline__ void operator()(const Acc& acc, const Unit& u, int wr, int wc, int fr, int fq) const {
        const int row0 = u.pm * BM + wr * 64 + fr;
        float f[2][4];
        { f32x4 sp[2][4];
#pragma unroll
          for (int ai = 0; ai < 2; ++ai)
#pragma unroll
              for (int m = 0; m < 4; ++m) sp[ai][m] = *(const f32x4*)(ssq + (size_t)(row0 + ai * HALF + m * 16) * 4);
#pragma unroll
          for (int ai = 0; ai < 2; ++ai)
#pragma unroll
              for (int m = 0; m < 4; ++m) f[ai][m] = rsqrtf(((sp[ai][m][0] + sp[ai][m][1]) + (sp[ai][m][2] + sp[ai][m][3])) * (1.f / 256.f) + 1e-6f) * QSCALE; }
#pragma unroll
        for (int bj = 0; bj < 2; ++bj) { const int g = 8 * u.pn + 4 * bj + wc; const bool is_rope = (g % 3) == 2;
            bf16_t* qcol = Q + 32 * g;
            if (!is_rope) {
#pragma unroll
                for (int ai = 0; ai < 2; ++ai)
#pragma unroll
                    for (int m = 0; m < 4; ++m) { const int t = row0 + ai * HALF + m * 16;
                        const f32x4 v0 = acc[ai][bj][m][0] * f[ai][m], v1 = acc[ai][bj][m][1] * f[ai][m];
                        u32x4 w; w.x = cvt_pk_bf16(v0[0], v0[1]); w.y = cvt_pk_bf16(v0[2], v0[3]); w.z = cvt_pk_bf16(v1[0], v1[1]); w.w = cvt_pk_bf16(v1[2], v1[3]);
                        *(u32x4*)(qcol + (size_t)t * QW + 8 * fq) = w; }
            } else {
#pragma unroll
                for (int ai = 0; ai < 2; ++ai) { f32x4 cs[4], sn[4];
#pragma unroll
                    for (int m = 0; m < 4; ++m) { const int t = row0 + ai * HALF + m * 16; cs[m] = *(const f32x4*)(rope + (size_t)t * 32 + 4 * fq); sn[m] = *(const f32x4*)(rope + (size_t)t * 32 + 16 + 4 * fq); }
#pragma unroll
                    for (int m = 0; m < 4; ++m) { const int t = row0 + ai * HALF + m * 16;
                        const f32x4 a0 = acc[ai][bj][m][0], a1 = acc[ai][bj][m][1];
                        const f32x4 o1 = (a0 * cs[m] - a1 * sn[m]) * f[ai][m], o2 = (a1 * cs[m] + a0 * sn[m]) * f[ai][m];
                        u32x2 w1, w2; w1.x = cvt_pk_bf16(o1[0], o1[1]); w1.y = cvt_pk_bf16(o1[2], o1[3]); w2.x = cvt_pk_bf16(o2[0], o2[1]); w2.y = cvt_pk_bf16(o2[2], o2[3]);
                        *(u32x2*)(qcol + (size_t)t * QW + 4 * fq) = w1; *(u32x2*)(qcol + (size_t)t * QW + 16 + 4 * fq) = w2; }
                    asm volatile("" ::: "memory"); }
            } }
    }
};

constexpr int SSQ_LDS = RING_BYTES + 1024;
struct EpiKV { static constexpr bool HAS_PREFETCH = false, AFTER_DRAIN = false; static constexpr int NST = 16;
    bf16_t* KN; bf16_t* V;
    __device__ __forceinline__ void operator()(const Acc& acc, const Unit& u, int wr, int wc, int fr, int fq, LAS unsigned char* lds, int buf) const {
        const int b = u.pm >> 3;
        const LAS f32x4* sq = (const LAS f32x4*)(lds + SSQ_LDS + buf * 4096) + wr * 64 + fr;
        float f[2][4];
#pragma unroll
        for (int ai = 0; ai < 2; ++ai)
#pragma unroll
            for (int m = 0; m < 4; ++m) { const f32x4 sp = sq[ai * HALF + m * 16]; f[ai][m] = rsqrtf(((sp[0] + sp[1]) + (sp[2] + sp[3])) * (1.f / 128.f) + 1e-6f); }
#pragma unroll
        for (int bj = 0; bj < 2; ++bj) { const int g = 8 * u.pn + 4 * bj + wc, head = g >> 2, part = g & 3;
            char* base = (part < 2) ? (char*)KN + (4 * part + fq) * 1024 + fr * 16 : (char*)V + (part - 2) * 4096 + fr * 64 + fq * 16;
            const int mstep = (part < 2) ? 256 : 1024;
            base += (size_t)(b * 8 + head) * 32 * 8192;
#pragma unroll
            for (int ai = 0; ai < 2; ++ai) { const int tile = (4 * u.pm + 2 * ai + wr) & 31;
#pragma unroll
                for (int m = 0; m < 4; ++m) {
                    const f32x4 v0 = acc[ai][bj][m][0] * f[ai][m], v1 = acc[ai][bj][m][1] * f[ai][m];
                    u32x4 w; w.x = cvt_pk_bf16(v0[0], v0[1]); w.y = cvt_pk_bf16(v0[2], v0[3]); w.z = cvt_pk_bf16(v1[0], v1[1]); w.w = cvt_pk_bf16(v1[2], v1[3]);
                    *(u32x4*)(base + (size_t)tile * 8192 + m * mstep) = w; } } }
    }
};

struct MixedOrder {
    const char* HB; const char* P; const char* WIN; const char* WQ; const char* WKV; int G, c;
    __device__ __forceinline__ void set_long(int k, MUnit& m) const { const int li = k * G + c, w = (li % NXCD) * 96 + li / NXCD, pm = w / 6, pn = 2 + w % 6;
        m.A = HB + (size_t)pm * (256 * 1024 * 2); m.B = WIN + (size_t)pn * (256 * 1024 * 2); m.nt = 16; m.kb2 = 2048u; m.type = 0; m.u.pm = pm; m.u.pn = pn; }
    __device__ __forceinline__ void set_short(int k, MUnit& m) const { const int si = k * G + c, s = (si % NXCD) * 112 + si / NXCD;
        if (s < 384) { const int pm = s / 3, pn = s % 3; m.A = P + (size_t)pm * (256 * 1024 * 2); m.B = WQ + (size_t)pn * (256 * 256 * 2); m.nt = 4; m.kb2 = 512u; m.type = 1; m.u.pm = pm; m.u.pn = pn; }
        else { const int s2 = s - 384, pm = s2 >> 2, pn = s2 & 3; m.A = P + 512 + (size_t)pm * (256 * 1024 * 2); m.B = WKV + (size_t)pn * (256 * 256 * 2); m.nt = 4; m.kb2 = 512u; m.type = 2; m.u.pm = pm; m.u.pn = pn; } }
    __device__ __forceinline__ bool next(int i, MUnit& m) const {
        const int ns = (c < 128) ? 4 : 3; if (i >= 3 + ns) return false;
        const int k = i >> 1; const bool even = (c & 1) == 0;
        if (i == 6) { set_short(3, m); return true; }
        if (even == ((i & 1) == 0)) set_long(k, m); else set_short(k, m);
        return true;
    }
};
struct EpiMix { EpiP p; EpiStore q; EpiKV kv; const float* ssqkv;
    __device__ __forceinline__ void prefetch(const MUnit& m, int buf, LAS unsigned char* lds, int wid, int lane) const {
        if (m.type == 2 && wid < 4) __builtin_amdgcn_global_load_lds((const unsigned*)(ssqkv + (size_t)m.u.pm * 1024 + wid * 256 + lane * 4), (LAS unsigned*)(lds + SSQ_LDS + buf * 4096 + wid * 1024), 16, 0, 0);
    }
    __device__ __forceinline__ void operator()(const Acc& acc, const MUnit& m, int wr, int wc, int fr, int fq, LAS unsigned char* lds, int buf) const {
        if (m.type == 0) p(acc, m.u, wr, wc, fr, fq); else if (m.type == 1) q(acc, m.u, wr, wc, fr, fq); else kv(acc, m.u, wr, wc, fr, fq, lds, buf);
    }
};

template <int CTRL> __device__ __forceinline__ float dppf(float v) { return __builtin_bit_cast(float, __builtin_amdgcn_update_dpp(0, __builtin_bit_cast(int, v), CTRL, 0xf, 0xf, true)); }
template <int CTRL> __device__ __forceinline__ f32x4 dpp4(f32x4 v) { f32x4 r; r[0] = dppf<CTRL>(v[0]); r[1] = dppf<CTRL>(v[1]); r[2] = dppf<CTRL>(v[2]); r[3] = dppf<CTRL>(v[3]); return r; }

constexpr int CW_LDS = RING_BYTES + 1024;
struct EpiUp { static constexpr bool HAS_PREFETCH = true; static constexpr int NST = 0;
    bf16_t* ACT; float* E; const float* cw; const float* cb;
    __device__ __forceinline__ void prefetch(const Unit& u, int buf, LAS unsigned char* lds, int wid, int lane) const {
        if (wid < 4) { const float* base = (wid < 3) ? cw + (size_t)wid * UPW : cb;
            const float* src = base + 128 * u.pn + ((lane & 32) ? DFF : 0) + 4 * (lane & 31);
            __builtin_amdgcn_global_load_lds((const unsigned*)src, (LAS unsigned*)(lds + CW_LDS + buf * 4096 + wid * 1024), 16, 0, 0); }
    }
    __device__ __forceinline__ void run(const Acc& acc, const Unit& u, int wr, int wc, int fr, int fq, LAS unsigned char* lds, int buf) const {
        const int cl = 32 * wc + 8 * fq;
        const int cbase = 128 * u.pn + cl;
        const LAS float* wl = (const LAS float*)(lds + CW_LDS + buf * 4096) + cl;
        u32x2 res0[2][4];
#pragma unroll
        for (int n = 0; n < 2; ++n) { const int c0 = cbase + 4 * n;
            const f32x4 wg0 = *(const LAS f32x4*)(wl + 4 * n), wg1 = *(const LAS f32x4*)(wl + 256 + 4 * n), wg2 = *(const LAS f32x4*)(wl + 512 + 4 * n), bg = *(const LAS f32x4*)(wl + 768 + 4 * n);
            const f32x4 wv0 = *(const LAS f32x4*)(wl + 128 + 4 * n), wv1 = *(const LAS f32x4*)(wl + 384 + 4 * n), wv2 = *(const LAS f32x4*)(wl + 640 + 4 * n), bv = *(const LAS f32x4*)(wl + 896 + 4 * n);
#pragma unroll
            for (int ai = 0; ai < 2; ++ai) { f32x4 pg1 = {0.f, 0.f, 0.f, 0.f}, pg2 = pg1, pv1 = pg1, pv2 = pg1;
                const int blk = 4 * u.pm + 2 * ai + wr;
#pragma unroll
                for (int m = 0; m < 4; ++m) { const f32x4 gcur = acc[ai][0][m][n], vcur = acc[ai][1][m][n];
                    const f32x4 rg1 = dpp4<0x121>(gcur), rg2 = dpp4<0x122>(gcur), rv1 = dpp4<0x121>(vcur), rv2 = dpp4<0x122>(vcur);
                    const f32x4 g1 = (fr >= 1) ? rg1 : pg1, g2 = (fr >= 2) ? rg2 : pg2, v1 = (fr >= 1) ? rv1 : pv1, v2 = (fr >= 2) ? rv2 : pv2;
                    const f32x4 cg = bg + wg0 * g2 + wg1 * g1 + wg2 * gcur, cv = bv + wv0 * v2 + wv1 * v1 + wv2 * vcur;
                    f32x4 a; a[0] = silu_f(cg[0]) * cv[0]; a[1] = silu_f(cg[1]) * cv[1]; a[2] = silu_f(cg[2]) * cv[2]; a[3] = silu_f(cg[3]) * cv[3];
                    u32x2 w; w.x = cvt_pk_bf16(a[0], a[1]); w.y = cvt_pk_bf16(a[2], a[3]);
                    const int t = u.pm * BM + ai * HALF + wr * 64 + m * 16 + fr;
                    if (n == 0) res0[ai][m] = w;
                    else if (!(m == 0 && fr < 2)) { u32x4 o; o.x = res0[ai][m].x; o.y = res0[ai][m].y; o.z = w.x; o.w = w.y; *(u32x4*)(ACT + (size_t)t * DFF + cbase) = o; }
                    if (m == 0 && fr < 2) { float* e = E + ((size_t)blk * 4 + fr) * UPW + c0; *(f32x4*)e = gcur; *(f32x4*)(e + DFF) = vcur; }
                    if (m == 3 && fr >= 14) { float* e = E + ((size_t)blk * 4 + 2 + (fr - 14)) * UPW + c0; *(f32x4*)e = gcur; *(f32x4*)(e + DFF) = vcur; }
                    pg1 = rg1; pg2 = rg2; pv1 = rv1; pv2 = rv2; } } }
    }
};
}

namespace att {
constexpr int NSLOT = 3, K_OFF = 0, KSLOT = 12288, V_OFF = NSLOT * KSLOT, VSLOT = 8192, WS_OFF = V_OFF + NSLOT * VSLOT, OST_OFF = WS_OFF + 8 * 256, LDS_END = OST_OFF + 8 * 8192;
static_assert(LDS_END <= RING_BYTES, "attention LDS");
__device__ __forceinline__ int crow(int r, int hi) { return (r & 3) + 8 * (r >> 2) + 4 * hi; }
typedef short v4i16_t __attribute__((ext_vector_type(4)));
__device__ __forceinline__ s16x4 vtr(const LAS unsigned char* p) { return __builtin_bit_cast(s16x4, __builtin_amdgcn_ds_read_tr16_b64_v4i16((LAS v4i16_t*)p)); }
__device__ __forceinline__ void glds(const char* src, LAS unsigned char* dst) { unsigned keep; const unsigned d = (unsigned)__builtin_amdgcn_readfirstlane((int)(unsigned)(uintptr_t)dst);
    asm volatile("s_mov_b32 %0, m0\n\ts_mov_b32 m0, %2\n\ts_nop 0\n\tglobal_load_lds_dwordx4 %1, off\n\ts_mov_b32 m0, %0" : "=&s"(keep) : "v"(src), "s"(d) : "memory"); }
__device__ __forceinline__ float max3f(float a, float b, float c) { float r; asm("v_max3_f32 %0, %1, %2, %3" : "=v"(r) : "v"(a), "v"(b), "v"(c)); return r; }
__device__ __forceinline__ float max2f(float a, float b) { float r; asm("v_max_f32_e32 %0, %1, %2" : "=v"(r) : "v"(a), "v"(b)); return r; }
__device__ __forceinline__ float fadd_s(float a, float b) { float r; asm("v_add_f32_e32 %0, %1, %2" : "=v"(r) : "v"(a), "v"(b)); return r; }
constexpr float THRL = 4.0f;

struct AUnit { int b, h, qb; };
__device__ __forceinline__ bool unit_of(int k, int vcu, int G, AUnit& u) {
    const int it = vcu + (k >> 2) * G, r = k & 3; if (it >= 256) return false;
    const int grp = it >> 3, i8 = it & 7, bh = grp * 4 + r; u.b = bh >> 3; u.h = bh & 7;
    u.qb = (r == 0) ? 7 - i8 : (r == 1) ? i8 : (r == 2) ? 7 - (i8 ^ 1) : (i8 ^ 1); return true;
}
__device__ __forceinline__ void attn_phase(int vcu, int G, const float* ssqq, const float* rope, const bf16_t* Q, const bf16_t* KN, const bf16_t* KR, const bf16_t* V, bf16_t* Y, const float* ong, LAS unsigned char* lds) {
    int tid = threadIdx.x; asm volatile("" : "+v"(tid));
    const int lane = tid & 63, r32 = lane & 31, hi = lane >> 5; const int wid = __builtin_amdgcn_readfirstlane(tid >> 6);
    const int lo16 = wid * 1024 + lane * 16;
    LAS float* wsf = (LAS float*)(lds + WS_OFF + wid * 256);
    const int kl = hi * 1024 + r32 * 16, vl = ((lane >> 4) & 1) * 32 + (lane & 3) * 8 + (4 * hi + ((lane & 15) >> 2)) * 64;
#define ATT_ISSUE(U, tile, slot) do { const size_t bh_ = (size_t)((U).b * 8 + (U).h); \
        glds((const char*)KN + (bh_ * 32 + (tile)) * 8192 + lo16, lds + K_OFF + (slot) * KSLOT + wid * 1024); glds((const char*)V + (bh_ * 32 + (tile)) * 8192 + lo16, lds + V_OFF + (slot) * VSLOT + wid * 1024); \
        if (wid < 4) glds((const char*)KR + ((size_t)(U).b * 32 + (tile)) * 4096 + lo16, lds + K_OFF + (slot) * KSLOT + 8192 + wid * 1024); } while (0)
#define ATT_QLOAD(dst, aux, U) do { const size_t row_ = (size_t)((U).b * SEQ + 256 * (U).qb + 32 * wid + r32); const bf16_t* qp_ = Q + row_ * QW + 96 * (U).h + 8 * hi; \
        _Pragma("unroll") for (int ks = 0; ks < 6; ++ks) dst[ks] = *(const bf16x8*)(qp_ + 16 * ks); \
        aux[0] = *(const f32x4*)(ssqq + row_ * 4); aux[1] = *(const f32x4*)(rope + row_ * 32 + 8 * hi); aux[2] = *(const f32x4*)(rope + row_ * 32 + 8 * hi + 4); \
        aux[3] = *(const f32x4*)(rope + row_ * 32 + 16 + 8 * hi); aux[4] = *(const f32x4*)(rope + row_ * 32 + 16 + 8 * hi + 4); } while (0)
#define ATT_QFIX(q, aux) do { const float f_ = rsqrtf(((aux[0][0] + aux[0][1]) + (aux[0][2] + aux[0][3])) * (1.f / 256.f) + 1e-6f) * QSCALE; \
        _Pragma("unroll") for (int ks = 0; ks < 4; ++ks) { const u32x4 w_ = __builtin_bit_cast(u32x4, q[ks]); u32x4 o_; \
            _Pragma("unroll") for (int e = 0; e < 4; ++e) o_[e] = cvt_pk_bf16(bf_lo(w_[e]) * f_, bf_hi(w_[e]) * f_); q[ks] = __builtin_bit_cast(bf16x8, o_); } \
        { const u32x4 a_ = __builtin_bit_cast(u32x4, q[4]), b_ = __builtin_bit_cast(u32x4, q[5]); u32x4 oa_, ob_; \
          _Pragma("unroll") for (int e = 0; e < 4; ++e) { const float x1l = bf_lo(a_[e]), x1h = bf_hi(a_[e]), x2l = bf_lo(b_[e]), x2h = bf_hi(b_[e]); \
              const float cl = (e < 2) ? aux[1][2 * e] : aux[2][2 * e - 4], ch = (e < 2) ? aux[1][2 * e + 1] : aux[2][2 * e - 3], sl = (e < 2) ? aux[3][2 * e] : aux[4][2 * e - 4], sh = (e < 2) ? aux[3][2 * e + 1] : aux[4][2 * e - 3]; \
              oa_[e] = cvt_pk_bf16((x1l * cl - x2l * sl) * f_, (x1h * ch - x2h * sh) * f_); ob_[e] = cvt_pk_bf16((x2l * cl + x1l * sl) * f_, (x2h * ch + x1h * sh) * f_); } \
          q[4] = __builtin_bit_cast(bf16x8, oa_); q[5] = __builtin_bit_cast(bf16x8, ob_); } } while (0)
    AUnit cur, nxt;
    if (!unit_of(0, vcu, G, cur)) return;
    bf16x8 qr[6], qn[6]; f32x4 qa[5], qna[5];
    ATT_QLOAD(qr, qa, cur);
    ATT_QFIX(qr, qa);
    asm volatile("" : "+v"(qr[0]), "+v"(qr[1]), "+v"(qr[2]), "+v"(qr[3]), "+v"(qr[4]), "+v"(qr[5]));
    ATT_ISSUE(cur, 0, 0); ATT_ISSUE(cur, 1, 1);
    int slot = 0;
    for (int k = 0;; ++k) {
        const bool has_next = unit_of(k + 1, vcu, G, nxt);
        const int NT = 4 * cur.qb + 4, jmax = 4 * cur.qb + (wid >> 1);
        float mrun = 0.f, lrun = 0.f; f32x16 o[2]; o[0] = f32x16{}; o[1] = f32x16{}; f32x16 negm = f32x16{};
        for (int j = 0; j < NT; ++j) {
            if (j == 0 && k > 0) { if (wid < 4) asm volatile("s_waitcnt vmcnt(13) lgkmcnt(0)\n\ts_barrier" ::: "memory"); else asm volatile("s_waitcnt vmcnt(12) lgkmcnt(0)\n\ts_barrier" ::: "memory"); }
            else if (j + 1 < NT || has_next) { if (wid < 4) asm volatile("s_waitcnt vmcnt(3) lgkmcnt(0)\n\ts_barrier" ::: "memory"); else asm volatile("s_waitcnt vmcnt(2) lgkmcnt(0)\n\ts_barrier" ::: "memory"); }
            else asm volatile("s_waitcnt vmcnt(0) lgkmcnt(0)\n\ts_barrier" ::: "memory");
            { const int s2 = (slot == 0) ? 2 : slot - 1;
              if (j + 2 < NT) ATT_ISSUE(cur, j + 2, s2); else if (has_next) ATT_ISSUE(nxt, j + 2 - NT, s2); }
            if (j == NT - 1 && has_next) ATT_QLOAD(qn, qna, nxt);
            if (j <= jmax) {
                const LAS unsigned char* kp = lds + K_OFF + slot * KSLOT + kl;
                f32x16 p0, p1;
#pragma unroll
                for (int ks = 0; ks < 6; ++ks) { const bf16x8 k0 = *(const LAS bf16x8*)(kp + ks * 2048), k1 = *(const LAS bf16x8*)(kp + ks * 2048 + 512);
                    if (ks == 0) { p0 = __builtin_amdgcn_mfma_f32_32x32x16_bf16(k0, qr[0], negm, 0, 0, 0); p1 = __builtin_amdgcn_mfma_f32_32x32x16_bf16(k1, qr[0], negm, 0, 0, 0); }
                    else { p0 = __builtin_amdgcn_mfma_f32_32x32x16_bf16(k0, qr[ks], p0, 0, 0, 0); p1 = __builtin_amdgcn_mfma_f32_32x32x16_bf16(k1, qr[ks], p1, 0, 0, 0); } }
                float rm;
                { float a = max3f(p0[0], p0[1], p1[0]), c = max3f(p0[2], p0[3], p1[1]); a = max3f(a, p1[2], p1[3]);
#pragma unroll
                  for (int r = 4; r < 16; r += 4) { a = max3f(a, p0[r], p0[r + 1]); c = max3f(c, p0[r + 2], p0[r + 3]); a = max3f(a, p1[r], p1[r + 1]); c = max3f(c, p1[r + 2], p1[r + 3]); }
                  rm = max2f(a, c); rm = max2f(rm, __shfl_xor(rm, 32)); }
                if (j == 0 || __any(rm > THRL)) {
                    const float dl = (j == 0) ? rm : fmaxf(rm, 0.f);
                    mrun += dl;
#pragma unroll
                    for (int r = 0; r < 16; ++r) { p0[r] -= dl; p1[r] -= dl; }
#pragma unroll
                    for (int r = 0; r < 16; ++r) negm[r] = -mrun;
                    if (j != 0) { const float alpha = fexp2(-dl); lrun *= alpha;
                        if (hi == 0) wsf[r32] = alpha;
#pragma unroll
                        for (int r = 0; r < 16; ++r) { const float a_ = wsf[crow(r, hi)]; o[0][r] *= a_; o[1][r] *= a_; } }
                }
#pragma unroll
                for (int r = 0; r < 16; ++r) { p0[r] = fexp2(p0[r]); p1[r] = fexp2(p1[r]); }
                { float s0 = fadd_s(p0[0], p1[0]), s1 = fadd_s(p0[1], p1[1]);
#pragma unroll
                  for (int r = 2; r < 16; r += 2) { s0 = fadd_s(s0, p0[r]); s1 = fadd_s(s1, p0[r + 1]); s0 = fadd_s(s0, p1[r]); s1 = fadd_s(s1, p1[r + 1]); }
                  lrun = fadd_s(lrun, fadd_s(s0, s1)); }
                bf16x8 pa[4];
                { u32x4 w0, w1, w2, w3;
                  w0.x = cvt_pk_bf16(p0[0], p0[1]); w0.y = cvt_pk_bf16(p0[2], p0[3]); w0.z = cvt_pk_bf16(p0[4], p0[5]); w0.w = cvt_pk_bf16(p0[6], p0[7]);
                  w1.x = cvt_pk_bf16(p0[8], p0[9]); w1.y = cvt_pk_bf16(p0[10], p0[11]); w1.z = cvt_pk_bf16(p0[12], p0[13]); w1.w = cvt_pk_bf16(p0[14], p0[15]);
                  w2.x = cvt_pk_bf16(p1[0], p1[1]); w2.y = cvt_pk_bf16(p1[2], p1[3]); w2.z = cvt_pk_bf16(p1[4], p1[5]); w2.w = cvt_pk_bf16(p1[6], p1[7]);
                  w3.x = cvt_pk_bf16(p1[8], p1[9]); w3.y = cvt_pk_bf16(p1[10], p1[11]); w3.z = cvt_pk_bf16(p1[12], p1[13]); w3.w = cvt_pk_bf16(p1[14], p1[15]);
                  pa[0] = __builtin_bit_cast(bf16x8, w0); pa[1] = __builtin_bit_cast(bf16x8, w1); pa[2] = __builtin_bit_cast(bf16x8, w2); pa[3] = __builtin_bit_cast(bf16x8, w3); }
                const LAS unsigned char* vp = lds + V_OFF + slot * VSLOT + vl;
#pragma unroll
                for (int d0 = 0; d0 < 2; ++d0)
#pragma unroll
                    for (int ks = 0; ks < 4; ++ks) { const s16x4 lo = vtr(vp + d0 * 4096 + ks * 1024), hh = vtr(vp + d0 * 4096 + ks * 1024 + 512);
                        const bf16x8 vf = {lo[0], lo[1], lo[2], lo[3], hh[0], hh[1], hh[2], hh[3]};
                        o[d0] = __builtin_amdgcn_mfma_f32_32x32x16_bf16(pa[ks], vf, o[d0], 0, 0, 0); }
            }
            slot = (slot == 2) ? 0 : slot + 1;
        }
        { const float lt = lrun + __shfl_xor(lrun, 32);
          if (hi == 0) wsf[r32] = frcp(lt);
          LAS float* stg = (LAS float*)(lds + OST_OFF + wid * 8192);
#pragma unroll
          for (int r = 0; r < 16; ++r) { const float inv = wsf[crow(r, hi)]; const int orow = crow(r, hi); stg[orow * 64 + r32] = o[0][r] * inv; stg[orow * 64 + 32 + r32] = o[1][r] * inv; }
          const int ch = lane & 7;
          const f32x4 ga = *(const f32x4*)(ong + 64 * cur.h + 8 * ch), gb = *(const f32x4*)(ong + 64 * cur.h + 8 * ch + 4);
          bf16_t* Yw = Y + (size_t)(cur.b * SEQ + 256 * cur.qb + 32 * wid) * D + 64 * cur.h + 8 * ch;
#pragma unroll
          for (int i = 0; i < 4; ++i) { const int row = i * 8 + (lane >> 3);
              const f32x4 va = *(const LAS f32x4*)(stg + row * 64 + 8 * ch), vb = *(const LAS f32x4*)(stg + row * 64 + 8 * ch + 4);
              float ss = (va[0] * va[0] + va[1] * va[1]) + (va[2] * va[2] + va[3] * va[3]) + (vb[0] * vb[0] + vb[1] * vb[1]) + (vb[2] * vb[2] + vb[3] * vb[3]);
              ss += pg8::dppf<0xB1>(ss); ss += pg8::dppf<0x4E>(ss); ss += pg8::dppf<0x141>(ss);
              const float rs = rsqrtf(ss * (1.f / 64.f) + 1e-6f);
              const f32x4 oa = va * rs * ga, ob = vb * rs * gb;
              u32x4 w; w.x = cvt_pk_bf16(oa[0], oa[1]); w.y = cvt_pk_bf16(oa[2], oa[3]); w.z = cvt_pk_bf16(ob[0], ob[1]); w.w = cvt_pk_bf16(ob[2], ob[3]);
              *(u32x4*)(Yw + (size_t)row * D) = w; } }
        if (!has_next) break;
        cur = nxt;
#pragma unroll
        for (int ks = 0; ks < 6; ++ks) qr[ks] = qn[ks];
        ATT_QFIX(qr, qna);
    }
    asm volatile("s_waitcnt vmcnt(0) lgkmcnt(0)\n\ts_barrier" ::: "memory");
#undef ATT_ISSUE
#undef ATT_QLOAD
#undef ATT_QFIX
}
}

#define XB_TMO      128
#define XB_XCNT(j)  (256  + 64 * (j))
#define XB_XSUB(j)  (1280 + 64 * (j))
#define XB_XGEN(j)  (2304 + 64 * (j))
#define XB_TOP      3328
#define XB_TOPGEN   3392
#define XCD_BAR_WORDS 3456
#define XB_SPIN_CAP (1u << 18)
__device__ __forceinline__ unsigned xb_ld(unsigned* p)              { return __hip_atomic_load(p, __ATOMIC_RELAXED, __HIP_MEMORY_SCOPE_AGENT); }
__device__ __forceinline__ unsigned xb_add(unsigned* p, unsigned v) { return __hip_atomic_fetch_add(p, v, __ATOMIC_RELAXED, __HIP_MEMORY_SCOPE_AGENT); }
__device__ __forceinline__ unsigned xb_xcc_id() { return (unsigned)__builtin_amdgcn_s_getreg((3 << 11) | 20) & 0xFu; }
#define XB_SPIN(cond, bar) do { unsigned _sp = 0; while (cond) { __builtin_amdgcn_s_sleep(1); \
    if ((++_sp & 255u) == 0u) { if (xb_ld(&(bar)[XB_TMO])) break; if (_sp > XB_SPIN_CAP) { atomicAdd(&(bar)[XB_TMO], 1u); break; } } } } while (0)
struct XcdBarrier { unsigned* bar; unsigned x; volatile LAS unsigned* st; };
__device__ __forceinline__ XcdBarrier xcd_barrier_post(unsigned* bar, volatile LAS unsigned* st) {
    XcdBarrier b; b.bar = bar; b.x = xb_xcc_id(); b.st = st;
    if (threadIdx.x == 0) (void)xb_add(&bar[XB_XCNT(b.x)], 1u);
    return b;
}
__device__ __forceinline__ void xcd_barrier_complete(unsigned* bar, unsigned x, unsigned& nloc, unsigned& nx) {
    const unsigned G = gridDim.x * gridDim.y * gridDim.z;
    unsigned sum, cnt, mine, sp = 0u;
    for (;;) {
        sum = 0u; cnt = 0u; mine = 0u;
#pragma unroll
        for (unsigned j = 0; j < 16; ++j) { const unsigned c = xb_ld(&bar[XB_XCNT(j)]); sum += c; cnt += (c > 0u) ? 1u : 0u; mine = (j == x) ? c : mine; }
        if (sum == G) break;
        __builtin_amdgcn_s_sleep(1);
        if ((++sp & 255u) == 0u) { if (xb_ld(&bar[XB_TMO])) break; if (sp > XB_SPIN_CAP) { atomicAdd(&bar[XB_TMO], 1u); break; } }
    }
    nloc = mine > 0u ? mine : 1u; nx = cnt > 0u ? cnt : 1u;
}
__device__ __forceinline__ void xcd_barrier(const XcdBarrier& b) {
    asm volatile("s_waitcnt vmcnt(0)" ::: "memory");
    __syncthreads();
    if (threadIdx.x == 0) {
        unsigned* bar = b.bar;
        __builtin_amdgcn_s_waitcnt(0);
        unsigned nloc = b.st[0], nx = b.st[1];
        if (nloc == 0u) { xcd_barrier_complete(bar, b.x, nloc, nx); b.st[0] = nloc; b.st[1] = nx; }
        const unsigned old = xb_add(&bar[XB_XSUB(b.x)], 1u);
        const unsigned gen = old / nloc;
        if (old + 1u == (gen + 1u) * nloc) {
            __builtin_amdgcn_fence(__ATOMIC_RELEASE, "agent");
            asm volatile("s_waitcnt vmcnt(0)" ::: "memory");
            const unsigned og = xb_add(&bar[XB_TOP], 1u);
            const unsigned tg = og / nx;
            if (og + 1u == (tg + 1u) * nx) xb_add(&bar[XB_TOPGEN], 1u);
            else XB_SPIN(xb_ld(&bar[XB_TOPGEN]) == tg, bar);
            __builtin_amdgcn_fence(__ATOMIC_ACQUIRE, "agent");
            xb_add(&bar[XB_XGEN(b.x)], 1u);
            asm volatile("s_waitcnt vmcnt(0)" ::: "memory");
        } else {
            XB_SPIN(xb_ld(&bar[XB_XGEN(b.x)]) == gen, bar);
            __builtin_amdgcn_fence(__ATOMIC_ACQUIRE, "agent");
            asm volatile("s_waitcnt vmcnt(0)" ::: "memory");
        }
    }
    __syncthreads();
}

struct Args { const float* in[22]; const int* pos; float* out; unsigned char* ws; int ph_lo, ph_hi; };
__constant__ float c_invfreq[16] = {1.0f, 0.5623413251903491f, 0.31622776601683794f, 0.1778279410038923f, 0.1f, 0.05623413251903491f, 0.03162277660168379f, 0.01778279410038923f,
                                    0.01f, 0.005623413251903491f, 0.0031622776601683794f, 0.001778279410038923f, 0.001f, 0.0005623413251903491f, 0.00031622776601683794f, 0.0001778279410038923f};

__device__ __forceinline__ int colmap(int which, int s) {
    const int p = (s & ~31) + pg8::perm32(s & 31);
    switch (which) {
        case 0: { if (s < 1024) return p < 416 ? p : (p < 512 ? -1 : p - 96);
                  const int bj = (s >> 7) & 1, ch = 128 * ((s >> 8) - 4) + 32 * ((s >> 5) & 3) + pg8::perm32(s & 31); return (bj ? 1440 : 928) + ch; }
        case 4: { const int pn = s >> 8, bj = (s >> 7) & 1, wc = (s >> 5) & 3; return bj * DFF + 128 * pn + 32 * wc + pg8::perm32(s & 31); }
        default: return p;
    }
}
__device__ __forceinline__ void p0_transpose_item(const float* W, int ldw, int Ksrc, const float* kscale, bf16_t* WT, int Kdst, int which, LAS float* scr, int item, int nblk, int lane) {
    const int kb = item / nblk, nb = item % nblk, k0 = 64 * kb, s0 = 32 * nb;
    const int cm = colmap(which, s0 + (lane & 31));
    float tv[32];
#pragma unroll
    for (int i = 0; i < 32; ++i) { const int k = k0 + 2 * i + (lane >> 5); tv[i] = (cm >= 0 && k < Ksrc) ? W[(size_t)k * ldw + cm] : 0.f; }
    if (kscale) {
#pragma unroll
        for (int i = 0; i < 32; ++i) { const int k = k0 + 2 * i + (lane >> 5); if (k < Ksrc) tv[i] *= kscale[k]; } }
#pragma unroll
    for (int i = 0; i < 32; ++i) scr[(2 * i + (lane >> 5)) * 33 + (lane & 31)] = tv[i];
    asm volatile("s_waitcnt lgkmcnt(0)" ::: "memory");
    const int c = lane & 7;
#pragma unroll
    for (int j = 0; j < 4; ++j) { const int n = (lane >> 3) + 8 * j; const LAS float* s = scr + (8 * c) * 33 + n;
        u32x4 o; o.x = cvt_pk_bf16(s[0 * 33], s[1 * 33]); o.y = cvt_pk_bf16(s[2 * 33], s[3 * 33]); o.z = cvt_pk_bf16(s[4 * 33], s[5 * 33]); o.w = cvt_pk_bf16(s[6 * 33], s[7 * 33]);
        *(u32x4*)(WT + (size_t)(s0 + n) * Kdst + k0 + 8 * c) = o; }
    asm volatile("s_waitcnt lgkmcnt(0)" ::: "memory");
}

constexpr int N_PHASES = 11;
#define OPAQUE_LANE(name) int name##_t = (int)threadIdx.x; asm volatile("" : "+v"(name##_t)); const int name = name##_t & 63

__global__ void __launch_bounds__(512, 2) mk_fwd(Args args) {
    extern __shared__ __attribute__((aligned(16))) unsigned char lds_raw[];
    LAS unsigned char* lds = (LAS unsigned char*)lds_raw;
    volatile LAS unsigned* MISC = (volatile LAS unsigned*)(lds + MISC_OFF);
    const int tid = threadIdx.x, lane = tid & 63, wave = __builtin_amdgcn_readfirstlane(tid >> 6);
    const int G = gridDim.x; const int bx = blockIdx.x; const int vcu = (G % 8 == 0) ? (bx % 8) * (G / 8) + bx / 8 : bx;
    const int gw = vcu * 8 + wave, NGW = G * 8;
    unsigned char* ws = args.ws;
    const float* x = args.in[0]; const float* cvec = args.in[1]; const int* pos = args.pos;
    const float* w_ada = args.in[3]; const float* b_ada = args.in[4]; const float* w_in = args.in[5];
    const float* qg = args.in[6]; const float* w_qup = args.in[7]; const float* kvg = args.in[8]; const float* w_kvup = args.in[9];
    const float* conv_w = args.in[10]; const float* conv_b = args.in[11]; const float* ong = args.in[12]; const float* w_out = args.in[13];
    const float* ln1g = args.in[14]; const float* ln1b = args.in[15]; const float* w_up = args.in[16];
    const float* fcw = args.in[17]; const float* fcb = args.in[18]; const float* w_down = args.in[19];
    const float* ln2g = args.in[20]; const float* ln2b = args.in[21];
    float* out = args.out;
    float* MOD = (float*)(ws + WS_MOD); float* ROPE = (float*)(ws + WS_ROPE); float* SSQQ = (float*)(ws + WS_SSQQ); float* SSQKV = (float*)(ws + WS_SSQKV);
    bf16_t* WIN = (bf16_t*)(ws + WS_WIN); bf16_t* WQ = (bf16_t*)(ws + WS_WQ); bf16_t* WKV = (bf16_t*)(ws + WS_WKV); bf16_t* WOUT = (bf16_t*)(ws + WS_WOUT);
    bf16_t* WUP = (bf16_t*)(ws + WS_WUP); bf16_t* WDN = (bf16_t*)(ws + WS_WDN);
    bf16_t* HB = (bf16_t*)(ws + WS_HB); bf16_t* FF = (bf16_t*)(ws + WS_FF); bf16_t* P = (bf16_t*)(ws + WS_P); bf16_t* MIX = (bf16_t*)(ws + WS_MIX);
    bf16_t* U = (bf16_t*)(ws + WS_U); bf16_t* Qb = (bf16_t*)(ws + WS_Q); bf16_t* KN = (bf16_t*)(ws + WS_KN); bf16_t* KR = (bf16_t*)(ws + WS_KR); bf16_t* Vb = (bf16_t*)(ws + WS_V);
    bf16_t* Y = (bf16_t*)(ws + WS_Y); bf16_t* X1 = (bf16_t*)(ws + WS_X1); bf16_t* ACT = (bf16_t*)(ws + WS_ACT); float* E = (float*)(ws + WS_E);

    for (int u = tid; u < (LDS_BYTES - LDSCTL_OFF) / 4; u += 512) ((LAS unsigned*)(lds + LDSCTL_OFF))[u] = 0u;
    __syncthreads();
    XcdBarrier bar; bar.bar = (unsigned*)(ws + WS_CTL) + CW_BAR; bar.x = 0; bar.st = nullptr;
    if (MK_N_LAUNCHES == 1) bar = xcd_barrier_post((unsigned*)(ws + WS_CTL) + CW_BAR, MISC + 8);
    const int lo = args.ph_lo, hi = args.ph_hi;
#ifndef PH_MASK
#define PH_MASK 0x7ff
#endif
#define IN(k) (((PH_MASK >> (k)) & 1) && lo <= (k) && (k) < hi)
#define SEAM(k) do { if (IN(k) && IN((k) + 1)) xcd_barrier(bar); } while (0)

    if (IN(0)) {
        OPAQUE_LANE(ln);
        if (bx < 192) {
            LAS float* cact = (LAS float*)lds; LAS float* part = (LAS float*)(lds + 65536);
            const int n0 = 32 * bx, c4 = tid & 7, kr = tid >> 3;
            f32x4 wv[16];
#pragma unroll
            for (int i = 0; i < 16; ++i) wv[i] = *(const f32x4*)(w_ada + (size_t)(kr + 64 * i) * 6144 + n0 + 4 * c4);
            for (int i = tid; i < 16 * 1024; i += 512) { const float v = cvec[i]; cact[i] = v * frcp(1.f + fexp2(-LOG2E * v)); }
            __syncthreads();
            f32x4 a[16];
#pragma unroll
            for (int b = 0; b < 16; ++b) a[b] = (f32x4){0.f, 0.f, 0.f, 0.f};
#pragma unroll
            for (int i = 0; i < 16; ++i) { const int k = kr + 64 * i;
#pragma unroll
                for (int b = 0; b < 16; ++b) a[b] += wv[i] * cact[b * 1024 + k];
                if ((i & 1) == 1) asm volatile("" ::: "memory"); }
#pragma unroll
            for (int b = 0; b < 16; ++b)
#pragma unroll
                for (int e = 0; e < 4; ++e) { float v = a[b][e]; v += __shfl_xor(v, 8); v += __shfl_xor(v, 16); v += __shfl_xor(v, 32); a[b][e] = v; }
            if (ln < 8) {
#pragma unroll
                for (int b = 0; b < 16; ++b) *(LAS f32x4*)(part + (wave * 16 + b) * 32 + 4 * c4) = a[b]; }
            __syncthreads();
            { const int b = tid >> 5, col = tid & 31; float s = 0.f;
#pragma unroll
              for (int w8 = 0; w8 < 8; ++w8) s += part[(w8 * 16 + b) * 32 + col];
              MOD[b * 6144 + n0 + col] = s + b_ada[n0 + col]; }
            __syncthreads();
        }
        for (int idx = gw * 64 + ln; idx < T * 16; idx += NGW * 64) { const int t = idx >> 4, i = idx & 15; const float ang = (float)pos[t] * c_invfreq[i];
            ROPE[(size_t)t * 32 + i] = cosf(ang); ROPE[(size_t)t * 32 + 16 + i] = sinf(ang); }
    }
    SEAM(0);
    if (IN(1)) {
        OPAQUE_LANE(ln);
        {
        LAS float* scr = (LAS float*)(lds + wave * 16384);
        constexpr int I0 = 16 * 64, I1 = 4 * 24, I2 = 4 * 32, I3 = 16 * 32, I4 = 16 * 176, I5 = 44 * 32, NIT = I0 + I1 + I2 + I3 + I4 + I5;
        for (int it = gw; it < NIT; it += NGW) {
            int r = it;
            if (r < I0) { p0_transpose_item(w_in, INW, D, nullptr, WIN, D, 0, scr, r, 64, ln); continue; } r -= I0;
            if (r < I1) { p0_transpose_item(w_qup, QW, 256, qg, WQ, 256, 1, scr, r, 24, ln); continue; } r -= I1;
            if (r < I2) { p0_transpose_item(w_kvup, 1024, 128, kvg, WKV, 256, 2, scr, r, 32, ln); continue; } r -= I2;
            if (r < I3) { p0_transpose_item(w_out, D, D, nullptr, WOUT, D, 3, scr, r, 32, ln); continue; } r -= I3;
            if (r < I4) { p0_transpose_item(w_up, UPW, D, nullptr, WUP, D, 4, scr, r, 176, ln); continue; } r -= I4;
            p0_transpose_item(w_down, D, DFF, nullptr, WDN, DFF, 5, scr, r, 32, ln);
        }
            }
        for (int row0 = gw * 16; row0 < T; row0 += NGW * 16) { const int b = row0 / SEQ; const float* mb = MOD + b * 6144;
            f32x4 sc[4], sh[4];
#pragma unroll
            for (int j = 0; j < 4; ++j) { const int col = 4 * ln + 256 * j; sh[j] = *(const f32x4*)(mb + col); sc[j] = *(const f32x4*)(mb + 1024 + col) + 1.f; }
            for (int rr = 0; rr < 16; ++rr) { const int t = row0 + rr; const float* xr = x + (size_t)t * D;
                f32x4 v[4]; float s = 0.f;
#pragma unroll
                for (int j = 0; j < 4; ++j) { v[j] = *(const f32x4*)(xr + 4 * ln + 256 * j); s += (v[j][0] + v[j][1]) + (v[j][2] + v[j][3]); }
                const float mean = wave_sum(s) * (1.f / D); float q = 0.f;
#pragma unroll
                for (int j = 0; j < 4; ++j) { v[j] = v[j] - mean; q += (v[j][0] * v[j][0] + v[j][1] * v[j][1]) + (v[j][2] * v[j][2] + v[j][3] * v[j][3]); }
                const float rstd = rsqrtf(wave_sum(q) * (1.f / D) + 1e-5f);
#pragma unroll
                for (int j = 0; j < 4; ++j) { const f32x4 o = v[j] * rstd * sc[j] + sh[j]; u32x2 w; w.x = cvt_pk_bf16(o[0], o[1]); w.y = cvt_pk_bf16(o[2], o[3]);
                    *(u32x2*)(HB + (size_t)t * D + 4 * ln + 256 * j) = w; } } }
    }
    SEAM(1);
    if (IN(2)) {
        pg8::Gemm g{HB, D, WIN, T, 512, D}; pg8::StaticOrder S; S.init(T, 512, G, bx);
        pg8::EpiP E1{P, U, SSQQ, SSQKV};
        pg8::gemm_phase<pg8::EpiP, true>(lds, g, S, E1);
    }
    SEAM(2);
    if (IN(3)) {
        OPAQUE_LANE(ln);
        for (int row0 = gw * 16; row0 < T; row0 += NGW * 16) {
            { const int t = row0 + (ln >> 2), c = ln & 3, i0 = 8 * (c & 1); const bf16_t* pr = P + (size_t)t * PW + 384;
              const u32x4 r1 = *(const u32x4*)(pr + i0), r2 = *(const u32x4*)(pr + 16 + i0);
              const f32x4 ca = *(const f32x4*)(ROPE + (size_t)t * 32 + i0), cb = *(const f32x4*)(ROPE + (size_t)t * 32 + i0 + 4), sa = *(const f32x4*)(ROPE + (size_t)t * 32 + 16 + i0), sb = *(const f32x4*)(ROPE + (size_t)t * 32 + 16 + i0 + 4);
              float ov[8];
#pragma unroll
              for (int e = 0; e < 8; ++e) { const float x1 = (e & 1) ? bf_hi(r1[e >> 1]) : bf_lo(r1[e >> 1]), x2 = (e & 1) ? bf_hi(r2[e >> 1]) : bf_lo(r2[e >> 1]);
                  const float cs = (e < 4) ? ca[e & 3] : cb[e & 3], sn = (e < 4) ? sa[e & 3] : sb[e & 3];
                  ov[e] = (c < 2) ? x1 * cs - x2 * sn : x2 * cs + x1 * sn; }
              u32x4 o; o.x = cvt_pk_bf16(ov[0], ov[1]); o.y = cvt_pk_bf16(ov[2], ov[3]); o.z = cvt_pk_bf16(ov[4], ov[5]); o.w = cvt_pk_bf16(ov[6], ov[7]);
              *(u32x4*)((char*)KR + (size_t)(t >> 6) * 4096 + c * 1024 + (t & 63) * 16) = o; }
        }
        { pg8::MixedOrder S{(const char*)HB, (const char*)P, (const char*)WIN, (const char*)WQ, (const char*)WKV, G, bx};
          pg8::EpiMix EM{pg8::EpiP{P, U, SSQQ, SSQKV}, pg8::EpiStore{Qb, QW}, pg8::EpiKV{KN, Vb}, SSQKV};
          pg8::gemm_multi<pg8::MixedOrder, pg8::EpiMix>(lds, S, EM); }
    }
    SEAM(3);
    if (IN(4)) {
        att::attn_phase(vcu, G, SSQQ, ROPE, Qb, KN, KR, Vb, Y, ong, lds);
        { OPAQUE_LANE(ln);
        for (int row0 = gw * 16; row0 < T; row0 += NGW * 16) {
            const int c0 = 8 * ln;
            float w0[8], w1[8], w2[8], cb8[8], gn[8];
#pragma unroll
            for (int e = 0; e < 8; ++e) { w0[e] = conv_w[c0 + e]; w1[e] = conv_w[512 + c0 + e]; w2[e] = conv_w[1024 + c0 + e]; cb8[e] = conv_b[c0 + e]; gn[e] = ong[512 + c0 + e]; }
            float um2[8], um1[8];
#pragma unroll
            for (int e = 0; e < 8; ++e) { um2[e] = 0.f; um1[e] = 0.f; }
            if ((row0 % SEQ) != 0) {
                const u32x4 a2 = *(const u32x4*)(U + (size_t)(row0 - 2) * 512 + c0), a1 = *(const u32x4*)(U + (size_t)(row0 - 1) * 512 + c0);
#pragma unroll
                for (int e = 0; e < 4; ++e) { um2[2 * e] = bf_lo(a2[e]); um2[2 * e + 1] = bf_hi(a2[e]); um1[2 * e] = bf_lo(a1[e]); um1[2 * e + 1] = bf_hi(a1[e]); }
            }
            for (int rr = 0; rr < 16; ++rr) { const int t = row0 + rr;
                const u32x4 gb = *(const u32x4*)(P + (size_t)t * PW + 512 + c0), uu = *(const u32x4*)(U + (size_t)t * 512 + c0);
                float u0[8], yv[8]; float ss = 0.f;
#pragma unroll
                for (int e = 0; e < 4; ++e) { u0[2 * e] = bf_lo(uu[e]); u0[2 * e + 1] = bf_hi(uu[e]); }
#pragma unroll
                for (int e = 0; e < 8; ++e) { const float gbe = (e & 1) ? bf_hi(gb[e >> 1]) : bf_lo(gb[e >> 1]);
                    yv[e] = gbe * (cb8[e] + w0[e] * um2[e] + w1[e] * um1[e] + w2[e] * u0[e]); ss += yv[e] * yv[e]; um2[e] = um1[e]; um1[e] = u0[e]; }
                ss += __shfl_xor(ss, 1); ss += __shfl_xor(ss, 2); ss += __shfl_xor(ss, 4);
                const float rs = rsqrtf(ss * (1.f / 64.f) + 1e-6f);
                u32x4 o; o.x = cvt_pk_bf16(yv[0] * rs * gn[0], yv[1] * rs * gn[1]); o.y = cvt_pk_bf16(yv[2] * rs * gn[2], yv[3] * rs * gn[3]);
                o.z = cvt_pk_bf16(yv[4] * rs * gn[4], yv[5] * rs * gn[5]); o.w = cvt_pk_bf16(yv[6] * rs * gn[6], yv[7] * rs * gn[7]);
                *(u32x4*)(Y + (size_t)t * D + 512 + c0) = o; }
        }
            }
    }
    SEAM(4);
    if (IN(5)) {
        pg8::Gemm g{Y, D, WOUT, T, D, D}; pg8::StaticOrder S; S.init(T, D, G, bx); pg8::EpiStore E4{MIX, D};
        pg8::gemm_phase<pg8::EpiStore, true>(lds, g, S, E4);
    }
    SEAM(5);
    if (IN(6)) {
        OPAQUE_LANE(ln);
        for (int row0 = gw * 16; row0 < T; row0 += NGW * 16) { const int b = row0 / SEQ; const float* mb = MOD + b * 6144;
            f32x4 gt[4], g1v[4], b1v[4], sc[4], sh[4];
#pragma unroll
            for (int j = 0; j < 4; ++j) { const int col = 4 * ln + 256 * j; gt[j] = *(const f32x4*)(mb + 2048 + col); g1v[j] = *(const f32x4*)(ln1g + col); b1v[j] = *(const f32x4*)(ln1b + col);
                sh[j] = *(const f32x4*)(mb + 3072 + col); sc[j] = *(const f32x4*)(mb + 4096 + col) + 1.f; }
            for (int rr = 0; rr < 16; ++rr) { const int t = row0 + rr;
                f32x4 v[4]; float s = 0.f;
#pragma unroll
                for (int j = 0; j < 4; ++j) { const int col = 4 * ln + 256 * j; const f32x4 xv = *(const f32x4*)(x + (size_t)t * D + col); const u32x2 mw = *(const u32x2*)(MIX + (size_t)t * D + col);
                    const f32x4 mx = {bf_lo(mw.x), bf_hi(mw.x), bf_lo(mw.y), bf_hi(mw.y)};
                    v[j] = xv * ALPHA + gt[j] * mx; s += (v[j][0] + v[j][1]) + (v[j][2] + v[j][3]); }
                float mean = wave_sum(s) * (1.f / D); float q = 0.f;
#pragma unroll
                for (int j = 0; j < 4; ++j) { v[j] = v[j] - mean; q += (v[j][0] * v[j][0] + v[j][1] * v[j][1]) + (v[j][2] * v[j][2] + v[j][3] * v[j][3]); }
                float rstd = rsqrtf(wave_sum(q) * (1.f / D) + 1e-5f);
                s = 0.f;
#pragma unroll
                for (int j = 0; j < 4; ++j) { v[j] = v[j] * rstd * g1v[j] + b1v[j]; u32x2 w; w.x = cvt_pk_bf16(v[j][0], v[j][1]); w.y = cvt_pk_bf16(v[j][2], v[j][3]); *(u32x2*)(X1 + (size_t)t * D + 4 * ln + 256 * j) = w; s += (v[j][0] + v[j][1]) + (v[j][2] + v[j][3]); }
                mean = wave_sum(s) * (1.f / D); q = 0.f;
#pragma unroll
                for (int j = 0; j < 4; ++j) { v[j] = v[j] - mean; q += (v[j][0] * v[j][0] + v[j][1] * v[j][1]) + (v[j][2] * v[j][2] + v[j][3] * v[j][3]); }
                rstd = rsqrtf(wave_sum(q) * (1.f / D) + 1e-5f);
#pragma unroll
                for (int j = 0; j < 4; ++j) { const f32x4 o = v[j] * rstd * sc[j] + sh[j]; u32x2 w; w.x = cvt_pk_bf16(o[0], o[1]); w.y = cvt_pk_bf16(o[2], o[3]);
                    *(u32x2*)(HB + (size_t)t * D + 4 * ln + 256 * j) = w; } } }
    }
    SEAM(6);
    if (IN(7)) {
        pg8::Gemm g{HB, D, WUP, T, UPW, D}; pg8::StaticOrder S; S.init(T, UPW, G, bx); pg8::EpiUp E5{ACT, E, fcw, fcb};
        pg8::gemm_phase<pg8::EpiUp, true>(lds, g, S, E5);
    }
    SEAM(7);
    if (IN(8)) {
        OPAQUE_LANE(ln);
        constexpr int NITEM = 512 * 2 * (DFF / 4);
        for (int it = (gw * 64 + ln); it < NITEM; it += NGW * 64) { const int c4 = it % (DFF / 4), rb = it / (DFF / 4), rr = rb & 1, blk = rb >> 1; const int c0 = 4 * c4;
            const bool first = (blk & 31) == 0;
            const float* e0 = E + ((size_t)blk * 4 + rr) * UPW + c0;
            const float* em1 = (rr == 0) ? E + ((size_t)(blk - 1) * 4 + 3) * UPW + c0 : E + ((size_t)blk * 4 + 0) * UPW + c0;
            const float* em2 = (rr == 0) ? E + ((size_t)(blk - 1) * 4 + 2) * UPW + c0 : E + ((size_t)(blk - 1) * 4 + 3) * UPW + c0;
            const f32x4 z = {0.f, 0.f, 0.f, 0.f};
            const f32x4 g0 = *(const f32x4*)e0, v0 = *(const f32x4*)(e0 + DFF);
            const bool has1 = !(first && rr == 0), has2 = !first;
            const f32x4 g1 = has1 ? *(const f32x4*)em1 : z, v1 = has1 ? *(const f32x4*)(em1 + DFF) : z;
            const f32x4 g2 = has2 ? *(const f32x4*)em2 : z, v2 = has2 ? *(const f32x4*)(em2 + DFF) : z;
            const f32x4 wg0 = *(const f32x4*)(fcw + c0), wg1 = *(const f32x4*)(fcw + UPW + c0), wg2 = *(const f32x4*)(fcw + 2 * UPW + c0), bg = *(const f32x4*)(fcb + c0);
            const f32x4 wv0 = *(const f32x4*)(fcw + DFF + c0), wv1 = *(const f32x4*)(fcw + UPW + DFF + c0), wv2 = *(const f32x4*)(fcw + 2 * UPW + DFF + c0), bv = *(const f32x4*)(fcb + DFF + c0);
            const f32x4 cg = bg + wg0 * g2 + wg1 * g1 + wg2 * g0, cv = bv + wv0 * v2 + wv1 * v1 + wv2 * v0;
            u32x2 w; w.x = cvt_pk_bf16(silu_f(cg[0]) * cv[0], silu_f(cg[1]) * cv[1]); w.y = cvt_pk_bf16(silu_f(cg[2]) * cv[2], silu_f(cg[3]) * cv[3]);
            *(u32x2*)(ACT + (size_t)(64 * blk + rr) * DFF + c0) = w; }
    }
    SEAM(8);
    if (IN(9)) {
        pg8::Gemm g{ACT, DFF, WDN, T, D, DFF}; pg8::StaticOrder S; S.init(T, D, G, bx); pg8::EpiStore E6{FF, D};
        pg8::gemm_phase<pg8::EpiStore, true>(lds, g, S, E6);
    }
    SEAM(9);
    if (IN(10)) {
        OPAQUE_LANE(ln);
        for (int row0 = gw * 16; row0 < T; row0 += NGW * 16) { const int b = row0 / SEQ; const float* mb = MOD + b * 6144;
            f32x4 gt[4], g2v[4], b2v[4];
#pragma unroll
            for (int j = 0; j < 4; ++j) { const int col = 4 * ln + 256 * j; gt[j] = *(const f32x4*)(mb + 5120 + col); g2v[j] = *(const f32x4*)(ln2g + col); b2v[j] = *(const f32x4*)(ln2b + col); }
            for (int rr = 0; rr < 16; ++rr) { const int t = row0 + rr;
                f32x4 v[4]; float s = 0.f;
#pragma unroll
                for (int j = 0; j < 4; ++j) { const int col = 4 * ln + 256 * j; const u32x2 xw = *(const u32x2*)(X1 + (size_t)t * D + col); const f32x4 xv = {bf_lo(xw.x), bf_hi(xw.x), bf_lo(xw.y), bf_hi(xw.y)}; const u32x2 mw = *(const u32x2*)(FF + (size_t)t * D + col);
                    const f32x4 mx = {bf_lo(mw.x), bf_hi(mw.x), bf_lo(mw.y), bf_hi(mw.y)};
                    v[j] = xv * ALPHA + gt[j] * mx; s += (v[j][0] + v[j][1]) + (v[j][2] + v[j][3]); }
                const float mean = wave_sum(s) * (1.f / D); float q = 0.f;
#pragma unroll
                for (int j = 0; j < 4; ++j) { v[j] = v[j] - mean; q += (v[j][0] * v[j][0] + v[j][1] * v[j][1]) + (v[j][2] * v[j][2] + v[j][3] * v[j][3]); }
                const float rstd = rsqrtf(wave_sum(q) * (1.f / D) + 1e-5f);
#pragma unroll
                for (int j = 0; j < 4; ++j) { *(f32x4*)(out + (size_t)t * D + 4 * ln + 256 * j) = v[j] * rstd * g2v[j] + b2v[j]; } } }
    }
#undef IN
#undef SEAM
}

extern "C" void kernel_launch(void* const* d_in, const int* in_sizes, int n_in, void* d_out, int out_size, void* d_ws, size_t ws_size, hipStream_t stream) {
    static int grid = 0;
    if (grid == 0) {
        if (n_in != 22 || in_sizes[0] != T * D || out_size != T * D || ws_size < WS_END) { fprintf(stderr, "kernel_launch: unexpected shapes / workspace (n_in %d, ws %zu)\n", n_in, ws_size); grid = -1; return; }
        int dev = 0, cus = 0, per_cu = 0;
        if (hipGetDevice(&dev) != hipSuccess || hipDeviceGetAttribute(&cus, hipDeviceAttributeMultiprocessorCount, dev) != hipSuccess) { grid = -1; return; }
        if (hipFuncSetAttribute((const void*)mk_fwd, hipFuncAttributeMaxDynamicSharedMemorySize, LDS_BYTES) != hipSuccess) { fprintf(stderr, "kernel_launch: hipFuncSetAttribute failed\n"); grid = -1; return; }
        if (hipOccupancyMaxActiveBlocksPerMultiprocessor(&per_cu, (const void*)mk_fwd, 512, LDS_BYTES) != hipSuccess || per_cu < 1) { fprintf(stderr, "kernel_launch: occupancy query says %d blocks per CU\n", per_cu); (void)hipGetLastError(); grid = -1; return; }
        grid = cus;
    }
    if (grid < 0) return;
    hipMemsetAsync((char*)d_ws + WS_CTL, 0, CTL_ZERO_BYTES, stream);
    Args a{};
    for (int i = 0; i < 22; ++i) a.in[i] = (const float*)d_in[i];
    a.pos = (const int*)d_in[2]; a.out = (float*)d_out; a.ws = (unsigned char*)d_ws;
#if MK_N_LAUNCHES == 1
    a.ph_lo = 0; a.ph_hi = N_PHASES;
    hipLaunchKernelGGL(mk_fwd, dim3(grid), dim3(512), LDS_BYTES, stream, a);
#else
    for (int p = 0; p < N_PHASES; ++p) { a.ph_lo = p; a.ph_hi = p + 1; hipLaunchKernelGGL(mk_fwd, dim3(grid), dim3(512), LDS_BYTES, stream, a); }
#endif
}
```

```cpp
#include <hip/hip_runtime.h>
#include <cstdio>
#include <cstdint>

#define LAS __attribute__((address_space(3)))
#define GAS __attribute__((address_space(1)))
typedef unsigned short bf16_t;
typedef short bf16x8 __attribute__((ext_vector_type(8)));
typedef short s16x4 __attribute__((ext_vector_type(4)));
typedef float f32x4 __attribute__((ext_vector_type(4)));
typedef float f32x2 __attribute__((ext_vector_type(2)));
typedef float f32x16 __attribute__((ext_vector_type(16)));
typedef unsigned u32x4 __attribute__((ext_vector_type(4)));
typedef unsigned u32x2 __attribute__((ext_vector_type(2)));
typedef GAS unsigned gu32;

#ifndef MK_N_LAUNCHES
#define MK_N_LAUNCHES 1
#endif

constexpr int D = 1024, NB = 16, SEQ = 2048, T = NB * SEQ, NH = 8, DFF = 2816, UPW = 2 * DFF;
constexpr int PW = 1024;
constexpr int G1N = 2048;
constexpr int QW = 768, INW = 1952;
constexpr float ALPHA = 1.189207115002721f;
constexpr float QSCALE = 0.10206207261596575f * 1.4426950408889634f;
constexpr float LOG2E = 1.4426950408889634f;

constexpr size_t MiB = 1u << 20;
constexpr size_t WS_CTL = 0, CTL_ZERO_BYTES = 64 * 1024;
constexpr size_t WS_MOD = 1 * MiB;
constexpr size_t WS_ROPE = 2 * MiB;
constexpr size_t WS_SSQQ = 6 * MiB;
constexpr size_t WS_SSQKV = 6 * MiB + 512 * 1024;
constexpr size_t WS_WIN = 8 * MiB;
constexpr size_t WS_WQ = 12 * MiB;
constexpr size_t WS_WKV = 12 * MiB + 512 * 1024;
constexpr size_t WS_WOUT = 13 * MiB;
constexpr size_t WS_WUP = 15 * MiB;
constexpr size_t WS_WDN = 26 * MiB;
constexpr size_t WS_HB = 32 * MiB;
constexpr size_t WS_FF = 32 * MiB;
constexpr size_t WS_P = 96 * MiB;
constexpr size_t WS_U = 160 * MiB;
constexpr size_t WS_MIX = 96 * MiB;
constexpr size_t WS_Q = 224 * MiB;
constexpr size_t WS_KN = 272 * MiB;
constexpr size_t WS_KR = 304 * MiB;
constexpr size_t WS_V = 306 * MiB;
constexpr size_t WS_Y = 338 * MiB;
constexpr size_t WS_X1 = 338 * MiB;
constexpr size_t WS_ACT = 96 * MiB;
constexpr size_t WS_E = 272 * MiB;
constexpr size_t WS_END = 402 * MiB;
constexpr int CW_BAR = 1024;

constexpr int RING_BYTES = 131072, LDSCTL_OFF = RING_BYTES, MISC_OFF = LDSCTL_OFF + 320, LDS_BYTES = 147456;

__device__ __forceinline__ unsigned cvt_pk_bf16(float lo, float hi) { unsigned r; asm volatile("v_cvt_pk_bf16_f32 %0, %1, %2" : "=v"(r) : "v"(lo), "v"(hi)); return r; }
__device__ __forceinline__ float bf_lo(unsigned u) { return __uint_as_float(u << 16); }
__device__ __forceinline__ float bf_hi(unsigned u) { return __uint_as_float(u & 0xffff0000u); }
__device__ __forceinline__ float fexp2(float x) { return __builtin_amdgcn_exp2f(x); }
__device__ __forceinline__ float frcp(float x) { return __builtin_amdgcn_rcpf(x); }
__device__ __forceinline__ float silu_f(float v) { return v * frcp(1.f + fexp2(-LOG2E * v)); }
__device__ __forceinline__ float wave_sum(float v) {
#pragma unroll
    for (int o = 1; o < 64; o <<= 1) v += __shfl_xor(v, o);
    return v;
}

namespace pg8 {
constexpr int BM = 256, BK = 64, HALF = 128, HTB = HALF * BK * 2, STAGE_BYTES = 8 * HTB, NXCD = 8, WGM = 8;
__host__ __device__ __forceinline__ int lds_byte(int r, int c) { const int st = (r >> 4) * 2 + (c >> 5), rr = r & 15, cc = c & 31, ob = rr * 64 + cc * 2; return st * 1024 + (ob ^ (((ob >> 9) & 1) << 5)); }
__host__ __device__ __forceinline__ void stage_rc(int b, int& R, int& C) { const int st = b / 1024, sb = b % 1024, swz = sb ^ (((sb >> 9) & 1) << 5); R = (st >> 1) * 16 + swz / 64; C = (st & 1) * 32 + (swz % 64) / 2; }
__host__ __device__ __forceinline__ int perm32(int rho) { const int n = rho >> 4, i = rho & 15; return 8 * (i >> 2) + 4 * n + (i & 3); }

struct Unit { int pm, pn; };
struct Gemm { const bf16_t* A; int lda; const bf16_t* Bt; int M, N, K; };

struct StaticOrder {
    int nM, nN, nwg, G, c;
    __device__ __forceinline__ void init(int M, int N, int G_, int c_) { nM = M / BM; nN = N / BM; nwg = nM * nN; G = G_; c = c_; }
    __device__ __forceinline__ bool next(int i, Unit& u) const {
        const long L = (long)i * G + c; if (L >= nwg) return false;
        int wgid = (int)L; { const int q = nwg / NXCD, r = nwg % NXCD, xcd = wgid % NXCD, off = wgid / NXCD; wgid = (xcd < r ? xcd * (q + 1) : r * (q + 1) + (xcd - r) * q) + off; }
        const int nig = WGM * nN, gid = wgid / nig, fm = gid * WGM, gsz = (nM - fm) < WGM ? (nM - fm) : WGM;
        u.pm = fm + ((wgid % nig) % gsz); u.pn = (wgid % nig) / gsz; return true;
    }
};

template <class Epi, bool ALIGN_EPI>
__device__ __forceinline__ void gemm_phase(LAS unsigned char* lds, const Gemm g, const StaticOrder& S, const Epi& E) {
    int tid = threadIdx.x; asm volatile("" : "+v"(tid));
    const int wid = __builtin_amdgcn_readfirstlane(tid >> 6), lane = tid & 63, wr = wid >> 2, wc = wid & 3, fr = lane & 15, fq = lane >> 4;
    const int K = g.K, nt = K / BK;
    unsigned voffA[2], voffB[2];
#pragma unroll
    for (int i = 0; i < 2; ++i) { int R, C; stage_rc(tid * 16 + i * 8192, R, C);
        voffA[i] = (unsigned)(R * g.lda + C) * 2u; voffB[i] = (unsigned)(R * K + C) * 2u; }
    const size_t kstep = (size_t)(BK * 2);
    const size_t hstepA = (size_t)HALF * g.lda * 2, hstepB = (size_t)HALF * K * 2;
    const size_t tstepA = 2 * hstepA, tstepB = 2 * hstepB;
    const unsigned ldsw = (unsigned)wid * 1024u;
    const int aoff = lds_byte(wr * 64 + fr, fq * 8), boff = lds_byte(wc * 32 + fr, fq * 8);
#define PG8_SA(b, h) (((b) * 2 + (h)) * HTB)
#define PG8_SB(b, h) ((4 + (b) * 2 + (h)) * HTB)
#define PG8_STAGE(bufoff, gbase, voff) do { _Pragma("unroll") for (int _i = 0; _i < 2; ++_i) \
        __builtin_amdgcn_global_load_lds((const unsigned*)((const char*)(gbase) + (voff)[_i]), (LAS unsigned*)(lds + (bufoff) + ldsw + _i * 8192), 16, 0, 0); } while (0)
#define PG8_LDA(dst, b, h) do { _Pragma("unroll") for (int m = 0; m < 4; ++m) _Pragma("unroll") for (int k = 0; k < 2; ++k) dst[m][k] = *(const LAS bf16x8*)(lds + PG8_SA(b, h) + aoff + m * 2048 + k * 1024); } while (0)
#define PG8_LDB(dst, b, h) do { _Pragma("unroll") for (int n = 0; n < 2; ++n) _Pragma("unroll") for (int k = 0; k < 2; ++k) dst[n][k] = *(const LAS bf16x8*)(lds + PG8_SB(b, h) + boff + n * 2048 + k * 1024); } while (0)
#define PG8_MMA(ai, bj, At, Bt) do { __builtin_amdgcn_s_setprio(1); _Pragma("unroll") for (int m = 0; m < 4; ++m) _Pragma("unroll") for (int n = 0; n < 2; ++n) _Pragma("unroll") for (int k = 0; k < 2; ++k) \
        acc[ai][bj][m][n] = __builtin_amdgcn_mfma_f32_16x16x32_bf16(Bt[n][k], At[m][k], acc[ai][bj][m][n], 0, 0, 0); __builtin_amdgcn_s_setprio(0); } while (0)
#define PG8_WAIT_V(n) asm volatile("s_waitcnt vmcnt(" #n ")" ::: "memory")
#define PG8_WAIT_L(n) asm volatile("s_waitcnt lgkmcnt(" #n ")" ::: "memory")
#define PG8_BAR __builtin_amdgcn_s_barrier()
#define PG8_SCHED __builtin_amdgcn_sched_barrier(0)
    Unit cur, nxt; int ui = 0;
    if (!S.next(0, cur)) return;
    f32x4 acc[2][2][4][2];
#pragma unroll
    for (int a = 0; a < 2; ++a)
#pragma unroll
        for (int b = 0; b < 2; ++b)
#pragma unroll
            for (int m = 0; m < 4; ++m)
#pragma unroll
                for (int n = 0; n < 2; ++n) acc[a][b][m][n] = (f32x4){0.f, 0.f, 0.f, 0.f};
    bf16x8 At[4][2], B0[2][2], B1[2][2];
    const char* cA = (const char*)g.A + (size_t)cur.pm * tstepA; const char* cB = (const char*)g.Bt + (size_t)cur.pn * tstepB;
    if constexpr (Epi::HAS_PREFETCH) E.prefetch(cur, 0, lds, wid, lane);
    PG8_STAGE(PG8_SB(0, 0), cB, voffB); PG8_STAGE(PG8_SB(0, 1), cB + hstepB, voffB); PG8_STAGE(PG8_SA(0, 0), cA, voffA); PG8_STAGE(PG8_SA(0, 1), cA + hstepA, voffA);
    if (wr == 1) PG8_BAR;
    PG8_WAIT_V(2); PG8_BAR;
    PG8_STAGE(PG8_SB(1, 0), cB + kstep, voffB); PG8_STAGE(PG8_SA(1, 0), cA + kstep, voffA); PG8_STAGE(PG8_SB(1, 1), cB + hstepB + kstep, voffB);
    PG8_WAIT_V(6); PG8_BAR;
    for (;;) {
        const bool has_next = S.next(ui + 1, nxt);
        const char* nA = has_next ? (const char*)g.A + (size_t)nxt.pm * tstepA : cA; const char* nB = has_next ? (const char*)g.Bt + (size_t)nxt.pn * tstepB : cB;
#pragma nounroll
        for (int t = 0; t < nt; t += 2) {
            const bool last = (t == nt - 2);
            const char* a1 = cA + (size_t)(t + 1) * kstep;
            const char* a2 = last ? nA : cA + (size_t)(t + 2) * kstep; const char* b2 = last ? nB : cB + (size_t)(t + 2) * kstep;
            const char* a3 = a2 + kstep; const char* b3 = b2 + kstep;
            const bool rlx = (Epi::NST > 0) && (t == 0) && (ui > 0);
            PG8_LDB(B0, 0, 0); PG8_LDB(B1, 0, 1); PG8_SCHED; PG8_LDA(At, 0, 0); PG8_STAGE(PG8_SA(1, 1), a1 + hstepA, voffA);
            if (rlx) { if constexpr (Epi::NST >= 16) PG8_WAIT_V(24); else PG8_WAIT_V(16); } else PG8_WAIT_V(8);
            PG8_WAIT_L(0); PG8_BAR; PG8_MMA(0, 0, At, B0); PG8_MMA(0, 1, At, B1); PG8_BAR; PG8_SCHED;
            PG8_LDA(At, 0, 1); PG8_STAGE(PG8_SB(0, 0), b2, voffB); PG8_STAGE(PG8_SB(0, 1), b2 + hstepB, voffB); PG8_STAGE(PG8_SA(0, 0), a2, voffA);
            if (rlx) { if constexpr (Epi::NST >= 16) PG8_WAIT_V(24); else PG8_WAIT_V(16); } else PG8_WAIT_V(8);
            PG8_WAIT_L(0); PG8_BAR; PG8_MMA(1, 0, At, B0); PG8_MMA(1, 1, At, B1); PG8_BAR; PG8_SCHED;
            PG8_LDB(B0, 1, 0); PG8_LDB(B1, 1, 1); PG8_SCHED; PG8_LDA(At, 1, 0); PG8_STAGE(PG8_SA(0, 1), a2 + hstepA, voffA);
            PG8_WAIT_V(8); PG8_WAIT_L(0); PG8_BAR; PG8_MMA(0, 0, At, B0); PG8_MMA(0, 1, At, B1); PG8_BAR; PG8_SCHED;
            PG8_LDA(At, 1, 1); PG8_STAGE(PG8_SB(1, 0), b3, voffB); PG8_STAGE(PG8_SB(1, 1), b3 + hstepB, voffB); PG8_STAGE(PG8_SA(1, 0), a3, voffA);
            PG8_WAIT_V(8); PG8_WAIT_L(0); PG8_BAR; PG8_MMA(1, 0, At, B0); PG8_MMA(1, 1, At, B1); PG8_BAR; PG8_SCHED;
        }
        if constexpr (ALIGN_EPI) { if (wr == 0) PG8_BAR; }
        { int t_e = threadIdx.x; asm volatile("" : "+v"(t_e)); const int fr_e = t_e & 15, fq_e = (t_e >> 4) & 3;
          if constexpr (Epi::HAS_PREFETCH) { if (has_next) E.prefetch(nxt, (ui + 1) & 1, lds, wid, t_e & 63); E.run(acc, cur, wr, wc, fr_e, fq_e, lds, ui & 1); }
          else E(acc, cur, wr, wc, fr_e, fq_e); }
        if (!has_next) break;
#pragma unroll
        for (int a = 0; a < 2; ++a)
#pragma unroll
            for (int b = 0; b < 2; ++b)
#pragma unroll
                for (int m = 0; m < 4; ++m)
#pragma unroll
                    for (int n = 0; n < 2; ++n) acc[a][b][m][n] = (f32x4){0.f, 0.f, 0.f, 0.f};
        cur = nxt; cA = nA; cB = nB; ++ui;
        if constexpr (ALIGN_EPI) { if (wr == 1) PG8_BAR; }
    }
    PG8_WAIT_V(0);
    if constexpr (!ALIGN_EPI) { if (wr == 0) PG8_BAR; }
    PG8_BAR;
#undef PG8_SA
#undef PG8_SB
#undef PG8_STAGE
#undef PG8_LDA
#undef PG8_LDB
#undef PG8_MMA
#undef PG8_WAIT_V
#undef PG8_WAIT_L
#undef PG8_BAR
#undef PG8_SCHED
}

struct MUnit { const char* A; const char* B; int nt; unsigned kb2; int type; Unit u; };
template <class Sched, class Disp>
__device__ __forceinline__ void gemm_multi(LAS unsigned char* lds, const Sched& S, const Disp& E) {
    int tid = threadIdx.x; asm volatile("" : "+v"(tid));
    const int wid = __builtin_amdgcn_readfirstlane(tid >> 6), lane = tid & 63, wr = wid >> 2, wc = wid & 3, fr = lane & 15, fq = lane >> 4;
    unsigned voffA[2], rB[2], cB2[2];
#pragma unroll
    for (int i = 0; i < 2; ++i) { int R, C; stage_rc(tid * 16 + i * 8192, R, C); voffA[i] = (unsigned)(R * 1024 + C) * 2u; rB[i] = (unsigned)R; cB2[i] = (unsigned)C * 2u; }
    const size_t kstep = (size_t)(BK * 2);
    const size_t hstepA = (size_t)HALF * 1024 * 2;
    const unsigned ldsw = (unsigned)wid * 1024u;
    const int aoff = lds_byte(wr * 64 + fr, fq * 8), boff = lds_byte(wc * 32 + fr, fq * 8);
#define PG8_SA(b, h) (((b) * 2 + (h)) * HTB)
#define PG8_SB(b, h) ((4 + (b) * 2 + (h)) * HTB)
#define PG8_STAGE(bufoff, gbase, voff) do { _Pragma("unroll") for (int _i = 0; _i < 2; ++_i) \
        __builtin_amdgcn_global_load_lds((const unsigned*)((const char*)(gbase) + (voff)[_i]), (LAS unsigned*)(lds + (bufoff) + ldsw + _i * 8192), 16, 0, 0); } while (0)
#define PG8_LDA(dst, b, h) do { _Pragma("unroll") for (int m = 0; m < 4; ++m) _Pragma("unroll") for (int k = 0; k < 2; ++k) dst[m][k] = *(const LAS bf16x8*)(lds + PG8_SA(b, h) + aoff + m * 2048 + k * 1024); } while (0)
#define PG8_LDB(dst, b, h) do { _Pragma("unroll") for (int n = 0; n < 2; ++n) _Pragma("unroll") for (int k = 0; k < 2; ++k) dst[n][k] = *(const LAS bf16x8*)(lds + PG8_SB(b, h) + boff + n * 2048 + k * 1024); } while (0)
#define PG8_MMA(ai, bj, At, Bt) do { __builtin_amdgcn_s_setprio(1); _Pragma("unroll") for (int m = 0; m < 4; ++m) _Pragma("unroll") for (int n = 0; n < 2; ++n) _Pragma("unroll") for (int k = 0; k < 2; ++k) \
        acc[ai][bj][m][n] = __builtin_amdgcn_mfma_f32_16x16x32_bf16(Bt[n][k], At[m][k], acc[ai][bj][m][n], 0, 0, 0); __builtin_amdgcn_s_setprio(0); } while (0)
#define PG8_WAIT_V(n) asm volatile("s_waitcnt vmcnt(" #n ")" ::: "memory")
#define PG8_WAIT_L(n) asm volatile("s_waitcnt lgkmcnt(" #n ")" ::: "memory")
#define PG8_BAR __builtin_amdgcn_s_barrier()
#define PG8_SCHED __builtin_amdgcn_sched_barrier(0)
    MUnit cur, nxt; int ui = 0; int relax = 0;
    if (!S.next(0, cur)) return;
    f32x4 acc[2][2][4][2];
#pragma unroll
    for (int a = 0; a < 2; ++a)
#pragma unroll
        for (int b = 0; b < 2; ++b)
#pragma unroll
            for (int m = 0; m < 4; ++m)
#pragma unroll
                for (int n = 0; n < 2; ++n) acc[a][b][m][n] = (f32x4){0.f, 0.f, 0.f, 0.f};
    bf16x8 At[4][2], B0[2][2], B1[2][2];
    const char* cA = cur.A; const char* cB = cur.B;
    E.prefetch(cur, 0, lds, wid, lane);
    unsigned voffB[2]; voffB[0] = rB[0] * cur.kb2 + cB2[0]; voffB[1] = rB[1] * cur.kb2 + cB2[1];
    size_t hstepB = (size_t)HALF * cur.kb2;
    PG8_STAGE(PG8_SB(0, 0), cB, voffB); PG8_STAGE(PG8_SB(0, 1), cB + hstepB, voffB); PG8_STAGE(PG8_SA(0, 0), cA, voffA); PG8_STAGE(PG8_SA(0, 1), cA + hstepA, voffA);
    if (wr == 1) PG8_BAR;
    PG8_WAIT_V(2); PG8_BAR;
    PG8_STAGE(PG8_SB(1, 0), cB + kstep, voffB); PG8_STAGE(PG8_SA(1, 0), cA + kstep, voffA); PG8_STAGE(PG8_SB(1, 1), cB + hstepB + kstep, voffB);
    PG8_WAIT_V(6); PG8_BAR;
    for (;;) {
        const bool has_next = S.next(ui + 1, nxt);
        if (!has_next) nxt = cur;
        const char* nA = nxt.A; const char* nB = nxt.B;
        unsigned nvoffB[2]; nvoffB[0] = rB[0] * nxt.kb2 + cB2[0]; nvoffB[1] = rB[1] * nxt.kb2 + cB2[1];
        const size_t nhstepB = (size_t)HALF * nxt.kb2;
        const int nt = cur.nt;
#pragma nounroll
        for (int t = 0; t < nt; t += 2) {
            const bool last = (t == nt - 2);
            const char* a1 = cA + (size_t)(t + 1) * kstep;
            const char* a2 = last ? nA : cA + (size_t)(t + 2) * kstep; const char* b2 = last ? nB : cB + (size_t)(t + 2) * kstep;
            const char* a3 = a2 + kstep; const char* b3 = b2 + kstep;
            unsigned vB2[2]; vB2[0] = last ? nvoffB[0] : voffB[0]; vB2[1] = last ? nvoffB[1] : voffB[1];
            const size_t hB2 = last ? nhstepB : hstepB;
            const int rlx = (t == 0) ? relax : 0;
            PG8_LDB(B0, 0, 0); PG8_LDB(B1, 0, 1); PG8_SCHED; PG8_LDA(At, 0, 0); PG8_STAGE(PG8_SA(1, 1), a1 + hstepA, voffA);
            if (rlx >= 16) PG8_WAIT_V(24); else if (rlx >= 8) PG8_WAIT_V(16); else PG8_WAIT_V(8);
            PG8_WAIT_L(0); PG8_BAR; PG8_MMA(0, 0, At, B0); PG8_MMA(0, 1, At, B1); PG8_BAR; PG8_SCHED;
            PG8_LDA(At, 0, 1); PG8_STAGE(PG8_SB(0, 0), b2, vB2); PG8_STAGE(PG8_SB(0, 1), b2 + hB2, vB2); PG8_STAGE(PG8_SA(0, 0), a2, voffA);
            if (rlx >= 16) PG8_WAIT_V(24); else if (rlx >= 8) PG8_WAIT_V(16); else PG8_WAIT_V(8);
            PG8_WAIT_L(0); PG8_BAR; PG8_MMA(1, 0, At, B0); PG8_MMA(1, 1, At, B1); PG8_BAR; PG8_SCHED;
            PG8_LDB(B0, 1, 0); PG8_LDB(B1, 1, 1); PG8_SCHED; PG8_LDA(At, 1, 0); PG8_STAGE(PG8_SA(0, 1), a2 + hstepA, voffA);
            PG8_WAIT_V(8); PG8_WAIT_L(0); PG8_BAR; PG8_MMA(0, 0, At, B0); PG8_MMA(0, 1, At, B1); PG8_BAR; PG8_SCHED;
            PG8_LDA(At, 1, 1); PG8_STAGE(PG8_SB(1, 0), b3, vB2); PG8_STAGE(PG8_SB(1, 1), b3 + hB2, vB2); PG8_STAGE(PG8_SA(1, 0), a3, voffA);
            PG8_WAIT_V(8); PG8_WAIT_L(0); PG8_BAR; PG8_MMA(1, 0, At, B0); PG8_MMA(1, 1, At, B1); PG8_BAR; PG8_SCHED;
        }
        if (wr == 0) PG8_BAR;
        { int t_e = threadIdx.x; asm volatile("" : "+v"(t_e)); if (has_next) E.prefetch(nxt, (ui + 1) & 1, lds, wid, t_e & 63); E(acc, cur, wr, wc, t_e & 15, (t_e >> 4) & 3, lds, ui & 1); }
        if (!has_next) break;
#pragma unroll
        for (int a = 0; a < 2; ++a)
#pragma unroll
            for (int b = 0; b < 2; ++b)
#pragma unroll
                for (int m = 0; m < 4; ++m)
#pragma unroll
                    for (int n = 0; n < 2; ++n) acc[a][b][m][n] = (f32x4){0.f, 0.f, 0.f, 0.f};
        relax = (cur.type == 0 && cur.u.pn >= 4) ? 8 : 16;
        cur = nxt; cA = nA; cB = nB; voffB[0] = nvoffB[0]; voffB[1] = nvoffB[1]; hstepB = nhstepB; ++ui;
        if (wr == 1) PG8_BAR;
    }
    PG8_WAIT_V(0);
    PG8_BAR;
#undef PG8_SA
#undef PG8_SB
#undef PG8_STAGE
#undef PG8_LDA
#undef PG8_LDB
#undef PG8_MMA
#undef PG8_WAIT_V
#undef PG8_WAIT_L
#undef PG8_BAR
#undef PG8_SCHED
}

typedef f32x4 Acc[2][2][4][2];

struct EpiStore { static constexpr bool HAS_PREFETCH = false; static constexpr int NST = 16;
    bf16_t* O; int ldc;
    __device__ __forceinline__ void operator()(const Acc& acc, const Unit& u, int wr, int wc, int fr, int fq) const {
        const int row0 = u.pm * BM + wr * 64 + fr, col0 = u.pn * BM + wc * 32 + 8 * fq;
#pragma unroll
        for (int ai = 0; ai < 2; ++ai)
#pragma unroll
            for (int m = 0; m < 4; ++m) { bf16_t* rowp = O + (size_t)(row0 + ai * HALF + m * 16) * ldc + col0;
#pragma unroll
                for (int bj = 0; bj < 2; ++bj) { const f32x4 v0 = acc[ai][bj][m][0], v1 = acc[ai][bj][m][1];
                    u32x4 w; w.x = cvt_pk_bf16(v0[0], v0[1]); w.y = cvt_pk_bf16(v0[2], v0[3]); w.z = cvt_pk_bf16(v1[0], v1[1]); w.w = cvt_pk_bf16(v1[2], v1[3]);
                    *(u32x4*)(rowp + bj * HALF) = w; } }
    }
};

struct EpiP { static constexpr bool HAS_PREFETCH = false, AFTER_DRAIN = false; static constexpr int NST = 8;
    bf16_t* O; bf16_t* U; float* ssq_q; float* ssq_kv;
    __device__ __forceinline__ void operator()(const Acc& acc, const Unit& u, int wr, int wc, int fr, int fq) const {
        const int row0 = u.pm * BM + wr * 64 + fr;
        if (u.pn >= 4) {
            bf16_t* ucol = U + 128 * (u.pn - 4) + 32 * wc + 8 * fq;
#pragma unroll
            for (int ai = 0; ai < 2; ++ai)
#pragma unroll
                for (int m = 0; m < 4; ++m) { const f32x4 v0 = acc[ai][0][m][0] * acc[ai][1][m][0], v1 = acc[ai][0][m][1] * acc[ai][1][m][1];
                    u32x4 w; w.x = cvt_pk_bf16(v0[0], v0[1]); w.y = cvt_pk_bf16(v0[2], v0[3]); w.z = cvt_pk_bf16(v1[0], v1[1]); w.w = cvt_pk_bf16(v1[2], v1[3]);
                    *(u32x4*)(ucol + (size_t)(row0 + ai * HALF + m * 16) * 512) = w; }
            return;
        }
        EpiStore st{O, PW}; st(acc, u, wr, wc, fr, fq);
        if (u.pn <= 1) {
            float* dst = (u.pn == 0) ? ssq_q : ssq_kv;
#pragma unroll
            for (int ai = 0; ai < 2; ++ai)
#pragma unroll
                for (int m = 0; m < 4; ++m) { float s = 0.f;
#pragma unroll
                    for (int n = 0; n < 2; ++n) { const f32x4 a = acc[ai][0][m][n]; s += (a[0] * a[0] + a[1] * a[1]) + (a[2] * a[2] + a[3] * a[3]); }
                    if (u.pn == 0) {
#pragma unroll
                        for (int n = 0; n < 2; ++n) { const f32x4 a = acc[ai][1][m][n]; s += (a[0] * a[0] + a[1] * a[1]) + (a[2] * a[2] + a[3] * a[3]); } }
                    s += __shfl_xor(s, 16); s += __shfl_xor(s, 32);
                    if (fq == 0) dst[(size_t)(row0 + ai * HALF + m * 16) * 4 + wc] = s; }
        }
    }
};

struct EpiQ { static constexpr bool HAS_PREFETCH = false, AFTER_DRAIN = false; static constexpr int NST = 0;
    bf16_t* Q; const float* ssq; const float* rope;
    __device__ __forceinline__ void operator()(const Acc& acc, const Unit& u, int wr, int wc, int fr, int fq) const {
        const int row0 = u.pm * BM + wr * 64 + fr;
        float f[2][4];
        { f32x4 sp[2][4];
#pragma unroll
          for (int ai = 0; ai < 2; ++ai)
#pragma unroll
              for (int m = 0; m < 4; ++m) sp[ai][m] = *(const f32x4*)(ssq + (size_t)(row0 + ai * HALF + m * 16) * 4);
#pragma unroll
          for (int ai = 0; ai < 2; ++ai)
#pragma unroll
              for (int m = 0; m < 4; ++m) f[ai][m] = rsqrtf(((sp[ai][m][0] + sp[ai][m][1]) + (sp[ai][m][2] + sp[ai][m][3])) * (1.f / 256.f) + 1e-6f) * QSCALE; }
#pragma unroll
        for (int bj = 0; bj < 2; ++bj) { const int g = 8 * u.pn + 4 * bj + wc; const bool is_rope = (g % 3) == 2;
            bf16_t* qcol = Q + 32 * g;
            if (!is_rope) {
#pragma unroll
                for (int ai = 0; ai < 2; ++ai)
#pragma unroll
                    for (int m = 0; m < 4; ++m) { const int t = row0 + ai * HALF + m * 16;
                        const f32x4 v0 = acc[ai][bj][m][0] * f[ai][m], v1 = acc[ai][bj][m][1] * f[ai][m];
                        u32x4 w; w.x = cvt_pk_bf16(v0[0], v0[1]); w.y = cvt_pk_bf16(v0[2], v0[3]); w.z = cvt_pk_bf16(v1[0], v1[1]); w.w = cvt_pk_bf16(v1[2], v1[3]);
                        *(u32x4*)(qcol + (size_t)t * QW + 8 * fq) = w; }
            } else {
#pragma unroll
                for (int ai = 0; ai < 2; ++ai) { f32x4 cs[4], sn[4];
#pragma unroll
                    for (int m = 0; m < 4; ++m) { const int t = row0 + ai * HALF + m * 16; cs[m] = *(const f32x4*)(rope + (size_t)t * 32 + 4 * fq); sn[m] = *(const f32x4*)(rope + (size_t)t * 32 + 16 + 4 * fq); }
#pragma unroll
                    for (int m = 0; m < 4; ++m) { const int t = row0 + ai * HALF + m * 16;
                        const f32x4 a0 = acc[ai][bj][m][0], a1 = acc[ai][bj][m][1];
                        const f32x4 o1 = (a0 * cs[m] - a1 * sn[m]) * f[ai][m], o2 = (a1 * cs[m] + a0 * sn[m]) * f[ai][m];
                        u32x2 w1, w2; w1.x = cvt_pk_bf16(o1[0], o1[1]); w1.y = cvt_pk_bf16(o1[2], o1[3]); w2.x = cvt_pk_bf16(o2[0], o2[1]); w2.y = cvt_pk_bf16(o2[2], o2[3]);
                        *(u32x2*)(qcol + (size_t)t * QW + 4 * fq) = w1; *(u32x2*)(qcol + (size_t)t * QW + 16 + 4 * fq) = w2; }
                    asm volatile("" ::: "memory"); }
            } }
    }
};

constexpr int SSQ_LDS = RING_BYTES + 1024;
struct EpiKV { static constexpr bool HAS_PREFETCH = false, AFTER_DRAIN = false; static constexpr int NST = 16;
    bf16_t* KN; bf16_t* V;
    __device__ __forceinline__ void operator()(const Acc& acc, const Unit& u, int wr, int wc, int fr, int fq, LAS unsigned char* lds, int buf) const {
        const int b = u.pm >> 3;
        const LAS f32x4* sq = (const LAS f32x4*)(lds + SSQ_LDS + buf * 4096) + wr * 64 + fr;
        float f[2][4];
#pragma unroll
        for (int ai = 0; ai < 2; ++ai)
#pragma unroll
            for (int m = 0; m < 4; ++m) { const f32x4 sp = sq[ai * HALF + m * 16]; f[ai][m] = rsqrtf(((sp[0] + sp[1]) + (sp[2] + sp[3])) * (1.f / 128.f) + 1e-6f); }
#pragma unroll
        for (int bj = 0; bj < 2; ++bj) { const int g = 8 * u.pn + 4 * bj + wc, head = g >> 2, part = g & 3;
            char* base = (part < 2) ? (char*)KN + (4 * part + fq) * 1024 + fr * 16 : (char*)V + (part - 2) * 4096 + fr * 64 + fq * 16;
            const int mstep = (part < 2) ? 256 : 1024;
            base += (size_t)(b * 8 + head) * 32 * 8192;
#pragma unroll
            for (int ai = 0; ai < 2; ++ai) { const int tile = (4 * u.pm + 2 * ai + wr) & 31;
#pragma unroll
                for (int m = 0; m < 4; ++m) {
                    const f32x4 v0 = acc[ai][bj][m][0] * f[ai][m], v1 = acc[ai][bj][m][1] * f[ai][m];
                    u32x4 w; w.x = cvt_pk_bf16(v0[0], v0[1]); w.y = cvt_pk_bf16(v0[2], v0[3]); w.z = cvt_pk_bf16(v1[0], v1[1]); w.w = cvt_pk_bf16(v1[2], v1[3]);
                    *(u32x4*)(base + (size_t)tile * 8192 + m * mstep) = w; } } }
    }
};

struct MixedOrder {
    const char* HB; const char* P; const char* WIN; const char* WQ; const char* WKV; int G, c;
    __device__ __forceinline__ void set_long(int k, MUnit& m) const { const int li = k * G + c, w = (li % NXCD) * 96 + li / NXCD, pm = w / 6, pn = 2 + w % 6;
        m.A = HB + (size_t)pm * (256 * 1024 * 2); m.B = WIN + (size_t)pn * (256 * 1024 * 2); m.nt = 16; m.kb2 = 2048u; m.type = 0; m.u.pm = pm; m.u.pn = pn; }
    __device__ __forceinline__ void set_short(int k, MUnit& m) const { const int si = k * G + c, s = (si % NXCD) * 112 + si / NXCD;
        if (s < 384) { const int pm = s / 3, pn = s % 3; m.A = P + (size_t)pm * (256 * 1024 * 2); m.B = WQ + (size_t)pn * (256 * 256 * 2); m.nt = 4; m.kb2 = 512u; m.type = 1; m.u.pm = pm; m.u.pn = pn; }
        else { const int s2 = s - 384, pm = s2 >> 2, pn = s2 & 3; m.A = P + 512 + (size_t)pm * (256 * 1024 * 2); m.B = WKV + (size_t)pn * (256 * 256 * 2); m.nt = 4; m.kb2 = 512u; m.type = 2; m.u.pm = pm; m.u.pn = pn; } }
    __device__ __forceinline__ bool next(int i, MUnit& m) const {
        const int ns = (c < 128) ? 4 : 3; if (i >= 3 + ns) return false;
        const int k = i >> 1; const bool even = (c & 1) == 0;
        if (i == 6) { set_short(3, m); return true; }
        if (even == ((i & 1) == 0)) set_long(k, m); else set_short(k, m);
        return true;
    }
};
struct EpiMix { EpiP p; EpiStore q; EpiKV kv; const float* ssqkv;
    __device__ __forceinline__ void prefetch(const MUnit& m, int buf, LAS unsigned char* lds, int wid, int lane) const {
        if (m.type == 2 && wid < 4) __builtin_amdgcn_global_load_lds((const unsigned*)(ssqkv + (size_t)m.u.pm * 1024 + wid * 256 + lane * 4), (LAS unsigned*)(lds + SSQ_LDS + buf * 4096 + wid * 1024), 16, 0, 0);
    }
    __device__ __forceinline__ void operator()(const Acc& acc, const MUnit& m, int wr, int wc, int fr, int fq, LAS unsigned char* lds, int buf) const {
        if (m.type == 0) p(acc, m.u, wr, wc, fr, fq); else if (m.type == 1) q(acc, m.u, wr, wc, fr, fq); else kv(acc, m.u, wr, wc, fr, fq, lds, buf);
    }
};

template <int CTRL> __device__ __forceinline__ float dppf(float v) { return __builtin_bit_cast(float, __builtin_amdgcn_update_dpp(0, __builtin_bit_cast(int, v), CTRL, 0xf, 0xf, true)); }
template <int CTRL> __device__ __forceinline__ f32x4 dpp4(f32x4 v) { f32x4 r; r[0] = dppf<CTRL>(v[0]); r[1] = dppf<CTRL>(v[1]); r[2] = dppf<CTRL>(v[2]); r[3] = dppf<CTRL>(v[3]); return r; }

constexpr int CW_LDS = RING_BYTES + 1024;
struct EpiUp { static constexpr bool HAS_PREFETCH = true; static constexpr int NST = 0;
    bf16_t* ACT; float* E; const float* cw; const float* cb;
    __device__ __forceinline__ void prefetch(const Unit& u, int buf, LAS unsigned char* lds, int wid, int lane) const {
        if (wid < 4) { const float* base = (wid < 3) ? cw + (size_t)wid * UPW : cb;
            const float* src = base + 128 * u.pn + ((lane & 32) ? DFF : 0) + 4 * (lane & 31);
            __builtin_amdgcn_global_load_lds((const unsigned*)src, (LAS unsigned*)(lds + CW_LDS + buf * 4096 + wid * 1024), 16, 0, 0); }
    }
    __device__ __forceinline__ void run(const Acc& acc, const Unit& u, int wr, int wc, int fr, int fq, LAS unsigned char* lds, int buf) const {
        const int cl = 32 * wc + 8 * fq;
        const int cbase = 128 * u.pn + cl;
        const LAS float* wl = (const LAS float*)(lds + CW_LDS + buf * 4096) + cl;
        u32x2 res0[2][4];
#pragma unroll
        for (int n = 0; n < 2; ++n) { const int c0 = cbase + 4 * n;
            const f32x4 wg0 = *(const LAS f32x4*)(wl + 4 * n), wg1 = *(const LAS f32x4*)(wl + 256 + 4 * n), wg2 = *(const LAS f32x4*)(wl + 512 + 4 * n), bg = *(const LAS f32x4*)(wl + 768 + 4 * n);
            const f32x4 wv0 = *(const LAS f32x4*)(wl + 128 + 4 * n), wv1 = *(const LAS f32x4*)(wl + 384 + 4 * n), wv2 = *(const LAS f32x4*)(wl + 640 + 4 * n), bv = *(const LAS f32x4*)(wl + 896 + 4 * n);
#pragma unroll
            for (int ai = 0; ai < 2; ++ai) { f32x4 pg1 = {0.f, 0.f, 0.f, 0.f}, pg2 = pg1, pv1 = pg1, pv2 = pg1;
                const int blk = 4 * u.pm + 2 * ai + wr;
#pragma unroll
                for (int m = 0; m < 4; ++m) { const f32x4 gcur = acc[ai][0][m][n], vcur = acc[ai][1][m][n];
                    const f32x4 rg1 = dpp4<0x121>(gcur), rg2 = dpp4<0x122>(gcur), rv1 = dpp4<0x121>(vcur), rv2 = dpp4<0x122>(vcur);
                    const f32x4 g1 = (fr >= 1) ? rg1 : pg1, g2 = (fr >= 2) ? rg2 : pg2, v1 = (fr >= 1) ? rv1 : pv1, v2 = (fr >= 2) ? rv2 : pv2;
                    const f32x4 cg = bg + wg0 * g2 + wg1 * g1 + wg2 * gcur, cv = bv + wv0 * v2 + wv1 * v1 + wv2 * vcur;
                    f32x4 a; a[0] = silu_f(cg[0]) * cv[0]; a[1] = silu_f(cg[1]) * cv[1]; a[2] = silu_f(cg[2]) * cv[2]; a[3] = silu_f(cg[3]) * cv[3];
                    u32x2 w; w.x = cvt_pk_bf16(a[0], a[1]); w.y = cvt_pk_bf16(a[2], a[3]);
                    const int t = u.pm * BM + ai * HALF + wr * 64 + m * 16 + fr;
                    if (n == 0) res0[ai][m] = w;
                    else if (!(m == 0 && fr < 2)) { u32x4 o; o.x = res0[ai][m].x; o.y = res0[ai][m].y; o.z = w.x; o.w = w.y; *(u32x4*)(ACT + (size_t)t * DFF + cbase) = o; }
                    if (m == 0 && fr < 2) { float* e = E + ((size_t)blk * 4 + fr) * UPW + c0; *(f32x4*)e = gcur; *(f32x4*)(e + DFF) = vcur; }
                    if (m == 3 && fr >= 14) { float* e = E + ((size_t)blk * 4 + 2 + (fr - 14)) * UPW + c0; *(f32x4*)e = gcur; *(f32x4*)(e + DFF) = vcur; }
                    pg1 = rg1; pg2 = rg2; pv1 = rv1; pv2 = rv2; } } }
    }
};
}

namespace att {
constexpr int NSLOT = 3, K_OFF = 0, KSLOT = 12288, V_OFF = NSLOT * KSLOT, VSLOT = 8192, WS_OFF = V_OFF + NSLOT * VSLOT, OST_OFF = WS_OFF + 8 * 256, LDS_END = OST_OFF + 8 * 8192;
static_assert(LDS_END <= RING_BYTES, "attention LDS");
__device__ __forceinline__ int crow(int r, int hi) { return (r & 3) + 8 * (r >> 2) + 4 * hi; }
typedef short v4i16_t __attribute__((ext_vector_type(4)));
__device__ __forceinline__ s16x4 vtr(const LAS unsigned char* p) { return __builtin_bit_cast(s16x4, __builtin_amdgcn_ds_read_tr16_b64_v4i16((LAS v4i16_t*)p)); }
__device__ __forceinline__ void glds(const char* src, LAS unsigned char* dst) { unsigned keep; const unsigned d = (unsigned)__builtin_amdgcn_readfirstlane((int)(unsigned)(uintptr_t)dst);
    asm volatile("s_mov_b32 %0, m0\n\ts_mov_b32 m0, %2\n\ts_nop 0\n\tglobal_load_lds_dwordx4 %1, off\n\ts_mov_b32 m0, %0" : "=&s"(keep) : "v"(src), "s"(d) : "memory"); }
__device__ __forceinline__ float max3f(float a, float b, float c) { float r; asm("v_max3_f32 %0, %1, %2, %3" : "=v"(r) : "v"(a), "v"(b), "v"(c)); return r; }
__device__ __forceinline__ float max2f(float a, float b) { float r; asm("v_max_f32_e32 %0, %1, %2" : "=v"(r) : "v"(a), "v"(b)); return r; }
__device__ __forceinline__ float fadd_s(float a, float b) { float r = a + b; asm volatile("" : "+v"(r)); return r; }
typedef float f32x2_t __attribute__((ext_vector_type(2))); typedef __bf16 bf16x2_t __attribute__((ext_vector_type(2)));
__device__ __forceinline__ unsigned cvtpk_m(float lo, float hi) { f32x2_t v = {lo, hi}; bf16x2_t b2 = __builtin_convertvector(v, bf16x2_t); return __builtin_bit_cast(unsigned, b2); }
constexpr float THRL = 4.0f;

struct AUnit { int b, h, qb; };
__device__ __forceinline__ bool unit_of(int k, int vcu, int G, AUnit& u) {
    const int it = vcu + (k >> 2) * G, r = k & 3; if (it >= 256) return false;
    const int grp = it >> 3, i8 = it & 7, bh = grp * 4 + r; u.b = bh >> 3; u.h = bh & 7;
    u.qb = (r == 0) ? 7 - i8 : (r == 1) ? i8 : (r == 2) ? 7 - (i8 ^ 1) : (i8 ^ 1); return true;
}
__device__ __forceinline__ void attn_phase(int vcu, int G, const float* ssqq, const float* rope, const bf16_t* Q, const bf16_t* KN, const bf16_t* KR, const bf16_t* V, bf16_t* Y, const float* ong, LAS unsigned char* lds) {
    int tid = threadIdx.x; asm volatile("" : "+v"(tid));
    const int lane = tid & 63, r32 = lane & 31, hi = lane >> 5; const int wid = __builtin_amdgcn_readfirstlane(tid >> 6);
    const int lo16 = wid * 1024 + lane * 16;
    LAS float* wsf = (LAS float*)(lds + WS_OFF + wid * 256);
    const int kl = hi * 1024 + r32 * 16, vl = ((lane >> 4) & 1) * 32 + (lane & 3) * 8 + (4 * hi + ((lane & 15) >> 2)) * 64;
#define ATT_ISSUE(U, tile, slot) do { const size_t bh_ = (size_t)((U).b * 8 + (U).h); \
        glds((const char*)KN + (bh_ * 32 + (tile)) * 8192 + lo16, lds + K_OFF + (slot) * KSLOT + wid * 1024); glds((const char*)V + (bh_ * 32 + (tile)) * 8192 + lo16, lds + V_OFF + (slot) * VSLOT + wid * 1024); \
        if (wid < 4) glds((const char*)KR + ((size_t)(U).b * 32 + (tile)) * 4096 + lo16, lds + K_OFF + (slot) * KSLOT + 8192 + wid * 1024); } while (0)
#define ATT_QLOAD(dst, aux, U) do { const size_t row_ = (size_t)((U).b * SEQ + 256 * (U).qb + 32 * wid + r32); const bf16_t* qp_ = Q + row_ * QW + 96 * (U).h + 8 * hi; \
        _Pragma("unroll") for (int ks = 0; ks < 6; ++ks) dst[ks] = *(const bf16x8*)(qp_ + 16 * ks); \
        aux[0] = *(const f32x4*)(ssqq + row_ * 4); aux[1] = *(const f32x4*)(rope + row_ * 32 + 8 * hi); aux[2] = *(const f32x4*)(rope + row_ * 32 + 8 * hi + 4); \
        aux[3] = *(const f32x4*)(rope + row_ * 32 + 16 + 8 * hi); aux[4] = *(const f32x4*)(rope + row_ * 32 + 16 + 8 * hi + 4); } while (0)
#define ATT_QFIX(q, aux) do { const float f_ = rsqrtf(((aux[0][0] + aux[0][1]) + (aux[0][2] + aux[0][3])) * (1.f / 256.f) + 1e-6f) * QSCALE; \
        _Pragma("unroll") for (int ks = 0; ks < 4; ++ks) { const u32x4 w_ = __builtin_bit_cast(u32x4, q[ks]); u32x4 o_; \
            _Pragma("unroll") for (int e = 0; e < 4; ++e) o_[e] = cvtpk_m(bf_lo(w_[e]) * f_, bf_hi(w_[e]) * f_); q[ks] = __builtin_bit_cast(bf16x8, o_); } \
        { const u32x4 a_ = __builtin_bit_cast(u32x4, q[4]), b_ = __builtin_bit_cast(u32x4, q[5]); u32x4 oa_, ob_; \
          _Pragma("unroll") for (int e = 0; e < 4; ++e) { const float x1l = bf_lo(a_[e]), x1h = bf_hi(a_[e]), x2l = bf_lo(b_[e]), x2h = bf_hi(b_[e]); \
              const float cl = (e < 2) ? aux[1][2 * e] : aux[2][2 * e - 4], ch = (e < 2) ? aux[1][2 * e + 1] : aux[2][2 * e - 3], sl = (e < 2) ? aux[3][2 * e] : aux[4][2 * e - 4], sh = (e < 2) ? aux[3][2 * e + 1] : aux[4][2 * e - 3]; \
              oa_[e] = cvtpk_m((x1l * cl - x2l * sl) * f_, (x1h * ch - x2h * sh) * f_); ob_[e] = cvtpk_m((x2l * cl + x1l * sl) * f_, (x2h * ch + x1h * sh) * f_); } \
          q[4] = __builtin_bit_cast(bf16x8, oa_); q[5] = __builtin_bit_cast(bf16x8, ob_); } } while (0)
    AUnit cur, nxt;
    if (!unit_of(0, vcu, G, cur)) return;
    bf16x8 qr[6], qn[6]; f32x4 qa[5], qna[5];
    ATT_QLOAD(qr, qa, cur);
    ATT_QFIX(qr, qa);
    asm volatile("" : "+v"(qr[0]), "+v"(qr[1]), "+v"(qr[2]), "+v"(qr[3]), "+v"(qr[4]), "+v"(qr[5]));
    ATT_ISSUE(cur, 0, 0); ATT_ISSUE(cur, 1, 1);
    int slot = 0;
    for (int k = 0;; ++k) {
        const bool has_next = unit_of(k + 1, vcu, G, nxt);
        const int NT = 4 * cur.qb + 4, jmax = 4 * cur.qb + (wid >> 1);
        float mrun = 0.f, lrun = 0.f; f32x16 o[2]; o[0] = f32x16{}; o[1] = f32x16{}; f32x16 negm = f32x16{};
        for (int j = 0; j < NT; ++j) {
            if (j == 0 && k > 0) { if (wid < 4) asm volatile("s_waitcnt vmcnt(13) lgkmcnt(0)\n\ts_barrier" ::: "memory"); else asm volatile("s_waitcnt vmcnt(12) lgkmcnt(0)\n\ts_barrier" ::: "memory"); }
            else if (j + 1 < NT || has_next) { if (wid < 4) asm volatile("s_waitcnt vmcnt(3) lgkmcnt(0)\n\ts_barrier" ::: "memory"); else asm volatile("s_waitcnt vmcnt(2) lgkmcnt(0)\n\ts_barrier" ::: "memory"); }
            else asm volatile("s_waitcnt vmcnt(0) lgkmcnt(0)\n\ts_barrier" ::: "memory");
            { const int s2 = (slot == 0) ? 2 : slot - 1;
              if (j + 2 < NT) ATT_ISSUE(cur, j + 2, s2); else if (has_next) ATT_ISSUE(nxt, j + 2 - NT, s2); }
            if (j == NT - 1 && has_next) ATT_QLOAD(qn, qna, nxt);
            if (j <= jmax) {
                const LAS unsigned char* kp = lds + K_OFF + slot * KSLOT + kl;
                f32x16 p0, p1;
#pragma unroll
                for (int ks = 0; ks < 6; ++ks) { const bf16x8 k0 = *(const LAS bf16x8*)(kp + ks * 2048), k1 = *(const LAS bf16x8*)(kp + ks * 2048 + 512);
                    if (ks == 0) { p0 = __builtin_amdgcn_mfma_f32_32x32x16_bf16(k0, qr[0], negm, 0, 0, 0); p1 = __builtin_amdgcn_mfma_f32_32x32x16_bf16(k1, qr[0], negm, 0, 0, 0); }
                    else { p0 = __builtin_amdgcn_mfma_f32_32x32x16_bf16(k0, qr[ks], p0, 0, 0, 0); p1 = __builtin_amdgcn_mfma_f32_32x32x16_bf16(k1, qr[ks], p1, 0, 0, 0); } }
                asm volatile("s_nop 15\n\ts_nop 7" : "+v"(p0), "+v"(p1));
                float rm;
                { float a = max3f(p0[0], p0[1], p1[0]), c = max3f(p0[2], p0[3], p1[1]); a = max3f(a, p1[2], p1[3]);
#pragma unroll
                  for (int r = 4; r < 16; r += 4) { a = max3f(a, p0[r], p0[r + 1]); c = max3f(c, p0[r + 2], p0[r + 3]); a = max3f(a, p1[r], p1[r + 1]); c = max3f(c, p1[r + 2], p1[r + 3]); }
                  rm = max2f(a, c); rm = max2f(rm, __shfl_xor(rm, 32)); }
                if (j == 0 || __any(rm > THRL)) {
                    const float dl = (j == 0) ? rm : fmaxf(rm, 0.f);
                    mrun += dl;
#pragma unroll
                    for (int r = 0; r < 16; ++r) { p0[r] -= dl; p1[r] -= dl; }
#pragma unroll
                    for (int r = 0; r < 16; ++r) negm[r] = -mrun;
                    if (j != 0) { const float alpha = fexp2(-dl); lrun *= alpha;
                        if (hi == 0) wsf[r32] = alpha;
#pragma unroll
                        for (int r = 0; r < 16; ++r) { const float a_ = wsf[crow(r, hi)]; o[0][r] *= a_; o[1][r] *= a_; } }
                }
#pragma unroll
                for (int r = 0; r < 16; ++r) { p0[r] = fexp2(p0[r]); p1[r] = fexp2(p1[r]); }
                { float s0 = fadd_s(p0[0], p1[0]), s1 = fadd_s(p0[1], p1[1]);
#pragma unroll
                  for (int r = 2; r < 16; r += 2) { s0 = fadd_s(s0, p0[r]); s1 = fadd_s(s1, p0[r + 1]); s0 = fadd_s(s0, p1[r]); s1 = fadd_s(s1, p1[r + 1]); }
                  lrun = fadd_s(lrun, fadd_s(s0, s1)); }
                bf16x8 pa[4];
                { u32x4 w0, w1, w2, w3;
                  w0.x = cvtpk_m(p0[0], p0[1]); w0.y = cvtpk_m(p0[2], p0[3]); w0.z = cvtpk_m(p0[4], p0[5]); w0.w = cvtpk_m(p0[6], p0[7]);
                  w1.x = cvtpk_m(p0[8], p0[9]); w1.y = cvtpk_m(p0[10], p0[11]); w1.z = cvtpk_m(p0[12], p0[13]); w1.w = cvtpk_m(p0[14], p0[15]);
                  w2.x = cvtpk_m(p1[0], p1[1]); w2.y = cvtpk_m(p1[2], p1[3]); w2.z = cvtpk_m(p1[4], p1[5]); w2.w = cvtpk_m(p1[6], p1[7]);
                  w3.x = cvtpk_m(p1[8], p1[9]); w3.y = cvtpk_m(p1[10], p1[11]); w3.z = cvtpk_m(p1[12], p1[13]); w3.w = cvtpk_m(p1[14], p1[15]);
                  pa[0] = __builtin_bit_cast(bf16x8, w0); pa[1] = __builtin_bit_cast(bf16x8, w1); pa[2] = __builtin_bit_cast(bf16x8, w2); pa[3] = __builtin_bit_cast(bf16x8, w3); }
                const LAS unsigned char* vp = lds + V_OFF + slot * VSLOT + vl;
#pragma unroll
                for (int d0 = 0; d0 < 2; ++d0)
#pragma unroll
                    for (int ks = 0; ks < 4; ++ks) { const s16x4 lo = vtr(vp + d0 * 4096 + ks * 1024), hh = vtr(vp + d0 * 4096 + ks * 1024 + 512);
                        const bf16x8 vf = {lo[0], lo[1], lo[2], lo[3], hh[0], hh[1], hh[2], hh[3]};
                        o[d0] = __builtin_amdgcn_mfma_f32_32x32x16_bf16(pa[ks], vf, o[d0], 0, 0, 0); }
            }
            slot = (slot == 2) ? 0 : slot + 1;
        }
        { const float lt = lrun + __shfl_xor(lrun, 32);
          if (hi == 0) wsf[r32] = frcp(lt);
          LAS float* stg = (LAS float*)(lds + OST_OFF + wid * 8192);
#pragma unroll
          for (int r = 0; r < 16; ++r) { const float inv = wsf[crow(r, hi)]; const int orow = crow(r, hi); stg[orow * 64 + r32] = o[0][r] * inv; stg[orow * 64 + 32 + r32] = o[1][r] * inv; }
          asm volatile("s_waitcnt lgkmcnt(0)" ::: "memory");
          const int ch = lane & 7;
          const f32x4 ga = *(const f32x4*)(ong + 64 * cur.h + 8 * ch), gb = *(const f32x4*)(ong + 64 * cur.h + 8 * ch + 4);
          bf16_t* Yw = Y + (size_t)(cur.b * SEQ + 256 * cur.qb + 32 * wid) * D + 64 * cur.h + 8 * ch;
#pragma unroll
          for (int i = 0; i < 4; ++i) { const int row = i * 8 + (lane >> 3);
              const f32x4 va = *(const LAS f32x4*)(stg + row * 64 + 8 * ch), vb = *(const LAS f32x4*)(stg + row * 64 + 8 * ch + 4);
              float ss = (va[0] * va[0] + va[1] * va[1]) + (va[2] * va[2] + va[3] * va[3]) + (vb[0] * vb[0] + vb[1] * vb[1]) + (vb[2] * vb[2] + vb[3] * vb[3]);
              ss += pg8::dppf<0xB1>(ss); ss += pg8::dppf<0x4E>(ss); ss += pg8::dppf<0x141>(ss);
              const float rs = rsqrtf(ss * (1.f / 64.f) + 1e-6f);
              const f32x4 oa = va * rs * ga, ob = vb * rs * gb;
              u32x4 w; w.x = cvtpk_m(oa[0], oa[1]); w.y = cvtpk_m(oa[2], oa[3]); w.z = cvtpk_m(ob[0], ob[1]); w.w = cvtpk_m(ob[2], ob[3]);
              *(u32x4*)(Yw + (size_t)row * D) = w; } }
        if (!has_next) break;
        cur = nxt;
#pragma unroll
        for (int ks = 0; ks < 6; ++ks) qr[ks] = qn[ks];
        ATT_QFIX(qr, qna);
    }
    asm volatile("s_waitcnt vmcnt(0) lgkmcnt(0)\n\ts_barrier" ::: "memory");
#undef ATT_ISSUE
#undef ATT_QLOAD
#undef ATT_QFIX
}
}

#define XB_TMO      128
#define XB_XCNT(j)  (256  + 64 * (j))
#define XB_XSUB(j)  (1280 + 64 * (j))
#define XB_XGEN(j)  (2304 + 64 * (j))
#define XB_TOP      3328
#define XB_TOPGEN   3392
#define XCD_BAR_WORDS 3456
#define XB_SPIN_CAP (1u << 18)
__device__ __forceinline__ unsigned xb_ld(unsigned* p)              { return __hip_atomic_load(p, __ATOMIC_RELAXED, __HIP_MEMORY_SCOPE_AGENT); }
__device__ __forceinline__ unsigned xb_add(unsigned* p, unsigned v) { return __hip_atomic_fetch_add(p, v, __ATOMIC_RELAXED, __HIP_MEMORY_SCOPE_AGENT); }
__device__ __forceinline__ unsigned xb_xcc_id() { return (unsigned)__builtin_amdgcn_s_getreg((3 << 11) | 20) & 0xFu; }
#define XB_SPIN(cond, bar) do { unsigned _sp = 0; while (cond) { __builtin_amdgcn_s_sleep(1); \
    if ((++_sp & 255u) == 0u) { if (xb_ld(&(bar)[XB_TMO])) break; if (_sp > XB_SPIN_CAP) { atomicAdd(&(bar)[XB_TMO], 1u); break; } } } } while (0)
struct XcdBarrier { unsigned* bar; unsigned x; volatile LAS unsigned* st; };
__device__ __forceinline__ XcdBarrier xcd_barrier_post(unsigned* bar, volatile LAS unsigned* st) {
    XcdBarrier b; b.bar = bar; b.x = xb_xcc_id(); b.st = st;
    if (threadIdx.x == 0) (void)xb_add(&bar[XB_XCNT(b.x)], 1u);
    return b;
}
__device__ __forceinline__ void xcd_barrier_complete(unsigned* bar, unsigned x, unsigned& nloc, unsigned& nx) {
    const unsigned G = gridDim.x * gridDim.y * gridDim.z;
    unsigned sum, cnt, mine, sp = 0u;
    for (;;) {
        sum = 0u; cnt = 0u; mine = 0u;
#pragma unroll
        for (unsigned j = 0; j < 16; ++j) { const unsigned c = xb_ld(&bar[XB_XCNT(j)]); sum += c; cnt += (c > 0u) ? 1u : 0u; mine = (j == x) ? c : mine; }
        if (sum == G) break;
        __builtin_amdgcn_s_sleep(1);
        if ((++sp & 255u) == 0u) { if (xb_ld(&bar[XB_TMO])) break; if (sp > XB_SPIN_CAP) { atomicAdd(&bar[XB_TMO], 1u); break; } }
    }
    nloc = mine > 0u ? mine : 1u; nx = cnt > 0u ? cnt : 1u;
}
__device__ __forceinline__ void xcd_barrier(const XcdBarrier& b) {
    asm volatile("s_waitcnt vmcnt(0)" ::: "memory");
    __syncthreads();
    if (threadIdx.x == 0) {
        unsigned* bar = b.bar;
        __builtin_amdgcn_s_waitcnt(0);
        unsigned nloc = b.st[0], nx = b.st[1];
        if (nloc == 0u) { xcd_barrier_complete(bar, b.x, nloc, nx); b.st[0] = nloc; b.st[1] = nx; }
        const unsigned old = xb_add(&bar[XB_XSUB(b.x)], 1u);
        const unsigned gen = old / nloc;
        if (old + 1u == (gen + 1u) * nloc) {
            __builtin_amdgcn_fence(__ATOMIC_RELEASE, "agent");
            asm volatile("s_waitcnt vmcnt(0)" ::: "memory");
            const unsigned og = xb_add(&bar[XB_TOP], 1u);
            const unsigned tg = og / nx;
            if (og + 1u == (tg + 1u) * nx) xb_add(&bar[XB_TOPGEN], 1u);
            else XB_SPIN(xb_ld(&bar[XB_TOPGEN]) == tg, bar);
            __builtin_amdgcn_fence(__ATOMIC_ACQUIRE, "agent");
            xb_add(&bar[XB_XGEN(b.x)], 1u);
            asm volatile("s_waitcnt vmcnt(0)" ::: "memory");
        } else {
            XB_SPIN(xb_ld(&bar[XB_XGEN(b.x)]) == gen, bar);
            __builtin_amdgcn_fence(__ATOMIC_ACQUIRE, "agent");
            asm volatile("s_waitcnt vmcnt(0)" ::: "memory");
        }
    }
    __syncthreads();
}

struct Args { const float* in[22]; const int* pos; float* out; unsigned char* ws; int ph_lo, ph_hi; };
__constant__ float c_invfreq[16] = {1.0f, 0.5623413251903491f, 0.31622776601683794f, 0.1778279410038923f, 0.1f, 0.05623413251903491f, 0.03162277660168379f, 0.01778279410038923f,
                                    0.01f, 0.005623413251903491f, 0.0031622776601683794f, 0.001778279410038923f, 0.001f, 0.0005623413251903491f, 0.00031622776601683794f, 0.0001778279410038923f};

__device__ __forceinline__ int colmap(int which, int s) {
    const int p = (s & ~31) + pg8::perm32(s & 31);
    switch (which) {
        case 0: { if (s < 1024) return p < 416 ? p : (p < 512 ? -1 : p - 96);
                  const int bj = (s >> 7) & 1, ch = 128 * ((s >> 8) - 4) + 32 * ((s >> 5) & 3) + pg8::perm32(s & 31); return (bj ? 1440 : 928) + ch; }
        case 4: { const int pn = s >> 8, bj = (s >> 7) & 1, wc = (s >> 5) & 3; return bj * DFF + 128 * pn + 32 * wc + pg8::perm32(s & 31); }
        default: return p;
    }
}
__device__ __forceinline__ void p0_transpose_item(const float* W, int ldw, int Ksrc, const float* kscale, bf16_t* WT, int Kdst, int which, LAS float* scr, int item, int nblk, int lane) {
    const int kb = item / nblk, nb = item % nblk, k0 = 64 * kb, s0 = 32 * nb;
    const int cm = colmap(which, s0 + (lane & 31));
    float tv[32];
#pragma unroll
    for (int i = 0; i < 32; ++i) { const int k = k0 + 2 * i + (lane >> 5); tv[i] = (cm >= 0 && k < Ksrc) ? W[(size_t)k * ldw + cm] : 0.f; }
    if (kscale) {
#pragma unroll
        for (int i = 0; i < 32; ++i) { const int k = k0 + 2 * i + (lane >> 5); if (k < Ksrc) tv[i] *= kscale[k]; } }
#pragma unroll
    for (int i = 0; i < 32; ++i) scr[(2 * i + (lane >> 5)) * 33 + (lane & 31)] = tv[i];
    asm volatile("s_waitcnt lgkmcnt(0)" ::: "memory");
    const int c = lane & 7;
#pragma unroll
    for (int j = 0; j < 4; ++j) { const int n = (lane >> 3) + 8 * j; const LAS float* s = scr + (8 * c) * 33 + n;
        u32x4 o; o.x = cvt_pk_bf16(s[0 * 33], s[1 * 33]); o.y = cvt_pk_bf16(s[2 * 33], s[3 * 33]); o.z = cvt_pk_bf16(s[4 * 33], s[5 * 33]); o.w = cvt_pk_bf16(s[6 * 33], s[7 * 33]);
        *(u32x4*)(WT + (size_t)(s0 + n) * Kdst + k0 + 8 * c) = o; }
    asm volatile("s_waitcnt lgkmcnt(0)" ::: "memory");
}

constexpr int N_PHASES = 11;
#define OPAQUE_LANE(name) int name##_t = (int)threadIdx.x; asm volatile("" : "+v"(name##_t)); const int name = name##_t & 63

__global__ void __launch_bounds__(512, 2) mk_fwd(Args args) {
    extern __shared__ __attribute__((aligned(16))) unsigned char lds_raw[];
    LAS unsigned char* lds = (LAS unsigned char*)lds_raw;
    volatile LAS unsigned* MISC = (volatile LAS unsigned*)(lds + MISC_OFF);
    const int tid = threadIdx.x, lane = tid & 63, wave = __builtin_amdgcn_readfirstlane(tid >> 6);
    const int G = gridDim.x; const int bx = blockIdx.x; const int vcu = (G % 8 == 0) ? (bx % 8) * (G / 8) + bx / 8 : bx;
    const int gw = vcu * 8 + wave, NGW = G * 8;
    unsigned char* ws = args.ws;
    const float* x = args.in[0]; const float* cvec = args.in[1]; const int* pos = args.pos;
    const float* w_ada = args.in[3]; const float* b_ada = args.in[4]; const float* w_in = args.in[5];
    const float* qg = args.in[6]; const float* w_qup = args.in[7]; const float* kvg = args.in[8]; const float* w_kvup = args.in[9];
    const float* conv_w = args.in[10]; const float* conv_b = args.in[11]; const float* ong = args.in[12]; const float* w_out = args.in[13];
    const float* ln1g = args.in[14]; const float* ln1b = args.in[15]; const float* w_up = args.in[16];
    const float* fcw = args.in[17]; const float* fcb = args.in[18]; const float* w_down = args.in[19];
    const float* ln2g = args.in[20]; const float* ln2b = args.in[21];
    float* out = args.out;
    float* MOD = (float*)(ws + WS_MOD); float* ROPE = (float*)(ws + WS_ROPE); float* SSQQ = (float*)(ws + WS_SSQQ); float* SSQKV = (float*)(ws + WS_SSQKV);
    bf16_t* WIN = (bf16_t*)(ws + WS_WIN); bf16_t* WQ = (bf16_t*)(ws + WS_WQ); bf16_t* WKV = (bf16_t*)(ws + WS_WKV); bf16_t* WOUT = (bf16_t*)(ws + WS_WOUT);
    bf16_t* WUP = (bf16_t*)(ws + WS_WUP); bf16_t* WDN = (bf16_t*)(ws + WS_WDN);
    bf16_t* HB = (bf16_t*)(ws + WS_HB); bf16_t* FF = (bf16_t*)(ws + WS_FF); bf16_t* P = (bf16_t*)(ws + WS_P); bf16_t* MIX = (bf16_t*)(ws + WS_MIX);
    bf16_t* U = (bf16_t*)(ws + WS_U); bf16_t* Qb = (bf16_t*)(ws + WS_Q); bf16_t* KN = (bf16_t*)(ws + WS_KN); bf16_t* KR = (bf16_t*)(ws + WS_KR); bf16_t* Vb = (bf16_t*)(ws + WS_V);
    bf16_t* Y = (bf16_t*)(ws + WS_Y); bf16_t* X1 = (bf16_t*)(ws + WS_X1); bf16_t* ACT = (bf16_t*)(ws + WS_ACT); float* E = (float*)(ws + WS_E);

    for (int u = tid; u < (LDS_BYTES - LDSCTL_OFF) / 4; u += 512) ((LAS unsigned*)(lds + LDSCTL_OFF))[u] = 0u;
    __syncthreads();
    XcdBarrier bar; bar.bar = (unsigned*)(ws + WS_CTL) + CW_BAR; bar.x = 0; bar.st = nullptr;
    if (MK_N_LAUNCHES == 1) bar = xcd_barrier_post((unsigned*)(ws + WS_CTL) + CW_BAR, MISC + 8);
    const int lo = args.ph_lo, hi = args.ph_hi;
#ifndef PH_MASK
#define PH_MASK 0x7ff
#endif
#define IN(k) (((PH_MASK >> (k)) & 1) && lo <= (k) && (k) < hi)
#define SEAM(k) do { if (IN(k) && IN((k) + 1)) xcd_barrier(bar); } while (0)

    if (IN(0)) {
        OPAQUE_LANE(ln);
        if (bx < 192) {
            LAS float* cact = (LAS float*)lds; LAS float* part = (LAS float*)(lds + 65536);
            const int n0 = 32 * bx, c4 = tid & 7, kr = tid >> 3;
            f32x4 wv[16];
#pragma unroll
            for (int i = 0; i < 16; ++i) wv[i] = *(const f32x4*)(w_ada + (size_t)(kr + 64 * i) * 6144 + n0 + 4 * c4);
            for (int i = tid; i < 16 * 1024; i += 512) { const float v = cvec[i]; cact[i] = v * frcp(1.f + fexp2(-LOG2E * v)); }
            __syncthreads();
            f32x4 a[16];
#pragma unroll
            for (int b = 0; b < 16; ++b) a[b] = (f32x4){0.f, 0.f, 0.f, 0.f};
#pragma unroll
            for (int i = 0; i < 16; ++i) { const int k = kr + 64 * i;
#pragma unroll
                for (int b = 0; b < 16; ++b) a[b] += wv[i] * cact[b * 1024 + k];
                if ((i & 1) == 1) asm volatile("" ::: "memory"); }
#pragma unroll
            for (int b = 0; b < 16; ++b)
#pragma unroll
                for (int e = 0; e < 4; ++e) { float v = a[b][e]; v += __shfl_xor(v, 8); v += __shfl_xor(v, 16); v += __shfl_xor(v, 32); a[b][e] = v; }
            if (ln < 8) {
#pragma unroll
                for (int b = 0; b < 16; ++b) *(LAS f32x4*)(part + (wave * 16 + b) * 32 + 4 * c4) = a[b]; }
            __syncthreads();
            { const int b = tid >> 5, col = tid & 31; float s = 0.f;
#pragma unroll
              for (int w8 = 0; w8 < 8; ++w8) s += part[(w8 * 16 + b) * 32 + col];
              MOD[b * 6144 + n0 + col] = s + b_ada[n0 + col]; }
            __syncthreads();
        }
        for (int idx = gw * 64 + ln; idx < T * 16; idx += NGW * 64) { const int t = idx >> 4, i = idx & 15; const float ang = (float)pos[t] * c_invfreq[i];
            ROPE[(size_t)t * 32 + i] = cosf(ang); ROPE[(size_t)t * 32 + 16 + i] = sinf(ang); }
    }
    SEAM(0);
    if (IN(1)) {
        OPAQUE_LANE(ln);
        {
        LAS float* scr = (LAS float*)(lds + wave * 16384);
        constexpr int I0 = 16 * 64, I1 = 4 * 24, I2 = 4 * 32, I3 = 16 * 32, I4 = 16 * 176, I5 = 44 * 32, NIT = I0 + I1 + I2 + I3 + I4 + I5;
        for (int it = gw; it < NIT; it += NGW) {
            int r = it;
            if (r < I0) { p0_transpose_item(w_in, INW, D, nullptr, WIN, D, 0, scr, r, 64, ln); continue; } r -= I0;
            if (r < I1) { p0_transpose_item(w_qup, QW, 256, qg, WQ, 256, 1, scr, r, 24, ln); continue; } r -= I1;
            if (r < I2) { p0_transpose_item(w_kvup, 1024, 128, kvg, WKV, 256, 2, scr, r, 32, ln); continue; } r -= I2;
            if (r < I3) { p0_transpose_item(w_out, D, D, nullptr, WOUT, D, 3, scr, r, 32, ln); continue; } r -= I3;
            if (r < I4) { p0_transpose_item(w_up, UPW, D, nullptr, WUP, D, 4, scr, r, 176, ln); continue; } r -= I4;
            p0_transpose_item(w_down, D, DFF, nullptr, WDN, DFF, 5, scr, r, 32, ln);
        }
            }
        for (int row0 = gw * 16; row0 < T; row0 += NGW * 16) { const int b = row0 / SEQ; const float* mb = MOD + b * 6144;
            f32x4 sc[4], sh[4];
#pragma unroll
            for (int j = 0; j < 4; ++j) { const int col = 4 * ln + 256 * j; sh[j] = *(const f32x4*)(mb + col); sc[j] = *(const f32x4*)(mb + 1024 + col) + 1.f; }
            for (int rr = 0; rr < 16; ++rr) { const int t = row0 + rr; const float* xr = x + (size_t)t * D;
                f32x4 v[4]; float s = 0.f;
#pragma unroll
                for (int j = 0; j < 4; ++j) { v[j] = *(const f32x4*)(xr + 4 * ln + 256 * j); s += (v[j][0] + v[j][1]) + (v[j][2] + v[j][3]); }
                const float mean = wave_sum(s) * (1.f / D); float q = 0.f;
#pragma unroll
                for (int j = 0; j < 4; ++j) { v[j] = v[j] - mean; q += (v[j][0] * v[j][0] + v[j][1] * v[j][1]) + (v[j][2] * v[j][2] + v[j][3] * v[j][3]); }
                const float rstd = rsqrtf(wave_sum(q) * (1.f / D) + 1e-5f);
#pragma unroll
                for (int j = 0; j < 4; ++j) { const f32x4 o = v[j] * rstd * sc[j] + sh[j]; u32x2 w; w.x = cvt_pk_bf16(o[0], o[1]); w.y = cvt_pk_bf16(o[2], o[3]);
                    *(u32x2*)(HB + (size_t)t * D + 4 * ln + 256 * j) = w; } } }
    }
    SEAM(1);
    if (IN(2)) {
        pg8::Gemm g{HB, D, WIN, T, 512, D}; pg8::StaticOrder S; S.init(T, 512, G, bx);
        pg8::EpiP E1{P, U, SSQQ, SSQKV};
        pg8::gemm_phase<pg8::EpiP, true>(lds, g, S, E1);
    }
    SEAM(2);
    if (IN(3)) {
        OPAQUE_LANE(ln);
        for (int row0 = gw * 16; row0 < T; row0 += NGW * 16) {
            { const int t = row0 + (ln >> 2), c = ln & 3, i0 = 8 * (c & 1); const bf16_t* pr = P + (size_t)t * PW + 384;
              const u32x4 r1 = *(const u32x4*)(pr + i0), r2 = *(const u32x4*)(pr + 16 + i0);
              const f32x4 ca = *(const f32x4*)(ROPE + (size_t)t * 32 + i0), cb = *(const f32x4*)(ROPE + (size_t)t * 32 + i0 + 4), sa = *(const f32x4*)(ROPE + (size_t)t * 32 + 16 + i0), sb = *(const f32x4*)(ROPE + (size_t)t * 32 + 16 + i0 + 4);
              float ov[8];
#pragma unroll
              for (int e = 0; e < 8; ++e) { const float x1 = (e & 1) ? bf_hi(r1[e >> 1]) : bf_lo(r1[e >> 1]), x2 = (e & 1) ? bf_hi(r2[e >> 1]) : bf_lo(r2[e >> 1]);
                  const float cs = (e < 4) ? ca[e & 3] : cb[e & 3], sn = (e < 4) ? sa[e & 3] : sb[e & 3];
                  ov[e] = (c < 2) ? x1 * cs - x2 * sn : x2 * cs + x1 * sn; }
              u32x4 o; o.x = cvt_pk_bf16(ov[0], ov[1]); o.y = cvt_pk_bf16(ov[2], ov[3]); o.z = cvt_pk_bf16(ov[4], ov[5]); o.w = cvt_pk_bf16(ov[6], ov[7]);
              *(u32x4*)((char*)KR + (size_t)(t >> 6) * 4096 + c * 1024 + (t & 63) * 16) = o; }
        }
        { pg8::MixedOrder S{(const char*)HB, (const char*)P, (const char*)WIN, (const char*)WQ, (const char*)WKV, G, bx};
          pg8::EpiMix EM{pg8::EpiP{P, U, SSQQ, SSQKV}, pg8::EpiStore{Qb, QW}, pg8::EpiKV{KN, Vb}, SSQKV};
          pg8::gemm_multi<pg8::MixedOrder, pg8::EpiMix>(lds, S, EM); }
    }
    SEAM(3);
    if (IN(4)) {
        att::attn_phase(vcu, G, SSQQ, ROPE, Qb, KN, KR, Vb, Y, ong, lds);
        { OPAQUE_LANE(ln);
        for (int row0 = gw * 16; row0 < T; row0 += NGW * 16) {
            const int c0 = 8 * ln;
            float w0[8], w1[8], w2[8], cb8[8], gn[8];
#pragma unroll
            for (int e = 0; e < 8; ++e) { w0[e] = conv_w[c0 + e]; w1[e] = conv_w[512 + c0 + e]; w2[e] = conv_w[1024 + c0 + e]; cb8[e] = conv_b[c0 + e]; gn[e] = ong[512 + c0 + e]; }
            float um2[8], um1[8];
#pragma unroll
            for (int e = 0; e < 8; ++e) { um2[e] = 0.f; um1[e] = 0.f; }
            if ((row0 % SEQ) != 0) {
                const u32x4 a2 = *(const u32x4*)(U + (size_t)(row0 - 2) * 512 + c0), a1 = *(const u32x4*)(U + (size_t)(row0 - 1) * 512 + c0);
#pragma unroll
                for (int e = 0; e < 4; ++e) { um2[2 * e] = bf_lo(a2[e]); um2[2 * e + 1] = bf_hi(a2[e]); um1[2 * e] = bf_lo(a1[e]); um1[2 * e + 1] = bf_hi(a1[e]); }
            }
            for (int rr = 0; rr < 16; ++rr) { const int t = row0 + rr;
                const u32x4 gb = *(const u32x4*)(P + (size_t)t * PW + 512 + c0), uu = *(const u32x4*)(U + (size_t)t * 512 + c0);
                float u0[8], yv[8]; float ss = 0.f;
#pragma unroll
                for (int e = 0; e < 4; ++e) { u0[2 * e] = bf_lo(uu[e]); u0[2 * e + 1] = bf_hi(uu[e]); }
#pragma unroll
                for (int e = 0; e < 8; ++e) { const float gbe = (e & 1) ? bf_hi(gb[e >> 1]) : bf_lo(gb[e >> 1]);
                    yv[e] = gbe * (cb8[e] + w0[e] * um2[e] + w1[e] * um1[e] + w2[e] * u0[e]); ss += yv[e] * yv[e]; um2[e] = um1[e]; um1[e] = u0[e]; }
                ss += __shfl_xor(ss, 1); ss += __shfl_xor(ss, 2); ss += __shfl_xor(ss, 4);
                const float rs = rsqrtf(ss * (1.f / 64.f) + 1e-6f);
                u32x4 o; o.x = cvt_pk_bf16(yv[0] * rs * gn[0], yv[1] * rs * gn[1]); o.y = cvt_pk_bf16(yv[2] * rs * gn[2], yv[3] * rs * gn[3]);
                o.z = cvt_pk_bf16(yv[4] * rs * gn[4], yv[5] * rs * gn[5]); o.w = cvt_pk_bf16(yv[6] * rs * gn[6], yv[7] * rs * gn[7]);
                *(u32x4*)(Y + (size_t)t * D + 512 + c0) = o; }
        }
            }
    }
    SEAM(4);
    if (IN(5)) {
        pg8::Gemm g{Y, D, WOUT, T, D, D}; pg8::StaticOrder S; S.init(T, D, G, bx); pg8::EpiStore E4{MIX, D};
        pg8::gemm_phase<pg8::EpiStore, true>(lds, g, S, E4);
    }
    SEAM(5);
    if (IN(6)) {
        OPAQUE_LANE(ln);
        for (int row0 = gw * 16; row0 < T; row0 += NGW * 16) { const int b = row0 / SEQ; const float* mb = MOD + b * 6144;
            f32x4 gt[4], g1v[4], b1v[4], sc[4], sh[4];
#pragma unroll
            for (int j = 0; j < 4; ++j) { const int col = 4 * ln + 256 * j; gt[j] = *(const f32x4*)(mb + 2048 + col); g1v[j] = *(const f32x4*)(ln1g + col); b1v[j] = *(const f32x4*)(ln1b + col);
                sh[j] = *(const f32x4*)(mb + 3072 + col); sc[j] = *(const f32x4*)(mb + 4096 + col) + 1.f; }
            for (int rr = 0; rr < 16; ++rr) { const int t = row0 + rr;
                f32x4 v[4]; float s = 0.f;
#pragma unroll
                for (int j = 0; j < 4; ++j) { const int col = 4 * ln + 256 * j; const f32x4 xv = *(const f32x4*)(x + (size_t)t * D + col); const u32x2 mw = *(const u32x2*)(MIX + (size_t)t * D + col);
                    const f32x4 mx = {bf_lo(mw.x), bf_hi(mw.x), bf_lo(mw.y), bf_hi(mw.y)};
                    v[j] = xv * ALPHA + gt[j] * mx; s += (v[j][0] + v[j][1]) + (v[j][2] + v[j][3]); }
                float mean = wave_sum(s) * (1.f / D); float q = 0.f;
#pragma unroll
                for (int j = 0; j < 4; ++j) { v[j] = v[j] - mean; q += (v[j][0] * v[j][0] + v[j][1] * v[j][1]) + (v[j][2] * v[j][2] + v[j][3] * v[j][3]); }
                float rstd = rsqrtf(wave_sum(q) * (1.f / D) + 1e-5f);
                s = 0.f;
#pragma unroll
                for (int j = 0; j < 4; ++j) { v[j] = v[j] * rstd * g1v[j] + b1v[j]; u32x2 w; w.x = cvt_pk_bf16(v[j][0], v[j][1]); w.y = cvt_pk_bf16(v[j][2], v[j][3]); *(u32x2*)(X1 + (size_t)t * D + 4 * ln + 256 * j) = w; s += (v[j][0] + v[j][1]) + (v[j][2] + v[j][3]); }
                mean = wave_sum(s) * (1.f / D); q = 0.f;
#pragma unroll
                for (int j = 0; j < 4; ++j) { v[j] = v[j] - mean; q += (v[j][0] * v[j][0] + v[j][1] * v[j][1]) + (v[j][2] * v[j][2] + v[j][3] * v[j][3]); }
                rstd = rsqrtf(wave_sum(q) * (1.f / D) + 1e-5f);
#pragma unroll
                for (int j = 0; j < 4; ++j) { const f32x4 o = v[j] * rstd * sc[j] + sh[j]; u32x2 w; w.x = cvt_pk_bf16(o[0], o[1]); w.y = cvt_pk_bf16(o[2], o[3]);
                    *(u32x2*)(HB + (size_t)t * D + 4 * ln + 256 * j) = w; } } }
    }
    SEAM(6);
    if (IN(7)) {
        pg8::Gemm g{HB, D, WUP, T, UPW, D}; pg8::StaticOrder S; S.init(T, UPW, G, bx); pg8::EpiUp E5{ACT, E, fcw, fcb};
        pg8::gemm_phase<pg8::EpiUp, true>(lds, g, S, E5);
    }
    SEAM(7);
    if (IN(8)) {
        OPAQUE_LANE(ln);
        constexpr int NITEM = 512 * 2 * (DFF / 4);
        for (int it = (gw * 64 + ln); it < NITEM; it += NGW * 64) { const int c4 = it % (DFF / 4), rb = it / (DFF / 4), rr = rb & 1, blk = rb >> 1; const int c0 = 4 * c4;
            const bool first = (blk & 31) == 0;
            const float* e0 = E + ((size_t)blk * 4 + rr) * UPW + c0;
            const float* em1 = (rr == 0) ? E + ((size_t)(blk - 1) * 4 + 3) * UPW + c0 : E + ((size_t)blk * 4 + 0) * UPW + c0;
            const float* em2 = (rr == 0) ? E + ((size_t)(blk - 1) * 4 + 2) * UPW + c0 : E + ((size_t)(blk - 1) * 4 + 3) * UPW + c0;
            const f32x4 z = {0.f, 0.f, 0.f, 0.f};
            const f32x4 g0 = *(const f32x4*)e0, v0 = *(const f32x4*)(e0 + DFF);
            const bool has1 = !(first && rr == 0), has2 = !first;
            const f32x4 g1 = has1 ? *(const f32x4*)em1 : z, v1 = has1 ? *(const f32x4*)(em1 + DFF) : z;
            const f32x4 g2 = has2 ? *(const f32x4*)em2 : z, v2 = has2 ? *(const f32x4*)(em2 + DFF) : z;
            const f32x4 wg0 = *(const f32x4*)(fcw + c0), wg1 = *(const f32x4*)(fcw + UPW + c0), wg2 = *(const f32x4*)(fcw + 2 * UPW + c0), bg = *(const f32x4*)(fcb + c0);
            const f32x4 wv0 = *(const f32x4*)(fcw + DFF + c0), wv1 = *(const f32x4*)(fcw + UPW + DFF + c0), wv2 = *(const f32x4*)(fcw + 2 * UPW + DFF + c0), bv = *(const f32x4*)(fcb + DFF + c0);
            const f32x4 cg = bg + wg0 * g2 + wg1 * g1 + wg2 * g0, cv = bv + wv0 * v2 + wv1 * v1 + wv2 * v0;
            u32x2 w; w.x = cvt_pk_bf16(silu_f(cg[0]) * cv[0], silu_f(cg[1]) * cv[1]); w.y = cvt_pk_bf16(silu_f(cg[2]) * cv[2], silu_f(cg[3]) * cv[3]);
            *(u32x2*)(ACT + (size_t)(64 * blk + rr) * DFF + c0) = w; }
    }
    SEAM(8);
    if (IN(9)) {
        pg8::Gemm g{ACT, DFF, WDN, T, D, DFF}; pg8::StaticOrder S; S.init(T, D, G, bx); pg8::EpiStore E6{FF, D};
        pg8::gemm_phase<pg8::EpiStore, true>(lds, g, S, E6);
    }
    SEAM(9);
    if (IN(10)) {
        OPAQUE_LANE(ln);
        for (int row0 = gw * 16; row0 < T; row0 += NGW * 16) { const int b = row0 / SEQ; const float* mb = MOD + b * 6144;
            f32x4 gt[4], g2v[4], b2v[4];
#pragma unroll
            for (int j = 0; j < 4; ++j) { const int col = 4 * ln + 256 * j; gt[j] = *(const f32x4*)(mb + 5120 + col); g2v[j] = *(const f32x4*)(ln2g + col); b2v[j] = *(const f32x4*)(ln2b + col); }
            for (int rr = 0; rr < 16; ++rr) { const int t = row0 + rr;
                f32x4 v[4]; float s = 0.f;
#pragma unroll
                for (int j = 0; j < 4; ++j) { const int col = 4 * ln + 256 * j; const u32x2 xw = *(const u32x2*)(X1 + (size_t)t * D + col); const f32x4 xv = {bf_lo(xw.x), bf_hi(xw.x), bf_lo(xw.y), bf_hi(xw.y)}; const u32x2 mw = *(const u32x2*)(FF + (size_t)t * D + col);
                    const f32x4 mx = {bf_lo(mw.x), bf_hi(mw.x), bf_lo(mw.y), bf_hi(mw.y)};
                    v[j] = xv * ALPHA + gt[j] * mx; s += (v[j][0] + v[j][1]) + (v[j][2] + v[j][3]); }
                const float mean = wave_sum(s) * (1.f / D); float q = 0.f;
#pragma unroll
                for (int j = 0; j < 4; ++j) { v[j] = v[j] - mean; q += (v[j][0] * v[j][0] + v[j][1] * v[j][1]) + (v[j][2] * v[j][2] + v[j][3] * v[j][3]); }
                const float rstd = rsqrtf(wave_sum(q) * (1.f / D) + 1e-5f);
#pragma unroll
                for (int j = 0; j < 4; ++j) { *(f32x4*)(out + (size_t)t * D + 4 * ln + 256 * j) = v[j] * rstd * g2v[j] + b2v[j]; } } }
    }
#undef IN
#undef SEAM
}

extern "C" void kernel_launch(void* const* d_in, const int* in_sizes, int n_in, void* d_out, int out_size, void* d_ws, size_t ws_size, hipStream_t stream) {
    static int grid = 0;
    if (grid == 0) {
        if (n_in != 22 || in_sizes[0] != T * D || out_size != T * D || ws_size < WS_END) { fprintf(stderr, "kernel_launch: unexpected shapes / workspace (n_in %d, ws %zu)\n", n_in, ws_size); grid = -1; return; }
        int dev = 0, cus = 0, per_cu = 0;
        if (hipGetDevice(&dev) != hipSuccess || hipDeviceGetAttribute(&cus, hipDeviceAttributeMultiprocessorCount, dev) != hipSuccess) { grid = -1; return; }
        if (hipFuncSetAttribute((const void*)mk_fwd, hipFuncAttributeMaxDynamicSharedMemorySize, LDS_BYTES) != hipSuccess) { fprintf(stderr, "kernel_launch: hipFuncSetAttribute failed\n"); grid = -1; return; }
        if (hipOccupancyMaxActiveBlocksPerMultiprocessor(&per_cu, (const void*)mk_fwd, 512, LDS_BYTES) != hipSuccess || per_cu < 1) { fprintf(stderr, "kernel_launch: occupancy query says %d blocks per CU\n", per_cu); (void)hipGetLastError(); grid = -1; return; }
        grid = cus;
    }
    if (grid < 0) return;
    hipMemsetAsync((char*)d_ws + WS_CTL, 0, CTL_ZERO_BYTES, stream);
    Args a{};
    for (int i = 0; i < 22; ++i) a.in[i] = (const float*)d_in[i];
    a.pos = (const int*)d_in[2]; a.out = (float*)d_out; a.ws = (unsigned char*)d_ws;
#if MK_N_LAUNCHES == 1
    a.ph_lo = 0; a.ph_hi = N_PHASES;
    hipLaunchKernelGGL(mk_fwd, dim3(grid), dim3(512), LDS_BYTES, stream, a);
#else
    for (int p = 0; p < N_PHASES; ++p) { a.ph_lo = p; a.ph_hi = p + 1; hipLaunchKernelGGL(mk_fwd, dim3(grid), dim3(512), LDS_BYTES, stream, a); }
#endif
}
```

```cpp
#include <hip/hip_runtime.h>
#include <cstdio>
#include <cstdint>

#define LAS __attribute__((address_space(3)))
#define GAS __attribute__((address_space(1)))
typedef unsigned short bf16_t;
typedef short bf16x8 __attribute__((ext_vector_type(8)));
typedef short s16x4 __attribute__((ext_vector_type(4)));
typedef float f32x4 __attribute__((ext_vector_type(4)));
typedef float f32x2 __attribute__((ext_vector_type(2)));
typedef float f32x16 __attribute__((ext_vector_type(16)));
typedef unsigned u32x4 __attribute__((ext_vector_type(4)));
typedef unsigned u32x2 __attribute__((ext_vector_type(2)));
typedef GAS unsigned gu32;

#ifndef MK_N_LAUNCHES
#define MK_N_LAUNCHES 1
#endif

constexpr int D = 1024, NB = 16, SEQ = 2048, T = NB * SEQ, NH = 8, DFF = 2816, UPW = 2 * DFF;
constexpr int PW = 1024;
constexpr int G1N = 2048;
constexpr int QW = 768, INW = 1952;
constexpr float ALPHA = 1.189207115002721f;
constexpr float QSCALE = 0.10206207261596575f * 1.4426950408889634f;
constexpr float LOG2E = 1.4426950408889634f;

constexpr size_t MiB = 1u << 20;
constexpr size_t WS_CTL = 0, CTL_ZERO_BYTES = 64 * 1024;
constexpr size_t WS_MOD = 1 * MiB;
constexpr size_t WS_ROPE = 2 * MiB;
constexpr size_t WS_SSQQ = 6 * MiB;
constexpr size_t WS_SSQKV = 6 * MiB + 512 * 1024;
constexpr size_t WS_WIN = 8 * MiB;
constexpr size_t WS_WQ = 12 * MiB;
constexpr size_t WS_WKV = 12 * MiB + 512 * 1024;
constexpr size_t WS_WOUT = 13 * MiB;
constexpr size_t WS_WUP = 15 * MiB;
constexpr size_t WS_WDN = 26 * MiB;
constexpr size_t WS_HB = 32 * MiB;
constexpr size_t WS_FF = 32 * MiB;
constexpr size_t WS_P = 96 * MiB;
constexpr size_t WS_U = 160 * MiB;
constexpr size_t WS_MIX = 96 * MiB;
constexpr size_t WS_Q = 224 * MiB;
constexpr size_t WS_KN = 272 * MiB;
constexpr size_t WS_KR = 304 * MiB;
constexpr size_t WS_V = 306 * MiB;
constexpr size_t WS_Y = 338 * MiB;
constexpr size_t WS_X1 = 338 * MiB;
constexpr size_t WS_ACT = 96 * MiB;
constexpr size_t WS_E = 272 * MiB;
constexpr size_t WS_END = 402 * MiB;
constexpr int CW_BAR = 1024;

constexpr int RING_BYTES = 131072, LDSCTL_OFF = RING_BYTES, MISC_OFF = LDSCTL_OFF + 320, LDS_BYTES = 147456;

__device__ __forceinline__ unsigned cvt_pk_bf16(float lo, float hi) { unsigned r; asm volatile("v_cvt_pk_bf16_f32 %0, %1, %2" : "=v"(r) : "v"(lo), "v"(hi)); return r; }
__device__ __forceinline__ float bf_lo(unsigned u) { return __uint_as_float(u << 16); }
__device__ __forceinline__ float bf_hi(unsigned u) { return __uint_as_float(u & 0xffff0000u); }
__device__ __forceinline__ float fexp2(float x) { return __builtin_amdgcn_exp2f(x); }
__device__ __forceinline__ float frcp(float x) { return __builtin_amdgcn_rcpf(x); }
__device__ __forceinline__ float silu_f(float v) { return v * frcp(1.f + fexp2(-LOG2E * v)); }
__device__ __forceinline__ float wave_sum(float v) {
#pragma unroll
    for (int o = 1; o < 64; o <<= 1) v += __shfl_xor(v, o);
    return v;
}

namespace pg8 {
constexpr int BM = 256, BK = 64, HALF = 128, HTB = HALF * BK * 2, STAGE_BYTES = 8 * HTB, NXCD = 8, WGM = 8;
__host__ __device__ __forceinline__ int lds_byte(int r, int c) { const int st = (r >> 4) * 2 + (c >> 5), rr = r & 15, cc = c & 31, ob = rr * 64 + cc * 2; return st * 1024 + (ob ^ (((ob >> 9) & 1) << 5)); }
__host__ __device__ __forceinline__ void stage_rc(int b, int& R, int& C) { const int st = b / 1024, sb = b % 1024, swz = sb ^ (((sb >> 9) & 1) << 5); R = (st >> 1) * 16 + swz / 64; C = (st & 1) * 32 + (swz % 64) / 2; }
__host__ __device__ __forceinline__ int perm32(int rho) { const int n = rho >> 4, i = rho & 15; return 8 * (i >> 2) + 4 * n + (i & 3); }

struct Unit { int pm, pn; };
struct Gemm { const bf16_t* A; int lda; const bf16_t* Bt; int M, N, K; };

struct StaticOrder {
    int nM, nN, nwg, G, c;
    __device__ __forceinline__ void init(int M, int N, int G_, int c_) { nM = M / BM; nN = N / BM; nwg = nM * nN; G = G_; c = c_; }
    __device__ __forceinline__ bool next(int i, Unit& u) const {
        const long L = (long)i * G + c; if (L >= nwg) return false;
        int wgid = (int)L; { const int q = nwg / NXCD, r = nwg % NXCD, xcd = wgid % NXCD, off = wgid / NXCD; wgid = (xcd < r ? xcd * (q + 1) : r * (q + 1) + (xcd - r) * q) + off; }
        const int nig = WGM * nN, gid = wgid / nig, fm = gid * WGM, gsz = (nM - fm) < WGM ? (nM - fm) : WGM;
        u.pm = fm + ((wgid % nig) % gsz); u.pn = (wgid % nig) / gsz; return true;
    }
};

template <class Epi, bool ALIGN_EPI>
__device__ __forceinline__ void gemm_phase(LAS unsigned char* lds, const Gemm g, const StaticOrder& S, const Epi& E) {
    int tid = threadIdx.x; asm volatile("" : "+v"(tid));
    const int wid = __builtin_amdgcn_readfirstlane(tid >> 6), lane = tid & 63, wr = wid >> 2, wc = wid & 3, fr = lane & 15, fq = lane >> 4;
    const int K = g.K, nt = K / BK;
    unsigned voffA[2], voffB[2];
#pragma unroll
    for (int i = 0; i < 2; ++i) { int R, C; stage_rc(tid * 16 + i * 8192, R, C);
        voffA[i] = (unsigned)(R * g.lda + C) * 2u; voffB[i] = (unsigned)(R * K + C) * 2u; }
    const size_t kstep = (size_t)(BK * 2);
    const size_t hstepA = (size_t)HALF * g.lda * 2, hstepB = (size_t)HALF * K * 2;
    const size_t tstepA = 2 * hstepA, tstepB = 2 * hstepB;
    const unsigned ldsw = (unsigned)wid * 1024u;
    const int aoff = lds_byte(wr * 64 + fr, fq * 8), boff = lds_byte(wc * 32 + fr, fq * 8);
#define PG8_SA(b, h) (((b) * 2 + (h)) * HTB)
#define PG8_SB(b, h) ((4 + (b) * 2 + (h)) * HTB)
#define PG8_STAGE(bufoff, gbase, voff) do { _Pragma("unroll") for (int _i = 0; _i < 2; ++_i) \
        __builtin_amdgcn_global_load_lds((const unsigned*)((const char*)(gbase) + (voff)[_i]), (LAS unsigned*)(lds + (bufoff) + ldsw + _i * 8192), 16, 0, 0); } while (0)
#define PG8_LDA(dst, b, h) do { _Pragma("unroll") for (int m = 0; m < 4; ++m) _Pragma("unroll") for (int k = 0; k < 2; ++k) dst[m][k] = *(const LAS bf16x8*)(lds + PG8_SA(b, h) + aoff + m * 2048 + k * 1024); } while (0)
#define PG8_LDB(dst, b, h) do { _Pragma("unroll") for (int n = 0; n < 2; ++n) _Pragma("unroll") for (int k = 0; k < 2; ++k) dst[n][k] = *(const LAS bf16x8*)(lds + PG8_SB(b, h) + boff + n * 2048 + k * 1024); } while (0)
#define PG8_MMA(ai, bj, At, Bt) do { __builtin_amdgcn_s_setprio(1); _Pragma("unroll") for (int m = 0; m < 4; ++m) _Pragma("unroll") for (int n = 0; n < 2; ++n) _Pragma("unroll") for (int k = 0; k < 2; ++k) \
        acc[ai][bj][m][n] = __builtin_amdgcn_mfma_f32_16x16x32_bf16(Bt[n][k], At[m][k], acc[ai][bj][m][n], 0, 0, 0); __builtin_amdgcn_s_setprio(0); } while (0)
#define PG8_WAIT_V(n) asm volatile("s_waitcnt vmcnt(" #n ")" ::: "memory")
#define PG8_WAIT_L(n) asm volatile("s_waitcnt lgkmcnt(" #n ")" ::: "memory")
#define PG8_BAR __builtin_amdgcn_s_barrier()
#define PG8_SCHED __builtin_amdgcn_sched_barrier(0)
    Unit cur, nxt; int ui = 0;
    if (!S.next(0, cur)) return;
    f32x4 acc[2][2][4][2];
#pragma unroll
    for (int a = 0; a < 2; ++a)
#pragma unroll
        for (int b = 0; b < 2; ++b)
#pragma unroll
            for (int m = 0; m < 4; ++m)
#pragma unroll
                for (int n = 0; n < 2; ++n) acc[a][b][m][n] = (f32x4){0.f, 0.f, 0.f, 0.f};
    bf16x8 At[4][2], B0[2][2], B1[2][2];
    const char* cA = (const char*)g.A + (size_t)cur.pm * tstepA; const char* cB = (const char*)g.Bt + (size_t)cur.pn * tstepB;
    if constexpr (Epi::HAS_PREFETCH) E.prefetch(cur, 0, lds, wid, lane);
    PG8_STAGE(PG8_SB(0, 0), cB, voffB); PG8_STAGE(PG8_SB(0, 1), cB + hstepB, voffB); PG8_STAGE(PG8_SA(0, 0), cA, voffA); PG8_STAGE(PG8_SA(0, 1), cA + hstepA, voffA);
    if (wr == 1) PG8_BAR;
    PG8_WAIT_V(2); PG8_BAR;
    PG8_STAGE(PG8_SB(1, 0), cB + kstep, voffB); PG8_STAGE(PG8_SA(1, 0), cA + kstep, voffA); PG8_STAGE(PG8_SB(1, 1), cB + hstepB + kstep, voffB);
    PG8_WAIT_V(6); PG8_BAR;
    for (;;) {
        const bool has_next = S.next(ui + 1, nxt);
        const char* nA = has_next ? (const char*)g.A + (size_t)nxt.pm * tstepA : cA; const char* nB = has_next ? (const char*)g.Bt + (size_t)nxt.pn * tstepB : cB;
#pragma nounroll
        for (int t = 0; t < nt; t += 2) {
            const bool last = (t == nt - 2);
            const char* a1 = cA + (size_t)(t + 1) * kstep;
            const char* a2 = last ? nA : cA + (size_t)(t + 2) * kstep; const char* b2 = last ? nB : cB + (size_t)(t + 2) * kstep;
            const char* a3 = a2 + kstep; const char* b3 = b2 + kstep;
            const bool rlx = (Epi::NST > 0) && (t == 0) && (ui > 0);
            PG8_LDB(B0, 0, 0); PG8_LDB(B1, 0, 1); PG8_SCHED; PG8_LDA(At, 0, 0); PG8_STAGE(PG8_SA(1, 1), a1 + hstepA, voffA);
            if (rlx) { if constexpr (Epi::NST >= 16) PG8_WAIT_V(24); else PG8_WAIT_V(16); } else PG8_WAIT_V(8);
            PG8_WAIT_L(0); PG8_BAR; PG8_MMA(0, 0, At, B0); PG8_MMA(0, 1, At, B1); PG8_BAR; PG8_SCHED;
            PG8_LDA(At, 0, 1); PG8_STAGE(PG8_SB(0, 0), b2, voffB); PG8_STAGE(PG8_SB(0, 1), b2 + hstepB, voffB); PG8_STAGE(PG8_SA(0, 0), a2, voffA);
            if (rlx) { if constexpr (Epi::NST >= 16) PG8_WAIT_V(24); else PG8_WAIT_V(16); } else PG8_WAIT_V(8);
            PG8_WAIT_L(0); PG8_BAR; PG8_MMA(1, 0, At, B0); PG8_MMA(1, 1, At, B1); PG8_BAR; PG8_SCHED;
            PG8_LDB(B0, 1, 0); PG8_LDB(B1, 1, 1); PG8_SCHED; PG8_LDA(At, 1, 0); PG8_STAGE(PG8_SA(0, 1), a2 + hstepA, voffA);
            PG8_WAIT_V(8); PG8_WAIT_L(0); PG8_BAR; PG8_MMA(0, 0, At, B0); PG8_MMA(0, 1, At, B1); PG8_BAR; PG8_SCHED;
            PG8_LDA(At, 1, 1); PG8_STAGE(PG8_SB(1, 0), b3, voffB); PG8_STAGE(PG8_SB(1, 1), b3 + hstepB, voffB); PG8_STAGE(PG8_SA(1, 0), a3, voffA);
            PG8_WAIT_V(8); PG8_WAIT_L(0); PG8_BAR; PG8_MMA(1, 0, At, B0); PG8_MMA(1, 1, At, B1); PG8_BAR; PG8_SCHED;
        }
        if constexpr (ALIGN_EPI) { if (wr == 0) PG8_BAR; }
        { int t_e = threadIdx.x; asm volatile("" : "+v"(t_e)); const int fr_e = t_e & 15, fq_e = (t_e >> 4) & 3;
          if constexpr (Epi::HAS_PREFETCH) { if (has_next) E.prefetch(nxt, (ui + 1) & 1, lds, wid, t_e & 63); E.run(acc, cur, wr, wc, fr_e, fq_e, lds, ui & 1); }
          else E(acc, cur, wr, wc, fr_e, fq_e); }
        if (!has_next) break;
#pragma unroll
        for (int a = 0; a < 2; ++a)
#pragma unroll
            for (int b = 0; b < 2; ++b)
#pragma unroll
                for (int m = 0; m < 4; ++m)
#pragma unroll
                    for (int n = 0; n < 2; ++n) acc[a][b][m][n] = (f32x4){0.f, 0.f, 0.f, 0.f};
        cur = nxt; cA = nA; cB = nB; ++ui;
        if constexpr (ALIGN_EPI) { if (wr == 1) PG8_BAR; }
    }
    PG8_WAIT_V(0);
    if constexpr (!ALIGN_EPI) { if (wr == 0) PG8_BAR; }
    PG8_BAR;
#undef PG8_SA
#undef PG8_SB
#undef PG8_STAGE
#undef PG8_LDA
#undef PG8_LDB
#undef PG8_MMA
#undef PG8_WAIT_V
#undef PG8_WAIT_L
#undef PG8_BAR
#undef PG8_SCHED
}

struct MUnit { const char* A; const char* B; int nt; unsigned kb2; int type; Unit u; };
template <class Sched, class Disp>
__device__ __forceinline__ void gemm_multi(LAS unsigned char* lds, const Sched& S, const Disp& E) {
    int tid = threadIdx.x; asm volatile("" : "+v"(tid));
    const int wid = __builtin_amdgcn_readfirstlane(tid >> 6), lane = tid & 63, wr = wid >> 2, wc = wid & 3, fr = lane & 15, fq = lane >> 4;
    unsigned voffA[2], rB[2], cB2[2];
#pragma unroll
    for (int i = 0; i < 2; ++i) { int R, C; stage_rc(tid * 16 + i * 8192, R, C); voffA[i] = (unsigned)(R * 1024 + C) * 2u; rB[i] = (unsigned)R; cB2[i] = (unsigned)C * 2u; }
    const size_t kstep = (size_t)(BK * 2);
    const size_t hstepA = (size_t)HALF * 1024 * 2;
    const unsigned ldsw = (unsigned)wid * 1024u;
    const int aoff = lds_byte(wr * 64 + fr, fq * 8), boff = lds_byte(wc * 32 + fr, fq * 8);
#define PG8_SA(b, h) (((b) * 2 + (h)) * HTB)
#define PG8_SB(b, h) ((4 + (b) * 2 + (h)) * HTB)
#define PG8_STAGE(bufoff, gbase, voff) do { _Pragma("unroll") for (int _i = 0; _i < 2; ++_i) \
        __builtin_amdgcn_global_load_lds((const unsigned*)((const char*)(gbase) + (voff)[_i]), (LAS unsigned*)(lds + (bufoff) + ldsw + _i * 8192), 16, 0, 0); } while (0)
#define PG8_LDA(dst, b, h) do { _Pragma("unroll") for (int m = 0; m < 4; ++m) _Pragma("unroll") for (int k = 0; k < 2; ++k) dst[m][k] = *(const LAS bf16x8*)(lds + PG8_SA(b, h) + aoff + m * 2048 + k * 1024); } while (0)
#define PG8_LDB(dst, b, h) do { _Pragma("unroll") for (int n = 0; n < 2; ++n) _Pragma("unroll") for (int k = 0; k < 2; ++k) dst[n][k] = *(const LAS bf16x8*)(lds + PG8_SB(b, h) + boff + n * 2048 + k * 1024); } while (0)
#define PG8_MMA(ai, bj, At, Bt) do { __builtin_amdgcn_s_setprio(1); _Pragma("unroll") for (int m = 0; m < 4; ++m) _Pragma("unroll") for (int n = 0; n < 2; ++n) _Pragma("unroll") for (int k = 0; k < 2; ++k) \
        acc[ai][bj][m][n] = __builtin_amdgcn_mfma_f32_16x16x32_bf16(Bt[n][k], At[m][k], acc[ai][bj][m][n], 0, 0, 0); __builtin_amdgcn_s_setprio(0); } while (0)
#define PG8_WAIT_V(n) asm volatile("s_waitcnt vmcnt(" #n ")" ::: "memory")
#define PG8_WAIT_L(n) asm volatile("s_waitcnt lgkmcnt(" #n ")" ::: "memory")
#define PG8_BAR __builtin_amdgcn_s_barrier()
#define PG8_SCHED __builtin_amdgcn_sched_barrier(0)
    MUnit cur, nxt; int ui = 0; int relax = 0;
    if (!S.next(0, cur)) return;
    f32x4 acc[2][2][4][2];
#pragma unroll
    for (int a = 0; a < 2; ++a)
#pragma unroll
        for (int b = 0; b < 2; ++b)
#pragma unroll
            for (int m = 0; m < 4; ++m)
#pragma unroll
                for (int n = 0; n < 2; ++n) acc[a][b][m][n] = (f32x4){0.f, 0.f, 0.f, 0.f};
    bf16x8 At[4][2], B0[2][2], B1[2][2];
    const char* cA = cur.A; const char* cB = cur.B;
    E.prefetch(cur, 0, lds, wid, lane);
    unsigned voffB[2]; voffB[0] = rB[0] * cur.kb2 + cB2[0]; voffB[1] = rB[1] * cur.kb2 + cB2[1];
    size_t hstepB = (size_t)HALF * cur.kb2;
    PG8_STAGE(PG8_SB(0, 0), cB, voffB); PG8_STAGE(PG8_SB(0, 1), cB + hstepB, voffB); PG8_STAGE(PG8_SA(0, 0), cA, voffA); PG8_STAGE(PG8_SA(0, 1), cA + hstepA, voffA);
    if (wr == 1) PG8_BAR;
    PG8_WAIT_V(2); PG8_BAR;
    PG8_STAGE(PG8_SB(1, 0), cB + kstep, voffB); PG8_STAGE(PG8_SA(1, 0), cA + kstep, voffA); PG8_STAGE(PG8_SB(1, 1), cB + hstepB + kstep, voffB);
    PG8_WAIT_V(6); PG8_BAR;
    for (;;) {
        const bool has_next = S.next(ui + 1, nxt);
        if (!has_next) nxt = cur;
        const char* nA = nxt.A; const char* nB = nxt.B;
        unsigned nvoffB[2]; nvoffB[0] = rB[0] * nxt.kb2 + cB2[0]; nvoffB[1] = rB[1] * nxt.kb2 + cB2[1];
        const size_t nhstepB = (size_t)HALF * nxt.kb2;
        const int nt = cur.nt;
#pragma nounroll
        for (int t = 0; t < nt; t += 2) {
            const bool last = (t == nt - 2);
            const char* a1 = cA + (size_t)(t + 1) * kstep;
            const char* a2 = last ? nA : cA + (size_t)(t + 2) * kstep; const char* b2 = last ? nB : cB + (size_t)(t + 2) * kstep;
            const char* a3 = a2 + kstep; const char* b3 = b2 + kstep;
            unsigned vB2[2]; vB2[0] = last ? nvoffB[0] : voffB[0]; vB2[1] = last ? nvoffB[1] : voffB[1];
            const size_t hB2 = last ? nhstepB : hstepB;
            const int rlx = (t == 0) ? relax : 0;
            PG8_LDB(B0, 0, 0); PG8_LDB(B1, 0, 1); PG8_SCHED; PG8_LDA(At, 0, 0); PG8_STAGE(PG8_SA(1, 1), a1 + hstepA, voffA);
            if (rlx >= 16) PG8_WAIT_V(24); else if (rlx >= 8) PG8_WAIT_V(16); else PG8_WAIT_V(8);
            PG8_WAIT_L(0); PG8_BAR; PG8_MMA(0, 0, At, B0); PG8_MMA(0, 1, At, B1); PG8_BAR; PG8_SCHED;
            PG8_LDA(At, 0, 1); PG8_STAGE(PG8_SB(0, 0), b2, vB2); PG8_STAGE(PG8_SB(0, 1), b2 + hB2, vB2); PG8_STAGE(PG8_SA(0, 0), a2, voffA);
            if (rlx >= 16) PG8_WAIT_V(24); else if (rlx >= 8) PG8_WAIT_V(16); else PG8_WAIT_V(8);
            PG8_WAIT_L(0); PG8_BAR; PG8_MMA(1, 0, At, B0); PG8_MMA(1, 1, At, B1); PG8_BAR; PG8_SCHED;
            PG8_LDB(B0, 1, 0); PG8_LDB(B1, 1, 1); PG8_SCHED; PG8_LDA(At, 1, 0); PG8_STAGE(PG8_SA(0, 1), a2 + hstepA, voffA);
            PG8_WAIT_V(8); PG8_WAIT_L(0); PG8_BAR; PG8_MMA(0, 0, At, B0); PG8_MMA(0, 1, At, B1); PG8_BAR; PG8_SCHED;
            PG8_LDA(At, 1, 1); PG8_STAGE(PG8_SB(1, 0), b3, vB2); PG8_STAGE(PG8_SB(1, 1), b3 + hB2, vB2); PG8_STAGE(PG8_SA(1, 0), a3, voffA);
            PG8_WAIT_V(8); PG8_WAIT_L(0); PG8_BAR; PG8_MMA(1, 0, At, B0); PG8_MMA(1, 1, At, B1); PG8_BAR; PG8_SCHED;
        }
        if (wr == 0) PG8_BAR;
        { int t_e = threadIdx.x; asm volatile("" : "+v"(t_e)); if (has_next) E.prefetch(nxt, (ui + 1) & 1, lds, wid, t_e & 63); E(acc, cur, wr, wc, t_e & 15, (t_e >> 4) & 3, lds, ui & 1); }
        if (!has_next) break;
#pragma unroll
        for (int a = 0; a < 2; ++a)
#pragma unroll
            for (int b = 0; b < 2; ++b)
#pragma unroll
                for (int m = 0; m < 4; ++m)
#pragma unroll
                    for (int n = 0; n < 2; ++n) acc[a][b][m][n] = (f32x4){0.f, 0.f, 0.f, 0.f};
        relax = (cur.type == 0 && cur.u.pn >= 4) ? 8 : 16;
        cur = nxt; cA = nA; cB = nB; voffB[0] = nvoffB[0]; voffB[1] = nvoffB[1]; hstepB = nhstepB; ++ui;
        if (wr == 1) PG8_BAR;
    }
    PG8_WAIT_V(0);
    PG8_BAR;
#undef PG8_SA
#undef PG8_SB
#undef PG8_STAGE
#undef PG8_LDA
#undef PG8_LDB
#undef PG8_MMA
#undef PG8_WAIT_V
#undef PG8_WAIT_L
#undef PG8_BAR
#undef PG8_SCHED
}

typedef f32x4 Acc[2][2][4][2];

struct EpiStore { static constexpr bool HAS_PREFETCH = false; static constexpr int NST = 16;
    bf16_t* O; int ldc;
    __device__ __forceinline__ void operator()(const Acc& acc, const Unit& u, int wr, int wc, int fr, int fq) const {
        const int row0 = u.pm * BM + wr * 64 + fr, col0 = u.pn * BM + wc * 32 + 8 * fq;
#pragma unroll
        for (int ai = 0; ai < 2; ++ai)
#pragma unroll
            for (int m = 0; m < 4; ++m) { bf16_t* rowp = O + (size_t)(row0 + ai * HALF + m * 16) * ldc + col0;
#pragma unroll
                for (int bj = 0; bj < 2; ++bj) { const f32x4 v0 = acc[ai][bj][m][0], v1 = acc[ai][bj][m][1];
                    u32x4 w; w.x = cvt_pk_bf16(v0[0], v0[1]); w.y = cvt_pk_bf16(v0[2], v0[3]); w.z = cvt_pk_bf16(v1[0], v1[1]); w.w = cvt_pk_bf16(v1[2], v1[3]);
                    *(u32x4*)(rowp + bj * HALF) = w; } }
    }
};

struct EpiP { static constexpr bool HAS_PREFETCH = false, AFTER_DRAIN = false; static constexpr int NST = 8;
    bf16_t* O; bf16_t* U; float* ssq_q; float* ssq_kv;
    __device__ __forceinline__ void operator()(const Acc& acc, const Unit& u, int wr, int wc, int fr, int fq) const {
        const int row0 = u.pm * BM + wr * 64 + fr;
        if (u.pn >= 4) {
            bf16_t* ucol = U + 128 * (u.pn - 4) + 32 * wc + 8 * fq;
#pragma unroll
            for (int ai = 0; ai < 2; ++ai)
#pragma unroll
                for (int m = 0; m < 4; ++m) { const f32x4 v0 = acc[ai][0][m][0] * acc[ai][1][m][0], v1 = acc[ai][0][m][1] * acc[ai][1][m][1];
                    u32x4 w; w.x = cvt_pk_bf16(v0[0], v0[1]); w.y = cvt_pk_bf16(v0[2], v0[3]); w.z = cvt_pk_bf16(v1[0], v1[1]); w.w = cvt_pk_bf16(v1[2], v1[3]);
                    *(u32x4*)(ucol + (size_t)(row0 + ai * HALF + m * 16) * 512) = w; }
            return;
        }
        EpiStore st{O, PW}; st(acc, u, wr, wc, fr, fq);
        if (u.pn <= 1) {
            float* dst = (u.pn == 0) ? ssq_q : ssq_kv;
#pragma unroll
            for (int ai = 0; ai < 2; ++ai)
#pragma unroll
                for (int m = 0; m < 4; ++m) { float s = 0.f;
#pragma unroll
                    for (int n = 0; n < 2; ++n) { const f32x4 a = acc[ai][0][m][n]; s += (a[0] * a[0] + a[1] * a[1]) + (a[2] * a[2] + a[3] * a[3]); }
                    if (u.pn == 0) {
#pragma unroll
                        for (int n = 0; n < 2; ++n) { const f32x4 a = acc[ai][1][m][n]; s += (a[0] * a[0] + a[1] * a[1]) + (a[2] * a[2] + a[3] * a[3]); } }
                    s += __shfl_xor(s, 16); s += __shfl_xor(s, 32);
                    if (fq == 0) dst[(size_t)(row0 + ai * HALF + m * 16) * 4 + wc] = s; }
        }
    }
};

constexpr int SSQ_LDS = RING_BYTES + 1024;
struct EpiKV { static constexpr bool HAS_PREFETCH = false, AFTER_DRAIN = false; static constexpr int NST = 16;
    bf16_t* KN; bf16_t* V;
    __device__ __forceinline__ void operator()(const Acc& acc, const Unit& u, int wr, int wc, int fr, int fq, LAS unsigned char* lds, int buf) const {
        const int b = u.pm >> 3;
        const LAS f32x4* sq = (const LAS f32x4*)(lds + SSQ_LDS + buf * 4096) + wr * 64 + fr;
        float f[2][4];
#pragma unroll
        for (int ai = 0; ai < 2; ++ai)
#pragma unroll
            for (int m = 0; m < 4; ++m) { const f32x4 sp = sq[ai * HALF + m * 16]; f[ai][m] = rsqrtf(((sp[0] + sp[1]) + (sp[2] + sp[3])) * (1.f / 128.f) + 1e-6f); }
#pragma unroll
        for (int bj = 0; bj < 2; ++bj) { const int g = 8 * u.pn + 4 * bj + wc, head = g >> 2, part = g & 3;
            char* base = (part < 2) ? (char*)KN + (4 * part + fq) * 1024 + fr * 16 : (char*)V + (part - 2) * 4096 + fr * 64 + fq * 16;
            const int mstep = (part < 2) ? 256 : 1024;
            base += (size_t)(b * 8 + head) * 32 * 8192;
#pragma unroll
            for (int ai = 0; ai < 2; ++ai) { const int tile = (4 * u.pm + 2 * ai + wr) & 31;
#pragma unroll
                for (int m = 0; m < 4; ++m) {
                    const f32x4 v0 = acc[ai][bj][m][0] * f[ai][m], v1 = acc[ai][bj][m][1] * f[ai][m];
                    u32x4 w; w.x = cvt_pk_bf16(v0[0], v0[1]); w.y = cvt_pk_bf16(v0[2], v0[3]); w.z = cvt_pk_bf16(v1[0], v1[1]); w.w = cvt_pk_bf16(v1[2], v1[3]);
                    *(u32x4*)(base + (size_t)tile * 8192 + m * mstep) = w; } } }
    }
};

struct MixedOrder {
    const char* HB; const char* P; const char* WIN; const char* WQ; const char* WKV; int G, c;
    __device__ __forceinline__ void set_long(int k, MUnit& m) const { const int li = k * G + c, w = (li % NXCD) * 96 + li / NXCD, pm = w / 6, pn = 2 + w % 6;
        m.A = HB + (size_t)pm * (256 * 1024 * 2); m.B = WIN + (size_t)pn * (256 * 1024 * 2); m.nt = 16; m.kb2 = 2048u; m.type = 0; m.u.pm = pm; m.u.pn = pn; }
    __device__ __forceinline__ void set_short(int k, MUnit& m) const { const int si = k * G + c, s = (si % NXCD) * 112 + si / NXCD;
        if (s < 384) { const int pm = s / 3, pn = s % 3; m.A = P + (size_t)pm * (256 * 1024 * 2); m.B = WQ + (size_t)pn * (256 * 256 * 2); m.nt = 4; m.kb2 = 512u; m.type = 1; m.u.pm = pm; m.u.pn = pn; }
        else { const int s2 = s - 384, pm = s2 >> 2, pn = s2 & 3; m.A = P + 512 + (size_t)pm * (256 * 1024 * 2); m.B = WKV + (size_t)pn * (256 * 256 * 2); m.nt = 4; m.kb2 = 512u; m.type = 2; m.u.pm = pm; m.u.pn = pn; } }
    __device__ __forceinline__ bool next(int i, MUnit& m) const {
        const int ns = (c < 128) ? 4 : 3; if (i >= 3 + ns) return false;
        const int k = i >> 1; const bool even = (c & 1) == 0;
        if (i == 6) { set_short(3, m); return true; }
        if (even == ((i & 1) == 0)) set_long(k, m); else set_short(k, m);
        return true;
    }
};
struct EpiMix { EpiP p; EpiStore q; EpiKV kv; const float* ssqkv;
    __device__ __forceinline__ void prefetch(const MUnit& m, int buf, LAS unsigned char* lds, int wid, int lane) const {
        if (m.type == 2 && wid < 4) __builtin_amdgcn_global_load_lds((const unsigned*)(ssqkv + (size_t)m.u.pm * 1024 + wid * 256 + lane * 4), (LAS unsigned*)(lds + SSQ_LDS + buf * 4096 + wid * 1024), 16, 0, 0);
    }
    __device__ __forceinline__ void operator()(const Acc& acc, const MUnit& m, int wr, int wc, int fr, int fq, LAS unsigned char* lds, int buf) const {
        if (m.type == 0) p(acc, m.u, wr, wc, fr, fq); else if (m.type == 1) q(acc, m.u, wr, wc, fr, fq); else kv(acc, m.u, wr, wc, fr, fq, lds, buf);
    }
};

template <int CTRL> __device__ __forceinline__ float dppf(float v) { return __builtin_bit_cast(float, __builtin_amdgcn_update_dpp(0, __builtin_bit_cast(int, v), CTRL, 0xf, 0xf, true)); }
template <int CTRL> __device__ __forceinline__ f32x4 dpp4(f32x4 v) { f32x4 r; r[0] = dppf<CTRL>(v[0]); r[1] = dppf<CTRL>(v[1]); r[2] = dppf<CTRL>(v[2]); r[3] = dppf<CTRL>(v[3]); return r; }

constexpr int CW_LDS = RING_BYTES + 1024;
struct EpiUp { static constexpr bool HAS_PREFETCH = true; static constexpr int NST = 0;
    bf16_t* ACT; float* E; const float* cw; const float* cb;
    __device__ __forceinline__ void prefetch(const Unit& u, int buf, LAS unsigned char* lds, int wid, int lane) const {
        if (wid < 4) { const float* base = (wid < 3) ? cw + (size_t)wid * UPW : cb;
            const float* src = base + 128 * u.pn + ((lane & 32) ? DFF : 0) + 4 * (lane & 31);
            __builtin_amdgcn_global_load_lds((const unsigned*)src, (LAS unsigned*)(lds + CW_LDS + buf * 4096 + wid * 1024), 16, 0, 0); }
    }
    __device__ __forceinline__ void run(const Acc& acc, const Unit& u, int wr, int wc, int fr, int fq, LAS unsigned char* lds, int buf) const {
        const int cl = 32 * wc + 8 * fq;
        const int cbase = 128 * u.pn + cl;
        const LAS float* wl = (const LAS float*)(lds + CW_LDS + buf * 4096) + cl;
        u32x2 res0[2][4];
#pragma unroll
        for (int n = 0; n < 2; ++n) { const int c0 = cbase + 4 * n;
            const f32x4 wg0 = *(const LAS f32x4*)(wl + 4 * n), wg1 = *(const LAS f32x4*)(wl + 256 + 4 * n), wg2 = *(const LAS f32x4*)(wl + 512 + 4 * n), bg = *(const LAS f32x4*)(wl + 768 + 4 * n);
            const f32x4 wv0 = *(const LAS f32x4*)(wl + 128 + 4 * n), wv1 = *(const LAS f32x4*)(wl + 384 + 4 * n), wv2 = *(const LAS f32x4*)(wl + 640 + 4 * n), bv = *(const LAS f32x4*)(wl + 896 + 4 * n);
#pragma unroll
            for (int ai = 0; ai < 2; ++ai) { f32x4 pg1 = {0.f, 0.f, 0.f, 0.f}, pg2 = pg1, pv1 = pg1, pv2 = pg1;
                const int blk = 4 * u.pm + 2 * ai + wr;
#pragma unroll
                for (int m = 0; m < 4; ++m) { const f32x4 gcur = acc[ai][0][m][n], vcur = acc[ai][1][m][n];
                    const f32x4 rg1 = dpp4<0x121>(gcur), rg2 = dpp4<0x122>(gcur), rv1 = dpp4<0x121>(vcur), rv2 = dpp4<0x122>(vcur);
                    const f32x4 g1 = (fr >= 1) ? rg1 : pg1, g2 = (fr >= 2) ? rg2 : pg2, v1 = (fr >= 1) ? rv1 : pv1, v2 = (fr >= 2) ? rv2 : pv2;
                    const f32x4 cg = bg + wg0 * g2 + wg1 * g1 + wg2 * gcur, cv = bv + wv0 * v2 + wv1 * v1 + wv2 * vcur;
                    f32x4 a; a[0] = silu_f(cg[0]) * cv[0]; a[1] = silu_f(cg[1]) * cv[1]; a[2] = silu_f(cg[2]) * cv[2]; a[3] = silu_f(cg[3]) * cv[3];
                    u32x2 w; w.x = cvt_pk_bf16(a[0], a[1]); w.y = cvt_pk_bf16(a[2], a[3]);
                    const int t = u.pm * BM + ai * HALF + wr * 64 + m * 16 + fr;
                    if (n == 0) res0[ai][m] = w;
                    else if (!(m == 0 && fr < 2)) { u32x4 o; o.x = res0[ai][m].x; o.y = res0[ai][m].y; o.z = w.x; o.w = w.y; *(u32x4*)(ACT + (size_t)t * DFF + cbase) = o; }
                    if (m == 0 && fr < 2) { float* e = E + ((size_t)blk * 4 + fr) * UPW + c0; *(f32x4*)e = gcur; *(f32x4*)(e + DFF) = vcur; }
                    if (m == 3 && fr >= 14) { float* e = E + ((size_t)blk * 4 + 2 + (fr - 14)) * UPW + c0; *(f32x4*)e = gcur; *(f32x4*)(e + DFF) = vcur; }
                    pg1 = rg1; pg2 = rg2; pv1 = rv1; pv2 = rv2; } } }
    }
};
}

namespace att {
constexpr int NSLOT = 3, K_OFF = 0, KSLOT = 12288, V_OFF = NSLOT * KSLOT, VSLOT = 8192, WS_OFF = V_OFF + NSLOT * VSLOT, OST_OFF = WS_OFF + 8 * 256, LDS_END = OST_OFF + 8 * 8192;
static_assert(LDS_END <= RING_BYTES, "attention LDS");
__device__ __forceinline__ int crow(int r, int hi) { return (r & 3) + 8 * (r >> 2) + 4 * hi; }
typedef short v4i16_t __attribute__((ext_vector_type(4)));
__device__ __forceinline__ s16x4 vtr(const LAS unsigned char* p) { return __builtin_bit_cast(s16x4, __builtin_amdgcn_ds_read_tr16_b64_v4i16((LAS v4i16_t*)p)); }
__device__ __forceinline__ void glds(const char* src, LAS unsigned char* dst) { unsigned keep; const unsigned d = (unsigned)__builtin_amdgcn_readfirstlane((int)(unsigned)(uintptr_t)dst);
    asm volatile("s_mov_b32 %0, m0\n\ts_mov_b32 m0, %2\n\ts_nop 0\n\tglobal_load_lds_dwordx4 %1, off\n\ts_mov_b32 m0, %0" : "=&s"(keep) : "v"(src), "s"(d) : "memory"); }
__device__ __forceinline__ float max3f(float a, float b, float c) { float r; asm("v_max3_f32 %0, %1, %2, %3" : "=v"(r) : "v"(a), "v"(b), "v"(c)); return r; }
__device__ __forceinline__ float max2f(float a, float b) { float r; asm("v_max_f32_e32 %0, %1, %2" : "=v"(r) : "v"(a), "v"(b)); return r; }
__device__ __forceinline__ float fadd_s(float a, float b) { float r = a + b; asm volatile("" : "+v"(r)); return r; }
typedef float f32x2_t __attribute__((ext_vector_type(2))); typedef __bf16 bf16x2_t __attribute__((ext_vector_type(2)));
__device__ __forceinline__ unsigned cvtpk_m(float lo, float hi) { f32x2_t v = {lo, hi}; bf16x2_t b2 = __builtin_convertvector(v, bf16x2_t); return __builtin_bit_cast(unsigned, b2); }
constexpr float THRL = 4.0f;

struct AUnit { int b, h, qb; };
__device__ __forceinline__ bool unit_of(int k, int vcu, int G, AUnit& u) {
    const int it = vcu + (k >> 2) * G, r = k & 3; if (it >= 256) return false;
    const int grp = it >> 3, i8 = it & 7, bh = grp * 4 + r; u.b = bh >> 3; u.h = bh & 7;
    u.qb = (r == 0) ? 7 - i8 : (r == 1) ? i8 : (r == 2) ? 7 - (i8 ^ 1) : (i8 ^ 1); return true;
}
__device__ __forceinline__ void attn_phase(int vcu, int G, const float* ssqq, const float* rope, const bf16_t* Q, const bf16_t* KN, const bf16_t* KR, const bf16_t* V, bf16_t* Y, const float* ong, LAS unsigned char* lds) {
    int tid = threadIdx.x; asm volatile("" : "+v"(tid));
    const int lane = tid & 63, r32 = lane & 31, hi = lane >> 5; const int wid = __builtin_amdgcn_readfirstlane(tid >> 6);
    const int lo16 = wid * 1024 + lane * 16;
    LAS float* wsf = (LAS float*)(lds + WS_OFF + wid * 256);
    const int kl = hi * 1024 + r32 * 16, vl = ((lane >> 4) & 1) * 32 + (lane & 3) * 8 + (4 * hi + ((lane & 15) >> 2)) * 64;
#define ATT_ISSUE(U, tile, slot) do { const size_t bh_ = (size_t)((U).b * 8 + (U).h); \
        glds((const char*)KN + (bh_ * 32 + (tile)) * 8192 + lo16, lds + K_OFF + (slot) * KSLOT + wid * 1024); glds((const char*)V + (bh_ * 32 + (tile)) * 8192 + lo16, lds + V_OFF + (slot) * VSLOT + wid * 1024); \
        if (wid < 4) glds((const char*)KR + ((size_t)(U).b * 32 + (tile)) * 4096 + lo16, lds + K_OFF + (slot) * KSLOT + 8192 + wid * 1024); } while (0)
#define ATT_QLOAD(dst, aux, U) do { const size_t row_ = (size_t)((U).b * SEQ + 256 * (U).qb + 32 * wid + r32); const bf16_t* qp_ = Q + row_ * QW + 96 * (U).h + 8 * hi; \
        _Pragma("unroll") for (int ks = 0; ks < 6; ++ks) dst[ks] = *(const bf16x8*)(qp_ + 16 * ks); \
        aux[0] = *(const f32x4*)(ssqq + row_ * 4); aux[1] = *(const f32x4*)(rope + row_ * 32 + 8 * hi); aux[2] = *(const f32x4*)(rope + row_ * 32 + 8 * hi + 4); \
        aux[3] = *(const f32x4*)(rope + row_ * 32 + 16 + 8 * hi); aux[4] = *(const f32x4*)(rope + row_ * 32 + 16 + 8 * hi + 4); } while (0)
#define ATT_QFIX(q, aux) do { const float f_ = rsqrtf(((aux[0][0] + aux[0][1]) + (aux[0][2] + aux[0][3])) * (1.f / 256.f) + 1e-6f) * QSCALE; \
        _Pragma("unroll") for (int ks = 0; ks < 4; ++ks) { const u32x4 w_ = __builtin_bit_cast(u32x4, q[ks]); u32x4 o_; \
            _Pragma("unroll") for (int e = 0; e < 4; ++e) o_[e] = cvtpk_m(bf_lo(w_[e]) * f_, bf_hi(w_[e]) * f_); q[ks] = __builtin_bit_cast(bf16x8, o_); } \
        { const u32x4 a_ = __builtin_bit_cast(u32x4, q[4]), b_ = __builtin_bit_cast(u32x4, q[5]); u32x4 oa_, ob_; \
          _Pragma("unroll") for (int e = 0; e < 4; ++e) { const float x1l = bf_lo(a_[e]), x1h = bf_hi(a_[e]), x2l = bf_lo(b_[e]), x2h = bf_hi(b_[e]); \
              const float cl = (e < 2) ? aux[1][2 * e] : aux[2][2 * e - 4], ch = (e < 2) ? aux[1][2 * e + 1] : aux[2][2 * e - 3], sl = (e < 2) ? aux[3][2 * e] : aux[4][2 * e - 4], sh = (e < 2) ? aux[3][2 * e + 1] : aux[4][2 * e - 3]; \
              oa_[e] = cvtpk_m((x1l * cl - x2l * sl) * f_, (x1h * ch - x2h * sh) * f_); ob_[e] = cvtpk_m((x2l * cl + x1l * sl) * f_, (x2h * ch + x1h * sh) * f_); } \
          q[4] = __builtin_bit_cast(bf16x8, oa_); q[5] = __builtin_bit_cast(bf16x8, ob_); } } while (0)
    AUnit cur, nxt;
    if (!unit_of(0, vcu, G, cur)) return;
    bf16x8 qr[6], qn[6]; f32x4 qa[5], qna[5];
    ATT_QLOAD(qr, qa, cur);
    ATT_QFIX(qr, qa);
    asm volatile("" : "+v"(qr[0]), "+v"(qr[1]), "+v"(qr[2]), "+v"(qr[3]), "+v"(qr[4]), "+v"(qr[5]));
    ATT_ISSUE(cur, 0, 0); ATT_ISSUE(cur, 1, 1);
    int slot = 0;
    for (int k = 0;; ++k) {
        const bool has_next = unit_of(k + 1, vcu, G, nxt);
        const int NT = 4 * cur.qb + 4, jmax = 4 * cur.qb + (wid >> 1);
        float mrun = 0.f, lrun = 0.f; f32x16 o[2]; o[0] = f32x16{}; o[1] = f32x16{}; f32x16 negm = f32x16{};
        for (int j = 0; j < NT; ++j) {
            if (j == 0 && k > 0) { if (wid < 4) asm volatile("s_waitcnt vmcnt(13) lgkmcnt(0)\n\ts_barrier" ::: "memory"); else asm volatile("s_waitcnt vmcnt(12) lgkmcnt(0)\n\ts_barrier" ::: "memory"); }
            else if (j + 1 < NT || has_next) { if (wid < 4) asm volatile("s_waitcnt vmcnt(3) lgkmcnt(0)\n\ts_barrier" ::: "memory"); else asm volatile("s_waitcnt vmcnt(2) lgkmcnt(0)\n\ts_barrier" ::: "memory"); }
            else asm volatile("s_waitcnt vmcnt(0) lgkmcnt(0)\n\ts_barrier" ::: "memory");
            { const int s2 = (slot == 0) ? 2 : slot - 1;
              if (j + 2 < NT) ATT_ISSUE(cur, j + 2, s2); else if (has_next) ATT_ISSUE(nxt, j + 2 - NT, s2); }
            if (j == NT - 1 && has_next) ATT_QLOAD(qn, qna, nxt);
            if (j <= jmax) {
                const LAS unsigned char* kp = lds + K_OFF + slot * KSLOT + kl;
                f32x16 p0, p1;
#pragma unroll
                for (int ks = 0; ks < 6; ++ks) { const bf16x8 k0 = *(const LAS bf16x8*)(kp + ks * 2048), k1 = *(const LAS bf16x8*)(kp + ks * 2048 + 512);
                    if (ks == 0) { p0 = __builtin_amdgcn_mfma_f32_32x32x16_bf16(k0, qr[0], negm, 0, 0, 0); p1 = __builtin_amdgcn_mfma_f32_32x32x16_bf16(k1, qr[0], negm, 0, 0, 0); }
                    else { p0 = __builtin_amdgcn_mfma_f32_32x32x16_bf16(k0, qr[ks], p0, 0, 0, 0); p1 = __builtin_amdgcn_mfma_f32_32x32x16_bf16(k1, qr[ks], p1, 0, 0, 0); } }
                asm volatile("s_nop 15\n\ts_nop 7" : "+v"(p0), "+v"(p1));
                float rm;
                { float a = max3f(p0[0], p0[1], p1[0]), c = max3f(p0[2], p0[3], p1[1]); a = max3f(a, p1[2], p1[3]);
#pragma unroll
                  for (int r = 4; r < 16; r += 4) { a = max3f(a, p0[r], p0[r + 1]); c = max3f(c, p0[r + 2], p0[r + 3]); a = max3f(a, p1[r], p1[r + 1]); c = max3f(c, p1[r + 2], p1[r + 3]); }
                  rm = max2f(a, c); rm = max2f(rm, __shfl_xor(rm, 32)); }
                if (j == 0 || __any(rm > THRL)) {
                    const float dl = (j == 0) ? rm : fmaxf(rm, 0.f);
                    mrun += dl;
#pragma unroll
                    for (int r = 0; r < 16; ++r) { p0[r] -= dl; p1[r] -= dl; }
#pragma unroll
                    for (int r = 0; r < 16; ++r) negm[r] = -mrun;
                    if (j != 0) { const float alpha = fexp2(-dl); lrun *= alpha;
                        if (hi == 0) wsf[r32] = alpha;
#pragma unroll
                        for (int r = 0; r < 16; ++r) { const float a_ = wsf[crow(r, hi)]; o[0][r] *= a_; o[1][r] *= a_; } }
                }
#pragma unroll
                for (int r = 0; r < 16; ++r) { p0[r] = fexp2(p0[r]); p1[r] = fexp2(p1[r]); }
                { float s0 = fadd_s(p0[0], p1[0]), s1 = fadd_s(p0[1], p1[1]);
#pragma unroll
                  for (int r = 2; r < 16; r += 2) { s0 = fadd_s(s0, p0[r]); s1 = fadd_s(s1, p0[r + 1]); s0 = fadd_s(s0, p1[r]); s1 = fadd_s(s1, p1[r + 1]); }
                  lrun = fadd_s(lrun, fadd_s(s0, s1)); }
                bf16x8 pa[4];
                { u32x4 w0, w1, w2, w3;
                  w0.x = cvtpk_m(p0[0], p0[1]); w0.y = cvtpk_m(p0[2], p0[3]); w0.z = cvtpk_m(p0[4], p0[5]); w0.w = cvtpk_m(p0[6], p0[7]);
                  w1.x = cvtpk_m(p0[8], p0[9]); w1.y = cvtpk_m(p0[10], p0[11]); w1.z = cvtpk_m(p0[12], p0[13]); w1.w = cvtpk_m(p0[14], p0[15]);
                  w2.x = cvtpk_m(p1[0], p1[1]); w2.y = cvtpk_m(p1[2], p1[3]); w2.z = cvtpk_m(p1[4], p1[5]); w2.w = cvtpk_m(p1[6], p1[7]);
                  w3.x = cvtpk_m(p1[8], p1[9]); w3.y = cvtpk_m(p1[10], p1[11]); w3.z = cvtpk_m(p1[12], p1[13]); w3.w = cvtpk_m(p1[14], p1[15]);
                  pa[0] = __builtin_bit_cast(bf16x8, w0); pa[1] = __builtin_bit_cast(bf16x8, w1); pa[2] = __builtin_bit_cast(bf16x8, w2); pa[3] = __builtin_bit_cast(bf16x8, w3); }
                const LAS unsigned char* vp = lds + V_OFF + slot * VSLOT + vl;
#pragma unroll
                for (int d0 = 0; d0 < 2; ++d0)
#pragma unroll
                    for (int ks = 0; ks < 4; ++ks) { const s16x4 lo = vtr(vp + d0 * 4096 + ks * 1024), hh = vtr(vp + d0 * 4096 + ks * 1024 + 512);
                        const bf16x8 vf = {lo[0], lo[1], lo[2], lo[3], hh[0], hh[1], hh[2], hh[3]};
                        o[d0] = __builtin_amdgcn_mfma_f32_32x32x16_bf16(pa[ks], vf, o[d0], 0, 0, 0); }
            }
            slot = (slot == 2) ? 0 : slot + 1;
        }
        { const float lt = lrun + __shfl_xor(lrun, 32);
          if (hi == 0) wsf[r32] = frcp(lt);
          LAS float* stg = (LAS float*)(lds + OST_OFF + wid * 8192);
#pragma unroll
          for (int r = 0; r < 16; ++r) { const float inv = wsf[crow(r, hi)]; const int orow = crow(r, hi); stg[orow * 64 + r32] = o[0][r] * inv; stg[orow * 64 + 32 + r32] = o[1][r] * inv; }
          asm volatile("s_waitcnt lgkmcnt(0)" ::: "memory");
          const int ch = lane & 7;
          const f32x4 ga = *(const f32x4*)(ong + 64 * cur.h + 8 * ch), gb = *(const f32x4*)(ong + 64 * cur.h + 8 * ch + 4);
          bf16_t* Yw = Y + (size_t)(cur.b * SEQ + 256 * cur.qb + 32 * wid) * D + 64 * cur.h + 8 * ch;
#pragma unroll
          for (int i = 0; i < 4; ++i) { const int row = i * 8 + (lane >> 3);
              const f32x4 va = *(const LAS f32x4*)(stg + row * 64 + 8 * ch), vb = *(const LAS f32x4*)(stg + row * 64 + 8 * ch + 4);
              float ss = (va[0] * va[0] + va[1] * va[1]) + (va[2] * va[2] + va[3] * va[3]) + (vb[0] * vb[0] + vb[1] * vb[1]) + (vb[2] * vb[2] + vb[3] * vb[3]);
              ss += pg8::dppf<0xB1>(ss); ss += pg8::dppf<0x4E>(ss); ss += pg8::dppf<0x141>(ss);
              const float rs = rsqrtf(ss * (1.f / 64.f) + 1e-6f);
              const f32x4 oa = va * rs * ga, ob = vb * rs * gb;
              u32x4 w; w.x = cvtpk_m(oa[0], oa[1]); w.y = cvtpk_m(oa[2], oa[3]); w.z = cvtpk_m(ob[0], ob[1]); w.w = cvtpk_m(ob[2], ob[3]);
              *(u32x4*)(Yw + (size_t)row * D) = w; } }
        if (!has_next) break;
        cur = nxt;
#pragma unroll
        for (int ks = 0; ks < 6; ++ks) qr[ks] = qn[ks];
        ATT_QFIX(qr, qna);
    }
    asm volatile("s_waitcnt vmcnt(0) lgkmcnt(0)\n\ts_barrier" ::: "memory");
#undef ATT_ISSUE
#undef ATT_QLOAD
#undef ATT_QFIX
}
}

#define XB_TMO      128
#define XB_XCNT(j)  (256  + 64 * (j))
#define XB_XSUB(j)  (1280 + 64 * (j))
#define XB_XGEN(j)  (2304 + 64 * (j))
#define XB_TOP      3328
#define XB_TOPGEN   3392
#define XCD_BAR_WORDS 3456
#define XB_SPIN_CAP (1u << 18)
__device__ __forceinline__ unsigned xb_ld(unsigned* p)              { return __hip_atomic_load(p, __ATOMIC_RELAXED, __HIP_MEMORY_SCOPE_AGENT); }
__device__ __forceinline__ unsigned xb_add(unsigned* p, unsigned v) { return __hip_atomic_fetch_add(p, v, __ATOMIC_RELAXED, __HIP_MEMORY_SCOPE_AGENT); }
__device__ __forceinline__ unsigned xb_xcc_id() { return (unsigned)__builtin_amdgcn_s_getreg((3 << 11) | 20) & 0xFu; }
#define XB_SPIN(cond, bar) do { unsigned _sp = 0; while (cond) { __builtin_amdgcn_s_sleep(1); \
    if ((++_sp & 255u) == 0u) { if (xb_ld(&(bar)[XB_TMO])) break; if (_sp > XB_SPIN_CAP) { atomicAdd(&(bar)[XB_TMO], 1u); break; } } } } while (0)
struct XcdBarrier { unsigned* bar; unsigned x; volatile LAS unsigned* st; };
__device__ __forceinline__ XcdBarrier xcd_barrier_post(unsigned* bar, volatile LAS unsigned* st) {
    XcdBarrier b; b.bar = bar; b.x = xb_xcc_id(); b.st = st;
    if (threadIdx.x == 0) (void)xb_add(&bar[XB_XCNT(b.x)], 1u);
    return b;
}
__device__ __forceinline__ void xcd_barrier_complete(unsigned* bar, unsigned x, unsigned& nloc, unsigned& nx) {
    const unsigned G = gridDim.x * gridDim.y * gridDim.z;
    unsigned sum, cnt, mine, sp = 0u;
    for (;;) {
        sum = 0u; cnt = 0u; mine = 0u;
#pragma unroll
        for (unsigned j = 0; j < 16; ++j) { const unsigned c = xb_ld(&bar[XB_XCNT(j)]); sum += c; cnt += (c > 0u) ? 1u : 0u; mine = (j == x) ? c : mine; }
        if (sum == G) break;
        __builtin_amdgcn_s_sleep(1);
        if ((++sp & 255u) == 0u) { if (xb_ld(&bar[XB_TMO])) break; if (sp > XB_SPIN_CAP) { atomicAdd(&bar[XB_TMO], 1u); break; } }
    }
    nloc = mine > 0u ? mine : 1u; nx = cnt > 0u ? cnt : 1u;
}
__device__ __forceinline__ void xcd_barrier(const XcdBarrier& b) {
    asm volatile("s_waitcnt vmcnt(0)" ::: "memory");
    __syncthreads();
    if (threadIdx.x == 0) {
        unsigned* bar = b.bar;
        __builtin_amdgcn_s_waitcnt(0);
        unsigned nloc = b.st[0], nx = b.st[1];
        if (nloc == 0u) { xcd_barrier_complete(bar, b.x, nloc, nx); b.st[0] = nloc; b.st[1] = nx; }
        const unsigned old = xb_add(&bar[XB_XSUB(b.x)], 1u);
        const unsigned gen = old / nloc;
        if (old + 1u == (gen + 1u) * nloc) {
            __builtin_amdgcn_fence(__ATOMIC_RELEASE, "agent");
            asm volatile("s_waitcnt vmcnt(0)" ::: "memory");
            const unsigned og = xb_add(&bar[XB_TOP], 1u);
            const unsigned tg = og / nx;
            if (og + 1u == (tg + 1u) * nx) xb_add(&bar[XB_TOPGEN], 1u);
            else XB_SPIN(xb_ld(&bar[XB_TOPGEN]) == tg, bar);
            __builtin_amdgcn_fence(__ATOMIC_ACQUIRE, "agent");
            xb_add(&bar[XB_XGEN(b.x)], 1u);
            asm volatile("s_waitcnt vmcnt(0)" ::: "memory");
        } else {
            XB_SPIN(xb_ld(&bar[XB_XGEN(b.x)]) == gen, bar);
            __builtin_amdgcn_fence(__ATOMIC_ACQUIRE, "agent");
            asm volatile("s_waitcnt vmcnt(0)" ::: "memory");
        }
    }
    __syncthreads();
}

struct Args { const float* in[22]; const int* pos; float* out; unsigned char* ws; int ph_lo, ph_hi; };
__constant__ float c_invfreq[16] = {1.0f, 0.5623413251903491f, 0.31622776601683794f, 0.1778279410038923f, 0.1f, 0.05623413251903491f, 0.03162277660168379f, 0.01778279410038923f,
                                    0.01f, 0.005623413251903491f, 0.0031622776601683794f, 0.001778279410038923f, 0.001f, 0.0005623413251903491f, 0.00031622776601683794f, 0.0001778279410038923f};

__device__ __forceinline__ int colmap(int which, int s) {
    const int p = (s & ~31) + pg8::perm32(s & 31);
    switch (which) {
        case 0: { if (s < 1024) return p < 416 ? p : (p < 512 ? -1 : p - 96);
                  const int bj = (s >> 7) & 1, ch = 128 * ((s >> 8) - 4) + 32 * ((s >> 5) & 3) + pg8::perm32(s & 31); return (bj ? 1440 : 928) + ch; }
        case 4: { const int pn = s >> 8, bj = (s >> 7) & 1, wc = (s >> 5) & 3; return bj * DFF + 128 * pn + 32 * wc + pg8::perm32(s & 31); }
        default: return p;
    }
}
__device__ __forceinline__ void p0_transpose_item(const float* W, int ldw, int Ksrc, const float* kscale, bf16_t* WT, int Kdst, int which, LAS float* scr, int item, int nblk, int lane) {
    const int kb = item / nblk, nb = item % nblk, k0 = 64 * kb, s0 = 32 * nb;
    const int cm = colmap(which, s0 + (lane & 31));
    float tv[32];
#pragma unroll
    for (int i = 0; i < 32; ++i) { const int k = k0 + 2 * i + (lane >> 5); tv[i] = (cm >= 0 && k < Ksrc) ? W[(size_t)k * ldw + cm] : 0.f; }
    if (kscale) {
#pragma unroll
        for (int i = 0; i < 32; ++i) { const int k = k0 + 2 * i + (lane >> 5); if (k < Ksrc) tv[i] *= kscale[k]; } }
#pragma unroll
    for (int i = 0; i < 32; ++i) scr[(2 * i + (lane >> 5)) * 33 + (lane & 31)] = tv[i];
    asm volatile("s_waitcnt lgkmcnt(0)" ::: "memory");
    const int c = lane & 7;
#pragma unroll
    for (int j = 0; j < 4; ++j) { const int n = (lane >> 3) + 8 * j; const LAS float* s = scr + (8 * c) * 33 + n;
        u32x4 o; o.x = cvt_pk_bf16(s[0 * 33], s[1 * 33]); o.y = cvt_pk_bf16(s[2 * 33], s[3 * 33]); o.z = cvt_pk_bf16(s[4 * 33], s[5 * 33]); o.w = cvt_pk_bf16(s[6 * 33], s[7 * 33]);
        *(u32x4*)(WT + (size_t)(s0 + n) * Kdst + k0 + 8 * c) = o; }
    asm volatile("s_waitcnt lgkmcnt(0)" ::: "memory");
}

constexpr int N_PHASES = 11;
#define OPAQUE_LANE(name) int name##_t = (int)threadIdx.x; asm volatile("" : "+v"(name##_t)); const int name = name##_t & 63

__global__ void __launch_bounds__(512, 2) mk_fwd(Args args) {
    extern __shared__ __attribute__((aligned(16))) unsigned char lds_raw[];
    LAS unsigned char* lds = (LAS unsigned char*)lds_raw;
    volatile LAS unsigned* MISC = (volatile LAS unsigned*)(lds + MISC_OFF);
    const int tid = threadIdx.x, lane = tid & 63, wave = __builtin_amdgcn_readfirstlane(tid >> 6);
    const int G = gridDim.x; const int bx = blockIdx.x; const int vcu = (G % 8 == 0) ? (bx % 8) * (G / 8) + bx / 8 : bx;
    const int gw = vcu * 8 + wave, NGW = G * 8;
    unsigned char* ws = args.ws;
    const float* x = args.in[0]; const float* cvec = args.in[1]; const int* pos = args.pos;
    const float* w_ada = args.in[3]; const float* b_ada = args.in[4]; const float* w_in = args.in[5];
    const float* qg = args.in[6]; const float* w_qup = args.in[7]; const float* kvg = args.in[8]; const float* w_kvup = args.in[9];
    const float* conv_w = args.in[10]; const float* conv_b = args.in[11]; const float* ong = args.in[12]; const float* w_out = args.in[13];
    const float* ln1g = args.in[14]; const float* ln1b = args.in[15]; const float* w_up = args.in[16];
    const float* fcw = args.in[17]; const float* fcb = args.in[18]; const float* w_down = args.in[19];
    const float* ln2g = args.in[20]; const float* ln2b = args.in[21];
    float* out = args.out;
    float* MOD = (float*)(ws + WS_MOD); float* ROPE = (float*)(ws + WS_ROPE); float* SSQQ = (float*)(ws + WS_SSQQ); float* SSQKV = (float*)(ws + WS_SSQKV);
    bf16_t* WIN = (bf16_t*)(ws + WS_WIN); bf16_t* WQ = (bf16_t*)(ws + WS_WQ); bf16_t* WKV = (bf16_t*)(ws + WS_WKV); bf16_t* WOUT = (bf16_t*)(ws + WS_WOUT);
    bf16_t* WUP = (bf16_t*)(ws + WS_WUP); bf16_t* WDN = (bf16_t*)(ws + WS_WDN);
    bf16_t* HB = (bf16_t*)(ws + WS_HB); bf16_t* FF = (bf16_t*)(ws + WS_FF); bf16_t* P = (bf16_t*)(ws + WS_P); bf16_t* MIX = (bf16_t*)(ws + WS_MIX);
    bf16_t* U = (bf16_t*)(ws + WS_U); bf16_t* Qb = (bf16_t*)(ws + WS_Q); bf16_t* KN = (bf16_t*)(ws + WS_KN); bf16_t* KR = (bf16_t*)(ws + WS_KR); bf16_t* Vb = (bf16_t*)(ws + WS_V);
    bf16_t* Y = (bf16_t*)(ws + WS_Y); bf16_t* X1 = (bf16_t*)(ws + WS_X1); bf16_t* ACT = (bf16_t*)(ws + WS_ACT); float* E = (float*)(ws + WS_E);

    for (int u = tid; u < (LDS_BYTES - LDSCTL_OFF) / 4; u += 512) ((LAS unsigned*)(lds + LDSCTL_OFF))[u] = 0u;
    __syncthreads();
    XcdBarrier bar; bar.bar = (unsigned*)(ws + WS_CTL) + CW_BAR; bar.x = 0; bar.st = nullptr;
    if (MK_N_LAUNCHES == 1) bar = xcd_barrier_post((unsigned*)(ws + WS_CTL) + CW_BAR, MISC + 8);
    const int lo = args.ph_lo, hi = args.ph_hi;
#ifndef PH_MASK
#define PH_MASK 0x7ff
#endif
#define IN(k) (((PH_MASK >> (k)) & 1) && lo <= (k) && (k) < hi)
#define SEAM(k) do { if (IN(k) && IN((k) + 1)) xcd_barrier(bar); } while (0)

    if (IN(0)) {
        OPAQUE_LANE(ln);
        if (bx < 192) {
            LAS float* cact = (LAS float*)lds; LAS float* part = (LAS float*)(lds + 65536);
            const int n0 = 32 * bx, c4 = tid & 7, kr = tid >> 3;
            f32x4 wv[16];
#pragma unroll
            for (int i = 0; i < 16; ++i) wv[i] = *(const f32x4*)(w_ada + (size_t)(kr + 64 * i) * 6144 + n0 + 4 * c4);
            for (int i = tid; i < 16 * 1024; i += 512) { const float v = cvec[i]; cact[i] = v * frcp(1.f + fexp2(-LOG2E * v)); }
            __syncthreads();
            f32x4 a[16];
#pragma unroll
            for (int b = 0; b < 16; ++b) a[b] = (f32x4){0.f, 0.f, 0.f, 0.f};
#pragma unroll
            for (int i = 0; i < 16; ++i) { const int k = kr + 64 * i;
#pragma unroll
                for (int b = 0; b < 16; ++b) a[b] += wv[i] * cact[b * 1024 + k];
                if ((i & 1) == 1) asm volatile("" ::: "memory"); }
#pragma unroll
            for (int b = 0; b < 16; ++b)
#pragma unroll
                for (int e = 0; e < 4; ++e) { float v = a[b][e]; v += __shfl_xor(v, 8); v += __shfl_xor(v, 16); v += __shfl_xor(v, 32); a[b][e] = v; }
            if (ln < 8) {
#pragma unroll
                for (int b = 0; b < 16; ++b) *(LAS f32x4*)(part + (wave * 16 + b) * 32 + 4 * c4) = a[b]; }
            __syncthreads();
            { const int b = tid >> 5, col = tid & 31; float s = 0.f;
#pragma unroll
              for (int w8 = 0; w8 < 8; ++w8) s += part[(w8 * 16 + b) * 32 + col];
              MOD[b * 6144 + n0 + col] = s + b_ada[n0 + col]; }
            __syncthreads();
        }
        for (int idx = gw * 64 + ln; idx < T * 16; idx += NGW * 64) { const int t = idx >> 4, i = idx & 15; const float ang = (float)pos[t] * c_invfreq[i];
            ROPE[(size_t)t * 32 + i] = cosf(ang); ROPE[(size_t)t * 32 + 16 + i] = sinf(ang); }
    }
    SEAM(0);
    if (IN(1)) {
        OPAQUE_LANE(ln);
        {
        LAS float* scr = (LAS float*)(lds + wave * 16384);
        constexpr int I0 = 16 * 64, I1 = 4 * 24, I2 = 4 * 32, I3 = 16 * 32, I4 = 16 * 176, I5 = 44 * 32, NIT = I0 + I1 + I2 + I3 + I4 + I5;
        for (int it = gw; it < NIT; it += NGW) {
            int r = it;
            if (r < I0) { p0_transpose_item(w_in, INW, D, nullptr, WIN, D, 0, scr, r, 64, ln); continue; } r -= I0;
            if (r < I1) { p0_transpose_item(w_qup, QW, 256, qg, WQ, 256, 1, scr, r, 24, ln); continue; } r -= I1;
            if (r < I2) { p0_transpose_item(w_kvup, 1024, 128, kvg, WKV, 256, 2, scr, r, 32, ln); continue; } r -= I2;
            if (r < I3) { p0_transpose_item(w_out, D, D, nullptr, WOUT, D, 3, scr, r, 32, ln); continue; } r -= I3;
            if (r < I4) { p0_transpose_item(w_up, UPW, D, nullptr, WUP, D, 4, scr, r, 176, ln); continue; } r -= I4;
            p0_transpose_item(w_down, D, DFF, nullptr, WDN, DFF, 5, scr, r, 32, ln);
        }
            }
        for (int row0 = gw * 16; row0 < T; row0 += NGW * 16) { const int b = row0 / SEQ; const float* mb = MOD + b * 6144;
            f32x4 sc[4], sh[4];
#pragma unroll
            for (int j = 0; j < 4; ++j) { const int col = 4 * ln + 256 * j; sh[j] = *(const f32x4*)(mb + col); sc[j] = *(const f32x4*)(mb + 1024 + col) + 1.f; }
            for (int rr = 0; rr < 16; ++rr) { const int t = row0 + rr; const float* xr = x + (size_t)t * D;
                f32x4 v[4]; float s = 0.f;
#pragma unroll
                for (int j = 0; j < 4; ++j) { v[j] = *(const f32x4*)(xr + 4 * ln + 256 * j); s += (v[j][0] + v[j][1]) + (v[j][2] + v[j][3]); }
                const float mean = wave_sum(s) * (1.f / D); float q = 0.f;
#pragma unroll
                for (int j = 0; j < 4; ++j) { v[j] = v[j] - mean; q += (v[j][0] * v[j][0] + v[j][1] * v[j][1]) + (v[j][2] * v[j][2] + v[j][3] * v[j][3]); }
                const float rstd = rsqrtf(wave_sum(q) * (1.f / D) + 1e-5f);
#pragma unroll
                for (int j = 0; j < 4; ++j) { const f32x4 o = v[j] * rstd * sc[j] + sh[j]; u32x2 w; w.x = cvt_pk_bf16(o[0], o[1]); w.y = cvt_pk_bf16(o[2], o[3]);
                    *(u32x2*)(HB + (size_t)t * D + 4 * ln + 256 * j) = w; } } }
    }
    SEAM(1);
    if (IN(2)) {
        pg8::Gemm g{HB, D, WIN, T, 512, D}; pg8::StaticOrder S; S.init(T, 512, G, bx);
        pg8::EpiP E1{P, U, SSQQ, SSQKV};
        pg8::gemm_phase<pg8::EpiP, true>(lds, g, S, E1);
    }
    SEAM(2);
    if (IN(3)) {
        OPAQUE_LANE(ln);
        for (int row0 = gw * 16; row0 < T; row0 += NGW * 16) {
            { const int t = row0 + (ln >> 2), c = ln & 3, i0 = 8 * (c & 1); const bf16_t* pr = P + (size_t)t * PW + 384;
              const u32x4 r1 = *(const u32x4*)(pr + i0), r2 = *(const u32x4*)(pr + 16 + i0);
              const f32x4 ca = *(const f32x4*)(ROPE + (size_t)t * 32 + i0), cb = *(const f32x4*)(ROPE + (size_t)t * 32 + i0 + 4), sa = *(const f32x4*)(ROPE + (size_t)t * 32 + 16 + i0), sb = *(const f32x4*)(ROPE + (size_t)t * 32 + 16 + i0 + 4);
              float ov[8];
#pragma unroll
              for (int e = 0; e < 8; ++e) { const float x1 = (e & 1) ? bf_hi(r1[e >> 1]) : bf_lo(r1[e >> 1]), x2 = (e & 1) ? bf_hi(r2[e >> 1]) : bf_lo(r2[e >> 1]);
                  const float cs = (e < 4) ? ca[e & 3] : cb[e & 3], sn = (e < 4) ? sa[e & 3] : sb[e & 3];
                  ov[e] = (c < 2) ? x1 * cs - x2 * sn : x2 * cs + x1 * sn; }
              u32x4 o; o.x = cvt_pk_bf16(ov[0], ov[1]); o.y = cvt_pk_bf16(ov[2], ov[3]); o.z = cvt_pk_bf16(ov[4], ov[5]); o.w = cvt_pk_bf16(ov[6], ov[7]);
              *(u32x4*)((char*)KR + (size_t)(t >> 6) * 4096 + c * 1024 + (t & 63) * 16) = o; }
        }
        { pg8::MixedOrder S{(const char*)HB, (const char*)P, (const char*)WIN, (const char*)WQ, (const char*)WKV, G, bx};
          pg8::EpiMix EM{pg8::EpiP{P, U, SSQQ, SSQKV}, pg8::EpiStore{Qb, QW}, pg8::EpiKV{KN, Vb}, SSQKV};
          pg8::gemm_multi<pg8::MixedOrder, pg8::EpiMix>(lds, S, EM); }
    }
    SEAM(3);
    if (IN(4)) {
        att::attn_phase(vcu, G, SSQQ, ROPE, Qb, KN, KR, Vb, Y, ong, lds);
        { OPAQUE_LANE(ln);
        for (int row0 = gw * 16; row0 < T; row0 += NGW * 16) {
            const int c0 = 8 * ln;
            float w0[8], w1[8], w2[8], cb8[8], gn[8];
#pragma unroll
            for (int e = 0; e < 8; ++e) { w0[e] = conv_w[c0 + e]; w1[e] = conv_w[512 + c0 + e]; w2[e] = conv_w[1024 + c0 + e]; cb8[e] = conv_b[c0 + e]; gn[e] = ong[512 + c0 + e]; }
            float um2[8], um1[8];
#pragma unroll
            for (int e = 0; e < 8; ++e) { um2[e] = 0.f; um1[e] = 0.f; }
            if ((row0 % SEQ) != 0) {
                const u32x4 a2 = *(const u32x4*)(U + (size_t)(row0 - 2) * 512 + c0), a1 = *(const u32x4*)(U + (size_t)(row0 - 1) * 512 + c0);
#pragma unroll
                for (int e = 0; e < 4; ++e) { um2[2 * e] = bf_lo(a2[e]); um2[2 * e + 1] = bf_hi(a2[e]); um1[2 * e] = bf_lo(a1[e]); um1[2 * e + 1] = bf_hi(a1[e]); }
            }
            for (int rr = 0; rr < 16; ++rr) { const int t = row0 + rr;
                const u32x4 gb = *(const u32x4*)(P + (size_t)t * PW + 512 + c0), uu = *(const u32x4*)(U + (size_t)t * 512 + c0);
                float u0[8], yv[8]; float ss = 0.f;
#pragma unroll
                for (int e = 0; e < 4; ++e) { u0[2 * e] = bf_lo(uu[e]); u0[2 * e + 1] = bf_hi(uu[e]); }
#pragma unroll
                for (int e = 0; e < 8; ++e) { const float gbe = (e & 1) ? bf_hi(gb[e >> 1]) : bf_lo(gb[e >> 1]);
                    yv[e] = gbe * (cb8[e] + w0[e] * um2[e] + w1[e] * um1[e] + w2[e] * u0[e]); ss += yv[e] * yv[e]; um2[e] = um1[e]; um1[e] = u0[e]; }
                ss += __shfl_xor(ss, 1); ss += __shfl_xor(ss, 2); ss += __shfl_xor(ss, 4);
                const float rs = rsqrtf(ss * (1.f / 64.f) + 1e-6f);
                u32x4 o; o.x = cvt_pk_bf16(yv[0] * rs * gn[0], yv[1] * rs * gn[1]); o.y = cvt_pk_bf16(yv[2] * rs * gn[2], yv[3] * rs * gn[3]);
                o.z = cvt_pk_bf16(yv[4] * rs * gn[4], yv[5] * rs * gn[5]); o.w = cvt_pk_bf16(yv[6] * rs * gn[6], yv[7] * rs * gn[7]);
                *(u32x4*)(Y + (size_t)t * D + 512 + c0) = o; }
        }
            }
    }
    SEAM(4);
    if (IN(5)) {
        pg8::Gemm g{Y, D, WOUT, T, D, D}; pg8::StaticOrder S; S.init(T, D, G, bx); pg8::EpiStore E4{MIX, D};
        pg8::gemm_phase<pg8::EpiStore, true>(lds, g, S, E4);
    }
    SEAM(5);
    if (IN(6)) {
        OPAQUE_LANE(ln);
        for (int row0 = gw * 16; row0 < T; row0 += NGW * 16) { const int b = row0 / SEQ; const float* mb = MOD + b * 6144;
            f32x4 gt[4], g1v[4], b1v[4], sc[4], sh[4];
#pragma unroll
            for (int j = 0; j < 4; ++j) { const int col = 4 * ln + 256 * j; gt[j] = *(const f32x4*)(mb + 2048 + col); g1v[j] = *(const f32x4*)(ln1g + col); b1v[j] = *(const f32x4*)(ln1b + col);
                sh[j] = *(const f32x4*)(mb + 3072 + col); sc[j] = *(const f32x4*)(mb + 4096 + col) + 1.f; }
            for (int rr = 0; rr < 16; ++rr) { const int t = row0 + rr;
                f32x4 v[4]; float s = 0.f;
#pragma unroll
                for (int j = 0; j < 4; ++j) { const int col = 4 * ln + 256 * j; const f32x4 xv = *(const f32x4*)(x + (size_t)t * D + col); const u32x2 mw = *(const u32x2*)(MIX + (size_t)t * D + col);
                    const f32x4 mx = {bf_lo(mw.x), bf_hi(mw.x), bf_lo(mw.y), bf_hi(mw.y)};
                    v[j] = xv * ALPHA + gt[j] * mx; s += (v[j][0] + v[j][1]) + (v[j][2] + v[j][3]); }
                float mean = wave_sum(s) * (1.f / D); float q = 0.f;
#pragma unroll
                for (int j = 0; j < 4; ++j) { v[j] = v[j] - mean; q += (v[j][0] * v[j][0] + v[j][1] * v[j][1]) + (v[j][2] * v[j][2] + v[j][3] * v[j][3]); }
                float rstd = rsqrtf(wave_sum(q) * (1.f / D) + 1e-5f);
                s = 0.f;
#pragma unroll
                for (int j = 0; j < 4; ++j) { v[j] = v[j] * rstd * g1v[j] + b1v[j]; u32x2 w; w.x = cvt_pk_bf16(v[j][0], v[j][1]); w.y = cvt_pk_bf16(v[j][2], v[j][3]); *(u32x2*)(X1 + (size_t)t * D + 4 * ln + 256 * j) = w; s += (v[j][0] + v[j][1]) + (v[j][2] + v[j][3]); }
                mean = wave_sum(s) * (1.f / D); q = 0.f;
#pragma unroll
                for (int j = 0; j < 4; ++j) { v[j] = v[j] - mean; q += (v[j][0] * v[j][0] + v[j][1] * v[j][1]) + (v[j][2] * v[j][2] + v[j][3] * v[j][3]); }
                rstd = rsqrtf(wave_sum(q) * (1.f / D) + 1e-5f);
#pragma unroll
                for (int j = 0; j < 4; ++j) { const f32x4 o = v[j] * rstd * sc[j] + sh[j]; u32x2 w; w.x = cvt_pk_bf16(o[0], o[1]); w.y = cvt_pk_bf16(o[2], o[3]);
                    *(u32x2*)(HB + (size_t)t * D + 4 * ln + 256 * j) = w; } } }
    }
    SEAM(6);
    if (IN(7)) {
        pg8::Gemm g{HB, D, WUP, T, UPW, D}; pg8::StaticOrder S; S.init(T, UPW, G, bx); pg8::EpiUp E5{ACT, E, fcw, fcb};
        pg8::gemm_phase<pg8::EpiUp, true>(lds, g, S, E5);
    }
    SEAM(7);
    if (IN(8)) {
        OPAQUE_LANE(ln);
        constexpr int NITEM = 512 * 2 * (DFF / 4);
        for (int it = (gw * 64 + ln); it < NITEM; it += NGW * 64) { const int c4 = it % (DFF / 4), rb = it / (DFF / 4), rr = rb & 1, blk = rb >> 1; const int c0 = 4 * c4;
            const bool first = (blk & 31) == 0;
            const float* e0 = E + ((size_t)blk * 4 + rr) * UPW + c0;
            const float* em1 = (rr == 0) ? E + ((size_t)(blk - 1) * 4 + 3) * UPW + c0 : E + ((size_t)blk * 4 + 0) * UPW + c0;
            const float* em2 = (rr == 0) ? E + ((size_t)(blk - 1) * 4 + 2) * UPW + c0 : E + ((size_t)(blk - 1) * 4 + 3) * UPW + c0;
            const f32x4 z = {0.f, 0.f, 0.f, 0.f};
            const f32x4 g0 = *(const f32x4*)e0, v0 = *(const f32x4*)(e0 + DFF);
            const bool has1 = !(first && rr == 0), has2 = !first;
            const f32x4 g1 = has1 ? *(const f32x4*)em1 : z, v1 = has1 ? *(const f32x4*)(em1 + DFF) : z;
            const f32x4 g2 = has2 ? *(const f32x4*)em2 : z, v2 = has2 ? *(const f32x4*)(em2 + DFF) : z;
            const f32x4 wg0 = *(const f32x4*)(fcw + c0), wg1 = *(const f32x4*)(fcw + UPW + c0), wg2 = *(const f32x4*)(fcw + 2 * UPW + c0), bg = *(const f32x4*)(fcb + c0);
            const f32x4 wv0 = *(const f32x4*)(fcw + DFF + c0), wv1 = *(const f32x4*)(fcw + UPW + DFF + c0), wv2 = *(const f32x4*)(fcw + 2 * UPW + DFF + c0), bv = *(const f32x4*)(fcb + DFF + c0);
            const f32x4 cg = bg + wg0 * g2 + wg1 * g1 + wg2 * g0, cv = bv + wv0 * v2 + wv1 * v1 + wv2 * v0;
            u32x2 w; w.x = cvt_pk_bf16(silu_f(cg[0]) * cv[0], silu_f(cg[1]) * cv[1]); w.y = cvt_pk_bf16(silu_f(cg[2]) * cv[2], silu_f(cg[3]) * cv[3]);
            *(u32x2*)(ACT + (size_t)(64 * blk + rr) * DFF + c0) = w; }
    }
    SEAM(8);
    if (IN(9)) {
        pg8::Gemm g{ACT, DFF, WDN, T, D, DFF}; pg8::StaticOrder S; S.init(T, D, G, bx); pg8::EpiStore E6{FF, D};
        pg8::gemm_phase<pg8::EpiStore, true>(lds, g, S, E6);
    }
    SEAM(9);
    if (IN(10)) {
        OPAQUE_LANE(ln);
        for (int row0 = gw * 16; row0 < T; row0 += NGW * 16) { const int b = row0 / SEQ; const float* mb = MOD + b * 6144;
            f32x4 gt[4], g2v[4], b2v[4];
#pragma unroll
            for (int j = 0; j < 4; ++j) { const int col = 4 * ln + 256 * j; gt[j] = *(const f32x4*)(mb + 5120 + col); g2v[j] = *(const f32x4*)(ln2g + col); b2v[j] = *(const f32x4*)(ln2b + col); }
            for (int rr = 0; rr < 16; ++rr) { const int t = row0 + rr;
                f32x4 v[4]; float s = 0.f;
#pragma unroll
                for (int j = 0; j < 4; ++j) { const int col = 4 * ln + 256 * j; const u32x2 xw = *(const u32x2*)(X1 + (size_t)t * D + col); const f32x4 xv = {bf_lo(xw.x), bf_hi(xw.x), bf_lo(xw.y), bf_hi(xw.y)}; const u32x2 mw = *(const u32x2*)(FF + (size_t)t * D + col);
                    const f32x4 mx = {bf_lo(mw.x), bf_hi(mw.x), bf_lo(mw.y), bf_hi(mw.y)};
                    v[j] = xv * ALPHA + gt[j] * mx; s += (v[j][0] + v[j][1]) + (v[j][2] + v[j][3]); }
                const float mean = wave_sum(s) * (1.f / D); float q = 0.f;
#pragma unroll
                for (int j = 0; j < 4; ++j) { v[j] = v[j] - mean; q += (v[j][0] * v[j][0] + v[j][1] * v[j][1]) + (v[j][2] * v[j][2] + v[j][3] * v[j][3]); }
                const float rstd = rsqrtf(wave_sum(q) * (1.f / D) + 1e-5f);
#pragma unroll
                for (int j = 0; j < 4; ++j) { *(f32x4*)(out + (size_t)t * D + 4 * ln + 256 * j) = v[j] * rstd * g2v[j] + b2v[j]; } } }
    }
#undef IN
#undef SEAM
}

extern "C" void kernel_launch(void* const* d_in, const int* in_sizes, int n_in, void* d_out, int out_size, void* d_ws, size_t ws_size, hipStream_t stream) {
    static int grid = 0;
    if (grid == 0) {
        if (n_in != 22 || in_sizes[0] != T * D || out_size != T * D || ws_size < WS_END) { fprintf(stderr, "kernel_launch: unexpected shapes / workspace (n_in %d, ws %zu)\n", n_in, ws_size); grid = -1; return; }
        int dev = 0, cus = 0, per_cu = 0;
        if (hipGetDevice(&dev) != hipSuccess || hipDeviceGetAttribute(&cus, hipDeviceAttributeMultiprocessorCount, dev) != hipSuccess) { grid = -1; return; }
        if (hipFuncSetAttribute((const void*)mk_fwd, hipFuncAttributeMaxDynamicSharedMemorySize, LDS_BYTES) != hipSuccess) { fprintf(stderr, "kernel_launch: hipFuncSetAttribute failed\n"); grid = -1; return; }
        if (hipOccupancyMaxActiveBlocksPerMultiprocessor(&per_cu, (const void*)mk_fwd, 512, LDS_BYTES) != hipSuccess || per_cu < 1) { fprintf(stderr, "kernel_launch: occupancy query says %d blocks per CU\n", per_cu); (void)hipGetLastError(); grid = -1; return; }
        grid = cus;
    }
    if (grid < 0) return;
    hipMemsetAsync((char*)d_ws + WS_CTL, 0, CTL_ZERO_BYTES, stream);
    Args a{};
    for (int i = 0; i < 22; ++i) a.in[i] = (const float*)d_in[i];
    a.pos = (const int*)d_in[2]; a.out = (float*)d_out; a.ws = (unsigned char*)d_ws;
#if MK_N_LAUNCHES == 1
    a.ph_lo = 0; a.ph_hi = N_PHASES;
    hipLaunchKernelGGL(mk_fwd, dim3(grid), dim3(512), LDS_BYTES, stream, a);
#else
    for (int p = 0; p < N_PHASES; ++p) { a.ph_lo = p; a.ph_hi = p + 1; hipLaunchKernelGGL(mk_fwd, dim3(grid), dim3(512), LDS_BYTES, stream, a); }
#endif
}
```

```cpp
#include <hip/hip_runtime.h>
#include <cstdio>
#include <cstdint>

#define LAS __attribute__((address_space(3)))
#define GAS __attribute__((address_space(1)))
typedef unsigned short bf16_t;
typedef short bf16x8 __attribute__((ext_vector_type(8)));
typedef short s16x4 __attribute__((ext_vector_type(4)));
typedef float f32x4 __attribute__((ext_vector_type(4)));
typedef float f32x2 __attribute__((ext_vector_type(2)));
typedef float f32x16 __attribute__((ext_vector_type(16)));
typedef unsigned u32x4 __attribute__((ext_vector_type(4)));
typedef unsigned u32x2 __attribute__((ext_vector_type(2)));
typedef GAS unsigned gu32;

#ifndef MK_N_LAUNCHES
#define MK_N_LAUNCHES 1
#endif

constexpr int D = 1024, NB = 16, SEQ = 2048, T = NB * SEQ, NH = 8, DFF = 2816, UPW = 2 * DFF;
constexpr int PW = 1024;
constexpr int G1N = 2048;
constexpr int QW = 768, INW = 1952;
constexpr float ALPHA = 1.189207115002721f;
constexpr float QSCALE = 0.10206207261596575f * 1.4426950408889634f;
constexpr float LOG2E = 1.4426950408889634f;

constexpr size_t MiB = 1u << 20;
constexpr size_t WS_CTL = 0, CTL_ZERO_BYTES = 64 * 1024;
constexpr size_t WS_MOD = 1 * MiB;
constexpr size_t WS_ROPE = 2 * MiB;
constexpr size_t WS_SSQQ = 6 * MiB;
constexpr size_t WS_SSQKV = 6 * MiB + 512 * 1024;
constexpr size_t WS_WIN = 8 * MiB;
constexpr size_t WS_WQ = 12 * MiB;
constexpr size_t WS_WKV = 12 * MiB + 512 * 1024;
constexpr size_t WS_WOUT = 13 * MiB;
constexpr size_t WS_WUP = 15 * MiB;
constexpr size_t WS_WDN = 26 * MiB;
constexpr size_t WS_HB = 32 * MiB;
constexpr size_t WS_FF = 32 * MiB;
constexpr size_t WS_P = 96 * MiB;
constexpr size_t WS_U = 160 * MiB;
constexpr size_t WS_MIX = 96 * MiB;
constexpr size_t WS_Q = 224 * MiB;
constexpr size_t WS_KN = 272 * MiB;
constexpr size_t WS_KR = 304 * MiB;
constexpr size_t WS_V = 306 * MiB;
constexpr size_t WS_Y = 338 * MiB;
constexpr size_t WS_X1 = 338 * MiB;
constexpr size_t WS_ACT = 96 * MiB;
constexpr size_t WS_E = 272 * MiB;
constexpr size_t WS_END = 402 * MiB;
constexpr int CW_BAR = 1024;

constexpr int RING_BYTES = 131072, LDSCTL_OFF = RING_BYTES, MISC_OFF = LDSCTL_OFF + 320, LDS_BYTES = 147456;

__device__ __forceinline__ unsigned cvt_pk_bf16(float lo, float hi) { unsigned r; asm volatile("v_cvt_pk_bf16_f32 %0, %1, %2" : "=v"(r) : "v"(lo), "v"(hi)); return r; }
__device__ __forceinline__ float bf_lo(unsigned u) { return __uint_as_float(u << 16); }
__device__ __forceinline__ float bf_hi(unsigned u) { return __uint_as_float(u & 0xffff0000u); }
__device__ __forceinline__ float fexp2(float x) { return __builtin_amdgcn_exp2f(x); }
__device__ __forceinline__ float frcp(float x) { return __builtin_amdgcn_rcpf(x); }
__device__ __forceinline__ float silu_f(float v) { return v * frcp(1.f + fexp2(-LOG2E * v)); }
__device__ __forceinline__ float wave_sum(float v) {
#pragma unroll
    for (int o = 1; o < 64; o <<= 1) v += __shfl_xor(v, o);
    return v;
}

namespace pg8 {
constexpr int BM = 256, BK = 64, HALF = 128, HTB = HALF * BK * 2, STAGE_BYTES = 8 * HTB, NXCD = 8, WGM = 8;
__host__ __device__ __forceinline__ int lds_byte(int r, int c) { const int st = (r >> 4) * 2 + (c >> 5), rr = r & 15, cc = c & 31, ob = rr * 64 + cc * 2; return st * 1024 + (ob ^ (((ob >> 9) & 1) << 5)); }
__host__ __device__ __forceinline__ void stage_rc(int b, int& R, int& C) { const int st = b / 1024, sb = b % 1024, swz = sb ^ (((sb >> 9) & 1) << 5); R = (st >> 1) * 16 + swz / 64; C = (st & 1) * 32 + (swz % 64) / 2; }
__host__ __device__ __forceinline__ int perm32(int rho) { const int n = rho >> 4, i = rho & 15; return 8 * (i >> 2) + 4 * n + (i & 3); }

struct Unit { int pm, pn; };
struct Gemm { const bf16_t* A; int lda; const bf16_t* Bt; int M, N, K; };

struct StaticOrder {
    int nM, nN, nwg, G, c;
    __device__ __forceinline__ void init(int M, int N, int G_, int c_) { nM = M / BM; nN = N / BM; nwg = nM * nN; G = G_; c = c_; }
    __device__ __forceinline__ bool next(int i, Unit& u) const {
        const long L = (long)i * G + c; if (L >= nwg) return false;
        int wgid = (int)L; { const int q = nwg / NXCD, r = nwg % NXCD, xcd = wgid % NXCD, off = wgid / NXCD; wgid = (xcd < r ? xcd * (q + 1) : r * (q + 1) + (xcd - r) * q) + off; }
        const int nig = WGM * nN, gid = wgid / nig, fm = gid * WGM, gsz = (nM - fm) < WGM ? (nM - fm) : WGM;
        u.pm = fm + ((wgid % nig) % gsz); u.pn = (wgid % nig) / gsz; return true;
    }
};

template <class Epi, bool ALIGN_EPI>
__device__ __forceinline__ void gemm_phase(LAS unsigned char* lds, const Gemm g, const StaticOrder& S, const Epi& E) {
    int tid = threadIdx.x; asm volatile("" : "+v"(tid));
    const int wid = __builtin_amdgcn_readfirstlane(tid >> 6), lane = tid & 63, wr = wid >> 2, wc = wid & 3, fr = lane & 15, fq = lane >> 4;
    const int K = g.K, nt = K / BK;
    unsigned voffA[2], voffB[2];
#pragma unroll
    for (int i = 0; i < 2; ++i) { int R, C; stage_rc(tid * 16 + i * 8192, R, C);
        voffA[i] = (unsigned)(R * g.lda + C) * 2u; voffB[i] = (unsigned)(R * K + C) * 2u; }
    const size_t kstep = (size_t)(BK * 2);
    const size_t hstepA = (size_t)HALF * g.lda * 2, hstepB = (size_t)HALF * K * 2;
    const size_t tstepA = 2 * hstepA, tstepB = 2 * hstepB;
    const unsigned ldsw = (unsigned)wid * 1024u;
    const int aoff = lds_byte(wr * 64 + fr, fq * 8), boff = lds_byte(wc * 32 + fr, fq * 8);
#define PG8_SA(b, h) (((b) * 2 + (h)) * HTB)
#define PG8_SB(b, h) ((4 + (b) * 2 + (h)) * HTB)
#define PG8_STAGE(bufoff, gbase, voff) do { _Pragma("unroll") for (int _i = 0; _i < 2; ++_i) \
        __builtin_amdgcn_global_load_lds((const unsigned*)((const char*)(gbase) + (voff)[_i]), (LAS unsigned*)(lds + (bufoff) + ldsw + _i * 8192), 16, 0, 0); } while (0)
#define PG8_LDA(dst, b, h) do { _Pragma("unroll") for (int m = 0; m < 4; ++m) _Pragma("unroll") for (int k = 0; k < 2; ++k) dst[m][k] = *(const LAS bf16x8*)(lds + PG8_SA(b, h) + aoff + m * 2048 + k * 1024); } while (0)
#define PG8_LDB(dst, b, h) do { _Pragma("unroll") for (int n = 0; n < 2; ++n) _Pragma("unroll") for (int k = 0; k < 2; ++k) dst[n][k] = *(const LAS bf16x8*)(lds + PG8_SB(b, h) + boff + n * 2048 + k * 1024); } while (0)
#define PG8_MMA(ai, bj, At, Bt) do { __builtin_amdgcn_s_setprio(1); _Pragma("unroll") for (int m = 0; m < 4; ++m) _Pragma("unroll") for (int n = 0; n < 2; ++n) _Pragma("unroll") for (int k = 0; k < 2; ++k) \
        acc[ai][bj][m][n] = __builtin_amdgcn_mfma_f32_16x16x32_bf16(Bt[n][k], At[m][k], acc[ai][bj][m][n], 0, 0, 0); __builtin_amdgcn_s_setprio(0); } while (0)
#define PG8_WAIT_V(n) asm volatile("s_waitcnt vmcnt(" #n ")" ::: "memory")
#define PG8_WAIT_L(n) asm volatile("s_waitcnt lgkmcnt(" #n ")" ::: "memory")
#define PG8_BAR __builtin_amdgcn_s_barrier()
#define PG8_SCHED __builtin_amdgcn_sched_barrier(0)
    Unit cur, nxt; int ui = 0;
    if (!S.next(0, cur)) return;
    f32x4 acc[2][2][4][2];
#pragma unroll
    for (int a = 0; a < 2; ++a)
#pragma unroll
        for (int b = 0; b < 2; ++b)
#pragma unroll
            for (int m = 0; m < 4; ++m)
#pragma unroll
                for (int n = 0; n < 2; ++n) acc[a][b][m][n] = (f32x4){0.f, 0.f, 0.f, 0.f};
    bf16x8 At[4][2], B0[2][2], B1[2][2];
    const char* cA = (const char*)g.A + (size_t)cur.pm * tstepA; const char* cB = (const char*)g.Bt + (size_t)cur.pn * tstepB;
    if constexpr (Epi::HAS_PREFETCH) E.prefetch(cur, 0, lds, wid, lane);
    PG8_STAGE(PG8_SB(0, 0), cB, voffB); PG8_STAGE(PG8_SB(0, 1), cB + hstepB, voffB); PG8_STAGE(PG8_SA(0, 0), cA, voffA); PG8_STAGE(PG8_SA(0, 1), cA + hstepA, voffA);
    if (wr == 1) PG8_BAR;
    PG8_WAIT_V(2); PG8_BAR;
    PG8_STAGE(PG8_SB(1, 0), cB + kstep, voffB); PG8_STAGE(PG8_SA(1, 0), cA + kstep, voffA); PG8_STAGE(PG8_SB(1, 1), cB + hstepB + kstep, voffB);
    PG8_WAIT_V(6); PG8_BAR;
    for (;;) {
        const bool has_next = S.next(ui + 1, nxt);
        const char* nA = has_next ? (const char*)g.A + (size_t)nxt.pm * tstepA : cA; const char* nB = has_next ? (const char*)g.Bt + (size_t)nxt.pn * tstepB : cB;
#pragma nounroll
        for (int t = 0; t < nt; t += 2) {
            const bool last = (t == nt - 2);
            const char* a1 = cA + (size_t)(t + 1) * kstep;
            const char* a2 = last ? nA : cA + (size_t)(t + 2) * kstep; const char* b2 = last ? nB : cB + (size_t)(t + 2) * kstep;
            const char* a3 = a2 + kstep; const char* b3 = b2 + kstep;
            const bool rlx = (Epi::NST > 0) && (t == 0) && (ui > 0);
            PG8_LDB(B0, 0, 0); PG8_LDB(B1, 0, 1); PG8_SCHED; PG8_LDA(At, 0, 0); PG8_STAGE(PG8_SA(1, 1), a1 + hstepA, voffA);
            if (rlx) { if constexpr (Epi::NST >= 16) PG8_WAIT_V(24); else PG8_WAIT_V(16); } else PG8_WAIT_V(8);
            PG8_WAIT_L(0); PG8_BAR; PG8_MMA(0, 0, At, B0); PG8_MMA(0, 1, At, B1); PG8_BAR; PG8_SCHED;
            PG8_LDA(At, 0, 1); PG8_STAGE(PG8_SB(0, 0), b2, voffB); PG8_STAGE(PG8_SB(0, 1), b2 + hstepB, voffB); PG8_STAGE(PG8_SA(0, 0), a2, voffA);
            if (rlx) { if constexpr (Epi::NST >= 16) PG8_WAIT_V(24); else PG8_WAIT_V(16); } else PG8_WAIT_V(8);
            PG8_WAIT_L(0); PG8_BAR; PG8_MMA(1, 0, At, B0); PG8_MMA(1, 1, At, B1); PG8_BAR; PG8_SCHED;
            PG8_LDB(B0, 1, 0); PG8_LDB(B1, 1, 1); PG8_SCHED; PG8_LDA(At, 1, 0); PG8_STAGE(PG8_SA(0, 1), a2 + hstepA, voffA);
            PG8_WAIT_V(8); PG8_WAIT_L(0); PG8_BAR; PG8_MMA(0, 0, At, B0); PG8_MMA(0, 1, At, B1); PG8_BAR; PG8_SCHED;
            PG8_LDA(At, 1, 1); PG8_STAGE(PG8_SB(1, 0), b3, voffB); PG8_STAGE(PG8_SB(1, 1), b3 + hstepB, voffB); PG8_STAGE(PG8_SA(1, 0), a3, voffA);
            PG8_WAIT_V(8); PG8_WAIT_L(0); PG8_BAR; PG8_MMA(1, 0, At, B0); PG8_MMA(1, 1, At, B1); PG8_BAR; PG8_SCHED;
        }
        if constexpr (ALIGN_EPI) { if (wr == 0) PG8_BAR; }
        { int t_e = threadIdx.x; asm volatile("" : "+v"(t_e)); const int fr_e = t_e & 15, fq_e = (t_e >> 4) & 3;
          if constexpr (Epi::HAS_PREFETCH) { if (has_next) E.prefetch(nxt, (ui + 1) & 1, lds, wid, t_e & 63); E.run(acc, cur, wr, wc, fr_e, fq_e, lds, ui & 1); }
          else E(acc, cur, wr, wc, fr_e, fq_e); }
        if (!has_next) break;
#pragma unroll
        for (int a = 0; a < 2; ++a)
#pragma unroll
            for (int b = 0; b < 2; ++b)
#pragma unroll
                for (int m = 0; m < 4; ++m)
#pragma unroll
                    for (int n = 0; n < 2; ++n) acc[a][b][m][n] = (f32x4){0.f, 0.f, 0.f, 0.f};
        cur = nxt; cA = nA; cB = nB; ++ui;
        if constexpr (ALIGN_EPI) { if (wr == 1) PG8_BAR; }
    }
    PG8_WAIT_V(0);
    if constexpr (!ALIGN_EPI) { if (wr == 0) PG8_BAR; }
    PG8_BAR;
#undef PG8_SA
#undef PG8_SB
#undef PG8_STAGE
#undef PG8_LDA
#undef PG8_LDB
#undef PG8_MMA
#undef PG8_WAIT_V
#undef PG8_WAIT_L
#undef PG8_BAR
#undef PG8_SCHED
}

struct MUnit { const char* A; const char* B; int nt; unsigned kb2; int type; Unit u; };
template <class Sched, class Disp>
__device__ __forceinline__ void gemm_multi(LAS unsigned char* lds, const Sched& S, const Disp& E) {
    int tid = threadIdx.x; asm volatile("" : "+v"(tid));
    const int wid = __builtin_amdgcn_readfirstlane(tid >> 6), lane = tid & 63, wr = wid >> 2, wc = wid & 3, fr = lane & 15, fq = lane >> 4;
    unsigned voffA[2], rB[2], cB2[2];
#pragma unroll
    for (int i = 0; i < 2; ++i) { int R, C; stage_rc(tid * 16 + i * 8192, R, C); voffA[i] = (unsigned)(R * 1024 + C) * 2u; rB[i] = (unsigned)R; cB2[i] = (unsigned)C * 2u; }
    const size_t kstep = (size_t)(BK * 2);
    const size_t hstepA = (size_t)HALF * 1024 * 2;
    const unsigned ldsw = (unsigned)wid * 1024u;
    const int aoff = lds_byte(wr * 64 + fr, fq * 8), boff = lds_byte(wc * 32 + fr, fq * 8);
#define PG8_SA(b, h) (((b) * 2 + (h)) * HTB)
#define PG8_SB(b, h) ((4 + (b) * 2 + (h)) * HTB)
#define PG8_STAGE(bufoff, gbase, voff) do { _Pragma("unroll") for (int _i = 0; _i < 2; ++_i) \
        __builtin_amdgcn_global_load_lds((const unsigned*)((const char*)(gbase) + (voff)[_i]), (LAS unsigned*)(lds + (bufoff) + ldsw + _i * 8192), 16, 0, 0); } while (0)
#define PG8_LDA(dst, b, h) do { _Pragma("unroll") for (int m = 0; m < 4; ++m) _Pragma("unroll") for (int k = 0; k < 2; ++k) dst[m][k] = *(const LAS bf16x8*)(lds + PG8_SA(b, h) + aoff + m * 2048 + k * 1024); } while (0)
#define PG8_LDB(dst, b, h) do { _Pragma("unroll") for (int n = 0; n < 2; ++n) _Pragma("unroll") for (int k = 0; k < 2; ++k) dst[n][k] = *(const LAS bf16x8*)(lds + PG8_SB(b, h) + boff + n * 2048 + k * 1024); } while (0)
#define PG8_MMA(ai, bj, At, Bt) do { __builtin_amdgcn_s_setprio(1); _Pragma("unroll") for (int m = 0; m < 4; ++m) _Pragma("unroll") for (int n = 0; n < 2; ++n) _Pragma("unroll") for (int k = 0; k < 2; ++k) \
        acc[ai][bj][m][n] = __builtin_amdgcn_mfma_f32_16x16x32_bf16(Bt[n][k], At[m][k], acc[ai][bj][m][n], 0, 0, 0); __builtin_amdgcn_s_setprio(0); } while (0)
#define PG8_WAIT_V(n) asm volatile("s_waitcnt vmcnt(" #n ")" ::: "memory")
#define PG8_WAIT_L(n) asm volatile("s_waitcnt lgkmcnt(" #n ")" ::: "memory")
#define PG8_BAR __builtin_amdgcn_s_barrier()
#define PG8_SCHED __builtin_amdgcn_sched_barrier(0)
    MUnit cur, nxt; int ui = 0; int relax = 0;
    if (!S.next(0, cur)) return;
    f32x4 acc[2][2][4][2];
#pragma unroll
    for (int a = 0; a < 2; ++a)
#pragma unroll
        for (int b = 0; b < 2; ++b)
#pragma unroll
            for (int m = 0; m < 4; ++m)
#pragma unroll
                for (int n = 0; n < 2; ++n) acc[a][b][m][n] = (f32x4){0.f, 0.f, 0.f, 0.f};
    bf16x8 At[4][2], B0[2][2], B1[2][2];
    const char* cA = cur.A; const char* cB = cur.B;
    E.prefetch(cur, 0, lds, wid, lane);
    unsigned voffB[2]; voffB[0] = rB[0] * cur.kb2 + cB2[0]; voffB[1] = rB[1] * cur.kb2 + cB2[1];
    size_t hstepB = (size_t)HALF * cur.kb2;
    PG8_STAGE(PG8_SB(0, 0), cB, voffB); PG8_STAGE(PG8_SB(0, 1), cB + hstepB, voffB); PG8_STAGE(PG8_SA(0, 0), cA, voffA); PG8_STAGE(PG8_SA(0, 1), cA + hstepA, voffA);
    if (wr == 1) PG8_BAR;
    PG8_WAIT_V(2); PG8_BAR;
    PG8_STAGE(PG8_SB(1, 0), cB + kstep, voffB); PG8_STAGE(PG8_SA(1, 0), cA + kstep, voffA); PG8_STAGE(PG8_SB(1, 1), cB + hstepB + kstep, voffB);
    PG8_WAIT_V(6); PG8_BAR;
    for (;;) {
        const bool has_next = S.next(ui + 1, nxt);
        if (!has_next) nxt = cur;
        const char* nA = nxt.A; const char* nB = nxt.B;
        unsigned nvoffB[2]; nvoffB[0] = rB[0] * nxt.kb2 + cB2[0]; nvoffB[1] = rB[1] * nxt.kb2 + cB2[1];
        const size_t nhstepB = (size_t)HALF * nxt.kb2;
        const int nt = cur.nt;
#pragma nounroll
        for (int t = 0; t < nt; t += 2) {
            const bool last = (t == nt - 2);
            const char* a1 = cA + (size_t)(t + 1) * kstep;
            const char* a2 = last ? nA : cA + (size_t)(t + 2) * kstep; const char* b2 = last ? nB : cB + (size_t)(t + 2) * kstep;
            const char* a3 = a2 + kstep; const char* b3 = b2 + kstep;
            unsigned vB2[2]; vB2[0] = last ? nvoffB[0] : voffB[0]; vB2[1] = last ? nvoffB[1] : voffB[1];
            const size_t hB2 = last ? nhstepB : hstepB;
            const int rlx = (t == 0) ? relax : 0;
            PG8_LDB(B0, 0, 0); PG8_LDB(B1, 0, 1); PG8_SCHED; PG8_LDA(At, 0, 0); PG8_STAGE(PG8_SA(1, 1), a1 + hstepA, voffA);
            if (rlx >= 16) PG8_WAIT_V(24); else if (rlx >= 8) PG8_WAIT_V(16); else PG8_WAIT_V(8);
            PG8_WAIT_L(0); PG8_BAR; PG8_MMA(0, 0, At, B0); PG8_MMA(0, 1, At, B1); PG8_BAR; PG8_SCHED;
            PG8_LDA(At, 0, 1); PG8_STAGE(PG8_SB(0, 0), b2, vB2); PG8_STAGE(PG8_SB(0, 1), b2 + hB2, vB2); PG8_STAGE(PG8_SA(0, 0), a2, voffA);
            if (rlx >= 16) PG8_WAIT_V(24); else if (rlx >= 8) PG8_WAIT_V(16); else PG8_WAIT_V(8);
            PG8_WAIT_L(0); PG8_BAR; PG8_MMA(1, 0, At, B0); PG8_MMA(1, 1, At, B1); PG8_BAR; PG8_SCHED;
            PG8_LDB(B0, 1, 0); PG8_LDB(B1, 1, 1); PG8_SCHED; PG8_LDA(At, 1, 0); PG8_STAGE(PG8_SA(0, 1), a2 + hstepA, voffA);
            PG8_WAIT_V(8); PG8_WAIT_L(0); PG8_BAR; PG8_MMA(0, 0, At, B0); PG8_MMA(0, 1, At, B1); PG8_BAR; PG8_SCHED;
            PG8_LDA(At, 1, 1); PG8_STAGE(PG8_SB(1, 0), b3, vB2); PG8_STAGE(PG8_SB(1, 1), b3 + hB2, vB2); PG8_STAGE(PG8_SA(1, 0), a3, voffA);
            PG8_WAIT_V(8); PG8_WAIT_L(0); PG8_BAR; PG8_MMA(1, 0, At, B0); PG8_MMA(1, 1, At, B1); PG8_BAR; PG8_SCHED;
        }
        if (wr == 0) PG8_BAR;
        { int t_e = threadIdx.x; asm volatile("" : "+v"(t_e)); if (has_next) E.prefetch(nxt, (ui + 1) & 1, lds, wid, t_e & 63); E(acc, cur, wr, wc, t_e & 15, (t_e >> 4) & 3, lds, ui & 1); }
        if (!has_next) break;
#pragma unroll
        for (int a = 0; a < 2; ++a)
#pragma unroll
            for (int b = 0; b < 2; ++b)
#pragma unroll
                for (int m = 0; m < 4; ++m)
#pragma unroll
                    for (int n = 0; n < 2; ++n) acc[a][b][m][n] = (f32x4){0.f, 0.f, 0.f, 0.f};
        relax = (cur.type == 0 && cur.u.pn >= 4) ? 8 : 16;
        cur = nxt; cA = nA; cB = nB; voffB[0] = nvoffB[0]; voffB[1] = nvoffB[1]; hstepB = nhstepB; ++ui;
        if (wr == 1) PG8_BAR;
    }
    PG8_WAIT_V(0);
    PG8_BAR;
#undef PG8_SA
#undef PG8_SB
#undef PG8_STAGE
#undef PG8_LDA
#undef PG8_LDB
#undef PG8_MMA
#undef PG8_WAIT_V
#undef PG8_WAIT_L
#undef PG8_BAR
#undef PG8_SCHED
}

typedef f32x4 Acc[2][2][4][2];

struct EpiStore { static constexpr bool HAS_PREFETCH = false; static constexpr int NST = 16;
    bf16_t* O; int ldc; bool nt = false;
    __device__ __forceinline__ void operator()(const Acc& acc, const Unit& u, int wr, int wc, int fr, int fq) const {
        const int row0 = u.pm * BM + wr * 64 + fr, col0 = u.pn * BM + wc * 32 + 8 * fq;
#pragma unroll
        for (int ai = 0; ai < 2; ++ai)
#pragma unroll
            for (int m = 0; m < 4; ++m) { bf16_t* rowp = O + (size_t)(row0 + ai * HALF + m * 16) * ldc + col0;
#pragma unroll
                for (int bj = 0; bj < 2; ++bj) { const f32x4 v0 = acc[ai][bj][m][0], v1 = acc[ai][bj][m][1];
                    u32x4 w; w.x = cvt_pk_bf16(v0[0], v0[1]); w.y = cvt_pk_bf16(v0[2], v0[3]); w.z = cvt_pk_bf16(v1[0], v1[1]); w.w = cvt_pk_bf16(v1[2], v1[3]);
                    if (nt) __builtin_nontemporal_store(w, (u32x4*)(rowp + bj * HALF)); else *(u32x4*)(rowp + bj * HALF) = w; } }
    }
};

struct EpiP { static constexpr bool HAS_PREFETCH = false, AFTER_DRAIN = false; static constexpr int NST = 8;
    bf16_t* O; bf16_t* U; float* ssq_q; float* ssq_kv;
    __device__ __forceinline__ void operator()(const Acc& acc, const Unit& u, int wr, int wc, int fr, int fq) const {
        const int row0 = u.pm * BM + wr * 64 + fr;
        if (u.pn >= 4) {
            bf16_t* ucol = U + 128 * (u.pn - 4) + 32 * wc + 8 * fq;
#pragma unroll
            for (int ai = 0; ai < 2; ++ai)
#pragma unroll
                for (int m = 0; m < 4; ++m) { const f32x4 v0 = acc[ai][0][m][0] * acc[ai][1][m][0], v1 = acc[ai][0][m][1] * acc[ai][1][m][1];
                    u32x4 w; w.x = cvt_pk_bf16(v0[0], v0[1]); w.y = cvt_pk_bf16(v0[2], v0[3]); w.z = cvt_pk_bf16(v1[0], v1[1]); w.w = cvt_pk_bf16(v1[2], v1[3]);
                    *(u32x4*)(ucol + (size_t)(row0 + ai * HALF + m * 16) * 512) = w; }
            return;
        }
        EpiStore st{O, PW}; st(acc, u, wr, wc, fr, fq);
        if (u.pn <= 1) {
            float* dst = (u.pn == 0) ? ssq_q : ssq_kv;
#pragma unroll
            for (int ai = 0; ai < 2; ++ai)
#pragma unroll
                for (int m = 0; m < 4; ++m) { float s = 0.f;
#pragma unroll
                    for (int n = 0; n < 2; ++n) { const f32x4 a = acc[ai][0][m][n]; s += (a[0] * a[0] + a[1] * a[1]) + (a[2] * a[2] + a[3] * a[3]); }
                    if (u.pn == 0) {
#pragma unroll
                        for (int n = 0; n < 2; ++n) { const f32x4 a = acc[ai][1][m][n]; s += (a[0] * a[0] + a[1] * a[1]) + (a[2] * a[2] + a[3] * a[3]); } }
                    s += __shfl_xor(s, 16); s += __shfl_xor(s, 32);
                    if (fq == 0) dst[(size_t)(row0 + ai * HALF + m * 16) * 4 + wc] = s; }
        }
    }
};

constexpr int SSQ_LDS = RING_BYTES + 1024;
struct EpiKV { static constexpr bool HAS_PREFETCH = false, AFTER_DRAIN = false; static constexpr int NST = 16;
    bf16_t* KN; bf16_t* V;
    __device__ __forceinline__ void operator()(const Acc& acc, const Unit& u, int wr, int wc, int fr, int fq, LAS unsigned char* lds, int buf) const {
        const int b = u.pm >> 3;
        const LAS f32x4* sq = (const LAS f32x4*)(lds + SSQ_LDS + buf * 4096) + wr * 64 + fr;
        float f[2][4];
#pragma unroll
        for (int ai = 0; ai < 2; ++ai)
#pragma unroll
            for (int m = 0; m < 4; ++m) { const f32x4 sp = sq[ai * HALF + m * 16]; f[ai][m] = rsqrtf(((sp[0] + sp[1]) + (sp[2] + sp[3])) * (1.f / 128.f) + 1e-6f); }
#pragma unroll
        for (int bj = 0; bj < 2; ++bj) { const int g = 8 * u.pn + 4 * bj + wc, head = g >> 2, part = g & 3;
            char* base = (part < 2) ? (char*)KN + (4 * part + fq) * 1024 + fr * 16 : (char*)V + (part - 2) * 4096 + fr * 64 + fq * 16;
            const int mstep = (part < 2) ? 256 : 1024;
            base += (size_t)(b * 8 + head) * 32 * 8192;
#pragma unroll
            for (int ai = 0; ai < 2; ++ai) { const int tile = (4 * u.pm + 2 * ai + wr) & 31;
#pragma unroll
                for (int m = 0; m < 4; ++m) {
                    const f32x4 v0 = acc[ai][bj][m][0] * f[ai][m], v1 = acc[ai][bj][m][1] * f[ai][m];
                    u32x4 w; w.x = cvt_pk_bf16(v0[0], v0[1]); w.y = cvt_pk_bf16(v0[2], v0[3]); w.z = cvt_pk_bf16(v1[0], v1[1]); w.w = cvt_pk_bf16(v1[2], v1[3]);
                    __builtin_nontemporal_store(w, (u32x4*)(base + (size_t)tile * 8192 + m * mstep)); } } }
    }
};

struct MixedOrder {
    const char* HB; const char* P; const char* WIN; const char* WQ; const char* WKV; int G, c;
    __device__ __forceinline__ void set_long(int k, MUnit& m) const { const int li = k * G + c, w = (li % NXCD) * 96 + li / NXCD, pm = w / 6, pn = 2 + w % 6;
        m.A = HB + (size_t)pm * (256 * 1024 * 2); m.B = WIN + (size_t)pn * (256 * 1024 * 2); m.nt = 16; m.kb2 = 2048u; m.type = 0; m.u.pm = pm; m.u.pn = pn; }
    __device__ __forceinline__ void set_short(int k, MUnit& m) const { const int si = k * G + c, s = (si % NXCD) * 112 + si / NXCD;
        if (s < 384) { const int pm = s / 3, pn = s % 3; m.A = P + (size_t)pm * (256 * 1024 * 2); m.B = WQ + (size_t)pn * (256 * 256 * 2); m.nt = 4; m.kb2 = 512u; m.type = 1; m.u.pm = pm; m.u.pn = pn; }
        else { const int s2 = s - 384, pm = s2 >> 2, pn = s2 & 3; m.A = P + 512 + (size_t)pm * (256 * 1024 * 2); m.B = WKV + (size_t)pn * (256 * 256 * 2); m.nt = 4; m.kb2 = 512u; m.type = 2; m.u.pm = pm; m.u.pn = pn; } }
    __device__ __forceinline__ bool next(int i, MUnit& m) const {
        const int ns = (c < 128) ? 4 : 3; if (i >= 3 + ns) return false;
        const int k = i >> 1; const bool even = (c & 1) == 0;
        if (i == 6) { set_short(3, m); return true; }
        if (even == ((i & 1) == 0)) set_long(k, m); else set_short(k, m);
        return true;
    }
};
struct EpiMix { EpiP p; EpiStore q; EpiKV kv; const float* ssqkv;
    __device__ __forceinline__ void prefetch(const MUnit& m, int buf, LAS unsigned char* lds, int wid, int lane) const {
        if (m.type == 2 && wid < 4) __builtin_amdgcn_global_load_lds((const unsigned*)(ssqkv + (size_t)m.u.pm * 1024 + wid * 256 + lane * 4), (LAS unsigned*)(lds + SSQ_LDS + buf * 4096 + wid * 1024), 16, 0, 0);
    }
    __device__ __forceinline__ void operator()(const Acc& acc, const MUnit& m, int wr, int wc, int fr, int fq, LAS unsigned char* lds, int buf) const {
        if (m.type == 0) p(acc, m.u, wr, wc, fr, fq); else if (m.type == 1) q(acc, m.u, wr, wc, fr, fq); else kv(acc, m.u, wr, wc, fr, fq, lds, buf);
    }
};

template <int CTRL> __device__ __forceinline__ float dppf(float v) { return __builtin_bit_cast(float, __builtin_amdgcn_update_dpp(0, __builtin_bit_cast(int, v), CTRL, 0xf, 0xf, true)); }
template <int CTRL> __device__ __forceinline__ f32x4 dpp4(f32x4 v) { f32x4 r; r[0] = dppf<CTRL>(v[0]); r[1] = dppf<CTRL>(v[1]); r[2] = dppf<CTRL>(v[2]); r[3] = dppf<CTRL>(v[3]); return r; }

constexpr int CW_LDS = RING_BYTES + 1024;
struct EpiUp { static constexpr bool HAS_PREFETCH = true; static constexpr int NST = 0;
    bf16_t* ACT; float* E; const float* cw; const float* cb;
    __device__ __forceinline__ void prefetch(const Unit& u, int buf, LAS unsigned char* lds, int wid, int lane) const {
        if (wid < 4) { const float* base = (wid < 3) ? cw + (size_t)wid * UPW : cb;
            const float* src = base + 128 * u.pn + ((lane & 32) ? DFF : 0) + 4 * (lane & 31);
            __builtin_amdgcn_global_load_lds((const unsigned*)src, (LAS unsigned*)(lds + CW_LDS + buf * 4096 + wid * 1024), 16, 0, 0); }
    }
    __device__ __forceinline__ void run(const Acc& acc, const Unit& u, int wr, int wc, int fr, int fq, LAS unsigned char* lds, int buf) const {
        const int cl = 32 * wc + 8 * fq;
        const int cbase = 128 * u.pn + cl;
        const LAS float* wl = (const LAS float*)(lds + CW_LDS + buf * 4096) + cl;
        u32x2 res0[2][4];
#pragma unroll
        for (int n = 0; n < 2; ++n) { const int c0 = cbase + 4 * n;
            const f32x4 wg0 = *(const LAS f32x4*)(wl + 4 * n), wg1 = *(const LAS f32x4*)(wl + 256 + 4 * n), wg2 = *(const LAS f32x4*)(wl + 512 + 4 * n), bg = *(const LAS f32x4*)(wl + 768 + 4 * n);
            const f32x4 wv0 = *(const LAS f32x4*)(wl + 128 + 4 * n), wv1 = *(const LAS f32x4*)(wl + 384 + 4 * n), wv2 = *(const LAS f32x4*)(wl + 640 + 4 * n), bv = *(const LAS f32x4*)(wl + 896 + 4 * n);
#pragma unroll
            for (int ai = 0; ai < 2; ++ai) { f32x4 pg1 = {0.f, 0.f, 0.f, 0.f}, pg2 = pg1, pv1 = pg1, pv2 = pg1;
                const int blk = 4 * u.pm + 2 * ai + wr;
#pragma unroll
                for (int m = 0; m < 4; ++m) { const f32x4 gcur = acc[ai][0][m][n], vcur = acc[ai][1][m][n];
                    const f32x4 rg1 = dpp4<0x121>(gcur), rg2 = dpp4<0x122>(gcur), rv1 = dpp4<0x121>(vcur), rv2 = dpp4<0x122>(vcur);
                    const f32x4 g1 = (fr >= 1) ? rg1 : pg1, g2 = (fr >= 2) ? rg2 : pg2, v1 = (fr >= 1) ? rv1 : pv1, v2 = (fr >= 2) ? rv2 : pv2;
                    const f32x4 cg = bg + wg0 * g2 + wg1 * g1 + wg2 * gcur, cv = bv + wv0 * v2 + wv1 * v1 + wv2 * vcur;
                    f32x4 a; a[0] = silu_f(cg[0]) * cv[0]; a[1] = silu_f(cg[1]) * cv[1]; a[2] = silu_f(cg[2]) * cv[2]; a[3] = silu_f(cg[3]) * cv[3];
                    u32x2 w; w.x = cvt_pk_bf16(a[0], a[1]); w.y = cvt_pk_bf16(a[2], a[3]);
                    const int t = u.pm * BM + ai * HALF + wr * 64 + m * 16 + fr;
                    if (n == 0) res0[ai][m] = w;
                    else if (!(m == 0 && fr < 2)) { u32x4 o; o.x = res0[ai][m].x; o.y = res0[ai][m].y; o.z = w.x; o.w = w.y; *(u32x4*)(ACT + (size_t)t * DFF + cbase) = o; }
                    if (m == 0 && fr < 2) { float* e = E + ((size_t)blk * 4 + fr) * UPW + c0; *(f32x4*)e = gcur; *(f32x4*)(e + DFF) = vcur; }
                    if (m == 3 && fr >= 14) { float* e = E + ((size_t)blk * 4 + 2 + (fr - 14)) * UPW + c0; *(f32x4*)e = gcur; *(f32x4*)(e + DFF) = vcur; }
                    pg1 = rg1; pg2 = rg2; pv1 = rv1; pv2 = rv2; } } }
    }
};
}

namespace att {
constexpr int NSLOT = 3, K_OFF = 0, KSLOT = 12288, V_OFF = NSLOT * KSLOT, VSLOT = 8192, WS_OFF = V_OFF + NSLOT * VSLOT, OST_OFF = WS_OFF + 8 * 256, LDS_END = OST_OFF + 8 * 8192;
static_assert(LDS_END <= RING_BYTES, "attention LDS");
__device__ __forceinline__ int crow(int r, int hi) { return (r & 3) + 8 * (r >> 2) + 4 * hi; }
typedef short v4i16_t __attribute__((ext_vector_type(4)));
__device__ __forceinline__ s16x4 vtr(const LAS unsigned char* p) { return __builtin_bit_cast(s16x4, __builtin_amdgcn_ds_read_tr16_b64_v4i16((LAS v4i16_t*)p)); }
__device__ __forceinline__ void glds(const char* src, LAS unsigned char* dst) { unsigned keep; const unsigned d = (unsigned)__builtin_amdgcn_readfirstlane((int)(unsigned)(uintptr_t)dst);
    asm volatile("s_mov_b32 %0, m0\n\ts_mov_b32 m0, %2\n\ts_nop 0\n\tglobal_load_lds_dwordx4 %1, off\n\ts_mov_b32 m0, %0" : "=&s"(keep) : "v"(src), "s"(d) : "memory"); }
__device__ __forceinline__ float max3f(float a, float b, float c) { float r; asm("v_max3_f32 %0, %1, %2, %3" : "=v"(r) : "v"(a), "v"(b), "v"(c)); return r; }
__device__ __forceinline__ float max2f(float a, float b) { float r; asm("v_max_f32_e32 %0, %1, %2" : "=v"(r) : "v"(a), "v"(b)); return r; }
__device__ __forceinline__ float fadd_s(float a, float b) { float r = a + b; asm volatile("" : "+v"(r)); return r; }
typedef float f32x2_t __attribute__((ext_vector_type(2))); typedef __bf16 bf16x2_t __attribute__((ext_vector_type(2)));
__device__ __forceinline__ unsigned cvtpk_m(float lo, float hi) { f32x2_t v = {lo, hi}; bf16x2_t b2 = __builtin_convertvector(v, bf16x2_t); return __builtin_bit_cast(unsigned, b2); }
constexpr float THRL = 4.0f;

struct AUnit { int b, h, qb; };
__device__ __forceinline__ bool unit_of(int k, int vcu, int G, AUnit& u) {
    const int it = vcu + (k >> 2) * G, r = k & 3; if (it >= 256) return false;
    const int grp = it >> 3, i8 = it & 7, bh = grp * 4 + r; u.b = bh >> 3; u.h = bh & 7;
    u.qb = (r == 0) ? 7 - i8 : (r == 1) ? i8 : (r == 2) ? 7 - (i8 ^ 1) : (i8 ^ 1); return true;
}
__device__ __forceinline__ void attn_phase(int vcu, int G, const float* ssqq, const float* rope, const bf16_t* Q, const bf16_t* KN, const bf16_t* KR, const bf16_t* V, bf16_t* Y, const float* ong, LAS unsigned char* lds) {
    int tid = threadIdx.x; asm volatile("" : "+v"(tid));
    const int lane = tid & 63, r32 = lane & 31, hi = lane >> 5; const int wid = __builtin_amdgcn_readfirstlane(tid >> 6);
    const int lo16 = wid * 1024 + lane * 16;
    LAS float* wsf = (LAS float*)(lds + WS_OFF + wid * 256);
    const int kl = hi * 1024 + r32 * 16, vl = ((lane >> 4) & 1) * 32 + (lane & 3) * 8 + (4 * hi + ((lane & 15) >> 2)) * 64;
#define ATT_ISSUE(U, tile, slot) do { const size_t bh_ = (size_t)((U).b * 8 + (U).h); \
        glds((const char*)KN + (bh_ * 32 + (tile)) * 8192 + lo16, lds + K_OFF + (slot) * KSLOT + wid * 1024); glds((const char*)V + (bh_ * 32 + (tile)) * 8192 + lo16, lds + V_OFF + (slot) * VSLOT + wid * 1024); \
        if (wid < 4) glds((const char*)KR + ((size_t)(U).b * 32 + (tile)) * 4096 + lo16, lds + K_OFF + (slot) * KSLOT + 8192 + wid * 1024); } while (0)
#define ATT_QLOAD(dst, aux, U) do { const size_t row_ = (size_t)((U).b * SEQ + 256 * (U).qb + 32 * wid + r32); const bf16_t* qp_ = Q + row_ * QW + 96 * (U).h + 8 * hi; \
        _Pragma("unroll") for (int ks = 0; ks < 6; ++ks) dst[ks] = *(const bf16x8*)(qp_ + 16 * ks); \
        aux[0] = *(const f32x4*)(ssqq + row_ * 4); aux[1] = *(const f32x4*)(rope + row_ * 32 + 8 * hi); aux[2] = *(const f32x4*)(rope + row_ * 32 + 8 * hi + 4); \
        aux[3] = *(const f32x4*)(rope + row_ * 32 + 16 + 8 * hi); aux[4] = *(const f32x4*)(rope + row_ * 32 + 16 + 8 * hi + 4); } while (0)
#define ATT_QFIX(q, aux) do { const float f_ = rsqrtf(((aux[0][0] + aux[0][1]) + (aux[0][2] + aux[0][3])) * (1.f / 256.f) + 1e-6f) * QSCALE; \
        _Pragma("unroll") for (int ks = 0; ks < 4; ++ks) { const u32x4 w_ = __builtin_bit_cast(u32x4, q[ks]); u32x4 o_; \
            _Pragma("unroll") for (int e = 0; e < 4; ++e) o_[e] = cvtpk_m(bf_lo(w_[e]) * f_, bf_hi(w_[e]) * f_); q[ks] = __builtin_bit_cast(bf16x8, o_); } \
        { const u32x4 a_ = __builtin_bit_cast(u32x4, q[4]), b_ = __builtin_bit_cast(u32x4, q[5]); u32x4 oa_, ob_; \
          _Pragma("unroll") for (int e = 0; e < 4; ++e) { const float x1l = bf_lo(a_[e]), x1h = bf_hi(a_[e]), x2l = bf_lo(b_[e]), x2h = bf_hi(b_[e]); \
              const float cl = (e < 2) ? aux[1][2 * e] : aux[2][2 * e - 4], ch = (e < 2) ? aux[1][2 * e + 1] : aux[2][2 * e - 3], sl = (e < 2) ? aux[3][2 * e] : aux[4][2 * e - 4], sh = (e < 2) ? aux[3][2 * e + 1] : aux[4][2 * e - 3]; \
              oa_[e] = cvtpk_m((x1l * cl - x2l * sl) * f_, (x1h * ch - x2h * sh) * f_); ob_[e] = cvtpk_m((x2l * cl + x1l * sl) * f_, (x2h * ch + x1h * sh) * f_); } \
          q[4] = __builtin_bit_cast(bf16x8, oa_); q[5] = __builtin_bit_cast(bf16x8, ob_); } } while (0)
    AUnit cur, nxt;
    if (!unit_of(0, vcu, G, cur)) return;
    bf16x8 qr[6], qn[6]; f32x4 qa[5], qna[5];
    ATT_QLOAD(qr, qa, cur);
    ATT_QFIX(qr, qa);
    asm volatile("" : "+v"(qr[0]), "+v"(qr[1]), "+v"(qr[2]), "+v"(qr[3]), "+v"(qr[4]), "+v"(qr[5]));
    ATT_ISSUE(cur, 0, 0); ATT_ISSUE(cur, 1, 1);
    int slot = 0;
    for (int k = 0;; ++k) {
        const bool has_next = unit_of(k + 1, vcu, G, nxt);
        const int NT = 4 * cur.qb + 4, jmax = 4 * cur.qb + (wid >> 1);
        float mrun = 0.f, lrun = 0.f; f32x16 o[2]; o[0] = f32x16{}; o[1] = f32x16{}; f32x16 negm = f32x16{};
        for (int j = 0; j < NT; ++j) {
            if (j == 0 && k > 0) { if (wid < 4) asm volatile("s_waitcnt vmcnt(13) lgkmcnt(0)\n\ts_barrier" ::: "memory"); else asm volatile("s_waitcnt vmcnt(12) lgkmcnt(0)\n\ts_barrier" ::: "memory"); }
            else if (j + 1 < NT || has_next) { if (wid < 4) asm volatile("s_waitcnt vmcnt(3) lgkmcnt(0)\n\ts_barrier" ::: "memory"); else asm volatile("s_waitcnt vmcnt(2) lgkmcnt(0)\n\ts_barrier" ::: "memory"); }
            else asm volatile("s_waitcnt vmcnt(0) lgkmcnt(0)\n\ts_barrier" ::: "memory");
            { const int s2 = (slot == 0) ? 2 : slot - 1;
              if (j + 2 < NT) ATT_ISSUE(cur, j + 2, s2); else if (has_next) ATT_ISSUE(nxt, j + 2 - NT, s2); }
            if (j == NT - 1 && has_next) ATT_QLOAD(qn, qna, nxt);
            if (j <= jmax) {
                const LAS unsigned char* kp = lds + K_OFF + slot * KSLOT + kl;
                f32x16 p0, p1;
#pragma unroll
                for (int ks = 0; ks < 6; ++ks) { const bf16x8 k0 = *(const LAS bf16x8*)(kp + ks * 2048), k1 = *(const LAS bf16x8*)(kp + ks * 2048 + 512);
                    if (ks == 0) { p0 = __builtin_amdgcn_mfma_f32_32x32x16_bf16(k0, qr[0], negm, 0, 0, 0); p1 = __builtin_amdgcn_mfma_f32_32x32x16_bf16(k1, qr[0], negm, 0, 0, 0); }
                    else { p0 = __builtin_amdgcn_mfma_f32_32x32x16_bf16(k0, qr[ks], p0, 0, 0, 0); p1 = __builtin_amdgcn_mfma_f32_32x32x16_bf16(k1, qr[ks], p1, 0, 0, 0); } }
                asm volatile("s_nop 15\n\ts_nop 7" : "+v"(p0), "+v"(p1));
                float rm;
                { float a = max3f(p0[0], p0[1], p1[0]), c = max3f(p0[2], p0[3], p1[1]); a = max3f(a, p1[2], p1[3]);
#pragma unroll
                  for (int r = 4; r < 16; r += 4) { a = max3f(a, p0[r], p0[r + 1]); c = max3f(c, p0[r + 2], p0[r + 3]); a = max3f(a, p1[r], p1[r + 1]); c = max3f(c, p1[r + 2], p1[r + 3]); }
                  rm = max2f(a, c); rm = max2f(rm, __shfl_xor(rm, 32)); }
                if (j == 0 || __any(rm > THRL)) {
                    const float dl = (j == 0) ? rm : fmaxf(rm, 0.f);
                    mrun += dl;
#pragma unroll
                    for (int r = 0; r < 16; ++r) { p0[r] -= dl; p1[r] -= dl; }
#pragma unroll
                    for (int r = 0; r < 16; ++r) negm[r] = -mrun;
                    if (j != 0) { const float alpha = fexp2(-dl); lrun *= alpha;
                        if (hi == 0) wsf[r32] = alpha;
#pragma unroll
                        for (int r = 0; r < 16; ++r) { const float a_ = wsf[crow(r, hi)]; o[0][r] *= a_; o[1][r] *= a_; } }
                }
#pragma unroll
                for (int r = 0; r < 16; ++r) { p0[r] = fexp2(p0[r]); p1[r] = fexp2(p1[r]); }
                { float s0 = fadd_s(p0[0], p1[0]), s1 = fadd_s(p0[1], p1[1]);
#pragma unroll
                  for (int r = 2; r < 16; r += 2) { s0 = fadd_s(s0, p0[r]); s1 = fadd_s(s1, p0[r + 1]); s0 = fadd_s(s0, p1[r]); s1 = fadd_s(s1, p1[r + 1]); }
                  lrun = fadd_s(lrun, fadd_s(s0, s1)); }
                bf16x8 pa[4];
                { u32x4 w0, w1, w2, w3;
                  w0.x = cvtpk_m(p0[0], p0[1]); w0.y = cvtpk_m(p0[2], p0[3]); w0.z = cvtpk_m(p0[4], p0[5]); w0.w = cvtpk_m(p0[6], p0[7]);
                  w1.x = cvtpk_m(p0[8], p0[9]); w1.y = cvtpk_m(p0[10], p0[11]); w1.z = cvtpk_m(p0[12], p0[13]); w1.w = cvtpk_m(p0[14], p0[15]);
                  w2.x = cvtpk_m(p1[0], p1[1]); w2.y = cvtpk_m(p1[2], p1[3]); w2.z = cvtpk_m(p1[4], p1[5]); w2.w = cvtpk_m(p1[6], p1[7]);
                  w3.x = cvtpk_m(p1[8], p1[9]); w3.y = cvtpk_m(p1[10], p1[11]); w3.z = cvtpk_m(p1[12], p1[13]); w3.w = cvtpk_m(p1[14], p1[15]);
                  pa[0] = __builtin_bit_cast(bf16x8, w0); pa[1] = __builtin_bit_cast(bf16x8, w1); pa[2] = __builtin_bit_cast(bf16x8, w2); pa[3] = __builtin_bit_cast(bf16x8, w3); }
                const LAS unsigned char* vp = lds + V_OFF + slot * VSLOT + vl;
#pragma unroll
                for (int d0 = 0; d0 < 2; ++d0)
#pragma unroll
                    for (int ks = 0; ks < 4; ++ks) { const s16x4 lo = vtr(vp + d0 * 4096 + ks * 1024), hh = vtr(vp + d0 * 4096 + ks * 1024 + 512);
                        const bf16x8 vf = {lo[0], lo[1], lo[2], lo[3], hh[0], hh[1], hh[2], hh[3]};
                        o[d0] = __builtin_amdgcn_mfma_f32_32x32x16_bf16(pa[ks], vf, o[d0], 0, 0, 0); }
            }
            slot = (slot == 2) ? 0 : slot + 1;
        }
        { const float lt = lrun + __shfl_xor(lrun, 32);
          if (hi == 0) wsf[r32] = frcp(lt);
          LAS float* stg = (LAS float*)(lds + OST_OFF + wid * 8192);
#pragma unroll
          for (int r = 0; r < 16; ++r) { const float inv = wsf[crow(r, hi)]; const int orow = crow(r, hi); stg[orow * 64 + r32] = o[0][r] * inv; stg[orow * 64 + 32 + r32] = o[1][r] * inv; }
          asm volatile("s_waitcnt lgkmcnt(0)" ::: "memory");
          const int ch = lane & 7;
          const f32x4 ga = *(const f32x4*)(ong + 64 * cur.h + 8 * ch), gb = *(const f32x4*)(ong + 64 * cur.h + 8 * ch + 4);
          bf16_t* Yw = Y + (size_t)(cur.b * SEQ + 256 * cur.qb + 32 * wid) * D + 64 * cur.h + 8 * ch;
#pragma unroll
          for (int i = 0; i < 4; ++i) { const int row = i * 8 + (lane >> 3);
              const f32x4 va = *(const LAS f32x4*)(stg + row * 64 + 8 * ch), vb = *(const LAS f32x4*)(stg + row * 64 + 8 * ch + 4);
              float ss = (va[0] * va[0] + va[1] * va[1]) + (va[2] * va[2] + va[3] * va[3]) + (vb[0] * vb[0] + vb[1] * vb[1]) + (vb[2] * vb[2] + vb[3] * vb[3]);
              ss += pg8::dppf<0xB1>(ss); ss += pg8::dppf<0x4E>(ss); ss += pg8::dppf<0x141>(ss);
              const float rs = rsqrtf(ss * (1.f / 64.f) + 1e-6f);
              const f32x4 oa = va * rs * ga, ob = vb * rs * gb;
              u32x4 w; w.x = cvtpk_m(oa[0], oa[1]); w.y = cvtpk_m(oa[2], oa[3]); w.z = cvtpk_m(ob[0], ob[1]); w.w = cvtpk_m(ob[2], ob[3]);
              *(u32x4*)(Yw + (size_t)row * D) = w; } }
        if (!has_next) break;
        cur = nxt;
#pragma unroll
        for (int ks = 0; ks < 6; ++ks) qr[ks] = qn[ks];
        ATT_QFIX(qr, qna);
    }
    asm volatile("s_waitcnt vmcnt(0) lgkmcnt(0)\n\ts_barrier" ::: "memory");
#undef ATT_ISSUE
#undef ATT_QLOAD
#undef ATT_QFIX
}
}

#define XB_TMO      128
#define XB_XCNT(j)  (256  + 64 * (j))
#define XB_XSUB(j)  (1280 + 64 * (j))
#define XB_XGEN(j)  (2304 + 64 * (j))
#define XB_TOP      3328
#define XB_TOPGEN   3392
#define XCD_BAR_WORDS 3456
#define XB_SPIN_CAP (1u << 18)
__device__ __forceinline__ unsigned xb_ld(unsigned* p)              { return __hip_atomic_load(p, __ATOMIC_RELAXED, __HIP_MEMORY_SCOPE_AGENT); }
__device__ __forceinline__ unsigned xb_add(unsigned* p, unsigned v) { return __hip_atomic_fetch_add(p, v, __ATOMIC_RELAXED, __HIP_MEMORY_SCOPE_AGENT); }
__device__ __forceinline__ unsigned xb_xcc_id() { return (unsigned)__builtin_amdgcn_s_getreg((3 << 11) | 20) & 0xFu; }
#define XB_SPIN(cond, bar) do { unsigned _sp = 0; while (cond) { __builtin_amdgcn_s_sleep(1); \
    if ((++_sp & 255u) == 0u) { if (xb_ld(&(bar)[XB_TMO])) break; if (_sp > XB_SPIN_CAP) { atomicAdd(&(bar)[XB_TMO], 1u); break; } } } } while (0)
struct XcdBarrier { unsigned* bar; unsigned x; volatile LAS unsigned* st; };
__device__ __forceinline__ XcdBarrier xcd_barrier_post(unsigned* bar, volatile LAS unsigned* st) {
    XcdBarrier b; b.bar = bar; b.x = xb_xcc_id(); b.st = st;
    if (threadIdx.x == 0) (void)xb_add(&bar[XB_XCNT(b.x)], 1u);
    return b;
}
__device__ __forceinline__ void xcd_barrier_complete(unsigned* bar, unsigned x, unsigned& nloc, unsigned& nx) {
    const unsigned G = gridDim.x * gridDim.y * gridDim.z;
    unsigned sum, cnt, mine, sp = 0u;
    for (;;) {
        sum = 0u; cnt = 0u; mine = 0u;
#pragma unroll
        for (unsigned j = 0; j < 16; ++j) { const unsigned c = xb_ld(&bar[XB_XCNT(j)]); sum += c; cnt += (c > 0u) ? 1u : 0u; mine = (j == x) ? c : mine; }
        if (sum == G) break;
        __builtin_amdgcn_s_sleep(1);
        if ((++sp & 255u) == 0u) { if (xb_ld(&bar[XB_TMO])) break; if (sp > XB_SPIN_CAP) { atomicAdd(&bar[XB_TMO], 1u); break; } }
    }
    nloc = mine > 0u ? mine : 1u; nx = cnt > 0u ? cnt : 1u;
}
__device__ __forceinline__ void xcd_barrier(const XcdBarrier& b) {
    asm volatile("s_waitcnt vmcnt(0)" ::: "memory");
    __syncthreads();
    if (threadIdx.x == 0) {
        unsigned* bar = b.bar;
        __builtin_amdgcn_s_waitcnt(0);
        unsigned nloc = b.st[0], nx = b.st[1];
        if (nloc == 0u) { xcd_barrier_complete(bar, b.x, nloc, nx); b.st[0] = nloc; b.st[1] = nx; }
        const unsigned old = xb_add(&bar[XB_XSUB(b.x)], 1u);
        const unsigned gen = old / nloc;
        if (old + 1u == (gen + 1u) * nloc) {
            __builtin_amdgcn_fence(__ATOMIC_RELEASE, "agent");
            asm volatile("s_waitcnt vmcnt(0)" ::: "memory");
            const unsigned og = xb_add(&bar[XB_TOP], 1u);
            const unsigned tg = og / nx;
            if (og + 1u == (tg + 1u) * nx) xb_add(&bar[XB_TOPGEN], 1u);
            else XB_SPIN(xb_ld(&bar[XB_TOPGEN]) == tg, bar);
            __builtin_amdgcn_fence(__ATOMIC_ACQUIRE, "agent");
            xb_add(&bar[XB_XGEN(b.x)], 1u);
            asm volatile("s_waitcnt vmcnt(0)" ::: "memory");
        } else {
            XB_SPIN(xb_ld(&bar[XB_XGEN(b.x)]) == gen, bar);
            __builtin_amdgcn_fence(__ATOMIC_ACQUIRE, "agent");
            asm volatile("s_waitcnt vmcnt(0)" ::: "memory");
        }
    }
    __syncthreads();
}

struct Args { const float* in[22]; const int* pos; float* out; unsigned char* ws; int ph_lo, ph_hi; };
__constant__ float c_invfreq[16] = {1.0f, 0.5623413251903491f, 0.31622776601683794f, 0.1778279410038923f, 0.1f, 0.05623413251903491f, 0.03162277660168379f, 0.01778279410038923f,
                                    0.01f, 0.005623413251903491f, 0.0031622776601683794f, 0.001778279410038923f, 0.001f, 0.0005623413251903491f, 0.00031622776601683794f, 0.0001778279410038923f};

__device__ __forceinline__ int colmap(int which, int s) {
    const int p = (s & ~31) + pg8::perm32(s & 31);
    switch (which) {
        case 0: { if (s < 1024) return p < 416 ? p : (p < 512 ? -1 : p - 96);
                  const int bj = (s >> 7) & 1, ch = 128 * ((s >> 8) - 4) + 32 * ((s >> 5) & 3) + pg8::perm32(s & 31); return (bj ? 1440 : 928) + ch; }
        case 4: { const int pn = s >> 8, bj = (s >> 7) & 1, wc = (s >> 5) & 3; return bj * DFF + 128 * pn + 32 * wc + pg8::perm32(s & 31); }
        default: return p;
    }
}
__device__ __forceinline__ void p0_transpose_item(const float* W, int ldw, int Ksrc, const float* kscale, bf16_t* WT, int Kdst, int which, LAS float* scr, int item, int nblk, int lane) {
    const int kb = item / nblk, nb = item % nblk, k0 = 64 * kb, s0 = 32 * nb;
    const int cm = colmap(which, s0 + (lane & 31));
    float tv[32];
#pragma unroll
    for (int i = 0; i < 32; ++i) { const int k = k0 + 2 * i + (lane >> 5); tv[i] = (cm >= 0 && k < Ksrc) ? W[(size_t)k * ldw + cm] : 0.f; }
    if (kscale) {
#pragma unroll
        for (int i = 0; i < 32; ++i) { const int k = k0 + 2 * i + (lane >> 5); if (k < Ksrc) tv[i] *= kscale[k]; } }
#pragma unroll
    for (int i = 0; i < 32; ++i) scr[(2 * i + (lane >> 5)) * 33 + (lane & 31)] = tv[i];
    asm volatile("s_waitcnt lgkmcnt(0)" ::: "memory");
    const int c = lane & 7;
#pragma unroll
    for (int j = 0; j < 4; ++j) { const int n = (lane >> 3) + 8 * j; const LAS float* s = scr + (8 * c) * 33 + n;
        u32x4 o; o.x = cvt_pk_bf16(s[0 * 33], s[1 * 33]); o.y = cvt_pk_bf16(s[2 * 33], s[3 * 33]); o.z = cvt_pk_bf16(s[4 * 33], s[5 * 33]); o.w = cvt_pk_bf16(s[6 * 33], s[7 * 33]);
        *(u32x4*)(WT + (size_t)(s0 + n) * Kdst + k0 + 8 * c) = o; }
    asm volatile("s_waitcnt lgkmcnt(0)" ::: "memory");
}

constexpr int N_PHASES = 11;
#define OPAQUE_LANE(name) int name##_t = (int)threadIdx.x; asm volatile("" : "+v"(name##_t)); const int name = name##_t & 63

__global__ void __launch_bounds__(512, 2) mk_fwd(Args args) {
    extern __shared__ __attribute__((aligned(16))) unsigned char lds_raw[];
    LAS unsigned char* lds = (LAS unsigned char*)lds_raw;
    volatile LAS unsigned* MISC = (volatile LAS unsigned*)(lds + MISC_OFF);
    const int tid = threadIdx.x, lane = tid & 63, wave = __builtin_amdgcn_readfirstlane(tid >> 6);
    const int G = gridDim.x; const int bx = blockIdx.x; const int vcu = (G % 8 == 0) ? (bx % 8) * (G / 8) + bx / 8 : bx;
    const int gw = vcu * 8 + wave, NGW = G * 8;
    unsigned char* ws = args.ws;
    const float* x = args.in[0]; const float* cvec = args.in[1]; const int* pos = args.pos;
    const float* w_ada = args.in[3]; const float* b_ada = args.in[4]; const float* w_in = args.in[5];
    const float* qg = args.in[6]; const float* w_qup = args.in[7]; const float* kvg = args.in[8]; const float* w_kvup = args.in[9];
    const float* conv_w = args.in[10]; const float* conv_b = args.in[11]; const float* ong = args.in[12]; const float* w_out = args.in[13];
    const float* ln1g = args.in[14]; const float* ln1b = args.in[15]; const float* w_up = args.in[16];
    const float* fcw = args.in[17]; const float* fcb = args.in[18]; const float* w_down = args.in[19];
    const float* ln2g = args.in[20]; const float* ln2b = args.in[21];
    float* out = args.out;
    float* MOD = (float*)(ws + WS_MOD); float* ROPE = (float*)(ws + WS_ROPE); float* SSQQ = (float*)(ws + WS_SSQQ); float* SSQKV = (float*)(ws + WS_SSQKV);
    bf16_t* WIN = (bf16_t*)(ws + WS_WIN); bf16_t* WQ = (bf16_t*)(ws + WS_WQ); bf16_t* WKV = (bf16_t*)(ws + WS_WKV); bf16_t* WOUT = (bf16_t*)(ws + WS_WOUT);
    bf16_t* WUP = (bf16_t*)(ws + WS_WUP); bf16_t* WDN = (bf16_t*)(ws + WS_WDN);
    bf16_t* HB = (bf16_t*)(ws + WS_HB); bf16_t* FF = (bf16_t*)(ws + WS_FF); bf16_t* P = (bf16_t*)(ws + WS_P); bf16_t* MIX = (bf16_t*)(ws + WS_MIX);
    bf16_t* U = (bf16_t*)(ws + WS_U); bf16_t* Qb = (bf16_t*)(ws + WS_Q); bf16_t* KN = (bf16_t*)(ws + WS_KN); bf16_t* KR = (bf16_t*)(ws + WS_KR); bf16_t* Vb = (bf16_t*)(ws + WS_V);
    bf16_t* Y = (bf16_t*)(ws + WS_Y); bf16_t* X1 = (bf16_t*)(ws + WS_X1); bf16_t* ACT = (bf16_t*)(ws + WS_ACT); float* E = (float*)(ws + WS_E);

    for (int u = tid; u < (LDS_BYTES - LDSCTL_OFF) / 4; u += 512) ((LAS unsigned*)(lds + LDSCTL_OFF))[u] = 0u;
    __syncthreads();
    XcdBarrier bar; bar.bar = (unsigned*)(ws + WS_CTL) + CW_BAR; bar.x = 0; bar.st = nullptr;
    if (MK_N_LAUNCHES == 1) bar = xcd_barrier_post((unsigned*)(ws + WS_CTL) + CW_BAR, MISC + 8);
    const int lo = args.ph_lo, hi = args.ph_hi;
#ifndef PH_MASK
#define PH_MASK 0x7ff
#endif
#define IN(k) (((PH_MASK >> (k)) & 1) && lo <= (k) && (k) < hi)
#define SEAM(k) do { if (IN(k) && IN((k) + 1)) xcd_barrier(bar); } while (0)

    if (IN(0)) {
        OPAQUE_LANE(ln);
        if (bx < 192) {
            LAS float* cact = (LAS float*)lds; LAS float* part = (LAS float*)(lds + 65536);
            const int n0 = 32 * bx, c4 = tid & 7, kr = tid >> 3;
            f32x4 wv[16];
#pragma unroll
            for (int i = 0; i < 16; ++i) wv[i] = *(const f32x4*)(w_ada + (size_t)(kr + 64 * i) * 6144 + n0 + 4 * c4);
            for (int i = tid; i < 16 * 1024; i += 512) { const float v = cvec[i]; cact[i] = v * frcp(1.f + fexp2(-LOG2E * v)); }
            __syncthreads();
            f32x4 a[16];
#pragma unroll
            for (int b = 0; b < 16; ++b) a[b] = (f32x4){0.f, 0.f, 0.f, 0.f};
#pragma unroll
            for (int i = 0; i < 16; ++i) { const int k = kr + 64 * i;
#pragma unroll
                for (int b = 0; b < 16; ++b) a[b] += wv[i] * cact[b * 1024 + k];
                if ((i & 1) == 1) asm volatile("" ::: "memory"); }
#pragma unroll
            for (int b = 0; b < 16; ++b)
#pragma unroll
                for (int e = 0; e < 4; ++e) { float v = a[b][e]; v += __shfl_xor(v, 8); v += __shfl_xor(v, 16); v += __shfl_xor(v, 32); a[b][e] = v; }
            if (ln < 8) {
#pragma unroll
                for (int b = 0; b < 16; ++b) *(LAS f32x4*)(part + (wave * 16 + b) * 32 + 4 * c4) = a[b]; }
            __syncthreads();
            { const int b = tid >> 5, col = tid & 31; float s = 0.f;
#pragma unroll
              for (int w8 = 0; w8 < 8; ++w8) s += part[(w8 * 16 + b) * 32 + col];
              MOD[b * 6144 + n0 + col] = s + b_ada[n0 + col]; }
            __syncthreads();
        }
        for (int idx = gw * 64 + ln; idx < T * 16; idx += NGW * 64) { const int t = idx >> 4, i = idx & 15; const float ang = (float)pos[t] * c_invfreq[i];
            ROPE[(size_t)t * 32 + i] = cosf(ang); ROPE[(size_t)t * 32 + 16 + i] = sinf(ang); }
    }
    SEAM(0);
    if (IN(1)) {
        OPAQUE_LANE(ln);
        {
        LAS float* scr = (LAS float*)(lds + wave * 16384);
        constexpr int I0 = 16 * 64, I1 = 4 * 24, I2 = 4 * 32, I3 = 16 * 32, I4 = 16 * 176, I5 = 44 * 32, NIT = I0 + I1 + I2 + I3 + I4 + I5;
        for (int it = gw; it < NIT; it += NGW) {
            int r = it;
            if (r < I0) { p0_transpose_item(w_in, INW, D, nullptr, WIN, D, 0, scr, r, 64, ln); continue; } r -= I0;
            if (r < I1) { p0_transpose_item(w_qup, QW, 256, qg, WQ, 256, 1, scr, r, 24, ln); continue; } r -= I1;
            if (r < I2) { p0_transpose_item(w_kvup, 1024, 128, kvg, WKV, 256, 2, scr, r, 32, ln); continue; } r -= I2;
            if (r < I3) { p0_transpose_item(w_out, D, D, nullptr, WOUT, D, 3, scr, r, 32, ln); continue; } r -= I3;
            if (r < I4) { p0_transpose_item(w_up, UPW, D, nullptr, WUP, D, 4, scr, r, 176, ln); continue; } r -= I4;
            p0_transpose_item(w_down, D, DFF, nullptr, WDN, DFF, 5, scr, r, 32, ln);
        }
            }
        for (int row0 = gw * 16; row0 < T; row0 += NGW * 16) { const int b = row0 / SEQ; const float* mb = MOD + b * 6144;
            f32x4 sc[4], sh[4];
#pragma unroll
            for (int j = 0; j < 4; ++j) { const int col = 4 * ln + 256 * j; sh[j] = *(const f32x4*)(mb + col); sc[j] = *(const f32x4*)(mb + 1024 + col) + 1.f; }
            for (int rr = 0; rr < 16; ++rr) { const int t = row0 + rr; const float* xr = x + (size_t)t * D;
                f32x4 v[4]; float s = 0.f;
#pragma unroll
                for (int j = 0; j < 4; ++j) { v[j] = *(const f32x4*)(xr + 4 * ln + 256 * j); s += (v[j][0] + v[j][1]) + (v[j][2] + v[j][3]); }
                const float mean = wave_sum(s) * (1.f / D); float q = 0.f;
#pragma unroll
                for (int j = 0; j < 4; ++j) { v[j] = v[j] - mean; q += (v[j][0] * v[j][0] + v[j][1] * v[j][1]) + (v[j][2] * v[j][2] + v[j][3] * v[j][3]); }
                const float rstd = rsqrtf(wave_sum(q) * (1.f / D) + 1e-5f);
#pragma unroll
                for (int j = 0; j < 4; ++j) { const f32x4 o = v[j] * rstd * sc[j] + sh[j]; u32x2 w; w.x = cvt_pk_bf16(o[0], o[1]); w.y = cvt_pk_bf16(o[2], o[3]);
                    *(u32x2*)(HB + (size_t)t * D + 4 * ln + 256 * j) = w; } } }
    }
    SEAM(1);
    if (IN(2)) {
        pg8::Gemm g{HB, D, WIN, T, 512, D}; pg8::StaticOrder S; S.init(T, 512, G, bx);
        pg8::EpiP E1{P, U, SSQQ, SSQKV};
        pg8::gemm_phase<pg8::EpiP, true>(lds, g, S, E1);
    }
    SEAM(2);
    if (IN(3)) {
        OPAQUE_LANE(ln);
        for (int row0 = gw * 16; row0 < T; row0 += NGW * 16) {
            { const int t = row0 + (ln >> 2), c = ln & 3, i0 = 8 * (c & 1); const bf16_t* pr = P + (size_t)t * PW + 384;
              const u32x4 r1 = *(const u32x4*)(pr + i0), r2 = *(const u32x4*)(pr + 16 + i0);
              const f32x4 ca = *(const f32x4*)(ROPE + (size_t)t * 32 + i0), cb = *(const f32x4*)(ROPE + (size_t)t * 32 + i0 + 4), sa = *(const f32x4*)(ROPE + (size_t)t * 32 + 16 + i0), sb = *(const f32x4*)(ROPE + (size_t)t * 32 + 16 + i0 + 4);
              float ov[8];
#pragma unroll
              for (int e = 0; e < 8; ++e) { const float x1 = (e & 1) ? bf_hi(r1[e >> 1]) : bf_lo(r1[e >> 1]), x2 = (e & 1) ? bf_hi(r2[e >> 1]) : bf_lo(r2[e >> 1]);
                  const float cs = (e < 4) ? ca[e & 3] : cb[e & 3], sn = (e < 4) ? sa[e & 3] : sb[e & 3];
                  ov[e] = (c < 2) ? x1 * cs - x2 * sn : x2 * cs + x1 * sn; }
              u32x4 o; o.x = cvt_pk_bf16(ov[0], ov[1]); o.y = cvt_pk_bf16(ov[2], ov[3]); o.z = cvt_pk_bf16(ov[4], ov[5]); o.w = cvt_pk_bf16(ov[6], ov[7]);
              *(u32x4*)((char*)KR + (size_t)(t >> 6) * 4096 + c * 1024 + (t & 63) * 16) = o; }
        }
        { pg8::MixedOrder S{(const char*)HB, (const char*)P, (const char*)WIN, (const char*)WQ, (const char*)WKV, G, bx};
          pg8::EpiMix EM{pg8::EpiP{P, U, SSQQ, SSQKV}, pg8::EpiStore{Qb, QW, true}, pg8::EpiKV{KN, Vb}, SSQKV};
          pg8::gemm_multi<pg8::MixedOrder, pg8::EpiMix>(lds, S, EM); }
    }
    SEAM(3);
    if (IN(4)) {
        att::attn_phase(vcu, G, SSQQ, ROPE, Qb, KN, KR, Vb, Y, ong, lds);
        { OPAQUE_LANE(ln);
        for (int row0 = gw * 16; row0 < T; row0 += NGW * 16) {
            const int c0 = 8 * ln;
            float w0[8], w1[8], w2[8], cb8[8], gn[8];
#pragma unroll
            for (int e = 0; e < 8; ++e) { w0[e] = conv_w[c0 + e]; w1[e] = conv_w[512 + c0 + e]; w2[e] = conv_w[1024 + c0 + e]; cb8[e] = conv_b[c0 + e]; gn[e] = ong[512 + c0 + e]; }
            float um2[8], um1[8];
#pragma unroll
            for (int e = 0; e < 8; ++e) { um2[e] = 0.f; um1[e] = 0.f; }
            if ((row0 % SEQ) != 0) {
                const u32x4 a2 = *(const u32x4*)(U + (size_t)(row0 - 2) * 512 + c0), a1 = *(const u32x4*)(U + (size_t)(row0 - 1) * 512 + c0);
#pragma unroll
                for (int e = 0; e < 4; ++e) { um2[2 * e] = bf_lo(a2[e]); um2[2 * e + 1] = bf_hi(a2[e]); um1[2 * e] = bf_lo(a1[e]); um1[2 * e + 1] = bf_hi(a1[e]); }
            }
            for (int rr = 0; rr < 16; ++rr) { const int t = row0 + rr;
                const u32x4 gb = *(const u32x4*)(P + (size_t)t * PW + 512 + c0), uu = *(const u32x4*)(U + (size_t)t * 512 + c0);
                float u0[8], yv[8]; float ss = 0.f;
#pragma unroll
                for (int e = 0; e < 4; ++e) { u0[2 * e] = bf_lo(uu[e]); u0[2 * e + 1] = bf_hi(uu[e]); }
#pragma unroll
                for (int e = 0; e < 8; ++e) { const float gbe = (e & 1) ? bf_hi(gb[e >> 1]) : bf_lo(gb[e >> 1]);
                    yv[e] = gbe * (cb8[e] + w0[e] * um2[e] + w1[e] * um1[e] + w2[e] * u0[e]); ss += yv[e] * yv[e]; um2[e] = um1[e]; um1[e] = u0[e]; }
                ss += __shfl_xor(ss, 1); ss += __shfl_xor(ss, 2); ss += __shfl_xor(ss, 4);
                const float rs = rsqrtf(ss * (1.f / 64.f) + 1e-6f);
                u32x4 o; o.x = cvt_pk_bf16(yv[0] * rs * gn[0], yv[1] * rs * gn[1]); o.y = cvt_pk_bf16(yv[2] * rs * gn[2], yv[3] * rs * gn[3]);
                o.z = cvt_pk_bf16(yv[4] * rs * gn[4], yv[5] * rs * gn[5]); o.w = cvt_pk_bf16(yv[6] * rs * gn[6], yv[7] * rs * gn[7]);
                *(u32x4*)(Y + (size_t)t * D + 512 + c0) = o; }
        }
            }
    }
    SEAM(4);
    if (IN(5)) {
        pg8::Gemm g{Y, D, WOUT, T, D, D}; pg8::StaticOrder S; S.init(T, D, G, bx); pg8::EpiStore E4{MIX, D};
        pg8::gemm_phase<pg8::EpiStore, true>(lds, g, S, E4);
    }
    SEAM(5);
    if (IN(6)) {
        OPAQUE_LANE(ln);
        for (int row0 = gw * 16; row0 < T; row0 += NGW * 16) { const int b = row0 / SEQ; const float* mb = MOD + b * 6144;
            f32x4 gt[4], g1v[4], b1v[4], sc[4], sh[4];
#pragma unroll
            for (int j = 0; j < 4; ++j) { const int col = 4 * ln + 256 * j; gt[j] = *(const f32x4*)(mb + 2048 + col); g1v[j] = *(const f32x4*)(ln1g + col); b1v[j] = *(const f32x4*)(ln1b + col);
                sh[j] = *(const f32x4*)(mb + 3072 + col); sc[j] = *(const f32x4*)(mb + 4096 + col) + 1.f; }
            for (int rr = 0; rr < 16; ++rr) { const int t = row0 + rr;
                f32x4 v[4]; float s = 0.f;
#pragma unroll
                for (int j = 0; j < 4; ++j) { const int col = 4 * ln + 256 * j; const f32x4 xv = *(const f32x4*)(x + (size_t)t * D + col); const u32x2 mw = *(const u32x2*)(MIX + (size_t)t * D + col);
                    const f32x4 mx = {bf_lo(mw.x), bf_hi(mw.x), bf_lo(mw.y), bf_hi(mw.y)};
                    v[j] = xv * ALPHA + gt[j] * mx; s += (v[j][0] + v[j][1]) + (v[j][2] + v[j][3]); }
                float mean = wave_sum(s) * (1.f / D); float q = 0.f;
#pragma unroll
                for (int j = 0; j < 4; ++j) { v[j] = v[j] - mean; q += (v[j][0] * v[j][0] + v[j][1] * v[j][1]) + (v[j][2] * v[j][2] + v[j][3] * v[j][3]); }
                float rstd = rsqrtf(wave_sum(q) * (1.f / D) + 1e-5f);
                s = 0.f;
#pragma unroll
                for (int j = 0; j < 4; ++j) { v[j] = v[j] * rstd * g1v[j] + b1v[j]; u32x2 w; w.x = cvt_pk_bf16(v[j][0], v[j][1]); w.y = cvt_pk_bf16(v[j][2], v[j][3]); *(u32x2*)(X1 + (size_t)t * D + 4 * ln + 256 * j) = w; s += (v[j][0] + v[j][1]) + (v[j][2] + v[j][3]); }
                mean = wave_sum(s) * (1.f / D); q = 0.f;
#pragma unroll
                for (int j = 0; j < 4; ++j) { v[j] = v[j] - mean; q += (v[j][0] * v[j][0] + v[j][1] * v[j][1]) + (v[j][2] * v[j][2] + v[j][3] * v[j][3]); }
                rstd = rsqrtf(wave_sum(q) * (1.f / D) + 1e-5f);
#pragma unroll
                for (int j = 0; j < 4; ++j) { const f32x4 o = v[j] * rstd * sc[j] + sh[j]; u32x2 w; w.x = cvt_pk_bf16(o[0], o[1]); w.y = cvt_pk_bf16(o[2], o[3]);
                    *(u32x2*)(HB + (size_t)t * D + 4 * ln + 256 * j) = w; } } }
    }
    SEAM(6);
    if (IN(7)) {
        pg8::Gemm g{HB, D, WUP, T, UPW, D}; pg8::StaticOrder S; S.init(T, UPW, G, bx); pg8::EpiUp E5{ACT, E, fcw, fcb};
        pg8::gemm_phase<pg8::EpiUp, true>(lds, g, S, E5);
    }
    SEAM(7);
    if (IN(8)) {
        OPAQUE_LANE(ln);
        constexpr int NITEM = 512 * 2 * (DFF / 4);
        for (int it = (gw * 64 + ln); it < NITEM; it += NGW * 64) { const int c4 = it % (DFF / 4), rb = it / (DFF / 4), rr = rb & 1, blk = rb >> 1; const int c0 = 4 * c4;
            const bool first = (blk & 31) == 0;
            const float* e0 = E + ((size_t)blk * 4 + rr) * UPW + c0;
            const float* em1 = (rr == 0) ? E + ((size_t)(blk - 1) * 4 + 3) * UPW + c0 : E + ((size_t)blk * 4 + 0) * UPW + c0;
            const float* em2 = (rr == 0) ? E + ((size_t)(blk - 1) * 4 + 2) * UPW + c0 : E + ((size_t)(blk - 1) * 4 + 3) * UPW + c0;
            const f32x4 z = {0.f, 0.f, 0.f, 0.f};
            const f32x4 g0 = *(const f32x4*)e0, v0 = *(const f32x4*)(e0 + DFF);
            const bool has1 = !(first && rr == 0), has2 = !first;
            const f32x4 g1 = has1 ? *(const f32x4*)em1 : z, v1 = has1 ? *(const f32x4*)(em1 + DFF) : z;
            const f32x4 g2 = has2 ? *(const f32x4*)em2 : z, v2 = has2 ? *(const f32x4*)(em2 + DFF) : z;
            const f32x4 wg0 = *(const f32x4*)(fcw + c0), wg1 = *(const f32x4*)(fcw + UPW + c0), wg2 = *(const f32x4*)(fcw + 2 * UPW + c0), bg = *(const f32x4*)(fcb + c0);
            const f32x4 wv0 = *(const f32x4*)(fcw + DFF + c0), wv1 = *(const f32x4*)(fcw + UPW + DFF + c0), wv2 = *(const f32x4*)(fcw + 2 * UPW + DFF + c0), bv = *(const f32x4*)(fcb + DFF + c0);
            const f32x4 cg = bg + wg0 * g2 + wg1 * g1 + wg2 * g0, cv = bv + wv0 * v2 + wv1 * v1 + wv2 * v0;
            u32x2 w; w.x = cvt_pk_bf16(silu_f(cg[0]) * cv[0], silu_f(cg[1]) * cv[1]); w.y = cvt_pk_bf16(silu_f(cg[2]) * cv[2], silu_f(cg[3]) * cv[3]);
            *(u32x2*)(ACT + (size_t)(64 * blk + rr) * DFF + c0) = w; }
    }
    SEAM(8);
    if (IN(9)) {
        pg8::Gemm g{ACT, DFF, WDN, T, D, DFF}; pg8::StaticOrder S; S.init(T, D, G, bx); pg8::EpiStore E6{FF, D};
        pg8::gemm_phase<pg8::EpiStore, true>(lds, g, S, E6);
    }
    SEAM(9);
    if (IN(10)) {
        OPAQUE_LANE(ln);
        for (int row0 = gw * 16; row0 < T; row0 += NGW * 16) { const int b = row0 / SEQ; const float* mb = MOD + b * 6144;
            f32x4 gt[4], g2v[4], b2v[4];
#pragma unroll
            for (int j = 0; j < 4; ++j) { const int col = 4 * ln + 256 * j; gt[j] = *(const f32x4*)(mb + 5120 + col); g2v[j] = *(const f32x4*)(ln2g + col); b2v[j] = *(const f32x4*)(ln2b + col); }
            for (int rr = 0; rr < 16; ++rr) { const int t = row0 + rr;
                f32x4 v[4]; float s = 0.f;
#pragma unroll
                for (int j = 0; j < 4; ++j) { const int col = 4 * ln + 256 * j; const u32x2 xw = *(const u32x2*)(X1 + (size_t)t * D + col); const f32x4 xv = {bf_lo(xw.x), bf_hi(xw.x), bf_lo(xw.y), bf_hi(xw.y)}; const u32x2 mw = *(const u32x2*)(FF + (size_t)t * D + col);
                    const f32x4 mx = {bf_lo(mw.x), bf_hi(mw.x), bf_lo(mw.y), bf_hi(mw.y)};
                    v[j] = xv * ALPHA + gt[j] * mx; s += (v[j][0] + v[j][1]) + (v[j][2] + v[j][3]); }
                const float mean = wave_sum(s) * (1.f / D); float q = 0.f;
#pragma unroll
                for (int j = 0; j < 4; ++j) { v[j] = v[j] - mean; q += (v[j][0] * v[j][0] + v[j][1] * v[j][1]) + (v[j][2] * v[j][2] + v[j][3] * v[j][3]); }
                const float rstd = rsqrtf(wave_sum(q) * (1.f / D) + 1e-5f);
#pragma unroll
                for (int j = 0; j < 4; ++j) { *(f32x4*)(out + (size_t)t * D + 4 * ln + 256 * j) = v[j] * rstd * g2v[j] + b2v[j]; } } }
    }
#undef IN
#undef SEAM
}

extern "C" void kernel_launch(void* const* d_in, const int* in_sizes, int n_in, void* d_out, int out_size, void* d_ws, size_t ws_size, hipStream_t stream) {
    static int grid = 0;
    if (grid == 0) {
        if (n_in != 22 || in_sizes[0] != T * D || out_size != T * D || ws_size < WS_END) { fprintf(stderr, "kernel_launch: unexpected shapes / workspace (n_in %d, ws %zu)\n", n_in, ws_size); grid = -1; return; }
        int dev = 0, cus = 0, per_cu = 0;
        if (hipGetDevice(&dev) != hipSuccess || hipDeviceGetAttribute(&cus, hipDeviceAttributeMultiprocessorCount, dev) != hipSuccess) { grid = -1; return; }
        if (hipFuncSetAttribute((const void*)mk_fwd, hipFuncAttributeMaxDynamicSharedMemorySize, LDS_BYTES) != hipSuccess) { fprintf(stderr, "kernel_launch: hipFuncSetAttribute failed\n"); grid = -1; return; }
        if (hipOccupancyMaxActiveBlocksPerMultiprocessor(&per_cu, (const void*)mk_fwd, 512, LDS_BYTES) != hipSuccess || per_cu < 1) { fprintf(stderr, "kernel_launch: occupancy query says %d blocks per CU\n", per_cu); (void)hipGetLastError(); grid = -1; return; }
        grid = cus;
    }
    if (grid < 0) return;
    hipMemsetAsync((char*)d_ws + WS_CTL, 0, CTL_ZERO_BYTES, stream);
    Args a{};
    for (int i = 0; i < 22; ++i) a.in[i] = (const float*)d_in[i];
    a.pos = (const int*)d_in[2]; a.out = (float*)d_out; a.ws = (unsigned char*)d_ws;
#if MK_N_LAUNCHES == 1
    a.ph_lo = 0; a.ph_hi = N_PHASES;
    hipLaunchKernelGGL(mk_fwd, dim3(grid), dim3(512), LDS_BYTES, stream, a);
#else
    for (int p = 0; p < N_PHASES; ++p) { a.ph_lo = p; a.ph_hi = p + 1; hipLaunchKernelGGL(mk_fwd, dim3(grid), dim3(512), LDS_BYTES, stream, a); }
#endif
}
```

```cpp
#include <hip/hip_runtime.h>
#include <cstdio>
#include <cstdint>

#define LAS __attribute__((address_space(3)))
#define GAS __attribute__((address_space(1)))
typedef unsigned short bf16_t;
typedef short bf16x8 __attribute__((ext_vector_type(8)));
typedef short s16x4 __attribute__((ext_vector_type(4)));
typedef float f32x4 __attribute__((ext_vector_type(4)));
typedef float f32x2 __attribute__((ext_vector_type(2)));
typedef float f32x16 __attribute__((ext_vector_type(16)));
typedef unsigned u32x4 __attribute__((ext_vector_type(4)));
typedef unsigned u32x2 __attribute__((ext_vector_type(2)));
typedef GAS unsigned gu32;

#ifndef MK_N_LAUNCHES
#define MK_N_LAUNCHES 1
#endif

constexpr int D = 1024, NB = 16, SEQ = 2048, T = NB * SEQ, NH = 8, DFF = 2816, UPW = 2 * DFF;
constexpr int PW = 1024;
constexpr int G1N = 2048;
constexpr int QW = 768, INW = 1952;
constexpr float ALPHA = 1.189207115002721f;
constexpr float QSCALE = 0.10206207261596575f * 1.4426950408889634f;
constexpr float LOG2E = 1.4426950408889634f;

constexpr size_t MiB = 1u << 20;
constexpr size_t WS_CTL = 0, CTL_ZERO_BYTES = 64 * 1024;
constexpr size_t WS_MOD = 1 * MiB;
constexpr size_t WS_ROPE = 2 * MiB;
constexpr size_t WS_SSQQ = 6 * MiB;
constexpr size_t WS_SSQKV = 6 * MiB + 512 * 1024;
constexpr size_t WS_WIN = 8 * MiB;
constexpr size_t WS_WQ = 12 * MiB;
constexpr size_t WS_WKV = 12 * MiB + 512 * 1024;
constexpr size_t WS_WOUT = 13 * MiB;
constexpr size_t WS_WUP = 15 * MiB;
constexpr size_t WS_WDN = 26 * MiB;
constexpr size_t WS_HB = 32 * MiB;
constexpr size_t WS_FF = 32 * MiB;
constexpr size_t WS_P = 96 * MiB;
constexpr size_t WS_U = 160 * MiB;
constexpr size_t WS_MIX = 96 * MiB;
constexpr size_t WS_Q = 224 * MiB;
constexpr size_t WS_KN = 272 * MiB;
constexpr size_t WS_KR = 304 * MiB;
constexpr size_t WS_V = 306 * MiB;
constexpr size_t WS_Y = 338 * MiB;
constexpr size_t WS_X1 = 338 * MiB;
constexpr size_t WS_ACT = 96 * MiB;
constexpr size_t WS_E = 272 * MiB;
constexpr size_t WS_END = 402 * MiB;
constexpr int CW_BAR = 1024;

constexpr int RING_BYTES = 131072, LDSCTL_OFF = RING_BYTES, MISC_OFF = LDSCTL_OFF + 320, LDS_BYTES = 147456;

__device__ __forceinline__ unsigned cvt_pk_bf16(float lo, float hi) { unsigned r; asm volatile("v_cvt_pk_bf16_f32 %0, %1, %2" : "=v"(r) : "v"(lo), "v"(hi)); return r; }
__device__ __forceinline__ float bf_lo(unsigned u) { return __uint_as_float(u << 16); }
__device__ __forceinline__ float bf_hi(unsigned u) { return __uint_as_float(u & 0xffff0000u); }
__device__ __forceinline__ float fexp2(float x) { return __builtin_amdgcn_exp2f(x); }
__device__ __forceinline__ float frcp(float x) { return __builtin_amdgcn_rcpf(x); }
__device__ __forceinline__ float silu_f(float v) { return v * frcp(1.f + fexp2(-LOG2E * v)); }
__device__ __forceinline__ float wave_sum(float v) {
#pragma unroll
    for (int o = 1; o < 64; o <<= 1) v += __shfl_xor(v, o);
    return v;
}

namespace pg8 {
constexpr int BM = 256, BK = 64, HALF = 128, HTB = HALF * BK * 2, STAGE_BYTES = 8 * HTB, NXCD = 8, WGM = 8;
__host__ __device__ __forceinline__ int lds_byte(int r, int c) { const int st = (r >> 4) * 2 + (c >> 5), rr = r & 15, cc = c & 31, ob = rr * 64 + cc * 2; return st * 1024 + (ob ^ (((ob >> 9) & 1) << 5)); }
__host__ __device__ __forceinline__ void stage_rc(int b, int& R, int& C) { const int st = b / 1024, sb = b % 1024, swz = sb ^ (((sb >> 9) & 1) << 5); R = (st >> 1) * 16 + swz / 64; C = (st & 1) * 32 + (swz % 64) / 2; }
__host__ __device__ __forceinline__ int perm32(int rho) { const int n = rho >> 4, i = rho & 15; return 8 * (i >> 2) + 4 * n + (i & 3); }

struct Unit { int pm, pn; };
struct Gemm { const bf16_t* A; int lda; const bf16_t* Bt; int M, N, K; };

struct StaticOrder {
    int nM, nN, nwg, G, c;
    __device__ __forceinline__ void init(int M, int N, int G_, int c_) { nM = M / BM; nN = N / BM; nwg = nM * nN; G = G_; c = c_; }
    __device__ __forceinline__ bool next(int i, Unit& u) const {
        const long L = (long)i * G + c; if (L >= nwg) return false;
        int wgid = (int)L; { const int q = nwg / NXCD, r = nwg % NXCD, xcd = wgid % NXCD, off = wgid / NXCD; wgid = (xcd < r ? xcd * (q + 1) : r * (q + 1) + (xcd - r) * q) + off; }
        const int nig = WGM * nN, gid = wgid / nig, fm = gid * WGM, gsz = (nM - fm) < WGM ? (nM - fm) : WGM;
        u.pm = fm + ((wgid % nig) % gsz); u.pn = (wgid % nig) / gsz; return true;
    }
};

template <class Epi, bool ALIGN_EPI>
__device__ __forceinline__ void gemm_phase(LAS unsigned char* lds, const Gemm g, const StaticOrder& S, const Epi& E) {
    int tid = threadIdx.x; asm volatile("" : "+v"(tid));
    const int wid = __builtin_amdgcn_readfirstlane(tid >> 6), lane = tid & 63, wr = wid >> 2, wc = wid & 3, fr = lane & 15, fq = lane >> 4;
    const int K = g.K, nt = K / BK;
    unsigned voffA[2], voffB[2];
#pragma unroll
    for (int i = 0; i < 2; ++i) { int R, C; stage_rc(tid * 16 + i * 8192, R, C);
        voffA[i] = (unsigned)(R * g.lda + C) * 2u; voffB[i] = (unsigned)(R * K + C) * 2u; }
    const size_t kstep = (size_t)(BK * 2);
    const size_t hstepA = (size_t)HALF * g.lda * 2, hstepB = (size_t)HALF * K * 2;
    const size_t tstepA = 2 * hstepA, tstepB = 2 * hstepB;
    const unsigned ldsw = (unsigned)wid * 1024u;
    const int aoff = lds_byte(wr * 64 + fr, fq * 8), boff = lds_byte(wc * 32 + fr, fq * 8);
#define PG8_SA(b, h) (((b) * 2 + (h)) * HTB)
#define PG8_SB(b, h) ((4 + (b) * 2 + (h)) * HTB)
#define PG8_STAGE(bufoff, gbase, voff) do { _Pragma("unroll") for (int _i = 0; _i < 2; ++_i) \
        __builtin_amdgcn_global_load_lds((const unsigned*)((const char*)(gbase) + (voff)[_i]), (LAS unsigned*)(lds + (bufoff) + ldsw + _i * 8192), 16, 0, 0); } while (0)
#define PG8_LDA(dst, b, h) do { _Pragma("unroll") for (int m = 0; m < 4; ++m) _Pragma("unroll") for (int k = 0; k < 2; ++k) dst[m][k] = *(const LAS bf16x8*)(lds + PG8_SA(b, h) + aoff + m * 2048 + k * 1024); } while (0)
#define PG8_LDB(dst, b, h) do { _Pragma("unroll") for (int n = 0; n < 2; ++n) _Pragma("unroll") for (int k = 0; k < 2; ++k) dst[n][k] = *(const LAS bf16x8*)(lds + PG8_SB(b, h) + boff + n * 2048 + k * 1024); } while (0)
#define PG8_MMA(ai, bj, At, Bt) do { __builtin_amdgcn_s_setprio(1); _Pragma("unroll") for (int m = 0; m < 4; ++m) _Pragma("unroll") for (int n = 0; n < 2; ++n) _Pragma("unroll") for (int k = 0; k < 2; ++k) \
        acc[ai][bj][m][n] = __builtin_amdgcn_mfma_f32_16x16x32_bf16(Bt[n][k], At[m][k], acc[ai][bj][m][n], 0, 0, 0); __builtin_amdgcn_s_setprio(0); } while (0)
#define PG8_WAIT_V(n) asm volatile("s_waitcnt vmcnt(" #n ")" ::: "memory")
#define PG8_WAIT_L(n) asm volatile("s_waitcnt lgkmcnt(" #n ")" ::: "memory")
#define PG8_BAR __builtin_amdgcn_s_barrier()
#define PG8_SCHED __builtin_amdgcn_sched_barrier(0)
    Unit cur, nxt; int ui = 0;
    if (!S.next(0, cur)) return;
    f32x4 acc[2][2][4][2];
#pragma unroll
    for (int a = 0; a < 2; ++a)
#pragma unroll
        for (int b = 0; b < 2; ++b)
#pragma unroll
            for (int m = 0; m < 4; ++m)
#pragma unroll
                for (int n = 0; n < 2; ++n) acc[a][b][m][n] = (f32x4){0.f, 0.f, 0.f, 0.f};
    bf16x8 At[4][2], B0[2][2], B1[2][2];
    const char* cA = (const char*)g.A + (size_t)cur.pm * tstepA; const char* cB = (const char*)g.Bt + (size_t)cur.pn * tstepB;
    if constexpr (Epi::HAS_PREFETCH) E.prefetch(cur, 0, lds, wid, lane);
    PG8_STAGE(PG8_SB(0, 0), cB, voffB); PG8_STAGE(PG8_SB(0, 1), cB + hstepB, voffB); PG8_STAGE(PG8_SA(0, 0), cA, voffA); PG8_STAGE(PG8_SA(0, 1), cA + hstepA, voffA);
    if (wr == 1) PG8_BAR;
    PG8_WAIT_V(2); PG8_BAR;
    PG8_STAGE(PG8_SB(1, 0), cB + kstep, voffB); PG8_STAGE(PG8_SA(1, 0), cA + kstep, voffA); PG8_STAGE(PG8_SB(1, 1), cB + hstepB + kstep, voffB);
    PG8_WAIT_V(6); PG8_BAR;
    for (;;) {
        const bool has_next = S.next(ui + 1, nxt);
        const char* nA = has_next ? (const char*)g.A + (size_t)nxt.pm * tstepA : cA; const char* nB = has_next ? (const char*)g.Bt + (size_t)nxt.pn * tstepB : cB;
#pragma nounroll
        for (int t = 0; t < nt; t += 2) {
            const bool last = (t == nt - 2);
            const char* a1 = cA + (size_t)(t + 1) * kstep;
            const char* a2 = last ? nA : cA + (size_t)(t + 2) * kstep; const char* b2 = last ? nB : cB + (size_t)(t + 2) * kstep;
            const char* a3 = a2 + kstep; const char* b3 = b2 + kstep;
            const bool rlx = (Epi::NST > 0) && (t == 0) && (ui > 0);
            PG8_LDB(B0, 0, 0); PG8_LDB(B1, 0, 1); PG8_SCHED; PG8_LDA(At, 0, 0); PG8_STAGE(PG8_SA(1, 1), a1 + hstepA, voffA);
            if (rlx) { if constexpr (Epi::NST >= 16) PG8_WAIT_V(24); else PG8_WAIT_V(16); } else PG8_WAIT_V(8);
            PG8_WAIT_L(0); PG8_BAR; PG8_MMA(0, 0, At, B0); PG8_MMA(0, 1, At, B1); PG8_BAR; PG8_SCHED;
            PG8_LDA(At, 0, 1); PG8_STAGE(PG8_SB(0, 0), b2, voffB); PG8_STAGE(PG8_SB(0, 1), b2 + hstepB, voffB); PG8_STAGE(PG8_SA(0, 0), a2, voffA);
            if (rlx) { if constexpr (Epi::NST >= 16) PG8_WAIT_V(24); else PG8_WAIT_V(16); } else PG8_WAIT_V(8);
            PG8_WAIT_L(0); PG8_BAR; PG8_MMA(1, 0, At, B0); PG8_MMA(1, 1, At, B1); PG8_BAR; PG8_SCHED;
            PG8_LDB(B0, 1, 0); PG8_LDB(B1, 1, 1); PG8_SCHED; PG8_LDA(At, 1, 0); PG8_STAGE(PG8_SA(0, 1), a2 + hstepA, voffA);
            PG8_WAIT_V(8); PG8_WAIT_L(0); PG8_BAR; PG8_MMA(0, 0, At, B0); PG8_MMA(0, 1, At, B1); PG8_BAR; PG8_SCHED;
            PG8_LDA(At, 1, 1); PG8_STAGE(PG8_SB(1, 0), b3, voffB); PG8_STAGE(PG8_SB(1, 1), b3 + hstepB, voffB); PG8_STAGE(PG8_SA(1, 0), a3, voffA);
            PG8_WAIT_V(8); PG8_WAIT_L(0); PG8_BAR; PG8_MMA(1, 0, At, B0); PG8_MMA(1, 1, At, B1); PG8_BAR; PG8_SCHED;
        }
        if constexpr (ALIGN_EPI) { if (wr == 0) PG8_BAR; }
        { int t_e = threadIdx.x; asm volatile("" : "+v"(t_e)); const int fr_e = t_e & 15, fq_e = (t_e >> 4) & 3;
          if constexpr (Epi::HAS_PREFETCH) { if (has_next) E.prefetch(nxt, (ui + 1) & 1, lds, wid, t_e & 63); E.run(acc, cur, wr, wc, fr_e, fq_e, lds, ui & 1); }
          else E(acc, cur, wr, wc, fr_e, fq_e); }
        if (!has_next) break;
#pragma unroll
        for (int a = 0; a < 2; ++a)
#pragma unroll
            for (int b = 0; b < 2; ++b)
#pragma unroll
                for (int m = 0; m < 4; ++m)
#pragma unroll
                    for (int n = 0; n < 2; ++n) acc[a][b][m][n] = (f32x4){0.f, 0.f, 0.f, 0.f};
        cur = nxt; cA = nA; cB = nB; ++ui;
        if constexpr (ALIGN_EPI) { if (wr == 1) PG8_BAR; }
    }
    PG8_WAIT_V(0);
    if constexpr (!ALIGN_EPI) { if (wr == 0) PG8_BAR; }
    PG8_BAR;
#undef PG8_SA
#undef PG8_SB
#undef PG8_STAGE
#undef PG8_LDA
#undef PG8_LDB
#undef PG8_MMA
#undef PG8_WAIT_V
#undef PG8_WAIT_L
#undef PG8_BAR
#undef PG8_SCHED
}

struct MUnit { const char* A; const char* B; int nt; unsigned kb2; int type; Unit u; };
template <class Sched, class Disp>
__device__ __forceinline__ void gemm_multi(LAS unsigned char* lds, const Sched& S, const Disp& E) {
    int tid = threadIdx.x; asm volatile("" : "+v"(tid));
    const int wid = __builtin_amdgcn_readfirstlane(tid >> 6), lane = tid & 63, wr = wid >> 2, wc = wid & 3, fr = lane & 15, fq = lane >> 4;
    unsigned voffA[2], rB[2], cB2[2];
#pragma unroll
    for (int i = 0; i < 2; ++i) { int R, C; stage_rc(tid * 16 + i * 8192, R, C); voffA[i] = (unsigned)(R * 1024 + C) * 2u; rB[i] = (unsigned)R; cB2[i] = (unsigned)C * 2u; }
    const size_t kstep = (size_t)(BK * 2);
    const size_t hstepA = (size_t)HALF * 1024 * 2;
    const unsigned ldsw = (unsigned)wid * 1024u;
    const int aoff = lds_byte(wr * 64 + fr, fq * 8), boff = lds_byte(wc * 32 + fr, fq * 8);
#define PG8_SA(b, h) (((b) * 2 + (h)) * HTB)
#define PG8_SB(b, h) ((4 + (b) * 2 + (h)) * HTB)
#define PG8_STAGE(bufoff, gbase, voff) do { _Pragma("unroll") for (int _i = 0; _i < 2; ++_i) \
        __builtin_amdgcn_global_load_lds((const unsigned*)((const char*)(gbase) + (voff)[_i]), (LAS unsigned*)(lds + (bufoff) + ldsw + _i * 8192), 16, 0, 0); } while (0)
#define PG8_LDA(dst, b, h) do { _Pragma("unroll") for (int m = 0; m < 4; ++m) _Pragma("unroll") for (int k = 0; k < 2; ++k) dst[m][k] = *(const LAS bf16x8*)(lds + PG8_SA(b, h) + aoff + m * 2048 + k * 1024); } while (0)
#define PG8_LDB(dst, b, h) do { _Pragma("unroll") for (int n = 0; n < 2; ++n) _Pragma("unroll") for (int k = 0; k < 2; ++k) dst[n][k] = *(const LAS bf16x8*)(lds + PG8_SB(b, h) + boff + n * 2048 + k * 1024); } while (0)
#define PG8_MMA(ai, bj, At, Bt) do { __builtin_amdgcn_s_setprio(1); _Pragma("unroll") for (int m = 0; m < 4; ++m) _Pragma("unroll") for (int n = 0; n < 2; ++n) _Pragma("unroll") for (int k = 0; k < 2; ++k) \
        acc[ai][bj][m][n] = __builtin_amdgcn_mfma_f32_16x16x32_bf16(Bt[n][k], At[m][k], acc[ai][bj][m][n], 0, 0, 0); __builtin_amdgcn_s_setprio(0); } while (0)
#define PG8_WAIT_V(n) asm volatile("s_waitcnt vmcnt(" #n ")" ::: "memory")
#define PG8_WAIT_L(n) asm volatile("s_waitcnt lgkmcnt(" #n ")" ::: "memory")
#define PG8_BAR __builtin_amdgcn_s_barrier()
#define PG8_SCHED __builtin_amdgcn_sched_barrier(0)
    MUnit cur, nxt; int ui = 0; int relax = 0;
    if (!S.next(0, cur)) return;
    f32x4 acc[2][2][4][2];
#pragma unroll
    for (int a = 0; a < 2; ++a)
#pragma unroll
        for (int b = 0; b < 2; ++b)
#pragma unroll
            for (int m = 0; m < 4; ++m)
#pragma unroll
                for (int n = 0; n < 2; ++n) acc[a][b][m][n] = (f32x4){0.f, 0.f, 0.f, 0.f};
    bf16x8 At[4][2], B0[2][2], B1[2][2];
    const char* cA = cur.A; const char* cB = cur.B;
    E.prefetch(cur, 0, lds, wid, lane);
    unsigned voffB[2]; voffB[0] = rB[0] * cur.kb2 + cB2[0]; voffB[1] = rB[1] * cur.kb2 + cB2[1];
    size_t hstepB = (size_t)HALF * cur.kb2;
    PG8_STAGE(PG8_SB(0, 0), cB, voffB); PG8_STAGE(PG8_SB(0, 1), cB + hstepB, voffB); PG8_STAGE(PG8_SA(0, 0), cA, voffA); PG8_STAGE(PG8_SA(0, 1), cA + hstepA, voffA);
    if (wr == 1) PG8_BAR;
    PG8_WAIT_V(2); PG8_BAR;
    PG8_STAGE(PG8_SB(1, 0), cB + kstep, voffB); PG8_STAGE(PG8_SA(1, 0), cA + kstep, voffA); PG8_STAGE(PG8_SB(1, 1), cB + hstepB + kstep, voffB);
    PG8_WAIT_V(6); PG8_BAR;
    for (;;) {
        const bool has_next = S.next(ui + 1, nxt);
        if (!has_next) nxt = cur;
        const char* nA = nxt.A; const char* nB = nxt.B;
        unsigned nvoffB[2]; nvoffB[0] = rB[0] * nxt.kb2 + cB2[0]; nvoffB[1] = rB[1] * nxt.kb2 + cB2[1];
        const size_t nhstepB = (size_t)HALF * nxt.kb2;
        const int nt = cur.nt;
#pragma nounroll
        for (int t = 0; t < nt; t += 2) {
            const bool last = (t == nt - 2);
            const char* a1 = cA + (size_t)(t + 1) * kstep;
            const char* a2 = last ? nA : cA + (size_t)(t + 2) * kstep; const char* b2 = last ? nB : cB + (size_t)(t + 2) * kstep;
            const char* a3 = a2 + kstep; const char* b3 = b2 + kstep;
            unsigned vB2[2]; vB2[0] = last ? nvoffB[0] : voffB[0]; vB2[1] = last ? nvoffB[1] : voffB[1];
            const size_t hB2 = last ? nhstepB : hstepB;
            const int rlx = (t == 0) ? relax : 0;
            PG8_LDB(B0, 0, 0); PG8_LDB(B1, 0, 1); PG8_SCHED; PG8_LDA(At, 0, 0); PG8_STAGE(PG8_SA(1, 1), a1 + hstepA, voffA);
            if (rlx >= 16) PG8_WAIT_V(24); else if (rlx >= 8) PG8_WAIT_V(16); else PG8_WAIT_V(8);
            PG8_WAIT_L(0); PG8_BAR; PG8_MMA(0, 0, At, B0); PG8_MMA(0, 1, At, B1); PG8_BAR; PG8_SCHED;
            PG8_LDA(At, 0, 1); PG8_STAGE(PG8_SB(0, 0), b2, vB2); PG8_STAGE(PG8_SB(0, 1), b2 + hB2, vB2); PG8_STAGE(PG8_SA(0, 0), a2, voffA);
            if (rlx >= 16) PG8_WAIT_V(24); else if (rlx >= 8) PG8_WAIT_V(16); else PG8_WAIT_V(8);
            PG8_WAIT_L(0); PG8_BAR; PG8_MMA(1, 0, At, B0); PG8_MMA(1, 1, At, B1); PG8_BAR; PG8_SCHED;
            PG8_LDB(B0, 1, 0); PG8_LDB(B1, 1, 1); PG8_SCHED; PG8_LDA(At, 1, 0); PG8_STAGE(PG8_SA(0, 1), a2 + hstepA, voffA);
            PG8_WAIT_V(8); PG8_WAIT_L(0); PG8_BAR; PG8_MMA(0, 0, At, B0); PG8_MMA(0, 1, At, B1); PG8_BAR; PG8_SCHED;
            PG8_LDA(At, 1, 1); PG8_STAGE(PG8_SB(1, 0), b3, vB2); PG8_STAGE(PG8_SB(1, 1), b3 + hB2, vB2); PG8_STAGE(PG8_SA(1, 0), a3, voffA);
            PG8_WAIT_V(8); PG8_WAIT_L(0); PG8_BAR; PG8_MMA(1, 0, At, B0); PG8_MMA(1, 1, At, B1); PG8_BAR; PG8_SCHED;
        }
        if (wr == 0) PG8_BAR;
        { int t_e = threadIdx.x; asm volatile("" : "+v"(t_e)); if (has_next) E.prefetch(nxt, (ui + 1) & 1, lds, wid, t_e & 63); E(acc, cur, wr, wc, t_e & 15, (t_e >> 4) & 3, lds, ui & 1); }
        if (!has_next) break;
#pragma unroll
        for (int a = 0; a < 2; ++a)
#pragma unroll
            for (int b = 0; b < 2; ++b)
#pragma unroll
                for (int m = 0; m < 4; ++m)
#pragma unroll
                    for (int n = 0; n < 2; ++n) acc[a][b][m][n] = (f32x4){0.f, 0.f, 0.f, 0.f};
        relax = (cur.type == 0 && cur.u.pn >= 4) ? 8 : 16;
        cur = nxt; cA = nA; cB = nB; voffB[0] = nvoffB[0]; voffB[1] = nvoffB[1]; hstepB = nhstepB; ++ui;
        if (wr == 1) PG8_BAR;
    }
    PG8_WAIT_V(0);
    PG8_BAR;
#undef PG8_SA
#undef PG8_SB
#undef PG8_STAGE
#undef PG8_LDA
#undef PG8_LDB
#undef PG8_MMA
#undef PG8_WAIT_V
#undef PG8_WAIT_L
#undef PG8_BAR
#undef PG8_SCHED
}

typedef f32x4 Acc[2][2][4][2];

struct EpiStore { static constexpr bool HAS_PREFETCH = false; static constexpr int NST = 16;
    bf16_t* O; int ldc; bool nt = false;
    __device__ __forceinline__ void operator()(const Acc& acc, const Unit& u, int wr, int wc, int fr, int fq) const {
        const int row0 = u.pm * BM + wr * 64 + fr, col0 = u.pn * BM + wc * 32 + 8 * fq;
#pragma unroll
        for (int ai = 0; ai < 2; ++ai)
#pragma unroll
            for (int m = 0; m < 4; ++m) { bf16_t* rowp = O + (size_t)(row0 + ai * HALF + m * 16) * ldc + col0;
#pragma unroll
                for (int bj = 0; bj < 2; ++bj) { const f32x4 v0 = acc[ai][bj][m][0], v1 = acc[ai][bj][m][1];
                    u32x4 w; w.x = cvt_pk_bf16(v0[0], v0[1]); w.y = cvt_pk_bf16(v0[2], v0[3]); w.z = cvt_pk_bf16(v1[0], v1[1]); w.w = cvt_pk_bf16(v1[2], v1[3]);
                    if (nt) __builtin_nontemporal_store(w, (u32x4*)(rowp + bj * HALF)); else *(u32x4*)(rowp + bj * HALF) = w; } }
    }
};

struct EpiP { static constexpr bool HAS_PREFETCH = false, AFTER_DRAIN = false; static constexpr int NST = 8;
    bf16_t* O; bf16_t* U; float* ssq_q; float* ssq_kv;
    __device__ __forceinline__ void operator()(const Acc& acc, const Unit& u, int wr, int wc, int fr, int fq) const {
        const int row0 = u.pm * BM + wr * 64 + fr;
        if (u.pn >= 4) {
            bf16_t* ucol = U + 128 * (u.pn - 4) + 32 * wc + 8 * fq;
#pragma unroll
            for (int ai = 0; ai < 2; ++ai)
#pragma unroll
                for (int m = 0; m < 4; ++m) { const f32x4 v0 = acc[ai][0][m][0] * acc[ai][1][m][0], v1 = acc[ai][0][m][1] * acc[ai][1][m][1];
                    u32x4 w; w.x = cvt_pk_bf16(v0[0], v0[1]); w.y = cvt_pk_bf16(v0[2], v0[3]); w.z = cvt_pk_bf16(v1[0], v1[1]); w.w = cvt_pk_bf16(v1[2], v1[3]);
                    __builtin_nontemporal_store(w, (u32x4*)(ucol + (size_t)(row0 + ai * HALF + m * 16) * 512)); }
            return;
        }
        EpiStore st{O, PW, true}; st(acc, u, wr, wc, fr, fq);
        if (u.pn <= 1) {
            float* dst = (u.pn == 0) ? ssq_q : ssq_kv;
#pragma unroll
            for (int ai = 0; ai < 2; ++ai)
#pragma unroll
                for (int m = 0; m < 4; ++m) { float s = 0.f;
#pragma unroll
                    for (int n = 0; n < 2; ++n) { const f32x4 a = acc[ai][0][m][n]; s += (a[0] * a[0] + a[1] * a[1]) + (a[2] * a[2] + a[3] * a[3]); }
                    if (u.pn == 0) {
#pragma unroll
                        for (int n = 0; n < 2; ++n) { const f32x4 a = acc[ai][1][m][n]; s += (a[0] * a[0] + a[1] * a[1]) + (a[2] * a[2] + a[3] * a[3]); } }
                    s += __shfl_xor(s, 16); s += __shfl_xor(s, 32);
                    if (fq == 0) dst[(size_t)(row0 + ai * HALF + m * 16) * 4 + wc] = s; }
        }
    }
};

constexpr int SSQ_LDS = RING_BYTES + 1024;
struct EpiKV { static constexpr bool HAS_PREFETCH = false, AFTER_DRAIN = false; static constexpr int NST = 16;
    bf16_t* KN; bf16_t* V;
    __device__ __forceinline__ void operator()(const Acc& acc, const Unit& u, int wr, int wc, int fr, int fq, LAS unsigned char* lds, int buf) const {
        const int b = u.pm >> 3;
        const LAS f32x4* sq = (const LAS f32x4*)(lds + SSQ_LDS + buf * 4096) + wr * 64 + fr;
        float f[2][4];
#pragma unroll
        for (int ai = 0; ai < 2; ++ai)
#pragma unroll
            for (int m = 0; m < 4; ++m) { const f32x4 sp = sq[ai * HALF + m * 16]; f[ai][m] = rsqrtf(((sp[0] + sp[1]) + (sp[2] + sp[3])) * (1.f / 128.f) + 1e-6f); }
#pragma unroll
        for (int bj = 0; bj < 2; ++bj) { const int g = 8 * u.pn + 4 * bj + wc, head = g >> 2, part = g & 3;
            char* base = (part < 2) ? (char*)KN + (4 * part + fq) * 1024 + fr * 16 : (char*)V + (part - 2) * 4096 + fr * 64 + fq * 16;
            const int mstep = (part < 2) ? 256 : 1024;
            base += (size_t)(b * 8 + head) * 32 * 8192;
#pragma unroll
            for (int ai = 0; ai < 2; ++ai) { const int tile = (4 * u.pm + 2 * ai + wr) & 31;
#pragma unroll
                for (int m = 0; m < 4; ++m) {
                    const f32x4 v0 = acc[ai][bj][m][0] * f[ai][m], v1 = acc[ai][bj][m][1] * f[ai][m];
                    u32x4 w; w.x = cvt_pk_bf16(v0[0], v0[1]); w.y = cvt_pk_bf16(v0[2], v0[3]); w.z = cvt_pk_bf16(v1[0], v1[1]); w.w = cvt_pk_bf16(v1[2], v1[3]);
                    __builtin_nontemporal_store(w, (u32x4*)(base + (size_t)tile * 8192 + m * mstep)); } } }
    }
};

struct MixedOrder {
    const char* HB; const char* P; const char* WIN; const char* WQ; const char* WKV; int G, c;
    __device__ __forceinline__ void set_long(int k, MUnit& m) const { const int li = k * G + c, w = (li % NXCD) * 96 + li / NXCD, pm = w / 6, pn = 2 + w % 6;
        m.A = HB + (size_t)pm * (256 * 1024 * 2); m.B = WIN + (size_t)pn * (256 * 1024 * 2); m.nt = 16; m.kb2 = 2048u; m.type = 0; m.u.pm = pm; m.u.pn = pn; }
    __device__ __forceinline__ void set_short(int k, MUnit& m) const { const int si = k * G + c, s = (si % NXCD) * 112 + si / NXCD;
        if (s < 384) { const int pm = s / 3, pn = s % 3; m.A = P + (size_t)pm * (256 * 1024 * 2); m.B = WQ + (size_t)pn * (256 * 256 * 2); m.nt = 4; m.kb2 = 512u; m.type = 1; m.u.pm = pm; m.u.pn = pn; }
        else { const int s2 = s - 384, pm = s2 >> 2, pn = s2 & 3; m.A = P + 512 + (size_t)pm * (256 * 1024 * 2); m.B = WKV + (size_t)pn * (256 * 256 * 2); m.nt = 4; m.kb2 = 512u; m.type = 2; m.u.pm = pm; m.u.pn = pn; } }
    __device__ __forceinline__ bool next(int i, MUnit& m) const {
        const int ns = (c < 128) ? 4 : 3; if (i >= 3 + ns) return false;
        const int k = i >> 1; const bool even = (c & 1) == 0;
        if (i == 6) { set_short(3, m); return true; }
        if (even == ((i & 1) == 0)) set_long(k, m); else set_short(k, m);
        return true;
    }
};
struct EpiMix { EpiP p; EpiStore q; EpiKV kv; const float* ssqkv;
    __device__ __forceinline__ void prefetch(const MUnit& m, int buf, LAS unsigned char* lds, int wid, int lane) const {
        if (m.type == 2 && wid < 4) __builtin_amdgcn_global_load_lds((const unsigned*)(ssqkv + (size_t)m.u.pm * 1024 + wid * 256 + lane * 4), (LAS unsigned*)(lds + SSQ_LDS + buf * 4096 + wid * 1024), 16, 0, 0);
    }
    __device__ __forceinline__ void operator()(const Acc& acc, const MUnit& m, int wr, int wc, int fr, int fq, LAS unsigned char* lds, int buf) const {
        if (m.type == 0) p(acc, m.u, wr, wc, fr, fq); else if (m.type == 1) q(acc, m.u, wr, wc, fr, fq); else kv(acc, m.u, wr, wc, fr, fq, lds, buf);
    }
};

template <int CTRL> __device__ __forceinline__ float dppf(float v) { return __builtin_bit_cast(float, __builtin_amdgcn_update_dpp(0, __builtin_bit_cast(int, v), CTRL, 0xf, 0xf, true)); }
template <int CTRL> __device__ __forceinline__ f32x4 dpp4(f32x4 v) { f32x4 r; r[0] = dppf<CTRL>(v[0]); r[1] = dppf<CTRL>(v[1]); r[2] = dppf<CTRL>(v[2]); r[3] = dppf<CTRL>(v[3]); return r; }

constexpr int CW_LDS = RING_BYTES + 1024;
struct EpiUp { static constexpr bool HAS_PREFETCH = true; static constexpr int NST = 0;
    bf16_t* ACT; float* E; const float* cw; const float* cb;
    __device__ __forceinline__ void prefetch(const Unit& u, int buf, LAS unsigned char* lds, int wid, int lane) const {
        if (wid < 4) { const float* base = (wid < 3) ? cw + (size_t)wid * UPW : cb;
            const float* src = base + 128 * u.pn + ((lane & 32) ? DFF : 0) + 4 * (lane & 31);
            __builtin_amdgcn_global_load_lds((const unsigned*)src, (LAS unsigned*)(lds + CW_LDS + buf * 4096 + wid * 1024), 16, 0, 0); }
    }
    __device__ __forceinline__ void run(const Acc& acc, const Unit& u, int wr, int wc, int fr, int fq, LAS unsigned char* lds, int buf) const {
        const int cl = 32 * wc + 8 * fq;
        const int cbase = 128 * u.pn + cl;
        const LAS float* wl = (const LAS float*)(lds + CW_LDS + buf * 4096) + cl;
        u32x2 res0[2][4];
#pragma unroll
        for (int n = 0; n < 2; ++n) { const int c0 = cbase + 4 * n;
            const f32x4 wg0 = *(const LAS f32x4*)(wl + 4 * n), wg1 = *(const LAS f32x4*)(wl + 256 + 4 * n), wg2 = *(const LAS f32x4*)(wl + 512 + 4 * n), bg = *(const LAS f32x4*)(wl + 768 + 4 * n);
            const f32x4 wv0 = *(const LAS f32x4*)(wl + 128 + 4 * n), wv1 = *(const LAS f32x4*)(wl + 384 + 4 * n), wv2 = *(const LAS f32x4*)(wl + 640 + 4 * n), bv = *(const LAS f32x4*)(wl + 896 + 4 * n);
#pragma unroll
            for (int ai = 0; ai < 2; ++ai) { f32x4 pg1 = {0.f, 0.f, 0.f, 0.f}, pg2 = pg1, pv1 = pg1, pv2 = pg1;
                const int blk = 4 * u.pm + 2 * ai + wr;
#pragma unroll
                for (int m = 0; m < 4; ++m) { const f32x4 gcur = acc[ai][0][m][n], vcur = acc[ai][1][m][n];
                    const f32x4 rg1 = dpp4<0x121>(gcur), rg2 = dpp4<0x122>(gcur), rv1 = dpp4<0x121>(vcur), rv2 = dpp4<0x122>(vcur);
                    const f32x4 g1 = (fr >= 1) ? rg1 : pg1, g2 = (fr >= 2) ? rg2 : pg2, v1 = (fr >= 1) ? rv1 : pv1, v2 = (fr >= 2) ? rv2 : pv2;
                    const f32x4 cg = bg + wg0 * g2 + wg1 * g1 + wg2 * gcur, cv = bv + wv0 * v2 + wv1 * v1 + wv2 * vcur;
                    f32x4 a; a[0] = silu_f(cg[0]) * cv[0]; a[1] = silu_f(cg[1]) * cv[1]; a[2] = silu_f(cg[2]) * cv[2]; a[3] = silu_f(cg[3]) * cv[3];
                    u32x2 w; w.x = cvt_pk_bf16(a[0], a[1]); w.y = cvt_pk_bf16(a[2], a[3]);
                    const int t = u.pm * BM + ai * HALF + wr * 64 + m * 16 + fr;
                    if (n == 0) res0[ai][m] = w;
                    else if (!(m == 0 && fr < 2)) { u32x4 o; o.x = res0[ai][m].x; o.y = res0[ai][m].y; o.z = w.x; o.w = w.y; *(u32x4*)(ACT + (size_t)t * DFF + cbase) = o; }
                    if (m == 0 && fr < 2) { float* e = E + ((size_t)blk * 4 + fr) * UPW + c0; *(f32x4*)e = gcur; *(f32x4*)(e + DFF) = vcur; }
                    if (m == 3 && fr >= 14) { float* e = E + ((size_t)blk * 4 + 2 + (fr - 14)) * UPW + c0; *(f32x4*)e = gcur; *(f32x4*)(e + DFF) = vcur; }
                    pg1 = rg1; pg2 = rg2; pv1 = rv1; pv2 = rv2; } } }
    }
};
}

namespace att {
constexpr int NSLOT = 3, K_OFF = 0, KSLOT = 12288, V_OFF = NSLOT * KSLOT, VSLOT = 8192, WS_OFF = V_OFF + NSLOT * VSLOT, OST_OFF = WS_OFF + 8 * 256, LDS_END = OST_OFF + 8 * 8192;
static_assert(LDS_END <= RING_BYTES, "attention LDS");
__device__ __forceinline__ int crow(int r, int hi) { return (r & 3) + 8 * (r >> 2) + 4 * hi; }
typedef short v4i16_t __attribute__((ext_vector_type(4)));
__device__ __forceinline__ s16x4 vtr(const LAS unsigned char* p) { return __builtin_bit_cast(s16x4, __builtin_amdgcn_ds_read_tr16_b64_v4i16((LAS v4i16_t*)p)); }
__device__ __forceinline__ void glds(const char* src, LAS unsigned char* dst) { unsigned keep; const unsigned d = (unsigned)__builtin_amdgcn_readfirstlane((int)(unsigned)(uintptr_t)dst);
    asm volatile("s_mov_b32 %0, m0\n\ts_mov_b32 m0, %2\n\ts_nop 0\n\tglobal_load_lds_dwordx4 %1, off\n\ts_mov_b32 m0, %0" : "=&s"(keep) : "v"(src), "s"(d) : "memory"); }
__device__ __forceinline__ float max3f(float a, float b, float c) { float r; asm("v_max3_f32 %0, %1, %2, %3" : "=v"(r) : "v"(a), "v"(b), "v"(c)); return r; }
__device__ __forceinline__ float max2f(float a, float b) { float r; asm("v_max_f32_e32 %0, %1, %2" : "=v"(r) : "v"(a), "v"(b)); return r; }
__device__ __forceinline__ float fadd_s(float a, float b) { float r = a + b; asm volatile("" : "+v"(r)); return r; }
typedef float f32x2_t __attribute__((ext_vector_type(2))); typedef __bf16 bf16x2_t __attribute__((ext_vector_type(2)));
__device__ __forceinline__ unsigned cvtpk_m(float lo, float hi) { f32x2_t v = {lo, hi}; bf16x2_t b2 = __builtin_convertvector(v, bf16x2_t); return __builtin_bit_cast(unsigned, b2); }
constexpr float THRL = 4.0f;

struct AUnit { int b, h, qb; };
__device__ __forceinline__ bool unit_of(int k, int vcu, int G, AUnit& u) {
    const int it = vcu + (k >> 2) * G, r = k & 3; if (it >= 256) return false;
    const int grp = it >> 3, i8 = it & 7, bh = grp * 4 + r; u.b = bh >> 3; u.h = bh & 7;
    u.qb = (r == 0) ? 7 - i8 : (r == 1) ? i8 : (r == 2) ? 7 - (i8 ^ 1) : (i8 ^ 1); return true;
}
__device__ __forceinline__ void attn_phase(int vcu, int G, const float* ssqq, const float* rope, const bf16_t* Q, const bf16_t* KN, const bf16_t* KR, const bf16_t* V, bf16_t* Y, const float* ong, LAS unsigned char* lds) {
    int tid = threadIdx.x; asm volatile("" : "+v"(tid));
    const int lane = tid & 63, r32 = lane & 31, hi = lane >> 5; const int wid = __builtin_amdgcn_readfirstlane(tid >> 6);
    const int lo16 = wid * 1024 + lane * 16;
    LAS float* wsf = (LAS float*)(lds + WS_OFF + wid * 256);
    const int kl = hi * 1024 + r32 * 16, vl = ((lane >> 4) & 1) * 32 + (lane & 3) * 8 + (4 * hi + ((lane & 15) >> 2)) * 64;
#define ATT_ISSUE(U, tile, slot) do { const size_t bh_ = (size_t)((U).b * 8 + (U).h); \
        glds((const char*)KN + (bh_ * 32 + (tile)) * 8192 + lo16, lds + K_OFF + (slot) * KSLOT + wid * 1024); glds((const char*)V + (bh_ * 32 + (tile)) * 8192 + lo16, lds + V_OFF + (slot) * VSLOT + wid * 1024); \
        if (wid < 4) glds((const char*)KR + ((size_t)(U).b * 32 + (tile)) * 4096 + lo16, lds + K_OFF + (slot) * KSLOT + 8192 + wid * 1024); } while (0)
#define ATT_QLOAD(dst, aux, U) do { const size_t row_ = (size_t)((U).b * SEQ + 256 * (U).qb + 32 * wid + r32); const bf16_t* qp_ = Q + row_ * QW + 96 * (U).h + 8 * hi; \
        _Pragma("unroll") for (int ks = 0; ks < 6; ++ks) dst[ks] = *(const bf16x8*)(qp_ + 16 * ks); \
        aux[0] = *(const f32x4*)(ssqq + row_ * 4); aux[1] = *(const f32x4*)(rope + row_ * 32 + 8 * hi); aux[2] = *(const f32x4*)(rope + row_ * 32 + 8 * hi + 4); \
        aux[3] = *(const f32x4*)(rope + row_ * 32 + 16 + 8 * hi); aux[4] = *(const f32x4*)(rope + row_ * 32 + 16 + 8 * hi + 4); } while (0)
#define ATT_QFIX(q, aux) do { const float f_ = rsqrtf(((aux[0][0] + aux[0][1]) + (aux[0][2] + aux[0][3])) * (1.f / 256.f) + 1e-6f) * QSCALE; \
        _Pragma("unroll") for (int ks = 0; ks < 4; ++ks) { const u32x4 w_ = __builtin_bit_cast(u32x4, q[ks]); u32x4 o_; \
            _Pragma("unroll") for (int e = 0; e < 4; ++e) o_[e] = cvtpk_m(bf_lo(w_[e]) * f_, bf_hi(w_[e]) * f_); q[ks] = __builtin_bit_cast(bf16x8, o_); } \
        { const u32x4 a_ = __builtin_bit_cast(u32x4, q[4]), b_ = __builtin_bit_cast(u32x4, q[5]); u32x4 oa_, ob_; \
          _Pragma("unroll") for (int e = 0; e < 4; ++e) { const float x1l = bf_lo(a_[e]), x1h = bf_hi(a_[e]), x2l = bf_lo(b_[e]), x2h = bf_hi(b_[e]); \
              const float cl = (e < 2) ? aux[1][2 * e] : aux[2][2 * e - 4], ch = (e < 2) ? aux[1][2 * e + 1] : aux[2][2 * e - 3], sl = (e < 2) ? aux[3][2 * e] : aux[4][2 * e - 4], sh = (e < 2) ? aux[3][2 * e + 1] : aux[4][2 * e - 3]; \
              oa_[e] = cvtpk_m((x1l * cl - x2l * sl) * f_, (x1h * ch - x2h * sh) * f_); ob_[e] = cvtpk_m((x2l * cl + x1l * sl) * f_, (x2h * ch + x1h * sh) * f_); } \
          q[4] = __builtin_bit_cast(bf16x8, oa_); q[5] = __builtin_bit_cast(bf16x8, ob_); } } while (0)
    AUnit cur, nxt;
    if (!unit_of(0, vcu, G, cur)) return;
    bf16x8 qr[6], qn[6]; f32x4 qa[5], qna[5];
    ATT_QLOAD(qr, qa, cur);
    ATT_QFIX(qr, qa);
    asm volatile("" : "+v"(qr[0]), "+v"(qr[1]), "+v"(qr[2]), "+v"(qr[3]), "+v"(qr[4]), "+v"(qr[5]));
    ATT_ISSUE(cur, 0, 0); ATT_ISSUE(cur, 1, 1);
    int slot = 0;
    for (int k = 0;; ++k) {
        const bool has_next = unit_of(k + 1, vcu, G, nxt);
        const int NT = 4 * cur.qb + 4, jmax = 4 * cur.qb + (wid >> 1);
        float mrun = 0.f, lrun = 0.f; f32x16 o[2]; o[0] = f32x16{}; o[1] = f32x16{}; f32x16 negm = f32x16{};
        for (int j = 0; j < NT; ++j) {
            if (j == 0 && k > 0) { if (wid < 4) asm volatile("s_waitcnt vmcnt(13) lgkmcnt(0)\n\ts_barrier" ::: "memory"); else asm volatile("s_waitcnt vmcnt(12) lgkmcnt(0)\n\ts_barrier" ::: "memory"); }
            else if (j + 1 < NT || has_next) { if (wid < 4) asm volatile("s_waitcnt vmcnt(3) lgkmcnt(0)\n\ts_barrier" ::: "memory"); else asm volatile("s_waitcnt vmcnt(2) lgkmcnt(0)\n\ts_barrier" ::: "memory"); }
            else asm volatile("s_waitcnt vmcnt(0) lgkmcnt(0)\n\ts_barrier" ::: "memory");
            { const int s2 = (slot == 0) ? 2 : slot - 1;
              if (j + 2 < NT) ATT_ISSUE(cur, j + 2, s2); else if (has_next) ATT_ISSUE(nxt, j + 2 - NT, s2); }
            if (j == NT - 1 && has_next) ATT_QLOAD(qn, qna, nxt);
            if (j <= jmax) {
                const LAS unsigned char* kp = lds + K_OFF + slot * KSLOT + kl;
                f32x16 p0, p1;
#pragma unroll
                for (int ks = 0; ks < 6; ++ks) { const bf16x8 k0 = *(const LAS bf16x8*)(kp + ks * 2048), k1 = *(const LAS bf16x8*)(kp + ks * 2048 + 512);
                    if (ks == 0) { p0 = __builtin_amdgcn_mfma_f32_32x32x16_bf16(k0, qr[0], negm, 0, 0, 0); p1 = __builtin_amdgcn_mfma_f32_32x32x16_bf16(k1, qr[0], negm, 0, 0, 0); }
                    else { p0 = __builtin_amdgcn_mfma_f32_32x32x16_bf16(k0, qr[ks], p0, 0, 0, 0); p1 = __builtin_amdgcn_mfma_f32_32x32x16_bf16(k1, qr[ks], p1, 0, 0, 0); } }
                asm volatile("s_nop 15\n\ts_nop 7" : "+v"(p0), "+v"(p1));
                float rm;
                { float a = max3f(p0[0], p0[1], p1[0]), c = max3f(p0[2], p0[3], p1[1]); a = max3f(a, p1[2], p1[3]);
#pragma unroll
                  for (int r = 4; r < 16; r += 4) { a = max3f(a, p0[r], p0[r + 1]); c = max3f(c, p0[r + 2], p0[r + 3]); a = max3f(a, p1[r], p1[r + 1]); c = max3f(c, p1[r + 2], p1[r + 3]); }
                  rm = max2f(a, c); rm = max2f(rm, __shfl_xor(rm, 32)); }
                if (j == 0 || __any(rm > THRL)) {
                    const float dl = (j == 0) ? rm : fmaxf(rm, 0.f);
                    mrun += dl;
#pragma unroll
                    for (int r = 0; r < 16; ++r) { p0[r] -= dl; p1[r] -= dl; }
#pragma unroll
                    for (int r = 0; r < 16; ++r) negm[r] = -mrun;
                    if (j != 0) { const float alpha = fexp2(-dl); lrun *= alpha;
                        if (hi == 0) wsf[r32] = alpha;
#pragma unroll
                        for (int r = 0; r < 16; ++r) { const float a_ = wsf[crow(r, hi)]; o[0][r] *= a_; o[1][r] *= a_; } }
                }
#pragma unroll
                for (int r = 0; r < 16; ++r) { p0[r] = fexp2(p0[r]); p1[r] = fexp2(p1[r]); }
                { float s0 = fadd_s(p0[0], p1[0]), s1 = fadd_s(p0[1], p1[1]);
#pragma unroll
                  for (int r = 2; r < 16; r += 2) { s0 = fadd_s(s0, p0[r]); s1 = fadd_s(s1, p0[r + 1]); s0 = fadd_s(s0, p1[r]); s1 = fadd_s(s1, p1[r + 1]); }
                  lrun = fadd_s(lrun, fadd_s(s0, s1)); }
                bf16x8 pa[4];
                { u32x4 w0, w1, w2, w3;
                  w0.x = cvtpk_m(p0[0], p0[1]); w0.y = cvtpk_m(p0[2], p0[3]); w0.z = cvtpk_m(p0[4], p0[5]); w0.w = cvtpk_m(p0[6], p0[7]);
                  w1.x = cvtpk_m(p0[8], p0[9]); w1.y = cvtpk_m(p0[10], p0[11]); w1.z = cvtpk_m(p0[12], p0[13]); w1.w = cvtpk_m(p0[14], p0[15]);
                  w2.x = cvtpk_m(p1[0], p1[1]); w2.y = cvtpk_m(p1[2], p1[3]); w2.z = cvtpk_m(p1[4], p1[5]); w2.w = cvtpk_m(p1[6], p1[7]);
                  w3.x = cvtpk_m(p1[8], p1[9]); w3.y = cvtpk_m(p1[10], p1[11]); w3.z = cvtpk_m(p1[12], p1[13]); w3.w = cvtpk_m(p1[14], p1[15]);
                  pa[0] = __builtin_bit_cast(bf16x8, w0); pa[1] = __builtin_bit_cast(bf16x8, w1); pa[2] = __builtin_bit_cast(bf16x8, w2); pa[3] = __builtin_bit_cast(bf16x8, w3); }
                const LAS unsigned char* vp = lds + V_OFF + slot * VSLOT + vl;
#pragma unroll
                for (int d0 = 0; d0 < 2; ++d0)
#pragma unroll
                    for (int ks = 0; ks < 4; ++ks) { const s16x4 lo = vtr(vp + d0 * 4096 + ks * 1024), hh = vtr(vp + d0 * 4096 + ks * 1024 + 512);
                        const bf16x8 vf = {lo[0], lo[1], lo[2], lo[3], hh[0], hh[1], hh[2], hh[3]};
                        o[d0] = __builtin_amdgcn_mfma_f32_32x32x16_bf16(pa[ks], vf, o[d0], 0, 0, 0); }
            }
            slot = (slot == 2) ? 0 : slot + 1;
        }
        { const float lt = lrun + __shfl_xor(lrun, 32);
          if (hi == 0) wsf[r32] = frcp(lt);
          LAS float* stg = (LAS float*)(lds + OST_OFF + wid * 8192);
#pragma unroll
          for (int r = 0; r < 16; ++r) { const float inv = wsf[crow(r, hi)]; const int orow = crow(r, hi); stg[orow * 64 + r32] = o[0][r] * inv; stg[orow * 64 + 32 + r32] = o[1][r] * inv; }
          asm volatile("s_waitcnt lgkmcnt(0)" ::: "memory");
          const int ch = lane & 7;
          const f32x4 ga = *(const f32x4*)(ong + 64 * cur.h + 8 * ch), gb = *(const f32x4*)(ong + 64 * cur.h + 8 * ch + 4);
          bf16_t* Yw = Y + (size_t)(cur.b * SEQ + 256 * cur.qb + 32 * wid) * D + 64 * cur.h + 8 * ch;
#pragma unroll
          for (int i = 0; i < 4; ++i) { const int row = i * 8 + (lane >> 3);
              const f32x4 va = *(const LAS f32x4*)(stg + row * 64 + 8 * ch), vb = *(const LAS f32x4*)(stg + row * 64 + 8 * ch + 4);
              float ss = (va[0] * va[0] + va[1] * va[1]) + (va[2] * va[2] + va[3] * va[3]) + (vb[0] * vb[0] + vb[1] * vb[1]) + (vb[2] * vb[2] + vb[3] * vb[3]);
              ss += pg8::dppf<0xB1>(ss); ss += pg8::dppf<0x4E>(ss); ss += pg8::dppf<0x141>(ss);
              const float rs = rsqrtf(ss * (1.f / 64.f) + 1e-6f);
              const f32x4 oa = va * rs * ga, ob = vb * rs * gb;
              u32x4 w; w.x = cvtpk_m(oa[0], oa[1]); w.y = cvtpk_m(oa[2], oa[3]); w.z = cvtpk_m(ob[0], ob[1]); w.w = cvtpk_m(ob[2], ob[3]);
              *(u32x4*)(Yw + (size_t)row * D) = w; } }
        if (!has_next) break;
        cur = nxt;
#pragma unroll
        for (int ks = 0; ks < 6; ++ks) qr[ks] = qn[ks];
        ATT_QFIX(qr, qna);
    }
    asm volatile("s_waitcnt vmcnt(0) lgkmcnt(0)\n\ts_barrier" ::: "memory");
#undef ATT_ISSUE
#undef ATT_QLOAD
#undef ATT_QFIX
}
}

#define XB_TMO      128
#define XB_XCNT(j)  (256  + 64 * (j))
#define XB_XSUB(j)  (1280 + 64 * (j))
#define XB_XGEN(j)  (2304 + 64 * (j))
#define XB_TOP      3328
#define XB_TOPGEN   3392
#define XCD_BAR_WORDS 3456
#define XB_SPIN_CAP (1u << 18)
__device__ __forceinline__ unsigned xb_ld(unsigned* p)              { return __hip_atomic_load(p, __ATOMIC_RELAXED, __HIP_MEMORY_SCOPE_AGENT); }
__device__ __forceinline__ unsigned xb_add(unsigned* p, unsigned v) { return __hip_atomic_fetch_add(p, v, __ATOMIC_RELAXED, __HIP_MEMORY_SCOPE_AGENT); }
__device__ __forceinline__ unsigned xb_xcc_id() { return (unsigned)__builtin_amdgcn_s_getreg((3 << 11) | 20) & 0xFu; }
#define XB_SPIN(cond, bar) do { unsigned _sp = 0; while (cond) { __builtin_amdgcn_s_sleep(1); \
    if ((++_sp & 255u) == 0u) { if (xb_ld(&(bar)[XB_TMO])) break; if (_sp > XB_SPIN_CAP) { atomicAdd(&(bar)[XB_TMO], 1u); break; } } } } while (0)
struct XcdBarrier { unsigned* bar; unsigned x; volatile LAS unsigned* st; };
__device__ __forceinline__ XcdBarrier xcd_barrier_post(unsigned* bar, volatile LAS unsigned* st) {
    XcdBarrier b; b.bar = bar; b.x = xb_xcc_id(); b.st = st;
    if (threadIdx.x == 0) (void)xb_add(&bar[XB_XCNT(b.x)], 1u);
    return b;
}
__device__ __forceinline__ void xcd_barrier_complete(unsigned* bar, unsigned x, unsigned& nloc, unsigned& nx) {
    const unsigned G = gridDim.x * gridDim.y * gridDim.z;
    unsigned sum, cnt, mine, sp = 0u;
    for (;;) {
        sum = 0u; cnt = 0u; mine = 0u;
#pragma unroll
        for (unsigned j = 0; j < 16; ++j) { const unsigned c = xb_ld(&bar[XB_XCNT(j)]); sum += c; cnt += (c > 0u) ? 1u : 0u; mine = (j == x) ? c : mine; }
        if (sum == G) break;
        __builtin_amdgcn_s_sleep(1);
        if ((++sp & 255u) == 0u) { if (xb_ld(&bar[XB_TMO])) break; if (sp > XB_SPIN_CAP) { atomicAdd(&bar[XB_TMO], 1u); break; } }
    }
    nloc = mine > 0u ? mine : 1u; nx = cnt > 0u ? cnt : 1u;
}
__device__ __forceinline__ void xcd_barrier(const XcdBarrier& b) {
    asm volatile("s_waitcnt vmcnt(0)" ::: "memory");
    __syncthreads();
    if (threadIdx.x == 0) {
        unsigned* bar = b.bar;
        __builtin_amdgcn_s_waitcnt(0);
        unsigned nloc = b.st[0], nx = b.st[1];
        if (nloc == 0u) { xcd_barrier_complete(bar, b.x, nloc, nx); b.st[0] = nloc; b.st[1] = nx; }
        const unsigned old = xb_add(&bar[XB_XSUB(b.x)], 1u);
        const unsigned gen = old / nloc;
        if (old + 1u == (gen + 1u) * nloc) {
            __builtin_amdgcn_fence(__ATOMIC_RELEASE, "agent");
            asm volatile("s_waitcnt vmcnt(0)" ::: "memory");
            const unsigned og = xb_add(&bar[XB_TOP], 1u);
            const unsigned tg = og / nx;
            if (og + 1u == (tg + 1u) * nx) xb_add(&bar[XB_TOPGEN], 1u);
            else XB_SPIN(xb_ld(&bar[XB_TOPGEN]) == tg, bar);
            __builtin_amdgcn_fence(__ATOMIC_ACQUIRE, "agent");
            xb_add(&bar[XB_XGEN(b.x)], 1u);
            asm volatile("s_waitcnt vmcnt(0)" ::: "memory");
        } else {
            XB_SPIN(xb_ld(&bar[XB_XGEN(b.x)]) == gen, bar);
            __builtin_amdgcn_fence(__ATOMIC_ACQUIRE, "agent");
            asm volatile("s_waitcnt vmcnt(0)" ::: "memory");
        }
    }
    __syncthreads();
}

struct Args { const float* in[22]; const int* pos; float* out; unsigned char* ws; int ph_lo, ph_hi; };
__constant__ float c_invfreq[16] = {1.0f, 0.5623413251903491f, 0.31622776601683794f, 0.1778279410038923f, 0.1f, 0.05623413251903491f, 0.03162277660168379f, 0.01778279410038923f,
                                    0.01f, 0.005623413251903491f, 0.0031622776601683794f, 0.001778279410038923f, 0.001f, 0.0005623413251903491f, 0.00031622776601683794f, 0.0001778279410038923f};

__device__ __forceinline__ int colmap(int which, int s) {
    const int p = (s & ~31) + pg8::perm32(s & 31);
    switch (which) {
        case 0: { if (s < 1024) return p < 416 ? p : (p < 512 ? -1 : p - 96);
                  const int bj = (s >> 7) & 1, ch = 128 * ((s >> 8) - 4) + 32 * ((s >> 5) & 3) + pg8::perm32(s & 31); return (bj ? 1440 : 928) + ch; }
        case 4: { const int pn = s >> 8, bj = (s >> 7) & 1, wc = (s >> 5) & 3; return bj * DFF + 128 * pn + 32 * wc + pg8::perm32(s & 31); }
        default: return p;
    }
}
__device__ __forceinline__ void p0_transpose_item(const float* W, int ldw, int Ksrc, const float* kscale, bf16_t* WT, int Kdst, int which, LAS float* scr, int item, int nblk, int lane) {
    const int kb = item / nblk, nb = item % nblk, k0 = 64 * kb, s0 = 32 * nb;
    const int cm = colmap(which, s0 + (lane & 31));
    float tv[32];
#pragma unroll
    for (int i = 0; i < 32; ++i) { const int k = k0 + 2 * i + (lane >> 5); tv[i] = (cm >= 0 && k < Ksrc) ? __builtin_nontemporal_load(W + (size_t)k * ldw + cm) : 0.f; }
    if (kscale) {
#pragma unroll
        for (int i = 0; i < 32; ++i) { const int k = k0 + 2 * i + (lane >> 5); if (k < Ksrc) tv[i] *= kscale[k]; } }
#pragma unroll
    for (int i = 0; i < 32; ++i) scr[(2 * i + (lane >> 5)) * 33 + (lane & 31)] = tv[i];
    asm volatile("s_waitcnt lgkmcnt(0)" ::: "memory");
    const int c = lane & 7;
#pragma unroll
    for (int j = 0; j < 4; ++j) { const int n = (lane >> 3) + 8 * j; const LAS float* s = scr + (8 * c) * 33 + n;
        u32x4 o; o.x = cvt_pk_bf16(s[0 * 33], s[1 * 33]); o.y = cvt_pk_bf16(s[2 * 33], s[3 * 33]); o.z = cvt_pk_bf16(s[4 * 33], s[5 * 33]); o.w = cvt_pk_bf16(s[6 * 33], s[7 * 33]);
        *(u32x4*)(WT + (size_t)(s0 + n) * Kdst + k0 + 8 * c) = o; }
    asm volatile("s_waitcnt lgkmcnt(0)" ::: "memory");
}

constexpr int N_PHASES = 11;
#define OPAQUE_LANE(name) int name##_t = (int)threadIdx.x; asm volatile("" : "+v"(name##_t)); const int name = name##_t & 63

__global__ void __launch_bounds__(512, 2) mk_fwd(Args args) {
    extern __shared__ __attribute__((aligned(16))) unsigned char lds_raw[];
    LAS unsigned char* lds = (LAS unsigned char*)lds_raw;
    volatile LAS unsigned* MISC = (volatile LAS unsigned*)(lds + MISC_OFF);
    const int tid = threadIdx.x, lane = tid & 63, wave = __builtin_amdgcn_readfirstlane(tid >> 6);
    const int G = gridDim.x; const int bx = blockIdx.x; const int vcu = (G % 8 == 0) ? (bx % 8) * (G / 8) + bx / 8 : bx;
    const int gw = vcu * 8 + wave, NGW = G * 8;
    unsigned char* ws = args.ws;
    const float* x = args.in[0]; const float* cvec = args.in[1]; const int* pos = args.pos;
    const float* w_ada = args.in[3]; const float* b_ada = args.in[4]; const float* w_in = args.in[5];
    const float* qg = args.in[6]; const float* w_qup = args.in[7]; const float* kvg = args.in[8]; const float* w_kvup = args.in[9];
    const float* conv_w = args.in[10]; const float* conv_b = args.in[11]; const float* ong = args.in[12]; const float* w_out = args.in[13];
    const float* ln1g = args.in[14]; const float* ln1b = args.in[15]; const float* w_up = args.in[16];
    const float* fcw = args.in[17]; const float* fcb = args.in[18]; const float* w_down = args.in[19];
    const float* ln2g = args.in[20]; const float* ln2b = args.in[21];
    float* out = args.out;
    float* MOD = (float*)(ws + WS_MOD); float* ROPE = (float*)(ws + WS_ROPE); float* SSQQ = (float*)(ws + WS_SSQQ); float* SSQKV = (float*)(ws + WS_SSQKV);
    bf16_t* WIN = (bf16_t*)(ws + WS_WIN); bf16_t* WQ = (bf16_t*)(ws + WS_WQ); bf16_t* WKV = (bf16_t*)(ws + WS_WKV); bf16_t* WOUT = (bf16_t*)(ws + WS_WOUT);
    bf16_t* WUP = (bf16_t*)(ws + WS_WUP); bf16_t* WDN = (bf16_t*)(ws + WS_WDN);
    bf16_t* HB = (bf16_t*)(ws + WS_HB); bf16_t* FF = (bf16_t*)(ws + WS_FF); bf16_t* P = (bf16_t*)(ws + WS_P); bf16_t* MIX = (bf16_t*)(ws + WS_MIX);
    bf16_t* U = (bf16_t*)(ws + WS_U); bf16_t* Qb = (bf16_t*)(ws + WS_Q); bf16_t* KN = (bf16_t*)(ws + WS_KN); bf16_t* KR = (bf16_t*)(ws + WS_KR); bf16_t* Vb = (bf16_t*)(ws + WS_V);
    bf16_t* Y = (bf16_t*)(ws + WS_Y); bf16_t* X1 = (bf16_t*)(ws + WS_X1); bf16_t* ACT = (bf16_t*)(ws + WS_ACT); float* E = (float*)(ws + WS_E);

    for (int u = tid; u < (LDS_BYTES - LDSCTL_OFF) / 4; u += 512) ((LAS unsigned*)(lds + LDSCTL_OFF))[u] = 0u;
    __syncthreads();
    XcdBarrier bar; bar.bar = (unsigned*)(ws + WS_CTL) + CW_BAR; bar.x = 0; bar.st = nullptr;
    if (MK_N_LAUNCHES == 1) bar = xcd_barrier_post((unsigned*)(ws + WS_CTL) + CW_BAR, MISC + 8);
    const int lo = args.ph_lo, hi = args.ph_hi;
#ifndef PH_MASK
#define PH_MASK 0x7ff
#endif
#define IN(k) (((PH_MASK >> (k)) & 1) && lo <= (k) && (k) < hi)
#define SEAM(k) do { if (IN(k) && IN((k) + 1)) xcd_barrier(bar); } while (0)

    if (IN(0)) {
        OPAQUE_LANE(ln);
        if (bx < 192) {
            LAS float* cact = (LAS float*)lds; LAS float* part = (LAS float*)(lds + 65536);
            const int n0 = 32 * bx, c4 = tid & 7, kr = tid >> 3;
            f32x4 wv[16];
#pragma unroll
            for (int i = 0; i < 16; ++i) wv[i] = __builtin_nontemporal_load((const f32x4*)(w_ada + (size_t)(kr + 64 * i) * 6144 + n0 + 4 * c4));
            for (int i = tid; i < 16 * 1024; i += 512) { const float v = cvec[i]; cact[i] = v * frcp(1.f + fexp2(-LOG2E * v)); }
            __syncthreads();
            f32x4 a[16];
#pragma unroll
            for (int b = 0; b < 16; ++b) a[b] = (f32x4){0.f, 0.f, 0.f, 0.f};
#pragma unroll
            for (int i = 0; i < 16; ++i) { const int k = kr + 64 * i;
#pragma unroll
                for (int b = 0; b < 16; ++b) a[b] += wv[i] * cact[b * 1024 + k];
                if ((i & 1) == 1) asm volatile("" ::: "memory"); }
#pragma unroll
            for (int b = 0; b < 16; ++b)
#pragma unroll
                for (int e = 0; e < 4; ++e) { float v = a[b][e]; v += __shfl_xor(v, 8); v += __shfl_xor(v, 16); v += __shfl_xor(v, 32); a[b][e] = v; }
            if (ln < 8) {
#pragma unroll
                for (int b = 0; b < 16; ++b) *(LAS f32x4*)(part + (wave * 16 + b) * 32 + 4 * c4) = a[b]; }
            __syncthreads();
            { const int b = tid >> 5, col = tid & 31; float s = 0.f;
#pragma unroll
              for (int w8 = 0; w8 < 8; ++w8) s += part[(w8 * 16 + b) * 32 + col];
              MOD[b * 6144 + n0 + col] = s + b_ada[n0 + col]; }
            __syncthreads();
        }
        for (int idx = gw * 64 + ln; idx < T * 16; idx += NGW * 64) { const int t = idx >> 4, i = idx & 15; const float ang = (float)pos[t] * c_invfreq[i];
            ROPE[(size_t)t * 32 + i] = cosf(ang); ROPE[(size_t)t * 32 + 16 + i] = sinf(ang); }
    }
    SEAM(0);
    if (IN(1)) {
        OPAQUE_LANE(ln);
        {
        LAS float* scr = (LAS float*)(lds + wave * 16384);
        constexpr int I0 = 16 * 64, I1 = 4 * 24, I2 = 4 * 32, I3 = 16 * 32, I4 = 16 * 176, I5 = 44 * 32, NIT = I0 + I1 + I2 + I3 + I4 + I5;
        for (int it = gw; it < NIT; it += NGW) {
            int r = it;
            if (r < I0) { p0_transpose_item(w_in, INW, D, nullptr, WIN, D, 0, scr, r, 64, ln); continue; } r -= I0;
            if (r < I1) { p0_transpose_item(w_qup, QW, 256, qg, WQ, 256, 1, scr, r, 24, ln); continue; } r -= I1;
            if (r < I2) { p0_transpose_item(w_kvup, 1024, 128, kvg, WKV, 256, 2, scr, r, 32, ln); continue; } r -= I2;
            if (r < I3) { p0_transpose_item(w_out, D, D, nullptr, WOUT, D, 3, scr, r, 32, ln); continue; } r -= I3;
            if (r < I4) { p0_transpose_item(w_up, UPW, D, nullptr, WUP, D, 4, scr, r, 176, ln); continue; } r -= I4;
            p0_transpose_item(w_down, D, DFF, nullptr, WDN, DFF, 5, scr, r, 32, ln);
        }
            }
        for (int row0 = gw * 16; row0 < T; row0 += NGW * 16) { const int b = row0 / SEQ; const float* mb = MOD + b * 6144;
            f32x4 sc[4], sh[4];
#pragma unroll
            for (int j = 0; j < 4; ++j) { const int col = 4 * ln + 256 * j; sh[j] = *(const f32x4*)(mb + col); sc[j] = *(const f32x4*)(mb + 1024 + col) + 1.f; }
            for (int rr = 0; rr < 16; ++rr) { const int t = row0 + rr; const float* xr = x + (size_t)t * D;
                f32x4 v[4]; float s = 0.f;
#pragma unroll
                for (int j = 0; j < 4; ++j) { v[j] = __builtin_nontemporal_load((const f32x4*)(xr + 4 * ln + 256 * j)); s += (v[j][0] + v[j][1]) + (v[j][2] + v[j][3]); }
                const float mean = wave_sum(s) * (1.f / D); float q = 0.f;
#pragma unroll
                for (int j = 0; j < 4; ++j) { v[j] = v[j] - mean; q += (v[j][0] * v[j][0] + v[j][1] * v[j][1]) + (v[j][2] * v[j][2] + v[j][3] * v[j][3]); }
                const float rstd = rsqrtf(wave_sum(q) * (1.f / D) + 1e-5f);
#pragma unroll
                for (int j = 0; j < 4; ++j) { const f32x4 o = v[j] * rstd * sc[j] + sh[j]; u32x2 w; w.x = cvt_pk_bf16(o[0], o[1]); w.y = cvt_pk_bf16(o[2], o[3]);
                    *(u32x2*)(HB + (size_t)t * D + 4 * ln + 256 * j) = w; } } }
    }
    SEAM(1);
    if (IN(2)) {
        pg8::Gemm g{HB, D, WIN, T, 512, D}; pg8::StaticOrder S; S.init(T, 512, G, bx);
        pg8::EpiP E1{P, U, SSQQ, SSQKV};
        pg8::gemm_phase<pg8::EpiP, true>(lds, g, S, E1);
    }
    SEAM(2);
    if (IN(3)) {
        OPAQUE_LANE(ln);
        for (int row0 = gw * 16; row0 < T; row0 += NGW * 16) {
            { const int t = row0 + (ln >> 2), c = ln & 3, i0 = 8 * (c & 1); const bf16_t* pr = P + (size_t)t * PW + 384;
              const u32x4 r1 = *(const u32x4*)(pr + i0), r2 = *(const u32x4*)(pr + 16 + i0);
              const f32x4 ca = *(const f32x4*)(ROPE + (size_t)t * 32 + i0), cb = *(const f32x4*)(ROPE + (size_t)t * 32 + i0 + 4), sa = *(const f32x4*)(ROPE + (size_t)t * 32 + 16 + i0), sb = *(const f32x4*)(ROPE + (size_t)t * 32 + 16 + i0 + 4);
              float ov[8];
#pragma unroll
              for (int e = 0; e < 8; ++e) { const float x1 = (e & 1) ? bf_hi(r1[e >> 1]) : bf_lo(r1[e >> 1]), x2 = (e & 1) ? bf_hi(r2[e >> 1]) : bf_lo(r2[e >> 1]);
                  const float cs = (e < 4) ? ca[e & 3] : cb[e & 3], sn = (e < 4) ? sa[e & 3] : sb[e & 3];
                  ov[e] = (c < 2) ? x1 * cs - x2 * sn : x2 * cs + x1 * sn; }
              u32x4 o; o.x = cvt_pk_bf16(ov[0], ov[1]); o.y = cvt_pk_bf16(ov[2], ov[3]); o.z = cvt_pk_bf16(ov[4], ov[5]); o.w = cvt_pk_bf16(ov[6], ov[7]);
              *(u32x4*)((char*)KR + (size_t)(t >> 6) * 4096 + c * 1024 + (t & 63) * 16) = o; }
        }
        { pg8::MixedOrder S{(const char*)HB, (const char*)P, (const char*)WIN, (const char*)WQ, (const char*)WKV, G, bx};
          pg8::EpiMix EM{pg8::EpiP{P, U, SSQQ, SSQKV}, pg8::EpiStore{Qb, QW, true}, pg8::EpiKV{KN, Vb}, SSQKV};
          pg8::gemm_multi<pg8::MixedOrder, pg8::EpiMix>(lds, S, EM); }
    }
    SEAM(3);
    if (IN(4)) {
        att::attn_phase(vcu, G, SSQQ, ROPE, Qb, KN, KR, Vb, Y, ong, lds);
        { OPAQUE_LANE(ln);
        for (int row0 = gw * 16; row0 < T; row0 += NGW * 16) {
            const int c0 = 8 * ln;
            float w0[8], w1[8], w2[8], cb8[8], gn[8];
#pragma unroll
            for (int e = 0; e < 8; ++e) { w0[e] = conv_w[c0 + e]; w1[e] = conv_w[512 + c0 + e]; w2[e] = conv_w[1024 + c0 + e]; cb8[e] = conv_b[c0 + e]; gn[e] = ong[512 + c0 + e]; }
            float um2[8], um1[8];
#pragma unroll
            for (int e = 0; e < 8; ++e) { um2[e] = 0.f; um1[e] = 0.f; }
            if ((row0 % SEQ) != 0) {
                const u32x4 a2 = *(const u32x4*)(U + (size_t)(row0 - 2) * 512 + c0), a1 = *(const u32x4*)(U + (size_t)(row0 - 1) * 512 + c0);
#pragma unroll
                for (int e = 0; e < 4; ++e) { um2[2 * e] = bf_lo(a2[e]); um2[2 * e + 1] = bf_hi(a2[e]); um1[2 * e] = bf_lo(a1[e]); um1[2 * e + 1] = bf_hi(a1[e]); }
            }
            for (int rr = 0; rr < 16; ++rr) { const int t = row0 + rr;
                const u32x4 gb = __builtin_nontemporal_load((const u32x4*)(P + (size_t)t * PW + 512 + c0)), uu = __builtin_nontemporal_load((const u32x4*)(U + (size_t)t * 512 + c0));
                float u0[8], yv[8]; float ss = 0.f;
#pragma unroll
                for (int e = 0; e < 4; ++e) { u0[2 * e] = bf_lo(uu[e]); u0[2 * e + 1] = bf_hi(uu[e]); }
#pragma unroll
                for (int e = 0; e < 8; ++e) { const float gbe = (e & 1) ? bf_hi(gb[e >> 1]) : bf_lo(gb[e >> 1]);
                    yv[e] = gbe * (cb8[e] + w0[e] * um2[e] + w1[e] * um1[e] + w2[e] * u0[e]); ss += yv[e] * yv[e]; um2[e] = um1[e]; um1[e] = u0[e]; }
                ss += __shfl_xor(ss, 1); ss += __shfl_xor(ss, 2); ss += __shfl_xor(ss, 4);
                const float rs = rsqrtf(ss * (1.f / 64.f) + 1e-6f);
                u32x4 o; o.x = cvt_pk_bf16(yv[0] * rs * gn[0], yv[1] * rs * gn[1]); o.y = cvt_pk_bf16(yv[2] * rs * gn[2], yv[3] * rs * gn[3]);
                o.z = cvt_pk_bf16(yv[4] * rs * gn[4], yv[5] * rs * gn[5]); o.w = cvt_pk_bf16(yv[6] * rs * gn[6], yv[7] * rs * gn[7]);
                *(u32x4*)(Y + (size_t)t * D + 512 + c0) = o; }
        }
            }
    }
    SEAM(4);
    if (IN(5)) {
        pg8::Gemm g{Y, D, WOUT, T, D, D}; pg8::StaticOrder S; S.init(T, D, G, bx); pg8::EpiStore E4{MIX, D, true};
        pg8::gemm_phase<pg8::EpiStore, true>(lds, g, S, E4);
    }
    SEAM(5);
    if (IN(6)) {
        OPAQUE_LANE(ln);
        for (int row0 = gw * 16; row0 < T; row0 += NGW * 16) { const int b = row0 / SEQ; const float* mb = MOD + b * 6144;
            f32x4 gt[4], g1v[4], b1v[4], sc[4], sh[4];
#pragma unroll
            for (int j = 0; j < 4; ++j) { const int col = 4 * ln + 256 * j; gt[j] = *(const f32x4*)(mb + 2048 + col); g1v[j] = *(const f32x4*)(ln1g + col); b1v[j] = *(const f32x4*)(ln1b + col);
                sh[j] = *(const f32x4*)(mb + 3072 + col); sc[j] = *(const f32x4*)(mb + 4096 + col) + 1.f; }
            for (int rr = 0; rr < 16; ++rr) { const int t = row0 + rr;
                f32x4 v[4]; float s = 0.f;
#pragma unroll
                for (int j = 0; j < 4; ++j) { const int col = 4 * ln + 256 * j; const f32x4 xv = __builtin_nontemporal_load((const f32x4*)(x + (size_t)t * D + col)); const u32x2 mw = __builtin_nontemporal_load((const u32x2*)(MIX + (size_t)t * D + col));
                    const f32x4 mx = {bf_lo(mw.x), bf_hi(mw.x), bf_lo(mw.y), bf_hi(mw.y)};
                    v[j] = xv * ALPHA + gt[j] * mx; s += (v[j][0] + v[j][1]) + (v[j][2] + v[j][3]); }
                float mean = wave_sum(s) * (1.f / D); float q = 0.f;
#pragma unroll
                for (int j = 0; j < 4; ++j) { v[j] = v[j] - mean; q += (v[j][0] * v[j][0] + v[j][1] * v[j][1]) + (v[j][2] * v[j][2] + v[j][3] * v[j][3]); }
                float rstd = rsqrtf(wave_sum(q) * (1.f / D) + 1e-5f);
                s = 0.f;
#pragma unroll
                for (int j = 0; j < 4; ++j) { v[j] = v[j] * rstd * g1v[j] + b1v[j]; u32x2 w; w.x = cvt_pk_bf16(v[j][0], v[j][1]); w.y = cvt_pk_bf16(v[j][2], v[j][3]); __builtin_nontemporal_store(w, (u32x2*)(X1 + (size_t)t * D + 4 * ln + 256 * j)); s += (v[j][0] + v[j][1]) + (v[j][2] + v[j][3]); }
                mean = wave_sum(s) * (1.f / D); q = 0.f;
#pragma unroll
                for (int j = 0; j < 4; ++j) { v[j] = v[j] - mean; q += (v[j][0] * v[j][0] + v[j][1] * v[j][1]) + (v[j][2] * v[j][2] + v[j][3] * v[j][3]); }
                rstd = rsqrtf(wave_sum(q) * (1.f / D) + 1e-5f);
#pragma unroll
                for (int j = 0; j < 4; ++j) { const f32x4 o = v[j] * rstd * sc[j] + sh[j]; u32x2 w; w.x = cvt_pk_bf16(o[0], o[1]); w.y = cvt_pk_bf16(o[2], o[3]);
                    *(u32x2*)(HB + (size_t)t * D + 4 * ln + 256 * j) = w; } } }
    }
    SEAM(6);
    if (IN(7)) {
        pg8::Gemm g{HB, D, WUP, T, UPW, D}; pg8::StaticOrder S; S.init(T, UPW, G, bx); pg8::EpiUp E5{ACT, E, fcw, fcb};
        pg8::gemm_phase<pg8::EpiUp, true>(lds, g, S, E5);
    }
    SEAM(7);
    if (IN(8)) {
        OPAQUE_LANE(ln);
        constexpr int NITEM = 512 * 2 * (DFF / 4);
        for (int it = (gw * 64 + ln); it < NITEM; it += NGW * 64) { const int c4 = it % (DFF / 4), rb = it / (DFF / 4), rr = rb & 1, blk = rb >> 1; const int c0 = 4 * c4;
            const bool first = (blk & 31) == 0;
            const float* e0 = E + ((size_t)blk * 4 + rr) * UPW + c0;
            const float* em1 = (rr == 0) ? E + ((size_t)(blk - 1) * 4 + 3) * UPW + c0 : E + ((size_t)blk * 4 + 0) * UPW + c0;
            const float* em2 = (rr == 0) ? E + ((size_t)(blk - 1) * 4 + 2) * UPW + c0 : E + ((size_t)(blk - 1) * 4 + 3) * UPW + c0;
            const f32x4 z = {0.f, 0.f, 0.f, 0.f};
            const f32x4 g0 = *(const f32x4*)e0, v0 = *(const f32x4*)(e0 + DFF);
            const bool has1 = !(first && rr == 0), has2 = !first;
            const f32x4 g1 = has1 ? *(const f32x4*)em1 : z, v1 = has1 ? *(const f32x4*)(em1 + DFF) : z;
            const f32x4 g2 = has2 ? *(const f32x4*)em2 : z, v2 = has2 ? *(const f32x4*)(em2 + DFF) : z;
            const f32x4 wg0 = *(const f32x4*)(fcw + c0), wg1 = *(const f32x4*)(fcw + UPW + c0), wg2 = *(const f32x4*)(fcw + 2 * UPW + c0), bg = *(const f32x4*)(fcb + c0);
            const f32x4 wv0 = *(const f32x4*)(fcw + DFF + c0), wv1 = *(const f32x4*)(fcw + UPW + DFF + c0), wv2 = *(const f32x4*)(fcw + 2 * UPW + DFF + c0), bv = *(const f32x4*)(fcb + DFF + c0);
            const f32x4 cg = bg + wg0 * g2 + wg1 * g1 + wg2 * g0, cv = bv + wv0 * v2 + wv1 * v1 + wv2 * v0;
            u32x2 w; w.x = cvt_pk_bf16(silu_f(cg[0]) * cv[0], silu_f(cg[1]) * cv[1]); w.y = cvt_pk_bf16(silu_f(cg[2]) * cv[2], silu_f(cg[3]) * cv[3]);
            *(u32x2*)(ACT + (size_t)(64 * blk + rr) * DFF + c0) = w; }
    }
    SEAM(8);
    if (IN(9)) {
        pg8::Gemm g{ACT, DFF, WDN, T, D, DFF}; pg8::StaticOrder S; S.init(T, D, G, bx); pg8::EpiStore E6{FF, D, true};
        pg8::gemm_phase<pg8::EpiStore, true>(lds, g, S, E6);
    }
    SEAM(9);
    if (IN(10)) {
        OPAQUE_LANE(ln);
        for (int row0 = gw * 16; row0 < T; row0 += NGW * 16) { const int b = row0 / SEQ; const float* mb = MOD + b * 6144;
            f32x4 gt[4], g2v[4], b2v[4];
#pragma unroll
            for (int j = 0; j < 4; ++j) { const int col = 4 * ln + 256 * j; gt[j] = *(const f32x4*)(mb + 5120 + col); g2v[j] = *(const f32x4*)(ln2g + col); b2v[j] = *(const f32x4*)(ln2b + col); }
            for (int rr = 0; rr < 16; ++rr) { const int t = row0 + rr;
                f32x4 v[4]; float s = 0.f;
#pragma unroll
                for (int j = 0; j < 4; ++j) { const int col = 4 * ln + 256 * j; const u32x2 xw = __builtin_nontemporal_load((const u32x2*)(X1 + (size_t)t * D + col)); const f32x4 xv = {bf_lo(xw.x), bf_hi(xw.x), bf_lo(xw.y), bf_hi(xw.y)}; const u32x2 mw = __builtin_nontemporal_load((const u32x2*)(FF + (size_t)t * D + col));
                    const f32x4 mx = {bf_lo(mw.x), bf_hi(mw.x), bf_lo(mw.y), bf_hi(mw.y)};
                    v[j] = xv * ALPHA + gt[j] * mx; s += (v[j][0] + v[j][1]) + (v[j][2] + v[j][3]); }
                const float mean = wave_sum(s) * (1.f / D); float q = 0.f;
#pragma unroll
                for (int j = 0; j < 4; ++j) { v[j] = v[j] - mean; q += (v[j][0] * v[j][0] + v[j][1] * v[j][1]) + (v[j][2] * v[j][2] + v[j][3] * v[j][3]); }
                const float rstd = rsqrtf(wave_sum(q) * (1.f / D) + 1e-5f);
#pragma unroll
                for (int j = 0; j < 4; ++j) { __builtin_nontemporal_store(v[j] * rstd * g2v[j] + b2v[j], (f32x4*)(out + (size_t)t * D + 4 * ln + 256 * j)); } } }
    }
#undef IN
#undef SEAM
}

extern "C" void kernel_launch(void* const* d_in, const int* in_sizes, int n_in, void* d_out, int out_size, void* d_ws, size_t ws_size, hipStream_t stream) {
    static int grid = 0;
    if (grid == 0) {
        if (n_in != 22 || in_sizes[0] != T * D || out_size != T * D || ws_size < WS_END) { fprintf(stderr, "kernel_launch: unexpected shapes / workspace (n_in %d, ws %zu)\n", n_in, ws_size); grid = -1; return; }
        int dev = 0, cus = 0, per_cu = 0;
        if (hipGetDevice(&dev) != hipSuccess || hipDeviceGetAttribute(&cus, hipDeviceAttributeMultiprocessorCount, dev) != hipSuccess) { grid = -1; return; }
        if (hipFuncSetAttribute((const void*)mk_fwd, hipFuncAttributeMaxDynamicSharedMemorySize, LDS_BYTES) != hipSuccess) { fprintf(stderr, "kernel_launch: hipFuncSetAttribute failed\n"); grid = -1; return; }
        if (hipOccupancyMaxActiveBlocksPerMultiprocessor(&per_cu, (const void*)mk_fwd, 512, LDS_BYTES) != hipSuccess || per_cu < 1) { fprintf(stderr, "kernel_launch: occupancy query says %d blocks per CU\n", per_cu); (void)hipGetLastError(); grid = -1; return; }
        grid = cus;
    }
    if (grid < 0) return;
    hipMemsetAsync((char*)d_ws + WS_CTL, 0, CTL_ZERO_BYTES, stream);
    Args a{};
    for (int i = 0; i < 22; ++i) a.in[i] = (const float*)d_in[i];
    a.pos = (const int*)d_in[2]; a.out = (float*)d_out; a.ws = (unsigned char*)d_ws;
#if MK_N_LAUNCHES == 1
    a.ph_lo = 0; a.ph_hi = N_PHASES;
    hipLaunchKernelGGL(mk_fwd, dim3(grid), dim3(512), LDS_BYTES, stream, a);
#else
    for (int p = 0; p < N_PHASES; ++p) { a.ph_lo = p; a.ph_hi = p + 1; hipLaunchKernelGGL(mk_fwd, dim3(grid), dim3(512), LDS_BYTES, stream, a); }
#endif
}
```

```cpp
#include <hip/hip_runtime.h>
#include <cstdio>
#include <cstdint>

#define LAS __attribute__((address_space(3)))
#define GAS __attribute__((address_space(1)))
typedef unsigned short bf16_t;
typedef short bf16x8 __attribute__((ext_vector_type(8)));
typedef short s16x4 __attribute__((ext_vector_type(4)));
typedef float f32x4 __attribute__((ext_vector_type(4)));
typedef float f32x2 __attribute__((ext_vector_type(2)));
typedef float f32x16 __attribute__((ext_vector_type(16)));
typedef unsigned u32x4 __attribute__((ext_vector_type(4)));
typedef unsigned u32x2 __attribute__((ext_vector_type(2)));
typedef GAS unsigned gu32;

#ifndef MK_N_LAUNCHES
#define MK_N_LAUNCHES 1
#endif

constexpr int D = 1024, NB = 16, SEQ = 2048, T = NB * SEQ, NH = 8, DFF = 2816, UPW = 2 * DFF;
constexpr int PW = 1024;
constexpr int G1N = 2048;
constexpr int QW = 768, INW = 1952;
constexpr float ALPHA = 1.189207115002721f;
constexpr float QSCALE = 0.10206207261596575f * 1.4426950408889634f;
constexpr float LOG2E = 1.4426950408889634f;

constexpr size_t MiB = 1u << 20;
constexpr size_t WS_CTL = 0, CTL_ZERO_BYTES = 64 * 1024;
constexpr size_t WS_MOD = 1 * MiB;
constexpr size_t WS_ROPE = 2 * MiB;
constexpr size_t WS_SSQQ = 6 * MiB;
constexpr size_t WS_SSQKV = 6 * MiB + 512 * 1024;
constexpr size_t WS_WIN = 8 * MiB;
constexpr size_t WS_WQ = 12 * MiB;
constexpr size_t WS_WKV = 12 * MiB + 512 * 1024;
constexpr size_t WS_WOUT = 13 * MiB;
constexpr size_t WS_WUP = 15 * MiB;
constexpr size_t WS_WDN = 26 * MiB;
constexpr size_t WS_HB = 32 * MiB;
constexpr size_t WS_FF = 32 * MiB;
constexpr size_t WS_P = 96 * MiB;
constexpr size_t WS_U = 160 * MiB;
constexpr size_t WS_MIX = 96 * MiB;
constexpr size_t WS_Q = 224 * MiB;
constexpr size_t WS_KN = 272 * MiB;
constexpr size_t WS_KR = 304 * MiB;
constexpr size_t WS_V = 306 * MiB;
constexpr size_t WS_Y = 338 * MiB;
constexpr size_t WS_X1 = 338 * MiB;
constexpr size_t WS_ACT = 96 * MiB;
constexpr size_t WS_E = 272 * MiB;
constexpr size_t WS_END = 402 * MiB;
constexpr int CW_BAR = 1024;

constexpr int RING_BYTES = 131072, LDSCTL_OFF = RING_BYTES, MISC_OFF = LDSCTL_OFF + 320, LDS_BYTES = 147456;

__device__ __forceinline__ unsigned cvt_pk_bf16(float lo, float hi) { unsigned r; asm volatile("v_cvt_pk_bf16_f32 %0, %1, %2" : "=v"(r) : "v"(lo), "v"(hi)); return r; }
__device__ __forceinline__ float bf_lo(unsigned u) { return __uint_as_float(u << 16); }
__device__ __forceinline__ float bf_hi(unsigned u) { return __uint_as_float(u & 0xffff0000u); }
__device__ __forceinline__ float fexp2(float x) { return __builtin_amdgcn_exp2f(x); }
__device__ __forceinline__ float frcp(float x) { return __builtin_amdgcn_rcpf(x); }
__device__ __forceinline__ float silu_f(float v) { return v * frcp(1.f + fexp2(-LOG2E * v)); }
__device__ __forceinline__ float wave_sum(float v) {
#pragma unroll
    for (int o = 1; o < 64; o <<= 1) v += __shfl_xor(v, o);
    return v;
}

namespace pg8 {
constexpr int BM = 256, BK = 64, HALF = 128, HTB = HALF * BK * 2, STAGE_BYTES = 8 * HTB, NXCD = 8, WGM = 8;
__host__ __device__ __forceinline__ int lds_byte(int r, int c) { const int st = (r >> 4) * 2 + (c >> 5), rr = r & 15, cc = c & 31, ob = rr * 64 + cc * 2; return st * 1024 + (ob ^ (((ob >> 9) & 1) << 5)); }
__host__ __device__ __forceinline__ void stage_rc(int b, int& R, int& C) { const int st = b / 1024, sb = b % 1024, swz = sb ^ (((sb >> 9) & 1) << 5); R = (st >> 1) * 16 + swz / 64; C = (st & 1) * 32 + (swz % 64) / 2; }
__host__ __device__ __forceinline__ int perm32(int rho) { const int n = rho >> 4, i = rho & 15; return 8 * (i >> 2) + 4 * n + (i & 3); }

struct Unit { int pm, pn; };
struct Gemm { const bf16_t* A; int lda; const bf16_t* Bt; int M, N, K; };

struct StaticOrder {
    int nM, nN, nwg, G, c;
    __device__ __forceinline__ void init(int M, int N, int G_, int c_) { nM = M / BM; nN = N / BM; nwg = nM * nN; G = G_; c = c_; }
    __device__ __forceinline__ bool next(int i, Unit& u) const {
        const long L = (long)i * G + c; if (L >= nwg) return false;
        int wgid = (int)L; { const int q = nwg / NXCD, r = nwg % NXCD, xcd = wgid % NXCD, off = wgid / NXCD; wgid = (xcd < r ? xcd * (q + 1) : r * (q + 1) + (xcd - r) * q) + off; }
        const int nig = WGM * nN, gid = wgid / nig, fm = gid * WGM, gsz = (nM - fm) < WGM ? (nM - fm) : WGM;
        u.pm = fm + ((wgid % nig) % gsz); u.pn = (wgid % nig) / gsz; return true;
    }
};

template <class Epi, bool ALIGN_EPI>
__device__ __forceinline__ void gemm_phase(LAS unsigned char* lds, const Gemm g, const StaticOrder& S, const Epi& E) {
    int tid = threadIdx.x; asm volatile("" : "+v"(tid));
    const int wid = __builtin_amdgcn_readfirstlane(tid >> 6), lane = tid & 63, wr = wid >> 2, wc = wid & 3, fr = lane & 15, fq = lane >> 4;
    const int K = g.K, nt = K / BK;
    unsigned voffA[2], voffB[2];
#pragma unroll
    for (int i = 0; i < 2; ++i) { int R, C; stage_rc(tid * 16 + i * 8192, R, C);
        voffA[i] = (unsigned)(R * g.lda + C) * 2u; voffB[i] = (unsigned)(R * K + C) * 2u; }
    const size_t kstep = (size_t)(BK * 2);
    const size_t hstepA = (size_t)HALF * g.lda * 2, hstepB = (size_t)HALF * K * 2;
    const size_t tstepA = 2 * hstepA, tstepB = 2 * hstepB;
    const unsigned ldsw = (unsigned)wid * 1024u;
    const int aoff = lds_byte(wr * 64 + fr, fq * 8), boff = lds_byte(wc * 32 + fr, fq * 8);
#define PG8_SA(b, h) (((b) * 2 + (h)) * HTB)
#define PG8_SB(b, h) ((4 + (b) * 2 + (h)) * HTB)
#define PG8_STAGE(bufoff, gbase, voff) do { _Pragma("unroll") for (int _i = 0; _i < 2; ++_i) \
        __builtin_amdgcn_global_load_lds((const unsigned*)((const char*)(gbase) + (voff)[_i]), (LAS unsigned*)(lds + (bufoff) + ldsw + _i * 8192), 16, 0, 0); } while (0)
#define PG8_LDA(dst, b, h) do { _Pragma("unroll") for (int m = 0; m < 4; ++m) _Pragma("unroll") for (int k = 0; k < 2; ++k) dst[m][k] = *(const LAS bf16x8*)(lds + PG8_SA(b, h) + aoff + m * 2048 + k * 1024); } while (0)
#define PG8_LDB(dst, b, h) do { _Pragma("unroll") for (int n = 0; n < 2; ++n) _Pragma("unroll") for (int k = 0; k < 2; ++k) dst[n][k] = *(const LAS bf16x8*)(lds + PG8_SB(b, h) + boff + n * 2048 + k * 1024); } while (0)
#define PG8_MMA(ai, bj, At, Bt) do { __builtin_amdgcn_s_setprio(1); _Pragma("unroll") for (int m = 0; m < 4; ++m) _Pragma("unroll") for (int n = 0; n < 2; ++n) _Pragma("unroll") for (int k = 0; k < 2; ++k) \
        acc[ai][bj][m][n] = __builtin_amdgcn_mfma_f32_16x16x32_bf16(Bt[n][k], At[m][k], acc[ai][bj][m][n], 0, 0, 0); __builtin_amdgcn_s_setprio(0); } while (0)
#define PG8_WAIT_V(n) asm volatile("s_waitcnt vmcnt(" #n ")" ::: "memory")
#define PG8_WAIT_L(n) asm volatile("s_waitcnt lgkmcnt(" #n ")" ::: "memory")
#define PG8_BAR __builtin_amdgcn_s_barrier()
#define PG8_SCHED __builtin_amdgcn_sched_barrier(0)
    Unit cur, nxt; int ui = 0;
    if (!S.next(0, cur)) return;
    f32x4 acc[2][2][4][2];
#pragma unroll
    for (int a = 0; a < 2; ++a)
#pragma unroll
        for (int b = 0; b < 2; ++b)
#pragma unroll
            for (int m = 0; m < 4; ++m)
#pragma unroll
                for (int n = 0; n < 2; ++n) acc[a][b][m][n] = (f32x4){0.f, 0.f, 0.f, 0.f};
    bf16x8 At[4][2], B0[2][2], B1[2][2];
    const char* cA = (const char*)g.A + (size_t)cur.pm * tstepA; const char* cB = (const char*)g.Bt + (size_t)cur.pn * tstepB;
    if constexpr (Epi::HAS_PREFETCH) E.prefetch(cur, 0, lds, wid, lane);
    PG8_STAGE(PG8_SB(0, 0), cB, voffB); PG8_STAGE(PG8_SB(0, 1), cB + hstepB, voffB); PG8_STAGE(PG8_SA(0, 0), cA, voffA); PG8_STAGE(PG8_SA(0, 1), cA + hstepA, voffA);
    if (wr == 1) PG8_BAR;
    PG8_WAIT_V(2); PG8_BAR;
    PG8_STAGE(PG8_SB(1, 0), cB + kstep, voffB); PG8_STAGE(PG8_SA(1, 0), cA + kstep, voffA); PG8_STAGE(PG8_SB(1, 1), cB + hstepB + kstep, voffB);
    PG8_WAIT_V(6); PG8_BAR;
    for (;;) {
        const bool has_next = S.next(ui + 1, nxt);
        const char* nA = has_next ? (const char*)g.A + (size_t)nxt.pm * tstepA : cA; const char* nB = has_next ? (const char*)g.Bt + (size_t)nxt.pn * tstepB : cB;
#pragma nounroll
        for (int t = 0; t < nt; t += 2) {
            const bool last = (t == nt - 2);
            const char* a1 = cA + (size_t)(t + 1) * kstep;
            const char* a2 = last ? nA : cA + (size_t)(t + 2) * kstep; const char* b2 = last ? nB : cB + (size_t)(t + 2) * kstep;
            const char* a3 = a2 + kstep; const char* b3 = b2 + kstep;
            const bool rlx = (Epi::NST > 0) && (t == 0) && (ui > 0);
            PG8_LDB(B0, 0, 0); PG8_LDB(B1, 0, 1); PG8_SCHED; PG8_LDA(At, 0, 0); PG8_STAGE(PG8_SA(1, 1), a1 + hstepA, voffA);
            if (rlx) { if constexpr (Epi::NST >= 16) PG8_WAIT_V(24); else PG8_WAIT_V(16); } else PG8_WAIT_V(8);
            PG8_WAIT_L(0); PG8_BAR; PG8_MMA(0, 0, At, B0); PG8_MMA(0, 1, At, B1); PG8_BAR; PG8_SCHED;
            PG8_LDA(At, 0, 1); PG8_STAGE(PG8_SB(0, 0), b2, voffB); PG8_STAGE(PG8_SB(0, 1), b2 + hstepB, voffB); PG8_STAGE(PG8_SA(0, 0), a2, voffA);
            if (rlx) { if constexpr (Epi::NST >= 16) PG8_WAIT_V(24); else PG8_WAIT_V(16); } else PG8_WAIT_V(8);
            PG8_WAIT_L(0); PG8_BAR; PG8_MMA(1, 0, At, B0); PG8_MMA(1, 1, At, B1); PG8_BAR; PG8_SCHED;
            PG8_LDB(B0, 1, 0); PG8_LDB(B1, 1, 1); PG8_SCHED; PG8_LDA(At, 1, 0); PG8_STAGE(PG8_SA(0, 1), a2 + hstepA, voffA);
            PG8_WAIT_V(8); PG8_WAIT_L(0); PG8_BAR; PG8_MMA(0, 0, At, B0); PG8_MMA(0, 1, At, B1); PG8_BAR; PG8_SCHED;
            PG8_LDA(At, 1, 1); PG8_STAGE(PG8_SB(1, 0), b3, voffB); PG8_STAGE(PG8_SB(1, 1), b3 + hstepB, voffB); PG8_STAGE(PG8_SA(1, 0), a3, voffA);
            PG8_WAIT_V(8); PG8_WAIT_L(0); PG8_BAR; PG8_MMA(1, 0, At, B0); PG8_MMA(1, 1, At, B1); PG8_BAR; PG8_SCHED;
        }
        if constexpr (ALIGN_EPI) { if (wr == 0) PG8_BAR; }
        { int t_e = threadIdx.x; asm volatile("" : "+v"(t_e)); const int fr_e = t_e & 15, fq_e = (t_e >> 4) & 3;
          if constexpr (Epi::HAS_PREFETCH) { if (has_next) E.prefetch(nxt, (ui + 1) & 1, lds, wid, t_e & 63); E.run(acc, cur, wr, wc, fr_e, fq_e, lds, ui & 1); }
          else E(acc, cur, wr, wc, fr_e, fq_e); }
        if (!has_next) break;
#pragma unroll
        for (int a = 0; a < 2; ++a)
#pragma unroll
            for (int b = 0; b < 2; ++b)
#pragma unroll
                for (int m = 0; m < 4; ++m)
#pragma unroll
                    for (int n = 0; n < 2; ++n) acc[a][b][m][n] = (f32x4){0.f, 0.f, 0.f, 0.f};
        cur = nxt; cA = nA; cB = nB; ++ui;
        if constexpr (ALIGN_EPI) { if (wr == 1) PG8_BAR; }
    }
    PG8_WAIT_V(0);
    if constexpr (!ALIGN_EPI) { if (wr == 0) PG8_BAR; }
    PG8_BAR;
#undef PG8_SA
#undef PG8_SB
#undef PG8_STAGE
#undef PG8_LDA
#undef PG8_LDB
#undef PG8_MMA
#undef PG8_WAIT_V
#undef PG8_WAIT_L
#undef PG8_BAR
#undef PG8_SCHED
}

struct MUnit { const char* A; const char* B; int nt; unsigned kb2; int type; Unit u; };
template <class Sched, class Disp>
__device__ __forceinline__ void gemm_multi(LAS unsigned char* lds, const Sched& S, const Disp& E) {
    int tid = threadIdx.x; asm volatile("" : "+v"(tid));
    const int wid = __builtin_amdgcn_readfirstlane(tid >> 6), lane = tid & 63, wr = wid >> 2, wc = wid & 3, fr = lane & 15, fq = lane >> 4;
    unsigned voffA[2], rB[2], cB2[2];
#pragma unroll
    for (int i = 0; i < 2; ++i) { int R, C; stage_rc(tid * 16 + i * 8192, R, C); voffA[i] = (unsigned)(R * 1024 + C) * 2u; rB[i] = (unsigned)R; cB2[i] = (unsigned)C * 2u; }
    const size_t kstep = (size_t)(BK * 2);
    const size_t hstepA = (size_t)HALF * 1024 * 2;
    const unsigned ldsw = (unsigned)wid * 1024u;
    const int aoff = lds_byte(wr * 64 + fr, fq * 8), boff = lds_byte(wc * 32 + fr, fq * 8);
#define PG8_SA(b, h) (((b) * 2 + (h)) * HTB)
#define PG8_SB(b, h) ((4 + (b) * 2 + (h)) * HTB)
#define PG8_STAGE(bufoff, gbase, voff) do { _Pragma("unroll") for (int _i = 0; _i < 2; ++_i) \
        __builtin_amdgcn_global_load_lds((const unsigned*)((const char*)(gbase) + (voff)[_i]), (LAS unsigned*)(lds + (bufoff) + ldsw + _i * 8192), 16, 0, 0); } while (0)
#define PG8_LDA(dst, b, h) do { _Pragma("unroll") for (int m = 0; m < 4; ++m) _Pragma("unroll") for (int k = 0; k < 2; ++k) dst[m][k] = *(const LAS bf16x8*)(lds + PG8_SA(b, h) + aoff + m * 2048 + k * 1024); } while (0)
#define PG8_LDB(dst, b, h) do { _Pragma("unroll") for (int n = 0; n < 2; ++n) _Pragma("unroll") for (int k = 0; k < 2; ++k) dst[n][k] = *(const LAS bf16x8*)(lds + PG8_SB(b, h) + boff + n * 2048 + k * 1024); } while (0)
#define PG8_MMA(ai, bj, At, Bt) do { __builtin_amdgcn_s_setprio(1); _Pragma("unroll") for (int m = 0; m < 4; ++m) _Pragma("unroll") for (int n = 0; n < 2; ++n) _Pragma("unroll") for (int k = 0; k < 2; ++k) \
        acc[ai][bj][m][n] = __builtin_amdgcn_mfma_f32_16x16x32_bf16(Bt[n][k], At[m][k], acc[ai][bj][m][n], 0, 0, 0); __builtin_amdgcn_s_setprio(0); } while (0)
#define PG8_WAIT_V(n) asm volatile("s_waitcnt vmcnt(" #n ")" ::: "memory")
#define PG8_WAIT_L(n) asm volatile("s_waitcnt lgkmcnt(" #n ")" ::: "memory")
#define PG8_BAR __builtin_amdgcn_s_barrier()
#define PG8_SCHED __builtin_amdgcn_sched_barrier(0)
    MUnit cur, nxt; int ui = 0; int relax = 0;
    if (!S.next(0, cur)) return;
    f32x4 acc[2][2][4][2];
#pragma unroll
    for (int a = 0; a < 2; ++a)
#pragma unroll
        for (int b = 0; b < 2; ++b)
#pragma unroll
            for (int m = 0; m < 4; ++m)
#pragma unroll
                for (int n = 0; n < 2; ++n) acc[a][b][m][n] = (f32x4){0.f, 0.f, 0.f, 0.f};
    bf16x8 At[4][2], B0[2][2], B1[2][2];
    const char* cA = cur.A; const char* cB = cur.B;
    E.prefetch(cur, 0, lds, wid, lane);
    unsigned voffB[2]; voffB[0] = rB[0] * cur.kb2 + cB2[0]; voffB[1] = rB[1] * cur.kb2 + cB2[1];
    size_t hstepB = (size_t)HALF * cur.kb2;
    PG8_STAGE(PG8_SB(0, 0), cB, voffB); PG8_STAGE(PG8_SB(0, 1), cB + hstepB, voffB); PG8_STAGE(PG8_SA(0, 0), cA, voffA); PG8_STAGE(PG8_SA(0, 1), cA + hstepA, voffA);
    if (wr == 1) PG8_BAR;
    PG8_WAIT_V(2); PG8_BAR;
    PG8_STAGE(PG8_SB(1, 0), cB + kstep, voffB); PG8_STAGE(PG8_SA(1, 0), cA + kstep, voffA); PG8_STAGE(PG8_SB(1, 1), cB + hstepB + kstep, voffB);
    PG8_WAIT_V(6); PG8_BAR;
    for (;;) {
        const bool has_next = S.next(ui + 1, nxt);
        if (!has_next) nxt = cur;
        const char* nA = nxt.A; const char* nB = nxt.B;
        unsigned nvoffB[2]; nvoffB[0] = rB[0] * nxt.kb2 + cB2[0]; nvoffB[1] = rB[1] * nxt.kb2 + cB2[1];
        const size_t nhstepB = (size_t)HALF * nxt.kb2;
        const int nt = cur.nt;
#pragma nounroll
        for (int t = 0; t < nt; t += 2) {
            const bool last = (t == nt - 2);
            const char* a1 = cA + (size_t)(t + 1) * kstep;
            const char* a2 = last ? nA : cA + (size_t)(t + 2) * kstep; const char* b2 = last ? nB : cB + (size_t)(t + 2) * kstep;
            const char* a3 = a2 + kstep; const char* b3 = b2 + kstep;
            unsigned vB2[2]; vB2[0] = last ? nvoffB[0] : voffB[0]; vB2[1] = last ? nvoffB[1] : voffB[1];
            const size_t hB2 = last ? nhstepB : hstepB;
            const int rlx = (t == 0) ? relax : 0;
            PG8_LDB(B0, 0, 0); PG8_LDB(B1, 0, 1); PG8_SCHED; PG8_LDA(At, 0, 0); PG8_STAGE(PG8_SA(1, 1), a1 + hstepA, voffA);
            if (rlx >= 16) PG8_WAIT_V(24); else if (rlx >= 8) PG8_WAIT_V(16); else PG8_WAIT_V(8);
            PG8_WAIT_L(0); PG8_BAR; PG8_MMA(0, 0, At, B0); PG8_MMA(0, 1, At, B1); PG8_BAR; PG8_SCHED;
            PG8_LDA(At, 0, 1); PG8_STAGE(PG8_SB(0, 0), b2, vB2); PG8_STAGE(PG8_SB(0, 1), b2 + hB2, vB2); PG8_STAGE(PG8_SA(0, 0), a2, voffA);
            if (rlx >= 16) PG8_WAIT_V(24); else if (rlx >= 8) PG8_WAIT_V(16); else PG8_WAIT_V(8);
            PG8_WAIT_L(0); PG8_BAR; PG8_MMA(1, 0, At, B0); PG8_MMA(1, 1, At, B1); PG8_BAR; PG8_SCHED;
            PG8_LDB(B0, 1, 0); PG8_LDB(B1, 1, 1); PG8_SCHED; PG8_LDA(At, 1, 0); PG8_STAGE(PG8_SA(0, 1), a2 + hstepA, voffA);
            PG8_WAIT_V(8); PG8_WAIT_L(0); PG8_BAR; PG8_MMA(0, 0, At, B0); PG8_MMA(0, 1, At, B1); PG8_BAR; PG8_SCHED;
            PG8_LDA(At, 1, 1); PG8_STAGE(PG8_SB(1, 0), b3, vB2); PG8_STAGE(PG8_SB(1, 1), b3 + hB2, vB2); PG8_STAGE(PG8_SA(1, 0), a3, voffA);
            PG8_WAIT_V(8); PG8_WAIT_L(0); PG8_BAR; PG8_MMA(1, 0, At, B0); PG8_MMA(1, 1, At, B1); PG8_BAR; PG8_SCHED;
        }
        if (wr == 0) PG8_BAR;
        { int t_e = threadIdx.x; asm volatile("" : "+v"(t_e)); if (has_next) E.prefetch(nxt, (ui + 1) & 1, lds, wid, t_e & 63); E(acc, cur, wr, wc, t_e & 15, (t_e >> 4) & 3, lds, ui & 1); }
        if (!has_next) break;
#pragma unroll
        for (int a = 0; a < 2; ++a)
#pragma unroll
            for (int b = 0; b < 2; ++b)
#pragma unroll
                for (int m = 0; m < 4; ++m)
#pragma unroll
                    for (int n = 0; n < 2; ++n) acc[a][b][m][n] = (f32x4){0.f, 0.f, 0.f, 0.f};
        relax = (cur.type == 0 && cur.u.pn >= 4) ? 8 : 16;
        cur = nxt; cA = nA; cB = nB; voffB[0] = nvoffB[0]; voffB[1] = nvoffB[1]; hstepB = nhstepB; ++ui;
        if (wr == 1) PG8_BAR;
    }
    PG8_WAIT_V(0);
    PG8_BAR;
#undef PG8_SA
#undef PG8_SB
#undef PG8_STAGE
#undef PG8_LDA
#undef PG8_LDB
#undef PG8_MMA
#undef PG8_WAIT_V
#undef PG8_WAIT_L
#undef PG8_BAR
#undef PG8_SCHED
}

typedef f32x4 Acc[2][2][4][2];

struct EpiStore { static constexpr bool HAS_PREFETCH = false; static constexpr int NST = 16;
    bf16_t* O; int ldc; bool nt = false;
    __device__ __forceinline__ void operator()(const Acc& acc, const Unit& u, int wr, int wc, int fr, int fq) const {
        const int row0 = u.pm * BM + wr * 64 + fr, col0 = u.pn * BM + wc * 32 + 8 * fq;
#pragma unroll
        for (int ai = 0; ai < 2; ++ai)
#pragma unroll
            for (int m = 0; m < 4; ++m) { bf16_t* rowp = O + (size_t)(row0 + ai * HALF + m * 16) * ldc + col0;
#pragma unroll
                for (int bj = 0; bj < 2; ++bj) { const f32x4 v0 = acc[ai][bj][m][0], v1 = acc[ai][bj][m][1];
                    u32x4 w; w.x = cvt_pk_bf16(v0[0], v0[1]); w.y = cvt_pk_bf16(v0[2], v0[3]); w.z = cvt_pk_bf16(v1[0], v1[1]); w.w = cvt_pk_bf16(v1[2], v1[3]);
                    if (nt) __builtin_nontemporal_store(w, (u32x4*)(rowp + bj * HALF)); else *(u32x4*)(rowp + bj * HALF) = w; } }
    }
};

struct EpiP { static constexpr bool HAS_PREFETCH = false, AFTER_DRAIN = false; static constexpr int NST = 8;
    bf16_t* O; bf16_t* U; float* ssq_q; float* ssq_kv;
    __device__ __forceinline__ void operator()(const Acc& acc, const Unit& u, int wr, int wc, int fr, int fq) const {
        const int row0 = u.pm * BM + wr * 64 + fr;
        if (u.pn >= 4) {
            bf16_t* ucol = U + 128 * (u.pn - 4) + 32 * wc + 8 * fq;
#pragma unroll
            for (int ai = 0; ai < 2; ++ai)
#pragma unroll
                for (int m = 0; m < 4; ++m) { const f32x4 v0 = acc[ai][0][m][0] * acc[ai][1][m][0], v1 = acc[ai][0][m][1] * acc[ai][1][m][1];
                    u32x4 w; w.x = cvt_pk_bf16(v0[0], v0[1]); w.y = cvt_pk_bf16(v0[2], v0[3]); w.z = cvt_pk_bf16(v1[0], v1[1]); w.w = cvt_pk_bf16(v1[2], v1[3]);
                    *(u32x4*)(ucol + (size_t)(row0 + ai * HALF + m * 16) * 512) = w; }
            return;
        }
        EpiStore st{O, PW}; st(acc, u, wr, wc, fr, fq);
        if (u.pn <= 1) {
            float* dst = (u.pn == 0) ? ssq_q : ssq_kv;
#pragma unroll
            for (int ai = 0; ai < 2; ++ai)
#pragma unroll
                for (int m = 0; m < 4; ++m) { float s = 0.f;
#pragma unroll
                    for (int n = 0; n < 2; ++n) { const f32x4 a = acc[ai][0][m][n]; s += (a[0] * a[0] + a[1] * a[1]) + (a[2] * a[2] + a[3] * a[3]); }
                    if (u.pn == 0) {
#pragma unroll
                        for (int n = 0; n < 2; ++n) { const f32x4 a = acc[ai][1][m][n]; s += (a[0] * a[0] + a[1] * a[1]) + (a[2] * a[2] + a[3] * a[3]); } }
                    s += __shfl_xor(s, 16); s += __shfl_xor(s, 32);
                    if (fq == 0) dst[(size_t)(row0 + ai * HALF + m * 16) * 4 + wc] = s; }
        }
    }
};

constexpr int SSQ_LDS = RING_BYTES + 1024;
struct EpiKV { static constexpr bool HAS_PREFETCH = false, AFTER_DRAIN = false; static constexpr int NST = 16;
    bf16_t* KN; bf16_t* V;
    __device__ __forceinline__ void operator()(const Acc& acc, const Unit& u, int wr, int wc, int fr, int fq, LAS unsigned char* lds, int buf) const {
        const int b = u.pm >> 3;
        const LAS f32x4* sq = (const LAS f32x4*)(lds + SSQ_LDS + buf * 4096) + wr * 64 + fr;
        float f[2][4];
#pragma unroll
        for (int ai = 0; ai < 2; ++ai)
#pragma unroll
            for (int m = 0; m < 4; ++m) { const f32x4 sp = sq[ai * HALF + m * 16]; f[ai][m] = rsqrtf(((sp[0] + sp[1]) + (sp[2] + sp[3])) * (1.f / 128.f) + 1e-6f); }
#pragma unroll
        for (int bj = 0; bj < 2; ++bj) { const int g = 8 * u.pn + 4 * bj + wc, head = g >> 2, part = g & 3;
            char* base = (part < 2) ? (char*)KN + (4 * part + fq) * 1024 + fr * 16 : (char*)V + (part - 2) * 4096 + fr * 64 + fq * 16;
            const int mstep = (part < 2) ? 256 : 1024;
            base += (size_t)(b * 8 + head) * 32 * 8192;
#pragma unroll
            for (int ai = 0; ai < 2; ++ai) { const int tile = (4 * u.pm + 2 * ai + wr) & 31;
#pragma unroll
                for (int m = 0; m < 4; ++m) {
                    const f32x4 v0 = acc[ai][bj][m][0] * f[ai][m], v1 = acc[ai][bj][m][1] * f[ai][m];
                    u32x4 w; w.x = cvt_pk_bf16(v0[0], v0[1]); w.y = cvt_pk_bf16(v0[2], v0[3]); w.z = cvt_pk_bf16(v1[0], v1[1]); w.w = cvt_pk_bf16(v1[2], v1[3]);
                    __builtin_nontemporal_store(w, (u32x4*)(base + (size_t)tile * 8192 + m * mstep)); } } }
    }
};

struct MixedOrder {
    const char* HB; const char* P; const char* WIN; const char* WQ; const char* WKV; int G, c;
    __device__ __forceinline__ void set_long(int k, MUnit& m) const { const int li = k * G + c, w = (li % NXCD) * 96 + li / NXCD, pm = w / 6, pn = 2 + w % 6;
        m.A = HB + (size_t)pm * (256 * 1024 * 2); m.B = WIN + (size_t)pn * (256 * 1024 * 2); m.nt = 16; m.kb2 = 2048u; m.type = 0; m.u.pm = pm; m.u.pn = pn; }
    __device__ __forceinline__ void set_short(int k, MUnit& m) const { const int si = k * G + c, s = (si % NXCD) * 112 + si / NXCD;
        if (s < 384) { const int pm = s / 3, pn = s % 3; m.A = P + (size_t)pm * (256 * 1024 * 2); m.B = WQ + (size_t)pn * (256 * 256 * 2); m.nt = 4; m.kb2 = 512u; m.type = 1; m.u.pm = pm; m.u.pn = pn; }
        else { const int s2 = s - 384, pm = s2 >> 2, pn = s2 & 3; m.A = P + 512 + (size_t)pm * (256 * 1024 * 2); m.B = WKV + (size_t)pn * (256 * 256 * 2); m.nt = 4; m.kb2 = 512u; m.type = 2; m.u.pm = pm; m.u.pn = pn; } }
    __device__ __forceinline__ bool next(int i, MUnit& m) const {
        const int ns = (c < 128) ? 4 : 3; if (i >= 3 + ns) return false;
        const int k = i >> 1; const bool even = (c & 1) == 0;
        if (i == 6) { set_short(3, m); return true; }
        if (even == ((i & 1) == 0)) set_long(k, m); else set_short(k, m);
        return true;
    }
};
struct EpiMix { EpiP p; EpiStore q; EpiKV kv; const float* ssqkv;
    __device__ __forceinline__ void prefetch(const MUnit& m, int buf, LAS unsigned char* lds, int wid, int lane) const {
        if (m.type == 2 && wid < 4) __builtin_amdgcn_global_load_lds((const unsigned*)(ssqkv + (size_t)m.u.pm * 1024 + wid * 256 + lane * 4), (LAS unsigned*)(lds + SSQ_LDS + buf * 4096 + wid * 1024), 16, 0, 0);
    }
    __device__ __forceinline__ void operator()(const Acc& acc, const MUnit& m, int wr, int wc, int fr, int fq, LAS unsigned char* lds, int buf) const {
        if (m.type == 0) p(acc, m.u, wr, wc, fr, fq); else if (m.type == 1) q(acc, m.u, wr, wc, fr, fq); else kv(acc, m.u, wr, wc, fr, fq, lds, buf);
    }
};

template <int CTRL> __device__ __forceinline__ float dppf(float v) { return __builtin_bit_cast(float, __builtin_amdgcn_update_dpp(0, __builtin_bit_cast(int, v), CTRL, 0xf, 0xf, true)); }
template <int CTRL> __device__ __forceinline__ f32x4 dpp4(f32x4 v) { f32x4 r; r[0] = dppf<CTRL>(v[0]); r[1] = dppf<CTRL>(v[1]); r[2] = dppf<CTRL>(v[2]); r[3] = dppf<CTRL>(v[3]); return r; }

constexpr int CW_LDS = RING_BYTES + 1024;
struct EpiUp { static constexpr bool HAS_PREFETCH = true; static constexpr int NST = 0;
    bf16_t* ACT; float* E; const float* cw; const float* cb;
    __device__ __forceinline__ void prefetch(const Unit& u, int buf, LAS unsigned char* lds, int wid, int lane) const {
        if (wid < 4) { const float* base = (wid < 3) ? cw + (size_t)wid * UPW : cb;
            const float* src = base + 128 * u.pn + ((lane & 32) ? DFF : 0) + 4 * (lane & 31);
            __builtin_amdgcn_global_load_lds((const unsigned*)src, (LAS unsigned*)(lds + CW_LDS + buf * 4096 + wid * 1024), 16, 0, 0); }
    }
    __device__ __forceinline__ void run(const Acc& acc, const Unit& u, int wr, int wc, int fr, int fq, LAS unsigned char* lds, int buf) const {
        const int cl = 32 * wc + 8 * fq;
        const int cbase = 128 * u.pn + cl;
        const LAS float* wl = (const LAS float*)(lds + CW_LDS + buf * 4096) + cl;
        u32x2 res0[2][4];
#pragma unroll
        for (int n = 0; n < 2; ++n) { const int c0 = cbase + 4 * n;
            const f32x4 wg0 = *(const LAS f32x4*)(wl + 4 * n), wg1 = *(const LAS f32x4*)(wl + 256 + 4 * n), wg2 = *(const LAS f32x4*)(wl + 512 + 4 * n), bg = *(const LAS f32x4*)(wl + 768 + 4 * n);
            const f32x4 wv0 = *(const LAS f32x4*)(wl + 128 + 4 * n), wv1 = *(const LAS f32x4*)(wl + 384 + 4 * n), wv2 = *(const LAS f32x4*)(wl + 640 + 4 * n), bv = *(const LAS f32x4*)(wl + 896 + 4 * n);
#pragma unroll
            for (int ai = 0; ai < 2; ++ai) { f32x4 pg1 = {0.f, 0.f, 0.f, 0.f}, pg2 = pg1, pv1 = pg1, pv2 = pg1;
                const int blk = 4 * u.pm + 2 * ai + wr;
#pragma unroll
                for (int m = 0; m < 4; ++m) { const f32x4 gcur = acc[ai][0][m][n], vcur = acc[ai][1][m][n];
                    const f32x4 rg1 = dpp4<0x121>(gcur), rg2 = dpp4<0x122>(gcur), rv1 = dpp4<0x121>(vcur), rv2 = dpp4<0x122>(vcur);
                    const f32x4 g1 = (fr >= 1) ? rg1 : pg1, g2 = (fr >= 2) ? rg2 : pg2, v1 = (fr >= 1) ? rv1 : pv1, v2 = (fr >= 2) ? rv2 : pv2;
                    const f32x4 cg = bg + wg0 * g2 + wg1 * g1 + wg2 * gcur, cv = bv + wv0 * v2 + wv1 * v1 + wv2 * vcur;
                    f32x4 a; a[0] = silu_f(cg[0]) * cv[0]; a[1] = silu_f(cg[1]) * cv[1]; a[2] = silu_f(cg[2]) * cv[2]; a[3] = silu_f(cg[3]) * cv[3];
                    u32x2 w; w.x = cvt_pk_bf16(a[0], a[1]); w.y = cvt_pk_bf16(a[2], a[3]);
                    const int t = u.pm * BM + ai * HALF + wr * 64 + m * 16 + fr;
                    if (n == 0) res0[ai][m] = w;
                    else if (!(m == 0 && fr < 2)) { u32x4 o; o.x = res0[ai][m].x; o.y = res0[ai][m].y; o.z = w.x; o.w = w.y; __builtin_nontemporal_store(o, (u32x4*)(ACT + (size_t)t * DFF + cbase)); }
                    if (m == 0 && fr < 2) { float* e = E + ((size_t)blk * 4 + fr) * UPW + c0; *(f32x4*)e = gcur; *(f32x4*)(e + DFF) = vcur; }
                    if (m == 3 && fr >= 14) { float* e = E + ((size_t)blk * 4 + 2 + (fr - 14)) * UPW + c0; *(f32x4*)e = gcur; *(f32x4*)(e + DFF) = vcur; }
                    pg1 = rg1; pg2 = rg2; pv1 = rv1; pv2 = rv2; } } }
    }
};
}

namespace att {
constexpr int NSLOT = 3, K_OFF = 0, KSLOT = 12288, V_OFF = NSLOT * KSLOT, VSLOT = 8192, WS_OFF = V_OFF + NSLOT * VSLOT, OST_OFF = WS_OFF + 8 * 256, LDS_END = OST_OFF + 8 * 8192;
static_assert(LDS_END <= RING_BYTES, "attention LDS");
__device__ __forceinline__ int crow(int r, int hi) { return (r & 3) + 8 * (r >> 2) + 4 * hi; }
typedef short v4i16_t __attribute__((ext_vector_type(4)));
__device__ __forceinline__ s16x4 vtr(const LAS unsigned char* p) { return __builtin_bit_cast(s16x4, __builtin_amdgcn_ds_read_tr16_b64_v4i16((LAS v4i16_t*)p)); }
__device__ __forceinline__ void glds(const char* src, LAS unsigned char* dst) { unsigned keep; const unsigned d = (unsigned)__builtin_amdgcn_readfirstlane((int)(unsigned)(uintptr_t)dst);
    asm volatile("s_mov_b32 %0, m0\n\ts_mov_b32 m0, %2\n\ts_nop 0\n\tglobal_load_lds_dwordx4 %1, off\n\ts_mov_b32 m0, %0" : "=&s"(keep) : "v"(src), "s"(d) : "memory"); }
__device__ __forceinline__ float max3f(float a, float b, float c) { float r; asm("v_max3_f32 %0, %1, %2, %3" : "=v"(r) : "v"(a), "v"(b), "v"(c)); return r; }
__device__ __forceinline__ float max2f(float a, float b) { float r; asm("v_max_f32_e32 %0, %1, %2" : "=v"(r) : "v"(a), "v"(b)); return r; }
__device__ __forceinline__ float fadd_s(float a, float b) { float r = a + b; asm volatile("" : "+v"(r)); return r; }
typedef float f32x2_t __attribute__((ext_vector_type(2))); typedef __bf16 bf16x2_t __attribute__((ext_vector_type(2)));
__device__ __forceinline__ unsigned cvtpk_m(float lo, float hi) { f32x2_t v = {lo, hi}; bf16x2_t b2 = __builtin_convertvector(v, bf16x2_t); return __builtin_bit_cast(unsigned, b2); }
constexpr float THRL = 4.0f;

struct AUnit { int b, h, qb; };
__device__ __forceinline__ bool unit_of(int k, int vcu, int G, AUnit& u) {
    const int it = vcu + (k >> 2) * G, r = k & 3; if (it >= 256) return false;
    const int grp = it >> 3, i8 = it & 7, bh = grp * 4 + r; u.b = bh >> 3; u.h = bh & 7;
    u.qb = (r == 0) ? 7 - i8 : (r == 1) ? i8 : (r == 2) ? 7 - (i8 ^ 1) : (i8 ^ 1); return true;
}
__device__ __forceinline__ void attn_phase(int vcu, int G, const float* ssqq, const float* rope, const bf16_t* Q, const bf16_t* KN, const bf16_t* KR, const bf16_t* V, bf16_t* Y, const float* ong, LAS unsigned char* lds) {
    int tid = threadIdx.x; asm volatile("" : "+v"(tid));
    const int lane = tid & 63, r32 = lane & 31, hi = lane >> 5; const int wid = __builtin_amdgcn_readfirstlane(tid >> 6);
    const int lo16 = wid * 1024 + lane * 16;
    LAS float* wsf = (LAS float*)(lds + WS_OFF + wid * 256);
    const int kl = hi * 1024 + r32 * 16, vl = ((lane >> 4) & 1) * 32 + (lane & 3) * 8 + (4 * hi + ((lane & 15) >> 2)) * 64;
#define ATT_ISSUE(U, tile, slot) do { const size_t bh_ = (size_t)((U).b * 8 + (U).h); \
        glds((const char*)KN + (bh_ * 32 + (tile)) * 8192 + lo16, lds + K_OFF + (slot) * KSLOT + wid * 1024); glds((const char*)V + (bh_ * 32 + (tile)) * 8192 + lo16, lds + V_OFF + (slot) * VSLOT + wid * 1024); \
        if (wid < 4) glds((const char*)KR + ((size_t)(U).b * 32 + (tile)) * 4096 + lo16, lds + K_OFF + (slot) * KSLOT + 8192 + wid * 1024); } while (0)
#define ATT_QLOAD(dst, aux, U) do { const size_t row_ = (size_t)((U).b * SEQ + 256 * (U).qb + 32 * wid + r32); const bf16_t* qp_ = Q + row_ * QW + 96 * (U).h + 8 * hi; \
        _Pragma("unroll") for (int ks = 0; ks < 6; ++ks) dst[ks] = *(const bf16x8*)(qp_ + 16 * ks); \
        aux[0] = *(const f32x4*)(ssqq + row_ * 4); aux[1] = *(const f32x4*)(rope + row_ * 32 + 8 * hi); aux[2] = *(const f32x4*)(rope + row_ * 32 + 8 * hi + 4); \
        aux[3] = *(const f32x4*)(rope + row_ * 32 + 16 + 8 * hi); aux[4] = *(const f32x4*)(rope + row_ * 32 + 16 + 8 * hi + 4); } while (0)
#define ATT_QFIX(q, aux) do { const float f_ = rsqrtf(((aux[0][0] + aux[0][1]) + (aux[0][2] + aux[0][3])) * (1.f / 256.f) + 1e-6f) * QSCALE; \
        _Pragma("unroll") for (int ks = 0; ks < 4; ++ks) { const u32x4 w_ = __builtin_bit_cast(u32x4, q[ks]); u32x4 o_; \
            _Pragma("unroll") for (int e = 0; e < 4; ++e) o_[e] = cvtpk_m(bf_lo(w_[e]) * f_, bf_hi(w_[e]) * f_); q[ks] = __builtin_bit_cast(bf16x8, o_); } \
        { const u32x4 a_ = __builtin_bit_cast(u32x4, q[4]), b_ = __builtin_bit_cast(u32x4, q[5]); u32x4 oa_, ob_; \
          _Pragma("unroll") for (int e = 0; e < 4; ++e) { const float x1l = bf_lo(a_[e]), x1h = bf_hi(a_[e]), x2l = bf_lo(b_[e]), x2h = bf_hi(b_[e]); \
              const float cl = (e < 2) ? aux[1][2 * e] : aux[2][2 * e - 4], ch = (e < 2) ? aux[1][2 * e + 1] : aux[2][2 * e - 3], sl = (e < 2) ? aux[3][2 * e] : aux[4][2 * e - 4], sh = (e < 2) ? aux[3][2 * e + 1] : aux[4][2 * e - 3]; \
              oa_[e] = cvtpk_m((x1l * cl - x2l * sl) * f_, (x1h * ch - x2h * sh) * f_); ob_[e] = cvtpk_m((x2l * cl + x1l * sl) * f_, (x2h * ch + x1h * sh) * f_); } \
          q[4] = __builtin_bit_cast(bf16x8, oa_); q[5] = __builtin_bit_cast(bf16x8, ob_); } } while (0)
    AUnit cur, nxt;
    if (!unit_of(0, vcu, G, cur)) return;
    bf16x8 qr[6], qn[6]; f32x4 qa[5], qna[5];
    ATT_QLOAD(qr, qa, cur);
    ATT_QFIX(qr, qa);
    asm volatile("" : "+v"(qr[0]), "+v"(qr[1]), "+v"(qr[2]), "+v"(qr[3]), "+v"(qr[4]), "+v"(qr[5]));
    ATT_ISSUE(cur, 0, 0); ATT_ISSUE(cur, 1, 1);
    int slot = 0;
    for (int k = 0;; ++k) {
        const bool has_next = unit_of(k + 1, vcu, G, nxt);
        const int NT = 4 * cur.qb + 4, jmax = 4 * cur.qb + (wid >> 1);
        float mrun = 0.f, lrun = 0.f; f32x16 o[2]; o[0] = f32x16{}; o[1] = f32x16{}; f32x16 negm = f32x16{};
        for (int j = 0; j < NT; ++j) {
            if (j == 0 && k > 0) { if (wid < 4) asm volatile("s_waitcnt vmcnt(13) lgkmcnt(0)\n\ts_barrier" ::: "memory"); else asm volatile("s_waitcnt vmcnt(12) lgkmcnt(0)\n\ts_barrier" ::: "memory"); }
            else if (j + 1 < NT || has_next) { if (wid < 4) asm volatile("s_waitcnt vmcnt(3) lgkmcnt(0)\n\ts_barrier" ::: "memory"); else asm volatile("s_waitcnt vmcnt(2) lgkmcnt(0)\n\ts_barrier" ::: "memory"); }
            else asm volatile("s_waitcnt vmcnt(0) lgkmcnt(0)\n\ts_barrier" ::: "memory");
            { const int s2 = (slot == 0) ? 2 : slot - 1;
              if (j + 2 < NT) ATT_ISSUE(cur, j + 2, s2); else if (has_next) ATT_ISSUE(nxt, j + 2 - NT, s2); }
            if (j == NT - 1 && has_next) ATT_QLOAD(qn, qna, nxt);
            if (j <= jmax) {
                const LAS unsigned char* kp = lds + K_OFF + slot * KSLOT + kl;
                f32x16 p0, p1;
#pragma unroll
                for (int ks = 0; ks < 6; ++ks) { const bf16x8 k0 = *(const LAS bf16x8*)(kp + ks * 2048), k1 = *(const LAS bf16x8*)(kp + ks * 2048 + 512);
                    if (ks == 0) { p0 = __builtin_amdgcn_mfma_f32_32x32x16_bf16(k0, qr[0], negm, 0, 0, 0); p1 = __builtin_amdgcn_mfma_f32_32x32x16_bf16(k1, qr[0], negm, 0, 0, 0); }
                    else { p0 = __builtin_amdgcn_mfma_f32_32x32x16_bf16(k0, qr[ks], p0, 0, 0, 0); p1 = __builtin_amdgcn_mfma_f32_32x32x16_bf16(k1, qr[ks], p1, 0, 0, 0); } }
                asm volatile("s_nop 15\n\ts_nop 7" : "+v"(p0), "+v"(p1));
                float rm;
                { float a = max3f(p0[0], p0[1], p1[0]), c = max3f(p0[2], p0[3], p1[1]); a = max3f(a, p1[2], p1[3]);
#pragma unroll
                  for (int r = 4; r < 16; r += 4) { a = max3f(a, p0[r], p0[r + 1]); c = max3f(c, p0[r + 2], p0[r + 3]); a = max3f(a, p1[r], p1[r + 1]); c = max3f(c, p1[r + 2], p1[r + 3]); }
                  rm = max2f(a, c); rm = max2f(rm, __shfl_xor(rm, 32)); }
                if (j == 0 || __any(rm > THRL)) {
                    const float dl = (j == 0) ? rm : fmaxf(rm, 0.f);
                    mrun += dl;
#pragma unroll
                    for (int r = 0; r < 16; ++r) { p0[r] -= dl; p1[r] -= dl; }
#pragma unroll
                    for (int r = 0; r < 16; ++r) negm[r] = -mrun;
                    if (j != 0) { const float alpha = fexp2(-dl); lrun *= alpha;
                        if (hi == 0) wsf[r32] = alpha;
#pragma unroll
                        for (int r = 0; r < 16; ++r) { const float a_ = wsf[crow(r, hi)]; o[0][r] *= a_; o[1][r] *= a_; } }
                }
#pragma unroll
                for (int r = 0; r < 16; ++r) { p0[r] = fexp2(p0[r]); p1[r] = fexp2(p1[r]); }
                { float s0 = fadd_s(p0[0], p1[0]), s1 = fadd_s(p0[1], p1[1]);
#pragma unroll
                  for (int r = 2; r < 16; r += 2) { s0 = fadd_s(s0, p0[r]); s1 = fadd_s(s1, p0[r + 1]); s0 = fadd_s(s0, p1[r]); s1 = fadd_s(s1, p1[r + 1]); }
                  lrun = fadd_s(lrun, fadd_s(s0, s1)); }
                bf16x8 pa[4];
                { u32x4 w0, w1, w2, w3;
                  w0.x = cvtpk_m(p0[0], p0[1]); w0.y = cvtpk_m(p0[2], p0[3]); w0.z = cvtpk_m(p0[4], p0[5]); w0.w = cvtpk_m(p0[6], p0[7]);
                  w1.x = cvtpk_m(p0[8], p0[9]); w1.y = cvtpk_m(p0[10], p0[11]); w1.z = cvtpk_m(p0[12], p0[13]); w1.w = cvtpk_m(p0[14], p0[15]);
                  w2.x = cvtpk_m(p1[0], p1[1]); w2.y = cvtpk_m(p1[2], p1[3]); w2.z = cvtpk_m(p1[4], p1[5]); w2.w = cvtpk_m(p1[6], p1[7]);
                  w3.x = cvtpk_m(p1[8], p1[9]); w3.y = cvtpk_m(p1[10], p1[11]); w3.z = cvtpk_m(p1[12], p1[13]); w3.w = cvtpk_m(p1[14], p1[15]);
                  pa[0] = __builtin_bit_cast(bf16x8, w0); pa[1] = __builtin_bit_cast(bf16x8, w1); pa[2] = __builtin_bit_cast(bf16x8, w2); pa[3] = __builtin_bit_cast(bf16x8, w3); }
                const LAS unsigned char* vp = lds + V_OFF + slot * VSLOT + vl;
#pragma unroll
                for (int d0 = 0; d0 < 2; ++d0)
#pragma unroll
                    for (int ks = 0; ks < 4; ++ks) { const s16x4 lo = vtr(vp + d0 * 4096 + ks * 1024), hh = vtr(vp + d0 * 4096 + ks * 1024 + 512);
                        const bf16x8 vf = {lo[0], lo[1], lo[2], lo[3], hh[0], hh[1], hh[2], hh[3]};
                        o[d0] = __builtin_amdgcn_mfma_f32_32x32x16_bf16(pa[ks], vf, o[d0], 0, 0, 0); }
            }
            slot = (slot == 2) ? 0 : slot + 1;
        }
        { const float lt = lrun + __shfl_xor(lrun, 32);
          if (hi == 0) wsf[r32] = frcp(lt);
          LAS float* stg = (LAS float*)(lds + OST_OFF + wid * 8192);
#pragma unroll
          for (int r = 0; r < 16; ++r) { const float inv = wsf[crow(r, hi)]; const int orow = crow(r, hi); stg[orow * 64 + r32] = o[0][r] * inv; stg[orow * 64 + 32 + r32] = o[1][r] * inv; }
          asm volatile("s_waitcnt lgkmcnt(0)" ::: "memory");
          const int ch = lane & 7;
          const f32x4 ga = *(const f32x4*)(ong + 64 * cur.h + 8 * ch), gb = *(const f32x4*)(ong + 64 * cur.h + 8 * ch + 4);
          bf16_t* Yw = Y + (size_t)(cur.b * SEQ + 256 * cur.qb + 32 * wid) * D + 64 * cur.h + 8 * ch;
#pragma unroll
          for (int i = 0; i < 4; ++i) { const int row = i * 8 + (lane >> 3);
              const f32x4 va = *(const LAS f32x4*)(stg + row * 64 + 8 * ch), vb = *(const LAS f32x4*)(stg + row * 64 + 8 * ch + 4);
              float ss = (va[0] * va[0] + va[1] * va[1]) + (va[2] * va[2] + va[3] * va[3]) + (vb[0] * vb[0] + vb[1] * vb[1]) + (vb[2] * vb[2] + vb[3] * vb[3]);
              ss += pg8::dppf<0xB1>(ss); ss += pg8::dppf<0x4E>(ss); ss += pg8::dppf<0x141>(ss);
              const float rs = rsqrtf(ss * (1.f / 64.f) + 1e-6f);
              const f32x4 oa = va * rs * ga, ob = vb * rs * gb;
              u32x4 w; w.x = cvtpk_m(oa[0], oa[1]); w.y = cvtpk_m(oa[2], oa[3]); w.z = cvtpk_m(ob[0], ob[1]); w.w = cvtpk_m(ob[2], ob[3]);
              *(u32x4*)(Yw + (size_t)row * D) = w; } }
        if (!has_next) break;
        cur = nxt;
#pragma unroll
        for (int ks = 0; ks < 6; ++ks) qr[ks] = qn[ks];
        ATT_QFIX(qr, qna);
    }
    asm volatile("s_waitcnt vmcnt(0) lgkmcnt(0)\n\ts_barrier" ::: "memory");
#undef ATT_ISSUE
#undef ATT_QLOAD
#undef ATT_QFIX
}
}

#define XB_TMO      128
#define XB_XCNT(j)  (256  + 64 * (j))
#define XB_XSUB(j)  (1280 + 64 * (j))
#define XB_XGEN(j)  (2304 + 64 * (j))
#define XB_TOP      3328
#define XB_TOPGEN   3392
#define XCD_BAR_WORDS 3456
#define XB_SPIN_CAP (1u << 18)
__device__ __forceinline__ unsigned xb_ld(unsigned* p)              { return __hip_atomic_load(p, __ATOMIC_RELAXED, __HIP_MEMORY_SCOPE_AGENT); }
__device__ __forceinline__ unsigned xb_add(unsigned* p, unsigned v) { return __hip_atomic_fetch_add(p, v, __ATOMIC_RELAXED, __HIP_MEMORY_SCOPE_AGENT); }
__device__ __forceinline__ unsigned xb_xcc_id() { return (unsigned)__builtin_amdgcn_s_getreg((3 << 11) | 20) & 0xFu; }
#define XB_SPIN(cond, bar) do { unsigned _sp = 0; while (cond) { __builtin_amdgcn_s_sleep(1); \
    if ((++_sp & 255u) == 0u) { if (xb_ld(&(bar)[XB_TMO])) break; if (_sp > XB_SPIN_CAP) { atomicAdd(&(bar)[XB_TMO], 1u); break; } } } } while (0)
struct XcdBarrier { unsigned* bar; unsigned x; volatile LAS unsigned* st; };
__device__ __forceinline__ XcdBarrier xcd_barrier_post(unsigned* bar, volatile LAS unsigned* st) {
    XcdBarrier b; b.bar = bar; b.x = xb_xcc_id(); b.st = st;
    if (threadIdx.x == 0) (void)xb_add(&bar[XB_XCNT(b.x)], 1u);
    return b;
}
__device__ __forceinline__ void xcd_barrier_complete(unsigned* bar, unsigned x, unsigned& nloc, unsigned& nx) {
    const unsigned G = gridDim.x * gridDim.y * gridDim.z;
    unsigned sum, cnt, mine, sp = 0u;
    for (;;) {
        sum = 0u; cnt = 0u; mine = 0u;
#pragma unroll
        for (unsigned j = 0; j < 16; ++j) { const unsigned c = xb_ld(&bar[XB_XCNT(j)]); sum += c; cnt += (c > 0u) ? 1u : 0u; mine = (j == x) ? c : mine; }
        if (sum == G) break;
        __builtin_amdgcn_s_sleep(1);
        if ((++sp & 255u) == 0u) { if (xb_ld(&bar[XB_TMO])) break; if (sp > XB_SPIN_CAP) { atomicAdd(&bar[XB_TMO], 1u); break; } }
    }
    nloc = mine > 0u ? mine : 1u; nx = cnt > 0u ? cnt : 1u;
}
__device__ __forceinline__ void xcd_barrier(const XcdBarrier& b) {
    asm volatile("s_waitcnt vmcnt(0)" ::: "memory");
    __syncthreads();
    if (threadIdx.x == 0) {
        unsigned* bar = b.bar;
        __builtin_amdgcn_s_waitcnt(0);
        unsigned nloc = b.st[0], nx = b.st[1];
        if (nloc == 0u) { xcd_barrier_complete(bar, b.x, nloc, nx); b.st[0] = nloc; b.st[1] = nx; }
        const unsigned old = xb_add(&bar[XB_XSUB(b.x)], 1u);
        const unsigned gen = old / nloc;
        if (old + 1u == (gen + 1u) * nloc) {
            __builtin_amdgcn_fence(__ATOMIC_RELEASE, "agent");
            asm volatile("s_waitcnt vmcnt(0)" ::: "memory");
            const unsigned og = xb_add(&bar[XB_TOP], 1u);
            const unsigned tg = og / nx;
            if (og + 1u == (tg + 1u) * nx) xb_add(&bar[XB_TOPGEN], 1u);
            else XB_SPIN(xb_ld(&bar[XB_TOPGEN]) == tg, bar);
            __builtin_amdgcn_fence(__ATOMIC_ACQUIRE, "agent");
            xb_add(&bar[XB_XGEN(b.x)], 1u);
            asm volatile("s_waitcnt vmcnt(0)" ::: "memory");
        } else {
            XB_SPIN(xb_ld(&bar[XB_XGEN(b.x)]) == gen, bar);
            __builtin_amdgcn_fence(__ATOMIC_ACQUIRE, "agent");
            asm volatile("s_waitcnt vmcnt(0)" ::: "memory");
        }
    }
    __syncthreads();
}

struct Args { const float* in[22]; const int* pos; float* out; unsigned char* ws; int ph_lo, ph_hi; };
__constant__ float c_invfreq[16] = {1.0f, 0.5623413251903491f, 0.31622776601683794f, 0.1778279410038923f, 0.1f, 0.05623413251903491f, 0.03162277660168379f, 0.01778279410038923f,
                                    0.01f, 0.005623413251903491f, 0.0031622776601683794f, 0.001778279410038923f, 0.001f, 0.0005623413251903491f, 0.00031622776601683794f, 0.0001778279410038923f};

__device__ __forceinline__ int colmap(int which, int s) {
    const int p = (s & ~31) + pg8::perm32(s & 31);
    switch (which) {
        case 0: { if (s < 1024) return p < 416 ? p : (p < 512 ? -1 : p - 96);
                  const int bj = (s >> 7) & 1, ch = 128 * ((s >> 8) - 4) + 32 * ((s >> 5) & 3) + pg8::perm32(s & 31); return (bj ? 1440 : 928) + ch; }
        case 4: { const int pn = s >> 8, bj = (s >> 7) & 1, wc = (s >> 5) & 3; return bj * DFF + 128 * pn + 32 * wc + pg8::perm32(s & 31); }
        default: return p;
    }
}
__device__ __forceinline__ void p0_transpose_item(const float* W, int ldw, int Ksrc, const float* kscale, bf16_t* WT, int Kdst, int which, LAS float* scr, int item, int nblk, int lane) {
    const int kb = item / nblk, nb = item % nblk, k0 = 64 * kb, s0 = 32 * nb;
    const int cm = colmap(which, s0 + (lane & 31));
    float tv[32];
#pragma unroll
    for (int i = 0; i < 32; ++i) { const int k = k0 + 2 * i + (lane >> 5); tv[i] = (cm >= 0 && k < Ksrc) ? __builtin_nontemporal_load(W + (size_t)k * ldw + cm) : 0.f; }
    if (kscale) {
#pragma unroll
        for (int i = 0; i < 32; ++i) { const int k = k0 + 2 * i + (lane >> 5); if (k < Ksrc) tv[i] *= kscale[k]; } }
#pragma unroll
    for (int i = 0; i < 32; ++i) scr[(2 * i + (lane >> 5)) * 33 + (lane & 31)] = tv[i];
    asm volatile("s_waitcnt lgkmcnt(0)" ::: "memory");
    const int c = lane & 7;
#pragma unroll
    for (int j = 0; j < 4; ++j) { const int n = (lane >> 3) + 8 * j; const LAS float* s = scr + (8 * c) * 33 + n;
        u32x4 o; o.x = cvt_pk_bf16(s[0 * 33], s[1 * 33]); o.y = cvt_pk_bf16(s[2 * 33], s[3 * 33]); o.z = cvt_pk_bf16(s[4 * 33], s[5 * 33]); o.w = cvt_pk_bf16(s[6 * 33], s[7 * 33]);
        *(u32x4*)(WT + (size_t)(s0 + n) * Kdst + k0 + 8 * c) = o; }
    asm volatile("s_waitcnt lgkmcnt(0)" ::: "memory");
}

constexpr int N_PHASES = 11;
#define OPAQUE_LANE(name) int name##_t = (int)threadIdx.x; asm volatile("" : "+v"(name##_t)); const int name = name##_t & 63

__global__ void __launch_bounds__(512, 2) mk_fwd(Args args) {
    extern __shared__ __attribute__((aligned(16))) unsigned char lds_raw[];
    LAS unsigned char* lds = (LAS unsigned char*)lds_raw;
    volatile LAS unsigned* MISC = (volatile LAS unsigned*)(lds + MISC_OFF);
    const int tid = threadIdx.x, lane = tid & 63, wave = __builtin_amdgcn_readfirstlane(tid >> 6);
    const int G = gridDim.x; const int bx = blockIdx.x; const int vcu = (G % 8 == 0) ? (bx % 8) * (G / 8) + bx / 8 : bx;
    const int gw = vcu * 8 + wave, NGW = G * 8;
    unsigned char* ws = args.ws;
    const float* x = args.in[0]; const float* cvec = args.in[1]; const int* pos = args.pos;
    const float* w_ada = args.in[3]; const float* b_ada = args.in[4]; const float* w_in = args.in[5];
    const float* qg = args.in[6]; const float* w_qup = args.in[7]; const float* kvg = args.in[8]; const float* w_kvup = args.in[9];
    const float* conv_w = args.in[10]; const float* conv_b = args.in[11]; const float* ong = args.in[12]; const float* w_out = args.in[13];
    const float* ln1g = args.in[14]; const float* ln1b = args.in[15]; const float* w_up = args.in[16];
    const float* fcw = args.in[17]; const float* fcb = args.in[18]; const float* w_down = args.in[19];
    const float* ln2g = args.in[20]; const float* ln2b = args.in[21];
    float* out = args.out;
    float* MOD = (float*)(ws + WS_MOD); float* ROPE = (float*)(ws + WS_ROPE); float* SSQQ = (float*)(ws + WS_SSQQ); float* SSQKV = (float*)(ws + WS_SSQKV);
    bf16_t* WIN = (bf16_t*)(ws + WS_WIN); bf16_t* WQ = (bf16_t*)(ws + WS_WQ); bf16_t* WKV = (bf16_t*)(ws + WS_WKV); bf16_t* WOUT = (bf16_t*)(ws + WS_WOUT);
    bf16_t* WUP = (bf16_t*)(ws + WS_WUP); bf16_t* WDN = (bf16_t*)(ws + WS_WDN);
    bf16_t* HB = (bf16_t*)(ws + WS_HB); bf16_t* FF = (bf16_t*)(ws + WS_FF); bf16_t* P = (bf16_t*)(ws + WS_P); bf16_t* MIX = (bf16_t*)(ws + WS_MIX);
    bf16_t* U = (bf16_t*)(ws + WS_U); bf16_t* Qb = (bf16_t*)(ws + WS_Q); bf16_t* KN = (bf16_t*)(ws + WS_KN); bf16_t* KR = (bf16_t*)(ws + WS_KR); bf16_t* Vb = (bf16_t*)(ws + WS_V);
    bf16_t* Y = (bf16_t*)(ws + WS_Y); bf16_t* X1 = (bf16_t*)(ws + WS_X1); bf16_t* ACT = (bf16_t*)(ws + WS_ACT); float* E = (float*)(ws + WS_E);

    for (int u = tid; u < (LDS_BYTES - LDSCTL_OFF) / 4; u += 512) ((LAS unsigned*)(lds + LDSCTL_OFF))[u] = 0u;
    __syncthreads();
    XcdBarrier bar; bar.bar = (unsigned*)(ws + WS_CTL) + CW_BAR; bar.x = 0; bar.st = nullptr;
    if (MK_N_LAUNCHES == 1) bar = xcd_barrier_post((unsigned*)(ws + WS_CTL) + CW_BAR, MISC + 8);
    const int lo = args.ph_lo, hi = args.ph_hi;
#ifndef PH_MASK
#define PH_MASK 0x7ff
#endif
#define IN(k) (((PH_MASK >> (k)) & 1) && lo <= (k) && (k) < hi)
#define SEAM(k) do { if (IN(k) && IN((k) + 1)) xcd_barrier(bar); } while (0)

    if (IN(0)) {
        OPAQUE_LANE(ln);
        if (bx < 192) {
            LAS float* cact = (LAS float*)lds; LAS float* part = (LAS float*)(lds + 65536);
            const int n0 = 32 * bx, c4 = tid & 7, kr = tid >> 3;
            f32x4 wv[16];
#pragma unroll
            for (int i = 0; i < 16; ++i) wv[i] = __builtin_nontemporal_load((const f32x4*)(w_ada + (size_t)(kr + 64 * i) * 6144 + n0 + 4 * c4));
            for (int i = tid; i < 16 * 1024; i += 512) { const float v = cvec[i]; cact[i] = v * frcp(1.f + fexp2(-LOG2E * v)); }
            __syncthreads();
            f32x4 a[16];
#pragma unroll
            for (int b = 0; b < 16; ++b) a[b] = (f32x4){0.f, 0.f, 0.f, 0.f};
#pragma unroll
            for (int i = 0; i < 16; ++i) { const int k = kr + 64 * i;
#pragma unroll
                for (int b = 0; b < 16; ++b) a[b] += wv[i] * cact[b * 1024 + k];
                if ((i & 1) == 1) asm volatile("" ::: "memory"); }
#pragma unroll
            for (int b = 0; b < 16; ++b)
#pragma unroll
                for (int e = 0; e < 4; ++e) { float v = a[b][e]; v += __shfl_xor(v, 8); v += __shfl_xor(v, 16); v += __shfl_xor(v, 32); a[b][e] = v; }
            if (ln < 8) {
#pragma unroll
                for (int b = 0; b < 16; ++b) *(LAS f32x4*)(part + (wave * 16 + b) * 32 + 4 * c4) = a[b]; }
            __syncthreads();
            { const int b = tid >> 5, col = tid & 31; float s = 0.f;
#pragma unroll
              for (int w8 = 0; w8 < 8; ++w8) s += part[(w8 * 16 + b) * 32 + col];
              MOD[b * 6144 + n0 + col] = s + b_ada[n0 + col]; }
            __syncthreads();
        }
        for (int idx = gw * 64 + ln; idx < T * 16; idx += NGW * 64) { const int t = idx >> 4, i = idx & 15; const float ang = (float)pos[t] * c_invfreq[i];
            ROPE[(size_t)t * 32 + i] = cosf(ang); ROPE[(size_t)t * 32 + 16 + i] = sinf(ang); }
    }
    SEAM(0);
    if (IN(1)) {
        OPAQUE_LANE(ln);
        {
        LAS float* scr = (LAS float*)(lds + wave * 16384);
        constexpr int I0 = 16 * 64, I1 = 4 * 24, I2 = 4 * 32, I3 = 16 * 32, I4 = 16 * 176, I5 = 44 * 32, NIT = I0 + I1 + I2 + I3 + I4 + I5;
        for (int it = gw; it < NIT; it += NGW) {
            int r = it;
            if (r < I0) { p0_transpose_item(w_in, INW, D, nullptr, WIN, D, 0, scr, r, 64, ln); continue; } r -= I0;
            if (r < I1) { p0_transpose_item(w_qup, QW, 256, qg, WQ, 256, 1, scr, r, 24, ln); continue; } r -= I1;
            if (r < I2) { p0_transpose_item(w_kvup, 1024, 128, kvg, WKV, 256, 2, scr, r, 32, ln); continue; } r -= I2;
            if (r < I3) { p0_transpose_item(w_out, D, D, nullptr, WOUT, D, 3, scr, r, 32, ln); continue; } r -= I3;
            if (r < I4) { p0_transpose_item(w_up, UPW, D, nullptr, WUP, D, 4, scr, r, 176, ln); continue; } r -= I4;
            p0_transpose_item(w_down, D, DFF, nullptr, WDN, DFF, 5, scr, r, 32, ln);
        }
            }
        for (int row0 = gw * 16; row0 < T; row0 += NGW * 16) { const int b = row0 / SEQ; const float* mb = MOD + b * 6144;
            f32x4 sc[4], sh[4];
#pragma unroll
            for (int j = 0; j < 4; ++j) { const int col = 4 * ln + 256 * j; sh[j] = *(const f32x4*)(mb + col); sc[j] = *(const f32x4*)(mb + 1024 + col) + 1.f; }
            for (int rr = 0; rr < 16; ++rr) { const int t = row0 + rr; const float* xr = x + (size_t)t * D;
                f32x4 v[4]; float s = 0.f;
#pragma unroll
                for (int j = 0; j < 4; ++j) { v[j] = __builtin_nontemporal_load((const f32x4*)(xr + 4 * ln + 256 * j)); s += (v[j][0] + v[j][1]) + (v[j][2] + v[j][3]); }
                const float mean = wave_sum(s) * (1.f / D); float q = 0.f;
#pragma unroll
                for (int j = 0; j < 4; ++j) { v[j] = v[j] - mean; q += (v[j][0] * v[j][0] + v[j][1] * v[j][1]) + (v[j][2] * v[j][2] + v[j][3] * v[j][3]); }
                const float rstd = rsqrtf(wave_sum(q) * (1.f / D) + 1e-5f);
#pragma unroll
                for (int j = 0; j < 4; ++j) { const f32x4 o = v[j] * rstd * sc[j] + sh[j]; u32x2 w; w.x = cvt_pk_bf16(o[0], o[1]); w.y = cvt_pk_bf16(o[2], o[3]);
                    *(u32x2*)(HB + (size_t)t * D + 4 * ln + 256 * j) = w; } } }
    }
    SEAM(1);
    if (IN(2)) {
        pg8::Gemm g{HB, D, WIN, T, 512, D}; pg8::StaticOrder S; S.init(T, 512, G, bx);
        pg8::EpiP E1{P, U, SSQQ, SSQKV};
        pg8::gemm_phase<pg8::EpiP, true>(lds, g, S, E1);
    }
    SEAM(2);
    if (IN(3)) {
        OPAQUE_LANE(ln);
        for (int row0 = gw * 16; row0 < T; row0 += NGW * 16) {
            { const int t = row0 + (ln >> 2), c = ln & 3, i0 = 8 * (c & 1); const bf16_t* pr = P + (size_t)t * PW + 384;
              const u32x4 r1 = *(const u32x4*)(pr + i0), r2 = *(const u32x4*)(pr + 16 + i0);
              const f32x4 ca = *(const f32x4*)(ROPE + (size_t)t * 32 + i0), cb = *(const f32x4*)(ROPE + (size_t)t * 32 + i0 + 4), sa = *(const f32x4*)(ROPE + (size_t)t * 32 + 16 + i0), sb = *(const f32x4*)(ROPE + (size_t)t * 32 + 16 + i0 + 4);
              float ov[8];
#pragma unroll
              for (int e = 0; e < 8; ++e) { const float x1 = (e & 1) ? bf_hi(r1[e >> 1]) : bf_lo(r1[e >> 1]), x2 = (e & 1) ? bf_hi(r2[e >> 1]) : bf_lo(r2[e >> 1]);
                  const float cs = (e < 4) ? ca[e & 3] : cb[e & 3], sn = (e < 4) ? sa[e & 3] : sb[e & 3];
                  ov[e] = (c < 2) ? x1 * cs - x2 * sn : x2 * cs + x1 * sn; }
              u32x4 o; o.x = cvt_pk_bf16(ov[0], ov[1]); o.y = cvt_pk_bf16(ov[2], ov[3]); o.z = cvt_pk_bf16(ov[4], ov[5]); o.w = cvt_pk_bf16(ov[6], ov[7]);
              *(u32x4*)((char*)KR + (size_t)(t >> 6) * 4096 + c * 1024 + (t & 63) * 16) = o; }
        }
        { pg8::MixedOrder S{(const char*)HB, (const char*)P, (const char*)WIN, (const char*)WQ, (const char*)WKV, G, bx};
          pg8::EpiMix EM{pg8::EpiP{P, U, SSQQ, SSQKV}, pg8::EpiStore{Qb, QW, true}, pg8::EpiKV{KN, Vb}, SSQKV};
          pg8::gemm_multi<pg8::MixedOrder, pg8::EpiMix>(lds, S, EM); }
    }
    SEAM(3);
    if (IN(4)) {
        att::attn_phase(vcu, G, SSQQ, ROPE, Qb, KN, KR, Vb, Y, ong, lds);
        { OPAQUE_LANE(ln);
        for (int row0 = gw * 16; row0 < T; row0 += NGW * 16) {
            const int c0 = 8 * ln;
            float w0[8], w1[8], w2[8], cb8[8], gn[8];
#pragma unroll
            for (int e = 0; e < 8; ++e) { w0[e] = conv_w[c0 + e]; w1[e] = conv_w[512 + c0 + e]; w2[e] = conv_w[1024 + c0 + e]; cb8[e] = conv_b[c0 + e]; gn[e] = ong[512 + c0 + e]; }
            float um2[8], um1[8];
#pragma unroll
            for (int e = 0; e < 8; ++e) { um2[e] = 0.f; um1[e] = 0.f; }
            if ((row0 % SEQ) != 0) {
                const u32x4 a2 = *(const u32x4*)(U + (size_t)(row0 - 2) * 512 + c0), a1 = *(const u32x4*)(U + (size_t)(row0 - 1) * 512 + c0);
#pragma unroll
                for (int e = 0; e < 4; ++e) { um2[2 * e] = bf_lo(a2[e]); um2[2 * e + 1] = bf_hi(a2[e]); um1[2 * e] = bf_lo(a1[e]); um1[2 * e + 1] = bf_hi(a1[e]); }
            }
            for (int rr = 0; rr < 16; ++rr) { const int t = row0 + rr;
                const u32x4 gb = __builtin_nontemporal_load((const u32x4*)(P + (size_t)t * PW + 512 + c0)), uu = __builtin_nontemporal_load((const u32x4*)(U + (size_t)t * 512 + c0));
                float u0[8], yv[8]; float ss = 0.f;
#pragma unroll
                for (int e = 0; e < 4; ++e) { u0[2 * e] = bf_lo(uu[e]); u0[2 * e + 1] = bf_hi(uu[e]); }
#pragma unroll
                for (int e = 0; e < 8; ++e) { const float gbe = (e & 1) ? bf_hi(gb[e >> 1]) : bf_lo(gb[e >> 1]);
                    yv[e] = gbe * (cb8[e] + w0[e] * um2[e] + w1[e] * um1[e] + w2[e] * u0[e]); ss += yv[e] * yv[e]; um2[e] = um1[e]; um1[e] = u0[e]; }
                ss += __shfl_xor(ss, 1); ss += __shfl_xor(ss, 2); ss += __shfl_xor(ss, 4);
                const float rs = rsqrtf(ss * (1.f / 64.f) + 1e-6f);
                u32x4 o; o.x = cvt_pk_bf16(yv[0] * rs * gn[0], yv[1] * rs * gn[1]); o.y = cvt_pk_bf16(yv[2] * rs * gn[2], yv[3] * rs * gn[3]);
                o.z = cvt_pk_bf16(yv[4] * rs * gn[4], yv[5] * rs * gn[5]); o.w = cvt_pk_bf16(yv[6] * rs * gn[6], yv[7] * rs * gn[7]);
                *(u32x4*)(Y + (size_t)t * D + 512 + c0) = o; }
        }
            }
    }
    SEAM(4);
    if (IN(5)) {
        pg8::Gemm g{Y, D, WOUT, T, D, D}; pg8::StaticOrder S; S.init(T, D, G, bx); pg8::EpiStore E4{MIX, D, true};
        pg8::gemm_phase<pg8::EpiStore, true>(lds, g, S, E4);
    }
    SEAM(5);
    if (IN(6)) {
        OPAQUE_LANE(ln);
        for (int row0 = gw * 16; row0 < T; row0 += NGW * 16) { const int b = row0 / SEQ; const float* mb = MOD + b * 6144;
            f32x4 gt[4], g1v[4], b1v[4], sc[4], sh[4];
#pragma unroll
            for (int j = 0; j < 4; ++j) { const int col = 4 * ln + 256 * j; gt[j] = *(const f32x4*)(mb + 2048 + col); g1v[j] = *(const f32x4*)(ln1g + col); b1v[j] = *(const f32x4*)(ln1b + col);
                sh[j] = *(const f32x4*)(mb + 3072 + col); sc[j] = *(const f32x4*)(mb + 4096 + col) + 1.f; }
            for (int rr = 0; rr < 16; ++rr) { const int t = row0 + rr;
                f32x4 v[4]; float s = 0.f;
#pragma unroll
                for (int j = 0; j < 4; ++j) { const int col = 4 * ln + 256 * j; const f32x4 xv = __builtin_nontemporal_load((const f32x4*)(x + (size_t)t * D + col)); const u32x2 mw = __builtin_nontemporal_load((const u32x2*)(MIX + (size_t)t * D + col));
                    const f32x4 mx = {bf_lo(mw.x), bf_hi(mw.x), bf_lo(mw.y), bf_hi(mw.y)};
                    v[j] = xv * ALPHA + gt[j] * mx; s += (v[j][0] + v[j][1]) + (v[j][2] + v[j][3]); }
                float mean = wave_sum(s) * (1.f / D); float q = 0.f;
#pragma unroll
                for (int j = 0; j < 4; ++j) { v[j] = v[j] - mean; q += (v[j][0] * v[j][0] + v[j][1] * v[j][1]) + (v[j][2] * v[j][2] + v[j][3] * v[j][3]); }
                float rstd = rsqrtf(wave_sum(q) * (1.f / D) + 1e-5f);
                s = 0.f;
#pragma unroll
                for (int j = 0; j < 4; ++j) { v[j] = v[j] * rstd * g1v[j] + b1v[j]; u32x2 w; w.x = cvt_pk_bf16(v[j][0], v[j][1]); w.y = cvt_pk_bf16(v[j][2], v[j][3]); __builtin_nontemporal_store(w, (u32x2*)(X1 + (size_t)t * D + 4 * ln + 256 * j)); s += (v[j][0] + v[j][1]) + (v[j][2] + v[j][3]); }
                mean = wave_sum(s) * (1.f / D); q = 0.f;
#pragma unroll
                for (int j = 0; j < 4; ++j) { v[j] = v[j] - mean; q += (v[j][0] * v[j][0] + v[j][1] * v[j][1]) + (v[j][2] * v[j][2] + v[j][3] * v[j][3]); }
                rstd = rsqrtf(wave_sum(q) * (1.f / D) + 1e-5f);
#pragma unroll
                for (int j = 0; j < 4; ++j) { const f32x4 o = v[j] * rstd * sc[j] + sh[j]; u32x2 w; w.x = cvt_pk_bf16(o[0], o[1]); w.y = cvt_pk_bf16(o[2], o[3]);
                    *(u32x2*)(HB + (size_t)t * D + 4 * ln + 256 * j) = w; } } }
    }
    SEAM(6);
    if (IN(7)) {
        pg8::Gemm g{HB, D, WUP, T, UPW, D}; pg8::StaticOrder S; S.init(T, UPW, G, bx); pg8::EpiUp E5{ACT, E, fcw, fcb};
        pg8::gemm_phase<pg8::EpiUp, true>(lds, g, S, E5);
    }
    SEAM(7);
    if (IN(8)) {
        OPAQUE_LANE(ln);
        constexpr int NITEM = 512 * 2 * (DFF / 4);
        for (int it = (gw * 64 + ln); it < NITEM; it += NGW * 64) { const int c4 = it % (DFF / 4), rb = it / (DFF / 4), rr = rb & 1, blk = rb >> 1; const int c0 = 4 * c4;
            const bool first = (blk & 31) == 0;
            const float* e0 = E + ((size_t)blk * 4 + rr) * UPW + c0;
            const float* em1 = (rr == 0) ? E + ((size_t)(blk - 1) * 4 + 3) * UPW + c0 : E + ((size_t)blk * 4 + 0) * UPW + c0;
            const float* em2 = (rr == 0) ? E + ((size_t)(blk - 1) * 4 + 2) * UPW + c0 : E + ((size_t)(blk - 1) * 4 + 3) * UPW + c0;
            const f32x4 z = {0.f, 0.f, 0.f, 0.f};
            const f32x4 g0 = *(const f32x4*)e0, v0 = *(const f32x4*)(e0 + DFF);
            const bool has1 = !(first && rr == 0), has2 = !first;
            const f32x4 g1 = has1 ? *(const f32x4*)em1 : z, v1 = has1 ? *(const f32x4*)(em1 + DFF) : z;
            const f32x4 g2 = has2 ? *(const f32x4*)em2 : z, v2 = has2 ? *(const f32x4*)(em2 + DFF) : z;
            const f32x4 wg0 = *(const f32x4*)(fcw + c0), wg1 = *(const f32x4*)(fcw + UPW + c0), wg2 = *(const f32x4*)(fcw + 2 * UPW + c0), bg = *(const f32x4*)(fcb + c0);
            const f32x4 wv0 = *(const f32x4*)(fcw + DFF + c0), wv1 = *(const f32x4*)(fcw + UPW + DFF + c0), wv2 = *(const f32x4*)(fcw + 2 * UPW + DFF + c0), bv = *(const f32x4*)(fcb + DFF + c0);
            const f32x4 cg = bg + wg0 * g2 + wg1 * g1 + wg2 * g0, cv = bv + wv0 * v2 + wv1 * v1 + wv2 * v0;
            u32x2 w; w.x = cvt_pk_bf16(silu_f(cg[0]) * cv[0], silu_f(cg[1]) * cv[1]); w.y = cvt_pk_bf16(silu_f(cg[2]) * cv[2], silu_f(cg[3]) * cv[3]);
            *(u32x2*)(ACT + (size_t)(64 * blk + rr) * DFF + c0) = w; }
    }
    SEAM(8);
    if (IN(9)) {
        pg8::Gemm g{ACT, DFF, WDN, T, D, DFF}; pg8::StaticOrder S; S.init(T, D, G, bx); pg8::EpiStore E6{FF, D, true};
        pg8::gemm_phase<pg8::EpiStore, true>(lds, g, S, E6);
    }
    SEAM(9);
    if (IN(10)) {
        OPAQUE_LANE(ln);
        for (int row0 = gw * 16; row0 < T; row0 += NGW * 16) { const int b = row0 / SEQ; const float* mb = MOD + b * 6144;
            f32x4 gt[4], g2v[4], b2v[4];
#pragma unroll
            for (int j = 0; j < 4; ++j) { const int col = 4 * ln + 256 * j; gt[j] = *(const f32x4*)(mb + 5120 + col); g2v[j] = *(const f32x4*)(ln2g + col); b2v[j] = *(const f32x4*)(ln2b + col); }
            for (int rr = 0; rr < 16; ++rr) { const int t = row0 + rr;
                f32x4 v[4]; float s = 0.f;
#pragma unroll
                for (int j = 0; j < 4; ++j) { const int col = 4 * ln + 256 * j; const u32x2 xw = __builtin_nontemporal_load((const u32x2*)(X1 + (size_t)t * D + col)); const f32x4 xv = {bf_lo(xw.x), bf_hi(xw.x), bf_lo(xw.y), bf_hi(xw.y)}; const u32x2 mw = __builtin_nontemporal_load((const u32x2*)(FF + (size_t)t * D + col));
                    const f32x4 mx = {bf_lo(mw.x), bf_hi(mw.x), bf_lo(mw.y), bf_hi(mw.y)};
                    v[j] = xv * ALPHA + gt[j] * mx; s += (v[j][0] + v[j][1]) + (v[j][2] + v[j][3]); }
                const float mean = wave_sum(s) * (1.f / D); float q = 0.f;
#pragma unroll
                for (int j = 0; j < 4; ++j) { v[j] = v[j] - mean; q += (v[j][0] * v[j][0] + v[j][1] * v[j][1]) + (v[j][2] * v[j][2] + v[j][3] * v[j][3]); }
                const float rstd = rsqrtf(wave_sum(q) * (1.f / D) + 1e-5f);
#pragma unroll
                for (int j = 0; j < 4; ++j) { *(f32x4*)(out + (size_t)t * D + 4 * ln + 256 * j) = v[j] * rstd * g2v[j] + b2v[j]; } } }
    }
#undef IN
#undef SEAM
}

extern "C" void kernel_launch(void* const* d_in, const int* in_sizes, int n_in, void* d_out, int out_size, void* d_ws, size_t ws_size, hipStream_t stream) {
    static int grid = 0;
    if (grid == 0) {
        if (n_in != 22 || in_sizes[0] != T * D || out_size != T * D || ws_size < WS_END) { fprintf(stderr, "kernel_launch: unexpected shapes / workspace (n_in %d, ws %zu)\n", n_in, ws_size); grid = -1; return; }
        int dev = 0, cus = 0, per_cu = 0;
        if (hipGetDevice(&dev) != hipSuccess || hipDeviceGetAttribute(&cus, hipDeviceAttributeMultiprocessorCount, dev) != hipSuccess) { grid = -1; return; }
        if (hipFuncSetAttribute((const void*)mk_fwd, hipFuncAttributeMaxDynamicSharedMemorySize, LDS_BYTES) != hipSuccess) { fprintf(stderr, "kernel_launch: hipFuncSetAttribute failed\n"); grid = -1; return; }
        if (hipOccupancyMaxActiveBlocksPerMultiprocessor(&per_cu, (const void*)mk_fwd, 512, LDS_BYTES) != hipSuccess || per_cu < 1) { fprintf(stderr, "kernel_launch: occupancy query says %d blocks per CU\n", per_cu); (void)hipGetLastError(); grid = -1; return; }
        grid = cus;
    }
    if (grid < 0) return;
    hipMemsetAsync((char*)d_ws + WS_CTL, 0, CTL_ZERO_BYTES, stream);
    Args a{};
    for (int i = 0; i < 22; ++i) a.in[i] = (const float*)d_in[i];
    a.pos = (const int*)d_in[2]; a.out = (float*)d_out; a.ws = (unsigned char*)d_ws;
#if MK_N_LAUNCHES == 1
    a.ph_lo = 0; a.ph_hi = N_PHASES;
    hipLaunchKernelGGL(mk_fwd, dim3(grid), dim3(512), LDS_BYTES, stream, a);
#else
    for (int p = 0; p < N_PHASES; ++p) { a.ph_lo = p; a.ph_hi = p + 1; hipLaunchKernelGGL(mk_fwd, dim3(grid), dim3(512), LDS_BYTES, stream, a); }
#endif
}
```

```cpp
#include <hip/hip_runtime.h>
#include <cstdio>
#include <cstdint>

#define LAS __attribute__((address_space(3)))
#define GAS __attribute__((address_space(1)))
typedef unsigned short bf16_t;
typedef short bf16x8 __attribute__((ext_vector_type(8)));
typedef short s16x4 __attribute__((ext_vector_type(4)));
typedef float f32x4 __attribute__((ext_vector_type(4)));
typedef float f32x2 __attribute__((ext_vector_type(2)));
typedef float f32x16 __attribute__((ext_vector_type(16)));
typedef unsigned u32x4 __attribute__((ext_vector_type(4)));
typedef unsigned u32x2 __attribute__((ext_vector_type(2)));
typedef GAS unsigned gu32;

#ifndef MK_N_LAUNCHES
#define MK_N_LAUNCHES 1
#endif

constexpr int D = 1024, NB = 16, SEQ = 2048, T = NB * SEQ, NH = 8, DFF = 2816, UPW = 2 * DFF;
constexpr int PW = 1024;
constexpr int G1N = 2048;
constexpr int QW = 768, INW = 1952;
constexpr float ALPHA = 1.189207115002721f;
constexpr float QSCALE = 0.10206207261596575f * 1.4426950408889634f;
constexpr float LOG2E = 1.4426950408889634f;

constexpr size_t MiB = 1u << 20;
constexpr size_t WS_CTL = 0, CTL_ZERO_BYTES = 64 * 1024;
constexpr size_t WS_MOD = 1 * MiB;
constexpr size_t WS_ROPE = 2 * MiB;
constexpr size_t WS_SSQQ = 6 * MiB;
constexpr size_t WS_SSQKV = 6 * MiB + 512 * 1024;
constexpr size_t WS_WIN = 8 * MiB;
constexpr size_t WS_WQ = 12 * MiB;
constexpr size_t WS_WKV = 12 * MiB + 512 * 1024;
constexpr size_t WS_WOUT = 13 * MiB;
constexpr size_t WS_WUP = 15 * MiB;
constexpr size_t WS_WDN = 26 * MiB;
constexpr size_t WS_HB = 32 * MiB;
constexpr size_t WS_FF = 32 * MiB;
constexpr size_t WS_P = 96 * MiB;
constexpr size_t WS_U = 160 * MiB;
constexpr size_t WS_MIX = 96 * MiB;
constexpr size_t WS_Q = 224 * MiB;
constexpr size_t WS_KN = 272 * MiB;
constexpr size_t WS_KR = 304 * MiB;
constexpr size_t WS_V = 306 * MiB;
constexpr size_t WS_Y = 338 * MiB;
constexpr size_t WS_X1 = 338 * MiB;
constexpr size_t WS_ACT = 96 * MiB;
constexpr size_t WS_E = 272 * MiB;
constexpr size_t WS_END = 402 * MiB;
constexpr int CW_BAR = 1024;

constexpr int RING_BYTES = 131072, LDSCTL_OFF = RING_BYTES, MISC_OFF = LDSCTL_OFF + 320, LDS_BYTES = 147456;

__device__ __forceinline__ unsigned cvt_pk_bf16(float lo, float hi) { unsigned r; asm volatile("v_cvt_pk_bf16_f32 %0, %1, %2" : "=v"(r) : "v"(lo), "v"(hi)); return r; }
__device__ __forceinline__ float bf_lo(unsigned u) { return __uint_as_float(u << 16); }
__device__ __forceinline__ float bf_hi(unsigned u) { return __uint_as_float(u & 0xffff0000u); }
__device__ __forceinline__ float fexp2(float x) { return __builtin_amdgcn_exp2f(x); }
__device__ __forceinline__ float frcp(float x) { return __builtin_amdgcn_rcpf(x); }
__device__ __forceinline__ float silu_f(float v) { return v * frcp(1.f + fexp2(-LOG2E * v)); }
__device__ __forceinline__ float wave_sum(float v) {
#pragma unroll
    for (int o = 1; o < 64; o <<= 1) v += __shfl_xor(v, o);
    return v;
}

namespace pg8 {
constexpr int BM = 256, BK = 64, HALF = 128, HTB = HALF * BK * 2, STAGE_BYTES = 8 * HTB, NXCD = 8, WGM = 8;
__host__ __device__ __forceinline__ int lds_byte(int r, int c) { const int st = (r >> 4) * 2 + (c >> 5), rr = r & 15, cc = c & 31, ob = rr * 64 + cc * 2; return st * 1024 + (ob ^ (((ob >> 9) & 1) << 5)); }
__host__ __device__ __forceinline__ void stage_rc(int b, int& R, int& C) { const int st = b / 1024, sb = b % 1024, swz = sb ^ (((sb >> 9) & 1) << 5); R = (st >> 1) * 16 + swz / 64; C = (st & 1) * 32 + (swz % 64) / 2; }
__host__ __device__ __forceinline__ int perm32(int rho) { const int n = rho >> 4, i = rho & 15; return 8 * (i >> 2) + 4 * n + (i & 3); }

struct Unit { int pm, pn; };
struct Gemm { const bf16_t* A; int lda; const bf16_t* Bt; int M, N, K; };

struct StaticOrder {
    int nM, nN, nwg, G, c;
    __device__ __forceinline__ void init(int M, int N, int G_, int c_) { nM = M / BM; nN = N / BM; nwg = nM * nN; G = G_; c = c_; }
    __device__ __forceinline__ bool next(int i, Unit& u) const {
        const long L = (long)i * G + c; if (L >= nwg) return false;
        int wgid = (int)L; { const int q = nwg / NXCD, r = nwg % NXCD, xcd = wgid % NXCD, off = wgid / NXCD; wgid = (xcd < r ? xcd * (q + 1) : r * (q + 1) + (xcd - r) * q) + off; }
        const int nig = WGM * nN, gid = wgid / nig, fm = gid * WGM, gsz = (nM - fm) < WGM ? (nM - fm) : WGM;
        u.pm = fm + ((wgid % nig) % gsz); u.pn = (wgid % nig) / gsz; return true;
    }
};

template <class Epi, bool ALIGN_EPI>
__device__ __forceinline__ void gemm_phase(LAS unsigned char* lds, const Gemm g, const StaticOrder& S, const Epi& E) {
    int tid = threadIdx.x; asm volatile("" : "+v"(tid));
    const int wid = __builtin_amdgcn_readfirstlane(tid >> 6), lane = tid & 63, wr = wid >> 2, wc = wid & 3, fr = lane & 15, fq = lane >> 4;
    const int K = g.K, nt = K / BK;
    unsigned voffA[2], voffB[2];
#pragma unroll
    for (int i = 0; i < 2; ++i) { int R, C; stage_rc(tid * 16 + i * 8192, R, C);
        voffA[i] = (unsigned)(R * g.lda + C) * 2u; voffB[i] = (unsigned)(R * K + C) * 2u; }
    const size_t kstep = (size_t)(BK * 2);
    const size_t hstepA = (size_t)HALF * g.lda * 2, hstepB = (size_t)HALF * K * 2;
    const size_t tstepA = 2 * hstepA, tstepB = 2 * hstepB;
    const unsigned ldsw = (unsigned)wid * 1024u;
    const int aoff = lds_byte(wr * 64 + fr, fq * 8), boff = lds_byte(wc * 32 + fr, fq * 8);
#define PG8_SA(b, h) (((b) * 2 + (h)) * HTB)
#define PG8_SB(b, h) ((4 + (b) * 2 + (h)) * HTB)
#define PG8_STAGE(bufoff, gbase, voff) do { _Pragma("unroll") for (int _i = 0; _i < 2; ++_i) \
        __builtin_amdgcn_global_load_lds((const unsigned*)((const char*)(gbase) + (voff)[_i]), (LAS unsigned*)(lds + (bufoff) + ldsw + _i * 8192), 16, 0, 0); } while (0)
#define PG8_LDA(dst, b, h) do { _Pragma("unroll") for (int m = 0; m < 4; ++m) _Pragma("unroll") for (int k = 0; k < 2; ++k) dst[m][k] = *(const LAS bf16x8*)(lds + PG8_SA(b, h) + aoff + m * 2048 + k * 1024); } while (0)
#define PG8_LDB(dst, b, h) do { _Pragma("unroll") for (int n = 0; n < 2; ++n) _Pragma("unroll") for (int k = 0; k < 2; ++k) dst[n][k] = *(const LAS bf16x8*)(lds + PG8_SB(b, h) + boff + n * 2048 + k * 1024); } while (0)
#define PG8_MMA(ai, bj, At, Bt) do { __builtin_amdgcn_s_setprio(1); _Pragma("unroll") for (int m = 0; m < 4; ++m) _Pragma("unroll") for (int n = 0; n < 2; ++n) _Pragma("unroll") for (int k = 0; k < 2; ++k) \
        acc[ai][bj][m][n] = __builtin_amdgcn_mfma_f32_16x16x32_bf16(Bt[n][k], At[m][k], acc[ai][bj][m][n], 0, 0, 0); __builtin_amdgcn_s_setprio(0); } while (0)
#define PG8_WAIT_V(n) asm volatile("s_waitcnt vmcnt(" #n ")" ::: "memory")
#define PG8_WAIT_L(n) asm volatile("s_waitcnt lgkmcnt(" #n ")" ::: "memory")
#define PG8_BAR __builtin_amdgcn_s_barrier()
#define PG8_SCHED __builtin_amdgcn_sched_barrier(0)
    Unit cur, nxt; int ui = 0;
    if (!S.next(0, cur)) return;
    f32x4 acc[2][2][4][2];
#pragma unroll
    for (int a = 0; a < 2; ++a)
#pragma unroll
        for (int b = 0; b < 2; ++b)
#pragma unroll
            for (int m = 0; m < 4; ++m)
#pragma unroll
                for (int n = 0; n < 2; ++n) acc[a][b][m][n] = (f32x4){0.f, 0.f, 0.f, 0.f};
    bf16x8 At[4][2], B0[2][2], B1[2][2];
    const char* cA = (const char*)g.A + (size_t)cur.pm * tstepA; const char* cB = (const char*)g.Bt + (size_t)cur.pn * tstepB;
    if constexpr (Epi::HAS_PREFETCH) E.prefetch(cur, 0, lds, wid, lane);
    PG8_STAGE(PG8_SB(0, 0), cB, voffB); PG8_STAGE(PG8_SB(0, 1), cB + hstepB, voffB); PG8_STAGE(PG8_SA(0, 0), cA, voffA); PG8_STAGE(PG8_SA(0, 1), cA + hstepA, voffA);
    if (wr == 1) PG8_BAR;
    PG8_WAIT_V(2); PG8_BAR;
    PG8_STAGE(PG8_SB(1, 0), cB + kstep, voffB); PG8_STAGE(PG8_SA(1, 0), cA + kstep, voffA); PG8_STAGE(PG8_SB(1, 1), cB + hstepB + kstep, voffB);
    PG8_WAIT_V(6); PG8_BAR;
    for (;;) {
        const bool has_next = S.next(ui + 1, nxt);
        const char* nA = has_next ? (const char*)g.A + (size_t)nxt.pm * tstepA : cA; const char* nB = has_next ? (const char*)g.Bt + (size_t)nxt.pn * tstepB : cB;
#pragma nounroll
        for (int t = 0; t < nt; t += 2) {
            const bool last = (t == nt - 2);
            const char* a1 = cA + (size_t)(t + 1) * kstep;
            const char* a2 = last ? nA : cA + (size_t)(t + 2) * kstep; const char* b2 = last ? nB : cB + (size_t)(t + 2) * kstep;
            const char* a3 = a2 + kstep; const char* b3 = b2 + kstep;
            const bool rlx = (Epi::NST > 0) && (t == 0) && (ui > 0);
            PG8_LDB(B0, 0, 0); PG8_LDB(B1, 0, 1); PG8_SCHED; PG8_LDA(At, 0, 0); PG8_STAGE(PG8_SA(1, 1), a1 + hstepA, voffA);
            if (rlx) { if constexpr (Epi::NST >= 16) PG8_WAIT_V(24); else PG8_WAIT_V(16); } else PG8_WAIT_V(8);
            PG8_WAIT_L(0); PG8_BAR; PG8_MMA(0, 0, At, B0); PG8_MMA(0, 1, At, B1); PG8_BAR; PG8_SCHED;
            PG8_LDA(At, 0, 1); PG8_STAGE(PG8_SB(0, 0), b2, voffB); PG8_STAGE(PG8_SB(0, 1), b2 + hstepB, voffB); PG8_STAGE(PG8_SA(0, 0), a2, voffA);
            if (rlx) { if constexpr (Epi::NST >= 16) PG8_WAIT_V(24); else PG8_WAIT_V(16); } else PG8_WAIT_V(8);
            PG8_WAIT_L(0); PG8_BAR; PG8_MMA(1, 0, At, B0); PG8_MMA(1, 1, At, B1); PG8_BAR; PG8_SCHED;
            PG8_LDB(B0, 1, 0); PG8_LDB(B1, 1, 1); PG8_SCHED; PG8_LDA(At, 1, 0); PG8_STAGE(PG8_SA(0, 1), a2 + hstepA, voffA);
            PG8_WAIT_V(8); PG8_WAIT_L(0); PG8_BAR; PG8_MMA(0, 0, At, B0); PG8_MMA(0, 1, At, B1); PG8_BAR; PG8_SCHED;
            PG8_LDA(At, 1, 1); PG8_STAGE(PG8_SB(1, 0), b3, voffB); PG8_STAGE(PG8_SB(1, 1), b3 + hstepB, voffB); PG8_STAGE(PG8_SA(1, 0), a3, voffA);
            PG8_WAIT_V(8); PG8_WAIT_L(0); PG8_BAR; PG8_MMA(1, 0, At, B0); PG8_MMA(1, 1, At, B1); PG8_BAR; PG8_SCHED;
        }
        if constexpr (ALIGN_EPI) { if (wr == 0) PG8_BAR; }
        { int t_e = threadIdx.x; asm volatile("" : "+v"(t_e)); const int fr_e = t_e & 15, fq_e = (t_e >> 4) & 3;
          if constexpr (Epi::HAS_PREFETCH) { if (has_next) E.prefetch(nxt, (ui + 1) & 1, lds, wid, t_e & 63); E.run(acc, cur, wr, wc, fr_e, fq_e, lds, ui & 1); }
          else E(acc, cur, wr, wc, fr_e, fq_e); }
        if (!has_next) break;
#pragma unroll
        for (int a = 0; a < 2; ++a)
#pragma unroll
            for (int b = 0; b < 2; ++b)
#pragma unroll
                for (int m = 0; m < 4; ++m)
#pragma unroll
                    for (int n = 0; n < 2; ++n) acc[a][b][m][n] = (f32x4){0.f, 0.f, 0.f, 0.f};
        cur = nxt; cA = nA; cB = nB; ++ui;
        if constexpr (ALIGN_EPI) { if (wr == 1) PG8_BAR; }
    }
    PG8_WAIT_V(0);
    if constexpr (!ALIGN_EPI) { if (wr == 0) PG8_BAR; }
    PG8_BAR;
#undef PG8_SA
#undef PG8_SB
#undef PG8_STAGE
#undef PG8_LDA
#undef PG8_LDB
#undef PG8_MMA
#undef PG8_WAIT_V
#undef PG8_WAIT_L
#undef PG8_BAR
#undef PG8_SCHED
}

struct MUnit { const char* A; const char* B; int nt; unsigned kb2; int type; Unit u; };
template <class Sched, class Disp>
__device__ __forceinline__ void gemm_multi(LAS unsigned char* lds, const Sched& S, const Disp& E) {
    int tid = threadIdx.x; asm volatile("" : "+v"(tid));
    const int wid = __builtin_amdgcn_readfirstlane(tid >> 6), lane = tid & 63, wr = wid >> 2, wc = wid & 3, fr = lane & 15, fq = lane >> 4;
    unsigned voffA[2], rB[2], cB2[2];
#pragma unroll
    for (int i = 0; i < 2; ++i) { int R, C; stage_rc(tid * 16 + i * 8192, R, C); voffA[i] = (unsigned)(R * 1024 + C) * 2u; rB[i] = (unsigned)R; cB2[i] = (unsigned)C * 2u; }
    const size_t kstep = (size_t)(BK * 2);
    const size_t hstepA = (size_t)HALF * 1024 * 2;
    const unsigned ldsw = (unsigned)wid * 1024u;
    const int aoff = lds_byte(wr * 64 + fr, fq * 8), boff = lds_byte(wc * 32 + fr, fq * 8);
#define PG8_SA(b, h) (((b) * 2 + (h)) * HTB)
#define PG8_SB(b, h) ((4 + (b) * 2 + (h)) * HTB)
#define PG8_STAGE(bufoff, gbase, voff) do { _Pragma("unroll") for (int _i = 0; _i < 2; ++_i) \
        __builtin_amdgcn_global_load_lds((const unsigned*)((const char*)(gbase) + (voff)[_i]), (LAS unsigned*)(lds + (bufoff) + ldsw + _i * 8192), 16, 0, 0); } while (0)
#define PG8_LDA(dst, b, h) do { _Pragma("unroll") for (int m = 0; m < 4; ++m) _Pragma("unroll") for (int k = 0; k < 2; ++k) dst[m][k] = *(const LAS bf16x8*)(lds + PG8_SA(b, h) + aoff + m * 2048 + k * 1024); } while (0)
#define PG8_LDB(dst, b, h) do { _Pragma("unroll") for (int n = 0; n < 2; ++n) _Pragma("unroll") for (int k = 0; k < 2; ++k) dst[n][k] = *(const LAS bf16x8*)(lds + PG8_SB(b, h) + boff + n * 2048 + k * 1024); } while (0)
#define PG8_MMA(ai, bj, At, Bt) do { __builtin_amdgcn_s_setprio(1); _Pragma("unroll") for (int m = 0; m < 4; ++m) _Pragma("unroll") for (int n = 0; n < 2; ++n) _Pragma("unroll") for (int k = 0; k < 2; ++k) \
        acc[ai][bj][m][n] = __builtin_amdgcn_mfma_f32_16x16x32_bf16(Bt[n][k], At[m][k], acc[ai][bj][m][n], 0, 0, 0); __builtin_amdgcn_s_setprio(0); } while (0)
#define PG8_WAIT_V(n) asm volatile("s_waitcnt vmcnt(" #n ")" ::: "memory")
#define PG8_WAIT_L(n) asm volatile("s_waitcnt lgkmcnt(" #n ")" ::: "memory")
#define PG8_BAR __builtin_amdgcn_s_barrier()
#define PG8_SCHED __builtin_amdgcn_sched_barrier(0)
    MUnit cur, nxt; int ui = 0; int relax = 0;
    if (!S.next(0, cur)) return;
    f32x4 acc[2][2][4][2];
#pragma unroll
    for (int a = 0; a < 2; ++a)
#pragma unroll
        for (int b = 0; b < 2; ++b)
#pragma unroll
            for (int m = 0; m < 4; ++m)
#pragma unroll
                for (int n = 0; n < 2; ++n) acc[a][b][m][n] = (f32x4){0.f, 0.f, 0.f, 0.f};
    bf16x8 At[4][2], B0[2][2], B1[2][2];
    const char* cA = cur.A; const char* cB = cur.B;
    E.prefetch(cur, 0, lds, wid, lane);
    unsigned voffB[2]; voffB[0] = rB[0] * cur.kb2 + cB2[0]; voffB[1] = rB[1] * cur.kb2 + cB2[1];
    size_t hstepB = (size_t)HALF * cur.kb2;
    PG8_STAGE(PG8_SB(0, 0), cB, voffB); PG8_STAGE(PG8_SB(0, 1), cB + hstepB, voffB); PG8_STAGE(PG8_SA(0, 0), cA, voffA); PG8_STAGE(PG8_SA(0, 1), cA + hstepA, voffA);
    if (wr == 1) PG8_BAR;
    PG8_WAIT_V(2); PG8_BAR;
    PG8_STAGE(PG8_SB(1, 0), cB + kstep, voffB); PG8_STAGE(PG8_SA(1, 0), cA + kstep, voffA); PG8_STAGE(PG8_SB(1, 1), cB + hstepB + kstep, voffB);
    PG8_WAIT_V(6); PG8_BAR;
    for (;;) {
        const bool has_next = S.next(ui + 1, nxt);
        if (!has_next) nxt = cur;
        const char* nA = nxt.A; const char* nB = nxt.B;
        unsigned nvoffB[2]; nvoffB[0] = rB[0] * nxt.kb2 + cB2[0]; nvoffB[1] = rB[1] * nxt.kb2 + cB2[1];
        const size_t nhstepB = (size_t)HALF * nxt.kb2;
        const int nt = cur.nt;
#pragma nounroll
        for (int t = 0; t < nt; t += 2) {
            const bool last = (t == nt - 2);
            const char* a1 = cA + (size_t)(t + 1) * kstep;
            const char* a2 = last ? nA : cA + (size_t)(t + 2) * kstep; const char* b2 = last ? nB : cB + (size_t)(t + 2) * kstep;
            const char* a3 = a2 + kstep; const char* b3 = b2 + kstep;
            unsigned vB2[2]; vB2[0] = last ? nvoffB[0] : voffB[0]; vB2[1] = last ? nvoffB[1] : voffB[1];
            const size_t hB2 = last ? nhstepB : hstepB;
            const int rlx = (t == 0) ? relax : 0;
            PG8_LDB(B0, 0, 0); PG8_LDB(B1, 0, 1); PG8_SCHED; PG8_LDA(At, 0, 0); PG8_STAGE(PG8_SA(1, 1), a1 + hstepA, voffA);
            if (rlx >= 16) PG8_WAIT_V(24); else if (rlx >= 8) PG8_WAIT_V(16); else PG8_WAIT_V(8);
            PG8_WAIT_L(0); PG8_BAR; PG8_MMA(0, 0, At, B0); PG8_MMA(0, 1, At, B1); PG8_BAR; PG8_SCHED;
            PG8_LDA(At, 0, 1); PG8_STAGE(PG8_SB(0, 0), b2, vB2); PG8_STAGE(PG8_SB(0, 1), b2 + hB2, vB2); PG8_STAGE(PG8_SA(0, 0), a2, voffA);
            if (rlx >= 16) PG8_WAIT_V(24); else if (rlx >= 8) PG8_WAIT_V(16); else PG8_WAIT_V(8);
            PG8_WAIT_L(0); PG8_BAR; PG8_MMA(1, 0, At, B0); PG8_MMA(1, 1, At, B1); PG8_BAR; PG8_SCHED;
            PG8_LDB(B0, 1, 0); PG8_LDB(B1, 1, 1); PG8_SCHED; PG8_LDA(At, 1, 0); PG8_STAGE(PG8_SA(0, 1), a2 + hstepA, voffA);
            PG8_WAIT_V(8); PG8_WAIT_L(0); PG8_BAR; PG8_MMA(0, 0, At, B0); PG8_MMA(0, 1, At, B1); PG8_BAR; PG8_SCHED;
            PG8_LDA(At, 1, 1); PG8_STAGE(PG8_SB(1, 0), b3, vB2); PG8_STAGE(PG8_SB(1, 1), b3 + hB2, vB2); PG8_STAGE(PG8_SA(1, 0), a3, voffA);
            PG8_WAIT_V(8); PG8_WAIT_L(0); PG8_BAR; PG8_MMA(1, 0, At, B0); PG8_MMA(1, 1, At, B1); PG8_BAR; PG8_SCHED;
        }
        if (wr == 0) PG8_BAR;
        { int t_e = threadIdx.x; asm volatile("" : "+v"(t_e)); if (has_next) E.prefetch(nxt, (ui + 1) & 1, lds, wid, t_e & 63); E(acc, cur, wr, wc, t_e & 15, (t_e >> 4) & 3, lds, ui & 1); }
        if (!has_next) break;
#pragma unroll
        for (int a = 0; a < 2; ++a)
#pragma unroll
            for (int b = 0; b < 2; ++b)
#pragma unroll
                for (int m = 0; m < 4; ++m)
#pragma unroll
                    for (int n = 0; n < 2; ++n) acc[a][b][m][n] = (f32x4){0.f, 0.f, 0.f, 0.f};
        relax = (cur.type == 0 && cur.u.pn >= 4) ? 8 : 16;
        cur = nxt; cA = nA; cB = nB; voffB[0] = nvoffB[0]; voffB[1] = nvoffB[1]; hstepB = nhstepB; ++ui;
        if (wr == 1) PG8_BAR;
    }
    PG8_WAIT_V(0);
    PG8_BAR;
#undef PG8_SA
#undef PG8_SB
#undef PG8_STAGE
#undef PG8_LDA
#undef PG8_LDB
#undef PG8_MMA
#undef PG8_WAIT_V
#undef PG8_WAIT_L
#undef PG8_BAR
#undef PG8_SCHED
}

typedef f32x4 Acc[2][2][4][2];

struct EpiStore { static constexpr bool HAS_PREFETCH = false; static constexpr int NST = 16;
    bf16_t* O; int ldc; bool nt = false;
    __device__ __forceinline__ void operator()(const Acc& acc, const Unit& u, int wr, int wc, int fr, int fq) const {
        const int row0 = u.pm * BM + wr * 64 + fr, col0 = u.pn * BM + wc * 32 + 8 * fq;
#pragma unroll
        for (int ai = 0; ai < 2; ++ai)
#pragma unroll
            for (int m = 0; m < 4; ++m) { bf16_t* rowp = O + (size_t)(row0 + ai * HALF + m * 16) * ldc + col0;
#pragma unroll
                for (int bj = 0; bj < 2; ++bj) { const f32x4 v0 = acc[ai][bj][m][0], v1 = acc[ai][bj][m][1];
                    u32x4 w; w.x = cvt_pk_bf16(v0[0], v0[1]); w.y = cvt_pk_bf16(v0[2], v0[3]); w.z = cvt_pk_bf16(v1[0], v1[1]); w.w = cvt_pk_bf16(v1[2], v1[3]);
                    if (nt) __builtin_nontemporal_store(w, (u32x4*)(rowp + bj * HALF)); else *(u32x4*)(rowp + bj * HALF) = w; } }
    }
};

struct EpiP { static constexpr bool HAS_PREFETCH = false, AFTER_DRAIN = false; static constexpr int NST = 8;
    bf16_t* O; bf16_t* U; float* ssq_q; float* ssq_kv;
    __device__ __forceinline__ void operator()(const Acc& acc, const Unit& u, int wr, int wc, int fr, int fq) const {
        const int row0 = u.pm * BM + wr * 64 + fr;
        if (u.pn >= 4) {
            bf16_t* ucol = U + 128 * (u.pn - 4) + 32 * wc + 8 * fq;
#pragma unroll
            for (int ai = 0; ai < 2; ++ai)
#pragma unroll
                for (int m = 0; m < 4; ++m) { const f32x4 v0 = acc[ai][0][m][0] * acc[ai][1][m][0], v1 = acc[ai][0][m][1] * acc[ai][1][m][1];
                    u32x4 w; w.x = cvt_pk_bf16(v0[0], v0[1]); w.y = cvt_pk_bf16(v0[2], v0[3]); w.z = cvt_pk_bf16(v1[0], v1[1]); w.w = cvt_pk_bf16(v1[2], v1[3]);
                    *(u32x4*)(ucol + (size_t)(row0 + ai * HALF + m * 16) * 512) = w; }
            return;
        }
        EpiStore st{O, PW}; st(acc, u, wr, wc, fr, fq);
        if (u.pn <= 1) {
            float* dst = (u.pn == 0) ? ssq_q : ssq_kv;
#pragma unroll
            for (int ai = 0; ai < 2; ++ai)
#pragma unroll
                for (int m = 0; m < 4; ++m) { float s = 0.f;
#pragma unroll
                    for (int n = 0; n < 2; ++n) { const f32x4 a = acc[ai][0][m][n]; s += (a[0] * a[0] + a[1] * a[1]) + (a[2] * a[2] + a[3] * a[3]); }
                    if (u.pn == 0) {
#pragma unroll
                        for (int n = 0; n < 2; ++n) { const f32x4 a = acc[ai][1][m][n]; s += (a[0] * a[0] + a[1] * a[1]) + (a[2] * a[2] + a[3] * a[3]); } }
                    s += __shfl_xor(s, 16); s += __shfl_xor(s, 32);
                    if (fq == 0) dst[(size_t)(row0 + ai * HALF + m * 16) * 4 + wc] = s; }
        }
    }
};

constexpr int SSQ_LDS = RING_BYTES + 1024;
struct EpiKV { static constexpr bool HAS_PREFETCH = false, AFTER_DRAIN = false; static constexpr int NST = 16;
    bf16_t* KN; bf16_t* V;
    __device__ __forceinline__ void operator()(const Acc& acc, const Unit& u, int wr, int wc, int fr, int fq, LAS unsigned char* lds, int buf) const {
        const int b = u.pm >> 3;
        const LAS f32x4* sq = (const LAS f32x4*)(lds + SSQ_LDS + buf * 4096) + wr * 64 + fr;
        float f[2][4];
#pragma unroll
        for (int ai = 0; ai < 2; ++ai)
#pragma unroll
            for (int m = 0; m < 4; ++m) { const f32x4 sp = sq[ai * HALF + m * 16]; f[ai][m] = rsqrtf(((sp[0] + sp[1]) + (sp[2] + sp[3])) * (1.f / 128.f) + 1e-6f); }
#pragma unroll
        for (int bj = 0; bj < 2; ++bj) { const int g = 8 * u.pn + 4 * bj + wc, head = g >> 2, part = g & 3;
            char* base = (part < 2) ? (char*)KN + (4 * part + fq) * 1024 + fr * 16 : (char*)V + (part - 2) * 4096 + fr * 64 + fq * 16;
            const int mstep = (part < 2) ? 256 : 1024;
            base += (size_t)(b * 8 + head) * 32 * 8192;
#pragma unroll
            for (int ai = 0; ai < 2; ++ai) { const int tile = (4 * u.pm + 2 * ai + wr) & 31;
#pragma unroll
                for (int m = 0; m < 4; ++m) {
                    const f32x4 v0 = acc[ai][bj][m][0] * f[ai][m], v1 = acc[ai][bj][m][1] * f[ai][m];
                    u32x4 w; w.x = cvt_pk_bf16(v0[0], v0[1]); w.y = cvt_pk_bf16(v0[2], v0[3]); w.z = cvt_pk_bf16(v1[0], v1[1]); w.w = cvt_pk_bf16(v1[2], v1[3]);
                    __builtin_nontemporal_store(w, (u32x4*)(base + (size_t)tile * 8192 + m * mstep)); } } }
    }
};

struct MixedOrder {
    const char* HB; const char* P; const char* WIN; const char* WQ; const char* WKV; int G, c;
    __device__ __forceinline__ void set_long(int k, MUnit& m) const { const int li = k * G + c, w = (li % NXCD) * 96 + li / NXCD, pm = w / 6, pn = 2 + w % 6;
        m.A = HB + (size_t)pm * (256 * 1024 * 2); m.B = WIN + (size_t)pn * (256 * 1024 * 2); m.nt = 16; m.kb2 = 2048u; m.type = 0; m.u.pm = pm; m.u.pn = pn; }
    __device__ __forceinline__ void set_short(int k, MUnit& m) const { const int si = k * G + c, s = (si % NXCD) * 112 + si / NXCD;
        if (s < 384) { const int pm = s / 3, pn = s % 3; m.A = P + (size_t)pm * (256 * 1024 * 2); m.B = WQ + (size_t)pn * (256 * 256 * 2); m.nt = 4; m.kb2 = 512u; m.type = 1; m.u.pm = pm; m.u.pn = pn; }
        else { const int s2 = s - 384, pm = s2 >> 2, pn = s2 & 3; m.A = P + 512 + (size_t)pm * (256 * 1024 * 2); m.B = WKV + (size_t)pn * (256 * 256 * 2); m.nt = 4; m.kb2 = 512u; m.type = 2; m.u.pm = pm; m.u.pn = pn; } }
    __device__ __forceinline__ bool next(int i, MUnit& m) const {
        const int ns = (c < 128) ? 4 : 3; if (i >= 3 + ns) return false;
        const int k = i >> 1; const bool even = (c & 1) == 0;
        if (i == 6) { set_short(3, m); return true; }
        if (even == ((i & 1) == 0)) set_long(k, m); else set_short(k, m);
        return true;
    }
};
struct EpiMix { EpiP p; EpiStore q; EpiKV kv; const float* ssqkv;
    __device__ __forceinline__ void prefetch(const MUnit& m, int buf, LAS unsigned char* lds, int wid, int lane) const {
        if (m.type == 2 && wid < 4) __builtin_amdgcn_global_load_lds((const unsigned*)(ssqkv + (size_t)m.u.pm * 1024 + wid * 256 + lane * 4), (LAS unsigned*)(lds + SSQ_LDS + buf * 4096 + wid * 1024), 16, 0, 0);
    }
    __device__ __forceinline__ void operator()(const Acc& acc, const MUnit& m, int wr, int wc, int fr, int fq, LAS unsigned char* lds, int buf) const {
        if (m.type == 0) p(acc, m.u, wr, wc, fr, fq); else if (m.type == 1) q(acc, m.u, wr, wc, fr, fq); else kv(acc, m.u, wr, wc, fr, fq, lds, buf);
    }
};

template <int CTRL> __device__ __forceinline__ float dppf(float v) { return __builtin_bit_cast(float, __builtin_amdgcn_update_dpp(0, __builtin_bit_cast(int, v), CTRL, 0xf, 0xf, true)); }
template <int CTRL> __device__ __forceinline__ f32x4 dpp4(f32x4 v) { f32x4 r; r[0] = dppf<CTRL>(v[0]); r[1] = dppf<CTRL>(v[1]); r[2] = dppf<CTRL>(v[2]); r[3] = dppf<CTRL>(v[3]); return r; }

constexpr int CW_LDS = RING_BYTES + 1024;
struct EpiUp { static constexpr bool HAS_PREFETCH = true; static constexpr int NST = 0;
    bf16_t* ACT; float* E; const float* cw; const float* cb;
    __device__ __forceinline__ void prefetch(const Unit& u, int buf, LAS unsigned char* lds, int wid, int lane) const {
        if (wid < 4) { const float* base = (wid < 3) ? cw + (size_t)wid * UPW : cb;
            const float* src = base + 128 * u.pn + ((lane & 32) ? DFF : 0) + 4 * (lane & 31);
            __builtin_amdgcn_global_load_lds((const unsigned*)src, (LAS unsigned*)(lds + CW_LDS + buf * 4096 + wid * 1024), 16, 0, 0); }
    }
    __device__ __forceinline__ void run(const Acc& acc, const Unit& u, int wr, int wc, int fr, int fq, LAS unsigned char* lds, int buf) const {
        const int cl = 32 * wc + 8 * fq;
        const int cbase = 128 * u.pn + cl;
        const LAS float* wl = (const LAS float*)(lds + CW_LDS + buf * 4096) + cl;
        u32x2 res0[2][4];
#pragma unroll
        for (int n = 0; n < 2; ++n) { const int c0 = cbase + 4 * n;
            const f32x4 wg0 = *(const LAS f32x4*)(wl + 4 * n), wg1 = *(const LAS f32x4*)(wl + 256 + 4 * n), wg2 = *(const LAS f32x4*)(wl + 512 + 4 * n), bg = *(const LAS f32x4*)(wl + 768 + 4 * n);
            const f32x4 wv0 = *(const LAS f32x4*)(wl + 128 + 4 * n), wv1 = *(const LAS f32x4*)(wl + 384 + 4 * n), wv2 = *(const LAS f32x4*)(wl + 640 + 4 * n), bv = *(const LAS f32x4*)(wl + 896 + 4 * n);
#pragma unroll
            for (int ai = 0; ai < 2; ++ai) { f32x4 pg1 = {0.f, 0.f, 0.f, 0.f}, pg2 = pg1, pv1 = pg1, pv2 = pg1;
                const int blk = 4 * u.pm + 2 * ai + wr;
#pragma unroll
                for (int m = 0; m < 4; ++m) { const f32x4 gcur = acc[ai][0][m][n], vcur = acc[ai][1][m][n];
                    const f32x4 rg1 = dpp4<0x121>(gcur), rg2 = dpp4<0x122>(gcur), rv1 = dpp4<0x121>(vcur), rv2 = dpp4<0x122>(vcur);
                    const f32x4 g1 = (fr >= 1) ? rg1 : pg1, g2 = (fr >= 2) ? rg2 : pg2, v1 = (fr >= 1) ? rv1 : pv1, v2 = (fr >= 2) ? rv2 : pv2;
                    const f32x4 cg = bg + wg0 * g2 + wg1 * g1 + wg2 * gcur, cv = bv + wv0 * v2 + wv1 * v1 + wv2 * vcur;
                    f32x4 a; a[0] = silu_f(cg[0]) * cv[0]; a[1] = silu_f(cg[1]) * cv[1]; a[2] = silu_f(cg[2]) * cv[2]; a[3] = silu_f(cg[3]) * cv[3];
                    u32x2 w; w.x = cvt_pk_bf16(a[0], a[1]); w.y = cvt_pk_bf16(a[2], a[3]);
                    const int t = u.pm * BM + ai * HALF + wr * 64 + m * 16 + fr;
                    if (n == 0) res0[ai][m] = w;
                    else if (!(m == 0 && fr < 2)) { u32x4 o; o.x = res0[ai][m].x; o.y = res0[ai][m].y; o.z = w.x; o.w = w.y; __builtin_nontemporal_store(o, (u32x4*)(ACT + (size_t)t * DFF + cbase)); }
                    if (m == 0 && fr < 2) { float* e = E + ((size_t)blk * 4 + fr) * UPW + c0; *(f32x4*)e = gcur; *(f32x4*)(e + DFF) = vcur; }
                    if (m == 3 && fr >= 14) { float* e = E + ((size_t)blk * 4 + 2 + (fr - 14)) * UPW + c0; *(f32x4*)e = gcur; *(f32x4*)(e + DFF) = vcur; }
                    pg1 = rg1; pg2 = rg2; pv1 = rv1; pv2 = rv2; } } }
    }
};
}

namespace att {
constexpr int NSLOT = 3, K_OFF = 0, KSLOT = 12288, V_OFF = NSLOT * KSLOT, VSLOT = 8192, WS_OFF = V_OFF + NSLOT * VSLOT, OST_OFF = WS_OFF + 8 * 256, LDS_END = OST_OFF + 8 * 8192;
static_assert(LDS_END <= RING_BYTES, "attention LDS");
__device__ __forceinline__ int crow(int r, int hi) { return (r & 3) + 8 * (r >> 2) + 4 * hi; }
typedef short v4i16_t __attribute__((ext_vector_type(4)));
__device__ __forceinline__ s16x4 vtr(const LAS unsigned char* p) { return __builtin_bit_cast(s16x4, __builtin_amdgcn_ds_read_tr16_b64_v4i16((LAS v4i16_t*)p)); }
__device__ __forceinline__ void glds(const char* src, LAS unsigned char* dst) { unsigned keep; const unsigned d = (unsigned)__builtin_amdgcn_readfirstlane((int)(unsigned)(uintptr_t)dst);
    asm volatile("s_mov_b32 %0, m0\n\ts_mov_b32 m0, %2\n\ts_nop 0\n\tglobal_load_lds_dwordx4 %1, off\n\ts_mov_b32 m0, %0" : "=&s"(keep) : "v"(src), "s"(d) : "memory"); }
__device__ __forceinline__ float max3f(float a, float b, float c) { float r; asm("v_max3_f32 %0, %1, %2, %3" : "=v"(r) : "v"(a), "v"(b), "v"(c)); return r; }
__device__ __forceinline__ float max2f(float a, float b) { float r; asm("v_max_f32_e32 %0, %1, %2" : "=v"(r) : "v"(a), "v"(b)); return r; }
__device__ __forceinline__ float fadd_s(float a, float b) { float r = a + b; asm volatile("" : "+v"(r)); return r; }
typedef float f32x2_t __attribute__((ext_vector_type(2))); typedef __bf16 bf16x2_t __attribute__((ext_vector_type(2)));
__device__ __forceinline__ unsigned cvtpk_m(float lo, float hi) { f32x2_t v = {lo, hi}; bf16x2_t b2 = __builtin_convertvector(v, bf16x2_t); return __builtin_bit_cast(unsigned, b2); }
constexpr float THRL = 4.0f;

struct AUnit { int b, h, qb; };
__device__ __forceinline__ bool unit_of(int k, int vcu, int G, AUnit& u) {
    const int it = vcu + (k >> 2) * G, r = k & 3; if (it >= 256) return false;
    const int grp = it >> 3, i8 = it & 7, bh = grp * 4 + r; u.b = bh >> 3; u.h = bh & 7;
    u.qb = (r == 0) ? 7 - i8 : (r == 1) ? i8 : (r == 2) ? 7 - (i8 ^ 1) : (i8 ^ 1); return true;
}
__device__ __forceinline__ void attn_phase(int vcu, int G, const float* ssqq, const float* rope, const bf16_t* Q, const bf16_t* KN, const bf16_t* KR, const bf16_t* V, bf16_t* Y, const float* ong, LAS unsigned char* lds) {
    int tid = threadIdx.x; asm volatile("" : "+v"(tid));
    const int lane = tid & 63, r32 = lane & 31, hi = lane >> 5; const int wid = __builtin_amdgcn_readfirstlane(tid >> 6);
    const int lo16 = wid * 1024 + lane * 16;
    LAS float* wsf = (LAS float*)(lds + WS_OFF + wid * 256);
    const int kl = hi * 1024 + r32 * 16, vl = ((lane >> 4) & 1) * 32 + (lane & 3) * 8 + (4 * hi + ((lane & 15) >> 2)) * 64;
#define ATT_ISSUE(U, tile, slot) do { const size_t bh_ = (size_t)((U).b * 8 + (U).h); \
        glds((const char*)KN + (bh_ * 32 + (tile)) * 8192 + lo16, lds + K_OFF + (slot) * KSLOT + wid * 1024); glds((const char*)V + (bh_ * 32 + (tile)) * 8192 + lo16, lds + V_OFF + (slot) * VSLOT + wid * 1024); \
        if (wid < 4) glds((const char*)KR + ((size_t)(U).b * 32 + (tile)) * 4096 + lo16, lds + K_OFF + (slot) * KSLOT + 8192 + wid * 1024); } while (0)
#define ATT_QLOAD(dst, aux, U) do { const size_t row_ = (size_t)((U).b * SEQ + 256 * (U).qb + 32 * wid + r32); const bf16_t* qp_ = Q + row_ * QW + 96 * (U).h + 8 * hi; \
        _Pragma("unroll") for (int ks = 0; ks < 6; ++ks) dst[ks] = *(const bf16x8*)(qp_ + 16 * ks); \
        aux[0] = *(const f32x4*)(ssqq + row_ * 4); aux[1] = *(const f32x4*)(rope + row_ * 32 + 8 * hi); aux[2] = *(const f32x4*)(rope + row_ * 32 + 8 * hi + 4); \
        aux[3] = *(const f32x4*)(rope + row_ * 32 + 16 + 8 * hi); aux[4] = *(const f32x4*)(rope + row_ * 32 + 16 + 8 * hi + 4); } while (0)
#define ATT_QFIX(q, aux) do { const float f_ = rsqrtf(((aux[0][0] + aux[0][1]) + (aux[0][2] + aux[0][3])) * (1.f / 256.f) + 1e-6f) * QSCALE; \
        _Pragma("unroll") for (int ks = 0; ks < 4; ++ks) { const u32x4 w_ = __builtin_bit_cast(u32x4, q[ks]); u32x4 o_; \
            _Pragma("unroll") for (int e = 0; e < 4; ++e) o_[e] = cvtpk_m(bf_lo(w_[e]) * f_, bf_hi(w_[e]) * f_); q[ks] = __builtin_bit_cast(bf16x8, o_); } \
        { const u32x4 a_ = __builtin_bit_cast(u32x4, q[4]), b_ = __builtin_bit_cast(u32x4, q[5]); u32x4 oa_, ob_; \
          _Pragma("unroll") for (int e = 0; e < 4; ++e) { const float x1l = bf_lo(a_[e]), x1h = bf_hi(a_[e]), x2l = bf_lo(b_[e]), x2h = bf_hi(b_[e]); \
              const float cl = (e < 2) ? aux[1][2 * e] : aux[2][2 * e - 4], ch = (e < 2) ? aux[1][2 * e + 1] : aux[2][2 * e - 3], sl = (e < 2) ? aux[3][2 * e] : aux[4][2 * e - 4], sh = (e < 2) ? aux[3][2 * e + 1] : aux[4][2 * e - 3]; \
              oa_[e] = cvtpk_m((x1l * cl - x2l * sl) * f_, (x1h * ch - x2h * sh) * f_); ob_[e] = cvtpk_m((x2l * cl + x1l * sl) * f_, (x2h * ch + x1h * sh) * f_); } \
          q[4] = __builtin_bit_cast(bf16x8, oa_); q[5] = __builtin_bit_cast(bf16x8, ob_); } } while (0)
    AUnit cur, nxt;
    if (!unit_of(0, vcu, G, cur)) return;
    bf16x8 qr[6], qn[6]; f32x4 qa[5], qna[5];
    ATT_QLOAD(qr, qa, cur);
    ATT_QFIX(qr, qa);
    asm volatile("" : "+v"(qr[0]), "+v"(qr[1]), "+v"(qr[2]), "+v"(qr[3]), "+v"(qr[4]), "+v"(qr[5]));
    ATT_ISSUE(cur, 0, 0); ATT_ISSUE(cur, 1, 1);
    int slot = 0;
    for (int k = 0;; ++k) {
        const bool has_next = unit_of(k + 1, vcu, G, nxt);
        const int NT = 4 * cur.qb + 4, jmax = 4 * cur.qb + (wid >> 1);
        float mrun = 0.f, lrun = 0.f; f32x16 o[2]; o[0] = f32x16{}; o[1] = f32x16{}; f32x16 negm = f32x16{};
        for (int j = 0; j < NT; ++j) {
            if (j == 0 && k > 0) { if (wid < 4) asm volatile("s_waitcnt vmcnt(13) lgkmcnt(0)\n\ts_barrier" ::: "memory"); else asm volatile("s_waitcnt vmcnt(12) lgkmcnt(0)\n\ts_barrier" ::: "memory"); }
            else if (j + 1 < NT || has_next) { if (wid < 4) asm volatile("s_waitcnt vmcnt(3) lgkmcnt(0)\n\ts_barrier" ::: "memory"); else asm volatile("s_waitcnt vmcnt(2) lgkmcnt(0)\n\ts_barrier" ::: "memory"); }
            else asm volatile("s_waitcnt vmcnt(0) lgkmcnt(0)\n\ts_barrier" ::: "memory");
            { const int s2 = (slot == 0) ? 2 : slot - 1;
              if (j + 2 < NT) ATT_ISSUE(cur, j + 2, s2); else if (has_next) ATT_ISSUE(nxt, j + 2 - NT, s2); }
            if (j == NT - 1 && has_next) ATT_QLOAD(qn, qna, nxt);
            if (j <= jmax) {
                const LAS unsigned char* kp = lds + K_OFF + slot * KSLOT + kl;
                f32x16 p0, p1;
#pragma unroll
                for (int ks = 0; ks < 6; ++ks) { const bf16x8 k0 = *(const LAS bf16x8*)(kp + ks * 2048), k1 = *(const LAS bf16x8*)(kp + ks * 2048 + 512);
                    if (ks == 0) { p0 = __builtin_amdgcn_mfma_f32_32x32x16_bf16(k0, qr[0], negm, 0, 0, 0); p1 = __builtin_amdgcn_mfma_f32_32x32x16_bf16(k1, qr[0], negm, 0, 0, 0); }
                    else { p0 = __builtin_amdgcn_mfma_f32_32x32x16_bf16(k0, qr[ks], p0, 0, 0, 0); p1 = __builtin_amdgcn_mfma_f32_32x32x16_bf16(k1, qr[ks], p1, 0, 0, 0); } }
                asm volatile("s_nop 15\n\ts_nop 7" : "+v"(p0), "+v"(p1));
                float rm;
                { float a = max3f(p0[0], p0[1], p1[0]), c = max3f(p0[2], p0[3], p1[1]); a = max3f(a, p1[2], p1[3]);
#pragma unroll
                  for (int r = 4; r < 16; r += 4) { a = max3f(a, p0[r], p0[r + 1]); c = max3f(c, p0[r + 2], p0[r + 3]); a = max3f(a, p1[r], p1[r + 1]); c = max3f(c, p1[r + 2], p1[r + 3]); }
                  rm = max2f(a, c); rm = max2f(rm, __shfl_xor(rm, 32)); }
                if (j == 0 || __any(rm > THRL)) {
                    const float dl = (j == 0) ? rm : fmaxf(rm, 0.f);
                    mrun += dl;
#pragma unroll
                    for (int r = 0; r < 16; ++r) { p0[r] -= dl; p1[r] -= dl; }
#pragma unroll
                    for (int r = 0; r < 16; ++r) negm[r] = -mrun;
                    if (j != 0) { const float alpha = fexp2(-dl); lrun *= alpha;
                        if (hi == 0) wsf[r32] = alpha;
#pragma unroll
                        for (int r = 0; r < 16; ++r) { const float a_ = wsf[crow(r, hi)]; o[0][r] *= a_; o[1][r] *= a_; } }
                }
#pragma unroll
                for (int r = 0; r < 16; ++r) { p0[r] = fexp2(p0[r]); p1[r] = fexp2(p1[r]); }
                { float s0 = fadd_s(p0[0], p1[0]), s1 = fadd_s(p0[1], p1[1]);
#pragma unroll
                  for (int r = 2; r < 16; r += 2) { s0 = fadd_s(s0, p0[r]); s1 = fadd_s(s1, p0[r + 1]); s0 = fadd_s(s0, p1[r]); s1 = fadd_s(s1, p1[r + 1]); }
                  lrun = fadd_s(lrun, fadd_s(s0, s1)); }
                bf16x8 pa[4];
                { u32x4 w0, w1, w2, w3;
                  w0.x = cvtpk_m(p0[0], p0[1]); w0.y = cvtpk_m(p0[2], p0[3]); w0.z = cvtpk_m(p0[4], p0[5]); w0.w = cvtpk_m(p0[6], p0[7]);
                  w1.x = cvtpk_m(p0[8], p0[9]); w1.y = cvtpk_m(p0[10], p0[11]); w1.z = cvtpk_m(p0[12], p0[13]); w1.w = cvtpk_m(p0[14], p0[15]);
                  w2.x = cvtpk_m(p1[0], p1[1]); w2.y = cvtpk_m(p1[2], p1[3]); w2.z = cvtpk_m(p1[4], p1[5]); w2.w = cvtpk_m(p1[6], p1[7]);
                  w3.x = cvtpk_m(p1[8], p1[9]); w3.y = cvtpk_m(p1[10], p1[11]); w3.z = cvtpk_m(p1[12], p1[13]); w3.w = cvtpk_m(p1[14], p1[15]);
                  pa[0] = __builtin_bit_cast(bf16x8, w0); pa[1] = __builtin_bit_cast(bf16x8, w1); pa[2] = __builtin_bit_cast(bf16x8, w2); pa[3] = __builtin_bit_cast(bf16x8, w3); }
                const LAS unsigned char* vp = lds + V_OFF + slot * VSLOT + vl;
#pragma unroll
                for (int d0 = 0; d0 < 2; ++d0)
#pragma unroll
                    for (int ks = 0; ks < 4; ++ks) { const s16x4 lo = vtr(vp + d0 * 4096 + ks * 1024), hh = vtr(vp + d0 * 4096 + ks * 1024 + 512);
                        const bf16x8 vf = {lo[0], lo[1], lo[2], lo[3], hh[0], hh[1], hh[2], hh[3]};
                        o[d0] = __builtin_amdgcn_mfma_f32_32x32x16_bf16(pa[ks], vf, o[d0], 0, 0, 0); }
            }
            slot = (slot == 2) ? 0 : slot + 1;
        }
        { const float lt = lrun + __shfl_xor(lrun, 32);
          if (hi == 0) wsf[r32] = frcp(lt);
          LAS float* stg = (LAS float*)(lds + OST_OFF + wid * 8192);
#pragma unroll
          for (int r = 0; r < 16; ++r) { const float inv = wsf[crow(r, hi)]; const int orow = crow(r, hi); stg[orow * 64 + r32] = o[0][r] * inv; stg[orow * 64 + 32 + r32] = o[1][r] * inv; }
          asm volatile("s_waitcnt lgkmcnt(0)" ::: "memory");
          const int ch = lane & 7;
          const f32x4 ga = *(const f32x4*)(ong + 64 * cur.h + 8 * ch), gb = *(const f32x4*)(ong + 64 * cur.h + 8 * ch + 4);
          bf16_t* Yw = Y + (size_t)(cur.b * SEQ + 256 * cur.qb + 32 * wid) * D + 64 * cur.h + 8 * ch;
#pragma unroll
          for (int i = 0; i < 4; ++i) { const int row = i * 8 + (lane >> 3);
              const f32x4 va = *(const LAS f32x4*)(stg + row * 64 + 8 * ch), vb = *(const LAS f32x4*)(stg + row * 64 + 8 * ch + 4);
              float ss = (va[0] * va[0] + va[1] * va[1]) + (va[2] * va[2] + va[3] * va[3]) + (vb[0] * vb[0] + vb[1] * vb[1]) + (vb[2] * vb[2] + vb[3] * vb[3]);
              ss += pg8::dppf<0xB1>(ss); ss += pg8::dppf<0x4E>(ss); ss += pg8::dppf<0x141>(ss);
              const float rs = rsqrtf(ss * (1.f / 64.f) + 1e-6f);
              const f32x4 oa = va * rs * ga, ob = vb * rs * gb;
              u32x4 w; w.x = cvtpk_m(oa[0], oa[1]); w.y = cvtpk_m(oa[2], oa[3]); w.z = cvtpk_m(ob[0], ob[1]); w.w = cvtpk_m(ob[2], ob[3]);
              *(u32x4*)(Yw + (size_t)row * D) = w; } }
        if (!has_next) break;
        cur = nxt;
#pragma unroll
        for (int ks = 0; ks < 6; ++ks) qr[ks] = qn[ks];
        ATT_QFIX(qr, qna);
    }
    asm volatile("s_waitcnt vmcnt(0) lgkmcnt(0)\n\ts_barrier" ::: "memory");
#undef ATT_ISSUE
#undef ATT_QLOAD
#undef ATT_QFIX
}
}

#define XB_TMO      128
#define XB_XCNT(j)  (256  + 64 * (j))
#define XB_XSUB(j)  (1280 + 64 * (j))
#define XB_XGEN(j)  (2304 + 64 * (j))
#define XB_TOP      3328
#define XB_TOPGEN   3392
#define XCD_BAR_WORDS 3456
#define XB_SPIN_CAP (1u << 18)
__device__ __forceinline__ unsigned xb_ld(unsigned* p)              { return __hip_atomic_load(p, __ATOMIC_RELAXED, __HIP_MEMORY_SCOPE_AGENT); }
__device__ __forceinline__ unsigned xb_add(unsigned* p, unsigned v) { return __hip_atomic_fetch_add(p, v, __ATOMIC_RELAXED, __HIP_MEMORY_SCOPE_AGENT); }
__device__ __forceinline__ unsigned xb_xcc_id() { return (unsigned)__builtin_amdgcn_s_getreg((3 << 11) | 20) & 0xFu; }
#define XB_SPIN(cond, bar) do { unsigned _sp = 0; while (cond) { __builtin_amdgcn_s_sleep(1); \
    if ((++_sp & 255u) == 0u) { if (xb_ld(&(bar)[XB_TMO])) break; if (_sp > XB_SPIN_CAP) { atomicAdd(&(bar)[XB_TMO], 1u); break; } } } } while (0)
struct XcdBarrier { unsigned* bar; unsigned x; volatile LAS unsigned* st; };
__device__ __forceinline__ XcdBarrier xcd_barrier_post(unsigned* bar, volatile LAS unsigned* st) {
    XcdBarrier b; b.bar = bar; b.x = xb_xcc_id(); b.st = st;
    if (threadIdx.x == 0) (void)xb_add(&bar[XB_XCNT(b.x)], 1u);
    return b;
}
__device__ __forceinline__ void xcd_barrier_complete(unsigned* bar, unsigned x, unsigned& nloc, unsigned& nx) {
    const unsigned G = gridDim.x * gridDim.y * gridDim.z;
    unsigned sum, cnt, mine, sp = 0u;
    for (;;) {
        sum = 0u; cnt = 0u; mine = 0u;
#pragma unroll
        for (unsigned j = 0; j < 16; ++j) { const unsigned c = xb_ld(&bar[XB_XCNT(j)]); sum += c; cnt += (c > 0u) ? 1u : 0u; mine = (j == x) ? c : mine; }
        if (sum == G) break;
        __builtin_amdgcn_s_sleep(1);
        if ((++sp & 255u) == 0u) { if (xb_ld(&bar[XB_TMO])) break; if (sp > XB_SPIN_CAP) { atomicAdd(&bar[XB_TMO], 1u); break; } }
    }
    nloc = mine > 0u ? mine : 1u; nx = cnt > 0u ? cnt : 1u;
}
__device__ __forceinline__ void xcd_barrier(const XcdBarrier& b) {
    asm volatile("s_waitcnt vmcnt(0)" ::: "memory");
    __syncthreads();
    if (threadIdx.x == 0) {
        unsigned* bar = b.bar;
        __builtin_amdgcn_s_waitcnt(0);
        unsigned nloc = b.st[0], nx = b.st[1];
        if (nloc == 0u) { xcd_barrier_complete(bar, b.x, nloc, nx); b.st[0] = nloc; b.st[1] = nx; }
        const unsigned old = xb_add(&bar[XB_XSUB(b.x)], 1u);
        const unsigned gen = old / nloc;
        if (old + 1u == (gen + 1u) * nloc) {
            __builtin_amdgcn_fence(__ATOMIC_RELEASE, "agent");
            asm volatile("s_waitcnt vmcnt(0)" ::: "memory");
            const unsigned og = xb_add(&bar[XB_TOP], 1u);
            const unsigned tg = og / nx;
            if (og + 1u == (tg + 1u) * nx) xb_add(&bar[XB_TOPGEN], 1u);
            else XB_SPIN(xb_ld(&bar[XB_TOPGEN]) == tg, bar);
            __builtin_amdgcn_fence(__ATOMIC_ACQUIRE, "agent");
            xb_add(&bar[XB_XGEN(b.x)], 1u);
            asm volatile("s_waitcnt vmcnt(0)" ::: "memory");
        } else {
            XB_SPIN(xb_ld(&bar[XB_XGEN(b.x)]) == gen, bar);
            __builtin_amdgcn_fence(__ATOMIC_ACQUIRE, "agent");
            asm volatile("s_waitcnt vmcnt(0)" ::: "memory");
        }
    }
    __syncthreads();
}

struct Args { const float* in[22]; const int* pos; float* out; unsigned char* ws; int ph_lo, ph_hi; };
__constant__ float c_invfreq[16] = {1.0f, 0.5623413251903491f, 0.31622776601683794f, 0.1778279410038923f, 0.1f, 0.05623413251903491f, 0.03162277660168379f, 0.01778279410038923f,
                                    0.01f, 0.005623413251903491f, 0.0031622776601683794f, 0.001778279410038923f, 0.001f, 0.0005623413251903491f, 0.00031622776601683794f, 0.0001778279410038923f};

__device__ __forceinline__ int colmap(int which, int s) {
    const int p = (s & ~31) + pg8::perm32(s & 31);
    switch (which) {
        case 0: { if (s < 1024) return p < 416 ? p : (p < 512 ? -1 : p - 96);
                  const int bj = (s >> 7) & 1, ch = 128 * ((s >> 8) - 4) + 32 * ((s >> 5) & 3) + pg8::perm32(s & 31); return (bj ? 1440 : 928) + ch; }
        case 4: { const int pn = s >> 8, bj = (s >> 7) & 1, wc = (s >> 5) & 3; return bj * DFF + 128 * pn + 32 * wc + pg8::perm32(s & 31); }
        default: return p;
    }
}
__device__ __forceinline__ void p0_transpose_item(const float* W, int ldw, int Ksrc, const float* kscale, bf16_t* WT, int Kdst, int which, LAS float* scr, int item, int nblk, int lane) {
    const int kb = item / nblk, nb = item % nblk, k0 = 64 * kb, s0 = 32 * nb;
    const int cm = colmap(which, s0 + (lane & 31));
    float tv[32];
#pragma unroll
    for (int i = 0; i < 32; ++i) { const int k = k0 + 2 * i + (lane >> 5); tv[i] = (cm >= 0 && k < Ksrc) ? __builtin_nontemporal_load(W + (size_t)k * ldw + cm) : 0.f; }
    if (kscale) {
#pragma unroll
        for (int i = 0; i < 32; ++i) { const int k = k0 + 2 * i + (lane >> 5); if (k < Ksrc) tv[i] *= kscale[k]; } }
#pragma unroll
    for (int i = 0; i < 32; ++i) scr[(2 * i + (lane >> 5)) * 33 + (lane & 31)] = tv[i];
    asm volatile("s_waitcnt lgkmcnt(0)" ::: "memory");
    const int c = lane & 7;
#pragma unroll
    for (int j = 0; j < 4; ++j) { const int n = (lane >> 3) + 8 * j; const LAS float* s = scr + (8 * c) * 33 + n;
        u32x4 o; o.x = cvt_pk_bf16(s[0 * 33], s[1 * 33]); o.y = cvt_pk_bf16(s[2 * 33], s[3 * 33]); o.z = cvt_pk_bf16(s[4 * 33], s[5 * 33]); o.w = cvt_pk_bf16(s[6 * 33], s[7 * 33]);
        *(u32x4*)(WT + (size_t)(s0 + n) * Kdst + k0 + 8 * c) = o; }
    asm volatile("s_waitcnt lgkmcnt(0)" ::: "memory");
}

constexpr int N_PHASES = 11;
#define OPAQUE_LANE(name) int name##_t = (int)threadIdx.x; asm volatile("" : "+v"(name##_t)); const int name = name##_t & 63

__global__ void __launch_bounds__(512, 2) mk_fwd(Args args) {
    extern __shared__ __attribute__((aligned(16))) unsigned char lds_raw[];
    LAS unsigned char* lds = (LAS unsigned char*)lds_raw;
    volatile LAS unsigned* MISC = (volatile LAS unsigned*)(lds + MISC_OFF);
    const int tid = threadIdx.x, lane = tid & 63, wave = __builtin_amdgcn_readfirstlane(tid >> 6);
    const int G = gridDim.x; const int bx = blockIdx.x; const int vcu = (G % 8 == 0) ? (bx % 8) * (G / 8) + bx / 8 : bx;
    const int gw = vcu * 8 + wave, NGW = G * 8;
    unsigned char* ws = args.ws;
    const float* x = args.in[0]; const float* cvec = args.in[1]; const int* pos = args.pos;
    const float* w_ada = args.in[3]; const float* b_ada = args.in[4]; const float* w_in = args.in[5];
    const float* qg = args.in[6]; const float* w_qup = args.in[7]; const float* kvg = args.in[8]; const float* w_kvup = args.in[9];
    const float* conv_w = args.in[10]; const float* conv_b = args.in[11]; const float* ong = args.in[12]; const float* w_out = args.in[13];
    const float* ln1g = args.in[14]; const float* ln1b = args.in[15]; const float* w_up = args.in[16];
    const float* fcw = args.in[17]; const float* fcb = args.in[18]; const float* w_down = args.in[19];
    const float* ln2g = args.in[20]; const float* ln2b = args.in[21];
    float* out = args.out;
    float* MOD = (float*)(ws + WS_MOD); float* ROPE = (float*)(ws + WS_ROPE); float* SSQQ = (float*)(ws + WS_SSQQ); float* SSQKV = (float*)(ws + WS_SSQKV);
    bf16_t* WIN = (bf16_t*)(ws + WS_WIN); bf16_t* WQ = (bf16_t*)(ws + WS_WQ); bf16_t* WKV = (bf16_t*)(ws + WS_WKV); bf16_t* WOUT = (bf16_t*)(ws + WS_WOUT);
    bf16_t* WUP = (bf16_t*)(ws + WS_WUP); bf16_t* WDN = (bf16_t*)(ws + WS_WDN);
    bf16_t* HB = (bf16_t*)(ws + WS_HB); bf16_t* FF = (bf16_t*)(ws + WS_FF); bf16_t* P = (bf16_t*)(ws + WS_P); bf16_t* MIX = (bf16_t*)(ws + WS_MIX);
    bf16_t* U = (bf16_t*)(ws + WS_U); bf16_t* Qb = (bf16_t*)(ws + WS_Q); bf16_t* KN = (bf16_t*)(ws + WS_KN); bf16_t* KR = (bf16_t*)(ws + WS_KR); bf16_t* Vb = (bf16_t*)(ws + WS_V);
    bf16_t* Y = (bf16_t*)(ws + WS_Y); bf16_t* X1 = (bf16_t*)(ws + WS_X1); bf16_t* ACT = (bf16_t*)(ws + WS_ACT); float* E = (float*)(ws + WS_E);

    for (int u = tid; u < (LDS_BYTES - LDSCTL_OFF) / 4; u += 512) ((LAS unsigned*)(lds + LDSCTL_OFF))[u] = 0u;
    __syncthreads();
    XcdBarrier bar; bar.bar = (unsigned*)(ws + WS_CTL) + CW_BAR; bar.x = 0; bar.st = nullptr;
    if (MK_N_LAUNCHES == 1) bar = xcd_barrier_post((unsigned*)(ws + WS_CTL) + CW_BAR, MISC + 8);
    const int lo = args.ph_lo, hi = args.ph_hi;
#ifndef PH_MASK
#define PH_MASK 0x7ff
#endif
#define IN(k) (((PH_MASK >> (k)) & 1) && lo <= (k) && (k) < hi)
#define SEAM(k) do { if (IN(k) && IN((k) + 1)) xcd_barrier(bar); } while (0)

    if (IN(0)) {
        OPAQUE_LANE(ln);
        if (bx < 192) {
            LAS float* cact = (LAS float*)lds; LAS float* part = (LAS float*)(lds + 65536);
            const int n0 = 32 * bx, c4 = tid & 7, kr = tid >> 3;
            f32x4 wv[16];
#pragma unroll
            for (int i = 0; i < 16; ++i) wv[i] = __builtin_nontemporal_load((const f32x4*)(w_ada + (size_t)(kr + 64 * i) * 6144 + n0 + 4 * c4));
            for (int i = tid; i < 16 * 1024; i += 512) { const float v = cvec[i]; cact[i] = v * frcp(1.f + fexp2(-LOG2E * v)); }
            __syncthreads();
            f32x4 a[16];
#pragma unroll
            for (int b = 0; b < 16; ++b) a[b] = (f32x4){0.f, 0.f, 0.f, 0.f};
#pragma unroll
            for (int i = 0; i < 16; ++i) { const int k = kr + 64 * i;
#pragma unroll
                for (int b = 0; b < 16; ++b) a[b] += wv[i] * cact[b * 1024 + k];
                if ((i & 1) == 1) asm volatile("" ::: "memory"); }
#pragma unroll
            for (int b = 0; b < 16; ++b)
#pragma unroll
                for (int e = 0; e < 4; ++e) { float v = a[b][e]; v += __shfl_xor(v, 8); v += __shfl_xor(v, 16); v += __shfl_xor(v, 32); a[b][e] = v; }
            if (ln < 8) {
#pragma unroll
                for (int b = 0; b < 16; ++b) *(LAS f32x4*)(part + (wave * 16 + b) * 32 + 4 * c4) = a[b]; }
            __syncthreads();
            { const int b = tid >> 5, col = tid & 31; float s = 0.f;
#pragma unroll
              for (int w8 = 0; w8 < 8; ++w8) s += part[(w8 * 16 + b) * 32 + col];
              MOD[b * 6144 + n0 + col] = s + b_ada[n0 + col]; }
            __syncthreads();
        }
        for (int idx = gw * 64 + ln; idx < T * 16; idx += NGW * 64) { const int t = idx >> 4, i = idx & 15; const float ang = (float)pos[t] * c_invfreq[i];
            ROPE[(size_t)t * 32 + i] = cosf(ang); ROPE[(size_t)t * 32 + 16 + i] = sinf(ang); }
    }
    SEAM(0);
    if (IN(1)) {
        OPAQUE_LANE(ln);
        {
        LAS float* scr = (LAS float*)(lds + wave * 16384);
        constexpr int I0 = 16 * 64, I1 = 4 * 24, I2 = 4 * 32, I3 = 16 * 32, I4 = 16 * 176, I5 = 44 * 32, NIT = I0 + I1 + I2 + I3 + I4 + I5;
        for (int it = gw; it < NIT; it += NGW) {
            int r = it;
            if (r < I0) { p0_transpose_item(w_in, INW, D, nullptr, WIN, D, 0, scr, r, 64, ln); continue; } r -= I0;
            if (r < I1) { p0_transpose_item(w_qup, QW, 256, qg, WQ, 256, 1, scr, r, 24, ln); continue; } r -= I1;
            if (r < I2) { p0_transpose_item(w_kvup, 1024, 128, kvg, WKV, 256, 2, scr, r, 32, ln); continue; } r -= I2;
            if (r < I3) { p0_transpose_item(w_out, D, D, nullptr, WOUT, D, 3, scr, r, 32, ln); continue; } r -= I3;
            if (r < I4) { p0_transpose_item(w_up, UPW, D, nullptr, WUP, D, 4, scr, r, 176, ln); continue; } r -= I4;
            p0_transpose_item(w_down, D, DFF, nullptr, WDN, DFF, 5, scr, r, 32, ln);
        }
            }
        for (int row0 = gw * 16; row0 < T; row0 += NGW * 16) { const int b = row0 / SEQ; const float* mb = MOD + b * 6144;
            f32x4 sc[4], sh[4];
#pragma unroll
            for (int j = 0; j < 4; ++j) { const int col = 4 * ln + 256 * j; sh[j] = *(const f32x4*)(mb + col); sc[j] = *(const f32x4*)(mb + 1024 + col) + 1.f; }
            f32x4 xn[4];
#pragma unroll
            for (int j = 0; j < 4; ++j) xn[j] = __builtin_nontemporal_load((const f32x4*)(x + (size_t)row0 * D + 4 * ln + 256 * j));
            for (int rr = 0; rr < 16; ++rr) { const int t = row0 + rr;
                f32x4 v[4]; float s = 0.f;
#pragma unroll
                for (int j = 0; j < 4; ++j) { v[j] = xn[j]; s += (v[j][0] + v[j][1]) + (v[j][2] + v[j][3]); }
                if (rr + 1 < 16) {
#pragma unroll
                    for (int j = 0; j < 4; ++j) xn[j] = __builtin_nontemporal_load((const f32x4*)(x + (size_t)(t + 1) * D + 4 * ln + 256 * j)); }
                const float mean = wave_sum(s) * (1.f / D); float q = 0.f;
#pragma unroll
                for (int j = 0; j < 4; ++j) { v[j] = v[j] - mean; q += (v[j][0] * v[j][0] + v[j][1] * v[j][1]) + (v[j][2] * v[j][2] + v[j][3] * v[j][3]); }
                const float rstd = rsqrtf(wave_sum(q) * (1.f / D) + 1e-5f);
#pragma unroll
                for (int j = 0; j < 4; ++j) { const f32x4 o = v[j] * rstd * sc[j] + sh[j]; u32x2 w; w.x = cvt_pk_bf16(o[0], o[1]); w.y = cvt_pk_bf16(o[2], o[3]);
                    *(u32x2*)(HB + (size_t)t * D + 4 * ln + 256 * j) = w; } } }
    }
    SEAM(1);
    if (IN(2)) {
        pg8::Gemm g{HB, D, WIN, T, 512, D}; pg8::StaticOrder S; S.init(T, 512, G, bx);
        pg8::EpiP E1{P, U, SSQQ, SSQKV};
        pg8::gemm_phase<pg8::EpiP, true>(lds, g, S, E1);
    }
    SEAM(2);
    if (IN(3)) {
        OPAQUE_LANE(ln);
        for (int row0 = gw * 16; row0 < T; row0 += NGW * 16) {
            { const int t = row0 + (ln >> 2), c = ln & 3, i0 = 8 * (c & 1); const bf16_t* pr = P + (size_t)t * PW + 384;
              const u32x4 r1 = *(const u32x4*)(pr + i0), r2 = *(const u32x4*)(pr + 16 + i0);
              const f32x4 ca = *(const f32x4*)(ROPE + (size_t)t * 32 + i0), cb = *(const f32x4*)(ROPE + (size_t)t * 32 + i0 + 4), sa = *(const f32x4*)(ROPE + (size_t)t * 32 + 16 + i0), sb = *(const f32x4*)(ROPE + (size_t)t * 32 + 16 + i0 + 4);
              float ov[8];
#pragma unroll
              for (int e = 0; e < 8; ++e) { const float x1 = (e & 1) ? bf_hi(r1[e >> 1]) : bf_lo(r1[e >> 1]), x2 = (e & 1) ? bf_hi(r2[e >> 1]) : bf_lo(r2[e >> 1]);
                  const float cs = (e < 4) ? ca[e & 3] : cb[e & 3], sn = (e < 4) ? sa[e & 3] : sb[e & 3];
                  ov[e] = (c < 2) ? x1 * cs - x2 * sn : x2 * cs + x1 * sn; }
              u32x4 o; o.x = cvt_pk_bf16(ov[0], ov[1]); o.y = cvt_pk_bf16(ov[2], ov[3]); o.z = cvt_pk_bf16(ov[4], ov[5]); o.w = cvt_pk_bf16(ov[6], ov[7]);
              *(u32x4*)((char*)KR + (size_t)(t >> 6) * 4096 + c * 1024 + (t & 63) * 16) = o; }
        }
        { pg8::MixedOrder S{(const char*)HB, (const char*)P, (const char*)WIN, (const char*)WQ, (const char*)WKV, G, bx};
          pg8::EpiMix EM{pg8::EpiP{P, U, SSQQ, SSQKV}, pg8::EpiStore{Qb, QW, true}, pg8::EpiKV{KN, Vb}, SSQKV};
          pg8::gemm_multi<pg8::MixedOrder, pg8::EpiMix>(lds, S, EM); }
    }
    SEAM(3);
    if (IN(4)) {
        att::attn_phase(vcu, G, SSQQ, ROPE, Qb, KN, KR, Vb, Y, ong, lds);
        { OPAQUE_LANE(ln);
        for (int row0 = gw * 16; row0 < T; row0 += NGW * 16) {
            const int c0 = 8 * ln;
            float w0[8], w1[8], w2[8], cb8[8], gn[8];
#pragma unroll
            for (int e = 0; e < 8; ++e) { w0[e] = conv_w[c0 + e]; w1[e] = conv_w[512 + c0 + e]; w2[e] = conv_w[1024 + c0 + e]; cb8[e] = conv_b[c0 + e]; gn[e] = ong[512 + c0 + e]; }
            float um2[8], um1[8];
#pragma unroll
            for (int e = 0; e < 8; ++e) { um2[e] = 0.f; um1[e] = 0.f; }
            if ((row0 % SEQ) != 0) {
                const u32x4 a2 = *(const u32x4*)(U + (size_t)(row0 - 2) * 512 + c0), a1 = *(const u32x4*)(U + (size_t)(row0 - 1) * 512 + c0);
#pragma unroll
                for (int e = 0; e < 4; ++e) { um2[2 * e] = bf_lo(a2[e]); um2[2 * e + 1] = bf_hi(a2[e]); um1[2 * e] = bf_lo(a1[e]); um1[2 * e + 1] = bf_hi(a1[e]); }
            }
            for (int rr = 0; rr < 16; ++rr) { const int t = row0 + rr;
                const u32x4 gb = __builtin_nontemporal_load((const u32x4*)(P + (size_t)t * PW + 512 + c0)), uu = __builtin_nontemporal_load((const u32x4*)(U + (size_t)t * 512 + c0));
                float u0[8], yv[8]; float ss = 0.f;
#pragma unroll
                for (int e = 0; e < 4; ++e) { u0[2 * e] = bf_lo(uu[e]); u0[2 * e + 1] = bf_hi(uu[e]); }
#pragma unroll
                for (int e = 0; e < 8; ++e) { const float gbe = (e & 1) ? bf_hi(gb[e >> 1]) : bf_lo(gb[e >> 1]);
                    yv[e] = gbe * (cb8[e] + w0[e] * um2[e] + w1[e] * um1[e] + w2[e] * u0[e]); ss += yv[e] * yv[e]; um2[e] = um1[e]; um1[e] = u0[e]; }
                ss += __shfl_xor(ss, 1); ss += __shfl_xor(ss, 2); ss += __shfl_xor(ss, 4);
                const float rs = rsqrtf(ss * (1.f / 64.f) + 1e-6f);
                u32x4 o; o.x = cvt_pk_bf16(yv[0] * rs * gn[0], yv[1] * rs * gn[1]); o.y = cvt_pk_bf16(yv[2] * rs * gn[2], yv[3] * rs * gn[3]);
                o.z = cvt_pk_bf16(yv[4] * rs * gn[4], yv[5] * rs * gn[5]); o.w = cvt_pk_bf16(yv[6] * rs * gn[6], yv[7] * rs * gn[7]);
                *(u32x4*)(Y + (size_t)t * D + 512 + c0) = o; }
        }
            }
    }
    SEAM(4);
    if (IN(5)) {
        pg8::Gemm g{Y, D, WOUT, T, D, D}; pg8::StaticOrder S; S.init(T, D, G, bx); pg8::EpiStore E4{MIX, D, true};
        pg8::gemm_phase<pg8::EpiStore, true>(lds, g, S, E4);
    }
    SEAM(5);
    if (IN(6)) {
        OPAQUE_LANE(ln);
        for (int row0 = gw * 16; row0 < T; row0 += NGW * 16) { const int b = row0 / SEQ; const float* mb = MOD + b * 6144;
            f32x4 gt[4], g1v[4], b1v[4], sc[4], sh[4];
#pragma unroll
            for (int j = 0; j < 4; ++j) { const int col = 4 * ln + 256 * j; gt[j] = *(const f32x4*)(mb + 2048 + col); g1v[j] = *(const f32x4*)(ln1g + col); b1v[j] = *(const f32x4*)(ln1b + col);
                sh[j] = *(const f32x4*)(mb + 3072 + col); sc[j] = *(const f32x4*)(mb + 4096 + col) + 1.f; }
            f32x4 xn[4]; u32x2 mn[4];
#pragma unroll
            for (int j = 0; j < 4; ++j) { const int col = 4 * ln + 256 * j; xn[j] = __builtin_nontemporal_load((const f32x4*)(x + (size_t)row0 * D + col)); mn[j] = __builtin_nontemporal_load((const u32x2*)(MIX + (size_t)row0 * D + col)); }
            for (int rr = 0; rr < 16; ++rr) { const int t = row0 + rr;
                f32x4 v[4]; float s = 0.f;
#pragma unroll
                for (int j = 0; j < 4; ++j) { const f32x4 mx = {bf_lo(mn[j].x), bf_hi(mn[j].x), bf_lo(mn[j].y), bf_hi(mn[j].y)};
                    v[j] = xn[j] * ALPHA + gt[j] * mx; s += (v[j][0] + v[j][1]) + (v[j][2] + v[j][3]); }
                if (rr + 1 < 16) {
#pragma unroll
                    for (int j = 0; j < 4; ++j) { const int col = 4 * ln + 256 * j; xn[j] = __builtin_nontemporal_load((const f32x4*)(x + (size_t)(t + 1) * D + col)); mn[j] = __builtin_nontemporal_load((const u32x2*)(MIX + (size_t)(t + 1) * D + col)); } }
                float mean = wave_sum(s) * (1.f / D); float q = 0.f;
#pragma unroll
                for (int j = 0; j < 4; ++j) { v[j] = v[j] - mean; q += (v[j][0] * v[j][0] + v[j][1] * v[j][1]) + (v[j][2] * v[j][2] + v[j][3] * v[j][3]); }
                float rstd = rsqrtf(wave_sum(q) * (1.f / D) + 1e-5f);
                s = 0.f;
#pragma unroll
                for (int j = 0; j < 4; ++j) { v[j] = v[j] * rstd * g1v[j] + b1v[j]; u32x2 w; w.x = cvt_pk_bf16(v[j][0], v[j][1]); w.y = cvt_pk_bf16(v[j][2], v[j][3]); __builtin_nontemporal_store(w, (u32x2*)(X1 + (size_t)t * D + 4 * ln + 256 * j)); s += (v[j][0] + v[j][1]) + (v[j][2] + v[j][3]); }
                mean = wave_sum(s) * (1.f / D); q = 0.f;
#pragma unroll
                for (int j = 0; j < 4; ++j) { v[j] = v[j] - mean; q += (v[j][0] * v[j][0] + v[j][1] * v[j][1]) + (v[j][2] * v[j][2] + v[j][3] * v[j][3]); }
                rstd = rsqrtf(wave_sum(q) * (1.f / D) + 1e-5f);
#pragma unroll
                for (int j = 0; j < 4; ++j) { const f32x4 o = v[j] * rstd * sc[j] + sh[j]; u32x2 w; w.x = cvt_pk_bf16(o[0], o[1]); w.y = cvt_pk_bf16(o[2], o[3]);
                    *(u32x2*)(HB + (size_t)t * D + 4 * ln + 256 * j) = w; } } }
    }
    SEAM(6);
    if (IN(7)) {
        pg8::Gemm g{HB, D, WUP, T, UPW, D}; pg8::StaticOrder S; S.init(T, UPW, G, bx); pg8::EpiUp E5{ACT, E, fcw, fcb};
        pg8::gemm_phase<pg8::EpiUp, true>(lds, g, S, E5);
    }
    SEAM(7);
    if (IN(8)) {
        OPAQUE_LANE(ln);
        constexpr int NITEM = 512 * 2 * (DFF / 4);
        for (int it = (gw * 64 + ln); it < NITEM; it += NGW * 64) { const int c4 = it % (DFF / 4), rb = it / (DFF / 4), rr = rb & 1, blk = rb >> 1; const int c0 = 4 * c4;
            const bool first = (blk & 31) == 0;
            const float* e0 = E + ((size_t)blk * 4 + rr) * UPW + c0;
            const float* em1 = (rr == 0) ? E + ((size_t)(blk - 1) * 4 + 3) * UPW + c0 : E + ((size_t)blk * 4 + 0) * UPW + c0;
            const float* em2 = (rr == 0) ? E + ((size_t)(blk - 1) * 4 + 2) * UPW + c0 : E + ((size_t)(blk - 1) * 4 + 3) * UPW + c0;
            const f32x4 z = {0.f, 0.f, 0.f, 0.f};
            const f32x4 g0 = *(const f32x4*)e0, v0 = *(const f32x4*)(e0 + DFF);
            const bool has1 = !(first && rr == 0), has2 = !first;
            const f32x4 g1 = has1 ? *(const f32x4*)em1 : z, v1 = has1 ? *(const f32x4*)(em1 + DFF) : z;
            const f32x4 g2 = has2 ? *(const f32x4*)em2 : z, v2 = has2 ? *(const f32x4*)(em2 + DFF) : z;
            const f32x4 wg0 = *(const f32x4*)(fcw + c0), wg1 = *(const f32x4*)(fcw + UPW + c0), wg2 = *(const f32x4*)(fcw + 2 * UPW + c0), bg = *(const f32x4*)(fcb + c0);
            const f32x4 wv0 = *(const f32x4*)(fcw + DFF + c0), wv1 = *(const f32x4*)(fcw + UPW + DFF + c0), wv2 = *(const f32x4*)(fcw + 2 * UPW + DFF + c0), bv = *(const f32x4*)(fcb + DFF + c0);
            const f32x4 cg = bg + wg0 * g2 + wg1 * g1 + wg2 * g0, cv = bv + wv0 * v2 + wv1 * v1 + wv2 * v0;
            u32x2 w; w.x = cvt_pk_bf16(silu_f(cg[0]) * cv[0], silu_f(cg[1]) * cv[1]); w.y = cvt_pk_bf16(silu_f(cg[2]) * cv[2], silu_f(cg[3]) * cv[3]);
            *(u32x2*)(ACT + (size_t)(64 * blk + rr) * DFF + c0) = w; }
    }
    SEAM(8);
    if (IN(9)) {
        pg8::Gemm g{ACT, DFF, WDN, T, D, DFF}; pg8::StaticOrder S; S.init(T, D, G, bx); pg8::EpiStore E6{FF, D, true};
        pg8::gemm_phase<pg8::EpiStore, true>(lds, g, S, E6);
    }
    SEAM(9);
    if (IN(10)) {
        OPAQUE_LANE(ln);
        for (int row0 = gw * 16; row0 < T; row0 += NGW * 16) { const int b = row0 / SEQ; const float* mb = MOD + b * 6144;
            f32x4 gt[4], g2v[4], b2v[4];
#pragma unroll
            for (int j = 0; j < 4; ++j) { const int col = 4 * ln + 256 * j; gt[j] = *(const f32x4*)(mb + 5120 + col); g2v[j] = *(const f32x4*)(ln2g + col); b2v[j] = *(const f32x4*)(ln2b + col); }
            u32x2 xn[4], mn[4];
#pragma unroll
            for (int j = 0; j < 4; ++j) { const int col = 4 * ln + 256 * j; xn[j] = __builtin_nontemporal_load((const u32x2*)(X1 + (size_t)row0 * D + col)); mn[j] = __builtin_nontemporal_load((const u32x2*)(FF + (size_t)row0 * D + col)); }
            for (int rr = 0; rr < 16; ++rr) { const int t = row0 + rr;
                f32x4 v[4]; float s = 0.f; u32x2 xc[4], mc[4];
#pragma unroll
                for (int j = 0; j < 4; ++j) { xc[j] = xn[j]; mc[j] = mn[j]; }
                if (rr + 1 < 16) {
#pragma unroll
                    for (int j = 0; j < 4; ++j) { const int col = 4 * ln + 256 * j; xn[j] = __builtin_nontemporal_load((const u32x2*)(X1 + (size_t)(t + 1) * D + col)); mn[j] = __builtin_nontemporal_load((const u32x2*)(FF + (size_t)(t + 1) * D + col)); } }
#pragma unroll
                for (int j = 0; j < 4; ++j) { const u32x2 xw = xc[j]; const f32x4 xv = {bf_lo(xw.x), bf_hi(xw.x), bf_lo(xw.y), bf_hi(xw.y)}; const u32x2 mw = mc[j];
                    const f32x4 mx = {bf_lo(mw.x), bf_hi(mw.x), bf_lo(mw.y), bf_hi(mw.y)};
                    v[j] = xv * ALPHA + gt[j] * mx; s += (v[j][0] + v[j][1]) + (v[j][2] + v[j][3]); }
                const float mean = wave_sum(s) * (1.f / D); float q = 0.f;
#pragma unroll
                for (int j = 0; j < 4; ++j) { v[j] = v[j] - mean; q += (v[j][0] * v[j][0] + v[j][1] * v[j][1]) + (v[j][2] * v[j][2] + v[j][3] * v[j][3]); }
                const float rstd = rsqrtf(wave_sum(q) * (1.f / D) + 1e-5f);
#pragma unroll
                for (int j = 0; j < 4; ++j) { *(f32x4*)(out + (size_t)t * D + 4 * ln + 256 * j) = v[j] * rstd * g2v[j] + b2v[j]; } } }
    }
#undef IN
#undef SEAM
}

extern "C" void kernel_launch(void* const* d_in, const int* in_sizes, int n_in, void* d_out, int out_size, void* d_ws, size_t ws_size, hipStream_t stream) {
    static int grid = 0;
    if (grid == 0) {
        if (n_in != 22 || in_sizes[0] != T * D || out_size != T * D || ws_size < WS_END) { fprintf(stderr, "kernel_launch: unexpected shapes / workspace (n_in %d, ws %zu)\n", n_in, ws_size); grid = -1; return; }
        int dev = 0, cus = 0, per_cu = 0;
        if (hipGetDevice(&dev) != hipSuccess || hipDeviceGetAttribute(&cus, hipDeviceAttributeMultiprocessorCount, dev) != hipSuccess) { grid = -1; return; }
        if (hipFuncSetAttribute((const void*)mk_fwd, hipFuncAttributeMaxDynamicSharedMemorySize, LDS_BYTES) != hipSuccess) { fprintf(stderr, "kernel_launch: hipFuncSetAttribute failed\n"); grid = -1; return; }
        if (hipOccupancyMaxActiveBlocksPerMultiprocessor(&per_cu, (const void*)mk_fwd, 512, LDS_BYTES) != hipSuccess || per_cu < 1) { fprintf(stderr, "kernel_launch: occupancy query says %d blocks per CU\n", per_cu); (void)hipGetLastError(); grid = -1; return; }
        grid = cus;
    }
    if (grid < 0) return;
    hipMemsetAsync((char*)d_ws + WS_CTL, 0, CTL_ZERO_BYTES, stream);
    Args a{};
    for (int i = 0; i < 22; ++i) a.in[i] = (const float*)d_in[i];
    a.pos = (const int*)d_in[2]; a.out = (float*)d_out; a.ws = (unsigned char*)d_ws;
#if MK_N_LAUNCHES == 1
    a.ph_lo = 0; a.ph_hi = N_PHASES;
    hipLaunchKernelGGL(mk_fwd, dim3(grid), dim3(512), LDS_BYTES, stream, a);
#else
    for (int p = 0; p < N_PHASES; ++p) { a.ph_lo = p; a.ph_hi = p + 1; hipLaunchKernelGGL(mk_fwd, dim3(grid), dim3(512), LDS_BYTES, stream, a); }
#endif
}
```

```cpp
#include <hip/hip_runtime.h>
#include <cstdio>
#include <cstdint>

#define LAS __attribute__((address_space(3)))
#define GAS __attribute__((address_space(1)))
typedef unsigned short bf16_t;
typedef short bf16x8 __attribute__((ext_vector_type(8)));
typedef short s16x4 __attribute__((ext_vector_type(4)));
typedef float f32x4 __attribute__((ext_vector_type(4)));
typedef float f32x2 __attribute__((ext_vector_type(2)));
typedef float f32x16 __attribute__((ext_vector_type(16)));
typedef unsigned u32x4 __attribute__((ext_vector_type(4)));
typedef unsigned u32x2 __attribute__((ext_vector_type(2)));
typedef GAS unsigned gu32;

#ifndef MK_N_LAUNCHES
#define MK_N_LAUNCHES 1
#endif

constexpr int D = 1024, NB = 16, SEQ = 2048, T = NB * SEQ, NH = 8, DFF = 2816, UPW = 2 * DFF;
constexpr int PW = 1024;
constexpr int G1N = 2048;
constexpr int QW = 768, INW = 1952;
constexpr float ALPHA = 1.189207115002721f;
constexpr float QSCALE = 0.10206207261596575f * 1.4426950408889634f;
constexpr float LOG2E = 1.4426950408889634f;

constexpr size_t MiB = 1u << 20;
constexpr size_t WS_CTL = 0, CTL_ZERO_BYTES = 64 * 1024;
constexpr size_t WS_MOD = 1 * MiB;
constexpr size_t WS_ROPE = 2 * MiB;
constexpr size_t WS_SSQQ = 6 * MiB;
constexpr size_t WS_SSQKV = 6 * MiB + 512 * 1024;
constexpr size_t WS_WIN = 8 * MiB;
constexpr size_t WS_WQ = 12 * MiB;
constexpr size_t WS_WKV = 12 * MiB + 512 * 1024;
constexpr size_t WS_WOUT = 13 * MiB;
constexpr size_t WS_WUP = 15 * MiB;
constexpr size_t WS_WDN = 26 * MiB;
constexpr size_t WS_HB = 32 * MiB;
constexpr size_t WS_FF = 32 * MiB;
constexpr size_t WS_P = 96 * MiB;
constexpr size_t WS_U = 160 * MiB;
constexpr size_t WS_MIX = 96 * MiB;
constexpr size_t WS_Q = 224 * MiB;
constexpr size_t WS_KN = 272 * MiB;
constexpr size_t WS_KR = 304 * MiB;
constexpr size_t WS_V = 306 * MiB;
constexpr size_t WS_Y = 338 * MiB;
constexpr size_t WS_X1 = 338 * MiB;
constexpr size_t WS_ACT = 96 * MiB;
constexpr size_t WS_E = 272 * MiB;
constexpr size_t WS_END = 402 * MiB;
constexpr int CW_BAR = 1024;

constexpr int RING_BYTES = 131072, LDSCTL_OFF = RING_BYTES, MISC_OFF = LDSCTL_OFF + 320, LDS_BYTES = 147456;

__device__ __forceinline__ unsigned cvt_pk_bf16(float lo, float hi) { unsigned r; asm volatile("v_cvt_pk_bf16_f32 %0, %1, %2" : "=v"(r) : "v"(lo), "v"(hi)); return r; }
__device__ __forceinline__ float bf_lo(unsigned u) { return __uint_as_float(u << 16); }
__device__ __forceinline__ float bf_hi(unsigned u) { return __uint_as_float(u & 0xffff0000u); }
__device__ __forceinline__ float fexp2(float x) { return __builtin_amdgcn_exp2f(x); }
__device__ __forceinline__ float frcp(float x) { return __builtin_amdgcn_rcpf(x); }
__device__ __forceinline__ float silu_f(float v) { return v * frcp(1.f + fexp2(-LOG2E * v)); }
__device__ __forceinline__ float wave_sum(float v) {
#pragma unroll
    for (int o = 1; o < 64; o <<= 1) v += __shfl_xor(v, o);
    return v;
}

namespace pg8 {
constexpr int BM = 256, BK = 64, HALF = 128, HTB = HALF * BK * 2, STAGE_BYTES = 8 * HTB, NXCD = 8, WGM = 8;
__host__ __device__ __forceinline__ int lds_byte(int r, int c) { const int st = (r >> 4) * 2 + (c >> 5), rr = r & 15, cc = c & 31, ob = rr * 64 + cc * 2; return st * 1024 + (ob ^ (((ob >> 9) & 1) << 5)); }
__host__ __device__ __forceinline__ void stage_rc(int b, int& R, int& C) { const int st = b / 1024, sb = b % 1024, swz = sb ^ (((sb >> 9) & 1) << 5); R = (st >> 1) * 16 + swz / 64; C = (st & 1) * 32 + (swz % 64) / 2; }
__host__ __device__ __forceinline__ int perm32(int rho) { const int n = rho >> 4, i = rho & 15; return 8 * (i >> 2) + 4 * n + (i & 3); }

struct Unit { int pm, pn; };
struct Gemm { const bf16_t* A; int lda; const bf16_t* Bt; int M, N, K; };

struct StaticOrder {
    int nM, nN, nwg, G, c;
    __device__ __forceinline__ void init(int M, int N, int G_, int c_) { nM = M / BM; nN = N / BM; nwg = nM * nN; G = G_; c = c_; }
    __device__ __forceinline__ bool next(int i, Unit& u) const {
        const long L = (long)i * G + c; if (L >= nwg) return false;
        int wgid = (int)L; { const int q = nwg / NXCD, r = nwg % NXCD, xcd = wgid % NXCD, off = wgid / NXCD; wgid = (xcd < r ? xcd * (q + 1) : r * (q + 1) + (xcd - r) * q) + off; }
        const int nig = WGM * nN, gid = wgid / nig, fm = gid * WGM, gsz = (nM - fm) < WGM ? (nM - fm) : WGM;
        u.pm = fm + ((wgid % nig) % gsz); u.pn = (wgid % nig) / gsz; return true;
    }
};

template <class Epi, bool ALIGN_EPI>
__device__ __forceinline__ void gemm_phase(LAS unsigned char* lds, const Gemm g, const StaticOrder& S, const Epi& E) {
    int tid = threadIdx.x; asm volatile("" : "+v"(tid));
    const int wid = __builtin_amdgcn_readfirstlane(tid >> 6), lane = tid & 63, wr = wid >> 2, wc = wid & 3, fr = lane & 15, fq = lane >> 4;
    const int K = g.K, nt = K / BK;
    unsigned voffA[2], voffB[2];
#pragma unroll
    for (int i = 0; i < 2; ++i) { int R, C; stage_rc(tid * 16 + i * 8192, R, C);
        voffA[i] = (unsigned)(R * g.lda + C) * 2u; voffB[i] = (unsigned)(R * K + C) * 2u; }
    const size_t kstep = (size_t)(BK * 2);
    const size_t hstepA = (size_t)HALF * g.lda * 2, hstepB = (size_t)HALF * K * 2;
    const size_t tstepA = 2 * hstepA, tstepB = 2 * hstepB;
    const unsigned ldsw = (unsigned)wid * 1024u;
    const int aoff = lds_byte(wr * 64 + fr, fq * 8), boff = lds_byte(wc * 32 + fr, fq * 8);
#define PG8_SA(b, h) (((b) * 2 + (h)) * HTB)
#define PG8_SB(b, h) ((4 + (b) * 2 + (h)) * HTB)
#define PG8_STAGE(bufoff, gbase, voff) do { _Pragma("unroll") for (int _i = 0; _i < 2; ++_i) \
        __builtin_amdgcn_global_load_lds((const unsigned*)((const char*)(gbase) + (voff)[_i]), (LAS unsigned*)(lds + (bufoff) + ldsw + _i * 8192), 16, 0, 0); } while (0)
#define PG8_LDA(dst, b, h) do { _Pragma("unroll") for (int m = 0; m < 4; ++m) _Pragma("unroll") for (int k = 0; k < 2; ++k) dst[m][k] = *(const LAS bf16x8*)(lds + PG8_SA(b, h) + aoff + m * 2048 + k * 1024); } while (0)
#define PG8_LDB(dst, b, h) do { _Pragma("unroll") for (int n = 0; n < 2; ++n) _Pragma("unroll") for (int k = 0; k < 2; ++k) dst[n][k] = *(const LAS bf16x8*)(lds + PG8_SB(b, h) + boff + n * 2048 + k * 1024); } while (0)
#define PG8_MMA(ai, bj, At, Bt) do { __builtin_amdgcn_s_setprio(1); _Pragma("unroll") for (int m = 0; m < 4; ++m) _Pragma("unroll") for (int n = 0; n < 2; ++n) _Pragma("unroll") for (int k = 0; k < 2; ++k) \
        acc[ai][bj][m][n] = __builtin_amdgcn_mfma_f32_16x16x32_bf16(Bt[n][k], At[m][k], acc[ai][bj][m][n], 0, 0, 0); __builtin_amdgcn_s_setprio(0); } while (0)
#define PG8_WAIT_V(n) asm volatile("s_waitcnt vmcnt(" #n ")" ::: "memory")
#define PG8_WAIT_L(n) asm volatile("s_waitcnt lgkmcnt(" #n ")" ::: "memory")
#define PG8_BAR __builtin_amdgcn_s_barrier()
#define PG8_SCHED __builtin_amdgcn_sched_barrier(0)
    Unit cur, nxt; int ui = 0;
    if (!S.next(0, cur)) return;
    f32x4 acc[2][2][4][2];
#pragma unroll
    for (int a = 0; a < 2; ++a)
#pragma unroll
        for (int b = 0; b < 2; ++b)
#pragma unroll
            for (int m = 0; m < 4; ++m)
#pragma unroll
                for (int n = 0; n < 2; ++n) acc[a][b][m][n] = (f32x4){0.f, 0.f, 0.f, 0.f};
    bf16x8 At[4][2], B0[2][2], B1[2][2];
    const char* cA = (const char*)g.A + (size_t)cur.pm * tstepA; const char* cB = (const char*)g.Bt + (size_t)cur.pn * tstepB;
    if constexpr (Epi::HAS_PREFETCH) E.prefetch(cur, 0, lds, wid, lane);
    PG8_STAGE(PG8_SB(0, 0), cB, voffB); PG8_STAGE(PG8_SB(0, 1), cB + hstepB, voffB); PG8_STAGE(PG8_SA(0, 0), cA, voffA); PG8_STAGE(PG8_SA(0, 1), cA + hstepA, voffA);
    if (wr == 1) PG8_BAR;
    PG8_WAIT_V(2); PG8_BAR;
    PG8_STAGE(PG8_SB(1, 0), cB + kstep, voffB); PG8_STAGE(PG8_SA(1, 0), cA + kstep, voffA); PG8_STAGE(PG8_SB(1, 1), cB + hstepB + kstep, voffB);
    PG8_WAIT_V(6); PG8_BAR;
    for (;;) {
        const bool has_next = S.next(ui + 1, nxt);
        const char* nA = has_next ? (const char*)g.A + (size_t)nxt.pm * tstepA : cA; const char* nB = has_next ? (const char*)g.Bt + (size_t)nxt.pn * tstepB : cB;
#pragma nounroll
        for (int t = 0; t < nt; t += 2) {
            const bool last = (t == nt - 2);
            const char* a1 = cA + (size_t)(t + 1) * kstep;
            const char* a2 = last ? nA : cA + (size_t)(t + 2) * kstep; const char* b2 = last ? nB : cB + (size_t)(t + 2) * kstep;
            const char* a3 = a2 + kstep; const char* b3 = b2 + kstep;
            const bool rlx = (Epi::NST > 0) && (t == 0) && (ui > 0);
            PG8_LDB(B0, 0, 0); PG8_LDB(B1, 0, 1); PG8_SCHED; PG8_LDA(At, 0, 0); PG8_STAGE(PG8_SA(1, 1), a1 + hstepA, voffA);
            if (rlx) { if constexpr (Epi::NST >= 16) PG8_WAIT_V(24); else PG8_WAIT_V(16); } else PG8_WAIT_V(8);
            PG8_WAIT_L(0); PG8_BAR; PG8_MMA(0, 0, At, B0); PG8_MMA(0, 1, At, B1); PG8_BAR; PG8_SCHED;
            PG8_LDA(At, 0, 1); PG8_STAGE(PG8_SB(0, 0), b2, voffB); PG8_STAGE(PG8_SB(0, 1), b2 + hstepB, voffB); PG8_STAGE(PG8_SA(0, 0), a2, voffA);
            if (rlx) { if constexpr (Epi::NST >= 16) PG8_WAIT_V(24); else PG8_WAIT_V(16); } else PG8_WAIT_V(8);
            PG8_WAIT_L(0); PG8_BAR; PG8_MMA(1, 0, At, B0); PG8_MMA(1, 1, At, B1); PG8_BAR; PG8_SCHED;
            PG8_LDB(B0, 1, 0); PG8_LDB(B1, 1, 1); PG8_SCHED; PG8_LDA(At, 1, 0); PG8_STAGE(PG8_SA(0, 1), a2 + hstepA, voffA);
            PG8_WAIT_V(8); PG8_WAIT_L(0); PG8_BAR; PG8_MMA(0, 0, At, B0); PG8_MMA(0, 1, At, B1); PG8_BAR; PG8_SCHED;
            PG8_LDA(At, 1, 1); PG8_STAGE(PG8_SB(1, 0), b3, voffB); PG8_STAGE(PG8_SB(1, 1), b3 + hstepB, voffB); PG8_STAGE(PG8_SA(1, 0), a3, voffA);
            PG8_WAIT_V(8); PG8_WAIT_L(0); PG8_BAR; PG8_MMA(1, 0, At, B0); PG8_MMA(1, 1, At, B1); PG8_BAR; PG8_SCHED;
        }
        if constexpr (ALIGN_EPI) { if (wr == 0) PG8_BAR; }
        { int t_e = threadIdx.x; asm volatile("" : "+v"(t_e)); const int fr_e = t_e & 15, fq_e = (t_e >> 4) & 3;
          if constexpr (Epi::HAS_PREFETCH) { if (has_next) E.prefetch(nxt, (ui + 1) & 1, lds, wid, t_e & 63); E.run(acc, cur, wr, wc, fr_e, fq_e, lds, ui & 1); }
          else E(acc, cur, wr, wc, fr_e, fq_e); }
        if (!has_next) break;
#pragma unroll
        for (int a = 0; a < 2; ++a)
#pragma unroll
            for (int b = 0; b < 2; ++b)
#pragma unroll
                for (int m = 0; m < 4; ++m)
#pragma unroll
                    for (int n = 0; n < 2; ++n) acc[a][b][m][n] = (f32x4){0.f, 0.f, 0.f, 0.f};
        cur = nxt; cA = nA; cB = nB; ++ui;
        if constexpr (ALIGN_EPI) { if (wr == 1) PG8_BAR; }
    }
    PG8_WAIT_V(0);
    if constexpr (!ALIGN_EPI) { if (wr == 0) PG8_BAR; }
    PG8_BAR;
#undef PG8_SA
#undef PG8_SB
#undef PG8_STAGE
#undef PG8_LDA
#undef PG8_LDB
#undef PG8_MMA
#undef PG8_WAIT_V
#undef PG8_WAIT_L
#undef PG8_BAR
#undef PG8_SCHED
}

struct MUnit { const char* A; const char* B; int nt; unsigned kb2; int type; Unit u; };
template <class Sched, class Disp>
__device__ __forceinline__ void gemm_multi(LAS unsigned char* lds, const Sched& S, const Disp& E) {
    int tid = threadIdx.x; asm volatile("" : "+v"(tid));
    const int wid = __builtin_amdgcn_readfirstlane(tid >> 6), lane = tid & 63, wr = wid >> 2, wc = wid & 3, fr = lane & 15, fq = lane >> 4;
    unsigned voffA[2], rB[2], cB2[2];
#pragma unroll
    for (int i = 0; i < 2; ++i) { int R, C; stage_rc(tid * 16 + i * 8192, R, C); voffA[i] = (unsigned)(R * 1024 + C) * 2u; rB[i] = (unsigned)R; cB2[i] = (unsigned)C * 2u; }
    const size_t kstep = (size_t)(BK * 2);
    const size_t hstepA = (size_t)HALF * 1024 * 2;
    const unsigned ldsw = (unsigned)wid * 1024u;
    const int aoff = lds_byte(wr * 64 + fr, fq * 8), boff = lds_byte(wc * 32 + fr, fq * 8);
#define PG8_SA(b, h) (((b) * 2 + (h)) * HTB)
#define PG8_SB(b, h) ((4 + (b) * 2 + (h)) * HTB)
#define PG8_STAGE(bufoff, gbase, voff) do { _Pragma("unroll") for (int _i = 0; _i < 2; ++_i) \
        __builtin_amdgcn_global_load_lds((const unsigned*)((const char*)(gbase) + (voff)[_i]), (LAS unsigned*)(lds + (bufoff) + ldsw + _i * 8192), 16, 0, 0); } while (0)
#define PG8_LDA(dst, b, h) do { _Pragma("unroll") for (int m = 0; m < 4; ++m) _Pragma("unroll") for (int k = 0; k < 2; ++k) dst[m][k] = *(const LAS bf16x8*)(lds + PG8_SA(b, h) + aoff + m * 2048 + k * 1024); } while (0)
#define PG8_LDB(dst, b, h) do { _Pragma("unroll") for (int n = 0; n < 2; ++n) _Pragma("unroll") for (int k = 0; k < 2; ++k) dst[n][k] = *(const LAS bf16x8*)(lds + PG8_SB(b, h) + boff + n * 2048 + k * 1024); } while (0)
#define PG8_MMA(ai, bj, At, Bt) do { __builtin_amdgcn_s_setprio(1); _Pragma("unroll") for (int m = 0; m < 4; ++m) _Pragma("unroll") for (int n = 0; n < 2; ++n) _Pragma("unroll") for (int k = 0; k < 2; ++k) \
        acc[ai][bj][m][n] = __builtin_amdgcn_mfma_f32_16x16x32_bf16(Bt[n][k], At[m][k], acc[ai][bj][m][n], 0, 0, 0); __builtin_amdgcn_s_setprio(0); } while (0)
#define PG8_WAIT_V(n) asm volatile("s_waitcnt vmcnt(" #n ")" ::: "memory")
#define PG8_WAIT_L(n) asm volatile("s_waitcnt lgkmcnt(" #n ")" ::: "memory")
#define PG8_BAR __builtin_amdgcn_s_barrier()
#define PG8_SCHED __builtin_amdgcn_sched_barrier(0)
    MUnit cur, nxt; int ui = 0; int relax = 0;
    if (!S.next(0, cur)) return;
    f32x4 acc[2][2][4][2];
#pragma unroll
    for (int a = 0; a < 2; ++a)
#pragma unroll
        for (int b = 0; b < 2; ++b)
#pragma unroll
            for (int m = 0; m < 4; ++m)
#pragma unroll
                for (int n = 0; n < 2; ++n) acc[a][b][m][n] = (f32x4){0.f, 0.f, 0.f, 0.f};
    bf16x8 At[4][2], B0[2][2], B1[2][2];
    const char* cA = cur.A; const char* cB = cur.B;
    E.prefetch(cur, 0, lds, wid, lane);
    unsigned voffB[2]; voffB[0] = rB[0] * cur.kb2 + cB2[0]; voffB[1] = rB[1] * cur.kb2 + cB2[1];
    size_t hstepB = (size_t)HALF * cur.kb2;
    PG8_STAGE(PG8_SB(0, 0), cB, voffB); PG8_STAGE(PG8_SB(0, 1), cB + hstepB, voffB); PG8_STAGE(PG8_SA(0, 0), cA, voffA); PG8_STAGE(PG8_SA(0, 1), cA + hstepA, voffA);
    if (wr == 1) PG8_BAR;
    PG8_WAIT_V(2); PG8_BAR;
    PG8_STAGE(PG8_SB(1, 0), cB + kstep, voffB); PG8_STAGE(PG8_SA(1, 0), cA + kstep, voffA); PG8_STAGE(PG8_SB(1, 1), cB + hstepB + kstep, voffB);
    PG8_WAIT_V(6); PG8_BAR;
    for (;;) {
        const bool has_next = S.next(ui + 1, nxt);
        if (!has_next) nxt = cur;
        const char* nA = nxt.A; const char* nB = nxt.B;
        unsigned nvoffB[2]; nvoffB[0] = rB[0] * nxt.kb2 + cB2[0]; nvoffB[1] = rB[1] * nxt.kb2 + cB2[1];
        const size_t nhstepB = (size_t)HALF * nxt.kb2;
        const int nt = cur.nt;
#pragma nounroll
        for (int t = 0; t < nt; t += 2) {
            const bool last = (t == nt - 2);
            const char* a1 = cA + (size_t)(t + 1) * kstep;
            const char* a2 = last ? nA : cA + (size_t)(t + 2) * kstep; const char* b2 = last ? nB : cB + (size_t)(t + 2) * kstep;
            const char* a3 = a2 + kstep; const char* b3 = b2 + kstep;
            unsigned vB2[2]; vB2[0] = last ? nvoffB[0] : voffB[0]; vB2[1] = last ? nvoffB[1] : voffB[1];
            const size_t hB2 = last ? nhstepB : hstepB;
            const int rlx = (t == 0) ? relax : 0;
            PG8_LDB(B0, 0, 0); PG8_LDB(B1, 0, 1); PG8_SCHED; PG8_LDA(At, 0, 0); PG8_STAGE(PG8_SA(1, 1), a1 + hstepA, voffA);
            if (rlx >= 16) PG8_WAIT_V(24); else if (rlx >= 8) PG8_WAIT_V(16); else PG8_WAIT_V(8);
            PG8_WAIT_L(0); PG8_BAR; PG8_MMA(0, 0, At, B0); PG8_MMA(0, 1, At, B1); PG8_BAR; PG8_SCHED;
            PG8_LDA(At, 0, 1); PG8_STAGE(PG8_SB(0, 0), b2, vB2); PG8_STAGE(PG8_SB(0, 1), b2 + hB2, vB2); PG8_STAGE(PG8_SA(0, 0), a2, voffA);
            if (rlx >= 16) PG8_WAIT_V(24); else if (rlx >= 8) PG8_WAIT_V(16); else PG8_WAIT_V(8);
            PG8_WAIT_L(0); PG8_BAR; PG8_MMA(1, 0, At, B0); PG8_MMA(1, 1, At, B1); PG8_BAR; PG8_SCHED;
            PG8_LDB(B0, 1, 0); PG8_LDB(B1, 1, 1); PG8_SCHED; PG8_LDA(At, 1, 0); PG8_STAGE(PG8_SA(0, 1), a2 + hstepA, voffA);
            PG8_WAIT_V(8); PG8_WAIT_L(0); PG8_BAR; PG8_MMA(0, 0, At, B0); PG8_MMA(0, 1, At, B1); PG8_BAR; PG8_SCHED;
            PG8_LDA(At, 1, 1); PG8_STAGE(PG8_SB(1, 0), b3, vB2); PG8_STAGE(PG8_SB(1, 1), b3 + hB2, vB2); PG8_STAGE(PG8_SA(1, 0), a3, voffA);
            PG8_WAIT_V(8); PG8_WAIT_L(0); PG8_BAR; PG8_MMA(1, 0, At, B0); PG8_MMA(1, 1, At, B1); PG8_BAR; PG8_SCHED;
        }
        if (wr == 0) PG8_BAR;
        { int t_e = threadIdx.x; asm volatile("" : "+v"(t_e)); if (has_next) E.prefetch(nxt, (ui + 1) & 1, lds, wid, t_e & 63); E(acc, cur, wr, wc, t_e & 15, (t_e >> 4) & 3, lds, ui & 1); }
        if (!has_next) break;
#pragma unroll
        for (int a = 0; a < 2; ++a)
#pragma unroll
            for (int b = 0; b < 2; ++b)
#pragma unroll
                for (int m = 0; m < 4; ++m)
#pragma unroll
                    for (int n = 0; n < 2; ++n) acc[a][b][m][n] = (f32x4){0.f, 0.f, 0.f, 0.f};
        relax = (cur.type == 0 && cur.u.pn >= 4) ? 8 : 16;
        cur = nxt; cA = nA; cB = nB; voffB[0] = nvoffB[0]; voffB[1] = nvoffB[1]; hstepB = nhstepB; ++ui;
        if (wr == 1) PG8_BAR;
    }
    PG8_WAIT_V(0);
    PG8_BAR;
#undef PG8_SA
#undef PG8_SB
#undef PG8_STAGE
#undef PG8_LDA
#undef PG8_LDB
#undef PG8_MMA
#undef PG8_WAIT_V
#undef PG8_WAIT_L
#undef PG8_BAR
#undef PG8_SCHED
}

typedef f32x4 Acc[2][2][4][2];

struct EpiStore { static constexpr bool HAS_PREFETCH = false; static constexpr int NST = 16;
    bf16_t* O; int ldc; bool nt = false;
    __device__ __forceinline__ void operator()(const Acc& acc, const Unit& u, int wr, int wc, int fr, int fq) const {
        const int row0 = u.pm * BM + wr * 64 + fr, col0 = u.pn * BM + wc * 32 + 8 * fq;
#pragma unroll
        for (int ai = 0; ai < 2; ++ai)
#pragma unroll
            for (int m = 0; m < 4; ++m) { bf16_t* rowp = O + (size_t)(row0 + ai * HALF + m * 16) * ldc + col0;
#pragma unroll
                for (int bj = 0; bj < 2; ++bj) { const f32x4 v0 = acc[ai][bj][m][0], v1 = acc[ai][bj][m][1];
                    u32x4 w; w.x = cvt_pk_bf16(v0[0], v0[1]); w.y = cvt_pk_bf16(v0[2], v0[3]); w.z = cvt_pk_bf16(v1[0], v1[1]); w.w = cvt_pk_bf16(v1[2], v1[3]);
                    if (nt) __builtin_nontemporal_store(w, (u32x4*)(rowp + bj * HALF)); else *(u32x4*)(rowp + bj * HALF) = w; } }
    }
};

struct EpiP { static constexpr bool HAS_PREFETCH = false, AFTER_DRAIN = false; static constexpr int NST = 8;
    bf16_t* O; bf16_t* U; float* ssq_q; float* ssq_kv;
    __device__ __forceinline__ void operator()(const Acc& acc, const Unit& u, int wr, int wc, int fr, int fq) const {
        const int row0 = u.pm * BM + wr * 64 + fr;
        if (u.pn >= 4) {
            bf16_t* ucol = U + 128 * (u.pn - 4) + 32 * wc + 8 * fq;
#pragma unroll
            for (int ai = 0; ai < 2; ++ai)
#pragma unroll
                for (int m = 0; m < 4; ++m) { const f32x4 v0 = acc[ai][0][m][0] * acc[ai][1][m][0], v1 = acc[ai][0][m][1] * acc[ai][1][m][1];
                    u32x4 w; w.x = cvt_pk_bf16(v0[0], v0[1]); w.y = cvt_pk_bf16(v0[2], v0[3]); w.z = cvt_pk_bf16(v1[0], v1[1]); w.w = cvt_pk_bf16(v1[2], v1[3]);
                    *(u32x4*)(ucol + (size_t)(row0 + ai * HALF + m * 16) * 512) = w; }
            return;
        }
        EpiStore st{O, PW}; st(acc, u, wr, wc, fr, fq);
        if (u.pn <= 1) {
            float* dst = (u.pn == 0) ? ssq_q : ssq_kv;
#pragma unroll
            for (int ai = 0; ai < 2; ++ai)
#pragma unroll
                for (int m = 0; m < 4; ++m) { float s = 0.f;
#pragma unroll
                    for (int n = 0; n < 2; ++n) { const f32x4 a = acc[ai][0][m][n]; s += (a[0] * a[0] + a[1] * a[1]) + (a[2] * a[2] + a[3] * a[3]); }
                    if (u.pn == 0) {
#pragma unroll
                        for (int n = 0; n < 2; ++n) { const f32x4 a = acc[ai][1][m][n]; s += (a[0] * a[0] + a[1] * a[1]) + (a[2] * a[2] + a[3] * a[3]); } }
                    s += __shfl_xor(s, 16); s += __shfl_xor(s, 32);
                    if (fq == 0) dst[(size_t)(row0 + ai * HALF + m * 16) * 4 + wc] = s; }
        }
    }
};

constexpr int SSQ_LDS = RING_BYTES + 1024;
struct EpiKV { static constexpr bool HAS_PREFETCH = false, AFTER_DRAIN = false; static constexpr int NST = 16;
    bf16_t* KN; bf16_t* V;
    __device__ __forceinline__ void operator()(const Acc& acc, const Unit& u, int wr, int wc, int fr, int fq, LAS unsigned char* lds, int buf) const {
        const int b = u.pm >> 3;
        const LAS f32x4* sq = (const LAS f32x4*)(lds + SSQ_LDS + buf * 4096) + wr * 64 + fr;
        float f[2][4];
#pragma unroll
        for (int ai = 0; ai < 2; ++ai)
#pragma unroll
            for (int m = 0; m < 4; ++m) { const f32x4 sp = sq[ai * HALF + m * 16]; f[ai][m] = rsqrtf(((sp[0] + sp[1]) + (sp[2] + sp[3])) * (1.f / 128.f) + 1e-6f); }
#pragma unroll
        for (int bj = 0; bj < 2; ++bj) { const int g = 8 * u.pn + 4 * bj + wc, head = g >> 2, part = g & 3;
            char* base = (part < 2) ? (char*)KN + (4 * part + fq) * 1024 + fr * 16 : (char*)V + (part - 2) * 4096 + fr * 64 + fq * 16;
            const int mstep = (part < 2) ? 256 : 1024;
            base += (size_t)(b * 8 + head) * 32 * 8192;
#pragma unroll
            for (int ai = 0; ai < 2; ++ai) { const int tile = (4 * u.pm + 2 * ai + wr) & 31;
#pragma unroll
                for (int m = 0; m < 4; ++m) {
                    const f32x4 v0 = acc[ai][bj][m][0] * f[ai][m], v1 = acc[ai][bj][m][1] * f[ai][m];
                    u32x4 w; w.x = cvt_pk_bf16(v0[0], v0[1]); w.y = cvt_pk_bf16(v0[2], v0[3]); w.z = cvt_pk_bf16(v1[0], v1[1]); w.w = cvt_pk_bf16(v1[2], v1[3]);
                    __builtin_nontemporal_store(w, (u32x4*)(base + (size_t)tile * 8192 + m * mstep)); } } }
    }
};

struct MixedOrder {
    const char* HB; const char* P; const char* WIN; const char* WQ; const char* WKV; int G, c;
    __device__ __forceinline__ void set_long(int k, MUnit& m) const { const int li = k * G + c, w = (li % NXCD) * 96 + li / NXCD, pm = w / 6, pn = 2 + w % 6;
        m.A = HB + (size_t)pm * (256 * 1024 * 2); m.B = WIN + (size_t)pn * (256 * 1024 * 2); m.nt = 16; m.kb2 = 2048u; m.type = 0; m.u.pm = pm; m.u.pn = pn; }
    __device__ __forceinline__ void set_short(int k, MUnit& m) const { const int si = k * G + c, s = (si % NXCD) * 112 + si / NXCD;
        if (s < 384) { const int pm = s / 3, pn = s % 3; m.A = P + (size_t)pm * (256 * 1024 * 2); m.B = WQ + (size_t)pn * (256 * 256 * 2); m.nt = 4; m.kb2 = 512u; m.type = 1; m.u.pm = pm; m.u.pn = pn; }
        else { const int s2 = s - 384, pm = s2 >> 2, pn = s2 & 3; m.A = P + 512 + (size_t)pm * (256 * 1024 * 2); m.B = WKV + (size_t)pn * (256 * 256 * 2); m.nt = 4; m.kb2 = 512u; m.type = 2; m.u.pm = pm; m.u.pn = pn; } }
    __device__ __forceinline__ bool next(int i, MUnit& m) const {
        const int ns = (c < 128) ? 4 : 3; if (i >= 3 + ns) return false;
        const int k = i >> 1; const bool even = (c & 1) == 0;
        if (i == 6) { set_short(3, m); return true; }
        if (even == ((i & 1) == 0)) set_long(k, m); else set_short(k, m);
        return true;
    }
};
struct EpiMix { EpiP p; EpiStore q; EpiKV kv; const float* ssqkv;
    __device__ __forceinline__ void prefetch(const MUnit& m, int buf, LAS unsigned char* lds, int wid, int lane) const {
        if (m.type == 2 && wid < 4) __builtin_amdgcn_global_load_lds((const unsigned*)(ssqkv + (size_t)m.u.pm * 1024 + wid * 256 + lane * 4), (LAS unsigned*)(lds + SSQ_LDS + buf * 4096 + wid * 1024), 16, 0, 0);
    }
    __device__ __forceinline__ void operator()(const Acc& acc, const MUnit& m, int wr, int wc, int fr, int fq, LAS unsigned char* lds, int buf) const {
        if (m.type == 0) p(acc, m.u, wr, wc, fr, fq); else if (m.type == 1) q(acc, m.u, wr, wc, fr, fq); else kv(acc, m.u, wr, wc, fr, fq, lds, buf);
    }
};

template <int CTRL> __device__ __forceinline__ float dppf(float v) { return __builtin_bit_cast(float, __builtin_amdgcn_update_dpp(0, __builtin_bit_cast(int, v), CTRL, 0xf, 0xf, true)); }
template <int CTRL> __device__ __forceinline__ f32x4 dpp4(f32x4 v) { f32x4 r; r[0] = dppf<CTRL>(v[0]); r[1] = dppf<CTRL>(v[1]); r[2] = dppf<CTRL>(v[2]); r[3] = dppf<CTRL>(v[3]); return r; }

constexpr int CW_LDS = RING_BYTES + 1024;
struct EpiUp { static constexpr bool HAS_PREFETCH = true; static constexpr int NST = 0;
    bf16_t* ACT; float* E; const float* cw; const float* cb;
    __device__ __forceinline__ void prefetch(const Unit& u, int buf, LAS unsigned char* lds, int wid, int lane) const {
        if (wid < 4) { const float* base = (wid < 3) ? cw + (size_t)wid * UPW : cb;
            const float* src = base + 128 * u.pn + ((lane & 32) ? DFF : 0) + 4 * (lane & 31);
            __builtin_amdgcn_global_load_lds((const unsigned*)src, (LAS unsigned*)(lds + CW_LDS + buf * 4096 + wid * 1024), 16, 0, 0); }
    }
    __device__ __forceinline__ void run(const Acc& acc, const Unit& u, int wr, int wc, int fr, int fq, LAS unsigned char* lds, int buf) const {
        const int cl = 32 * wc + 8 * fq;
        const int cbase = 128 * u.pn + cl;
        const LAS float* wl = (const LAS float*)(lds + CW_LDS + buf * 4096) + cl;
        u32x2 res0[2][4];
#pragma unroll
        for (int n = 0; n < 2; ++n) { const int c0 = cbase + 4 * n;
            const f32x4 wg0 = *(const LAS f32x4*)(wl + 4 * n), wg1 = *(const LAS f32x4*)(wl + 256 + 4 * n), wg2 = *(const LAS f32x4*)(wl + 512 + 4 * n), bg = *(const LAS f32x4*)(wl + 768 + 4 * n);
            const f32x4 wv0 = *(const LAS f32x4*)(wl + 128 + 4 * n), wv1 = *(const LAS f32x4*)(wl + 384 + 4 * n), wv2 = *(const LAS f32x4*)(wl + 640 + 4 * n), bv = *(const LAS f32x4*)(wl + 896 + 4 * n);
#pragma unroll
            for (int ai = 0; ai < 2; ++ai) { f32x4 pg1 = {0.f, 0.f, 0.f, 0.f}, pg2 = pg1, pv1 = pg1, pv2 = pg1;
                const int blk = 4 * u.pm + 2 * ai + wr;
#pragma unroll
                for (int m = 0; m < 4; ++m) { const f32x4 gcur = acc[ai][0][m][n], vcur = acc[ai][1][m][n];
                    const f32x4 rg1 = dpp4<0x121>(gcur), rg2 = dpp4<0x122>(gcur), rv1 = dpp4<0x121>(vcur), rv2 = dpp4<0x122>(vcur);
                    const f32x4 g1 = (fr >= 1) ? rg1 : pg1, g2 = (fr >= 2) ? rg2 : pg2, v1 = (fr >= 1) ? rv1 : pv1, v2 = (fr >= 2) ? rv2 : pv2;
                    const f32x4 cg = bg + wg0 * g2 + wg1 * g1 + wg2 * gcur, cv = bv + wv0 * v2 + wv1 * v1 + wv2 * vcur;
                    f32x4 a; a[0] = silu_f(cg[0]) * cv[0]; a[1] = silu_f(cg[1]) * cv[1]; a[2] = silu_f(cg[2]) * cv[2]; a[3] = silu_f(cg[3]) * cv[3];
                    u32x2 w; w.x = cvt_pk_bf16(a[0], a[1]); w.y = cvt_pk_bf16(a[2], a[3]);
                    const int t = u.pm * BM + ai * HALF + wr * 64 + m * 16 + fr;
                    if (n == 0) res0[ai][m] = w;
                    else if (!(m == 0 && fr < 2)) { u32x4 o; o.x = res0[ai][m].x; o.y = res0[ai][m].y; o.z = w.x; o.w = w.y; __builtin_nontemporal_store(o, (u32x4*)(ACT + (size_t)t * DFF + cbase)); }
                    if (m == 0 && fr < 2) { float* e = E + ((size_t)blk * 4 + fr) * UPW + c0; *(f32x4*)e = gcur; *(f32x4*)(e + DFF) = vcur; }
                    if (m == 3 && fr >= 14) { float* e = E + ((size_t)blk * 4 + 2 + (fr - 14)) * UPW + c0; *(f32x4*)e = gcur; *(f32x4*)(e + DFF) = vcur; }
                    pg1 = rg1; pg2 = rg2; pv1 = rv1; pv2 = rv2; } } }
    }
};
}

namespace att {
constexpr int NSLOT = 3, K_OFF = 0, KSLOT = 12288, V_OFF = NSLOT * KSLOT, VSLOT = 8192, WS_OFF = V_OFF + NSLOT * VSLOT, OST_OFF = WS_OFF + 8 * 256, LDS_END = OST_OFF + 8 * 8192;
static_assert(LDS_END <= RING_BYTES, "attention LDS");
__device__ __forceinline__ int crow(int r, int hi) { return (r & 3) + 8 * (r >> 2) + 4 * hi; }
typedef short v4i16_t __attribute__((ext_vector_type(4)));
__device__ __forceinline__ s16x4 vtr(const LAS unsigned char* p) { return __builtin_bit_cast(s16x4, __builtin_amdgcn_ds_read_tr16_b64_v4i16((LAS v4i16_t*)p)); }
__device__ __forceinline__ void glds(const char* src, LAS unsigned char* dst) { unsigned keep; const unsigned d = (unsigned)__builtin_amdgcn_readfirstlane((int)(unsigned)(uintptr_t)dst);
    asm volatile("s_mov_b32 %0, m0\n\ts_mov_b32 m0, %2\n\ts_nop 0\n\tglobal_load_lds_dwordx4 %1, off\n\ts_mov_b32 m0, %0" : "=&s"(keep) : "v"(src), "s"(d) : "memory"); }
__device__ __forceinline__ float max3f(float a, float b, float c) { float r; asm("v_max3_f32 %0, %1, %2, %3" : "=v"(r) : "v"(a), "v"(b), "v"(c)); return r; }
__device__ __forceinline__ float max2f(float a, float b) { float r; asm("v_max_f32_e32 %0, %1, %2" : "=v"(r) : "v"(a), "v"(b)); return r; }
__device__ __forceinline__ float fadd_s(float a, float b) { float r = a + b; asm volatile("" : "+v"(r)); return r; }
typedef float f32x2_t __attribute__((ext_vector_type(2))); typedef __bf16 bf16x2_t __attribute__((ext_vector_type(2)));
__device__ __forceinline__ unsigned cvtpk_m(float lo, float hi) { f32x2_t v = {lo, hi}; bf16x2_t b2 = __builtin_convertvector(v, bf16x2_t); return __builtin_bit_cast(unsigned, b2); }
__device__ __forceinline__ float xmax32(float v) { float a = v, b = v; asm("s_nop 1\n\tv_permlane32_swap_b32 %0, %1\n\ts_nop 1\n\tv_max_f32_e32 %0, %0, %1" : "+v"(a), "+v"(b)); return a; }
constexpr float THRL = 4.0f;

struct AUnit { int b, h, qb; };
__device__ __forceinline__ bool unit_of(int k, int vcu, int G, AUnit& u) {
    const int it = vcu + (k >> 2) * G, r = k & 3; if (it >= 256) return false;
    const int grp = it >> 3, i8 = it & 7, bh = grp * 4 + r; u.b = bh >> 3; u.h = bh & 7;
    u.qb = (r == 0) ? 7 - i8 : (r == 1) ? i8 : (r == 2) ? 7 - (i8 ^ 1) : (i8 ^ 1); return true;
}
__device__ __forceinline__ void attn_phase(int vcu, int G, const float* ssqq, const float* rope, const bf16_t* Q, const bf16_t* KN, const bf16_t* KR, const bf16_t* V, bf16_t* Y, const float* ong, LAS unsigned char* lds) {
    int tid = threadIdx.x; asm volatile("" : "+v"(tid));
    const int lane = tid & 63, r32 = lane & 31, hi = lane >> 5; const int wid = __builtin_amdgcn_readfirstlane(tid >> 6);
    const int lo16 = wid * 1024 + lane * 16;
    LAS float* wsf = (LAS float*)(lds + WS_OFF + wid * 256);
    const int kl = hi * 1024 + r32 * 16, vl = ((lane >> 4) & 1) * 32 + (lane & 3) * 8 + (4 * hi + ((lane & 15) >> 2)) * 64;
#define ATT_ISSUE(U, tile, slot) do { const size_t bh_ = (size_t)((U).b * 8 + (U).h); \
        glds((const char*)KN + (bh_ * 32 + (tile)) * 8192 + lo16, lds + K_OFF + (slot) * KSLOT + wid * 1024); glds((const char*)V + (bh_ * 32 + (tile)) * 8192 + lo16, lds + V_OFF + (slot) * VSLOT + wid * 1024); \
        if (wid < 4) glds((const char*)KR + ((size_t)(U).b * 32 + (tile)) * 4096 + lo16, lds + K_OFF + (slot) * KSLOT + 8192 + wid * 1024); } while (0)
#define ATT_QLOAD(dst, aux, U) do { const size_t row_ = (size_t)((U).b * SEQ + 256 * (U).qb + 32 * wid + r32); const bf16_t* qp_ = Q + row_ * QW + 96 * (U).h + 8 * hi; \
        _Pragma("unroll") for (int ks = 0; ks < 6; ++ks) dst[ks] = *(const bf16x8*)(qp_ + 16 * ks); \
        aux[0] = *(const f32x4*)(ssqq + row_ * 4); aux[1] = *(const f32x4*)(rope + row_ * 32 + 8 * hi); aux[2] = *(const f32x4*)(rope + row_ * 32 + 8 * hi + 4); \
        aux[3] = *(const f32x4*)(rope + row_ * 32 + 16 + 8 * hi); aux[4] = *(const f32x4*)(rope + row_ * 32 + 16 + 8 * hi + 4); } while (0)
#define ATT_QFIX(q, aux) do { const float f_ = rsqrtf(((aux[0][0] + aux[0][1]) + (aux[0][2] + aux[0][3])) * (1.f / 256.f) + 1e-6f) * QSCALE; \
        _Pragma("unroll") for (int ks = 0; ks < 4; ++ks) { const u32x4 w_ = __builtin_bit_cast(u32x4, q[ks]); u32x4 o_; \
            _Pragma("unroll") for (int e = 0; e < 4; ++e) o_[e] = cvtpk_m(bf_lo(w_[e]) * f_, bf_hi(w_[e]) * f_); q[ks] = __builtin_bit_cast(bf16x8, o_); } \
        { const u32x4 a_ = __builtin_bit_cast(u32x4, q[4]), b_ = __builtin_bit_cast(u32x4, q[5]); u32x4 oa_, ob_; \
          _Pragma("unroll") for (int e = 0; e < 4; ++e) { const float x1l = bf_lo(a_[e]), x1h = bf_hi(a_[e]), x2l = bf_lo(b_[e]), x2h = bf_hi(b_[e]); \
              const float cl = (e < 2) ? aux[1][2 * e] : aux[2][2 * e - 4], ch = (e < 2) ? aux[1][2 * e + 1] : aux[2][2 * e - 3], sl = (e < 2) ? aux[3][2 * e] : aux[4][2 * e - 4], sh = (e < 2) ? aux[3][2 * e + 1] : aux[4][2 * e - 3]; \
              oa_[e] = cvtpk_m((x1l * cl - x2l * sl) * f_, (x1h * ch - x2h * sh) * f_); ob_[e] = cvtpk_m((x2l * cl + x1l * sl) * f_, (x2h * ch + x1h * sh) * f_); } \
          q[4] = __builtin_bit_cast(bf16x8, oa_); q[5] = __builtin_bit_cast(bf16x8, ob_); } } while (0)
    AUnit cur, nxt;
    if (!unit_of(0, vcu, G, cur)) return;
    bf16x8 qr[6], qn[6]; f32x4 qa[5], qna[5];
    ATT_QLOAD(qr, qa, cur);
    ATT_QFIX(qr, qa);
    asm volatile("" : "+v"(qr[0]), "+v"(qr[1]), "+v"(qr[2]), "+v"(qr[3]), "+v"(qr[4]), "+v"(qr[5]));
    ATT_ISSUE(cur, 0, 0); ATT_ISSUE(cur, 1, 1);
    int slot = 0;
    for (int k = 0;; ++k) {
        const bool has_next = unit_of(k + 1, vcu, G, nxt);
        const int NT = 4 * cur.qb + 4, jmax = 4 * cur.qb + (wid >> 1);
        float mrun = 0.f, lrun = 0.f; f32x16 o[2]; o[0] = f32x16{}; o[1] = f32x16{}; f32x16 negm = f32x16{};
        for (int j = 0; j < NT; ++j) {
            if (j == 0 && k > 0) { if (wid < 4) asm volatile("s_waitcnt vmcnt(13) lgkmcnt(0)\n\ts_barrier" ::: "memory"); else asm volatile("s_waitcnt vmcnt(12) lgkmcnt(0)\n\ts_barrier" ::: "memory"); }
            else if (j + 1 < NT || has_next) { if (wid < 4) asm volatile("s_waitcnt vmcnt(3) lgkmcnt(0)\n\ts_barrier" ::: "memory"); else asm volatile("s_waitcnt vmcnt(2) lgkmcnt(0)\n\ts_barrier" ::: "memory"); }
            else asm volatile("s_waitcnt vmcnt(0) lgkmcnt(0)\n\ts_barrier" ::: "memory");
            { const int s2 = (slot == 0) ? 2 : slot - 1;
              if (j + 2 < NT) ATT_ISSUE(cur, j + 2, s2); else if (has_next) ATT_ISSUE(nxt, j + 2 - NT, s2); }
            if (j == NT - 1 && has_next) ATT_QLOAD(qn, qna, nxt);
            if (j <= jmax) {
                const LAS unsigned char* kp = lds + K_OFF + slot * KSLOT + kl;
                f32x16 p0, p1;
#pragma unroll
                for (int ks = 0; ks < 6; ++ks) { const bf16x8 k0 = *(const LAS bf16x8*)(kp + ks * 2048), k1 = *(const LAS bf16x8*)(kp + ks * 2048 + 512);
                    if (ks == 0) { p0 = __builtin_amdgcn_mfma_f32_32x32x16_bf16(k0, qr[0], negm, 0, 0, 0); p1 = __builtin_amdgcn_mfma_f32_32x32x16_bf16(k1, qr[0], negm, 0, 0, 0); }
                    else { p0 = __builtin_amdgcn_mfma_f32_32x32x16_bf16(k0, qr[ks], p0, 0, 0, 0); p1 = __builtin_amdgcn_mfma_f32_32x32x16_bf16(k1, qr[ks], p1, 0, 0, 0); } }
                const LAS unsigned char* vp = lds + V_OFF + slot * VSLOT + vl;
                s16x4 vlo[4], vhi[4];
#pragma unroll
                for (int ks = 0; ks < 4; ++ks) { vlo[ks] = vtr(vp + ks * 1024); vhi[ks] = vtr(vp + ks * 1024 + 512); }
                asm volatile("s_nop 15\n\ts_nop 7" : "+v"(p0), "+v"(p1) : : "memory");
                float rm;
                { float a = max3f(p0[0], p0[1], p1[0]), c = max3f(p0[2], p0[3], p1[1]); a = max3f(a, p1[2], p1[3]);
#pragma unroll
                  for (int r = 4; r < 16; r += 4) { a = max3f(a, p0[r], p0[r + 1]); c = max3f(c, p0[r + 2], p0[r + 3]); a = max3f(a, p1[r], p1[r + 1]); c = max3f(c, p1[r + 2], p1[r + 3]); }
                  rm = max2f(a, c); rm = xmax32(rm); }
                if (j == 0 || __any(rm > THRL)) {
                    const float dl = (j == 0) ? rm : fmaxf(rm, 0.f);
                    mrun += dl;
#pragma unroll
                    for (int r = 0; r < 16; ++r) { p0[r] -= dl; p1[r] -= dl; }
#pragma unroll
                    for (int r = 0; r < 16; ++r) negm[r] = -mrun;
                    if (j != 0) { const float alpha = fexp2(-dl); lrun *= alpha;
                        if (hi == 0) wsf[r32] = alpha;
#pragma unroll
                        for (int r = 0; r < 16; ++r) { const float a_ = wsf[crow(r, hi)]; o[0][r] *= a_; o[1][r] *= a_; } }
                }
#pragma unroll
                for (int r = 0; r < 16; ++r) { p0[r] = fexp2(p0[r]); p1[r] = fexp2(p1[r]); }
                { float s0 = fadd_s(p0[0], p1[0]), s1 = fadd_s(p0[1], p1[1]);
#pragma unroll
                  for (int r = 2; r < 16; r += 2) { s0 = fadd_s(s0, p0[r]); s1 = fadd_s(s1, p0[r + 1]); s0 = fadd_s(s0, p1[r]); s1 = fadd_s(s1, p1[r + 1]); }
                  lrun = fadd_s(lrun, fadd_s(s0, s1)); }
                bf16x8 pa[4];
                { u32x4 w0, w1, w2, w3;
                  w0.x = cvtpk_m(p0[0], p0[1]); w0.y = cvtpk_m(p0[2], p0[3]); w0.z = cvtpk_m(p0[4], p0[5]); w0.w = cvtpk_m(p0[6], p0[7]);
                  w1.x = cvtpk_m(p0[8], p0[9]); w1.y = cvtpk_m(p0[10], p0[11]); w1.z = cvtpk_m(p0[12], p0[13]); w1.w = cvtpk_m(p0[14], p0[15]);
                  w2.x = cvtpk_m(p1[0], p1[1]); w2.y = cvtpk_m(p1[2], p1[3]); w2.z = cvtpk_m(p1[4], p1[5]); w2.w = cvtpk_m(p1[6], p1[7]);
                  w3.x = cvtpk_m(p1[8], p1[9]); w3.y = cvtpk_m(p1[10], p1[11]); w3.z = cvtpk_m(p1[12], p1[13]); w3.w = cvtpk_m(p1[14], p1[15]);
                  pa[0] = __builtin_bit_cast(bf16x8, w0); pa[1] = __builtin_bit_cast(bf16x8, w1); pa[2] = __builtin_bit_cast(bf16x8, w2); pa[3] = __builtin_bit_cast(bf16x8, w3); }
                s16x4 wlo[4], whi[4];
#pragma unroll
                for (int ks = 0; ks < 4; ++ks) { wlo[ks] = vtr(vp + 4096 + ks * 1024); whi[ks] = vtr(vp + 4096 + ks * 1024 + 512); }
                asm volatile("" ::: "memory");
#pragma unroll
                for (int ks = 0; ks < 4; ++ks) { const bf16x8 vf = {vlo[ks][0], vlo[ks][1], vlo[ks][2], vlo[ks][3], vhi[ks][0], vhi[ks][1], vhi[ks][2], vhi[ks][3]};
                    o[0] = __builtin_amdgcn_mfma_f32_32x32x16_bf16(pa[ks], vf, o[0], 0, 0, 0); }
#pragma unroll
                for (int ks = 0; ks < 4; ++ks) { const bf16x8 vf = {wlo[ks][0], wlo[ks][1], wlo[ks][2], wlo[ks][3], whi[ks][0], whi[ks][1], whi[ks][2], whi[ks][3]};
                    o[1] = __builtin_amdgcn_mfma_f32_32x32x16_bf16(pa[ks], vf, o[1], 0, 0, 0); }
            }
            slot = (slot == 2) ? 0 : slot + 1;
        }
        { const float lt = lrun + __shfl_xor(lrun, 32);
          if (hi == 0) wsf[r32] = frcp(lt);
          LAS float* stg = (LAS float*)(lds + OST_OFF + wid * 8192);
#pragma unroll
          for (int r = 0; r < 16; ++r) { const float inv = wsf[crow(r, hi)]; const int orow = crow(r, hi); stg[orow * 64 + r32] = o[0][r] * inv; stg[orow * 64 + 32 + r32] = o[1][r] * inv; }
          asm volatile("s_waitcnt lgkmcnt(0)" ::: "memory");
          const int ch = lane & 7;
          const f32x4 ga = *(const f32x4*)(ong + 64 * cur.h + 8 * ch), gb = *(const f32x4*)(ong + 64 * cur.h + 8 * ch + 4);
          bf16_t* Yw = Y + (size_t)(cur.b * SEQ + 256 * cur.qb + 32 * wid) * D + 64 * cur.h + 8 * ch;
#pragma unroll
          for (int i = 0; i < 4; ++i) { const int row = i * 8 + (lane >> 3);
              const f32x4 va = *(const LAS f32x4*)(stg + row * 64 + 8 * ch), vb = *(const LAS f32x4*)(stg + row * 64 + 8 * ch + 4);
              float ss = (va[0] * va[0] + va[1] * va[1]) + (va[2] * va[2] + va[3] * va[3]) + (vb[0] * vb[0] + vb[1] * vb[1]) + (vb[2] * vb[2] + vb[3] * vb[3]);
              ss += pg8::dppf<0xB1>(ss); ss += pg8::dppf<0x4E>(ss); ss += pg8::dppf<0x141>(ss);
              const float rs = rsqrtf(ss * (1.f / 64.f) + 1e-6f);
              const f32x4 oa = va * rs * ga, ob = vb * rs * gb;
              u32x4 w; w.x = cvtpk_m(oa[0], oa[1]); w.y = cvtpk_m(oa[2], oa[3]); w.z = cvtpk_m(ob[0], ob[1]); w.w = cvtpk_m(ob[2], ob[3]);
              *(u32x4*)(Yw + (size_t)row * D) = w; } }
        if (!has_next) break;
        cur = nxt;
#pragma unroll
        for (int ks = 0; ks < 6; ++ks) qr[ks] = qn[ks];
        ATT_QFIX(qr, qna);
    }
    asm volatile("s_waitcnt vmcnt(0) lgkmcnt(0)\n\ts_barrier" ::: "memory");
#undef ATT_ISSUE
#undef ATT_QLOAD
#undef ATT_QFIX
}
}

#define XB_TMO      128
#define XB_XCNT(j)  (256  + 64 * (j))
#define XB_XSUB(j)  (1280 + 64 * (j))
#define XB_XGEN(j)  (2304 + 64 * (j))
#define XB_TOP      3328
#define XB_TOPGEN   3392
#define XCD_BAR_WORDS 3456
#define XB_SPIN_CAP (1u << 18)
__device__ __forceinline__ unsigned xb_ld(unsigned* p)              { return __hip_atomic_load(p, __ATOMIC_RELAXED, __HIP_MEMORY_SCOPE_AGENT); }
__device__ __forceinline__ unsigned xb_add(unsigned* p, unsigned v) { return __hip_atomic_fetch_add(p, v, __ATOMIC_RELAXED, __HIP_MEMORY_SCOPE_AGENT); }
__device__ __forceinline__ unsigned xb_xcc_id() { return (unsigned)__builtin_amdgcn_s_getreg((3 << 11) | 20) & 0xFu; }
#define XB_SPIN(cond, bar) do { unsigned _sp = 0; while (cond) { __builtin_amdgcn_s_sleep(1); \
    if ((++_sp & 255u) == 0u) { if (xb_ld(&(bar)[XB_TMO])) break; if (_sp > XB_SPIN_CAP) { atomicAdd(&(bar)[XB_TMO], 1u); break; } } } } while (0)
struct XcdBarrier { unsigned* bar; unsigned x; volatile LAS unsigned* st; };
__device__ __forceinline__ XcdBarrier xcd_barrier_post(unsigned* bar, volatile LAS unsigned* st) {
    XcdBarrier b; b.bar = bar; b.x = xb_xcc_id(); b.st = st;
    if (threadIdx.x == 0) (void)xb_add(&bar[XB_XCNT(b.x)], 1u);
    return b;
}
__device__ __forceinline__ void xcd_barrier_complete(unsigned* bar, unsigned x, unsigned& nloc, unsigned& nx) {
    const unsigned G = gridDim.x * gridDim.y * gridDim.z;
    unsigned sum, cnt, mine, sp = 0u;
    for (;;) {
        sum = 0u; cnt = 0u; mine = 0u;
#pragma unroll
        for (unsigned j = 0; j < 16; ++j) { const unsigned c = xb_ld(&bar[XB_XCNT(j)]); sum += c; cnt += (c > 0u) ? 1u : 0u; mine = (j == x) ? c : mine; }
        if (sum == G) break;
        __builtin_amdgcn_s_sleep(1);
        if ((++sp & 255u) == 0u) { if (xb_ld(&bar[XB_TMO])) break; if (sp > XB_SPIN_CAP) { atomicAdd(&bar[XB_TMO], 1u); break; } }
    }
    nloc = mine > 0u ? mine : 1u; nx = cnt > 0u ? cnt : 1u;
}
__device__ __forceinline__ void xcd_barrier(const XcdBarrier& b) {
    asm volatile("s_waitcnt vmcnt(0)" ::: "memory");
    __syncthreads();
    if (threadIdx.x == 0) {
        unsigned* bar = b.bar;
        __builtin_amdgcn_s_waitcnt(0);
        unsigned nloc = b.st[0], nx = b.st[1];
        if (nloc == 0u) { xcd_barrier_complete(bar, b.x, nloc, nx); b.st[0] = nloc; b.st[1] = nx; }
        const unsigned old = xb_add(&bar[XB_XSUB(b.x)], 1u);
        const unsigned gen = old / nloc;
        if (old + 1u == (gen + 1u) * nloc) {
            __builtin_amdgcn_fence(__ATOMIC_RELEASE, "agent");
            asm volatile("s_waitcnt vmcnt(0)" ::: "memory");
            const unsigned og = xb_add(&bar[XB_TOP], 1u);
            const unsigned tg = og / nx;
            if (og + 1u == (tg + 1u) * nx) xb_add(&bar[XB_TOPGEN], 1u);
            else XB_SPIN(xb_ld(&bar[XB_TOPGEN]) == tg, bar);
            __builtin_amdgcn_fence(__ATOMIC_ACQUIRE, "agent");
            xb_add(&bar[XB_XGEN(b.x)], 1u);
            asm volatile("s_waitcnt vmcnt(0)" ::: "memory");
        } else {
            XB_SPIN(xb_ld(&bar[XB_XGEN(b.x)]) == gen, bar);
            __builtin_amdgcn_fence(__ATOMIC_ACQUIRE, "agent");
            asm volatile("s_waitcnt vmcnt(0)" ::: "memory");
        }
    }
    __syncthreads();
}

struct Args { const float* in[22]; const int* pos; float* out; unsigned char* ws; int ph_lo, ph_hi; };
__constant__ float c_invfreq[16] = {1.0f, 0.5623413251903491f, 0.31622776601683794f, 0.1778279410038923f, 0.1f, 0.05623413251903491f, 0.03162277660168379f, 0.01778279410038923f,
                                    0.01f, 0.005623413251903491f, 0.0031622776601683794f, 0.001778279410038923f, 0.001f, 0.0005623413251903491f, 0.00031622776601683794f, 0.0001778279410038923f};

__device__ __forceinline__ int colmap(int which, int s) {
    const int p = (s & ~31) + pg8::perm32(s & 31);
    switch (which) {
        case 0: { if (s < 1024) return p < 416 ? p : (p < 512 ? -1 : p - 96);
                  const int bj = (s >> 7) & 1, ch = 128 * ((s >> 8) - 4) + 32 * ((s >> 5) & 3) + pg8::perm32(s & 31); return (bj ? 1440 : 928) + ch; }
        case 4: { const int pn = s >> 8, bj = (s >> 7) & 1, wc = (s >> 5) & 3; return bj * DFF + 128 * pn + 32 * wc + pg8::perm32(s & 31); }
        default: return p;
    }
}
__device__ __forceinline__ void p0_transpose_item(const float* W, int ldw, int Ksrc, const float* kscale, bf16_t* WT, int Kdst, int which, LAS float* scr, int item, int nblk, int lane) {
    const int kb = item / nblk, nb = item % nblk, k0 = 64 * kb, s0 = 32 * nb;
    const int cm = colmap(which, s0 + (lane & 31));
    float tv[32];
#pragma unroll
    for (int i = 0; i < 32; ++i) { const int k = k0 + 2 * i + (lane >> 5); tv[i] = (cm >= 0 && k < Ksrc) ? __builtin_nontemporal_load(W + (size_t)k * ldw + cm) : 0.f; }
    if (kscale) {
#pragma unroll
        for (int i = 0; i < 32; ++i) { const int k = k0 + 2 * i + (lane >> 5); if (k < Ksrc) tv[i] *= kscale[k]; } }
#pragma unroll
    for (int i = 0; i < 32; ++i) scr[(2 * i + (lane >> 5)) * 33 + (lane & 31)] = tv[i];
    asm volatile("s_waitcnt lgkmcnt(0)" ::: "memory");
    const int c = lane & 7;
#pragma unroll
    for (int j = 0; j < 4; ++j) { const int n = (lane >> 3) + 8 * j; const LAS float* s = scr + (8 * c) * 33 + n;
        u32x4 o; o.x = cvt_pk_bf16(s[0 * 33], s[1 * 33]); o.y = cvt_pk_bf16(s[2 * 33], s[3 * 33]); o.z = cvt_pk_bf16(s[4 * 33], s[5 * 33]); o.w = cvt_pk_bf16(s[6 * 33], s[7 * 33]);
        *(u32x4*)(WT + (size_t)(s0 + n) * Kdst + k0 + 8 * c) = o; }
    asm volatile("s_waitcnt lgkmcnt(0)" ::: "memory");
}

constexpr int N_PHASES = 11;
#define OPAQUE_LANE(name) int name##_t = (int)threadIdx.x; asm volatile("" : "+v"(name##_t)); const int name = name##_t & 63

__global__ void __launch_bounds__(512, 2) mk_fwd(Args args) {
    extern __shared__ __attribute__((aligned(16))) unsigned char lds_raw[];
    LAS unsigned char* lds = (LAS unsigned char*)lds_raw;
    volatile LAS unsigned* MISC = (volatile LAS unsigned*)(lds + MISC_OFF);
    const int tid = threadIdx.x, lane = tid & 63, wave = __builtin_amdgcn_readfirstlane(tid >> 6);
    const int G = gridDim.x; const int bx = blockIdx.x; const int vcu = (G % 8 == 0) ? (bx % 8) * (G / 8) + bx / 8 : bx;
    const int gw = vcu * 8 + wave, NGW = G * 8;
    unsigned char* ws = args.ws;
    const float* x = args.in[0]; const float* cvec = args.in[1]; const int* pos = args.pos;
    const float* w_ada = args.in[3]; const float* b_ada = args.in[4]; const float* w_in = args.in[5];
    const float* qg = args.in[6]; const float* w_qup = args.in[7]; const float* kvg = args.in[8]; const float* w_kvup = args.in[9];
    const float* conv_w = args.in[10]; const float* conv_b = args.in[11]; const float* ong = args.in[12]; const float* w_out = args.in[13];
    const float* ln1g = args.in[14]; const float* ln1b = args.in[15]; const float* w_up = args.in[16];
    const float* fcw = args.in[17]; const float* fcb = args.in[18]; const float* w_down = args.in[19];
    const float* ln2g = args.in[20]; const float* ln2b = args.in[21];
    float* out = args.out;
    float* MOD = (float*)(ws + WS_MOD); float* ROPE = (float*)(ws + WS_ROPE); float* SSQQ = (float*)(ws + WS_SSQQ); float* SSQKV = (float*)(ws + WS_SSQKV);
    bf16_t* WIN = (bf16_t*)(ws + WS_WIN); bf16_t* WQ = (bf16_t*)(ws + WS_WQ); bf16_t* WKV = (bf16_t*)(ws + WS_WKV); bf16_t* WOUT = (bf16_t*)(ws + WS_WOUT);
    bf16_t* WUP = (bf16_t*)(ws + WS_WUP); bf16_t* WDN = (bf16_t*)(ws + WS_WDN);
    bf16_t* HB = (bf16_t*)(ws + WS_HB); bf16_t* FF = (bf16_t*)(ws + WS_FF); bf16_t* P = (bf16_t*)(ws + WS_P); bf16_t* MIX = (bf16_t*)(ws + WS_MIX);
    bf16_t* U = (bf16_t*)(ws + WS_U); bf16_t* Qb = (bf16_t*)(ws + WS_Q); bf16_t* KN = (bf16_t*)(ws + WS_KN); bf16_t* KR = (bf16_t*)(ws + WS_KR); bf16_t* Vb = (bf16_t*)(ws + WS_V);
    bf16_t* Y = (bf16_t*)(ws + WS_Y); bf16_t* X1 = (bf16_t*)(ws + WS_X1); bf16_t* ACT = (bf16_t*)(ws + WS_ACT); float* E = (float*)(ws + WS_E);

    for (int u = tid; u < (LDS_BYTES - LDSCTL_OFF) / 4; u += 512) ((LAS unsigned*)(lds + LDSCTL_OFF))[u] = 0u;
    __syncthreads();
    XcdBarrier bar; bar.bar = (unsigned*)(ws + WS_CTL) + CW_BAR; bar.x = 0; bar.st = nullptr;
    if (MK_N_LAUNCHES == 1) bar = xcd_barrier_post((unsigned*)(ws + WS_CTL) + CW_BAR, MISC + 8);
    const int lo = args.ph_lo, hi = args.ph_hi;
#ifndef PH_MASK
#define PH_MASK 0x7ff
#endif
#define IN(k) (((PH_MASK >> (k)) & 1) && lo <= (k) && (k) < hi)
#define SEAM(k) do { if (IN(k) && IN((k) + 1)) xcd_barrier(bar); } while (0)

    if (IN(0)) {
        OPAQUE_LANE(ln);
        if (bx < 192) {
            LAS float* cact = (LAS float*)lds; LAS float* part = (LAS float*)(lds + 65536);
            const int n0 = 32 * bx, c4 = tid & 7, kr = tid >> 3;
            f32x4 wv[16];
#pragma unroll
            for (int i = 0; i < 16; ++i) wv[i] = __builtin_nontemporal_load((const f32x4*)(w_ada + (size_t)(kr + 64 * i) * 6144 + n0 + 4 * c4));
            for (int i = tid; i < 16 * 1024; i += 512) { const float v = cvec[i]; cact[i] = v * frcp(1.f + fexp2(-LOG2E * v)); }
            __syncthreads();
            f32x4 a[16];
#pragma unroll
            for (int b = 0; b < 16; ++b) a[b] = (f32x4){0.f, 0.f, 0.f, 0.f};
#pragma unroll
            for (int i = 0; i < 16; ++i) { const int k = kr + 64 * i;
#pragma unroll
                for (int b = 0; b < 16; ++b) a[b] += wv[i] * cact[b * 1024 + k];
                if ((i & 1) == 1) asm volatile("" ::: "memory"); }
#pragma unroll
            for (int b = 0; b < 16; ++b)
#pragma unroll
                for (int e = 0; e < 4; ++e) { float v = a[b][e]; v += __shfl_xor(v, 8); v += __shfl_xor(v, 16); v += __shfl_xor(v, 32); a[b][e] = v; }
            if (ln < 8) {
#pragma unroll
                for (int b = 0; b < 16; ++b) *(LAS f32x4*)(part + (wave * 16 + b) * 32 + 4 * c4) = a[b]; }
            __syncthreads();
            { const int b = tid >> 5, col = tid & 31; float s = 0.f;
#pragma unroll
              for (int w8 = 0; w8 < 8; ++w8) s += part[(w8 * 16 + b) * 32 + col];
              MOD[b * 6144 + n0 + col] = s + b_ada[n0 + col]; }
            __syncthreads();
        }
        for (int idx = gw * 64 + ln; idx < T * 16; idx += NGW * 64) { const int t = idx >> 4, i = idx & 15; const float ang = (float)pos[t] * c_invfreq[i];
            ROPE[(size_t)t * 32 + i] = cosf(ang); ROPE[(size_t)t * 32 + 16 + i] = sinf(ang); }
    }
    SEAM(0);
    if (IN(1)) {
        OPAQUE_LANE(ln);
        {
        LAS float* scr = (LAS float*)(lds + wave * 16384);
        constexpr int I0 = 16 * 64, I1 = 4 * 24, I2 = 4 * 32, I3 = 16 * 32, I4 = 16 * 176, I5 = 44 * 32, NIT = I0 + I1 + I2 + I3 + I4 + I5;
        for (int it = gw; it < NIT; it += NGW) {
            int r = it;
            if (r < I0) { p0_transpose_item(w_in, INW, D, nullptr, WIN, D, 0, scr, r, 64, ln); continue; } r -= I0;
            if (r < I1) { p0_transpose_item(w_qup, QW, 256, qg, WQ, 256, 1, scr, r, 24, ln); continue; } r -= I1;
            if (r < I2) { p0_transpose_item(w_kvup, 1024, 128, kvg, WKV, 256, 2, scr, r, 32, ln); continue; } r -= I2;
            if (r < I3) { p0_transpose_item(w_out, D, D, nullptr, WOUT, D, 3, scr, r, 32, ln); continue; } r -= I3;
            if (r < I4) { p0_transpose_item(w_up, UPW, D, nullptr, WUP, D, 4, scr, r, 176, ln); continue; } r -= I4;
            p0_transpose_item(w_down, D, DFF, nullptr, WDN, DFF, 5, scr, r, 32, ln);
        }
            }
        for (int row0 = gw * 16; row0 < T; row0 += NGW * 16) { const int b = row0 / SEQ; const float* mb = MOD + b * 6144;
            f32x4 sc[4], sh[4];
#pragma unroll
            for (int j = 0; j < 4; ++j) { const int col = 4 * ln + 256 * j; sh[j] = *(const f32x4*)(mb + col); sc[j] = *(const f32x4*)(mb + 1024 + col) + 1.f; }
            f32x4 xn[4];
#pragma unroll
            for (int j = 0; j < 4; ++j) xn[j] = __builtin_nontemporal_load((const f32x4*)(x + (size_t)row0 * D + 4 * ln + 256 * j));
            for (int rr = 0; rr < 16; ++rr) { const int t = row0 + rr;
                f32x4 v[4]; float s = 0.f;
#pragma unroll
                for (int j = 0; j < 4; ++j) { v[j] = xn[j]; s += (v[j][0] + v[j][1]) + (v[j][2] + v[j][3]); }
                if (rr + 1 < 16) {
#pragma unroll
                    for (int j = 0; j < 4; ++j) xn[j] = __builtin_nontemporal_load((const f32x4*)(x + (size_t)(t + 1) * D + 4 * ln + 256 * j)); }
                const float mean = wave_sum(s) * (1.f / D); float q = 0.f;
#pragma unroll
                for (int j = 0; j < 4; ++j) { v[j] = v[j] - mean; q += (v[j][0] * v[j][0] + v[j][1] * v[j][1]) + (v[j][2] * v[j][2] + v[j][3] * v[j][3]); }
                const float rstd = rsqrtf(wave_sum(q) * (1.f / D) + 1e-5f);
#pragma unroll
                for (int j = 0; j < 4; ++j) { const f32x4 o = v[j] * rstd * sc[j] + sh[j]; u32x2 w; w.x = cvt_pk_bf16(o[0], o[1]); w.y = cvt_pk_bf16(o[2], o[3]);
                    *(u32x2*)(HB + (size_t)t * D + 4 * ln + 256 * j) = w; } } }
    }
    SEAM(1);
    if (IN(2)) {
        pg8::Gemm g{HB, D, WIN, T, 512, D}; pg8::StaticOrder S; S.init(T, 512, G, bx);
        pg8::EpiP E1{P, U, SSQQ, SSQKV};
        pg8::gemm_phase<pg8::EpiP, true>(lds, g, S, E1);
    }
    SEAM(2);
    if (IN(3)) {
        OPAQUE_LANE(ln);
        for (int row0 = gw * 16; row0 < T; row0 += NGW * 16) {
            { const int t = row0 + (ln >> 2), c = ln & 3, i0 = 8 * (c & 1); const bf16_t* pr = P + (size_t)t * PW + 384;
              const u32x4 r1 = *(const u32x4*)(pr + i0), r2 = *(const u32x4*)(pr + 16 + i0);
              const f32x4 ca = *(const f32x4*)(ROPE + (size_t)t * 32 + i0), cb = *(const f32x4*)(ROPE + (size_t)t * 32 + i0 + 4), sa = *(const f32x4*)(ROPE + (size_t)t * 32 + 16 + i0), sb = *(const f32x4*)(ROPE + (size_t)t * 32 + 16 + i0 + 4);
              float ov[8];
#pragma unroll
              for (int e = 0; e < 8; ++e) { const float x1 = (e & 1) ? bf_hi(r1[e >> 1]) : bf_lo(r1[e >> 1]), x2 = (e & 1) ? bf_hi(r2[e >> 1]) : bf_lo(r2[e >> 1]);
                  const float cs = (e < 4) ? ca[e & 3] : cb[e & 3], sn = (e < 4) ? sa[e & 3] : sb[e & 3];
                  ov[e] = (c < 2) ? x1 * cs - x2 * sn : x2 * cs + x1 * sn; }
              u32x4 o; o.x = cvt_pk_bf16(ov[0], ov[1]); o.y = cvt_pk_bf16(ov[2], ov[3]); o.z = cvt_pk_bf16(ov[4], ov[5]); o.w = cvt_pk_bf16(ov[6], ov[7]);
              *(u32x4*)((char*)KR + (size_t)(t >> 6) * 4096 + c * 1024 + (t & 63) * 16) = o; }
        }
        { pg8::MixedOrder S{(const char*)HB, (const char*)P, (const char*)WIN, (const char*)WQ, (const char*)WKV, G, bx};
          pg8::EpiMix EM{pg8::EpiP{P, U, SSQQ, SSQKV}, pg8::EpiStore{Qb, QW, true}, pg8::EpiKV{KN, Vb}, SSQKV};
          pg8::gemm_multi<pg8::MixedOrder, pg8::EpiMix>(lds, S, EM); }
    }
    SEAM(3);
    if (IN(4)) {
        att::attn_phase(vcu, G, SSQQ, ROPE, Qb, KN, KR, Vb, Y, ong, lds);
        { OPAQUE_LANE(ln);
        for (int row0 = gw * 16; row0 < T; row0 += NGW * 16) {
            const int c0 = 8 * ln;
            float w0[8], w1[8], w2[8], cb8[8], gn[8];
#pragma unroll
            for (int e = 0; e < 8; ++e) { w0[e] = conv_w[c0 + e]; w1[e] = conv_w[512 + c0 + e]; w2[e] = conv_w[1024 + c0 + e]; cb8[e] = conv_b[c0 + e]; gn[e] = ong[512 + c0 + e]; }
            float um2[8], um1[8];
#pragma unroll
            for (int e = 0; e < 8; ++e) { um2[e] = 0.f; um1[e] = 0.f; }
            if ((row0 % SEQ) != 0) {
                const u32x4 a2 = *(const u32x4*)(U + (size_t)(row0 - 2) * 512 + c0), a1 = *(const u32x4*)(U + (size_t)(row0 - 1) * 512 + c0);
#pragma unroll
                for (int e = 0; e < 4; ++e) { um2[2 * e] = bf_lo(a2[e]); um2[2 * e + 1] = bf_hi(a2[e]); um1[2 * e] = bf_lo(a1[e]); um1[2 * e + 1] = bf_hi(a1[e]); }
            }
            for (int rr = 0; rr < 16; ++rr) { const int t = row0 + rr;
                const u32x4 gb = __builtin_nontemporal_load((const u32x4*)(P + (size_t)t * PW + 512 + c0)), uu = __builtin_nontemporal_load((const u32x4*)(U + (size_t)t * 512 + c0));
                float u0[8], yv[8]; float ss = 0.f;
#pragma unroll
                for (int e = 0; e < 4; ++e) { u0[2 * e] = bf_lo(uu[e]); u0[2 * e + 1] = bf_hi(uu[e]); }
#pragma unroll
                for (int e = 0; e < 8; ++e) { const float gbe = (e & 1) ? bf_hi(gb[e >> 1]) : bf_lo(gb[e >> 1]);
                    yv[e] = gbe * (cb8[e] + w0[e] * um2[e] + w1[e] * um1[e] + w2[e] * u0[e]); ss += yv[e] * yv[e]; um2[e] = um1[e]; um1[e] = u0[e]; }
                ss += __shfl_xor(ss, 1); ss += __shfl_xor(ss, 2); ss += __shfl_xor(ss, 4);
                const float rs = rsqrtf(ss * (1.f / 64.f) + 1e-6f);
                u32x4 o; o.x = cvt_pk_bf16(yv[0] * rs * gn[0], yv[1] * rs * gn[1]); o.y = cvt_pk_bf16(yv[2] * rs * gn[2], yv[3] * rs * gn[3]);
                o.z = cvt_pk_bf16(yv[4] * rs * gn[4], yv[5] * rs * gn[5]); o.w = cvt_pk_bf16(yv[6] * rs * gn[6], yv[7] * rs * gn[7]);
                *(u32x4*)(Y + (size_t)t * D + 512 + c0) = o; }
        }
            }
    }
    SEAM(4);
    if (IN(5)) {
        pg8::Gemm g{Y, D, WOUT, T, D, D}; pg8::StaticOrder S; S.init(T, D, G, bx); pg8::EpiStore E4{MIX, D, true};
        pg8::gemm_phase<pg8::EpiStore, true>(lds, g, S, E4);
    }
    SEAM(5);
    if (IN(6)) {
        OPAQUE_LANE(ln);
        for (int row0 = gw * 16; row0 < T; row0 += NGW * 16) { const int b = row0 / SEQ; const float* mb = MOD + b * 6144;
            f32x4 gt[4], g1v[4], b1v[4], sc[4], sh[4];
#pragma unroll
            for (int j = 0; j < 4; ++j) { const int col = 4 * ln + 256 * j; gt[j] = *(const f32x4*)(mb + 2048 + col); g1v[j] = *(const f32x4*)(ln1g + col); b1v[j] = *(const f32x4*)(ln1b + col);
                sh[j] = *(const f32x4*)(mb + 3072 + col); sc[j] = *(const f32x4*)(mb + 4096 + col) + 1.f; }
            f32x4 xn[4]; u32x2 mn[4];
#pragma unroll
            for (int j = 0; j < 4; ++j) { const int col = 4 * ln + 256 * j; xn[j] = __builtin_nontemporal_load((const f32x4*)(x + (size_t)row0 * D + col)); mn[j] = __builtin_nontemporal_load((const u32x2*)(MIX + (size_t)row0 * D + col)); }
            for (int rr = 0; rr < 16; ++rr) { const int t = row0 + rr;
                f32x4 v[4]; float s = 0.f;
#pragma unroll
                for (int j = 0; j < 4; ++j) { const f32x4 mx = {bf_lo(mn[j].x), bf_hi(mn[j].x), bf_lo(mn[j].y), bf_hi(mn[j].y)};
                    v[j] = xn[j] * ALPHA + gt[j] * mx; s += (v[j][0] + v[j][1]) + (v[j][2] + v[j][3]); }
                if (rr + 1 < 16) {
#pragma unroll
                    for (int j = 0; j < 4; ++j) { const int col = 4 * ln + 256 * j; xn[j] = __builtin_nontemporal_load((const f32x4*)(x + (size_t)(t + 1) * D + col)); mn[j] = __builtin_nontemporal_load((const u32x2*)(MIX + (size_t)(t + 1) * D + col)); } }
                float mean = wave_sum(s) * (1.f / D); float q = 0.f;
#pragma unroll
                for (int j = 0; j < 4; ++j) { v[j] = v[j] - mean; q += (v[j][0] * v[j][0] + v[j][1] * v[j][1]) + (v[j][2] * v[j][2] + v[j][3] * v[j][3]); }
                float rstd = rsqrtf(wave_sum(q) * (1.f / D) + 1e-5f);
                s = 0.f;
#pragma unroll
                for (int j = 0; j < 4; ++j) { v[j] = v[j] * rstd * g1v[j] + b1v[j]; u32x2 w; w.x = cvt_pk_bf16(v[j][0], v[j][1]); w.y = cvt_pk_bf16(v[j][2], v[j][3]); __builtin_nontemporal_store(w, (u32x2*)(X1 + (size_t)t * D + 4 * ln + 256 * j)); s += (v[j][0] + v[j][1]) + (v[j][2] + v[j][3]); }
                mean = wave_sum(s) * (1.f / D); q = 0.f;
#pragma unroll
                for (int j = 0; j < 4; ++j) { v[j] = v[j] - mean; q += (v[j][0] * v[j][0] + v[j][1] * v[j][1]) + (v[j][2] * v[j][2] + v[j][3] * v[j][3]); }
                rstd = rsqrtf(wave_sum(q) * (1.f / D) + 1e-5f);
#pragma unroll
                for (int j = 0; j < 4; ++j) { const f32x4 o = v[j] * rstd * sc[j] + sh[j]; u32x2 w; w.x = cvt_pk_bf16(o[0], o[1]); w.y = cvt_pk_bf16(o[2], o[3]);
                    *(u32x2*)(HB + (size_t)t * D + 4 * ln + 256 * j) = w; } } }
    }
    SEAM(6);
    if (IN(7)) {
        pg8::Gemm g{HB, D, WUP, T, UPW, D}; pg8::StaticOrder S; S.init(T, UPW, G, bx); pg8::EpiUp E5{ACT, E, fcw, fcb};
        pg8::gemm_phase<pg8::EpiUp, true>(lds, g, S, E5);
    }
    SEAM(7);
    if (IN(8)) {
        OPAQUE_LANE(ln);
        constexpr int NITEM = 512 * 2 * (DFF / 4);
        for (int it = (gw * 64 + ln); it < NITEM; it += NGW * 64) { const int c4 = it % (DFF / 4), rb = it / (DFF / 4), rr = rb & 1, blk = rb >> 1; const int c0 = 4 * c4;
            const bool first = (blk & 31) == 0;
            const float* e0 = E + ((size_t)blk * 4 + rr) * UPW + c0;
            const float* em1 = (rr == 0) ? E + ((size_t)(blk - 1) * 4 + 3) * UPW + c0 : E + ((size_t)blk * 4 + 0) * UPW + c0;
            const float* em2 = (rr == 0) ? E + ((size_t)(blk - 1) * 4 + 2) * UPW + c0 : E + ((size_t)(blk - 1) * 4 + 3) * UPW + c0;
            const f32x4 z = {0.f, 0.f, 0.f, 0.f};
            const f32x4 g0 = *(const f32x4*)e0, v0 = *(const f32x4*)(e0 + DFF);
            const bool has1 = !(first && rr == 0), has2 = !first;
            const f32x4 g1 = has1 ? *(const f32x4*)em1 : z, v1 = has1 ? *(const f32x4*)(em1 + DFF) : z;
            const f32x4 g2 = has2 ? *(const f32x4*)em2 : z, v2 = has2 ? *(const f32x4*)(em2 + DFF) : z;
            const f32x4 wg0 = *(const f32x4*)(fcw + c0), wg1 = *(const f32x4*)(fcw + UPW + c0), wg2 = *(const f32x4*)(fcw + 2 * UPW + c0), bg = *(const f32x4*)(fcb + c0);
            const f32x4 wv0 = *(const f32x4*)(fcw + DFF + c0), wv1 = *(const f32x4*)(fcw + UPW + DFF + c0), wv2 = *(const f32x4*)(fcw + 2 * UPW + DFF + c0), bv = *(const f32x4*)(fcb + DFF + c0);
            const f32x4 cg = bg + wg0 * g2 + wg1 * g1 + wg2 * g0, cv = bv + wv0 * v2 + wv1 * v1 + wv2 * v0;
            u32x2 w; w.x = cvt_pk_bf16(silu_f(cg[0]) * cv[0], silu_f(cg[1]) * cv[1]); w.y = cvt_pk_bf16(silu_f(cg[2]) * cv[2], silu_f(cg[3]) * cv[3]);
            *(u32x2*)(ACT + (size_t)(64 * blk + rr) * DFF + c0) = w; }
    }
    SEAM(8);
    if (IN(9)) {
        pg8::Gemm g{ACT, DFF, WDN, T, D, DFF}; pg8::StaticOrder S; S.init(T, D, G, bx); pg8::EpiStore E6{FF, D, true};
        pg8::gemm_phase<pg8::EpiStore, true>(lds, g, S, E6);
    }
    SEAM(9);
    if (IN(10)) {
        OPAQUE_LANE(ln);
        for (int row0 = gw * 16; row0 < T; row0 += NGW * 16) { const int b = row0 / SEQ; const float* mb = MOD + b * 6144;
            f32x4 gt[4], g2v[4], b2v[4];
#pragma unroll
            for (int j = 0; j < 4; ++j) { const int col = 4 * ln + 256 * j; gt[j] = *(const f32x4*)(mb + 5120 + col); g2v[j] = *(const f32x4*)(ln2g + col); b2v[j] = *(const f32x4*)(ln2b + col); }
            u32x2 xn[4], mn[4];
#pragma unroll
            for (int j = 0; j < 4; ++j) { const int col = 4 * ln + 256 * j; xn[j] = __builtin_nontemporal_load((const u32x2*)(X1 + (size_t)row0 * D + col)); mn[j] = __builtin_nontemporal_load((const u32x2*)(FF + (size_t)row0 * D + col)); }
            for (int rr = 0; rr < 16; ++rr) { const int t = row0 + rr;
                f32x4 v[4]; float s = 0.f; u32x2 xc[4], mc[4];
#pragma unroll
                for (int j = 0; j < 4; ++j) { xc[j] = xn[j]; mc[j] = mn[j]; }
                if (rr + 1 < 16) {
#pragma unroll
                    for (int j = 0; j < 4; ++j) { const int col = 4 * ln + 256 * j; xn[j] = __builtin_nontemporal_load((const u32x2*)(X1 + (size_t)(t + 1) * D + col)); mn[j] = __builtin_nontemporal_load((const u32x2*)(FF + (size_t)(t + 1) * D + col)); } }
#pragma unroll
                for (int j = 0; j < 4; ++j) { const u32x2 xw = xc[j]; const f32x4 xv = {bf_lo(xw.x), bf_hi(xw.x), bf_lo(xw.y), bf_hi(xw.y)}; const u32x2 mw = mc[j];
                    const f32x4 mx = {bf_lo(mw.x), bf_hi(mw.x), bf_lo(mw.y), bf_hi(mw.y)};
                    v[j] = xv * ALPHA + gt[j] * mx; s += (v[j][0] + v[j][1]) + (v[j][2] + v[j][3]); }
                const float mean = wave_sum(s) * (1.f / D); float q = 0.f;
#pragma unroll
                for (int j = 0; j < 4; ++j) { v[j] = v[j] - mean; q += (v[j][0] * v[j][0] + v[j][1] * v[j][1]) + (v[j][2] * v[j][2] + v[j][3] * v[j][3]); }
                const float rstd = rsqrtf(wave_sum(q) * (1.f / D) + 1e-5f);
#pragma unroll
                for (int j = 0; j < 4; ++j) { *(f32x4*)(out + (size_t)t * D + 4 * ln + 256 * j) = v[j] * rstd * g2v[j] + b2v[j]; } } }
    }
#undef IN
#undef SEAM
}

extern "C" void kernel_launch(void* const* d_in, const int* in_sizes, int n_in, void* d_out, int out_size, void* d_ws, size_t ws_size, hipStream_t stream) {
    static int grid = 0;
    if (grid == 0) {
        if (n_in != 22 || in_sizes[0] != T * D || out_size != T * D || ws_size < WS_END) { fprintf(stderr, "kernel_launch: unexpected shapes / workspace (n_in %d, ws %zu)\n", n_in, ws_size); grid = -1; return; }
        int dev = 0, cus = 0, per_cu = 0;
        if (hipGetDevice(&dev) != hipSuccess || hipDeviceGetAttribute(&cus, hipDeviceAttributeMultiprocessorCount, dev) != hipSuccess) { grid = -1; return; }
        if (hipFuncSetAttribute((const void*)mk_fwd, hipFuncAttributeMaxDynamicSharedMemorySize, LDS_BYTES) != hipSuccess) { fprintf(stderr, "kernel_launch: hipFuncSetAttribute failed\n"); grid = -1; return; }
        if (hipOccupancyMaxActiveBlocksPerMultiprocessor(&per_cu, (const void*)mk_fwd, 512, LDS_BYTES) != hipSuccess || per_cu < 1) { fprintf(stderr, "kernel_launch: occupancy query says %d blocks per CU\n", per_cu); (void)hipGetLastError(); grid = -1; return; }
        grid = cus;
    }
    if (grid < 0) return;
    hipMemsetAsync((char*)d_ws + WS_CTL, 0, CTL_ZERO_BYTES, stream);
    Args a{};
    for (int i = 0; i < 22; ++i) a.in[i] = (const float*)d_in[i];
    a.pos = (const int*)d_in[2]; a.out = (float*)d_out; a.ws = (unsigned char*)d_ws;
#if MK_N_LAUNCHES == 1
    a.ph_lo = 0; a.ph_hi = N_PHASES;
    hipLaunchKernelGGL(mk_fwd, dim3(grid), dim3(512), LDS_BYTES, stream, a);
#else
    for (int p = 0; p < N_PHASES; ++p) { a.ph_lo = p; a.ph_hi = p + 1; hipLaunchKernelGGL(mk_fwd, dim3(grid), dim3(512), LDS_BYTES, stream, a); }
#endif
}
```

```cpp
#include <hip/hip_runtime.h>
#include <cstdio>
#include <cstdint>

#define LAS __attribute__((address_space(3)))
#define GAS __attribute__((address_space(1)))
typedef unsigned short bf16_t;
typedef short bf16x8 __attribute__((ext_vector_type(8)));
typedef short s16x4 __attribute__((ext_vector_type(4)));
typedef float f32x4 __attribute__((ext_vector_type(4)));
typedef float f32x2 __attribute__((ext_vector_type(2)));
typedef float f32x16 __attribute__((ext_vector_type(16)));
typedef unsigned u32x4 __attribute__((ext_vector_type(4)));
typedef unsigned u32x2 __attribute__((ext_vector_type(2)));
typedef GAS unsigned gu32;

#ifndef MK_N_LAUNCHES
#define MK_N_LAUNCHES 1
#endif

constexpr int D = 1024, NB = 16, SEQ = 2048, T = NB * SEQ, NH = 8, DFF = 2816, UPW = 2 * DFF;
constexpr int PW = 1024;
constexpr int G1N = 2048;
constexpr int QW = 768, INW = 1952;
constexpr float ALPHA = 1.189207115002721f;
constexpr float QSCALE = 0.10206207261596575f * 1.4426950408889634f;
constexpr float LOG2E = 1.4426950408889634f;

constexpr size_t MiB = 1u << 20;
constexpr size_t WS_CTL = 0, CTL_ZERO_BYTES = 64 * 1024;
constexpr size_t WS_MOD = 1 * MiB;
constexpr size_t WS_ROPE = 2 * MiB;
constexpr size_t WS_SSQQ = 6 * MiB;
constexpr size_t WS_SSQKV = 6 * MiB + 512 * 1024;
constexpr size_t WS_WIN = 8 * MiB;
constexpr size_t WS_WQ = 12 * MiB;
constexpr size_t WS_WKV = 12 * MiB + 512 * 1024;
constexpr size_t WS_WOUT = 13 * MiB;
constexpr size_t WS_WUP = 15 * MiB;
constexpr size_t WS_WDN = 26 * MiB;
constexpr size_t WS_HB = 32 * MiB;
constexpr size_t WS_FF = 32 * MiB;
constexpr size_t WS_P = 96 * MiB;
constexpr size_t WS_U = 160 * MiB;
constexpr size_t WS_MIX = 96 * MiB;
constexpr size_t WS_Q = 224 * MiB;
constexpr size_t WS_KN = 272 * MiB;
constexpr size_t WS_KR = 304 * MiB;
constexpr size_t WS_V = 306 * MiB;
constexpr size_t WS_Y = 338 * MiB;
constexpr size_t WS_X1 = 338 * MiB;
constexpr size_t WS_ACT = 96 * MiB;
constexpr size_t WS_E = 272 * MiB;
constexpr size_t WS_END = 402 * MiB;
constexpr int CW_BAR = 1024;

constexpr int RING_BYTES = 131072, LDSCTL_OFF = RING_BYTES, MISC_OFF = LDSCTL_OFF + 320, LDS_BYTES = 147456;

__device__ __forceinline__ unsigned cvt_pk_bf16(float lo, float hi) { unsigned r; asm volatile("v_cvt_pk_bf16_f32 %0, %1, %2" : "=v"(r) : "v"(lo), "v"(hi)); return r; }
__device__ __forceinline__ float bf_lo(unsigned u) { return __uint_as_float(u << 16); }
__device__ __forceinline__ float bf_hi(unsigned u) { return __uint_as_float(u & 0xffff0000u); }
__device__ __forceinline__ float fexp2(float x) { return __builtin_amdgcn_exp2f(x); }
__device__ __forceinline__ float frcp(float x) { return __builtin_amdgcn_rcpf(x); }
__device__ __forceinline__ float silu_f(float v) { return v * frcp(1.f + fexp2(-LOG2E * v)); }
__device__ __forceinline__ float wave_sum(float v) {
#pragma unroll
    for (int o = 1; o < 64; o <<= 1) v += __shfl_xor(v, o);
    return v;
}

namespace pg8 {
constexpr int BM = 256, BK = 64, HALF = 128, HTB = HALF * BK * 2, STAGE_BYTES = 8 * HTB, NXCD = 8, WGM = 4;
__host__ __device__ __forceinline__ int lds_byte(int r, int c) { const int st = (r >> 4) * 2 + (c >> 5), rr = r & 15, cc = c & 31, ob = rr * 64 + cc * 2; return st * 1024 + (ob ^ (((ob >> 9) & 1) << 5)); }
__host__ __device__ __forceinline__ void stage_rc(int b, int& R, int& C) { const int st = b / 1024, sb = b % 1024, swz = sb ^ (((sb >> 9) & 1) << 5); R = (st >> 1) * 16 + swz / 64; C = (st & 1) * 32 + (swz % 64) / 2; }
__host__ __device__ __forceinline__ int perm32(int rho) { const int n = rho >> 4, i = rho & 15; return 8 * (i >> 2) + 4 * n + (i & 3); }

struct Unit { int pm, pn; };
struct Gemm { const bf16_t* A; int lda; const bf16_t* Bt; int M, N, K; };

struct StaticOrder {
    int nM, nN, nwg, G, c; bool rev = false;
    __device__ __forceinline__ void init(int M, int N, int G_, int c_) { nM = M / BM; nN = N / BM; nwg = nM * nN; G = G_; c = c_; }
    __device__ __forceinline__ bool next(int i, Unit& u) const {
        const long L = (long)i * G + c; if (L >= nwg) return false;
        int wgid = (int)L; { const int q = nwg / NXCD, r = nwg % NXCD, xcd = wgid % NXCD, off = wgid / NXCD; wgid = (xcd < r ? xcd * (q + 1) : r * (q + 1) + (xcd - r) * q) + off; }
        const int nig = WGM * nN, gid = wgid / nig, fm = gid * WGM, gsz = (nM - fm) < WGM ? (nM - fm) : WGM;
        u.pm = fm + ((wgid % nig) % gsz); u.pn = (wgid % nig) / gsz; if (rev) u.pm = nM - 1 - u.pm; return true;
    }
};

template <class Epi, bool ALIGN_EPI>
__device__ __forceinline__ void gemm_phase(LAS unsigned char* lds, const Gemm g, const StaticOrder& S, const Epi& E) {
    int tid = threadIdx.x; asm volatile("" : "+v"(tid));
    const int wid = __builtin_amdgcn_readfirstlane(tid >> 6), lane = tid & 63, wr = wid >> 2, wc = wid & 3, fr = lane & 15, fq = lane >> 4;
    const int K = g.K, nt = K / BK;
    unsigned voffA[2], voffB[2];
#pragma unroll
    for (int i = 0; i < 2; ++i) { int R, C; stage_rc(tid * 16 + i * 8192, R, C);
        voffA[i] = (unsigned)(R * g.lda + C) * 2u; voffB[i] = (unsigned)(R * K + C) * 2u; }
    const size_t kstep = (size_t)(BK * 2);
    const size_t hstepA = (size_t)HALF * g.lda * 2, hstepB = (size_t)HALF * K * 2;
    const size_t tstepA = 2 * hstepA, tstepB = 2 * hstepB;
    const unsigned ldsw = (unsigned)wid * 1024u;
    const int aoff = lds_byte(wr * 64 + fr, fq * 8), boff = lds_byte(wc * 32 + fr, fq * 8);
#define PG8_SA(b, h) (((b) * 2 + (h)) * HTB)
#define PG8_SB(b, h) ((4 + (b) * 2 + (h)) * HTB)
#define PG8_STAGE(bufoff, gbase, voff) do { _Pragma("unroll") for (int _i = 0; _i < 2; ++_i) \
        __builtin_amdgcn_global_load_lds((const unsigned*)((const char*)(gbase) + (voff)[_i]), (LAS unsigned*)(lds + (bufoff) + ldsw + _i * 8192), 16, 0, 0); } while (0)
#define PG8_LDA(dst, b, h) do { _Pragma("unroll") for (int m = 0; m < 4; ++m) _Pragma("unroll") for (int k = 0; k < 2; ++k) dst[m][k] = *(const LAS bf16x8*)(lds + PG8_SA(b, h) + aoff + m * 2048 + k * 1024); } while (0)
#define PG8_LDB(dst, b, h) do { _Pragma("unroll") for (int n = 0; n < 2; ++n) _Pragma("unroll") for (int k = 0; k < 2; ++k) dst[n][k] = *(const LAS bf16x8*)(lds + PG8_SB(b, h) + boff + n * 2048 + k * 1024); } while (0)
#define PG8_MMA(ai, bj, At, Bt) do { __builtin_amdgcn_s_setprio(1); _Pragma("unroll") for (int m = 0; m < 4; ++m) _Pragma("unroll") for (int n = 0; n < 2; ++n) _Pragma("unroll") for (int k = 0; k < 2; ++k) \
        acc[ai][bj][m][n] = __builtin_amdgcn_mfma_f32_16x16x32_bf16(Bt[n][k], At[m][k], acc[ai][bj][m][n], 0, 0, 0); __builtin_amdgcn_s_setprio(0); } while (0)
#define PG8_WAIT_V(n) asm volatile("s_waitcnt vmcnt(" #n ")" ::: "memory")
#define PG8_WAIT_L(n) asm volatile("s_waitcnt lgkmcnt(" #n ")" ::: "memory")
#define PG8_BAR __builtin_amdgcn_s_barrier()
#define PG8_SCHED __builtin_amdgcn_sched_barrier(0)
    Unit cur, nxt; int ui = 0;
    if (!S.next(0, cur)) return;
    f32x4 acc[2][2][4][2];
#pragma unroll
    for (int a = 0; a < 2; ++a)
#pragma unroll
        for (int b = 0; b < 2; ++b)
#pragma unroll
            for (int m = 0; m < 4; ++m)
#pragma unroll
                for (int n = 0; n < 2; ++n) acc[a][b][m][n] = (f32x4){0.f, 0.f, 0.f, 0.f};
    bf16x8 At[4][2], B0[2][2], B1[2][2];
    const char* cA = (const char*)g.A + (size_t)cur.pm * tstepA; const char* cB = (const char*)g.Bt + (size_t)cur.pn * tstepB;
    if constexpr (Epi::HAS_PREFETCH) E.prefetch(cur, 0, lds, wid, lane);
    PG8_STAGE(PG8_SB(0, 0), cB, voffB); PG8_STAGE(PG8_SB(0, 1), cB + hstepB, voffB); PG8_STAGE(PG8_SA(0, 0), cA, voffA); PG8_STAGE(PG8_SA(0, 1), cA + hstepA, voffA);
    if (wr == 1) PG8_BAR;
    PG8_WAIT_V(2); PG8_BAR;
    PG8_STAGE(PG8_SB(1, 0), cB + kstep, voffB); PG8_STAGE(PG8_SA(1, 0), cA + kstep, voffA); PG8_STAGE(PG8_SB(1, 1), cB + hstepB + kstep, voffB);
    PG8_WAIT_V(6); PG8_BAR;
    for (;;) {
        const bool has_next = S.next(ui + 1, nxt);
        const char* nA = has_next ? (const char*)g.A + (size_t)nxt.pm * tstepA : cA; const char* nB = has_next ? (const char*)g.Bt + (size_t)nxt.pn * tstepB : cB;
#pragma nounroll
        for (int t = 0; t < nt; t += 2) {
            const bool last = (t == nt - 2);
            const char* a1 = cA + (size_t)(t + 1) * kstep;
            const char* a2 = last ? nA : cA + (size_t)(t + 2) * kstep; const char* b2 = last ? nB : cB + (size_t)(t + 2) * kstep;
            const char* a3 = a2 + kstep; const char* b3 = b2 + kstep;
            const bool rlx = (Epi::NST > 0) && (t == 0) && (ui > 0);
            PG8_LDB(B0, 0, 0); PG8_LDB(B1, 0, 1); PG8_SCHED; PG8_LDA(At, 0, 0); PG8_STAGE(PG8_SA(1, 1), a1 + hstepA, voffA);
            if (rlx) { if constexpr (Epi::NST >= 16) PG8_WAIT_V(24); else PG8_WAIT_V(16); } else PG8_WAIT_V(8);
            PG8_WAIT_L(0); PG8_BAR; PG8_MMA(0, 0, At, B0); PG8_MMA(0, 1, At, B1); PG8_BAR; PG8_SCHED;
            PG8_LDA(At, 0, 1); PG8_STAGE(PG8_SB(0, 0), b2, voffB); PG8_STAGE(PG8_SB(0, 1), b2 + hstepB, voffB); PG8_STAGE(PG8_SA(0, 0), a2, voffA);
            if (rlx) { if constexpr (Epi::NST >= 16) PG8_WAIT_V(24); else PG8_WAIT_V(16); } else PG8_WAIT_V(8);
            PG8_WAIT_L(0); PG8_BAR; PG8_MMA(1, 0, At, B0); PG8_MMA(1, 1, At, B1); PG8_BAR; PG8_SCHED;
            PG8_LDB(B0, 1, 0); PG8_LDB(B1, 1, 1); PG8_SCHED; PG8_LDA(At, 1, 0); PG8_STAGE(PG8_SA(0, 1), a2 + hstepA, voffA);
            PG8_WAIT_V(8); PG8_WAIT_L(0); PG8_BAR; PG8_MMA(0, 0, At, B0); PG8_MMA(0, 1, At, B1); PG8_BAR; PG8_SCHED;
            PG8_LDA(At, 1, 1); PG8_STAGE(PG8_SB(1, 0), b3, voffB); PG8_STAGE(PG8_SB(1, 1), b3 + hstepB, voffB); PG8_STAGE(PG8_SA(1, 0), a3, voffA);
            PG8_WAIT_V(8); PG8_WAIT_L(0); PG8_BAR; PG8_MMA(1, 0, At, B0); PG8_MMA(1, 1, At, B1); PG8_BAR; PG8_SCHED;
        }
        if constexpr (Epi::HAS_PREFETCH) { int t_x = threadIdx.x; asm volatile("" : "+v"(t_x));
            E.xch_write(acc, wr, wc, t_x & 15, (t_x >> 4) & 3, lds); asm volatile("s_waitcnt lgkmcnt(0)\n\ts_barrier" ::: "memory"); }
        if constexpr (ALIGN_EPI) { if (wr == 0) PG8_BAR; }
        { int t_e = threadIdx.x; asm volatile("" : "+v"(t_e)); const int fr_e = t_e & 15, fq_e = (t_e >> 4) & 3;
          if constexpr (Epi::HAS_PREFETCH) { if (has_next) E.prefetch(nxt, (ui + 1) & 1, lds, wid, t_e & 63); E.run(acc, cur, wr, wc, fr_e, fq_e, lds, ui & 1); }
          else E(acc, cur, wr, wc, fr_e, fq_e); }
        if (!has_next) break;
#pragma unroll
        for (int a = 0; a < 2; ++a)
#pragma unroll
            for (int b = 0; b < 2; ++b)
#pragma unroll
                for (int m = 0; m < 4; ++m)
#pragma unroll
                    for (int n = 0; n < 2; ++n) acc[a][b][m][n] = (f32x4){0.f, 0.f, 0.f, 0.f};
        cur = nxt; cA = nA; cB = nB; ++ui;
        if constexpr (ALIGN_EPI) { if (wr == 1) PG8_BAR; }
    }
    PG8_WAIT_V(0);
    if constexpr (!ALIGN_EPI) { if (wr == 0) PG8_BAR; }
    PG8_BAR;
#undef PG8_SA
#undef PG8_SB
#undef PG8_STAGE
#undef PG8_LDA
#undef PG8_LDB
#undef PG8_MMA
#undef PG8_WAIT_V
#undef PG8_WAIT_L
#undef PG8_BAR
#undef PG8_SCHED
}

struct MUnit { const char* A; const char* B; int nt; unsigned kb2; int type; Unit u; };
template <class Sched, class Disp>
__device__ __forceinline__ void gemm_multi(LAS unsigned char* lds, const Sched& S, const Disp& E) {
    int tid = threadIdx.x; asm volatile("" : "+v"(tid));
    const int wid = __builtin_amdgcn_readfirstlane(tid >> 6), lane = tid & 63, wr = wid >> 2, wc = wid & 3, fr = lane & 15, fq = lane >> 4;
    unsigned voffA[2], rB[2], cB2[2];
#pragma unroll
    for (int i = 0; i < 2; ++i) { int R, C; stage_rc(tid * 16 + i * 8192, R, C); voffA[i] = (unsigned)(R * 1024 + C) * 2u; rB[i] = (unsigned)R; cB2[i] = (unsigned)C * 2u; }
    const size_t kstep = (size_t)(BK * 2);
    const size_t hstepA = (size_t)HALF * 1024 * 2;
    const unsigned ldsw = (unsigned)wid * 1024u;
    const int aoff = lds_byte(wr * 64 + fr, fq * 8), boff = lds_byte(wc * 32 + fr, fq * 8);
#define PG8_SA(b, h) (((b) * 2 + (h)) * HTB)
#define PG8_SB(b, h) ((4 + (b) * 2 + (h)) * HTB)
#define PG8_STAGE(bufoff, gbase, voff) do { _Pragma("unroll") for (int _i = 0; _i < 2; ++_i) \
        __builtin_amdgcn_global_load_lds((const unsigned*)((const char*)(gbase) + (voff)[_i]), (LAS unsigned*)(lds + (bufoff) + ldsw + _i * 8192), 16, 0, 0); } while (0)
#define PG8_LDA(dst, b, h) do { _Pragma("unroll") for (int m = 0; m < 4; ++m) _Pragma("unroll") for (int k = 0; k < 2; ++k) dst[m][k] = *(const LAS bf16x8*)(lds + PG8_SA(b, h) + aoff + m * 2048 + k * 1024); } while (0)
#define PG8_LDB(dst, b, h) do { _Pragma("unroll") for (int n = 0; n < 2; ++n) _Pragma("unroll") for (int k = 0; k < 2; ++k) dst[n][k] = *(const LAS bf16x8*)(lds + PG8_SB(b, h) + boff + n * 2048 + k * 1024); } while (0)
#define PG8_MMA(ai, bj, At, Bt) do { __builtin_amdgcn_s_setprio(1); _Pragma("unroll") for (int m = 0; m < 4; ++m) _Pragma("unroll") for (int n = 0; n < 2; ++n) _Pragma("unroll") for (int k = 0; k < 2; ++k) \
        acc[ai][bj][m][n] = __builtin_amdgcn_mfma_f32_16x16x32_bf16(Bt[n][k], At[m][k], acc[ai][bj][m][n], 0, 0, 0); __builtin_amdgcn_s_setprio(0); } while (0)
#define PG8_WAIT_V(n) asm volatile("s_waitcnt vmcnt(" #n ")" ::: "memory")
#define PG8_WAIT_L(n) asm volatile("s_waitcnt lgkmcnt(" #n ")" ::: "memory")
#define PG8_BAR __builtin_amdgcn_s_barrier()
#define PG8_SCHED __builtin_amdgcn_sched_barrier(0)
    MUnit cur, nxt; int ui = 0; int relax = 0;
    if (!S.next(0, cur)) return;
    f32x4 acc[2][2][4][2];
#pragma unroll
    for (int a = 0; a < 2; ++a)
#pragma unroll
        for (int b = 0; b < 2; ++b)
#pragma unroll
            for (int m = 0; m < 4; ++m)
#pragma unroll
                for (int n = 0; n < 2; ++n) acc[a][b][m][n] = (f32x4){0.f, 0.f, 0.f, 0.f};
    bf16x8 At[4][2], B0[2][2], B1[2][2];
    const char* cA = cur.A; const char* cB = cur.B;
    E.prefetch(cur, 0, lds, wid, lane);
    unsigned voffB[2]; voffB[0] = rB[0] * cur.kb2 + cB2[0]; voffB[1] = rB[1] * cur.kb2 + cB2[1];
    size_t hstepB = (size_t)HALF * cur.kb2;
    PG8_STAGE(PG8_SB(0, 0), cB, voffB); PG8_STAGE(PG8_SB(0, 1), cB + hstepB, voffB); PG8_STAGE(PG8_SA(0, 0), cA, voffA); PG8_STAGE(PG8_SA(0, 1), cA + hstepA, voffA);
    if (wr == 1) PG8_BAR;
    PG8_WAIT_V(2); PG8_BAR;
    PG8_STAGE(PG8_SB(1, 0), cB + kstep, voffB); PG8_STAGE(PG8_SA(1, 0), cA + kstep, voffA); PG8_STAGE(PG8_SB(1, 1), cB + hstepB + kstep, voffB);
    PG8_WAIT_V(6); PG8_BAR;
    for (;;) {
        const bool has_next = S.next(ui + 1, nxt);
        if (!has_next) nxt = cur;
        const char* nA = nxt.A; const char* nB = nxt.B;
        unsigned nvoffB[2]; nvoffB[0] = rB[0] * nxt.kb2 + cB2[0]; nvoffB[1] = rB[1] * nxt.kb2 + cB2[1];
        const size_t nhstepB = (size_t)HALF * nxt.kb2;
        const int nt = cur.nt;
#pragma nounroll
        for (int t = 0; t < nt; t += 2) {
            const bool last = (t == nt - 2);
            const char* a1 = cA + (size_t)(t + 1) * kstep;
            const char* a2 = last ? nA : cA + (size_t)(t + 2) * kstep; const char* b2 = last ? nB : cB + (size_t)(t + 2) * kstep;
            const char* a3 = a2 + kstep; const char* b3 = b2 + kstep;
            unsigned vB2[2]; vB2[0] = last ? nvoffB[0] : voffB[0]; vB2[1] = last ? nvoffB[1] : voffB[1];
            const size_t hB2 = last ? nhstepB : hstepB;
            const int rlx = (t == 0) ? relax : 0;
            PG8_LDB(B0, 0, 0); PG8_LDB(B1, 0, 1); PG8_SCHED; PG8_LDA(At, 0, 0); PG8_STAGE(PG8_SA(1, 1), a1 + hstepA, voffA);
            if (rlx >= 16) PG8_WAIT_V(24); else if (rlx >= 8) PG8_WAIT_V(16); else PG8_WAIT_V(8);
            PG8_WAIT_L(0); PG8_BAR; PG8_MMA(0, 0, At, B0); PG8_MMA(0, 1, At, B1); PG8_BAR; PG8_SCHED;
            PG8_LDA(At, 0, 1); PG8_STAGE(PG8_SB(0, 0), b2, vB2); PG8_STAGE(PG8_SB(0, 1), b2 + hB2, vB2); PG8_STAGE(PG8_SA(0, 0), a2, voffA);
            if (rlx >= 16) PG8_WAIT_V(24); else if (rlx >= 8) PG8_WAIT_V(16); else PG8_WAIT_V(8);
            PG8_WAIT_L(0); PG8_BAR; PG8_MMA(1, 0, At, B0); PG8_MMA(1, 1, At, B1); PG8_BAR; PG8_SCHED;
            PG8_LDB(B0, 1, 0); PG8_LDB(B1, 1, 1); PG8_SCHED; PG8_LDA(At, 1, 0); PG8_STAGE(PG8_SA(0, 1), a2 + hstepA, voffA);
            PG8_WAIT_V(8); PG8_WAIT_L(0); PG8_BAR; PG8_MMA(0, 0, At, B0); PG8_MMA(0, 1, At, B1); PG8_BAR; PG8_SCHED;
            PG8_LDA(At, 1, 1); PG8_STAGE(PG8_SB(1, 0), b3, vB2); PG8_STAGE(PG8_SB(1, 1), b3 + hB2, vB2); PG8_STAGE(PG8_SA(1, 0), a3, voffA);
            PG8_WAIT_V(8); PG8_WAIT_L(0); PG8_BAR; PG8_MMA(1, 0, At, B0); PG8_MMA(1, 1, At, B1); PG8_BAR; PG8_SCHED;
        }
        if (wr == 0) PG8_BAR;
        { int t_e = threadIdx.x; asm volatile("" : "+v"(t_e)); if (has_next) E.prefetch(nxt, (ui + 1) & 1, lds, wid, t_e & 63); E(acc, cur, wr, wc, t_e & 15, (t_e >> 4) & 3, lds, ui & 1); }
        if (!has_next) break;
#pragma unroll
        for (int a = 0; a < 2; ++a)
#pragma unroll
            for (int b = 0; b < 2; ++b)
#pragma unroll
                for (int m = 0; m < 4; ++m)
#pragma unroll
                    for (int n = 0; n < 2; ++n) acc[a][b][m][n] = (f32x4){0.f, 0.f, 0.f, 0.f};
        relax = (cur.type == 0 && cur.u.pn >= 4) ? 8 : 16;
        cur = nxt; cA = nA; cB = nB; voffB[0] = nvoffB[0]; voffB[1] = nvoffB[1]; hstepB = nhstepB; ++ui;
        if (wr == 1) PG8_BAR;
    }
    PG8_WAIT_V(0);
    PG8_BAR;
#undef PG8_SA
#undef PG8_SB
#undef PG8_STAGE
#undef PG8_LDA
#undef PG8_LDB
#undef PG8_MMA
#undef PG8_WAIT_V
#undef PG8_WAIT_L
#undef PG8_BAR
#undef PG8_SCHED
}

typedef f32x4 Acc[2][2][4][2];

struct EpiStore { static constexpr bool HAS_PREFETCH = false; static constexpr int NST = 16;
    bf16_t* O; int ldc; bool nt = false;
    __device__ __forceinline__ void operator()(const Acc& acc, const Unit& u, int wr, int wc, int fr, int fq) const {
        const int row0 = u.pm * BM + wr * 64 + fr, col0 = u.pn * BM + wc * 32 + 8 * fq;
#pragma unroll
        for (int ai = 0; ai < 2; ++ai)
#pragma unroll
            for (int m = 0; m < 4; ++m) { bf16_t* rowp = O + (size_t)(row0 + ai * HALF + m * 16) * ldc + col0;
#pragma unroll
                for (int bj = 0; bj < 2; ++bj) { const f32x4 v0 = acc[ai][bj][m][0], v1 = acc[ai][bj][m][1];
                    u32x4 w; w.x = cvt_pk_bf16(v0[0], v0[1]); w.y = cvt_pk_bf16(v0[2], v0[3]); w.z = cvt_pk_bf16(v1[0], v1[1]); w.w = cvt_pk_bf16(v1[2], v1[3]);
                    if (nt) __builtin_nontemporal_store(w, (u32x4*)(rowp + bj * HALF)); else *(u32x4*)(rowp + bj * HALF) = w; } }
    }
};

struct EpiP { static constexpr bool HAS_PREFETCH = false, AFTER_DRAIN = false; static constexpr int NST = 8;
    bf16_t* O; bf16_t* U; float* ssq_q; float* ssq_kv;
    __device__ __forceinline__ void operator()(const Acc& acc, const Unit& u, int wr, int wc, int fr, int fq) const {
        const int row0 = u.pm * BM + wr * 64 + fr;
        if (u.pn >= 4) {
            bf16_t* ucol = U + 128 * (u.pn - 4) + 32 * wc + 8 * fq;
#pragma unroll
            for (int ai = 0; ai < 2; ++ai)
#pragma unroll
                for (int m = 0; m < 4; ++m) { const f32x4 v0 = acc[ai][0][m][0] * acc[ai][1][m][0], v1 = acc[ai][0][m][1] * acc[ai][1][m][1];
                    u32x4 w; w.x = cvt_pk_bf16(v0[0], v0[1]); w.y = cvt_pk_bf16(v0[2], v0[3]); w.z = cvt_pk_bf16(v1[0], v1[1]); w.w = cvt_pk_bf16(v1[2], v1[3]);
                    *(u32x4*)(ucol + (size_t)(row0 + ai * HALF + m * 16) * 512) = w; }
            return;
        }
        EpiStore st{O, PW}; st(acc, u, wr, wc, fr, fq);
        if (u.pn <= 1) {
            float* dst = (u.pn == 0) ? ssq_q : ssq_kv;
#pragma unroll
            for (int ai = 0; ai < 2; ++ai)
#pragma unroll
                for (int m = 0; m < 4; ++m) { float s = 0.f;
#pragma unroll
                    for (int n = 0; n < 2; ++n) { const f32x4 a = acc[ai][0][m][n]; s += (a[0] * a[0] + a[1] * a[1]) + (a[2] * a[2] + a[3] * a[3]); }
                    if (u.pn == 0) {
#pragma unroll
                        for (int n = 0; n < 2; ++n) { const f32x4 a = acc[ai][1][m][n]; s += (a[0] * a[0] + a[1] * a[1]) + (a[2] * a[2] + a[3] * a[3]); } }
                    s += __shfl_xor(s, 16); s += __shfl_xor(s, 32);
                    if (fq == 0) dst[(size_t)(row0 + ai * HALF + m * 16) * 4 + wc] = s; }
        }
    }
};

constexpr int SSQ_LDS = RING_BYTES + 1024;
struct EpiKV { static constexpr bool HAS_PREFETCH = false, AFTER_DRAIN = false; static constexpr int NST = 16;
    bf16_t* KN; bf16_t* V;
    __device__ __forceinline__ void operator()(const Acc& acc, const Unit& u, int wr, int wc, int fr, int fq, LAS unsigned char* lds, int buf) const {
        const int b = u.pm >> 3;
        const LAS f32x4* sq = (const LAS f32x4*)(lds + SSQ_LDS + buf * 4096) + wr * 64 + fr;
        float f[2][4];
#pragma unroll
        for (int ai = 0; ai < 2; ++ai)
#pragma unroll
            for (int m = 0; m < 4; ++m) { const f32x4 sp = sq[ai * HALF + m * 16]; f[ai][m] = rsqrtf(((sp[0] + sp[1]) + (sp[2] + sp[3])) * (1.f / 128.f) + 1e-6f); }
#pragma unroll
        for (int bj = 0; bj < 2; ++bj) { const int g = 8 * u.pn + 4 * bj + wc, head = g >> 2, part = g & 3;
            char* base = (part < 2) ? (char*)KN + (4 * part + fq) * 1024 + fr * 16 : (char*)V + (part - 2) * 4096 + fr * 64 + fq * 16;
            const int mstep = (part < 2) ? 256 : 1024;
            base += (size_t)(b * 8 + head) * 32 * 8192;
#pragma unroll
            for (int ai = 0; ai < 2; ++ai) { const int tile = (4 * u.pm + 2 * ai + wr) & 31;
#pragma unroll
                for (int m = 0; m < 4; ++m) {
                    const f32x4 v0 = acc[ai][bj][m][0] * f[ai][m], v1 = acc[ai][bj][m][1] * f[ai][m];
                    u32x4 w; w.x = cvt_pk_bf16(v0[0], v0[1]); w.y = cvt_pk_bf16(v0[2], v0[3]); w.z = cvt_pk_bf16(v1[0], v1[1]); w.w = cvt_pk_bf16(v1[2], v1[3]);
                    __builtin_nontemporal_store(w, (u32x4*)(base + (size_t)tile * 8192 + m * mstep)); } } }
    }
};

struct MixedOrder {
    const char* HB; const char* P; const char* WIN; const char* WQ; const char* WKV; int G, c;
    __device__ __forceinline__ void set_long(int k, MUnit& m) const { const int li = k * G + c, w = (li % NXCD) * 96 + li / NXCD, pm = w / 6, pn = 2 + w % 6;
        m.A = HB + (size_t)pm * (256 * 1024 * 2); m.B = WIN + (size_t)pn * (256 * 1024 * 2); m.nt = 16; m.kb2 = 2048u; m.type = 0; m.u.pm = pm; m.u.pn = pn; }
    __device__ __forceinline__ void set_short(int k, MUnit& m) const { const int si = k * G + c, s = (si % NXCD) * 112 + si / NXCD;
        if (s < 384) { const int pm = s / 3, pn = s % 3; m.A = P + (size_t)pm * (256 * 1024 * 2); m.B = WQ + (size_t)pn * (256 * 256 * 2); m.nt = 4; m.kb2 = 512u; m.type = 1; m.u.pm = pm; m.u.pn = pn; }
        else { const int s2 = s - 384, pm = s2 >> 2, pn = s2 & 3; m.A = P + 512 + (size_t)pm * (256 * 1024 * 2); m.B = WKV + (size_t)pn * (256 * 256 * 2); m.nt = 4; m.kb2 = 512u; m.type = 2; m.u.pm = pm; m.u.pn = pn; } }
    __device__ __forceinline__ bool next(int i, MUnit& m) const {
        const int ns = (c < 128) ? 4 : 3; if (i >= 3 + ns) return false;
        const int k = i >> 1; const bool even = (c & 1) == 0;
        if (i == 6) { set_short(3, m); return true; }
        if (even == ((i & 1) == 0)) set_long(k, m); else set_short(k, m);
        return true;
    }
};
struct EpiMix { EpiP p; EpiStore q; EpiKV kv; const float* ssqkv;
    __device__ __forceinline__ void prefetch(const MUnit& m, int buf, LAS unsigned char* lds, int wid, int lane) const {
        if (m.type == 2 && wid < 4) __builtin_amdgcn_global_load_lds((const unsigned*)(ssqkv + (size_t)m.u.pm * 1024 + wid * 256 + lane * 4), (LAS unsigned*)(lds + SSQ_LDS + buf * 4096 + wid * 1024), 16, 0, 0);
    }
    __device__ __forceinline__ void operator()(const Acc& acc, const MUnit& m, int wr, int wc, int fr, int fq, LAS unsigned char* lds, int buf) const {
        if (m.type == 0) p(acc, m.u, wr, wc, fr, fq); else if (m.type == 1) q(acc, m.u, wr, wc, fr, fq); else kv(acc, m.u, wr, wc, fr, fq, lds, buf);
    }
};

template <int CTRL> __device__ __forceinline__ float dppf(float v) { return __builtin_bit_cast(float, __builtin_amdgcn_update_dpp(0, __builtin_bit_cast(int, v), CTRL, 0xf, 0xf, true)); }
template <int CTRL> __device__ __forceinline__ f32x4 dpp4(f32x4 v) { f32x4 r; r[0] = dppf<CTRL>(v[0]); r[1] = dppf<CTRL>(v[1]); r[2] = dppf<CTRL>(v[2]); r[3] = dppf<CTRL>(v[3]); return r; }

#define PG8_FD(c_, x_, w_, ctl_) "v_fmac_f32_dpp " c_ ", " x_ ", " w_ " " ctl_ " row_mask:0xf bank_mask:0xf bound_ctrl:1\n\t"
#define PG8_TAPS(NAME, CA, CB) __device__ __forceinline__ void NAME(f32x4& c, const f32x4& x, const f32x4& w1, const f32x4& w0) { \
    float c0 = c[0], c1 = c[1], c2 = c[2], c3 = c[3]; \
    asm("s_nop 1\n\t" PG8_FD("%0", "%4", "%8", CA) PG8_FD("%1", "%5", "%9", CA) PG8_FD("%2", "%6", "%10", CA) PG8_FD("%3", "%7", "%11", CA) \
        PG8_FD("%0", "%4", "%12", CB) PG8_FD("%1", "%5", "%13", CB) PG8_FD("%2", "%6", "%14", CB) PG8_FD("%3", "%7", "%15", CB) \
        : "+v"(c0), "+v"(c1), "+v"(c2), "+v"(c3) : "v"(x[0]), "v"(x[1]), "v"(x[2]), "v"(x[3]), "v"(w1[0]), "v"(w1[1]), "v"(w1[2]), "v"(w1[3]), "v"(w0[0]), "v"(w0[1]), "v"(w0[2]), "v"(w0[3])); \
    c[0] = c0; c[1] = c1; c[2] = c2; c[3] = c3; }
PG8_TAPS(taps_cur, "row_shr:1", "row_shr:2")
PG8_TAPS(taps_prev, "row_shl:15", "row_shl:14")
constexpr int XCH_LDS = RING_BYTES + 1024 + 8192;
static_assert(XCH_LDS + 6144 <= LDS_BYTES, "XCH");
constexpr int CW_LDS = RING_BYTES + 1024;
struct EpiUp { static constexpr bool HAS_PREFETCH = true; static constexpr int NST = 0;
    bf16_t* ACT; float* E; const float* cw; const float* cb;
    __device__ __forceinline__ void prefetch(const Unit& u, int buf, LAS unsigned char* lds, int wid, int lane) const {
        if (wid < 4) { const float* base = (wid < 3) ? cw + (size_t)wid * UPW : cb;
            const float* src = base + 128 * u.pn + ((lane & 32) ? DFF : 0) + 4 * (lane & 31);
            __builtin_amdgcn_global_load_lds((const unsigned*)src, (LAS unsigned*)(lds + CW_LDS + buf * 4096 + wid * 1024), 16, 0, 0); }
    }
    __device__ __forceinline__ void xch_write(const Acc& acc, int wr, int wc, int fr, int fq, LAS unsigned char* lds) const {
        if (fr >= 14) { LAS float* x = (LAS float*)(lds + XCH_LDS) + (fr - 14) * 256 + 32 * wc + 8 * fq;
#pragma unroll
            for (int ai = 0; ai < 2; ++ai) { const int bi = 2 * ai + wr;
                if (bi < 3) {
#pragma unroll
                    for (int s = 0; s < 2; ++s)
#pragma unroll
                        for (int n = 0; n < 2; ++n) *(LAS f32x4*)(x + bi * 512 + s * 128 + 4 * n) = acc[ai][s][3][n]; } } }
    }
    __device__ __forceinline__ void run(const Acc& acc, const Unit& u, int wr, int wc, int fr, int fq, LAS unsigned char* lds, int buf) const {
        const int cl = 32 * wc + 8 * fq;
        const int cbase = 128 * u.pn + cl;
        const LAS float* wl = (const LAS float*)(lds + CW_LDS + buf * 4096) + cl;
        const LAS float* xr = (const LAS float*)(lds + XCH_LDS) + ((fr - 14) & 1) * 256 + cl;
        u32x2 res0[2][4];
#pragma unroll
        for (int n = 0; n < 2; ++n) { const int c0 = cbase + 4 * n;
            const f32x4 wg0 = *(const LAS f32x4*)(wl + 4 * n), wg1 = *(const LAS f32x4*)(wl + 256 + 4 * n), wg2 = *(const LAS f32x4*)(wl + 512 + 4 * n), bg = *(const LAS f32x4*)(wl + 768 + 4 * n);
            const f32x4 wv0 = *(const LAS f32x4*)(wl + 128 + 4 * n), wv1 = *(const LAS f32x4*)(wl + 384 + 4 * n), wv2 = *(const LAS f32x4*)(wl + 640 + 4 * n), bv = *(const LAS f32x4*)(wl + 896 + 4 * n);
#pragma unroll
            for (int ai = 0; ai < 2; ++ai) { f32x4 gprev = {0.f, 0.f, 0.f, 0.f}, vprev = gprev;
                const int bi = 2 * ai + wr, blk = 4 * u.pm + bi;
                const bool top = (ai == 0) && (wr == 0);
                if (!top && fr >= 14) { gprev = *(const LAS f32x4*)(xr + (bi - 1) * 512 + 4 * n); vprev = *(const LAS f32x4*)(xr + (bi - 1) * 512 + 128 + 4 * n); }
#pragma unroll
                for (int m = 0; m < 4; ++m) { const f32x4 gcur = acc[ai][0][m][n], vcur = acc[ai][1][m][n];
                    f32x4 cg = bg + wg2 * gcur, cv = bv + wv2 * vcur;
                    taps_cur(cg, gcur, wg1, wg0); taps_cur(cv, vcur, wv1, wv0);
                    if (m > 0 || !top) { taps_prev(cg, gprev, wg1, wg0); taps_prev(cv, vprev, wv1, wv0); }
                    f32x4 a; a[0] = silu_f(cg[0]) * cv[0]; a[1] = silu_f(cg[1]) * cv[1]; a[2] = silu_f(cg[2]) * cv[2]; a[3] = silu_f(cg[3]) * cv[3];
                    u32x2 w; w.x = cvt_pk_bf16(a[0], a[1]); w.y = cvt_pk_bf16(a[2], a[3]);
                    const int t = u.pm * BM + ai * HALF + wr * 64 + m * 16 + fr;
                    if (n == 0) res0[ai][m] = w;
                    else if (!(m == 0 && top && fr < 2)) { u32x4 o; o.x = res0[ai][m].x; o.y = res0[ai][m].y; o.z = w.x; o.w = w.y; __builtin_nontemporal_store(o, (u32x4*)(ACT + (size_t)t * DFF + cbase)); }
                    if (m == 0 && top && fr < 2) { float* e = E + ((size_t)blk * 4 + fr) * UPW + c0; *(f32x4*)e = gcur; *(f32x4*)(e + DFF) = vcur; }
                    if (m == 3 && bi == 3 && fr >= 14) { float* e = E + ((size_t)blk * 4 + 2 + (fr - 14)) * UPW + c0; *(f32x4*)e = gcur; *(f32x4*)(e + DFF) = vcur; }
                    gprev = gcur; vprev = vcur; } } }
    }
};
}

namespace att {
constexpr int NSLOT = 3, K_OFF = 0, KSLOT = 12288, V_OFF = NSLOT * KSLOT, VSLOT = 8192, WS_OFF = V_OFF + NSLOT * VSLOT, OST_OFF = WS_OFF + 8 * 256, LDS_END = OST_OFF + 8 * 8192;
static_assert(LDS_END <= RING_BYTES, "attention LDS");
__device__ __forceinline__ int crow(int r, int hi) { return (r & 3) + 8 * (r >> 2) + 4 * hi; }
typedef short v4i16_t __attribute__((ext_vector_type(4)));
__device__ __forceinline__ s16x4 vtr(const LAS unsigned char* p) { return __builtin_bit_cast(s16x4, __builtin_amdgcn_ds_read_tr16_b64_v4i16((LAS v4i16_t*)p)); }
__device__ __forceinline__ void glds(const char* src, LAS unsigned char* dst) { unsigned keep; const unsigned d = (unsigned)__builtin_amdgcn_readfirstlane((int)(unsigned)(uintptr_t)dst);
    asm volatile("s_mov_b32 %0, m0\n\ts_mov_b32 m0, %2\n\ts_nop 0\n\tglobal_load_lds_dwordx4 %1, off\n\ts_mov_b32 m0, %0" : "=&s"(keep) : "v"(src), "s"(d) : "memory"); }
__device__ __forceinline__ float max3f(float a, float b, float c) { float r; asm("v_max3_f32 %0, %1, %2, %3" : "=v"(r) : "v"(a), "v"(b), "v"(c)); return r; }
__device__ __forceinline__ float max2f(float a, float b) { float r; asm("v_max_f32_e32 %0, %1, %2" : "=v"(r) : "v"(a), "v"(b)); return r; }
__device__ __forceinline__ float fadd_s(float a, float b) { float r = a + b; asm volatile("" : "+v"(r)); return r; }
typedef float f32x2_t __attribute__((ext_vector_type(2))); typedef __bf16 bf16x2_t __attribute__((ext_vector_type(2)));
__device__ __forceinline__ unsigned cvtpk_m(float lo, float hi) { f32x2_t v = {lo, hi}; bf16x2_t b2 = __builtin_convertvector(v, bf16x2_t); return __builtin_bit_cast(unsigned, b2); }
__device__ __forceinline__ float xmax32(float v) { float a = v, b = v; asm("s_nop 1\n\tv_permlane32_swap_b32 %0, %1\n\ts_nop 1\n\tv_max_f32_e32 %0, %0, %1" : "+v"(a), "+v"(b)); return a; }
constexpr float THRL = 4.0f;

struct AUnit { int b, h, qb; };
__device__ __forceinline__ bool unit_of(int k, int vcu, int G, AUnit& u) {
    const int it = vcu + (k >> 2) * G, r = k & 3; if (it >= 256) return false;
    const int grp = it >> 3, i8 = it & 7, bh = grp * 4 + r; u.b = bh >> 3; u.h = bh & 7;
    u.qb = (r == 0) ? 7 - i8 : (r == 1) ? i8 : (r == 2) ? 7 - (i8 ^ 1) : (i8 ^ 1); return true;
}
__device__ __forceinline__ void attn_phase(int vcu, int G, const float* ssqq, const float* rope, const bf16_t* Q, const bf16_t* KN, const bf16_t* KR, const bf16_t* V, bf16_t* Y, const float* ong, LAS unsigned char* lds) {
    int tid = threadIdx.x; asm volatile("" : "+v"(tid));
    const int lane = tid & 63, r32 = lane & 31, hi = lane >> 5; const int wid = __builtin_amdgcn_readfirstlane(tid >> 6);
    const int lo16 = wid * 1024 + lane * 16;
    LAS float* wsf = (LAS float*)(lds + WS_OFF + wid * 256);
    const int kl = hi * 1024 + r32 * 16, vl = ((lane >> 4) & 1) * 32 + (lane & 3) * 8 + (4 * hi + ((lane & 15) >> 2)) * 64;
#define ATT_ISSUE(U, tile, slot) do { const size_t bh_ = (size_t)((U).b * 8 + (U).h); \
        glds((const char*)KN + (bh_ * 32 + (tile)) * 8192 + lo16, lds + K_OFF + (slot) * KSLOT + wid * 1024); glds((const char*)V + (bh_ * 32 + (tile)) * 8192 + lo16, lds + V_OFF + (slot) * VSLOT + wid * 1024); \
        if (wid < 4) glds((const char*)KR + ((size_t)(U).b * 32 + (tile)) * 4096 + lo16, lds + K_OFF + (slot) * KSLOT + 8192 + wid * 1024); } while (0)
#define ATT_QLOAD(dst, aux, U) do { const size_t row_ = (size_t)((U).b * SEQ + 256 * (U).qb + 32 * wid + r32); const bf16_t* qp_ = Q + row_ * QW + 96 * (U).h + 8 * hi; \
        _Pragma("unroll") for (int ks = 0; ks < 6; ++ks) dst[ks] = *(const bf16x8*)(qp_ + 16 * ks); \
        aux[0] = *(const f32x4*)(ssqq + row_ * 4); aux[1] = *(const f32x4*)(rope + row_ * 32 + 8 * hi); aux[2] = *(const f32x4*)(rope + row_ * 32 + 8 * hi + 4); \
        aux[3] = *(const f32x4*)(rope + row_ * 32 + 16 + 8 * hi); aux[4] = *(const f32x4*)(rope + row_ * 32 + 16 + 8 * hi + 4); } while (0)
#define ATT_QFIX(q, aux) do { const float f_ = rsqrtf(((aux[0][0] + aux[0][1]) + (aux[0][2] + aux[0][3])) * (1.f / 256.f) + 1e-6f) * QSCALE; \
        _Pragma("unroll") for (int ks = 0; ks < 4; ++ks) { const u32x4 w_ = __builtin_bit_cast(u32x4, q[ks]); u32x4 o_; \
            _Pragma("unroll") for (int e = 0; e < 4; ++e) o_[e] = cvtpk_m(bf_lo(w_[e]) * f_, bf_hi(w_[e]) * f_); q[ks] = __builtin_bit_cast(bf16x8, o_); } \
        { const u32x4 a_ = __builtin_bit_cast(u32x4, q[4]), b_ = __builtin_bit_cast(u32x4, q[5]); u32x4 oa_, ob_; \
          _Pragma("unroll") for (int e = 0; e < 4; ++e) { const float x1l = bf_lo(a_[e]), x1h = bf_hi(a_[e]), x2l = bf_lo(b_[e]), x2h = bf_hi(b_[e]); \
              const float cl = (e < 2) ? aux[1][2 * e] : aux[2][2 * e - 4], ch = (e < 2) ? aux[1][2 * e + 1] : aux[2][2 * e - 3], sl = (e < 2) ? aux[3][2 * e] : aux[4][2 * e - 4], sh = (e < 2) ? aux[3][2 * e + 1] : aux[4][2 * e - 3]; \
              oa_[e] = cvtpk_m((x1l * cl - x2l * sl) * f_, (x1h * ch - x2h * sh) * f_); ob_[e] = cvtpk_m((x2l * cl + x1l * sl) * f_, (x2h * ch + x1h * sh) * f_); } \
          q[4] = __builtin_bit_cast(bf16x8, oa_); q[5] = __builtin_bit_cast(bf16x8, ob_); } } while (0)
    AUnit cur, nxt;
    if (!unit_of(0, vcu, G, cur)) return;
    bf16x8 qr[6], qn[6]; f32x4 qa[5], qna[5];
    ATT_QLOAD(qr, qa, cur);
    ATT_QFIX(qr, qa);
    asm volatile("" : "+v"(qr[0]), "+v"(qr[1]), "+v"(qr[2]), "+v"(qr[3]), "+v"(qr[4]), "+v"(qr[5]));
    ATT_ISSUE(cur, 0, 0); ATT_ISSUE(cur, 1, 1);
    int slot = 0;
    for (int k = 0;; ++k) {
        const bool has_next = unit_of(k + 1, vcu, G, nxt);
        const int NT = 4 * cur.qb + 4, jmax = 4 * cur.qb + (wid >> 1);
        float mrun = 0.f, lrun = 0.f; f32x16 o[2]; o[0] = f32x16{}; o[1] = f32x16{}; f32x16 negm = f32x16{};
        for (int j = 0; j < NT; ++j) {
            if (j == 0 && k > 0) { if (wid < 4) asm volatile("s_waitcnt vmcnt(13) lgkmcnt(0)\n\ts_barrier" ::: "memory"); else asm volatile("s_waitcnt vmcnt(12) lgkmcnt(0)\n\ts_barrier" ::: "memory"); }
            else if (j + 1 < NT || has_next) { if (wid < 4) asm volatile("s_waitcnt vmcnt(3) lgkmcnt(0)\n\ts_barrier" ::: "memory"); else asm volatile("s_waitcnt vmcnt(2) lgkmcnt(0)\n\ts_barrier" ::: "memory"); }
            else asm volatile("s_waitcnt vmcnt(0) lgkmcnt(0)\n\ts_barrier" ::: "memory");
            { const int s2 = (slot == 0) ? 2 : slot - 1;
              if (j + 2 < NT) ATT_ISSUE(cur, j + 2, s2); else if (has_next) ATT_ISSUE(nxt, j + 2 - NT, s2); }
            if (j == NT - 1 && has_next) ATT_QLOAD(qn, qna, nxt);
            if (j <= jmax) {
                const LAS unsigned char* kp = lds + K_OFF + slot * KSLOT + kl;
                f32x16 p0, p1;
#pragma unroll
                for (int ks = 0; ks < 6; ++ks) { const bf16x8 k0 = *(const LAS bf16x8*)(kp + ks * 2048), k1 = *(const LAS bf16x8*)(kp + ks * 2048 + 512);
                    if (ks == 0) { p0 = __builtin_amdgcn_mfma_f32_32x32x16_bf16(k0, qr[0], negm, 0, 0, 0); p1 = __builtin_amdgcn_mfma_f32_32x32x16_bf16(k1, qr[0], negm, 0, 0, 0); }
                    else { p0 = __builtin_amdgcn_mfma_f32_32x32x16_bf16(k0, qr[ks], p0, 0, 0, 0); p1 = __builtin_amdgcn_mfma_f32_32x32x16_bf16(k1, qr[ks], p1, 0, 0, 0); } }
                const LAS unsigned char* vp = lds + V_OFF + slot * VSLOT + vl;
                s16x4 vlo[4], vhi[4];
#pragma unroll
                for (int ks = 0; ks < 4; ++ks) { vlo[ks] = vtr(vp + ks * 1024); vhi[ks] = vtr(vp + ks * 1024 + 512); }
                asm volatile("s_nop 15\n\ts_nop 7" : "+v"(p0), "+v"(p1) : : "memory");
                float rm;
                { float a = max3f(p0[0], p0[1], p1[0]), c = max3f(p0[2], p0[3], p1[1]); a = max3f(a, p1[2], p1[3]);
#pragma unroll
                  for (int r = 4; r < 16; r += 4) { a = max3f(a, p0[r], p0[r + 1]); c = max3f(c, p0[r + 2], p0[r + 3]); a = max3f(a, p1[r], p1[r + 1]); c = max3f(c, p1[r + 2], p1[r + 3]); }
                  rm = max2f(a, c); rm = xmax32(rm); }
                if (j == 0 || __any(rm > THRL)) {
                    const float dl = (j == 0) ? rm : fmaxf(rm, 0.f);
                    mrun += dl;
#pragma unroll
                    for (int r = 0; r < 16; ++r) { p0[r] -= dl; p1[r] -= dl; }
#pragma unroll
                    for (int r = 0; r < 16; ++r) negm[r] = -mrun;
                    if (j != 0) { const float alpha = fexp2(-dl); lrun *= alpha;
                        if (hi == 0) wsf[r32] = alpha;
#pragma unroll
                        for (int r = 0; r < 16; ++r) { const float a_ = wsf[crow(r, hi)]; o[0][r] *= a_; o[1][r] *= a_; } }
                }
#pragma unroll
                for (int r = 0; r < 16; ++r) { p0[r] = fexp2(p0[r]); p1[r] = fexp2(p1[r]); }
                { f32x2_t sa = f32x2_t{p0[0], p0[1]} + f32x2_t{p0[2], p0[3]}, sb = f32x2_t{p1[0], p1[1]} + f32x2_t{p1[2], p1[3]};
#pragma unroll
                  for (int r = 4; r < 16; r += 2) { sa += f32x2_t{p0[r], p0[r + 1]}; sb += f32x2_t{p1[r], p1[r + 1]}; }
                  sa += sb; lrun += sa[0] + sa[1]; }
                bf16x8 pa[4];
                { u32x4 w0, w1, w2, w3;
                  w0.x = cvtpk_m(p0[0], p0[1]); w0.y = cvtpk_m(p0[2], p0[3]); w0.z = cvtpk_m(p0[4], p0[5]); w0.w = cvtpk_m(p0[6], p0[7]);
                  w1.x = cvtpk_m(p0[8], p0[9]); w1.y = cvtpk_m(p0[10], p0[11]); w1.z = cvtpk_m(p0[12], p0[13]); w1.w = cvtpk_m(p0[14], p0[15]);
                  w2.x = cvtpk_m(p1[0], p1[1]); w2.y = cvtpk_m(p1[2], p1[3]); w2.z = cvtpk_m(p1[4], p1[5]); w2.w = cvtpk_m(p1[6], p1[7]);
                  w3.x = cvtpk_m(p1[8], p1[9]); w3.y = cvtpk_m(p1[10], p1[11]); w3.z = cvtpk_m(p1[12], p1[13]); w3.w = cvtpk_m(p1[14], p1[15]);
                  pa[0] = __builtin_bit_cast(bf16x8, w0); pa[1] = __builtin_bit_cast(bf16x8, w1); pa[2] = __builtin_bit_cast(bf16x8, w2); pa[3] = __builtin_bit_cast(bf16x8, w3); }
                s16x4 wlo[4], whi[4];
#pragma unroll
                for (int ks = 0; ks < 4; ++ks) { wlo[ks] = vtr(vp + 4096 + ks * 1024); whi[ks] = vtr(vp + 4096 + ks * 1024 + 512); }
                asm volatile("" ::: "memory");
#pragma unroll
                for (int ks = 0; ks < 4; ++ks) { const bf16x8 vf = {vlo[ks][0], vlo[ks][1], vlo[ks][2], vlo[ks][3], vhi[ks][0], vhi[ks][1], vhi[ks][2], vhi[ks][3]};
                    o[0] = __builtin_amdgcn_mfma_f32_32x32x16_bf16(pa[ks], vf, o[0], 0, 0, 0); }
#pragma unroll
                for (int ks = 0; ks < 4; ++ks) { const bf16x8 vf = {wlo[ks][0], wlo[ks][1], wlo[ks][2], wlo[ks][3], whi[ks][0], whi[ks][1], whi[ks][2], whi[ks][3]};
                    o[1] = __builtin_amdgcn_mfma_f32_32x32x16_bf16(pa[ks], vf, o[1], 0, 0, 0); }
            }
            slot = (slot == 2) ? 0 : slot + 1;
        }
        { const float lt = lrun + __shfl_xor(lrun, 32);
          if (hi == 0) wsf[r32] = frcp(lt);
          LAS float* stg = (LAS float*)(lds + OST_OFF + wid * 8192);
#pragma unroll
          for (int r = 0; r < 16; ++r) { const float inv = wsf[crow(r, hi)]; const int orow = crow(r, hi); stg[orow * 64 + r32] = o[0][r] * inv; stg[orow * 64 + 32 + r32] = o[1][r] * inv; }
          asm volatile("s_waitcnt lgkmcnt(0)" ::: "memory");
          const int ch = lane & 7;
          const f32x4 ga = *(const f32x4*)(ong + 64 * cur.h + 8 * ch), gb = *(const f32x4*)(ong + 64 * cur.h + 8 * ch + 4);
          bf16_t* Yw = Y + (size_t)(cur.b * SEQ + 256 * cur.qb + 32 * wid) * D + 64 * cur.h + 8 * ch;
#pragma unroll
          for (int i = 0; i < 4; ++i) { const int row = i * 8 + (lane >> 3);
              const f32x4 va = *(const LAS f32x4*)(stg + row * 64 + 8 * ch), vb = *(const LAS f32x4*)(stg + row * 64 + 8 * ch + 4);
              float ss = (va[0] * va[0] + va[1] * va[1]) + (va[2] * va[2] + va[3] * va[3]) + (vb[0] * vb[0] + vb[1] * vb[1]) + (vb[2] * vb[2] + vb[3] * vb[3]);
              ss += pg8::dppf<0xB1>(ss); ss += pg8::dppf<0x4E>(ss); ss += pg8::dppf<0x141>(ss);
              const float rs = rsqrtf(ss * (1.f / 64.f) + 1e-6f);
              const f32x4 oa = va * rs * ga, ob = vb * rs * gb;
              u32x4 w; w.x = cvtpk_m(oa[0], oa[1]); w.y = cvtpk_m(oa[2], oa[3]); w.z = cvtpk_m(ob[0], ob[1]); w.w = cvtpk_m(ob[2], ob[3]);
              *(u32x4*)(Yw + (size_t)row * D) = w; } }
        if (!has_next) break;
        cur = nxt;
#pragma unroll
        for (int ks = 0; ks < 6; ++ks) qr[ks] = qn[ks];
        ATT_QFIX(qr, qna);
    }
    asm volatile("s_waitcnt vmcnt(0) lgkmcnt(0)\n\ts_barrier" ::: "memory");
#undef ATT_ISSUE
#undef ATT_QLOAD
#undef ATT_QFIX
}
}

#define XB_TMO      128
#define XB_XCNT(j)  (256  + 64 * (j))
#define XB_XSUB(j)  (1280 + 64 * (j))
#define XB_XGEN(j)  (2304 + 64 * (j))
#define XB_TOP      3328
#define XB_TOPGEN   3392
#define XCD_BAR_WORDS 3456
#define XB_SPIN_CAP (1u << 18)
__device__ __forceinline__ unsigned xb_ld(unsigned* p)              { return __hip_atomic_load(p, __ATOMIC_RELAXED, __HIP_MEMORY_SCOPE_AGENT); }
__device__ __forceinline__ unsigned xb_add(unsigned* p, unsigned v) { return __hip_atomic_fetch_add(p, v, __ATOMIC_RELAXED, __HIP_MEMORY_SCOPE_AGENT); }
__device__ __forceinline__ unsigned xb_xcc_id() { return (unsigned)__builtin_amdgcn_s_getreg((3 << 11) | 20) & 0xFu; }
#define XB_SPIN(cond, bar) do { unsigned _sp = 0; while (cond) { __builtin_amdgcn_s_sleep(1); \
    if ((++_sp & 255u) == 0u) { if (xb_ld(&(bar)[XB_TMO])) break; if (_sp > XB_SPIN_CAP) { atomicAdd(&(bar)[XB_TMO], 1u); break; } } } } while (0)
struct XcdBarrier { unsigned* bar; unsigned x; volatile LAS unsigned* st; };
__device__ __forceinline__ XcdBarrier xcd_barrier_post(unsigned* bar, volatile LAS unsigned* st) {
    XcdBarrier b; b.bar = bar; b.x = xb_xcc_id(); b.st = st;
    if (threadIdx.x == 0) (void)xb_add(&bar[XB_XCNT(b.x)], 1u);
    return b;
}
__device__ __forceinline__ void xcd_barrier_complete(unsigned* bar, unsigned x, unsigned& nloc, unsigned& nx) {
    const unsigned G = gridDim.x * gridDim.y * gridDim.z;
    unsigned sum, cnt, mine, sp = 0u;
    for (;;) {
        sum = 0u; cnt = 0u; mine = 0u;
#pragma unroll
        for (unsigned j = 0; j < 16; ++j) { const unsigned c = xb_ld(&bar[XB_XCNT(j)]); sum += c; cnt += (c > 0u) ? 1u : 0u; mine = (j == x) ? c : mine; }
        if (sum == G) break;
        __builtin_amdgcn_s_sleep(1);
        if ((++sp & 255u) == 0u) { if (xb_ld(&bar[XB_TMO])) break; if (sp > XB_SPIN_CAP) { atomicAdd(&bar[XB_TMO], 1u); break; } }
    }
    nloc = mine > 0u ? mine : 1u; nx = cnt > 0u ? cnt : 1u;
}
__device__ __forceinline__ void xcd_barrier(const XcdBarrier& b) {
    asm volatile("s_waitcnt vmcnt(0)" ::: "memory");
    __syncthreads();
    if (threadIdx.x == 0) {
        unsigned* bar = b.bar;
        __builtin_amdgcn_s_waitcnt(0);
        unsigned nloc = b.st[0], nx = b.st[1];
        if (nloc == 0u) { xcd_barrier_complete(bar, b.x, nloc, nx); b.st[0] = nloc; b.st[1] = nx; }
        const unsigned old = xb_add(&bar[XB_XSUB(b.x)], 1u);
        const unsigned gen = old / nloc;
        if (old + 1u == (gen + 1u) * nloc) {
            __builtin_amdgcn_fence(__ATOMIC_RELEASE, "agent");
            asm volatile("s_waitcnt vmcnt(0)" ::: "memory");
            const unsigned og = xb_add(&bar[XB_TOP], 1u);
            const unsigned tg = og / nx;
            if (og + 1u == (tg + 1u) * nx) xb_add(&bar[XB_TOPGEN], 1u);
            else XB_SPIN(xb_ld(&bar[XB_TOPGEN]) == tg, bar);
            __builtin_amdgcn_fence(__ATOMIC_ACQUIRE, "agent");
            xb_add(&bar[XB_XGEN(b.x)], 1u);
            asm volatile("s_waitcnt vmcnt(0)" ::: "memory");
        } else {
            XB_SPIN(xb_ld(&bar[XB_XGEN(b.x)]) == gen, bar);
            __builtin_amdgcn_fence(__ATOMIC_ACQUIRE, "agent");
            asm volatile("s_waitcnt vmcnt(0)" ::: "memory");
        }
    }
    __syncthreads();
}

struct Args { const float* in[22]; const int* pos; float* out; unsigned char* ws; int ph_lo, ph_hi; };
__constant__ float c_invfreq[16] = {1.0f, 0.5623413251903491f, 0.31622776601683794f, 0.1778279410038923f, 0.1f, 0.05623413251903491f, 0.03162277660168379f, 0.01778279410038923f,
                                    0.01f, 0.005623413251903491f, 0.0031622776601683794f, 0.001778279410038923f, 0.001f, 0.0005623413251903491f, 0.00031622776601683794f, 0.0001778279410038923f};

__device__ __forceinline__ int colmap(int which, int s) {
    const int p = (s & ~31) + pg8::perm32(s & 31);
    switch (which) {
        case 0: { if (s < 1024) return p < 416 ? p : (p < 512 ? -1 : p - 96);
                  const int bj = (s >> 7) & 1, ch = 128 * ((s >> 8) - 4) + 32 * ((s >> 5) & 3) + pg8::perm32(s & 31); return (bj ? 1440 : 928) + ch; }
        case 4: { const int pn = s >> 8, bj = (s >> 7) & 1, wc = (s >> 5) & 3; return bj * DFF + 128 * pn + 32 * wc + pg8::perm32(s & 31); }
        default: return p;
    }
}
__device__ __forceinline__ void p0_transpose_item(const float* W, int ldw, int Ksrc, const float* kscale, bf16_t* WT, int Kdst, int which, LAS float* scr, int item, int nblk, int lane) {
    const int kb = item / nblk, nb = item % nblk, k0 = 64 * kb, s0 = 32 * nb;
    const int cm = colmap(which, s0 + (lane & 31));
    float tv[32];
#pragma unroll
    for (int i = 0; i < 32; ++i) { const int k = k0 + 2 * i + (lane >> 5); tv[i] = (cm >= 0 && k < Ksrc) ? __builtin_nontemporal_load(W + (size_t)k * ldw + cm) : 0.f; }
    if (kscale) {
#pragma unroll
        for (int i = 0; i < 32; ++i) { const int k = k0 + 2 * i + (lane >> 5); if (k < Ksrc) tv[i] *= kscale[k]; } }
#pragma unroll
    for (int i = 0; i < 32; ++i) scr[(2 * i + (lane >> 5)) * 33 + (lane & 31)] = tv[i];
    asm volatile("s_waitcnt lgkmcnt(0)" ::: "memory");
    const int c = lane & 7;
#pragma unroll
    for (int j = 0; j < 4; ++j) { const int n = (lane >> 3) + 8 * j; const LAS float* s = scr + (8 * c) * 33 + n;
        u32x4 o; o.x = cvt_pk_bf16(s[0 * 33], s[1 * 33]); o.y = cvt_pk_bf16(s[2 * 33], s[3 * 33]); o.z = cvt_pk_bf16(s[4 * 33], s[5 * 33]); o.w = cvt_pk_bf16(s[6 * 33], s[7 * 33]);
        *(u32x4*)(WT + (size_t)(s0 + n) * Kdst + k0 + 8 * c) = o; }
    asm volatile("s_waitcnt lgkmcnt(0)" ::: "memory");
}

constexpr int N_PHASES = 11;
#define OPAQUE_LANE(name) int name##_t = (int)threadIdx.x; asm volatile("" : "+v"(name##_t)); const int name = name##_t & 63

__global__ void __launch_bounds__(512, 2) mk_fwd(Args args) {
    extern __shared__ __attribute__((aligned(16))) unsigned char lds_raw[];
    LAS unsigned char* lds = (LAS unsigned char*)lds_raw;
    volatile LAS unsigned* MISC = (volatile LAS unsigned*)(lds + MISC_OFF);
    const int tid = threadIdx.x, lane = tid & 63, wave = __builtin_amdgcn_readfirstlane(tid >> 6);
    const int G = gridDim.x; const int bx = blockIdx.x; const int vcu = (G % 8 == 0) ? (bx % 8) * (G / 8) + bx / 8 : bx;
    const int gw = vcu * 8 + wave, NGW = G * 8;
    unsigned char* ws = args.ws;
    const float* x = args.in[0]; const float* cvec = args.in[1]; const int* pos = args.pos;
    const float* w_ada = args.in[3]; const float* b_ada = args.in[4]; const float* w_in = args.in[5];
    const float* qg = args.in[6]; const float* w_qup = args.in[7]; const float* kvg = args.in[8]; const float* w_kvup = args.in[9];
    const float* conv_w = args.in[10]; const float* conv_b = args.in[11]; const float* ong = args.in[12]; const float* w_out = args.in[13];
    const float* ln1g = args.in[14]; const float* ln1b = args.in[15]; const float* w_up = args.in[16];
    const float* fcw = args.in[17]; const float* fcb = args.in[18]; const float* w_down = args.in[19];
    const float* ln2g = args.in[20]; const float* ln2b = args.in[21];
    float* out = args.out;
    float* MOD = (float*)(ws + WS_MOD); float* ROPE = (float*)(ws + WS_ROPE); float* SSQQ = (float*)(ws + WS_SSQQ); float* SSQKV = (float*)(ws + WS_SSQKV);
    bf16_t* WIN = (bf16_t*)(ws + WS_WIN); bf16_t* WQ = (bf16_t*)(ws + WS_WQ); bf16_t* WKV = (bf16_t*)(ws + WS_WKV); bf16_t* WOUT = (bf16_t*)(ws + WS_WOUT);
    bf16_t* WUP = (bf16_t*)(ws + WS_WUP); bf16_t* WDN = (bf16_t*)(ws + WS_WDN);
    bf16_t* HB = (bf16_t*)(ws + WS_HB); bf16_t* FF = (bf16_t*)(ws + WS_FF); bf16_t* P = (bf16_t*)(ws + WS_P); bf16_t* MIX = (bf16_t*)(ws + WS_MIX);
    bf16_t* U = (bf16_t*)(ws + WS_U); bf16_t* Qb = (bf16_t*)(ws + WS_Q); bf16_t* KN = (bf16_t*)(ws + WS_KN); bf16_t* KR = (bf16_t*)(ws + WS_KR); bf16_t* Vb = (bf16_t*)(ws + WS_V);
    bf16_t* Y = (bf16_t*)(ws + WS_Y); bf16_t* X1 = (bf16_t*)(ws + WS_X1); bf16_t* ACT = (bf16_t*)(ws + WS_ACT); float* E = (float*)(ws + WS_E);

    for (int u = tid; u < (LDS_BYTES - LDSCTL_OFF) / 4; u += 512) ((LAS unsigned*)(lds + LDSCTL_OFF))[u] = 0u;
    __syncthreads();
    XcdBarrier bar; bar.bar = (unsigned*)(ws + WS_CTL) + CW_BAR; bar.x = 0; bar.st = nullptr;
    if (MK_N_LAUNCHES == 1) bar = xcd_barrier_post((unsigned*)(ws + WS_CTL) + CW_BAR, MISC + 8);
    const int lo = args.ph_lo, hi = args.ph_hi;
#ifndef PH_MASK
#define PH_MASK 0x7ff
#endif
#define IN(k) (((PH_MASK >> (k)) & 1) && lo <= (k) && (k) < hi)
#define SEAM(k) do { if (IN(k) && IN((k) + 1)) xcd_barrier(bar); } while (0)

    if (IN(0)) {
        OPAQUE_LANE(ln);
        if (bx < 192) {
            LAS float* cact = (LAS float*)lds; LAS float* part = (LAS float*)(lds + 65536);
            const int n0 = 32 * bx, c4 = tid & 7, kr = tid >> 3;
            f32x4 wv[16];
#pragma unroll
            for (int i = 0; i < 16; ++i) wv[i] = __builtin_nontemporal_load((const f32x4*)(w_ada + (size_t)(kr + 64 * i) * 6144 + n0 + 4 * c4));
            for (int i = tid; i < 16 * 1024; i += 512) { const float v = cvec[i]; cact[i] = v * frcp(1.f + fexp2(-LOG2E * v)); }
            __syncthreads();
            f32x4 a[16];
#pragma unroll
            for (int b = 0; b < 16; ++b) a[b] = (f32x4){0.f, 0.f, 0.f, 0.f};
#pragma unroll
            for (int i = 0; i < 16; ++i) { const int k = kr + 64 * i;
#pragma unroll
                for (int b = 0; b < 16; ++b) a[b] += wv[i] * cact[b * 1024 + k];
                if ((i & 1) == 1) asm volatile("" ::: "memory"); }
#pragma unroll
            for (int b = 0; b < 16; ++b)
#pragma unroll
                for (int e = 0; e < 4; ++e) { float v = a[b][e]; v += __shfl_xor(v, 8); v += __shfl_xor(v, 16); v += __shfl_xor(v, 32); a[b][e] = v; }
            if (ln < 8) {
#pragma unroll
                for (int b = 0; b < 16; ++b) *(LAS f32x4*)(part + (wave * 16 + b) * 32 + 4 * c4) = a[b]; }
            __syncthreads();
            { const int b = tid >> 5, col = tid & 31; float s = 0.f;
#pragma unroll
              for (int w8 = 0; w8 < 8; ++w8) s += part[(w8 * 16 + b) * 32 + col];
              MOD[b * 6144 + n0 + col] = s + b_ada[n0 + col]; }
            __syncthreads();
        }
        for (int idx = gw * 64 + ln; idx < T * 16; idx += NGW * 64) { const int t = idx >> 4, i = idx & 15; const float ang = (float)pos[t] * c_invfreq[i];
            ROPE[(size_t)t * 32 + i] = cosf(ang); ROPE[(size_t)t * 32 + 16 + i] = sinf(ang); }
    }
    SEAM(0);
    if (IN(1)) {
        OPAQUE_LANE(ln);
        {
        LAS float* scr = (LAS float*)(lds + wave * 16384);
        constexpr int I0 = 16 * 64, I1 = 4 * 24, I2 = 4 * 32, I3 = 16 * 32, I4 = 16 * 176, I5 = 44 * 32, NIT = I0 + I1 + I2 + I3 + I4 + I5;
        for (int it = gw; it < NIT; it += NGW) {
            int r = it;
            if (r < I0) { p0_transpose_item(w_in, INW, D, nullptr, WIN, D, 0, scr, r, 64, ln); continue; } r -= I0;
            if (r < I1) { p0_transpose_item(w_qup, QW, 256, qg, WQ, 256, 1, scr, r, 24, ln); continue; } r -= I1;
            if (r < I2) { p0_transpose_item(w_kvup, 1024, 128, kvg, WKV, 256, 2, scr, r, 32, ln); continue; } r -= I2;
            if (r < I3) { p0_transpose_item(w_out, D, D, nullptr, WOUT, D, 3, scr, r, 32, ln); continue; } r -= I3;
            if (r < I4) { p0_transpose_item(w_up, UPW, D, nullptr, WUP, D, 4, scr, r, 176, ln); continue; } r -= I4;
            p0_transpose_item(w_down, D, DFF, nullptr, WDN, DFF, 5, scr, r, 32, ln);
        }
            }
        for (int row0 = gw * 16; row0 < T; row0 += NGW * 16) { const int b = row0 / SEQ; const float* mb = MOD + b * 6144;
            f32x4 sc[4], sh[4];
#pragma unroll
            for (int j = 0; j < 4; ++j) { const int col = 4 * ln + 256 * j; sh[j] = *(const f32x4*)(mb + col); sc[j] = *(const f32x4*)(mb + 1024 + col) + 1.f; }
            f32x4 xn[4];
#pragma unroll
            for (int j = 0; j < 4; ++j) xn[j] = __builtin_nontemporal_load((const f32x4*)(x + (size_t)row0 * D + 4 * ln + 256 * j));
            for (int rr = 0; rr < 16; ++rr) { const int t = row0 + rr;
                f32x4 v[4]; float s = 0.f;
#pragma unroll
                for (int j = 0; j < 4; ++j) { v[j] = xn[j]; s += (v[j][0] + v[j][1]) + (v[j][2] + v[j][3]); }
                if (rr + 1 < 16) {
#pragma unroll
                    for (int j = 0; j < 4; ++j) xn[j] = __builtin_nontemporal_load((const f32x4*)(x + (size_t)(t + 1) * D + 4 * ln + 256 * j)); }
                const float mean = wave_sum(s) * (1.f / D); float q = 0.f;
#pragma unroll
                for (int j = 0; j < 4; ++j) { v[j] = v[j] - mean; q += (v[j][0] * v[j][0] + v[j][1] * v[j][1]) + (v[j][2] * v[j][2] + v[j][3] * v[j][3]); }
                const float rstd = rsqrtf(wave_sum(q) * (1.f / D) + 1e-5f);
#pragma unroll
                for (int j = 0; j < 4; ++j) { const f32x4 o = v[j] * rstd * sc[j] + sh[j]; u32x2 w; w.x = cvt_pk_bf16(o[0], o[1]); w.y = cvt_pk_bf16(o[2], o[3]);
                    *(u32x2*)(HB + (size_t)t * D + 4 * ln + 256 * j) = w; } } }
    }
    SEAM(1);
    if (IN(2)) {
        pg8::Gemm g{HB, D, WIN, T, 512, D}; pg8::StaticOrder S; S.init(T, 512, G, bx);
        pg8::EpiP E1{P, U, SSQQ, SSQKV};
        pg8::gemm_phase<pg8::EpiP, true>(lds, g, S, E1);
    }
    SEAM(2);
    if (IN(3)) {
        OPAQUE_LANE(ln);
        for (int row0 = gw * 16; row0 < T; row0 += NGW * 16) {
            { const int t = row0 + (ln >> 2), c = ln & 3, i0 = 8 * (c & 1); const bf16_t* pr = P + (size_t)t * PW + 384;
              const u32x4 r1 = *(const u32x4*)(pr + i0), r2 = *(const u32x4*)(pr + 16 + i0);
              const f32x4 ca = *(const f32x4*)(ROPE + (size_t)t * 32 + i0), cb = *(const f32x4*)(ROPE + (size_t)t * 32 + i0 + 4), sa = *(const f32x4*)(ROPE + (size_t)t * 32 + 16 + i0), sb = *(const f32x4*)(ROPE + (size_t)t * 32 + 16 + i0 + 4);
              float ov[8];
#pragma unroll
              for (int e = 0; e < 8; ++e) { const float x1 = (e & 1) ? bf_hi(r1[e >> 1]) : bf_lo(r1[e >> 1]), x2 = (e & 1) ? bf_hi(r2[e >> 1]) : bf_lo(r2[e >> 1]);
                  const float cs = (e < 4) ? ca[e & 3] : cb[e & 3], sn = (e < 4) ? sa[e & 3] : sb[e & 3];
                  ov[e] = (c < 2) ? x1 * cs - x2 * sn : x2 * cs + x1 * sn; }
              u32x4 o; o.x = cvt_pk_bf16(ov[0], ov[1]); o.y = cvt_pk_bf16(ov[2], ov[3]); o.z = cvt_pk_bf16(ov[4], ov[5]); o.w = cvt_pk_bf16(ov[6], ov[7]);
              *(u32x4*)((char*)KR + (size_t)(t >> 6) * 4096 + c * 1024 + (t & 63) * 16) = o; }
        }
        { pg8::MixedOrder S{(const char*)HB, (const char*)P, (const char*)WIN, (const char*)WQ, (const char*)WKV, G, bx};
          pg8::EpiMix EM{pg8::EpiP{P, U, SSQQ, SSQKV}, pg8::EpiStore{Qb, QW, true}, pg8::EpiKV{KN, Vb}, SSQKV};
          pg8::gemm_multi<pg8::MixedOrder, pg8::EpiMix>(lds, S, EM); }
    }
    SEAM(3);
    if (IN(4)) {
        att::attn_phase(vcu, G, SSQQ, ROPE, Qb, KN, KR, Vb, Y, ong, lds);
        { OPAQUE_LANE(ln);
        for (int row0 = gw * 16; row0 < T; row0 += NGW * 16) {
            const int c0 = 8 * ln;
            float w0[8], w1[8], w2[8], cb8[8], gn[8];
#pragma unroll
            for (int e = 0; e < 8; ++e) { w0[e] = conv_w[c0 + e]; w1[e] = conv_w[512 + c0 + e]; w2[e] = conv_w[1024 + c0 + e]; cb8[e] = conv_b[c0 + e]; gn[e] = ong[512 + c0 + e]; }
            float um2[8], um1[8];
#pragma unroll
            for (int e = 0; e < 8; ++e) { um2[e] = 0.f; um1[e] = 0.f; }
            if ((row0 % SEQ) != 0) {
                const u32x4 a2 = *(const u32x4*)(U + (size_t)(row0 - 2) * 512 + c0), a1 = *(const u32x4*)(U + (size_t)(row0 - 1) * 512 + c0);
#pragma unroll
                for (int e = 0; e < 4; ++e) { um2[2 * e] = bf_lo(a2[e]); um2[2 * e + 1] = bf_hi(a2[e]); um1[2 * e] = bf_lo(a1[e]); um1[2 * e + 1] = bf_hi(a1[e]); }
            }
            u32x4 gbn[4], uun[4];
#pragma unroll
            for (int q = 0; q < 4; ++q) { gbn[q] = __builtin_nontemporal_load((const u32x4*)(P + (size_t)(row0 + q) * PW + 512 + c0)); uun[q] = __builtin_nontemporal_load((const u32x4*)(U + (size_t)(row0 + q) * 512 + c0)); }
#pragma unroll
            for (int rr = 0; rr < 16; ++rr) { const int t = row0 + rr;
                const u32x4 gb = gbn[rr & 3], uu = uun[rr & 3];
                if (rr + 4 < 16) { gbn[rr & 3] = __builtin_nontemporal_load((const u32x4*)(P + (size_t)(t + 4) * PW + 512 + c0)); uun[rr & 3] = __builtin_nontemporal_load((const u32x4*)(U + (size_t)(t + 4) * 512 + c0)); }
                float u0[8], yv[8]; float ss = 0.f;
#pragma unroll
                for (int e = 0; e < 4; ++e) { u0[2 * e] = bf_lo(uu[e]); u0[2 * e + 1] = bf_hi(uu[e]); }
#pragma unroll
                for (int e = 0; e < 8; ++e) { const float gbe = (e & 1) ? bf_hi(gb[e >> 1]) : bf_lo(gb[e >> 1]);
                    yv[e] = gbe * (cb8[e] + w0[e] * um2[e] + w1[e] * um1[e] + w2[e] * u0[e]); ss += yv[e] * yv[e]; um2[e] = um1[e]; um1[e] = u0[e]; }
                ss += __shfl_xor(ss, 1); ss += __shfl_xor(ss, 2); ss += __shfl_xor(ss, 4);
                const float rs = rsqrtf(ss * (1.f / 64.f) + 1e-6f);
                u32x4 o; o.x = cvt_pk_bf16(yv[0] * rs * gn[0], yv[1] * rs * gn[1]); o.y = cvt_pk_bf16(yv[2] * rs * gn[2], yv[3] * rs * gn[3]);
                o.z = cvt_pk_bf16(yv[4] * rs * gn[4], yv[5] * rs * gn[5]); o.w = cvt_pk_bf16(yv[6] * rs * gn[6], yv[7] * rs * gn[7]);
                *(u32x4*)(Y + (size_t)t * D + 512 + c0) = o; }
        }
            }
    }
    SEAM(4);
    if (IN(5)) {
        pg8::Gemm g{Y, D, WOUT, T, D, D}; pg8::StaticOrder S; S.init(T, D, G, bx); pg8::EpiStore E4{MIX, D, true};
        pg8::gemm_phase<pg8::EpiStore, true>(lds, g, S, E4);
    }
    SEAM(5);
    if (IN(6)) {
        OPAQUE_LANE(ln);
        for (int row0 = gw * 16; row0 < T; row0 += NGW * 16) { const int b = row0 / SEQ; const float* mb = MOD + b * 6144;
            f32x4 gt[4], g1v[4], b1v[4], sc[4], sh[4];
#pragma unroll
            for (int j = 0; j < 4; ++j) { const int col = 4 * ln + 256 * j; gt[j] = *(const f32x4*)(mb + 2048 + col); g1v[j] = *(const f32x4*)(ln1g + col); b1v[j] = *(const f32x4*)(ln1b + col);
                sh[j] = *(const f32x4*)(mb + 3072 + col); sc[j] = *(const f32x4*)(mb + 4096 + col) + 1.f; }
            f32x4 xn[4]; u32x2 mn[4];
#pragma unroll
            for (int j = 0; j < 4; ++j) { const int col = 4 * ln + 256 * j; xn[j] = __builtin_nontemporal_load((const f32x4*)(x + (size_t)row0 * D + col)); mn[j] = __builtin_nontemporal_load((const u32x2*)(MIX + (size_t)row0 * D + col)); }
            for (int rr = 0; rr < 16; ++rr) { const int t = row0 + rr;
                f32x4 v[4]; float s = 0.f;
#pragma unroll
                for (int j = 0; j < 4; ++j) { const f32x4 mx = {bf_lo(mn[j].x), bf_hi(mn[j].x), bf_lo(mn[j].y), bf_hi(mn[j].y)};
                    v[j] = xn[j] * ALPHA + gt[j] * mx; s += (v[j][0] + v[j][1]) + (v[j][2] + v[j][3]); }
                if (rr + 1 < 16) {
#pragma unroll
                    for (int j = 0; j < 4; ++j) { const int col = 4 * ln + 256 * j; xn[j] = __builtin_nontemporal_load((const f32x4*)(x + (size_t)(t + 1) * D + col)); mn[j] = __builtin_nontemporal_load((const u32x2*)(MIX + (size_t)(t + 1) * D + col)); } }
                float mean = wave_sum(s) * (1.f / D); float q = 0.f;
#pragma unroll
                for (int j = 0; j < 4; ++j) { v[j] = v[j] - mean; q += (v[j][0] * v[j][0] + v[j][1] * v[j][1]) + (v[j][2] * v[j][2] + v[j][3] * v[j][3]); }
                float rstd = rsqrtf(wave_sum(q) * (1.f / D) + 1e-5f);
                s = 0.f;
#pragma unroll
                for (int j = 0; j < 4; ++j) { v[j] = v[j] * rstd * g1v[j] + b1v[j]; u32x2 w; w.x = cvt_pk_bf16(v[j][0], v[j][1]); w.y = cvt_pk_bf16(v[j][2], v[j][3]); __builtin_nontemporal_store(w, (u32x2*)(X1 + (size_t)t * D + 4 * ln + 256 * j)); s += (v[j][0] + v[j][1]) + (v[j][2] + v[j][3]); }
                mean = wave_sum(s) * (1.f / D); q = 0.f;
#pragma unroll
                for (int j = 0; j < 4; ++j) { v[j] = v[j] - mean; q += (v[j][0] * v[j][0] + v[j][1] * v[j][1]) + (v[j][2] * v[j][2] + v[j][3] * v[j][3]); }
                rstd = rsqrtf(wave_sum(q) * (1.f / D) + 1e-5f);
#pragma unroll
                for (int j = 0; j < 4; ++j) { const f32x4 o = v[j] * rstd * sc[j] + sh[j]; u32x2 w; w.x = cvt_pk_bf16(o[0], o[1]); w.y = cvt_pk_bf16(o[2], o[3]);
                    *(u32x2*)(HB + (size_t)t * D + 4 * ln + 256 * j) = w; } } }
    }
    SEAM(6);
    if (IN(7)) {
        pg8::Gemm g{HB, D, WUP, T, UPW, D}; pg8::StaticOrder S; S.init(T, UPW, G, bx); pg8::EpiUp E5{ACT, E, fcw, fcb};
        pg8::gemm_phase<pg8::EpiUp, true>(lds, g, S, E5);
    }
    SEAM(7);
    if (IN(8)) {
        OPAQUE_LANE(ln);
        constexpr int NITEM = 128 * 2 * (DFF / 4);
        for (int it = (gw * 64 + ln); it < NITEM; it += NGW * 64) { const int c4 = it % (DFF / 4), rb = it / (DFF / 4), rr = rb & 1, blk = 4 * (rb >> 1); const int c0 = 4 * c4;
            const bool first = (blk & 31) == 0;
            const float* e0 = E + ((size_t)blk * 4 + rr) * UPW + c0;
            const float* em1 = (rr == 0) ? E + ((size_t)(blk - 1) * 4 + 3) * UPW + c0 : E + ((size_t)blk * 4 + 0) * UPW + c0;
            const float* em2 = (rr == 0) ? E + ((size_t)(blk - 1) * 4 + 2) * UPW + c0 : E + ((size_t)(blk - 1) * 4 + 3) * UPW + c0;
            const f32x4 z = {0.f, 0.f, 0.f, 0.f};
            const f32x4 g0 = *(const f32x4*)e0, v0 = *(const f32x4*)(e0 + DFF);
            const bool has1 = !(first && rr == 0), has2 = !first;
            const f32x4 g1 = has1 ? *(const f32x4*)em1 : z, v1 = has1 ? *(const f32x4*)(em1 + DFF) : z;
            const f32x4 g2 = has2 ? *(const f32x4*)em2 : z, v2 = has2 ? *(const f32x4*)(em2 + DFF) : z;
            const f32x4 wg0 = *(const f32x4*)(fcw + c0), wg1 = *(const f32x4*)(fcw + UPW + c0), wg2 = *(const f32x4*)(fcw + 2 * UPW + c0), bg = *(const f32x4*)(fcb + c0);
            const f32x4 wv0 = *(const f32x4*)(fcw + DFF + c0), wv1 = *(const f32x4*)(fcw + UPW + DFF + c0), wv2 = *(const f32x4*)(fcw + 2 * UPW + DFF + c0), bv = *(const f32x4*)(fcb + DFF + c0);
            const f32x4 cg = bg + wg0 * g2 + wg1 * g1 + wg2 * g0, cv = bv + wv0 * v2 + wv1 * v1 + wv2 * v0;
            u32x2 w; w.x = cvt_pk_bf16(silu_f(cg[0]) * cv[0], silu_f(cg[1]) * cv[1]); w.y = cvt_pk_bf16(silu_f(cg[2]) * cv[2], silu_f(cg[3]) * cv[3]);
            *(u32x2*)(ACT + (size_t)(64 * blk + rr) * DFF + c0) = w; }
    }
    SEAM(8);
    if (IN(9)) {
        pg8::Gemm g{ACT, DFF, WDN, T, D, DFF}; pg8::StaticOrder S; S.init(T, D, G, bx); S.rev = true; pg8::EpiStore E6{FF, D, true};
        pg8::gemm_phase<pg8::EpiStore, true>(lds, g, S, E6);
    }
    SEAM(9);
    if (IN(10)) {
        OPAQUE_LANE(ln);
        for (int row0 = gw * 16; row0 < T; row0 += NGW * 16) { const int b = row0 / SEQ; const float* mb = MOD + b * 6144;
            f32x4 gt[4], g2v[4], b2v[4];
#pragma unroll
            for (int j = 0; j < 4; ++j) { const int col = 4 * ln + 256 * j; gt[j] = *(const f32x4*)(mb + 5120 + col); g2v[j] = *(const f32x4*)(ln2g + col); b2v[j] = *(const f32x4*)(ln2b + col); }
            u32x2 xn[4], mn[4];
#pragma unroll
            for (int j = 0; j < 4; ++j) { const int col = 4 * ln + 256 * j; xn[j] = __builtin_nontemporal_load((const u32x2*)(X1 + (size_t)row0 * D + col)); mn[j] = __builtin_nontemporal_load((const u32x2*)(FF + (size_t)row0 * D + col)); }
            for (int rr = 0; rr < 16; ++rr) { const int t = row0 + rr;
                f32x4 v[4]; float s = 0.f; u32x2 xc[4], mc[4];
#pragma unroll
                for (int j = 0; j < 4; ++j) { xc[j] = xn[j]; mc[j] = mn[j]; }
                if (rr + 1 < 16) {
#pragma unroll
                    for (int j = 0; j < 4; ++j) { const int col = 4 * ln + 256 * j; xn[j] = __builtin_nontemporal_load((const u32x2*)(X1 + (size_t)(t + 1) * D + col)); mn[j] = __builtin_nontemporal_load((const u32x2*)(FF + (size_t)(t + 1) * D + col)); } }
#pragma unroll
                for (int j = 0; j < 4; ++j) { const u32x2 xw = xc[j]; const f32x4 xv = {bf_lo(xw.x), bf_hi(xw.x), bf_lo(xw.y), bf_hi(xw.y)}; const u32x2 mw = mc[j];
                    const f32x4 mx = {bf_lo(mw.x), bf_hi(mw.x), bf_lo(mw.y), bf_hi(mw.y)};
                    v[j] = xv * ALPHA + gt[j] * mx; s += (v[j][0] + v[j][1]) + (v[j][2] + v[j][3]); }
                const float mean = wave_sum(s) * (1.f / D); float q = 0.f;
#pragma unroll
                for (int j = 0; j < 4; ++j) { v[j] = v[j] - mean; q += (v[j][0] * v[j][0] + v[j][1] * v[j][1]) + (v[j][2] * v[j][2] + v[j][3] * v[j][3]); }
                const float rstd = rsqrtf(wave_sum(q) * (1.f / D) + 1e-5f);
#pragma unroll
                for (int j = 0; j < 4; ++j) { *(f32x4*)(out + (size_t)t * D + 4 * ln + 256 * j) = v[j] * rstd * g2v[j] + b2v[j]; } } }
    }
#undef IN
#undef SEAM
}

extern "C" void kernel_launch(void* const* d_in, const int* in_sizes, int n_in, void* d_out, int out_size, void* d_ws, size_t ws_size, hipStream_t stream) {
    static int grid = 0;
    if (grid == 0) {
        if (n_in != 22 || in_sizes[0] != T * D || out_size != T * D || ws_size < WS_END) { fprintf(stderr, "kernel_launch: unexpected shapes / workspace (n_in %d, ws %zu)\n", n_in, ws_size); grid = -1; return; }
        int dev = 0, cus = 0, per_cu = 0;
        if (hipGetDevice(&dev) != hipSuccess || hipDeviceGetAttribute(&cus, hipDeviceAttributeMultiprocessorCount, dev) != hipSuccess) { grid = -1; return; }
        if (hipFuncSetAttribute((const void*)mk_fwd, hipFuncAttributeMaxDynamicSharedMemorySize, LDS_BYTES) != hipSuccess) { fprintf(stderr, "kernel_launch: hipFuncSetAttribute failed\n"); grid = -1; return; }
        if (hipOccupancyMaxActiveBlocksPerMultiprocessor(&per_cu, (const void*)mk_fwd, 512, LDS_BYTES) != hipSuccess || per_cu < 1) { fprintf(stderr, "kernel_launch: occupancy query says %d blocks per CU\n", per_cu); (void)hipGetLastError(); grid = -1; return; }
        grid = cus;
    }
    if (grid < 0) return;
    hipMemsetAsync((char*)d_ws + WS_CTL, 0, CTL_ZERO_BYTES, stream);
    Args a{};
    for (int i = 0; i < 22; ++i) a.in[i] = (const float*)d_in[i];
    a.pos = (const int*)d_in[2]; a.out = (float*)d_out; a.ws = (unsigned char*)d_ws;
#if MK_N_LAUNCHES == 1
    a.ph_lo = 0; a.ph_hi = N_PHASES;
    hipLaunchKernelGGL(mk_fwd, dim3(grid), dim3(512), LDS_BYTES, stream, a);
#else
    for (int p = 0; p < N_PHASES; ++p) { a.ph_lo = p; a.ph_hi = p + 1; hipLaunchKernelGGL(mk_fwd, dim3(grid), dim3(512), LDS_BYTES, stream, a); }
#endif
}
```

```cpp
#include <hip/hip_runtime.h>
#include <cstdio>
#include <cstdint>

#define LAS __attribute__((address_space(3)))
#define GAS __attribute__((address_space(1)))
typedef unsigned short bf16_t;
typedef short bf16x8 __attribute__((ext_vector_type(8)));
typedef short s16x4 __attribute__((ext_vector_type(4)));
typedef float f32x4 __attribute__((ext_vector_type(4)));
typedef float f32x2 __attribute__((ext_vector_type(2)));
typedef float f32x16 __attribute__((ext_vector_type(16)));
typedef unsigned u32x4 __attribute__((ext_vector_type(4)));
typedef unsigned u32x2 __attribute__((ext_vector_type(2)));
typedef GAS unsigned gu32;

#ifndef MK_N_LAUNCHES
#define MK_N_LAUNCHES 1
#endif

constexpr int D = 1024, NB = 16, SEQ = 2048, T = NB * SEQ, NH = 8, DFF = 2816, UPW = 2 * DFF;
constexpr int PW = 1024;
constexpr int G1N = 2048;
constexpr int QW = 768, INW = 1952;
constexpr float ALPHA = 1.189207115002721f;
constexpr float QSCALE = 0.10206207261596575f * 1.4426950408889634f;
constexpr float LOG2E = 1.4426950408889634f;

constexpr size_t MiB = 1u << 20;
constexpr size_t WS_CTL = 0, CTL_ZERO_BYTES = 64 * 1024;
constexpr size_t WS_MOD = 1 * MiB;
constexpr size_t WS_ROPE = 2 * MiB;
constexpr size_t WS_SSQQ = 6 * MiB;
constexpr size_t WS_SSQKV = 6 * MiB + 512 * 1024;
constexpr size_t WS_WIN = 8 * MiB;
constexpr size_t WS_WQ = 12 * MiB;
constexpr size_t WS_WKV = 12 * MiB + 512 * 1024;
constexpr size_t WS_WOUT = 13 * MiB;
constexpr size_t WS_WUP = 15 * MiB;
constexpr size_t WS_WDN = 26 * MiB;
constexpr size_t WS_HB = 32 * MiB;
constexpr size_t WS_FF = 32 * MiB;
constexpr size_t WS_P = 96 * MiB;
constexpr size_t WS_U = 160 * MiB;
constexpr size_t WS_MIX = 402 * MiB;
constexpr size_t WS_Q = 224 * MiB;
constexpr size_t WS_KN = 272 * MiB;
constexpr size_t WS_KR = 304 * MiB;
constexpr size_t WS_V = 306 * MiB;
constexpr size_t WS_Y = 338 * MiB;
constexpr size_t WS_X1 = 338 * MiB;
constexpr size_t WS_ACT = 96 * MiB;
constexpr size_t WS_E = 272 * MiB;
constexpr size_t WS_END = 466 * MiB;
constexpr int CW_BAR = 1024;

constexpr int RING_BYTES = 131072, LDSCTL_OFF = RING_BYTES, MISC_OFF = LDSCTL_OFF + 320, LDS_BYTES = 147456;

__device__ __forceinline__ unsigned cvt_pk_bf16(float lo, float hi) { unsigned r; asm volatile("v_cvt_pk_bf16_f32 %0, %1, %2" : "=v"(r) : "v"(lo), "v"(hi)); return r; }
__device__ __forceinline__ float bf_lo(unsigned u) { return __uint_as_float(u << 16); }
__device__ __forceinline__ float bf_hi(unsigned u) { return __uint_as_float(u & 0xffff0000u); }
__device__ __forceinline__ float fexp2(float x) { return __builtin_amdgcn_exp2f(x); }
__device__ __forceinline__ float frcp(float x) { return __builtin_amdgcn_rcpf(x); }
__device__ __forceinline__ float silu_f(float v) { return v * frcp(1.f + fexp2(-LOG2E * v)); }
__device__ __forceinline__ float wave_sum(float v) {
#pragma unroll
    for (int o = 1; o < 64; o <<= 1) v += __shfl_xor(v, o);
    return v;
}

namespace pg8 {
constexpr int BM = 256, BK = 64, HALF = 128, HTB = HALF * BK * 2, STAGE_BYTES = 8 * HTB, NXCD = 8, WGM = 4;
__host__ __device__ __forceinline__ int lds_byte(int r, int c) { const int st = (r >> 4) * 2 + (c >> 5), rr = r & 15, cc = c & 31, ob = rr * 64 + cc * 2; return st * 1024 + (ob ^ (((ob >> 9) & 1) << 5)); }
__host__ __device__ __forceinline__ void stage_rc(int b, int& R, int& C) { const int st = b / 1024, sb = b % 1024, swz = sb ^ (((sb >> 9) & 1) << 5); R = (st >> 1) * 16 + swz / 64; C = (st & 1) * 32 + (swz % 64) / 2; }
__host__ __device__ __forceinline__ int perm32(int rho) { const int n = rho >> 4, i = rho & 15; return 8 * (i >> 2) + 4 * n + (i & 3); }

struct Unit { int pm, pn; };
struct Gemm { const bf16_t* A; int lda; const bf16_t* Bt; int M, N, K; };

struct StaticOrder {
    int nM, nN, nwg, G, c, i0, i1;
    __device__ __forceinline__ void init(int M, int N, int G_, int c_) { nM = M / BM; nN = N / BM; nwg = nM * nN; G = G_; c = c_; i0 = 0; i1 = 1 << 20; }
    __device__ __forceinline__ bool next(int i, Unit& u) const {
        const int ii = i + i0; if (ii >= i1) return false;
        const long L = (long)ii * G + c; if (L >= nwg) return false;
        int wgid = (int)L; { const int q = nwg / NXCD, r = nwg % NXCD, xcd = wgid % NXCD, off = wgid / NXCD; wgid = (xcd < r ? xcd * (q + 1) : r * (q + 1) + (xcd - r) * q) + off; }
        const int nig = WGM * nN, gid = wgid / nig, fm = gid * WGM, gsz = (nM - fm) < WGM ? (nM - fm) : WGM;
        u.pm = fm + ((wgid % nig) % gsz); u.pn = (wgid % nig) / gsz; return true;
    }
};

template <class Epi, bool ALIGN_EPI>
__device__ __forceinline__ void gemm_phase(LAS unsigned char* lds, const Gemm g, const StaticOrder& S, const Epi& E) {
    int tid = threadIdx.x; asm volatile("" : "+v"(tid));
    const int wid = __builtin_amdgcn_readfirstlane(tid >> 6), lane = tid & 63, wr = wid >> 2, wc = wid & 3, fr = lane & 15, fq = lane >> 4;
    const int K = g.K, nt = K / BK;
    unsigned voffA[2], voffB[2];
#pragma unroll
    for (int i = 0; i < 2; ++i) { int R, C; stage_rc(tid * 16 + i * 8192, R, C);
        voffA[i] = (unsigned)(R * g.lda + C) * 2u; voffB[i] = (unsigned)(R * K + C) * 2u; }
    const size_t kstep = (size_t)(BK * 2);
    const size_t hstepA = (size_t)HALF * g.lda * 2, hstepB = (size_t)HALF * K * 2;
    const size_t tstepA = 2 * hstepA, tstepB = 2 * hstepB;
    const unsigned ldsw = (unsigned)wid * 1024u;
    const int aoff = lds_byte(wr * 64 + fr, fq * 8), boff = lds_byte(wc * 32 + fr, fq * 8);
#define PG8_SA(b, h) (((b) * 2 + (h)) * HTB)
#define PG8_SB(b, h) ((4 + (b) * 2 + (h)) * HTB)
#define PG8_STAGE(bufoff, gbase, voff) do { _Pragma("unroll") for (int _i = 0; _i < 2; ++_i) \
        __builtin_amdgcn_global_load_lds((const unsigned*)((const char*)(gbase) + (voff)[_i]), (LAS unsigned*)(lds + (bufoff) + ldsw + _i * 8192), 16, 0, 0); } while (0)
#define PG8_LDA(dst, b, h) do { _Pragma("unroll") for (int m = 0; m < 4; ++m) _Pragma("unroll") for (int k = 0; k < 2; ++k) dst[m][k] = *(const LAS bf16x8*)(lds + PG8_SA(b, h) + aoff + m * 2048 + k * 1024); } while (0)
#define PG8_LDB(dst, b, h) do { _Pragma("unroll") for (int n = 0; n < 2; ++n) _Pragma("unroll") for (int k = 0; k < 2; ++k) dst[n][k] = *(const LAS bf16x8*)(lds + PG8_SB(b, h) + boff + n * 2048 + k * 1024); } while (0)
#define PG8_MMA(ai, bj, At, Bt) do { __builtin_amdgcn_s_setprio(1); _Pragma("unroll") for (int m = 0; m < 4; ++m) _Pragma("unroll") for (int n = 0; n < 2; ++n) _Pragma("unroll") for (int k = 0; k < 2; ++k) \
        acc[ai][bj][m][n] = __builtin_amdgcn_mfma_f32_16x16x32_bf16(Bt[n][k], At[m][k], acc[ai][bj][m][n], 0, 0, 0); __builtin_amdgcn_s_setprio(0); } while (0)
#define PG8_WAIT_V(n) asm volatile("s_waitcnt vmcnt(" #n ")" ::: "memory")
#define PG8_WAIT_L(n) asm volatile("s_waitcnt lgkmcnt(" #n ")" ::: "memory")
#define PG8_BAR __builtin_amdgcn_s_barrier()
#define PG8_SCHED __builtin_amdgcn_sched_barrier(0)
    Unit cur, nxt; int ui = 0;
    if (!S.next(0, cur)) return;
    f32x4 acc[2][2][4][2];
#pragma unroll
    for (int a = 0; a < 2; ++a)
#pragma unroll
        for (int b = 0; b < 2; ++b)
#pragma unroll
            for (int m = 0; m < 4; ++m)
#pragma unroll
                for (int n = 0; n < 2; ++n) acc[a][b][m][n] = (f32x4){0.f, 0.f, 0.f, 0.f};
    bf16x8 At[4][2], B0[2][2], B1[2][2];
    const char* cA = (const char*)g.A + (size_t)cur.pm * tstepA; const char* cB = (const char*)g.Bt + (size_t)cur.pn * tstepB;
    if constexpr (Epi::HAS_PREFETCH) E.prefetch(cur, 0, lds, wid, lane);
    PG8_STAGE(PG8_SB(0, 0), cB, voffB); PG8_STAGE(PG8_SB(0, 1), cB + hstepB, voffB); PG8_STAGE(PG8_SA(0, 0), cA, voffA); PG8_STAGE(PG8_SA(0, 1), cA + hstepA, voffA);
    if (wr == 1) PG8_BAR;
    PG8_WAIT_V(2); PG8_BAR;
    PG8_STAGE(PG8_SB(1, 0), cB + kstep, voffB); PG8_STAGE(PG8_SA(1, 0), cA + kstep, voffA); PG8_STAGE(PG8_SB(1, 1), cB + hstepB + kstep, voffB);
    PG8_WAIT_V(6); PG8_BAR;
    for (;;) {
        const bool has_next = S.next(ui + 1, nxt);
        const char* nA = has_next ? (const char*)g.A + (size_t)nxt.pm * tstepA : cA; const char* nB = has_next ? (const char*)g.Bt + (size_t)nxt.pn * tstepB : cB;
#pragma nounroll
        for (int t = 0; t < nt; t += 2) {
            const bool last = (t == nt - 2);
            const char* a1 = cA + (size_t)(t + 1) * kstep;
            const char* a2 = last ? nA : cA + (size_t)(t + 2) * kstep; const char* b2 = last ? nB : cB + (size_t)(t + 2) * kstep;
            const char* a3 = a2 + kstep; const char* b3 = b2 + kstep;
            const bool rlx = (Epi::NST > 0) && (t == 0) && (ui > 0);
            PG8_LDB(B0, 0, 0); PG8_LDB(B1, 0, 1); PG8_SCHED; PG8_LDA(At, 0, 0); PG8_STAGE(PG8_SA(1, 1), a1 + hstepA, voffA);
            if (rlx) { if constexpr (Epi::NST >= 16) PG8_WAIT_V(24); else PG8_WAIT_V(16); } else PG8_WAIT_V(8);
            PG8_WAIT_L(0); PG8_BAR; PG8_MMA(0, 0, At, B0); PG8_MMA(0, 1, At, B1); PG8_BAR; PG8_SCHED;
            PG8_LDA(At, 0, 1); PG8_STAGE(PG8_SB(0, 0), b2, voffB); PG8_STAGE(PG8_SB(0, 1), b2 + hstepB, voffB); PG8_STAGE(PG8_SA(0, 0), a2, voffA);
            if (rlx) { if constexpr (Epi::NST >= 16) PG8_WAIT_V(24); else PG8_WAIT_V(16); } else PG8_WAIT_V(8);
            PG8_WAIT_L(0); PG8_BAR; PG8_MMA(1, 0, At, B0); PG8_MMA(1, 1, At, B1); PG8_BAR; PG8_SCHED;
            PG8_LDB(B0, 1, 0); PG8_LDB(B1, 1, 1); PG8_SCHED; PG8_LDA(At, 1, 0); PG8_STAGE(PG8_SA(0, 1), a2 + hstepA, voffA);
            PG8_WAIT_V(8); PG8_WAIT_L(0); PG8_BAR; PG8_MMA(0, 0, At, B0); PG8_MMA(0, 1, At, B1); PG8_BAR; PG8_SCHED;
            PG8_LDA(At, 1, 1); PG8_STAGE(PG8_SB(1, 0), b3, voffB); PG8_STAGE(PG8_SB(1, 1), b3 + hstepB, voffB); PG8_STAGE(PG8_SA(1, 0), a3, voffA);
            PG8_WAIT_V(8); PG8_WAIT_L(0); PG8_BAR; PG8_MMA(1, 0, At, B0); PG8_MMA(1, 1, At, B1); PG8_BAR; PG8_SCHED;
        }
        if constexpr (Epi::HAS_PREFETCH) { int t_x = threadIdx.x; asm volatile("" : "+v"(t_x));
            E.xch_write(acc, wr, wc, t_x & 15, (t_x >> 4) & 3, lds); asm volatile("s_waitcnt lgkmcnt(0)\n\ts_barrier" ::: "memory"); }
        if constexpr (ALIGN_EPI) { if (wr == 0) PG8_BAR; }
        { int t_e = threadIdx.x; asm volatile("" : "+v"(t_e)); const int fr_e = t_e & 15, fq_e = (t_e >> 4) & 3;
          if constexpr (Epi::HAS_PREFETCH) { if (has_next) E.prefetch(nxt, (ui + 1) & 1, lds, wid, t_e & 63); E.run(acc, cur, wr, wc, fr_e, fq_e, lds, ui & 1); }
          else E(acc, cur, wr, wc, fr_e, fq_e); }
        if (!has_next) break;
#pragma unroll
        for (int a = 0; a < 2; ++a)
#pragma unroll
            for (int b = 0; b < 2; ++b)
#pragma unroll
                for (int m = 0; m < 4; ++m)
#pragma unroll
                    for (int n = 0; n < 2; ++n) acc[a][b][m][n] = (f32x4){0.f, 0.f, 0.f, 0.f};
        cur = nxt; cA = nA; cB = nB; ++ui;
        if constexpr (ALIGN_EPI) { if (wr == 1) PG8_BAR; }
    }
    PG8_WAIT_V(0);
    if constexpr (!ALIGN_EPI) { if (wr == 0) PG8_BAR; }
    PG8_BAR;
#undef PG8_SA
#undef PG8_SB
#undef PG8_STAGE
#undef PG8_LDA
#undef PG8_LDB
#undef PG8_MMA
#undef PG8_WAIT_V
#undef PG8_WAIT_L
#undef PG8_BAR
#undef PG8_SCHED
}

struct MUnit { const char* A; const char* B; int nt; unsigned kb2; int type; Unit u; };
template <class Sched, class Disp>
__device__ __forceinline__ void gemm_multi(LAS unsigned char* lds, const Sched& S, const Disp& E) {
    int tid = threadIdx.x; asm volatile("" : "+v"(tid));
    const int wid = __builtin_amdgcn_readfirstlane(tid >> 6), lane = tid & 63, wr = wid >> 2, wc = wid & 3, fr = lane & 15, fq = lane >> 4;
    unsigned voffA[2], rB[2], cB2[2];
#pragma unroll
    for (int i = 0; i < 2; ++i) { int R, C; stage_rc(tid * 16 + i * 8192, R, C); voffA[i] = (unsigned)(R * 1024 + C) * 2u; rB[i] = (unsigned)R; cB2[i] = (unsigned)C * 2u; }
    const size_t kstep = (size_t)(BK * 2);
    const size_t hstepA = (size_t)HALF * 1024 * 2;
    const unsigned ldsw = (unsigned)wid * 1024u;
    const int aoff = lds_byte(wr * 64 + fr, fq * 8), boff = lds_byte(wc * 32 + fr, fq * 8);
#define PG8_SA(b, h) (((b) * 2 + (h)) * HTB)
#define PG8_SB(b, h) ((4 + (b) * 2 + (h)) * HTB)
#define PG8_STAGE(bufoff, gbase, voff) do { _Pragma("unroll") for (int _i = 0; _i < 2; ++_i) \
        __builtin_amdgcn_global_load_lds((const unsigned*)((const char*)(gbase) + (voff)[_i]), (LAS unsigned*)(lds + (bufoff) + ldsw + _i * 8192), 16, 0, 0); } while (0)
#define PG8_LDA(dst, b, h) do { _Pragma("unroll") for (int m = 0; m < 4; ++m) _Pragma("unroll") for (int k = 0; k < 2; ++k) dst[m][k] = *(const LAS bf16x8*)(lds + PG8_SA(b, h) + aoff + m * 2048 + k * 1024); } while (0)
#define PG8_LDB(dst, b, h) do { _Pragma("unroll") for (int n = 0; n < 2; ++n) _Pragma("unroll") for (int k = 0; k < 2; ++k) dst[n][k] = *(const LAS bf16x8*)(lds + PG8_SB(b, h) + boff + n * 2048 + k * 1024); } while (0)
#define PG8_MMA(ai, bj, At, Bt) do { __builtin_amdgcn_s_setprio(1); _Pragma("unroll") for (int m = 0; m < 4; ++m) _Pragma("unroll") for (int n = 0; n < 2; ++n) _Pragma("unroll") for (int k = 0; k < 2; ++k) \
        acc[ai][bj][m][n] = __builtin_amdgcn_mfma_f32_16x16x32_bf16(Bt[n][k], At[m][k], acc[ai][bj][m][n], 0, 0, 0); __builtin_amdgcn_s_setprio(0); } while (0)
#define PG8_WAIT_V(n) asm volatile("s_waitcnt vmcnt(" #n ")" ::: "memory")
#define PG8_WAIT_L(n) asm volatile("s_waitcnt lgkmcnt(" #n ")" ::: "memory")
#define PG8_BAR __builtin_amdgcn_s_barrier()
#define PG8_SCHED __builtin_amdgcn_sched_barrier(0)
    MUnit cur, nxt; int ui = 0; int relax = 0;
    if (!S.next(0, cur)) return;
    f32x4 acc[2][2][4][2];
#pragma unroll
    for (int a = 0; a < 2; ++a)
#pragma unroll
        for (int b = 0; b < 2; ++b)
#pragma unroll
            for (int m = 0; m < 4; ++m)
#pragma unroll
                for (int n = 0; n < 2; ++n) acc[a][b][m][n] = (f32x4){0.f, 0.f, 0.f, 0.f};
    bf16x8 At[4][2], B0[2][2], B1[2][2];
    const char* cA = cur.A; const char* cB = cur.B;
    E.prefetch(cur, 0, lds, wid, lane);
    unsigned voffB[2]; voffB[0] = rB[0] * cur.kb2 + cB2[0]; voffB[1] = rB[1] * cur.kb2 + cB2[1];
    size_t hstepB = (size_t)HALF * cur.kb2;
    PG8_STAGE(PG8_SB(0, 0), cB, voffB); PG8_STAGE(PG8_SB(0, 1), cB + hstepB, voffB); PG8_STAGE(PG8_SA(0, 0), cA, voffA); PG8_STAGE(PG8_SA(0, 1), cA + hstepA, voffA);
    if (wr == 1) PG8_BAR;
    PG8_WAIT_V(2); PG8_BAR;
    PG8_STAGE(PG8_SB(1, 0), cB + kstep, voffB); PG8_STAGE(PG8_SA(1, 0), cA + kstep, voffA); PG8_STAGE(PG8_SB(1, 1), cB + hstepB + kstep, voffB);
    PG8_WAIT_V(6); PG8_BAR;
    for (;;) {
        const bool has_next = S.next(ui + 1, nxt);
        if (!has_next) nxt = cur;
        const char* nA = nxt.A; const char* nB = nxt.B;
        unsigned nvoffB[2]; nvoffB[0] = rB[0] * nxt.kb2 + cB2[0]; nvoffB[1] = rB[1] * nxt.kb2 + cB2[1];
        const size_t nhstepB = (size_t)HALF * nxt.kb2;
        const int nt = cur.nt;
#pragma nounroll
        for (int t = 0; t < nt; t += 2) {
            const bool last = (t == nt - 2);
            const char* a1 = cA + (size_t)(t + 1) * kstep;
            const char* a2 = last ? nA : cA + (size_t)(t + 2) * kstep; const char* b2 = last ? nB : cB + (size_t)(t + 2) * kstep;
            const char* a3 = a2 + kstep; const char* b3 = b2 + kstep;
            unsigned vB2[2]; vB2[0] = last ? nvoffB[0] : voffB[0]; vB2[1] = last ? nvoffB[1] : voffB[1];
            const size_t hB2 = last ? nhstepB : hstepB;
            const int rlx = (t == 0) ? relax : 0;
            PG8_LDB(B0, 0, 0); PG8_LDB(B1, 0, 1); PG8_SCHED; PG8_LDA(At, 0, 0); PG8_STAGE(PG8_SA(1, 1), a1 + hstepA, voffA);
            if (rlx >= 16) PG8_WAIT_V(24); else if (rlx >= 8) PG8_WAIT_V(16); else PG8_WAIT_V(8);
            PG8_WAIT_L(0); PG8_BAR; PG8_MMA(0, 0, At, B0); PG8_MMA(0, 1, At, B1); PG8_BAR; PG8_SCHED;
            PG8_LDA(At, 0, 1); PG8_STAGE(PG8_SB(0, 0), b2, vB2); PG8_STAGE(PG8_SB(0, 1), b2 + hB2, vB2); PG8_STAGE(PG8_SA(0, 0), a2, voffA);
            if (rlx >= 16) PG8_WAIT_V(24); else if (rlx >= 8) PG8_WAIT_V(16); else PG8_WAIT_V(8);
            PG8_WAIT_L(0); PG8_BAR; PG8_MMA(1, 0, At, B0); PG8_MMA(1, 1, At, B1); PG8_BAR; PG8_SCHED;
            PG8_LDB(B0, 1, 0); PG8_LDB(B1, 1, 1); PG8_SCHED; PG8_LDA(At, 1, 0); PG8_STAGE(PG8_SA(0, 1), a2 + hstepA, voffA);
            PG8_WAIT_V(8); PG8_WAIT_L(0); PG8_BAR; PG8_MMA(0, 0, At, B0); PG8_MMA(0, 1, At, B1); PG8_BAR; PG8_SCHED;
            PG8_LDA(At, 1, 1); PG8_STAGE(PG8_SB(1, 0), b3, vB2); PG8_STAGE(PG8_SB(1, 1), b3 + hB2, vB2); PG8_STAGE(PG8_SA(1, 0), a3, voffA);
            PG8_WAIT_V(8); PG8_WAIT_L(0); PG8_BAR; PG8_MMA(1, 0, At, B0); PG8_MMA(1, 1, At, B1); PG8_BAR; PG8_SCHED;
        }
        if (wr == 0) PG8_BAR;
        { int t_e = threadIdx.x; asm volatile("" : "+v"(t_e)); if (has_next) E.prefetch(nxt, (ui + 1) & 1, lds, wid, t_e & 63); E(acc, cur, wr, wc, t_e & 15, (t_e >> 4) & 3, lds, ui & 1); }
        if (!has_next) break;
#pragma unroll
        for (int a = 0; a < 2; ++a)
#pragma unroll
            for (int b = 0; b < 2; ++b)
#pragma unroll
                for (int m = 0; m < 4; ++m)
#pragma unroll
                    for (int n = 0; n < 2; ++n) acc[a][b][m][n] = (f32x4){0.f, 0.f, 0.f, 0.f};
        relax = (cur.type == 0 && cur.u.pn >= 4) ? 8 : 16;
        cur = nxt; cA = nA; cB = nB; voffB[0] = nvoffB[0]; voffB[1] = nvoffB[1]; hstepB = nhstepB; ++ui;
        if (wr == 1) PG8_BAR;
    }
    PG8_WAIT_V(0);
    PG8_BAR;
#undef PG8_SA
#undef PG8_SB
#undef PG8_STAGE
#undef PG8_LDA
#undef PG8_LDB
#undef PG8_MMA
#undef PG8_WAIT_V
#undef PG8_WAIT_L
#undef PG8_BAR
#undef PG8_SCHED
}

typedef f32x4 Acc[2][2][4][2];

struct EpiStore { static constexpr bool HAS_PREFETCH = false; static constexpr int NST = 16;
    bf16_t* O; int ldc; bool nt = false;
    __device__ __forceinline__ void operator()(const Acc& acc, const Unit& u, int wr, int wc, int fr, int fq) const {
        const int row0 = u.pm * BM + wr * 64 + fr, col0 = u.pn * BM + wc * 32 + 8 * fq;
#pragma unroll
        for (int ai = 0; ai < 2; ++ai)
#pragma unroll
            for (int m = 0; m < 4; ++m) { bf16_t* rowp = O + (size_t)(row0 + ai * HALF + m * 16) * ldc + col0;
#pragma unroll
                for (int bj = 0; bj < 2; ++bj) { const f32x4 v0 = acc[ai][bj][m][0], v1 = acc[ai][bj][m][1];
                    u32x4 w; w.x = cvt_pk_bf16(v0[0], v0[1]); w.y = cvt_pk_bf16(v0[2], v0[3]); w.z = cvt_pk_bf16(v1[0], v1[1]); w.w = cvt_pk_bf16(v1[2], v1[3]);
                    if (nt) __builtin_nontemporal_store(w, (u32x4*)(rowp + bj * HALF)); else *(u32x4*)(rowp + bj * HALF) = w; } }
    }
};

struct EpiP { static constexpr bool HAS_PREFETCH = false, AFTER_DRAIN = false; static constexpr int NST = 8;
    bf16_t* O; bf16_t* U; float* ssq_q; float* ssq_kv;
    __device__ __forceinline__ void operator()(const Acc& acc, const Unit& u, int wr, int wc, int fr, int fq) const {
        const int row0 = u.pm * BM + wr * 64 + fr;
        if (u.pn >= 4) {
            bf16_t* ucol = U + 128 * (u.pn - 4) + 32 * wc + 8 * fq;
#pragma unroll
            for (int ai = 0; ai < 2; ++ai)
#pragma unroll
                for (int m = 0; m < 4; ++m) { const f32x4 v0 = acc[ai][0][m][0] * acc[ai][1][m][0], v1 = acc[ai][0][m][1] * acc[ai][1][m][1];
                    u32x4 w; w.x = cvt_pk_bf16(v0[0], v0[1]); w.y = cvt_pk_bf16(v0[2], v0[3]); w.z = cvt_pk_bf16(v1[0], v1[1]); w.w = cvt_pk_bf16(v1[2], v1[3]);
                    *(u32x4*)(ucol + (size_t)(row0 + ai * HALF + m * 16) * 512) = w; }
            return;
        }
        EpiStore st{O, PW}; st(acc, u, wr, wc, fr, fq);
        if (u.pn <= 1) {
            float* dst = (u.pn == 0) ? ssq_q : ssq_kv;
#pragma unroll
            for (int ai = 0; ai < 2; ++ai)
#pragma unroll
                for (int m = 0; m < 4; ++m) { float s = 0.f;
#pragma unroll
                    for (int n = 0; n < 2; ++n) { const f32x4 a = acc[ai][0][m][n]; s += (a[0] * a[0] + a[1] * a[1]) + (a[2] * a[2] + a[3] * a[3]); }
                    if (u.pn == 0) {
#pragma unroll
                        for (int n = 0; n < 2; ++n) { const f32x4 a = acc[ai][1][m][n]; s += (a[0] * a[0] + a[1] * a[1]) + (a[2] * a[2] + a[3] * a[3]); } }
                    s += __shfl_xor(s, 16); s += __shfl_xor(s, 32);
                    if (fq == 0) dst[(size_t)(row0 + ai * HALF + m * 16) * 4 + wc] = s; }
        }
    }
};

constexpr int SSQ_LDS = RING_BYTES + 1024;
struct EpiKV { static constexpr bool HAS_PREFETCH = false, AFTER_DRAIN = false; static constexpr int NST = 16;
    bf16_t* KN; bf16_t* V;
    __device__ __forceinline__ void operator()(const Acc& acc, const Unit& u, int wr, int wc, int fr, int fq, LAS unsigned char* lds, int buf) const {
        const int b = u.pm >> 3;
        const LAS f32x4* sq = (const LAS f32x4*)(lds + SSQ_LDS + buf * 4096) + wr * 64 + fr;
        float f[2][4];
#pragma unroll
        for (int ai = 0; ai < 2; ++ai)
#pragma unroll
            for (int m = 0; m < 4; ++m) { const f32x4 sp = sq[ai * HALF + m * 16]; f[ai][m] = rsqrtf(((sp[0] + sp[1]) + (sp[2] + sp[3])) * (1.f / 128.f) + 1e-6f); }
#pragma unroll
        for (int bj = 0; bj < 2; ++bj) { const int g = 8 * u.pn + 4 * bj + wc, head = g >> 2, part = g & 3;
            char* base = (part < 2) ? (char*)KN + (4 * part + fq) * 1024 + fr * 16 : (char*)V + (part - 2) * 4096 + fr * 64 + fq * 16;
            const int mstep = (part < 2) ? 256 : 1024;
            base += (size_t)(b * 8 + head) * 32 * 8192;
#pragma unroll
            for (int ai = 0; ai < 2; ++ai) { const int tile = (4 * u.pm + 2 * ai + wr) & 31;
#pragma unroll
                for (int m = 0; m < 4; ++m) {
                    const f32x4 v0 = acc[ai][bj][m][0] * f[ai][m], v1 = acc[ai][bj][m][1] * f[ai][m];
                    u32x4 w; w.x = cvt_pk_bf16(v0[0], v0[1]); w.y = cvt_pk_bf16(v0[2], v0[3]); w.z = cvt_pk_bf16(v1[0], v1[1]); w.w = cvt_pk_bf16(v1[2], v1[3]);
                    __builtin_nontemporal_store(w, (u32x4*)(base + (size_t)tile * 8192 + m * mstep)); } } }
    }
};

struct MixedOrder {
    const char* HB; const char* P; const char* WIN; const char* WQ; const char* WKV; int G, c;
    __device__ __forceinline__ void set_long(int li, MUnit& m) const { const int w = (li % NXCD) * 96 + li / NXCD, pm = w / 6, pn = 2 + w % 6;
        m.A = HB + (size_t)pm * (256 * 1024 * 2); m.B = WIN + (size_t)pn * (256 * 1024 * 2); m.nt = 16; m.kb2 = 2048u; m.type = 0; m.u.pm = pm; m.u.pn = pn; }
    __device__ __forceinline__ void set_short(int si, MUnit& m) const { const int sl = si / NXCD, pm = 16 * (si % NXCD) + sl / 7, kind = sl % 7;
        if (kind < 3) { const int pn = kind; m.A = P + (size_t)pm * (256 * 1024 * 2); m.B = WQ + (size_t)pn * (256 * 256 * 2); m.nt = 4; m.kb2 = 512u; m.type = 1; m.u.pm = pm; m.u.pn = pn; }
        else { const int pn = kind - 3; m.A = P + 512 + (size_t)pm * (256 * 1024 * 2); m.B = WKV + (size_t)pn * (256 * 256 * 2); m.nt = 4; m.kb2 = 512u; m.type = 2; m.u.pm = pm; m.u.pn = pn; } }
    __device__ __forceinline__ bool next(int i, MUnit& m) const {
        const bool clsA = (c >> 3) < 16; const int idx = clsA ? c : c - 128;
        const unsigned pat = clsA ? 0xDDu : 0x04u;
        if (i >= (clsA ? 8 : 5)) return false;
        const int nsb = __builtin_popcount(pat & ((1u << i) - 1u)), nlb = i - nsb;
        if ((pat >> i) & 1u) set_short(clsA ? nsb * 128 + idx : 768 + idx, m); else set_long(clsA ? 512 + nlb * 128 + idx : nlb * 128 + idx, m);
        return true;
    }
};
struct EpiMix { EpiP p; EpiStore q; EpiKV kv; const float* ssqkv;
    __device__ __forceinline__ void prefetch(const MUnit& m, int buf, LAS unsigned char* lds, int wid, int lane) const {
        if (m.type == 2 && wid < 4) __builtin_amdgcn_global_load_lds((const unsigned*)(ssqkv + (size_t)m.u.pm * 1024 + wid * 256 + lane * 4), (LAS unsigned*)(lds + SSQ_LDS + buf * 4096 + wid * 1024), 16, 0, 0);
    }
    __device__ __forceinline__ void operator()(const Acc& acc, const MUnit& m, int wr, int wc, int fr, int fq, LAS unsigned char* lds, int buf) const {
        if (m.type == 0) p(acc, m.u, wr, wc, fr, fq); else if (m.type == 1) q(acc, m.u, wr, wc, fr, fq); else kv(acc, m.u, wr, wc, fr, fq, lds, buf);
    }
};

template <int CTRL> __device__ __forceinline__ float dppf(float v) { return __builtin_bit_cast(float, __builtin_amdgcn_update_dpp(0, __builtin_bit_cast(int, v), CTRL, 0xf, 0xf, true)); }
template <int CTRL> __device__ __forceinline__ f32x4 dpp4(f32x4 v) { f32x4 r; r[0] = dppf<CTRL>(v[0]); r[1] = dppf<CTRL>(v[1]); r[2] = dppf<CTRL>(v[2]); r[3] = dppf<CTRL>(v[3]); return r; }

#define PG8_FD(c_, x_, w_, ctl_) "v_fmac_f32_dpp " c_ ", " x_ ", " w_ " " ctl_ " row_mask:0xf bank_mask:0xf bound_ctrl:1\n\t"
#define PG8_TAPS(NAME, CA, CB) __device__ __forceinline__ void NAME(f32x4& c, const f32x4& x, const f32x4& w1, const f32x4& w0) { \
    float c0 = c[0], c1 = c[1], c2 = c[2], c3 = c[3]; \
    asm("s_nop 1\n\t" PG8_FD("%0", "%4", "%8", CA) PG8_FD("%1", "%5", "%9", CA) PG8_FD("%2", "%6", "%10", CA) PG8_FD("%3", "%7", "%11", CA) \
        PG8_FD("%0", "%4", "%12", CB) PG8_FD("%1", "%5", "%13", CB) PG8_FD("%2", "%6", "%14", CB) PG8_FD("%3", "%7", "%15", CB) \
        : "+v"(c0), "+v"(c1), "+v"(c2), "+v"(c3) : "v"(x[0]), "v"(x[1]), "v"(x[2]), "v"(x[3]), "v"(w1[0]), "v"(w1[1]), "v"(w1[2]), "v"(w1[3]), "v"(w0[0]), "v"(w0[1]), "v"(w0[2]), "v"(w0[3])); \
    c[0] = c0; c[1] = c1; c[2] = c2; c[3] = c3; }
PG8_TAPS(taps_cur, "row_shr:1", "row_shr:2")
PG8_TAPS(taps_prev, "row_shl:15", "row_shl:14")
constexpr int XCH_LDS = RING_BYTES + 1024 + 8192;
static_assert(XCH_LDS + 6144 <= LDS_BYTES, "XCH");
constexpr int CW_LDS = RING_BYTES + 1024;
struct EpiUp { static constexpr bool HAS_PREFETCH = true; static constexpr int NST = 0;
    bf16_t* ACT; float* E; const float* cw; const float* cb;
    __device__ __forceinline__ void prefetch(const Unit& u, int buf, LAS unsigned char* lds, int wid, int lane) const {
        if (wid < 4) { const float* base = (wid < 3) ? cw + (size_t)wid * UPW : cb;
            const float* src = base + 128 * u.pn + ((lane & 32) ? DFF : 0) + 4 * (lane & 31);
            __builtin_amdgcn_global_load_lds((const unsigned*)src, (LAS unsigned*)(lds + CW_LDS + buf * 4096 + wid * 1024), 16, 0, 0); }
    }
    __device__ __forceinline__ void xch_write(const Acc& acc, int wr, int wc, int fr, int fq, LAS unsigned char* lds) const {
        if (fr >= 14) { LAS float* x = (LAS float*)(lds + XCH_LDS) + (fr - 14) * 256 + 32 * wc + 8 * fq;
#pragma unroll
            for (int ai = 0; ai < 2; ++ai) { const int bi = 2 * ai + wr;
                if (bi < 3) {
#pragma unroll
                    for (int s = 0; s < 2; ++s)
#pragma unroll
                        for (int n = 0; n < 2; ++n) *(LAS f32x4*)(x + bi * 512 + s * 128 + 4 * n) = acc[ai][s][3][n]; } } }
    }
    __device__ __forceinline__ void run(const Acc& acc, const Unit& u, int wr, int wc, int fr, int fq, LAS unsigned char* lds, int buf) const {
        const int cl = 32 * wc + 8 * fq;
        const int cbase = 128 * u.pn + cl;
        const LAS float* wl = (const LAS float*)(lds + CW_LDS + buf * 4096) + cl;
        const LAS float* xr = (const LAS float*)(lds + XCH_LDS) + ((fr - 14) & 1) * 256 + cl;
        u32x2 res0[2][4];
#pragma unroll
        for (int n = 0; n < 2; ++n) { const int c0 = cbase + 4 * n;
            const f32x4 wg0 = *(const LAS f32x4*)(wl + 4 * n), wg1 = *(const LAS f32x4*)(wl + 256 + 4 * n), wg2 = *(const LAS f32x4*)(wl + 512 + 4 * n), bg = *(const LAS f32x4*)(wl + 768 + 4 * n);
            const f32x4 wv0 = *(const LAS f32x4*)(wl + 128 + 4 * n), wv1 = *(const LAS f32x4*)(wl + 384 + 4 * n), wv2 = *(const LAS f32x4*)(wl + 640 + 4 * n), bv = *(const LAS f32x4*)(wl + 896 + 4 * n);
#pragma unroll
            for (int ai = 0; ai < 2; ++ai) { f32x4 gprev = {0.f, 0.f, 0.f, 0.f}, vprev = gprev;
                const int bi = 2 * ai + wr, blk = 4 * u.pm + bi;
                const bool top = (ai == 0) && (wr == 0);
                if (!top && fr >= 14) { gprev = *(const LAS f32x4*)(xr + (bi - 1) * 512 + 4 * n); vprev = *(const LAS f32x4*)(xr + (bi - 1) * 512 + 128 + 4 * n); }
#pragma unroll
                for (int m = 0; m < 4; ++m) { const f32x4 gcur = acc[ai][0][m][n], vcur = acc[ai][1][m][n];
                    f32x4 cg = bg + wg2 * gcur, cv = bv + wv2 * vcur;
                    taps_cur(cg, gcur, wg1, wg0); taps_cur(cv, vcur, wv1, wv0);
                    if (m > 0 || !top) { taps_prev(cg, gprev, wg1, wg0); taps_prev(cv, vprev, wv1, wv0); }
                    f32x4 a; a[0] = silu_f(cg[0]) * cv[0]; a[1] = silu_f(cg[1]) * cv[1]; a[2] = silu_f(cg[2]) * cv[2]; a[3] = silu_f(cg[3]) * cv[3];
                    u32x2 w; w.x = cvt_pk_bf16(a[0], a[1]); w.y = cvt_pk_bf16(a[2], a[3]);
                    const int t = u.pm * BM + ai * HALF + wr * 64 + m * 16 + fr;
                    if (n == 0) res0[ai][m] = w;
                    else if (!(m == 0 && top && fr < 2)) { u32x4 o; o.x = res0[ai][m].x; o.y = res0[ai][m].y; o.z = w.x; o.w = w.y; __builtin_nontemporal_store(o, (u32x4*)(ACT + (size_t)t * DFF + cbase)); }
                    if (m == 0 && top && fr < 2) { float* e = E + ((size_t)blk * 4 + fr) * UPW + c0; *(f32x4*)e = gcur; *(f32x4*)(e + DFF) = vcur; }
                    if (m == 3 && bi == 3 && fr >= 14) { float* e = E + ((size_t)blk * 4 + 2 + (fr - 14)) * UPW + c0; *(f32x4*)e = gcur; *(f32x4*)(e + DFF) = vcur; }
                    gprev = gcur; vprev = vcur; } } }
    }
};
}

namespace att {
constexpr int NSLOT = 3, K_OFF = 0, KSLOT = 12288, V_OFF = NSLOT * KSLOT, VSLOT = 8192, WS_OFF = V_OFF + NSLOT * VSLOT, OST_OFF = WS_OFF + 8 * 256, LDS_END = OST_OFF + 8 * 8192;
static_assert(LDS_END <= RING_BYTES, "attention LDS");
__device__ __forceinline__ int crow(int r, int hi) { return (r & 3) + 8 * (r >> 2) + 4 * hi; }
typedef short v4i16_t __attribute__((ext_vector_type(4)));
__device__ __forceinline__ s16x4 vtr(const LAS unsigned char* p) { return __builtin_bit_cast(s16x4, __builtin_amdgcn_ds_read_tr16_b64_v4i16((LAS v4i16_t*)p)); }
__device__ __forceinline__ void glds(const char* src, LAS unsigned char* dst) { unsigned keep; const unsigned d = (unsigned)__builtin_amdgcn_readfirstlane((int)(unsigned)(uintptr_t)dst);
    asm volatile("s_mov_b32 %0, m0\n\ts_mov_b32 m0, %2\n\ts_nop 0\n\tglobal_load_lds_dwordx4 %1, off\n\ts_mov_b32 m0, %0" : "=&s"(keep) : "v"(src), "s"(d) : "memory"); }
__device__ __forceinline__ float max3f(float a, float b, float c) { float r; asm("v_max3_f32 %0, %1, %2, %3" : "=v"(r) : "v"(a), "v"(b), "v"(c)); return r; }
__device__ __forceinline__ float max2f(float a, float b) { float r; asm("v_max_f32_e32 %0, %1, %2" : "=v"(r) : "v"(a), "v"(b)); return r; }
__device__ __forceinline__ float fadd_s(float a, float b) { float r = a + b; asm volatile("" : "+v"(r)); return r; }
typedef float f32x2_t __attribute__((ext_vector_type(2))); typedef __bf16 bf16x2_t __attribute__((ext_vector_type(2)));
__device__ __forceinline__ unsigned cvtpk_m(float lo, float hi) { f32x2_t v = {lo, hi}; bf16x2_t b2 = __builtin_convertvector(v, bf16x2_t); return __builtin_bit_cast(unsigned, b2); }
__device__ __forceinline__ float xmax32(float v) { float a = v, b = v; asm("s_nop 1\n\tv_permlane32_swap_b32 %0, %1\n\ts_nop 1\n\tv_max_f32_e32 %0, %0, %1" : "+v"(a), "+v"(b)); return a; }
constexpr float THRL = 4.0f;

struct AUnit { int b, h, qb; };
__device__ __forceinline__ bool unit_of(int k, int vcu, int G, AUnit& u) {
    const int it = vcu + (k >> 2) * G, r = k & 3; if (it >= 256) return false;
    const int grp = it >> 3, i8 = it & 7, bh = grp * 4 + r; u.b = bh >> 3; u.h = bh & 7;
    u.qb = (r == 0) ? 7 - i8 : (r == 1) ? i8 : (r == 2) ? 7 - (i8 ^ 1) : (i8 ^ 1); return true;
}
__device__ __forceinline__ void attn_phase(int vcu, int G, const float* ssqq, const float* rope, const bf16_t* Q, const bf16_t* KN, const bf16_t* KR, const bf16_t* V, bf16_t* Y, const float* ong, LAS unsigned char* lds) {
    int tid = threadIdx.x; asm volatile("" : "+v"(tid));
    const int lane = tid & 63, r32 = lane & 31, hi = lane >> 5; const int wid = __builtin_amdgcn_readfirstlane(tid >> 6);
    const int lo16 = wid * 1024 + lane * 16;
    LAS float* wsf = (LAS float*)(lds + WS_OFF + wid * 256);
    const int kl = hi * 1024 + r32 * 16, vl = ((lane >> 4) & 1) * 32 + (lane & 3) * 8 + (4 * hi + ((lane & 15) >> 2)) * 64;
#define ATT_ISSUE(U, tile, slot) do { const size_t bh_ = (size_t)((U).b * 8 + (U).h); \
        glds((const char*)KN + (bh_ * 32 + (tile)) * 8192 + lo16, lds + K_OFF + (slot) * KSLOT + wid * 1024); glds((const char*)V + (bh_ * 32 + (tile)) * 8192 + lo16, lds + V_OFF + (slot) * VSLOT + wid * 1024); \
        if (wid < 4) glds((const char*)KR + ((size_t)(U).b * 32 + (tile)) * 4096 + lo16, lds + K_OFF + (slot) * KSLOT + 8192 + wid * 1024); } while (0)
#define ATT_QLOAD(dst, aux, U) do { const size_t row_ = (size_t)((U).b * SEQ + 256 * (U).qb + 32 * wid + r32); const bf16_t* qp_ = Q + row_ * QW + 96 * (U).h + 8 * hi; \
        _Pragma("unroll") for (int ks = 0; ks < 6; ++ks) dst[ks] = *(const bf16x8*)(qp_ + 16 * ks); \
        aux[0] = *(const f32x4*)(ssqq + row_ * 4); aux[1] = *(const f32x4*)(rope + row_ * 32 + 8 * hi); aux[2] = *(const f32x4*)(rope + row_ * 32 + 8 * hi + 4); \
        aux[3] = *(const f32x4*)(rope + row_ * 32 + 16 + 8 * hi); aux[4] = *(const f32x4*)(rope + row_ * 32 + 16 + 8 * hi + 4); } while (0)
#define ATT_QFIX(q, aux) do { const float f_ = rsqrtf(((aux[0][0] + aux[0][1]) + (aux[0][2] + aux[0][3])) * (1.f / 256.f) + 1e-6f) * QSCALE; \
        _Pragma("unroll") for (int ks = 0; ks < 4; ++ks) { const u32x4 w_ = __builtin_bit_cast(u32x4, q[ks]); u32x4 o_; \
            _Pragma("unroll") for (int e = 0; e < 4; ++e) o_[e] = cvtpk_m(bf_lo(w_[e]) * f_, bf_hi(w_[e]) * f_); q[ks] = __builtin_bit_cast(bf16x8, o_); } \
        { const u32x4 a_ = __builtin_bit_cast(u32x4, q[4]), b_ = __builtin_bit_cast(u32x4, q[5]); u32x4 oa_, ob_; \
          _Pragma("unroll") for (int e = 0; e < 4; ++e) { const float x1l = bf_lo(a_[e]), x1h = bf_hi(a_[e]), x2l = bf_lo(b_[e]), x2h = bf_hi(b_[e]); \
              const float cl = (e < 2) ? aux[1][2 * e] : aux[2][2 * e - 4], ch = (e < 2) ? aux[1][2 * e + 1] : aux[2][2 * e - 3], sl = (e < 2) ? aux[3][2 * e] : aux[4][2 * e - 4], sh = (e < 2) ? aux[3][2 * e + 1] : aux[4][2 * e - 3]; \
              oa_[e] = cvtpk_m((x1l * cl - x2l * sl) * f_, (x1h * ch - x2h * sh) * f_); ob_[e] = cvtpk_m((x2l * cl + x1l * sl) * f_, (x2h * ch + x1h * sh) * f_); } \
          q[4] = __builtin_bit_cast(bf16x8, oa_); q[5] = __builtin_bit_cast(bf16x8, ob_); } } while (0)
    AUnit cur, nxt;
    if (!unit_of(0, vcu, G, cur)) return;
    bf16x8 qr[6], qn[6]; f32x4 qa[5], qna[5];
    ATT_QLOAD(qr, qa, cur);
    ATT_QFIX(qr, qa);
    asm volatile("" : "+v"(qr[0]), "+v"(qr[1]), "+v"(qr[2]), "+v"(qr[3]), "+v"(qr[4]), "+v"(qr[5]));
    ATT_ISSUE(cur, 0, 0); ATT_ISSUE(cur, 1, 1);
    int slot = 0;
    for (int k = 0;; ++k) {
        const bool has_next = unit_of(k + 1, vcu, G, nxt);
        const int NT = 4 * cur.qb + 4, jmax = 4 * cur.qb + (wid >> 1);
        float mrun = 0.f, lrun = 0.f; f32x16 o[2]; o[0] = f32x16{}; o[1] = f32x16{}; f32x16 negm = f32x16{};
        for (int j = 0; j < NT; ++j) {
            if (j == 0 && k > 0) { if (wid < 4) asm volatile("s_waitcnt vmcnt(13) lgkmcnt(0)\n\ts_barrier" ::: "memory"); else asm volatile("s_waitcnt vmcnt(12) lgkmcnt(0)\n\ts_barrier" ::: "memory"); }
            else if (j + 1 < NT || has_next) { if (wid < 4) asm volatile("s_waitcnt vmcnt(3) lgkmcnt(0)\n\ts_barrier" ::: "memory"); else asm volatile("s_waitcnt vmcnt(2) lgkmcnt(0)\n\ts_barrier" ::: "memory"); }
            else asm volatile("s_waitcnt vmcnt(0) lgkmcnt(0)\n\ts_barrier" ::: "memory");
            { const int s2 = (slot == 0) ? 2 : slot - 1;
              if (j + 2 < NT) ATT_ISSUE(cur, j + 2, s2); else if (has_next) ATT_ISSUE(nxt, j + 2 - NT, s2); }
            if (j == NT - 1 && has_next) ATT_QLOAD(qn, qna, nxt);
            if (j <= jmax) {
                const LAS unsigned char* kp = lds + K_OFF + slot * KSLOT + kl;
                f32x16 p0, p1;
#pragma unroll
                for (int ks = 0; ks < 6; ++ks) { const bf16x8 k0 = *(const LAS bf16x8*)(kp + ks * 2048), k1 = *(const LAS bf16x8*)(kp + ks * 2048 + 512);
                    if (ks == 0) { p0 = __builtin_amdgcn_mfma_f32_32x32x16_bf16(k0, qr[0], negm, 0, 0, 0); p1 = __builtin_amdgcn_mfma_f32_32x32x16_bf16(k1, qr[0], negm, 0, 0, 0); }
                    else { p0 = __builtin_amdgcn_mfma_f32_32x32x16_bf16(k0, qr[ks], p0, 0, 0, 0); p1 = __builtin_amdgcn_mfma_f32_32x32x16_bf16(k1, qr[ks], p1, 0, 0, 0); } }
                const LAS unsigned char* vp = lds + V_OFF + slot * VSLOT + vl;
                s16x4 vlo[4], vhi[4];
#pragma unroll
                for (int ks = 0; ks < 4; ++ks) { vlo[ks] = vtr(vp + ks * 1024); vhi[ks] = vtr(vp + ks * 1024 + 512); }
                asm volatile("s_nop 15\n\ts_nop 7" : "+v"(p0), "+v"(p1) : : "memory");
                float rm;
                { float a = max3f(p0[0], p0[1], p1[0]), c = max3f(p0[2], p0[3], p1[1]); a = max3f(a, p1[2], p1[3]);
#pragma unroll
                  for (int r = 4; r < 16; r += 4) { a = max3f(a, p0[r], p0[r + 1]); c = max3f(c, p0[r + 2], p0[r + 3]); a = max3f(a, p1[r], p1[r + 1]); c = max3f(c, p1[r + 2], p1[r + 3]); }
                  rm = max2f(a, c); rm = xmax32(rm); }
                if (j == 0 || __any(rm > THRL)) {
                    const float dl = (j == 0) ? rm : fmaxf(rm, 0.f);
                    mrun += dl;
#pragma unroll
                    for (int r = 0; r < 16; ++r) { p0[r] -= dl; p1[r] -= dl; }
#pragma unroll
                    for (int r = 0; r < 16; ++r) negm[r] = -mrun;
                    if (j != 0) { const float alpha = fexp2(-dl); lrun *= alpha;
                        if (hi == 0) wsf[r32] = alpha;
#pragma unroll
                        for (int r = 0; r < 16; ++r) { const float a_ = wsf[crow(r, hi)]; o[0][r] *= a_; o[1][r] *= a_; } }
                }
#pragma unroll
                for (int r = 0; r < 16; ++r) { p0[r] = fexp2(p0[r]); p1[r] = fexp2(p1[r]); }
                { f32x2_t sa = f32x2_t{p0[0], p0[1]} + f32x2_t{p0[2], p0[3]}, sb = f32x2_t{p1[0], p1[1]} + f32x2_t{p1[2], p1[3]};
#pragma unroll
                  for (int r = 4; r < 16; r += 2) { sa += f32x2_t{p0[r], p0[r + 1]}; sb += f32x2_t{p1[r], p1[r + 1]}; }
                  sa += sb; lrun += sa[0] + sa[1]; }
                bf16x8 pa[4];
                { u32x4 w0, w1, w2, w3;
                  w0.x = cvtpk_m(p0[0], p0[1]); w0.y = cvtpk_m(p0[2], p0[3]); w0.z = cvtpk_m(p0[4], p0[5]); w0.w = cvtpk_m(p0[6], p0[7]);
                  w1.x = cvtpk_m(p0[8], p0[9]); w1.y = cvtpk_m(p0[10], p0[11]); w1.z = cvtpk_m(p0[12], p0[13]); w1.w = cvtpk_m(p0[14], p0[15]);
                  w2.x = cvtpk_m(p1[0], p1[1]); w2.y = cvtpk_m(p1[2], p1[3]); w2.z = cvtpk_m(p1[4], p1[5]); w2.w = cvtpk_m(p1[6], p1[7]);
                  w3.x = cvtpk_m(p1[8], p1[9]); w3.y = cvtpk_m(p1[10], p1[11]); w3.z = cvtpk_m(p1[12], p1[13]); w3.w = cvtpk_m(p1[14], p1[15]);
                  pa[0] = __builtin_bit_cast(bf16x8, w0); pa[1] = __builtin_bit_cast(bf16x8, w1); pa[2] = __builtin_bit_cast(bf16x8, w2); pa[3] = __builtin_bit_cast(bf16x8, w3); }
                s16x4 wlo[4], whi[4];
#pragma unroll
                for (int ks = 0; ks < 4; ++ks) { wlo[ks] = vtr(vp + 4096 + ks * 1024); whi[ks] = vtr(vp + 4096 + ks * 1024 + 512); }
                asm volatile("" ::: "memory");
#pragma unroll
                for (int ks = 0; ks < 4; ++ks) { const bf16x8 vf = {vlo[ks][0], vlo[ks][1], vlo[ks][2], vlo[ks][3], vhi[ks][0], vhi[ks][1], vhi[ks][2], vhi[ks][3]};
                    o[0] = __builtin_amdgcn_mfma_f32_32x32x16_bf16(pa[ks], vf, o[0], 0, 0, 0); }
#pragma unroll
                for (int ks = 0; ks < 4; ++ks) { const bf16x8 vf = {wlo[ks][0], wlo[ks][1], wlo[ks][2], wlo[ks][3], whi[ks][0], whi[ks][1], whi[ks][2], whi[ks][3]};
                    o[1] = __builtin_amdgcn_mfma_f32_32x32x16_bf16(pa[ks], vf, o[1], 0, 0, 0); }
            }
            slot = (slot == 2) ? 0 : slot + 1;
        }
        { const float lt = lrun + __shfl_xor(lrun, 32);
          if (hi == 0) wsf[r32] = frcp(lt);
          LAS float* stg = (LAS float*)(lds + OST_OFF + wid * 8192);
#pragma unroll
          for (int r = 0; r < 16; ++r) { const float inv = wsf[crow(r, hi)]; const int orow = crow(r, hi); stg[orow * 64 + r32] = o[0][r] * inv; stg[orow * 64 + 32 + r32] = o[1][r] * inv; }
          asm volatile("s_waitcnt lgkmcnt(0)" ::: "memory");
          const int ch = lane & 7;
          const f32x4 ga = *(const f32x4*)(ong + 64 * cur.h + 8 * ch), gb = *(const f32x4*)(ong + 64 * cur.h + 8 * ch + 4);
          bf16_t* Yw = Y + (size_t)(cur.b * SEQ + 256 * cur.qb + 32 * wid) * D + 64 * cur.h + 8 * ch;
#pragma unroll
          for (int i = 0; i < 4; ++i) { const int row = i * 8 + (lane >> 3);
              const f32x4 va = *(const LAS f32x4*)(stg + row * 64 + 8 * ch), vb = *(const LAS f32x4*)(stg + row * 64 + 8 * ch + 4);
              float ss = (va[0] * va[0] + va[1] * va[1]) + (va[2] * va[2] + va[3] * va[3]) + (vb[0] * vb[0] + vb[1] * vb[1]) + (vb[2] * vb[2] + vb[3] * vb[3]);
              ss += pg8::dppf<0xB1>(ss); ss += pg8::dppf<0x4E>(ss); ss += pg8::dppf<0x141>(ss);
              const float rs = rsqrtf(ss * (1.f / 64.f) + 1e-6f);
              const f32x4 oa = va * rs * ga, ob = vb * rs * gb;
              u32x4 w; w.x = cvtpk_m(oa[0], oa[1]); w.y = cvtpk_m(oa[2], oa[3]); w.z = cvtpk_m(ob[0], ob[1]); w.w = cvtpk_m(ob[2], ob[3]);
              *(u32x4*)(Yw + (size_t)row * D) = w; } }
        if (!has_next) break;
        cur = nxt;
#pragma unroll
        for (int ks = 0; ks < 6; ++ks) qr[ks] = qn[ks];
        ATT_QFIX(qr, qna);
    }
    asm volatile("s_waitcnt vmcnt(0) lgkmcnt(0)\n\ts_barrier" ::: "memory");
#undef ATT_ISSUE
#undef ATT_QLOAD
#undef ATT_QFIX
}
}

#define XB_TMO      128
#define XB_XCNT(j)  (256  + 64 * (j))
#define XB_XSUB(j)  (1280 + 64 * (j))
#define XB_XGEN(j)  (2304 + 64 * (j))
#define XB_TOP      3328
#define XB_TOPGEN   3392
#define XCD_BAR_WORDS 3456
#define XB_SPIN_CAP (1u << 18)
__device__ __forceinline__ unsigned xb_ld(unsigned* p)              { return __hip_atomic_load(p, __ATOMIC_RELAXED, __HIP_MEMORY_SCOPE_AGENT); }
__device__ __forceinline__ unsigned xb_add(unsigned* p, unsigned v) { return __hip_atomic_fetch_add(p, v, __ATOMIC_RELAXED, __HIP_MEMORY_SCOPE_AGENT); }
__device__ __forceinline__ unsigned xb_xcc_id() { return (unsigned)__builtin_amdgcn_s_getreg((3 << 11) | 20) & 0xFu; }
#define XB_SPIN(cond, bar) do { unsigned _sp = 0; while (cond) { __builtin_amdgcn_s_sleep(1); \
    if ((++_sp & 255u) == 0u) { if (xb_ld(&(bar)[XB_TMO])) break; if (_sp > XB_SPIN_CAP) { atomicAdd(&(bar)[XB_TMO], 1u); break; } } } } while (0)
struct XcdBarrier { unsigned* bar; unsigned x; volatile LAS unsigned* st; };
__device__ __forceinline__ XcdBarrier xcd_barrier_post(unsigned* bar, volatile LAS unsigned* st) {
    XcdBarrier b; b.bar = bar; b.x = xb_xcc_id(); b.st = st;
    if (threadIdx.x == 0) st[3] = xb_add(&bar[XB_XCNT(b.x)], 1u);
    return b;
}
#define XB_XDONE(j) (3456 + 64 * (j))
__device__ __forceinline__ void xcd_barrier_complete(unsigned* bar, unsigned x, unsigned& nloc, unsigned& nx, unsigned& mask) {
    const unsigned G = gridDim.x * gridDim.y * gridDim.z;
    unsigned sum, cnt, mine, mk, sp = 0u;
    for (;;) {
        sum = 0u; cnt = 0u; mine = 0u; mk = 0u;
#pragma unroll
        for (unsigned j = 0; j < 16; ++j) { const unsigned c = xb_ld(&bar[XB_XCNT(j)]); sum += c; cnt += (c > 0u) ? 1u : 0u; mk |= (c > 0u) ? (1u << j) : 0u; mine = (j == x) ? c : mine; }
        if (sum == G) break;
        __builtin_amdgcn_s_sleep(1);
        if ((++sp & 255u) == 0u) { if (xb_ld(&bar[XB_TMO])) break; if (sp > XB_SPIN_CAP) { atomicAdd(&bar[XB_TMO], 1u); break; } }
    }
    nloc = mine > 0u ? mine : 1u; nx = cnt > 0u ? cnt : 1u; mask = mk;
}
#define XB_GCNT(j) (2304 + 64 * (j))
#define XB_GGEN(j) (2304 + 64 * (j) + 32)
__device__ __forceinline__ void xcd_barrier(const XcdBarrier& b, const bool wb = true) {
    asm volatile("s_waitcnt vmcnt(0)" ::: "memory");
    __syncthreads();
    if (threadIdx.x < 64) {
        unsigned* bar = b.bar; const unsigned lane = threadIdx.x;
        __builtin_amdgcn_s_waitcnt(0);
        unsigned nloc = b.st[0], mask = b.st[2];
        if (nloc == 0u) { unsigned nx; xcd_barrier_complete(bar, b.x, nloc, nx, mask); if (lane == 0u) { b.st[0] = nloc; b.st[1] = nx; b.st[2] = mask; b.st[5] = (nx == 8u && mask == 0xffu && nloc * 8u == gridDim.x && gridDim.x == 256u) ? 1u : 0u; } }
        unsigned old = 0u; if (lane == 0u) old = xb_add(&bar[XB_XSUB(b.x)], 1u);
        old = (unsigned)__builtin_amdgcn_readfirstlane((int)old);
        const unsigned tgt = old / nloc + 1u;
        if (old + 1u == tgt * nloc) {
            if (wb) __builtin_amdgcn_fence(__ATOMIC_RELEASE, "agent");
            asm volatile("s_waitcnt vmcnt(0)" ::: "memory");
            if (lane == 0u) __hip_atomic_store(&bar[XB_XDONE(b.x)], tgt, __ATOMIC_RELAXED, __HIP_MEMORY_SCOPE_AGENT);
        }
        __builtin_amdgcn_fence(__ATOMIC_ACQUIRE, "agent");
        { unsigned sp = 0u; const bool mine = lane < 16u && ((mask >> lane) & 1u);
          for (;;) { const unsigned v = mine ? xb_ld(&bar[XB_XDONE(lane)]) : tgt;
              if (__all((int)(v >= tgt))) break;
              __builtin_amdgcn_s_sleep(1);
              if ((++sp & 255u) == 0u) { if (xb_ld(&bar[XB_TMO])) break; if (sp > XB_SPIN_CAP) { if (lane == 0u) atomicAdd(&bar[XB_TMO], 1u); break; } } } }
        asm volatile("s_waitcnt vmcnt(0)" ::: "memory");
    }
    __syncthreads();
}

#define XB_GALL 3328
__device__ __forceinline__ void group_barrier(const XcdBarrier& b, bool post_all, unsigned wait_all) {
    asm volatile("s_waitcnt vmcnt(0)" ::: "memory");
    __syncthreads();
    if (threadIdx.x < 64) {
        unsigned* bar = b.bar; const unsigned lane = threadIdx.x;
        __builtin_amdgcn_s_waitcnt(0);
        const unsigned nloc = b.st[0];
        unsigned old = 0u; if (lane == 0u) old = xb_add(&bar[XB_GCNT(b.x)], 1u);
        old = (unsigned)__builtin_amdgcn_readfirstlane((int)old);
        const unsigned tgt = old / nloc + 1u;
        if (old + 1u == tgt * nloc) {
            if (post_all) { __builtin_amdgcn_fence(__ATOMIC_RELEASE, "agent"); asm volatile("s_waitcnt vmcnt(0)" ::: "memory"); }
            if (lane == 0u) { __hip_atomic_store(&bar[XB_GGEN(b.x)], tgt, __ATOMIC_RELAXED, __HIP_MEMORY_SCOPE_AGENT); if (post_all) (void)xb_add(&bar[XB_GALL], 1u); }
        }
        __builtin_amdgcn_fence(__ATOMIC_ACQUIRE, "agent");
        { unsigned sp = 0u;
          for (;;) { const unsigned v = xb_ld(&bar[XB_GGEN(b.x)]); const unsigned va = wait_all ? xb_ld(&bar[XB_GALL]) : 0u;
              if (v >= tgt && va >= wait_all) break;
              __builtin_amdgcn_s_sleep(1);
              if ((++sp & 255u) == 0u) { if (xb_ld(&bar[XB_TMO])) break; if (sp > XB_SPIN_CAP) { if (lane == 0u) atomicAdd(&bar[XB_TMO], 1u); break; } } } }
        asm volatile("s_waitcnt vmcnt(0)" ::: "memory");
    }
    __syncthreads();
}

#define XB_PAIR(pm) (4000 + (pm))
__device__ __forceinline__ void pair_barrier(const XcdBarrier& b, int pm) {
    asm volatile("s_waitcnt vmcnt(0)" ::: "memory");
    __syncthreads();
    if (threadIdx.x < 64) {
        unsigned* bar = b.bar; const unsigned lane = threadIdx.x;
        if (lane == 0u) (void)xb_add(&bar[XB_PAIR(pm)], 1u);
        __builtin_amdgcn_fence(__ATOMIC_ACQUIRE, "agent");
        { unsigned sp = 0u;
          for (;;) { const unsigned v = xb_ld(&bar[XB_PAIR(pm)]);
              if (v >= 2u) break;
              __builtin_amdgcn_s_sleep(1);
              if ((++sp & 255u) == 0u) { if (xb_ld(&bar[XB_TMO])) break; if (sp > XB_SPIN_CAP) { if (lane == 0u) atomicAdd(&bar[XB_TMO], 1u); break; } } } }
        asm volatile("s_waitcnt vmcnt(0)" ::: "memory");
    }
    __syncthreads();
}

constexpr int GCTL_WORDS = 4608, GCTL_FIN = 4544;
__device__ unsigned g_ctl[GCTL_WORDS];
struct Args { const float* in[22]; const int* pos; float* out; unsigned char* ws; int ph_lo, ph_hi; };
__constant__ float c_invfreq[16] = {1.0f, 0.5623413251903491f, 0.31622776601683794f, 0.1778279410038923f, 0.1f, 0.05623413251903491f, 0.03162277660168379f, 0.01778279410038923f,
                                    0.01f, 0.005623413251903491f, 0.0031622776601683794f, 0.001778279410038923f, 0.001f, 0.0005623413251903491f, 0.00031622776601683794f, 0.0001778279410038923f};

__device__ __forceinline__ int colmap(int which, int s) {
    const int p = (s & ~31) + pg8::perm32(s & 31);
    switch (which) {
        case 0: { if (s < 1024) return p < 416 ? p : (p < 512 ? -1 : p - 96);
                  const int bj = (s >> 7) & 1, ch = 128 * ((s >> 8) - 4) + 32 * ((s >> 5) & 3) + pg8::perm32(s & 31); return (bj ? 1440 : 928) + ch; }
        case 4: { const int pn = s >> 8, bj = (s >> 7) & 1, wc = (s >> 5) & 3; return bj * DFF + 128 * pn + 32 * wc + pg8::perm32(s & 31); }
        default: return p;
    }
}
__device__ __forceinline__ void p0_transpose_item(const float* W, int ldw, int Ksrc, const float* kscale, bf16_t* WT, int Kdst, int which, LAS float* scr, int item, int nblk, int lane) {
    const int kb = item / nblk, nb = item % nblk, k0 = 64 * kb, s0 = 32 * nb;
    const int cm = colmap(which, s0 + (lane & 31));
    float tv[32];
#pragma unroll
    for (int i = 0; i < 32; ++i) { const int k = k0 + 2 * i + (lane >> 5); tv[i] = (cm >= 0 && k < Ksrc) ? __builtin_nontemporal_load(W + (size_t)k * ldw + cm) : 0.f; }
    if (kscale) {
#pragma unroll
        for (int i = 0; i < 32; ++i) { const int k = k0 + 2 * i + (lane >> 5); if (k < Ksrc) tv[i] *= kscale[k]; } }
#pragma unroll
    for (int i = 0; i < 32; ++i) scr[(2 * i + (lane >> 5)) * 33 + (lane & 31)] = tv[i];
    asm volatile("s_waitcnt lgkmcnt(0)" ::: "memory");
    const int c = lane & 7;
#pragma unroll
    for (int j = 0; j < 4; ++j) { const int n = (lane >> 3) + 8 * j; const LAS float* s = scr + (8 * c) * 33 + n;
        u32x4 o; o.x = cvt_pk_bf16(s[0 * 33], s[1 * 33]); o.y = cvt_pk_bf16(s[2 * 33], s[3 * 33]); o.z = cvt_pk_bf16(s[4 * 33], s[5 * 33]); o.w = cvt_pk_bf16(s[6 * 33], s[7 * 33]);
        asm volatile("global_store_dwordx4 %0, %1, off sc0 sc1" : : "v"(WT + (size_t)(s0 + n) * Kdst + k0 + 8 * c), "v"(o) : "memory"); }
    asm volatile("s_waitcnt lgkmcnt(0)" ::: "memory");
}

__device__ __forceinline__ void st_wt(float* p, float v) { asm volatile("global_store_dword %0, %1, off sc0 sc1" : : "v"(p), "v"(v) : "memory"); }

constexpr int N_PHASES = 11;
#define OPAQUE_LANE(name) int name##_t = (int)threadIdx.x; asm volatile("" : "+v"(name##_t)); const int name = name##_t & 63

__global__ void __launch_bounds__(512, 2) mk_fwd(Args args) {
    extern __shared__ __attribute__((aligned(16))) unsigned char lds_raw[];
    LAS unsigned char* lds = (LAS unsigned char*)lds_raw;
    volatile LAS unsigned* MISC = (volatile LAS unsigned*)(lds + MISC_OFF);
    const int tid = threadIdx.x, lane = tid & 63, wave = __builtin_amdgcn_readfirstlane(tid >> 6);
    const int G = gridDim.x; const int bx = blockIdx.x; const int vcu = (G % 8 == 0) ? (bx % 8) * (G / 8) + bx / 8 : bx;
    const int gw = vcu * 8 + wave, NGW = G * 8;
    unsigned char* ws = args.ws;
    const float* x = args.in[0]; const float* cvec = args.in[1]; const int* pos = args.pos;
    const float* w_ada = args.in[3]; const float* b_ada = args.in[4]; const float* w_in = args.in[5];
    const float* qg = args.in[6]; const float* w_qup = args.in[7]; const float* kvg = args.in[8]; const float* w_kvup = args.in[9];
    const float* conv_w = args.in[10]; const float* conv_b = args.in[11]; const float* ong = args.in[12]; const float* w_out = args.in[13];
    const float* ln1g = args.in[14]; const float* ln1b = args.in[15]; const float* w_up = args.in[16];
    const float* fcw = args.in[17]; const float* fcb = args.in[18]; const float* w_down = args.in[19];
    const float* ln2g = args.in[20]; const float* ln2b = args.in[21];
    float* out = args.out;
    float* MOD = (float*)(ws + WS_MOD); float* ROPE = (float*)(ws + WS_ROPE); float* SSQQ = (float*)(ws + WS_SSQQ); float* SSQKV = (float*)(ws + WS_SSQKV);
    bf16_t* WIN = (bf16_t*)(ws + WS_WIN); bf16_t* WQ = (bf16_t*)(ws + WS_WQ); bf16_t* WKV = (bf16_t*)(ws + WS_WKV); bf16_t* WOUT = (bf16_t*)(ws + WS_WOUT);
    bf16_t* WUP = (bf16_t*)(ws + WS_WUP); bf16_t* WDN = (bf16_t*)(ws + WS_WDN);
    bf16_t* HB = (bf16_t*)(ws + WS_HB); bf16_t* FF = (bf16_t*)(ws + WS_FF); bf16_t* P = (bf16_t*)(ws + WS_P); bf16_t* MIX = (bf16_t*)(ws + WS_MIX);
    bf16_t* U = (bf16_t*)(ws + WS_U); bf16_t* Qb = (bf16_t*)(ws + WS_Q); bf16_t* KN = (bf16_t*)(ws + WS_KN); bf16_t* KR = (bf16_t*)(ws + WS_KR); bf16_t* Vb = (bf16_t*)(ws + WS_V);
    bf16_t* Y = (bf16_t*)(ws + WS_Y); bf16_t* X1 = (bf16_t*)(ws + WS_X1); bf16_t* ACT = (bf16_t*)(ws + WS_ACT); float* E = (float*)(ws + WS_E);

    for (int u = tid; u < (LDS_BYTES - LDSCTL_OFF) / 4; u += 512) ((LAS unsigned*)(lds + LDSCTL_OFF))[u] = 0u;
    __syncthreads();
    XcdBarrier bar; bar.bar = g_ctl; bar.x = 0; bar.st = nullptr;
    if (MK_N_LAUNCHES == 1) bar = xcd_barrier_post(g_ctl, MISC + 8);
    const int lo = args.ph_lo, hi = args.ph_hi;
#ifndef PH_MASK
#define PH_MASK 0x7ff
#endif
#define IN(k) (((PH_MASK >> (k)) & 1) && lo <= (k) && (k) < hi)
#define SEAM(k) do { if (IN(k) && IN((k) + 1)) xcd_barrier(bar); } while (0)

    auto weight_copies = [&](const int ln) __attribute__((always_inline)) {
        LAS float* scr = (LAS float*)(lds + wave * 16384);
        constexpr int I0 = 16 * 64, I1 = 4 * 24, I2 = 4 * 32, I3 = 16 * 32, I4 = 16 * 176, I5 = 44 * 32, NIT = I0 + I1 + I2 + I3 + I4 + I5;
        for (int it = gw; it < NIT; it += NGW) {
            int r = it;
            if (r < I0) { p0_transpose_item(w_in, INW, D, nullptr, WIN, D, 0, scr, r, 64, ln); continue; } r -= I0;
            if (r < I1) { p0_transpose_item(w_qup, QW, 256, qg, WQ, 256, 1, scr, r, 24, ln); continue; } r -= I1;
            if (r < I2) { p0_transpose_item(w_kvup, 1024, 128, kvg, WKV, 256, 2, scr, r, 32, ln); continue; } r -= I2;
            if (r < I3) { p0_transpose_item(w_out, D, D, nullptr, WOUT, D, 3, scr, r, 32, ln); continue; } r -= I3;
            if (r < I4) { p0_transpose_item(w_up, UPW, D, nullptr, WUP, D, 4, scr, r, 176, ln); continue; } r -= I4;
            p0_transpose_item(w_down, D, DFF, nullptr, WDN, DFF, 5, scr, r, 32, ln);
        }
    };
    f32x4 xpre[4] = {f32x4{0.f, 0.f, 0.f, 0.f}, f32x4{0.f, 0.f, 0.f, 0.f}, f32x4{0.f, 0.f, 0.f, 0.f}, f32x4{0.f, 0.f, 0.f, 0.f}};
    auto prefetch_x = [&](const int ln) __attribute__((always_inline)) {
        pg8::StaticOrder S2; S2.init(T, 512, G, (int)(MISC[11] * 8u + bar.x)); pg8::Unit u0; const bool ok = S2.next(0, u0);
        const int gwS16 = 256 * u0.pm + 128 * u0.pn + 16 * wave;
        if (MK_N_LAUNCHES == 1 && G == 256 && ok) {
#pragma unroll
            for (int j = 0; j < 4; ++j) xpre[j] = __builtin_nontemporal_load((const f32x4*)(x + (size_t)gwS16 * D + 4 * ln + 256 * j)); }
    };
    if (IN(0)) {
        OPAQUE_LANE(ln);
        if (bx < 192) {
            LAS float* part = (LAS float*)lds;
            const int n0 = 32 * bx, j = ln & 15, kk = ln >> 4, kb = 128 * wave + 32 * kk;
            f32x2 bw[32]; f32x4 a4[8];
#pragma unroll
            for (int s = 0; s < 32; ++s) bw[s] = __builtin_nontemporal_load((const f32x2*)(w_ada + (size_t)(kb + s) * 6144 + n0 + 2 * j));
#pragma unroll
            for (int u = 0; u < 8; ++u) a4[u] = *(const f32x4*)(cvec + j * 1024 + kb + 4 * u);
            asm volatile("" ::: "memory");
            weight_copies(ln);
            __syncthreads();
            prefetch_x(ln);
            f32x4 c0 = {0.f, 0.f, 0.f, 0.f}, c1 = c0;
#pragma unroll
            for (int s = 0; s < 32; ++s) { const float v = a4[s >> 2][s & 3], sa = v * frcp(1.f + fexp2(-LOG2E * v));
                c0 = __builtin_amdgcn_mfma_f32_16x16x4f32(sa, bw[s][0], c0, 0, 0, 0); c1 = __builtin_amdgcn_mfma_f32_16x16x4f32(sa, bw[s][1], c1, 0, 0, 0); }
#pragma unroll
            for (int r = 0; r < 4; ++r) { part[(wave * 16 + 4 * kk + r) * 32 + 2 * j] = c0[r]; part[(wave * 16 + 4 * kk + r) * 32 + 2 * j + 1] = c1[r]; }
            __syncthreads();
            { const int b = tid >> 5, col = tid & 31; float s = 0.f;
#pragma unroll
              for (int w8 = 0; w8 < 8; ++w8) s += part[(w8 * 16 + b) * 32 + col];
              st_wt(&MOD[b * 6144 + n0 + col], s + b_ada[n0 + col]); }
            __syncthreads();
        }
        {
          constexpr int NBLK = T * 16 / 512;
          if (G == 256) { if (bx >= 192) { int pv[16];
#pragma unroll
                  for (int m = 0; m < 16; ++m) pv[m] = pos[(((bx - 192) + 64 * m) * 512 + tid) >> 4];
                  weight_copies(ln);
                  __syncthreads(); prefetch_x(ln);
#pragma unroll
                  for (int m = 0; m < 16; ++m) { const int idx = ((bx - 192) + 64 * m) * 512 + tid; const int t = idx >> 4, i = idx & 15; const float ang = (float)pv[m] * c_invfreq[i];
                      float sn, cs; sincosf(ang, &sn, &cs); st_wt(&ROPE[(size_t)t * 32 + i], cs); st_wt(&ROPE[(size_t)t * 32 + 16 + i], sn); } } }
          else { if (bx >= 192) { weight_copies(ln); __syncthreads(); prefetch_x(ln); }
          for (int blk = bx; blk < NBLK; blk += G) { const int idx = blk * 512 + tid; const int t = idx >> 4, i = idx & 15; const float ang = (float)pos[t] * c_invfreq[i];
              float sn, cs; sincosf(ang, &sn, &cs); st_wt(&ROPE[(size_t)t * 32 + i], cs); st_wt(&ROPE[(size_t)t * 32 + 16 + i], sn); } } }
    }
    if (IN(0) && IN(1)) xcd_barrier(bar, false);
    const bool grouped1 = (MK_N_LAUNCHES == 1) && (MISC[13] != 0u) && IN(0);
    pg8::Unit u2{0, 0}; if (grouped1) { pg8::StaticOrder S2; S2.init(T, 512, G, (int)(MISC[11] * 8u + bar.x)); (void)S2.next(0, u2); }
    const int r1 = grouped1 ? 256 * u2.pm + 128 * u2.pn + 16 * wave : gw * 16;
    if (IN(1)) {
        OPAQUE_LANE(ln);
        for (int row0 = r1; row0 < T; row0 += NGW * 16) { const int b = row0 / SEQ; const float* mb = MOD + b * 6144;
            f32x4 sc[4], sh[4];
#pragma unroll
            for (int j = 0; j < 4; ++j) { const int col = 4 * ln + 256 * j; sh[j] = *(const f32x4*)(mb + col); sc[j] = *(const f32x4*)(mb + 1024 + col) + 1.f; }
            f32x4 xn[4];
#pragma unroll
            for (int j = 0; j < 4; ++j) { if (grouped1 && row0 == r1) xn[j] = xpre[j]; else xn[j] = __builtin_nontemporal_load((const f32x4*)(x + (size_t)row0 * D + 4 * ln + 256 * j)); }
            for (int rr = 0; rr < 16; ++rr) { const int t = row0 + rr;
                f32x4 v[4]; float s = 0.f;
#pragma unroll
                for (int j = 0; j < 4; ++j) { v[j] = xn[j]; s += (v[j][0] + v[j][1]) + (v[j][2] + v[j][3]); }
                if (rr + 1 < 16) {
#pragma unroll
                    for (int j = 0; j < 4; ++j) xn[j] = __builtin_nontemporal_load((const f32x4*)(x + (size_t)(t + 1) * D + 4 * ln + 256 * j)); }
                const float mean = wave_sum(s) * (1.f / D); float q = 0.f;
#pragma unroll
                for (int j = 0; j < 4; ++j) { v[j] = v[j] - mean; q += (v[j][0] * v[j][0] + v[j][1] * v[j][1]) + (v[j][2] * v[j][2] + v[j][3] * v[j][3]); }
                const float rstd = rsqrtf(wave_sum(q) * (1.f / D) + 1e-5f);
#pragma unroll
                for (int j = 0; j < 4; ++j) { const f32x4 o = v[j] * rstd * sc[j] + sh[j]; u32x2 w; w.x = cvt_pk_bf16(o[0], o[1]); w.y = cvt_pk_bf16(o[2], o[3]);
                    *(u32x2*)(HB + (size_t)t * D + 4 * ln + 256 * j) = w; } } }
    }
    if (IN(1) && IN(2)) { if (grouped1) pair_barrier(bar, u2.pm); else xcd_barrier(bar); }
    const bool grouped = (MK_N_LAUNCHES == 1) && (MISC[13] != 0u);
    const int cP = grouped ? (int)(MISC[11] * 8u + bar.x) : bx;
    const int vcuP = grouped ? (int)(bar.x * 32u + MISC[11]) : vcu, gwP = vcuP * 8 + wave;
#define GSEAM(k) do { if (IN(k) && IN((k) + 1)) { if (grouped) group_barrier(bar, (k) == 4, (k) == 6 ? 8u : 0u); else xcd_barrier(bar); } } while (0)
    if (IN(2)) {
        pg8::Gemm g{HB, D, WIN, T, 512, D}; pg8::StaticOrder S; S.init(T, 512, G, cP);
        pg8::EpiP E1{P, U, SSQQ, SSQKV};
        pg8::gemm_phase<pg8::EpiP, true>(lds, g, S, E1);
    }
    GSEAM(2);
    if (IN(3)) {
        { pg8::MixedOrder S{(const char*)HB, (const char*)P, (const char*)WIN, (const char*)WQ, (const char*)WKV, G, cP};
          pg8::EpiMix EM{pg8::EpiP{P, U, SSQQ, SSQKV}, pg8::EpiStore{Qb, QW, true}, pg8::EpiKV{KN, Vb}, SSQKV};
          pg8::gemm_multi<pg8::MixedOrder, pg8::EpiMix>(lds, S, EM); }
        { OPAQUE_LANE(ln);
        for (int row0 = gwP * 16; row0 < T; row0 += NGW * 16) {
            { const int t = row0 + (ln >> 2), c = ln & 3, i0 = 8 * (c & 1); const bf16_t* pr = P + (size_t)t * PW + 384;
              const u32x4 r1 = *(const u32x4*)(pr + i0), r2 = *(const u32x4*)(pr + 16 + i0);
              const f32x4 ca = *(const f32x4*)(ROPE + (size_t)t * 32 + i0), cb = *(const f32x4*)(ROPE + (size_t)t * 32 + i0 + 4), sa = *(const f32x4*)(ROPE + (size_t)t * 32 + 16 + i0), sb = *(const f32x4*)(ROPE + (size_t)t * 32 + 16 + i0 + 4);
              float ov[8];
#pragma unroll
              for (int e = 0; e < 8; ++e) { const float x1 = (e & 1) ? bf_hi(r1[e >> 1]) : bf_lo(r1[e >> 1]), x2 = (e & 1) ? bf_hi(r2[e >> 1]) : bf_lo(r2[e >> 1]);
                  const float cs = (e < 4) ? ca[e & 3] : cb[e & 3], sn = (e < 4) ? sa[e & 3] : sb[e & 3];
                  ov[e] = (c < 2) ? x1 * cs - x2 * sn : x2 * cs + x1 * sn; }
              u32x4 o; o.x = cvt_pk_bf16(ov[0], ov[1]); o.y = cvt_pk_bf16(ov[2], ov[3]); o.z = cvt_pk_bf16(ov[4], ov[5]); o.w = cvt_pk_bf16(ov[6], ov[7]);
              *(u32x4*)((char*)KR + (size_t)(t >> 6) * 4096 + c * 1024 + (t & 63) * 16) = o; }
        }
        }
    }
    GSEAM(3);
    if (IN(4)) {
        att::attn_phase(vcuP, G, SSQQ, ROPE, Qb, KN, KR, Vb, Y, ong, lds);
        { OPAQUE_LANE(ln);
        for (int row0 = gwP * 16; row0 < T; row0 += NGW * 16) {
            const int c0 = 8 * ln;
            float w0[8], w1[8], w2[8], cb8[8], gn[8];
#pragma unroll
            for (int e = 0; e < 8; ++e) { w0[e] = conv_w[c0 + e]; w1[e] = conv_w[512 + c0 + e]; w2[e] = conv_w[1024 + c0 + e]; cb8[e] = conv_b[c0 + e]; gn[e] = ong[512 + c0 + e]; }
            float um2[8], um1[8];
#pragma unroll
            for (int e = 0; e < 8; ++e) { um2[e] = 0.f; um1[e] = 0.f; }
            if ((row0 % SEQ) != 0) {
                const u32x4 a2 = *(const u32x4*)(U + (size_t)(row0 - 2) * 512 + c0), a1 = *(const u32x4*)(U + (size_t)(row0 - 1) * 512 + c0);
#pragma unroll
                for (int e = 0; e < 4; ++e) { um2[2 * e] = bf_lo(a2[e]); um2[2 * e + 1] = bf_hi(a2[e]); um1[2 * e] = bf_lo(a1[e]); um1[2 * e + 1] = bf_hi(a1[e]); }
            }
            u32x4 gbn[4], uun[4];
#pragma unroll
            for (int q = 0; q < 4; ++q) { gbn[q] = __builtin_nontemporal_load((const u32x4*)(P + (size_t)(row0 + q) * PW + 512 + c0)); uun[q] = __builtin_nontemporal_load((const u32x4*)(U + (size_t)(row0 + q) * 512 + c0)); }
#pragma unroll
            for (int rr = 0; rr < 16; ++rr) { const int t = row0 + rr;
                const u32x4 gb = gbn[rr & 3], uu = uun[rr & 3];
                if (rr + 4 < 16) { gbn[rr & 3] = __builtin_nontemporal_load((const u32x4*)(P + (size_t)(t + 4) * PW + 512 + c0)); uun[rr & 3] = __builtin_nontemporal_load((const u32x4*)(U + (size_t)(t + 4) * 512 + c0)); }
                float u0[8], yv[8]; float ss = 0.f;
#pragma unroll
                for (int e = 0; e < 4; ++e) { u0[2 * e] = bf_lo(uu[e]); u0[2 * e + 1] = bf_hi(uu[e]); }
#pragma unroll
                for (int e = 0; e < 8; ++e) { const float gbe = (e & 1) ? bf_hi(gb[e >> 1]) : bf_lo(gb[e >> 1]);
                    yv[e] = gbe * (cb8[e] + w0[e] * um2[e] + w1[e] * um1[e] + w2[e] * u0[e]); ss += yv[e] * yv[e]; um2[e] = um1[e]; um1[e] = u0[e]; }
                ss += __shfl_xor(ss, 1); ss += __shfl_xor(ss, 2); ss += __shfl_xor(ss, 4);
                const float rs = rsqrtf(ss * (1.f / 64.f) + 1e-6f);
                u32x4 o; o.x = cvt_pk_bf16(yv[0] * rs * gn[0], yv[1] * rs * gn[1]); o.y = cvt_pk_bf16(yv[2] * rs * gn[2], yv[3] * rs * gn[3]);
                o.z = cvt_pk_bf16(yv[4] * rs * gn[4], yv[5] * rs * gn[5]); o.w = cvt_pk_bf16(yv[6] * rs * gn[6], yv[7] * rs * gn[7]);
                *(u32x4*)(Y + (size_t)t * D + 512 + c0) = o; }
        }
            }
    }
    GSEAM(4);
    auto p6_rows = [&](const int rfirst, const int nr) __attribute__((always_inline)) {
        OPAQUE_LANE(ln);
        for (int row0 = rfirst; row0 < T; row0 += T) { const int b = row0 / SEQ; const float* mb = MOD + b * 6144;
            f32x4 gt[4], g1v[4], b1v[4], sc[4], sh[4];
#pragma unroll
            for (int j = 0; j < 4; ++j) { const int col = 4 * ln + 256 * j; gt[j] = *(const f32x4*)(mb + 2048 + col); g1v[j] = *(const f32x4*)(ln1g + col); b1v[j] = *(const f32x4*)(ln1b + col);
                sh[j] = *(const f32x4*)(mb + 3072 + col); sc[j] = *(const f32x4*)(mb + 4096 + col) + 1.f; }
            f32x4 xn[4]; u32x2 mn[4];
#pragma unroll
            for (int j = 0; j < 4; ++j) { const int col = 4 * ln + 256 * j; xn[j] = __builtin_nontemporal_load((const f32x4*)(x + (size_t)row0 * D + col)); mn[j] = __builtin_nontemporal_load((const u32x2*)(MIX + (size_t)row0 * D + col)); }
            for (int rr = 0; rr < nr; ++rr) { const int t = row0 + rr;
                f32x4 v[4]; float s = 0.f;
#pragma unroll
                for (int j = 0; j < 4; ++j) { const f32x4 mx = {bf_lo(mn[j].x), bf_hi(mn[j].x), bf_lo(mn[j].y), bf_hi(mn[j].y)};
                    v[j] = xn[j] * ALPHA + gt[j] * mx; s += (v[j][0] + v[j][1]) + (v[j][2] + v[j][3]); }
                if (rr + 1 < nr) {
#pragma unroll
                    for (int j = 0; j < 4; ++j) { const int col = 4 * ln + 256 * j; xn[j] = __builtin_nontemporal_load((const f32x4*)(x + (size_t)(t + 1) * D + col)); mn[j] = __builtin_nontemporal_load((const u32x2*)(MIX + (size_t)(t + 1) * D + col)); } }
                float mean = wave_sum(s) * (1.f / D); float q = 0.f;
#pragma unroll
                for (int j = 0; j < 4; ++j) { v[j] = v[j] - mean; q += (v[j][0] * v[j][0] + v[j][1] * v[j][1]) + (v[j][2] * v[j][2] + v[j][3] * v[j][3]); }
                float rstd = rsqrtf(wave_sum(q) * (1.f / D) + 1e-5f);
                s = 0.f;
#pragma unroll
                for (int j = 0; j < 4; ++j) { v[j] = v[j] * rstd * g1v[j] + b1v[j]; u32x2 w; w.x = cvt_pk_bf16(v[j][0], v[j][1]); w.y = cvt_pk_bf16(v[j][2], v[j][3]); __builtin_nontemporal_store(w, (u32x2*)(X1 + (size_t)t * D + 4 * ln + 256 * j)); s += (v[j][0] + v[j][1]) + (v[j][2] + v[j][3]); }
                mean = wave_sum(s) * (1.f / D); q = 0.f;
#pragma unroll
                for (int j = 0; j < 4; ++j) { v[j] = v[j] - mean; q += (v[j][0] * v[j][0] + v[j][1] * v[j][1]) + (v[j][2] * v[j][2] + v[j][3] * v[j][3]); }
                rstd = rsqrtf(wave_sum(q) * (1.f / D) + 1e-5f);
#pragma unroll
                for (int j = 0; j < 4; ++j) { const f32x4 o = v[j] * rstd * sc[j] + sh[j]; u32x2 w; w.x = cvt_pk_bf16(o[0], o[1]); w.y = cvt_pk_bf16(o[2], o[3]);
                    *(u32x2*)(HB + (size_t)t * D + 4 * ln + 256 * j) = w; } } }
    };
    const bool split56 = grouped && bar.x >= 5u && IN(5) && IN(6);
    if (split56) {
        const int rbase = (int)bar.x * 4096 + ((int)MISC[11] * 8 + wave) * 8;
        { pg8::Gemm g{Y, D, WOUT, T, D, D}; pg8::StaticOrder S; S.init(T, D, G, cP); S.i1 = 1; pg8::EpiStore E4{MIX, D, true};
          pg8::gemm_phase<pg8::EpiStore, true>(lds, g, S, E4); }
        group_barrier(bar, false, 0u);
        p6_rows(rbase, 8);
        { pg8::Gemm g{Y, D, WOUT, T, D, D}; pg8::StaticOrder S; S.init(T, D, G, cP); S.i0 = 1; pg8::EpiStore E4{MIX, D, true};
          pg8::gemm_phase<pg8::EpiStore, true>(lds, g, S, E4); }
        group_barrier(bar, false, 0u);
        p6_rows(rbase + 2048, 8);
    } else {
        if (IN(5)) {
            pg8::Gemm g{Y, D, WOUT, T, D, D}; pg8::StaticOrder S; S.init(T, D, G, cP); pg8::EpiStore E4{MIX, D, true};
            pg8::gemm_phase<pg8::EpiStore, true>(lds, g, S, E4);
        }
        GSEAM(5);
        if (IN(6)) { for (int row0 = gwP * 16; row0 < T; row0 += NGW * 16) p6_rows(row0, 16); }
    }
    GSEAM(6);
    if (IN(7)) {
        pg8::Gemm g{HB, D, WUP, T, UPW, D}; pg8::StaticOrder S; S.init(T, UPW, G, cP); pg8::EpiUp E5{ACT, E, fcw, fcb};
        pg8::gemm_phase<pg8::EpiUp, true>(lds, g, S, E5);
    }
    GSEAM(7);
    if (IN(8)) {
        OPAQUE_LANE(ln);
        constexpr int NITEM = 128 * 2 * (DFF / 4);
        const int it0 = grouped ? (int)MISC[11] * 512 + tid : gw * 64 + ln, itn = grouped ? 16 * 2 * (DFF / 4) : NITEM, its = grouped ? 32 * 512 : NGW * 64, tile0 = grouped ? 16 * (int)bar.x : 0;
        for (int it = it0; it < itn; it += its) { const int c4 = it % (DFF / 4), rb = it / (DFF / 4), rr = rb & 1, blk = 4 * (tile0 + (rb >> 1)); const int c0 = 4 * c4;
            const bool first = (blk & 31) == 0;
            const float* e0 = E + ((size_t)blk * 4 + rr) * UPW + c0;
            const float* em1 = (rr == 0) ? E + ((size_t)(blk - 1) * 4 + 3) * UPW + c0 : E + ((size_t)blk * 4 + 0) * UPW + c0;
            const float* em2 = (rr == 0) ? E + ((size_t)(blk - 1) * 4 + 2) * UPW + c0 : E + ((size_t)(blk - 1) * 4 + 3) * UPW + c0;
            const f32x4 z = {0.f, 0.f, 0.f, 0.f};
            const f32x4 g0 = *(const f32x4*)e0, v0 = *(const f32x4*)(e0 + DFF);
            const bool has1 = !(first && rr == 0), has2 = !first;
            const f32x4 g1 = has1 ? *(const f32x4*)em1 : z, v1 = has1 ? *(const f32x4*)(em1 + DFF) : z;
            const f32x4 g2 = has2 ? *(const f32x4*)em2 : z, v2 = has2 ? *(const f32x4*)(em2 + DFF) : z;
            const f32x4 wg0 = *(const f32x4*)(fcw + c0), wg1 = *(const f32x4*)(fcw + UPW + c0), wg2 = *(const f32x4*)(fcw + 2 * UPW + c0), bg = *(const f32x4*)(fcb + c0);
            const f32x4 wv0 = *(const f32x4*)(fcw + DFF + c0), wv1 = *(const f32x4*)(fcw + UPW + DFF + c0), wv2 = *(const f32x4*)(fcw + 2 * UPW + DFF + c0), bv = *(const f32x4*)(fcb + DFF + c0);
            const f32x4 cg = bg + wg0 * g2 + wg1 * g1 + wg2 * g0, cv = bv + wv0 * v2 + wv1 * v1 + wv2 * v0;
            u32x2 w; w.x = cvt_pk_bf16(silu_f(cg[0]) * cv[0], silu_f(cg[1]) * cv[1]); w.y = cvt_pk_bf16(silu_f(cg[2]) * cv[2], silu_f(cg[3]) * cv[3]);
            *(u32x2*)(ACT + (size_t)(64 * blk + rr) * DFF + c0) = w; }
    }
    GSEAM(8);
    if (IN(9)) {
        pg8::Gemm g{ACT, DFF, WDN, T, D, DFF}; pg8::StaticOrder S; S.init(T, D, G, cP); pg8::EpiStore E6{FF, D, true};
        pg8::gemm_phase<pg8::EpiStore, true>(lds, g, S, E6);
    }
    GSEAM(9);
    if (IN(10)) {
        OPAQUE_LANE(ln);
        for (int row0 = gwP * 16; row0 < T; row0 += NGW * 16) { const int b = row0 / SEQ; const float* mb = MOD + b * 6144;
            f32x4 gt[4], g2v[4], b2v[4];
#pragma unroll
            for (int j = 0; j < 4; ++j) { const int col = 4 * ln + 256 * j; gt[j] = *(const f32x4*)(mb + 5120 + col); g2v[j] = *(const f32x4*)(ln2g + col); b2v[j] = *(const f32x4*)(ln2b + col); }
            u32x2 xn[4], mn[4];
#pragma unroll
            for (int j = 0; j < 4; ++j) { const int col = 4 * ln + 256 * j; xn[j] = __builtin_nontemporal_load((const u32x2*)(X1 + (size_t)row0 * D + col)); mn[j] = __builtin_nontemporal_load((const u32x2*)(FF + (size_t)row0 * D + col)); }
            for (int rr = 0; rr < 16; ++rr) { const int t = row0 + rr;
                f32x4 v[4]; float s = 0.f; u32x2 xc[4], mc[4];
#pragma unroll
                for (int j = 0; j < 4; ++j) { xc[j] = xn[j]; mc[j] = mn[j]; }
                if (rr + 1 < 16) {
#pragma unroll
                    for (int j = 0; j < 4; ++j) { const int col = 4 * ln + 256 * j; xn[j] = __builtin_nontemporal_load((const u32x2*)(X1 + (size_t)(t + 1) * D + col)); mn[j] = __builtin_nontemporal_load((const u32x2*)(FF + (size_t)(t + 1) * D + col)); } }
#pragma unroll
                for (int j = 0; j < 4; ++j) { const u32x2 xw = xc[j]; const f32x4 xv = {bf_lo(xw.x), bf_hi(xw.x), bf_lo(xw.y), bf_hi(xw.y)}; const u32x2 mw = mc[j];
                    const f32x4 mx = {bf_lo(mw.x), bf_hi(mw.x), bf_lo(mw.y), bf_hi(mw.y)};
                    v[j] = xv * ALPHA + gt[j] * mx; s += (v[j][0] + v[j][1]) + (v[j][2] + v[j][3]); }
                const float mean = wave_sum(s) * (1.f / D); float q = 0.f;
#pragma unroll
                for (int j = 0; j < 4; ++j) { v[j] = v[j] - mean; q += (v[j][0] * v[j][0] + v[j][1] * v[j][1]) + (v[j][2] * v[j][2] + v[j][3] * v[j][3]); }
                const float rstd = rsqrtf(wave_sum(q) * (1.f / D) + 1e-5f);
#pragma unroll
                for (int j = 0; j < 4; ++j) { *(f32x4*)(out + (size_t)t * D + 4 * ln + 256 * j) = v[j] * rstd * g2v[j] + b2v[j]; } } }
    }
    if (MK_N_LAUNCHES == 1) {
        if (tid == 0) { const unsigned o = __hip_atomic_fetch_add(&g_ctl[GCTL_FIN], 1u, __ATOMIC_RELAXED, __HIP_MEMORY_SCOPE_AGENT); MISC[12] = (o + 1u == (unsigned)G) ? 1u : 0u; }
        __syncthreads();
        if (MISC[12] != 0u) { for (int i = tid; i < GCTL_WORDS; i += 512) __hip_atomic_store(&g_ctl[i], 0u, __ATOMIC_RELAXED, __HIP_MEMORY_SCOPE_AGENT); }
    }
#undef IN
#undef SEAM
}

extern "C" void kernel_launch(void* const* d_in, const int* in_sizes, int n_in, void* d_out, int out_size, void* d_ws, size_t ws_size, hipStream_t stream) {
    static int grid = 0;
    if (grid == 0) {
        if (n_in != 22 || in_sizes[0] != T * D || out_size != T * D || ws_size < WS_END) { fprintf(stderr, "kernel_launch: unexpected shapes / workspace (n_in %d, ws %zu)\n", n_in, ws_size); grid = -1; return; }
        int dev = 0, cus = 0, per_cu = 0;
        if (hipGetDevice(&dev) != hipSuccess || hipDeviceGetAttribute(&cus, hipDeviceAttributeMultiprocessorCount, dev) != hipSuccess) { grid = -1; return; }
        if (hipFuncSetAttribute((const void*)mk_fwd, hipFuncAttributeMaxDynamicSharedMemorySize, LDS_BYTES) != hipSuccess) { fprintf(stderr, "kernel_launch: hipFuncSetAttribute failed\n"); grid = -1; return; }
        if (hipOccupancyMaxActiveBlocksPerMultiprocessor(&per_cu, (const void*)mk_fwd, 512, LDS_BYTES) != hipSuccess || per_cu < 1) { fprintf(stderr, "kernel_launch: occupancy query says %d blocks per CU\n", per_cu); (void)hipGetLastError(); grid = -1; return; }
        grid = cus;
    }
    if (grid < 0) return;
    Args a{};
    for (int i = 0; i < 22; ++i) a.in[i] = (const float*)d_in[i];
    a.pos = (const int*)d_in[2]; a.out = (float*)d_out; a.ws = (unsigned char*)d_ws;
#if MK_N_LAUNCHES == 1
    a.ph_lo = 0; a.ph_hi = N_PHASES;
    hipLaunchKernelGGL(mk_fwd, dim3(grid), dim3(512), LDS_BYTES, stream, a);
#else
    for (int p = 0; p < N_PHASES; ++p) { a.ph_lo = p; a.ph_hi = p + 1; hipLaunchKernelGGL(mk_fwd, dim3(grid), dim3(512), LDS_BYTES, stream, a); }
#endif
}
```
